# Optimizing an MI355X kernel written in HIP

```python
import jax
import jax.numpy as jnp
from jax import lax
import numpy as np

D_MODEL = 1024
BATCH = 16
SEQ = 2048
DEPTH = 2

N_MIXERS = 2
EPS = 1e-6
NEG = -1e30
BIG = 1e9
ROPE_THETA = 500000.0

NSA_HEADS = 16
NSA_KV_GROUPS = 2
NSA_HEADS_PER_GROUP = NSA_HEADS // NSA_KV_GROUPS
HEAD_DIM = D_MODEL // NSA_HEADS
ROT_DIM = HEAD_DIM // 4
CMP_BLOCK = 32
CMP_STRIDE = 16
CMP_HIDDEN = 256
SEL_BLOCK = 64
SEL_TOPN = 8
WINDOW = 512
NSA_Q_BLOCK = 64
NSA_BRANCHES = 3
NSA_Q_COLS = NSA_HEADS * HEAD_DIM
NSA_KV_COLS = NSA_KV_GROUPS * HEAD_DIM
NSA_GATE_COLS = NSA_BRANCHES * NSA_HEADS
NSA_IN_COLS = NSA_Q_COLS + 2 * NSA_BRANCHES * NSA_KV_COLS + NSA_GATE_COLS

MLSTM_HEADS = 4
MLSTM_V_DIM = D_MODEL // MLSTM_HEADS
MLSTM_QK_DIM = MLSTM_V_DIM // 2
MLSTM_CHUNK = 64
GATE_SOFTCAP = 15.0
MLSTM_IN_COLS = 2 * MLSTM_HEADS * MLSTM_QK_DIM + 2 * MLSTM_HEADS * MLSTM_V_DIM + 2 * MLSTM_HEADS

N_EXPERTS = 32
N_GROUPS = 4
EXPERTS_PER_GROUP = N_EXPERTS // N_GROUPS
TOP_K = 2
D_EXPERT = 512
MOE_BLOCK = 128

kernel_name = 'hybrid_nsa_mlstm_grouped_moe_adaln'


def rms_norm(x, gain):
    xf = x.astype(jnp.float32)
    y = xf * lax.rsqrt(jnp.mean(xf * xf, axis=-1, keepdims=True) + EPS)
    return (y * gain.astype(jnp.float32)).astype(x.dtype)


def softcap(a):
    return GATE_SOFTCAP * jnp.tanh(a / GATE_SOFTCAP)


def partial_rope(x, pos):
    half = ROT_DIM // 2
    inv_freq = ROPE_THETA ** (-jnp.arange(half, dtype=jnp.float32) / half)
    ang = pos.astype(jnp.float32)[:, None] * inv_freq[None, :]
    cos = jnp.cos(ang)[:, None, :]
    sin = jnp.sin(ang)[:, None, :]
    xr = x[..., :ROT_DIM].astype(jnp.float32)
    x1, x2 = xr[..., :half], xr[..., half:]
    rot = jnp.concatenate([x1 * cos - x2 * sin, x2 * cos + x1 * sin], axis=-1).astype(x.dtype)
    return jnp.concatenate([rot, x[..., ROT_DIM:]], axis=-1)


def split_cols(a, sizes):
    return jnp.split(a, np.cumsum(sizes)[:-1].tolist(), axis=-1)


def to_group_major(a):
    return jnp.transpose(a, (0, 2, 1, 3))


def nsa_compress(a, pe, w1, b1, w2, b2):
    B, S, G, dh = a.shape
    nc = (S - CMP_BLOCK) // CMP_STRIDE + 1
    idx = np.arange(nc)[:, None] * CMP_STRIDE + np.arange(CMP_BLOCK)[None, :]
    blocks = a[:, idx] + pe[None, None, :, None, :]
    blocks = blocks.transpose(0, 1, 3, 2, 4).reshape(B, nc, G, CMP_BLOCK * dh)
    return jax.nn.gelu(blocks @ w1 + b1) @ w2 + b2


def nsa_mixer(h, w_in, w_out, q_gain, k_gain, cmp_pe, cmp_w1, cmp_b1, cmp_w2, cmp_b2):
    B, S, _ = h.shape
    G, R, dh, QB = NSA_KV_GROUPS, NSA_HEADS_PER_GROUP, HEAD_DIM, NSA_Q_BLOCK
    f32 = jnp.float32
    pos = jnp.arange(S, dtype=jnp.int32)
    q, kc, vc, ks, vs, kw, vw, gates = split_cols(h @ w_in, [NSA_Q_COLS] + [NSA_KV_COLS] * 6 + [NSA_GATE_COLS])
    q = partial_rope(rms_norm(q.reshape(B, S, NSA_HEADS, dh), q_gain), pos)
    ks = partial_rope(rms_norm(ks.reshape(B, S, G, dh), k_gain[1]), pos)
    kw = partial_rope(rms_norm(kw.reshape(B, S, G, dh), k_gain[2]), pos)
    kc = nsa_compress(kc.reshape(B, S, G, dh), cmp_pe[0], cmp_w1[0], cmp_b1[0], cmp_w2[0], cmp_b2[0])
    vc = nsa_compress(vc.reshape(B, S, G, dh), cmp_pe[1], cmp_w1[1], cmp_b1[1], cmp_w2[1], cmp_b2[1])
    nc = kc.shape[1]
    cmp_pos = jnp.arange(nc, dtype=jnp.int32) * CMP_STRIDE + (CMP_BLOCK - 1)
    kc = to_group_major(partial_rope(rms_norm(kc, k_gain[0]), cmp_pos))
    vc = to_group_major(vc)
    ns = S // SEL_BLOCK
    ks_blk = to_group_major(ks).reshape(B, G, ns, SEL_BLOCK, dh)
    vs_blk = to_group_major(vs.reshape(B, S, G, dh)).reshape(B, G, ns, SEL_BLOCK, dh)
    pad = ((0, 0), (0, 0), (WINDOW, 0), (0, 0))
    kw_pad = jnp.pad(to_group_major(kw), pad)
    vw_pad = jnp.pad(to_group_major(vw.reshape(B, S, G, dh)), pad)
    r, u = SEL_BLOCK // CMP_STRIDE, CMP_BLOCK // CMP_STRIDE
    c_idx = (r * np.arange(ns)[:, None, None] + np.arange(r)[None, :, None] + np.arange(u)[None, None, :]).reshape(ns, -1)
    cmp_to_sel = jnp.asarray((c_idx[:, :, None] == np.arange(nc)[None, None, :]).sum(1).T.astype(np.float32))
    n_top = min(SEL_TOPN, ns)
    scale = HEAD_DIM ** -0.5
    blk = jnp.arange(ns, dtype=jnp.int32)
    bi = jnp.arange(B)[:, None, None, None]
    gi = jnp.arange(G)[None, :, None, None]

    def attend_block(args):
        qb, gb, s0 = args
        t = s0 + jnp.arange(QB, dtype=jnp.int32)
        sc = jnp.einsum('bgrqd,bgcd->bgrqc', qb, kc).astype(f32) * scale
        valid_c = cmp_pos[None, :] <= t[:, None]
        p_c = jnp.where(valid_c, jax.nn.softmax(jnp.where(valid_c, sc, NEG), axis=-1), 0.0)
        o_c = jnp.einsum('bgrqc,bgcd->bgrqd', p_c.astype(vc.dtype), vc)
        imp = jnp.einsum('bgrqc,cj->bgqj', p_c, cmp_to_sel)
        cur = t // SEL_BLOCK
        forced = (blk[None, :] == 0) | (blk[None, :] == cur[:, None]) | (blk[None, :] == cur[:, None] - 1)
        allowed = blk[None, :] <= cur[:, None]
        imp = jnp.where(allowed, jnp.where(forced, BIG, imp), -BIG)
        _, sel = lax.top_k(imp, n_top)
        k_g = ks_blk[bi, gi, sel].reshape(B, G, QB, n_top * SEL_BLOCK, dh)
        v_g = vs_blk[bi, gi, sel].reshape(B, G, QB, n_top * SEL_BLOCK, dh)
        kpos = (sel[..., None] * SEL_BLOCK + jnp.arange(SEL_BLOCK, dtype=jnp.int32)).reshape(B, G, QB, n_top * SEL_BLOCK)
        valid_s = kpos[:, :, None] <= t[:, None]
        ss = jnp.einsum('bgrqd,bgqkd->bgrqk', qb, k_g).astype(f32) * scale
        p_s = jax.nn.softmax(jnp.where(valid_s, ss, NEG), axis=-1)
        o_s = jnp.einsum('bgrqk,bgqkd->bgrqd', p_s.astype(v_g.dtype), v_g)
        kwb = lax.dynamic_slice_in_dim(kw_pad, s0, WINDOW + QB, axis=2)
        vwb = lax.dynamic_slice_in_dim(vw_pad, s0, WINDOW + QB, axis=2)
        wpos = s0 - WINDOW + jnp.arange(WINDOW + QB, dtype=jnp.int32)
        valid_w = (wpos[None, :] <= t[:, None]) & (wpos[None, :] > t[:, None] - WINDOW) & (wpos[None, :] >= 0)
        sw = jnp.einsum('bgrqd,bgkd->bgrqk', qb, kwb).astype(f32) * scale
        p_w = jax.nn.softmax(jnp.where(valid_w, sw, NEG), axis=-1)
        o_w = jnp.einsum('bgrqk,bgkd->bgrqd', p_w.astype(vwb.dtype), vwb)
        return gb[:, 0][..., None] * o_c + gb[:, 1][..., None] * o_s + gb[:, 2][..., None] * o_w

    nq = S // QB
    q_blocks = q.reshape(B, nq, QB, G, R, dh).transpose(1, 0, 3, 4, 2, 5)
    g_blocks = jax.nn.sigmoid(gates).reshape(B, nq, QB, NSA_BRANCHES, G, R).transpose(1, 0, 3, 4, 5, 2)
    starts = jnp.arange(nq, dtype=jnp.int32) * QB
    o = lax.map(attend_block, (q_blocks, g_blocks, starts))
    o = o.transpose(1, 0, 4, 2, 3, 5).reshape(B, S, NSA_Q_COLS)
    return o @ w_out


def mlstm_mixer(h, w_in, w_out, b_igate, b_fgate, norm_gain):
    B, S, _ = h.shape
    NH, dqk, dv, L = MLSTM_HEADS, MLSTM_QK_DIM, MLSTM_V_DIM, MLSTM_CHUNK
    f32 = jnp.float32
    q, k, v, o, ig, fg = split_cols(h @ w_in, [NH * dqk, NH * dqk, NH * dv, NH * dv, NH, NH])

    def to_heads(a, d):
        return a.reshape(B, S, NH, d).transpose(0, 2, 1, 3).astype(f32)

    q = to_heads(q, dqk)
    k = to_heads(k, dqk) * (dqk ** -0.5)
    v = to_heads(v, dv)
    li = softcap(ig.astype(f32) + b_igate.astype(f32)).transpose(0, 2, 1)
    lf = jax.nn.log_sigmoid(softcap(fg.astype(f32) + b_fgate.astype(f32))).transpose(0, 2, 1)
    nch = S // L

    def to_chunks(a):
        return jnp.moveaxis(a.reshape(B, NH, nch, L, *a.shape[3:]), 2, 0)

    causal = np.tril(np.ones((L, L), dtype=bool))

    def step(carry, xs):
        C, n, m = carry
        qc, kc, vc, lic, lfc = xs
        b = jnp.cumsum(lfc, axis=-1)
        D = jnp.where(causal, b[..., :, None] - b[..., None, :] + lic[..., None, :], NEG)
        m_inter = b + m[..., None]
        m_t = jnp.maximum(m_inter, D.max(-1))
        A = jnp.exp(D - m_t[..., None]) * jnp.einsum('bhqd,bhkd->bhqk', qc, kc)
        inter = jnp.exp(m_inter - m_t)
        num = jnp.einsum('bhqk,bhkv->bhqv', A, vc) + inter[..., None] * jnp.einsum('bhqd,bhdv->bhqv', qc, C)
        den = A.sum(-1) + inter * jnp.einsum('bhqd,bhd->bhq', qc, n)
        h_out = num / jnp.maximum(jnp.abs(den), jnp.exp(-m_t))[..., None]
        m_new = m_t[..., -1]
        w = jnp.exp(b[..., -1:] - b + lic - m_new[..., None])
        decay = jnp.exp(m_inter[..., -1] - m_new)
        C_new = decay[..., None, None] * C + jnp.einsum('bhs,bhsd,bhsv->bhdv', w, kc, vc)
        n_new = decay[..., None] * n + jnp.einsum('bhs,bhsd->bhd', w, kc)
        return (C_new, n_new, m_new), h_out

    init = (jnp.zeros((B, NH, dqk, dv), f32), jnp.zeros((B, NH, dqk), f32), jnp.zeros((B, NH), f32))
    _, hs = lax.scan(step, init, (to_chunks(q), to_chunks(k), to_chunks(v), to_chunks(li), to_chunks(lf)))
    hs = jnp.moveaxis(hs, 0, 2).reshape(B, NH, S, dv).transpose(0, 2, 1, 3)
    hs = rms_norm(hs, norm_gain).reshape(B, S, NH * dv).astype(h.dtype)
    return (jax.nn.sigmoid(o) * hs) @ w_out


def moe_ffn(h, router_w, router_b, w_gate, w_up, w_down):
    B, S, D = h.shape
    T = B * S
    f32 = jnp.float32
    xf = h.reshape(T, D)
    affinity = jax.nn.sigmoid(xf.astype(f32) @ router_w.astype(f32))
    choice = (affinity + router_b.astype(f32)).reshape(T, N_GROUPS, EXPERTS_PER_GROUP)
    group_score = lax.top_k(choice, TOP_K)[0].sum(-1)
    group = jnp.argmax(group_score, axis=-1).astype(jnp.int32)
    in_group = jnp.take_along_axis(choice, group[:, None, None], axis=1)[:, 0]
    _, local = lax.top_k(in_group, TOP_K)
    expert = group[:, None] * EXPERTS_PER_GROUP + local
    aff = jnp.take_along_axis(affinity, expert, axis=1)
    weight = (aff / aff.sum(-1, keepdims=True)).astype(h.dtype)
    A = T * TOP_K
    e_flat = expert.reshape(A)
    tok_flat = jnp.repeat(jnp.arange(T, dtype=jnp.int32), TOP_K)
    w_flat = weight.reshape(A)
    order = jnp.argsort(e_flat)
    e_s, tok_s, w_s = e_flat[order], tok_flat[order], w_flat[order]
    counts = jax.ops.segment_sum(jnp.ones((A,), jnp.int32), e_flat, num_segments=N_EXPERTS)
    starts = jnp.cumsum(counts) - counts
    padded = (counts + MOE_BLOCK - 1) // MOE_BLOCK * MOE_BLOCK
    p_ends = jnp.cumsum(padded)
    p_starts = p_ends - padded
    dest = p_starts[e_s] + (jnp.arange(A, dtype=jnp.int32) - starts[e_s])
    nb = -(-A // MOE_BLOCK) + N_EXPERTS
    P = nb * MOE_BLOCK
    buf_tok = jnp.full((P,), T, jnp.int32).at[dest].set(tok_s)
    buf_w = jnp.zeros((P,), h.dtype).at[dest].set(w_s)
    block_start = jnp.arange(nb, dtype=jnp.int32) * MOE_BLOCK
    block_expert = jnp.minimum(jnp.searchsorted(p_ends, block_start, side='right'), N_EXPERTS - 1).astype(jnp.int32)
    x_pad = jnp.concatenate([xf, jnp.zeros((1, D), h.dtype)], axis=0)

    def expert_block(args):
        e, toks, ws = args
        xb = x_pad[toks]
        hid = jax.nn.silu(xb @ w_gate[e]) * (xb @ w_up[e])
        return (hid @ w_down[e]) * ws[:, None]

    out = lax.map(expert_block, (block_expert, buf_tok.reshape(nb, MOE_BLOCK), buf_w.reshape(nb, MOE_BLOCK)))
    y = jnp.zeros((T + 1, D), h.dtype).at[buf_tok].add(out.reshape(P, D))
    return y[:T].reshape(B, S, D)


def setup_inputs(seed: int = 0) -> dict:
    key = jax.random.key(seed)
    ks = jax.random.split(key, 32)
    D = D_MODEL
    n_nsa = (DEPTH + 1) // 2
    n_ml = DEPTH // 2

    def nrm(k, shape, s):
        return jax.random.normal(k, shape, jnp.float32) * s

    return {
        'x': nrm(ks[0], (BATCH, SEQ, D), 1.0),
        'c': nrm(ks[1], (BATCH, D), 1.0),
        'ada_w': nrm(ks[2], (DEPTH, D, 6 * D), 0.5 * D ** -0.5),
        'ada_b': nrm(ks[3], (DEPTH, 6 * D), 0.02),
        'norm_mix_gain': 1.0 + nrm(ks[4], (DEPTH, D), 0.05),
        'norm_ffn_gain': 1.0 + nrm(ks[5], (DEPTH, D), 0.05),
        'nsa_w_in': nrm(ks[6], (n_nsa, D, NSA_IN_COLS), D ** -0.5),
        'nsa_w_out': nrm(ks[7], (n_nsa, NSA_Q_COLS, D), NSA_Q_COLS ** -0.5),
        'nsa_q_gain': 1.0 + nrm(ks[8], (n_nsa, HEAD_DIM), 0.05),
        'nsa_k_gain': 1.0 + nrm(ks[9], (n_nsa, NSA_BRANCHES, HEAD_DIM), 0.05),
        'nsa_cmp_pe': nrm(ks[10], (n_nsa, 2, CMP_BLOCK, HEAD_DIM), 0.1),
        'nsa_cmp_w1': nrm(ks[11], (n_nsa, 2, CMP_BLOCK * HEAD_DIM, CMP_HIDDEN), (CMP_BLOCK * HEAD_DIM) ** -0.5),
        'nsa_cmp_b1': nrm(ks[12], (n_nsa, 2, CMP_HIDDEN), 0.02),
        'nsa_cmp_w2': nrm(ks[13], (n_nsa, 2, CMP_HIDDEN, HEAD_DIM), CMP_HIDDEN ** -0.5),
        'nsa_cmp_b2': nrm(ks[14], (n_nsa, 2, HEAD_DIM), 0.02),
        'mlstm_w_in': nrm(ks[15], (n_ml, D, MLSTM_IN_COLS), D ** -0.5),
        'mlstm_b_igate': nrm(ks[16], (n_ml, MLSTM_HEADS), 0.1),
        'mlstm_b_fgate': 3.0 + nrm(ks[17], (n_ml, MLSTM_HEADS), 0.5),
        'mlstm_norm_gain': 1.0 + nrm(ks[18], (n_ml, MLSTM_HEADS, MLSTM_V_DIM), 0.05),
        'mlstm_w_out': nrm(ks[19], (n_ml, MLSTM_HEADS * MLSTM_V_DIM, D), (MLSTM_HEADS * MLSTM_V_DIM) ** -0.5),
        'router_w': nrm(ks[20], (D, N_EXPERTS), D ** -0.5),
        'router_b': nrm(ks[21], (N_EXPERTS,), 0.01),
        'moe_w_gate': nrm(ks[22], (DEPTH, N_EXPERTS, D, D_EXPERT), D ** -0.5),
        'moe_w_up': nrm(ks[23], (DEPTH, N_EXPERTS, D, D_EXPERT), D ** -0.5),
        'moe_w_down': nrm(ks[24], (DEPTH, N_EXPERTS, D_EXPERT, D), D_EXPERT ** -0.5),
    }


def reference(x, c, ada_w, ada_b, norm_mix_gain, norm_ffn_gain,
              nsa_w_in, nsa_w_out, nsa_q_gain, nsa_k_gain, nsa_cmp_pe, nsa_cmp_w1, nsa_cmp_b1, nsa_cmp_w2, nsa_cmp_b2,
              mlstm_w_in, mlstm_b_igate, mlstm_b_fgate, mlstm_norm_gain, mlstm_w_out,
              router_w, router_b, moe_w_gate, moe_w_up, moe_w_down):
    cond = jax.nn.silu(c)
    for i in range(DEPTH):
        mod = cond @ ada_w[i] + ada_b[i]
        sh_m, sc_m, g_m, sh_f, sc_f, g_f = jnp.split(mod[:, None, :], 6, axis=-1)
        hm = rms_norm(x, norm_mix_gain[i]) * (1.0 + sc_m) + sh_m
        j = i // N_MIXERS
        if i % N_MIXERS == 0:
            y = nsa_mixer(hm, nsa_w_in[j], nsa_w_out[j], nsa_q_gain[j], nsa_k_gain[j], nsa_cmp_pe[j],
                          nsa_cmp_w1[j], nsa_cmp_b1[j], nsa_cmp_w2[j], nsa_cmp_b2[j])
        else:
            y = mlstm_mixer(hm, mlstm_w_in[j], mlstm_w_out[j], mlstm_b_igate[j], mlstm_b_fgate[j], mlstm_norm_gain[j])
        x = x + g_m * y
        hf = rms_norm(x, norm_ffn_gain[i]) * (1.0 + sc_f) + sh_f
        x = x + g_f * moe_ffn(hf, router_w, router_b, moe_w_gate[i], moe_w_up[i], moe_w_down[i])
    return x
```

```cpp
#include <hip/hip_runtime.h>
#include <stdint.h>

typedef unsigned short bf16_t;
__device__ __forceinline__ float bf2f(bf16_t v) { return __uint_as_float(((unsigned)v) << 16); }
__device__ __forceinline__ bf16_t f2bf(float f) { unsigned u = __float_as_uint(f); u += 0x7FFFu + ((u >> 16) & 1u); return (bf16_t)(u >> 16); }

constexpr int Bn = 16, S = 2048, D = 1024, T = Bn * S;
constexpr int NSA_COLS = 1840, ML_COLS = 3080;
constexpr int NE = 32, DE = 512;
constexpr int MC = 4096;

__device__ __forceinline__ float wave_sum(float v) { for (int o = 32; o > 0; o >>= 1) v += __shfl_xor(v, o); return v; }
__device__ __forceinline__ float wave_max(float v) { for (int o = 32; o > 0; o >>= 1) v = fmaxf(v, __shfl_xor(v, o)); return v; }
__device__ __forceinline__ float sigmoidf_(float x) { return 1.f / (1.f + expf(-x)); }

__global__ void k_rope_table(float* tab) {
    int i = blockIdx.x * blockDim.x + threadIdx.x; if (i >= 2048 * 8) return;
    int pos = i >> 3, j = i & 7;
    float inv = (float)pow(500000.0, -(double)j / 8.0);
    float ang = (float)pos * inv;
    tab[pos * 16 + j] = (float)cos((double)ang); tab[pos * 16 + 8 + j] = (float)sin((double)ang);
}
__global__ void k_mod(const float* c, const float* ada_w, const float* ada_b, float* mod) {
    int idx = blockIdx.x * blockDim.x + threadIdx.x; if (idx >= 2 * 16 * 6144) return;
    int n = idx % 6144, b = (idx / 6144) % 16, i = idx / (6144 * 16);
    float acc = ada_b[i * 6144 + n];
    for (int k = 0; k < D; ++k) { float cv = c[b * D + k]; float sv = cv / (1.f + expf(-cv)); acc += sv * ada_w[((size_t)i * D + k) * 6144 + n]; }
    mod[idx] = acc;
}
__global__ void __launch_bounds__(256) k_norm(const float* xin, const float* gain, const float* mod_sh, const float* mod_sc, bf16_t* h, float* rstd) {
    int row = blockIdx.x * 4 + (threadIdx.x >> 6), lane = threadIdx.x & 63; int b = row / S;
    const float* xr = xin + (size_t)row * D; float v[16]; float ss = 0.f;
#pragma unroll
    for (int j = 0; j < 4; ++j) { float4 f = *(const float4*)(xr + j * 256 + lane * 4); v[j*4] = f.x; v[j*4+1] = f.y; v[j*4+2] = f.z; v[j*4+3] = f.w; ss += f.x*f.x + f.y*f.y + f.z*f.z + f.w*f.w; }
    ss = wave_sum(ss); float r = rsqrtf(ss / D + 1e-6f); if (lane == 0) rstd[row] = r;
#pragma unroll
    for (int j = 0; j < 4; ++j)
#pragma unroll
        for (int e = 0; e < 4; ++e) { int col = j * 256 + lane * 4 + e; float y = v[j*4+e] * r * gain[col] * (1.f + mod_sc[b * 6144 + col]) + mod_sh[b * 6144 + col]; h[(size_t)row * D + col] = f2bf(y); }
}
__global__ void k_combine(const float* xin, const float* mod_g, const bf16_t* outk, float* xout) {
    size_t i = (size_t)blockIdx.x * blockDim.x + threadIdx.x; if (i >= (size_t)T * D) return;
    int col = i % D; int row = i / D; int b = row / S;
    xout[i] = xin[i] + mod_g[b * 6144 + col] * (bf2f(outk[i]) + bf2f(outk[(size_t)T * D + i]));
}

template <class AF, class BF, class EF>
__global__ void __launch_bounds__(256) k_gemm(int M, int N, int K, AF af, BF bf, EF ef) {
    __shared__ float As[16][68]; __shared__ float Bs[16][68];
    const int tid = threadIdx.x, tx = tid & 15, ty = tid >> 4; const int m0 = blockIdx.y * 64, n0 = blockIdx.x * 64;
    if (!af.active(m0)) return;
    float acc[4][4];
#pragma unroll
    for (int i = 0; i < 4; ++i)
#pragma unroll
        for (int j = 0; j < 4; ++j) acc[i][j] = 0.f;
    for (int k0 = 0; k0 < K; k0 += 16) {
#pragma unroll
        for (int i = 0; i < 4; ++i) { int idx = tid + 256 * i; int m = idx >> 4, k = idx & 15; As[k][m] = (m0 + m < M) ? af(m0 + m, k0 + k) : 0.f; }
#pragma unroll
        for (int i = 0; i < 4; ++i) { int idx = tid + 256 * i; int k = idx >> 6, n = idx & 63; Bs[k][n] = (n0 + n < N) ? bf(k0 + k, n0 + n) : 0.f; }
        __syncthreads();
#pragma unroll
        for (int k = 0; k < 16; ++k) { float a[4], b[4];
#pragma unroll
            for (int i = 0; i < 4; ++i) { a[i] = As[k][ty * 4 + i]; b[i] = Bs[k][tx * 4 + i]; }
#pragma unroll
            for (int i = 0; i < 4; ++i)
#pragma unroll
                for (int j = 0; j < 4; ++j) acc[i][j] += a[i] * b[j]; }
        __syncthreads();
    }
#pragma unroll
    for (int i = 0; i < 4; ++i)
#pragma unroll
        for (int j = 0; j < 4; j += 2) { int m = m0 + ty * 4 + i, n = n0 + tx * 4 + j; if (m < M && n < N) ef(m, n, acc[i][j], acc[i][j + 1]); }
}
struct A_bf16 { const bf16_t* p; int lda; int pad; __device__ bool active(int) const { return true; } __device__ float operator()(int m, int k) const { return bf2f(p[(size_t)m * lda + k]); } };
struct B_f32 { const float* p; int ldb; int pad; __device__ float operator()(int k, int n) const { return p[(size_t)k * ldb + n]; } };
struct E_f32 { float* c; int ldc; int pad; __device__ void operator()(int m, int n, float v0, float v1) const { c[(size_t)m * ldc + n] = v0; c[(size_t)m * ldc + n + 1] = v1; } };
struct E_resid { const float* xin; const float* mod_g; float* xout; int row0; int pad;
    __device__ void operator()(int m, int n, float v0, float v1) const { int row = row0 + m; int b = row / S; size_t i = (size_t)row * D + n;
        xout[i] = xin[i] + mod_g[b * 6144 + n] * v0; xout[i + 1] = xin[i + 1] + mod_g[b * 6144 + n + 1] * v1; } };
struct A_moe1 { const bf16_t* h; const int* rowtok; const int* total; __device__ bool active(int m0) const { return m0 < *total; }
    __device__ float operator()(int m, int k) const { int tk = rowtok[m]; return tk < 0 ? 0.f : bf2f(h[(size_t)(tk >> 1) * D + k]); } };
struct B_moe1 { const float* wg; const float* wu; const int* tile_e; __device__ float operator()(int k, int n) const { int e = tile_e[blockIdx.y]; int j = n >> 1;
        return (n & 1) ? wu[((size_t)e * D + k) * DE + j] : wg[((size_t)e * D + k) * DE + j]; } };
struct E_moe1 { bf16_t* hid; __device__ void operator()(int m, int n, float g, float u) const { float sg = g / (1.f + expf(-g)); hid[(size_t)m * DE + (n >> 1)] = f2bf(sg * u); } };
struct A_moe2 { const bf16_t* hid; const int* total; __device__ bool active(int m0) const { return m0 < *total; } __device__ float operator()(int m, int k) const { return bf2f(hid[(size_t)m * DE + k]); } };
struct B_moe2 { const float* wd; const int* tile_e; __device__ float operator()(int k, int n) const { int e = tile_e[blockIdx.y]; return wd[((size_t)e * DE + k) * D + n]; } };
struct E_moe2 { bf16_t* outk; const int* rowtok; const float* tokw; __device__ void operator()(int m, int n, float v0, float v1) const { int tk = rowtok[m]; if (tk < 0) return; float w = tokw[tk];
        size_t i = (size_t)(tk & 1) * T * D + (size_t)(tk >> 1) * D + n; outk[i] = f2bf(v0 * w); outk[i + 1] = f2bf(v1 * w); } };

__global__ void __launch_bounds__(256) k_nsa_epi(const float* tmp, int row0, const float* q_gain, const float* k_gain, const float* rope, bf16_t* q, bf16_t* kv, float* gates) {
    int gw = blockIdx.x * 4 + (threadIdx.x >> 6), lane = threadIdx.x & 63; int m = gw / 29, slot = gw % 29; if (m >= MC) return;
    int row = row0 + m; int b = row / S, s = row % S; const float* tr = tmp + (size_t)m * NSA_COLS;
    if (slot == 28) { if (lane < 48) gates[(size_t)row * 48 + lane] = sigmoidf_(tr[1792 + lane]); return; }
    float v = tr[slot * 64 + lane];
    bool normed = false; const float* gain = nullptr; int ten = -1, g = 0;
    if (slot < 16) { normed = true; gain = q_gain; }
    else { int kk = slot - 16; ten = kk >> 1; g = kk & 1; if (ten == 2) { normed = true; gain = k_gain + 64; } if (ten == 4) { normed = true; gain = k_gain + 128; } }
    if (normed) { float ss = wave_sum(v * v); v = v * rsqrtf(ss / 64.f + 1e-6f) * gain[lane];
        float other = __shfl_xor(v, 8); if (lane < 16) { int j = lane & 7; float cs = rope[s * 16 + j], sn = rope[s * 16 + 8 + j]; v = (lane < 8) ? (v * cs - other * sn) : (v * cs + other * sn); } }
    if (slot < 16) q[(size_t)row * D + slot * 64 + lane] = f2bf(v);
    else kv[(size_t)ten * T * 128 + ((size_t)(b * 2 + g) * S + s) * 64 + lane] = f2bf(v);
}
__global__ void k_cmp_bias(const float* pe, const float* w1, const float* b1, float* cb1) {
    int idx = blockIdx.x * blockDim.x + threadIdx.x; if (idx >= 512) return; int w = idx >> 8, j = idx & 255; float acc = b1[idx];
    for (int k = 0; k < 2048; ++k) acc += pe[w * 2048 + k] * w1[((size_t)w * 2048 + k) * 256 + j];
    cb1[idx] = acc;
}
__global__ void __launch_bounds__(64) k_cmp2(const float* tmp, const float* cb1, const float* w2, const float* b2, const float* kgain0, const float* rope, int is_k, bf16_t* out) {
    int row = blockIdx.x, lane = threadIdx.x; int c = row & 127; __shared__ float hid[256];
    for (int j = lane; j < 256; j += 64) { float x = tmp[(size_t)row * 256 + j] + cb1[j]; hid[j] = 0.5f * x * (1.f + tanhf(0.7978845608028654f * (x + 0.044715f * x * x * x))); }
    __syncthreads();
    float acc = b2[lane]; for (int j = 0; j < 256; ++j) acc += hid[j] * w2[j * 64 + lane];
    float v = acc;
    if (is_k) { float ss = wave_sum(v * v); v = v * rsqrtf(ss / 64.f + 1e-6f) * kgain0[lane]; int pos = c * 16 + 31; if (pos > 2047) pos = 2047;
        float other = __shfl_xor(v, 8); if (lane < 16) { int j = lane & 7; float cs = rope[pos * 16 + j], sn = rope[pos * 16 + 8 + j]; v = (lane < 8) ? (v * cs - other * sn) : (v * cs + other * sn); } }
    if (c == 127) v = 0.f;
    out[(size_t)row * 64 + lane] = f2bf(v);
}

__device__ __forceinline__ float dot64(const float* qs, const bf16_t* kr) { float acc = 0.f;
#pragma unroll
    for (int i = 0; i < 8; ++i) { uint4 u = *(const uint4*)(kr + i * 8); const unsigned w[4] = {u.x, u.y, u.z, u.w};
#pragma unroll
        for (int e = 0; e < 4; ++e) { acc += qs[i * 8 + e * 2] * __uint_as_float(w[e] << 16); acc += qs[i * 8 + e * 2 + 1] * __uint_as_float(w[e] & 0xFFFF0000u); } }
    return acc; }
__global__ void __launch_bounds__(512) k_nsa_attn(const bf16_t* q, const bf16_t* kv, const bf16_t* kcmp, const bf16_t* vcmp, const float* gates, bf16_t* o) {
    const int t = blockIdx.x, g = blockIdx.y, b = t / S, s = t % S; const int w = threadIdx.x >> 6, lane = threadIdx.x & 63, head = g * 8 + w;
    __shared__ float qs[8][64]; __shared__ float pc[8][128]; __shared__ float ps[8][512]; __shared__ int sel[8]; __shared__ float imps[32];
    qs[w][lane] = bf2f(q[(size_t)t * D + head * 64 + lane]);
    __syncthreads();
    const float scale = 0.125f; const size_t bg = (size_t)(b * 2 + g);
    const bf16_t* kc = kcmp + bg * 128 * 64; const bf16_t* vc = vcmp + bg * 128 * 64;
    const bf16_t* ks = kv + (size_t)2 * T * 128 + bg * S * 64; const bf16_t* vs = kv + (size_t)3 * T * 128 + bg * S * 64;
    const bf16_t* kw = kv + (size_t)4 * T * 128 + bg * S * 64; const bf16_t* vw = kv + (size_t)5 * T * 128 + bg * S * 64;
    float sc[2]; bool vl[2]; float mx = -3e38f;
#pragma unroll
    for (int i = 0; i < 2; ++i) { int c = lane + 64 * i; vl[i] = (c < 127) && (c * 16 + 31 <= s); sc[i] = vl[i] ? dot64(qs[w], kc + c * 64) * scale : -3e38f; mx = fmaxf(mx, sc[i]); }
    mx = wave_max(mx); float p[2], sum = 0.f;
#pragma unroll
    for (int i = 0; i < 2; ++i) { p[i] = vl[i] ? expf(sc[i] - mx) : 0.f; sum += p[i]; }
    sum = wave_sum(sum); float inv = sum > 0.f ? 1.f / sum : 0.f;
    pc[w][lane] = p[0] * inv; pc[w][lane + 64] = p[1] * inv;
    __syncthreads();
    float oc = 0.f; for (int c = 0; c < 127; ++c) oc += pc[w][c] * bf2f(vc[c * 64 + lane]);
    const int cur = s >> 6;
    if (threadIdx.x < 32) { int j = threadIdx.x; float im = 0.f;
        for (int r = 0; r < 8; ++r) { const float* pr = pc[r]; im += pr[4 * j] + 2.f * pr[4 * j + 1] + 2.f * pr[4 * j + 2] + 2.f * pr[4 * j + 3] + ((4 * j + 4 < 127) ? pr[4 * j + 4] : 0.f); }
        bool forced = (j == 0) || (j == cur) || (j == cur - 1); bool allowed = j <= cur;
        imps[j] = allowed ? (forced ? 1e9f : im) : -1e9f; }
    __syncthreads();
    if (threadIdx.x == 0) { unsigned used = 0u; for (int i = 0; i < 8; ++i) { int best = -1; float bv = -3e38f; for (int j = 0; j < 32; ++j) if (!((used >> j) & 1u) && imps[j] > bv) { bv = imps[j]; best = j; } used |= 1u << best; sel[i] = best; } }
    __syncthreads();
    float ss8[8]; mx = -3e38f;
#pragma unroll
    for (int i = 0; i < 8; ++i) { int key = sel[i] * 64 + lane; bool v = key <= s; ss8[i] = v ? dot64(qs[w], ks + (size_t)key * 64) * scale : -3e38f; mx = fmaxf(mx, ss8[i]); }
    mx = wave_max(mx); sum = 0.f;
#pragma unroll
    for (int i = 0; i < 8; ++i) { float e = (ss8[i] > -1e38f) ? expf(ss8[i] - mx) : 0.f; ps[w][i * 64 + lane] = e; sum += e; }
    sum = wave_sum(sum); inv = 1.f / sum;
    __syncthreads();
    float os = 0.f; for (int i = 0; i < 8; ++i) { const bf16_t* vb = vs + (size_t)sel[i] * 64 * 64; for (int kk = 0; kk < 64; ++kk) os += ps[w][i * 64 + kk] * bf2f(vb[kk * 64 + lane]); }
    os *= inv;
    __syncthreads();
    mx = -3e38f;
#pragma unroll
    for (int i = 0; i < 8; ++i) { int key = s - 511 + i * 64 + lane; bool v = key >= 0; ss8[i] = v ? dot64(qs[w], kw + (size_t)key * 64) * scale : -3e38f; mx = fmaxf(mx, ss8[i]); }
    mx = wave_max(mx); sum = 0.f;
#pragma unroll
    for (int i = 0; i < 8; ++i) { float e = (ss8[i] > -1e38f) ? expf(ss8[i] - mx) : 0.f; ps[w][i * 64 + lane] = e; sum += e; }
    sum = wave_sum(sum); inv = 1.f / sum;
    __syncthreads();
    float ow = 0.f; for (int kk = 0; kk < 512; ++kk) { int key = s - 511 + kk; if (key >= 0) ow += ps[w][kk] * bf2f(vw[(size_t)key * 64 + lane]); }
    ow *= inv;
    const float* gt = gates + (size_t)t * 48;
    o[(size_t)t * D + head * 64 + lane] = f2bf(gt[head] * oc + gt[16 + head] * os + gt[32 + head] * ow);
}

__global__ void __launch_bounds__(256) k_router(const float* x, const float* rstd, const float* gain, const float* mod_sh, const float* mod_sc, const float* rw, float* aff) {
    int e = threadIdx.x & 31; int t = blockIdx.x * 8 + (threadIdx.x >> 5); int b = t / S; float r = rstd[t]; float acc = 0.f;
    for (int k = 0; k < D; ++k) { float hf = x[(size_t)t * D + k] * r * gain[k] * (1.f + mod_sc[b * 6144 + k]) + mod_sh[b * 6144 + k]; acc += hf * rw[k * NE + e]; }
    aff[(size_t)t * NE + e] = sigmoidf_(acc);
}
__global__ void k_route(const float* aff, const float* rb, float* tokw, int* cnt, int* list) {
    int t = blockIdx.x * blockDim.x + threadIdx.x; if (t >= T) return;
    float bestgs = -3e38f; int be0 = 0, be1 = 0; float ba0 = 0.f, ba1 = 0.f;
#pragma unroll
    for (int g = 0; g < 4; ++g) { float v1 = -3e38f, v2 = -3e38f, a1 = 0.f, a2 = 0.f; int i1 = 0, i2 = 0;
#pragma unroll
        for (int i = 0; i < 8; ++i) { float a = aff[(size_t)t * NE + g * 8 + i]; float ch = a + rb[g * 8 + i];
            if (ch > v1) { v2 = v1; a2 = a1; i2 = i1; v1 = ch; a1 = a; i1 = i; } else if (ch > v2) { v2 = ch; a2 = a; i2 = i; } }
        float gs = v1 + v2; if (gs > bestgs) { bestgs = gs; be0 = g * 8 + i1; be1 = g * 8 + i2; ba0 = a1; ba1 = a2; } }
    float sum = ba0 + ba1; tokw[t * 2] = ba0 / sum; tokw[t * 2 + 1] = ba1 / sum;
    int p0 = atomicAdd(&cnt[be0], 1); list[(size_t)be0 * T + p0] = t * 2;
    int p1 = atomicAdd(&cnt[be1], 1); list[(size_t)be1 * T + p1] = t * 2 + 1;
}
__global__ void k_moe_plan(const int* cnt, int* pstart, int* total, int* tile_e) {
    if (threadIdx.x == 0) { int acc = 0; for (int e = 0; e < NE; ++e) { pstart[e] = acc; int pc = (cnt[e] + 63) / 64 * 64; for (int i = 0; i < pc / 64; ++i) tile_e[acc / 64 + i] = e; acc += pc; } pstart[NE] = acc; *total = acc; }
}
__global__ void k_moe_fill(const int* cnt, const int* pstart, const int* list, int* rowtok) {
    int e = blockIdx.y; int i = blockIdx.x * blockDim.x + threadIdx.x; int n = pstart[e + 1] - pstart[e]; if (i >= n) return;
    rowtok[pstart[e] + i] = (i < cnt[e]) ? list[(size_t)e * T + i] : -1;
}

__global__ void __launch_bounds__(256) k_ml_gates(const float* x, const float* rstd, const float* gain, const float* mod_sh, const float* mod_sc, const float* w_in, const float* bi, const float* bfg, float* li, float* lf) {
    int j = threadIdx.x & 7; int t = blockIdx.x * 32 + (threadIdx.x >> 3); int b = t / S; float r = rstd[t]; float acc = 0.f;
    for (int k = 0; k < D; ++k) { float hf = x[(size_t)t * D + k] * r * gain[k] * (1.f + mod_sc[b * 6144 + k]) + mod_sh[b * 6144 + k]; acc += hf * w_in[(size_t)k * ML_COLS + 3072 + j]; }
    if (j < 4) { float a = acc + bi[j]; li[t * 4 + j] = 15.f * tanhf(a / 15.f); }
    else { float a = acc + bfg[j - 4]; float c = 15.f * tanhf(a / 15.f); lf[t * 4 + j - 4] = (c >= 0.f) ? -log1pf(expf(-c)) : (c - log1pf(expf(c))); }
}
__global__ void k_ml_epi(const float* tmp, int row0, bf16_t* proj) {
    size_t i = (size_t)blockIdx.x * blockDim.x + threadIdx.x; if (i >= (size_t)MC * 3072) return; int m = i / 3072, n = i % 3072;
    float v = tmp[(size_t)m * ML_COLS + n]; if (n >= 512 && n < 1024) v *= 0.08838834764831845f; if (n >= 2048) v = sigmoidf_(v);
    proj[(size_t)(row0 + m) * 3072 + n] = f2bf(v);
}
__global__ void __launch_bounds__(256) k_ml_scan(bf16_t* proj, const float* li, const float* lf) {
    const int b = blockIdx.x >> 2, h = blockIdx.x & 3, v = threadIdx.x, lane = v & 63, wv = v >> 6;
    __shared__ float qs[128], ks[128], red[4];
    float C[128];
#pragma unroll
    for (int d = 0; d < 128; ++d) C[d] = 0.f;
    float nd = 0.f, m = 0.f;
    for (int s = 0; s < S; ++s) { const size_t t = (size_t)b * S + s; bf16_t* pr = proj + t * 3072;
        __syncthreads();
        if (v < 128) { qs[v] = bf2f(pr[h * 128 + v]); ks[v] = bf2f(pr[512 + h * 128 + v]); }
        const float vv = bf2f(pr[1024 + h * 256 + v]); const float lft = lf[t * 4 + h], lit = li[t * 4 + h];
        const float mn = fmaxf(lft + m, lit); const float fd = expf(lft + m - mn), ig = expf(lit - mn); m = mn;
        __syncthreads();
        float num = 0.f; const float iv = ig * vv;
#pragma unroll
        for (int d = 0; d < 128; ++d) { C[d] = fd * C[d] + ks[d] * iv; num += qs[d] * C[d]; }
        float part = 0.f; if (v < 128) { nd = fd * nd + ig * ks[v]; part = qs[v] * nd; }
        part = wave_sum(part); if (lane == 0) red[wv] = part;
        __syncthreads();
        const float den = red[0] + red[1] + red[2] + red[3];
        pr[1024 + h * 256 + v] = f2bf(num / fmaxf(fabsf(den), expf(-m)));
    }
}
__global__ void __launch_bounds__(256) k_ml_gate(bf16_t* proj, const float* ngain) {
    int gw = blockIdx.x * 4 + (threadIdx.x >> 6), lane = threadIdx.x & 63; int t = gw >> 2, h = gw & 3; bf16_t* pr = proj + (size_t)t * 3072;
    float hv[4]; float ss = 0.f;
#pragma unroll
    for (int i = 0; i < 4; ++i) { hv[i] = bf2f(pr[1024 + h * 256 + i * 64 + lane]); ss += hv[i] * hv[i]; }
    ss = wave_sum(ss); float r = rsqrtf(ss / 256.f + 1e-6f);
#pragma unroll
    for (int i = 0; i < 4; ++i) { int c = h * 256 + i * 64 + lane; pr[2048 + c] = f2bf(bf2f(pr[2048 + c]) * hv[i] * r * ngain[c]); }
}

static inline size_t al(size_t x) { return (x + 255) & ~(size_t)255; }
extern "C" void kernel_launch(void* const* d_in, const int* in_sizes, int n_in, void* d_out, int out_size, void* d_ws, size_t ws_size, hipStream_t stream) {
    const float* x = (const float*)d_in[0]; const float* c = (const float*)d_in[1]; const float* ada_w = (const float*)d_in[2]; const float* ada_b = (const float*)d_in[3];
    const float* g_mix = (const float*)d_in[4]; const float* g_ffn = (const float*)d_in[5];
    const float* nsa_w_in = (const float*)d_in[6]; const float* nsa_w_out = (const float*)d_in[7]; const float* q_gain = (const float*)d_in[8]; const float* k_gain = (const float*)d_in[9];
    const float* cmp_pe = (const float*)d_in[10]; const float* cmp_w1 = (const float*)d_in[11]; const float* cmp_b1 = (const float*)d_in[12]; const float* cmp_w2 = (const float*)d_in[13]; const float* cmp_b2 = (const float*)d_in[14];
    const float* ml_w_in = (const float*)d_in[15]; const float* ml_bi = (const float*)d_in[16]; const float* ml_bf = (const float*)d_in[17]; const float* ml_ng = (const float*)d_in[18]; const float* ml_w_out = (const float*)d_in[19];
    const float* router_w = (const float*)d_in[20]; const float* router_b = (const float*)d_in[21]; const float* w_gate = (const float*)d_in[22]; const float* w_up = (const float*)d_in[23]; const float* w_down = (const float*)d_in[24];
    float* out = (float*)d_out; char* ws = (char*)d_ws;
    size_t off = 0;
    auto take = [&](size_t bytes) { size_t o = off; off = al(off + bytes); return o; };
    int* cnt = (int*)(ws + take(2 * 64 * 4));
    float* mod = (float*)(ws + take((size_t)2 * 16 * 6144 * 4));
    float* rope = (float*)(ws + take(2048 * 16 * 4));
    float* rstd = (float*)(ws + take((size_t)T * 4));
    float* cb1 = (float*)(ws + take(512 * 4));
    int* pstart = (int*)(ws + take(64 * 4)); int* total = (int*)(ws + take(64)); int* tile_e = (int*)(ws + take(2048 * 4));
    int* rowtok = (int*)(ws + take((size_t)(65536 + 2048) * 4)); float* tokw = (float*)(ws + take((size_t)T * 2 * 4)); int* list = (int*)(ws + take((size_t)NE * T * 4));
    float* aff = (float*)(ws + take((size_t)T * NE * 4)); float* li = (float*)(ws + take((size_t)T * 4 * 4)); float* lf = (float*)(ws + take((size_t)T * 4 * 4));
    bf16_t* h = (bf16_t*)(ws + take((size_t)T * D * 2));
    float* tmp = (float*)(ws + take((size_t)MC * ML_COLS * 4));
    float* xa = (float*)(ws + take((size_t)T * D * 4));
    size_t r1 = off;
    bf16_t* q = (bf16_t*)(ws + take((size_t)T * D * 2)); bf16_t* kv = (bf16_t*)(ws + take((size_t)6 * T * 128 * 2 + (1 << 20)));
    float* gates = (float*)(ws + take((size_t)T * 48 * 4)); bf16_t* kcmp = (bf16_t*)(ws + take((size_t)32 * 128 * 64 * 2)); bf16_t* vcmp = (bf16_t*)(ws + take((size_t)32 * 128 * 64 * 2));
    size_t end_nsa = off; off = r1;
    bf16_t* proj = (bf16_t*)(ws + take((size_t)T * 3072 * 2)); size_t end_ml = off; off = r1;
    bf16_t* hid = (bf16_t*)(ws + take((size_t)(65536 + 2048) * DE * 2)); bf16_t* outk = (bf16_t*)(ws + take((size_t)2 * T * D * 2)); size_t end_moe = off;
    size_t need = end_nsa > end_ml ? end_nsa : end_ml; if (end_moe > need) need = end_moe;
    if (need > ws_size) return;

    hipMemsetAsync(cnt, 0, 2 * 64 * 4, stream);
    k_rope_table<<<(2048 * 8 + 255) / 256, 256, 0, stream>>>(rope);
    k_mod<<<(2 * 16 * 6144 + 255) / 256, 256, 0, stream>>>(c, ada_w, ada_b, mod);

    auto moe = [&](int layer, const float* xin  , float* xout) {
        const float* m = mod + (size_t)layer * 16 * 6144;
        k_norm<<<T / 4, 256, 0, stream>>>(xin, g_ffn + layer * D, m + 3 * D, m + 4 * D, h, rstd);
        k_router<<<T / 8, 256, 0, stream>>>(xin, rstd, g_ffn + layer * D, m + 3 * D, m + 4 * D, router_w, aff);
        int* cn = cnt + layer * 64;
        k_route<<<T / 256, 256, 0, stream>>>(aff, router_b, tokw, cn, list);
        k_moe_plan<<<1, 64, 0, stream>>>(cn, pstart, total, tile_e);
        k_moe_fill<<<dim3(T / 256, NE), 256, 0, stream>>>(cn, pstart, list, rowtok);
        const int maxrows = 65536 + 2048;
        const size_t wo = (size_t)layer * NE * D * DE;
        k_gemm<<<dim3(2 * DE / 64, maxrows / 64), 256, 0, stream>>>(maxrows, 2 * DE, D, A_moe1{h, rowtok, total}, B_moe1{w_gate + wo, w_up + wo, tile_e}, E_moe1{hid});
        k_gemm<<<dim3(D / 64, maxrows / 64), 256, 0, stream>>>(maxrows, D, DE, A_moe2{hid, total}, B_moe2{w_down + wo, tile_e}, E_moe2{outk, rowtok, tokw});
        k_combine<<<(unsigned)(((size_t)T * D + 255) / 256), 256, 0, stream>>>(xin, m + 5 * D, outk, xout);
    };

    {
        const float* m = mod;
        k_norm<<<T / 4, 256, 0, stream>>>(x, g_mix, m + 0 * D, m + 1 * D, h, rstd);
        for (int r0 = 0; r0 < T; r0 += MC) {
            k_gemm<<<dim3((NSA_COLS + 63) / 64, MC / 64), 256, 0, stream>>>(MC, NSA_COLS, D, A_bf16{h + (size_t)r0 * D, D}, B_f32{nsa_w_in, NSA_COLS}, E_f32{tmp, NSA_COLS});
            k_nsa_epi<<<(MC * 29 + 3) / 4, 256, 0, stream>>>(tmp, r0, q_gain, k_gain, rope, q, kv, gates);
        }
        k_cmp_bias<<<2, 256, 0, stream>>>(cmp_pe, cmp_w1, cmp_b1, cb1);
        for (int w = 0; w < 2; ++w) {
            const bf16_t* raw = kv + (size_t)w * T * 128;
            k_gemm<<<dim3(256 / 64, 4096 / 64), 256, 0, stream>>>(4096, 256, 2048, A_bf16{raw, 1024}, B_f32{cmp_w1 + (size_t)w * 2048 * 256, 256}, E_f32{tmp, 256});
            k_cmp2<<<4096, 64, 0, stream>>>(tmp, cb1 + w * 256, cmp_w2 + (size_t)w * 256 * 64, cmp_b2 + w * 64, k_gain, rope, w == 0, w == 0 ? kcmp : vcmp);
        }
        k_nsa_attn<<<dim3(T, 2), 512, 0, stream>>>(q, kv, kcmp, vcmp, gates, h);
        for (int r0 = 0; r0 < T; r0 += MC)
            k_gemm<<<dim3(D / 64, MC / 64), 256, 0, stream>>>(MC, D, D, A_bf16{h + (size_t)r0 * D, D}, B_f32{nsa_w_out, D}, E_resid{x, m + 2 * D, out, r0});
        moe(0, out, xa);
    }
    {
        const float* m = mod + (size_t)16 * 6144;
        k_norm<<<T / 4, 256, 0, stream>>>(xa, g_mix + D, m + 0 * D, m + 1 * D, h, rstd);
        k_ml_gates<<<T / 32, 256, 0, stream>>>(xa, rstd, g_mix + D, m + 0 * D, m + 1 * D, ml_w_in, ml_bi, ml_bf, li, lf);
        for (int r0 = 0; r0 < T; r0 += MC) {
            k_gemm<<<dim3(3072 / 64, MC / 64), 256, 0, stream>>>(MC, 3072, D, A_bf16{h + (size_t)r0 * D, D}, B_f32{ml_w_in, ML_COLS}, E_f32{tmp, ML_COLS});
            k_ml_epi<<<(unsigned)(((size_t)MC * 3072 + 255) / 256), 256, 0, stream>>>(tmp, r0, proj);
        }
        k_ml_scan<<<64, 256, 0, stream>>>(proj, li, lf);
        k_ml_gate<<<T, 256, 0, stream>>>(proj, ml_ng);
        for (int r0 = 0; r0 < T; r0 += MC)
            k_gemm<<<dim3(D / 64, MC / 64), 256, 0, stream>>>(MC, D, D, A_bf16{proj + (size_t)r0 * 3072 + 2048, 3072}, B_f32{ml_w_out, D}, E_resid{xa, m + 2 * D, out, r0});
        moe(1, out, out);
    }
}
```

```cpp
#include <hip/hip_runtime.h>
#include <stdint.h>

typedef unsigned short bf16_t;
__device__ __forceinline__ float bf2f(bf16_t v) { return __uint_as_float(((unsigned)v) << 16); }
__device__ __forceinline__ bf16_t f2bf(float f) { unsigned u = __float_as_uint(f); u += 0x7FFFu + ((u >> 16) & 1u); return (bf16_t)(u >> 16); }

constexpr int Bn = 16, S = 2048, D = 1024, T = Bn * S;
constexpr int NSA_COLS = 1840, ML_COLS = 3080;
constexpr int NE = 32, DE = 512;
constexpr int MC = 4096;

__device__ __forceinline__ float wave_sum(float v) { for (int o = 32; o > 0; o >>= 1) v += __shfl_xor(v, o); return v; }
__device__ __forceinline__ float wave_max(float v) { for (int o = 32; o > 0; o >>= 1) v = fmaxf(v, __shfl_xor(v, o)); return v; }
__device__ __forceinline__ float sigmoidf_(float x) { return 1.f / (1.f + expf(-x)); }

__global__ void k_rope_table(float* tab) {
    int i = blockIdx.x * blockDim.x + threadIdx.x; if (i >= 2048 * 8) return;
    int pos = i >> 3, j = i & 7;
    float inv = (float)pow(500000.0, -(double)j / 8.0);
    float ang = (float)pos * inv;
    tab[pos * 16 + j] = (float)cos((double)ang); tab[pos * 16 + 8 + j] = (float)sin((double)ang);
}
__global__ void k_mod(const float* c, const float* ada_w, const float* ada_b, float* mod) {
    int idx = blockIdx.x * blockDim.x + threadIdx.x; if (idx >= 2 * 16 * 6144) return;
    int n = idx % 6144, b = (idx / 6144) % 16, i = idx / (6144 * 16);
    float acc = ada_b[i * 6144 + n];
    for (int k = 0; k < D; ++k) { float cv = c[b * D + k]; float sv = cv / (1.f + expf(-cv)); acc += sv * ada_w[((size_t)i * D + k) * 6144 + n]; }
    mod[idx] = acc;
}
__global__ void __launch_bounds__(256) k_norm(const float* xin, const float* gain, const float* mod_sh, const float* mod_sc, bf16_t* h, float* rstd) {
    int row = blockIdx.x * 4 + (threadIdx.x >> 6), lane = threadIdx.x & 63; int b = row / S;
    const float* xr = xin + (size_t)row * D; float v[16]; float ss = 0.f;
#pragma unroll
    for (int j = 0; j < 4; ++j) { float4 f = *(const float4*)(xr + j * 256 + lane * 4); v[j*4] = f.x; v[j*4+1] = f.y; v[j*4+2] = f.z; v[j*4+3] = f.w; ss += f.x*f.x + f.y*f.y + f.z*f.z + f.w*f.w; }
    ss = wave_sum(ss); float r = rsqrtf(ss / D + 1e-6f); if (lane == 0) rstd[row] = r;
#pragma unroll
    for (int j = 0; j < 4; ++j)
#pragma unroll
        for (int e = 0; e < 4; ++e) { int col = j * 256 + lane * 4 + e; float y = v[j*4+e] * r * gain[col] * (1.f + mod_sc[b * 6144 + col]) + mod_sh[b * 6144 + col]; h[(size_t)row * D + col] = f2bf(y); }
}
__global__ void k_combine(const float* xin, const float* mod_g, const bf16_t* outk, float* xout) {
    size_t i = (size_t)blockIdx.x * blockDim.x + threadIdx.x; if (i >= (size_t)T * D) return;
    int col = i % D; int row = i / D; int b = row / S;
    xout[i] = xin[i] + mod_g[b * 6144 + col] * (bf2f(outk[i]) + bf2f(outk[(size_t)T * D + i]));
}

template <class AF, class BF, class EF>
__global__ void __launch_bounds__(256) k_gemm(int M, int N, int K, AF af, BF bf, EF ef) {
    __shared__ float As[16][68]; __shared__ float Bs[16][68];
    const int tid = threadIdx.x, tx = tid & 15, ty = tid >> 4; const int m0 = blockIdx.y * 64, n0 = blockIdx.x * 64;
    if (!af.active(m0)) return;
    float acc[4][4];
#pragma unroll
    for (int i = 0; i < 4; ++i)
#pragma unroll
        for (int j = 0; j < 4; ++j) acc[i][j] = 0.f;
    for (int k0 = 0; k0 < K; k0 += 16) {
#pragma unroll
        for (int i = 0; i < 4; ++i) { int idx = tid + 256 * i; int m = idx >> 4, k = idx & 15; As[k][m] = (m0 + m < M) ? af(m0 + m, k0 + k) : 0.f; }
#pragma unroll
        for (int i = 0; i < 4; ++i) { int idx = tid + 256 * i; int k = idx >> 6, n = idx & 63; Bs[k][n] = (n0 + n < N) ? bf(k0 + k, n0 + n) : 0.f; }
        __syncthreads();
#pragma unroll
        for (int k = 0; k < 16; ++k) { float a[4], b[4];
#pragma unroll
            for (int i = 0; i < 4; ++i) { a[i] = As[k][ty * 4 + i]; b[i] = Bs[k][tx * 4 + i]; }
#pragma unroll
            for (int i = 0; i < 4; ++i)
#pragma unroll
                for (int j = 0; j < 4; ++j) acc[i][j] += a[i] * b[j]; }
        __syncthreads();
    }
#pragma unroll
    for (int i = 0; i < 4; ++i)
#pragma unroll
        for (int j = 0; j < 4; j += 2) { int m = m0 + ty * 4 + i, n = n0 + tx * 4 + j; if (m < M && n < N) ef(m, n, acc[i][j], acc[i][j + 1]); }
}
struct A_bf16 { const bf16_t* p; int lda; int pad; __device__ bool active(int) const { return true; } __device__ float operator()(int m, int k) const { return bf2f(p[(size_t)m * lda + k]); } };
struct B_f32 { const float* p; int ldb; int pad; __device__ float operator()(int k, int n) const { return p[(size_t)k * ldb + n]; } };
struct E_f32 { float* c; int ldc; int pad; __device__ void operator()(int m, int n, float v0, float v1) const { c[(size_t)m * ldc + n] = v0; c[(size_t)m * ldc + n + 1] = v1; } };
struct E_resid { const float* xin; const float* mod_g; float* xout; int row0; int pad;
    __device__ void operator()(int m, int n, float v0, float v1) const { int row = row0 + m; int b = row / S; size_t i = (size_t)row * D + n;
        xout[i] = xin[i] + mod_g[b * 6144 + n] * v0; xout[i + 1] = xin[i + 1] + mod_g[b * 6144 + n + 1] * v1; } };
struct A_moe1 { const bf16_t* h; const int* rowtok; const int* total; __device__ bool active(int m0) const { return m0 < *total; }
    __device__ float operator()(int m, int k) const { int tk = rowtok[m]; return tk < 0 ? 0.f : bf2f(h[(size_t)(tk >> 1) * D + k]); } };
struct B_moe1 { const float* wg; const float* wu; const int* tile_e; __device__ float operator()(int k, int n) const { int e = tile_e[blockIdx.y]; int j = n >> 1;
        return (n & 1) ? wu[((size_t)e * D + k) * DE + j] : wg[((size_t)e * D + k) * DE + j]; } };
struct E_moe1 { bf16_t* hid; __device__ void operator()(int m, int n, float g, float u) const { float sg = g / (1.f + expf(-g)); hid[(size_t)m * DE + (n >> 1)] = f2bf(sg * u); } };
struct A_moe2 { const bf16_t* hid; const int* total; __device__ bool active(int m0) const { return m0 < *total; } __device__ float operator()(int m, int k) const { return bf2f(hid[(size_t)m * DE + k]); } };
struct B_moe2 { const float* wd; const int* tile_e; __device__ float operator()(int k, int n) const { int e = tile_e[blockIdx.y]; return wd[((size_t)e * DE + k) * D + n]; } };
struct E_moe2 { bf16_t* outk; const int* rowtok; const float* tokw; __device__ void operator()(int m, int n, float v0, float v1) const { int tk = rowtok[m]; if (tk < 0) return; float w = tokw[tk];
        size_t i = (size_t)(tk & 1) * T * D + (size_t)(tk >> 1) * D + n; outk[i] = f2bf(v0 * w); outk[i + 1] = f2bf(v1 * w); } };

__global__ void __launch_bounds__(256) k_nsa_epi(const float* tmp, int row0, const float* q_gain, const float* k_gain, const float* rope, bf16_t* q, bf16_t* kv, float* gates) {
    int gw = blockIdx.x * 4 + (threadIdx.x >> 6), lane = threadIdx.x & 63; int m = gw / 29, slot = gw % 29; if (m >= MC) return;
    int row = row0 + m; int b = row / S, s = row % S; const float* tr = tmp + (size_t)m * NSA_COLS;
    if (slot == 28) { if (lane < 48) gates[(size_t)row * 48 + lane] = sigmoidf_(tr[1792 + lane]); return; }
    float v = tr[slot * 64 + lane];
    bool normed = false; const float* gain = nullptr; int ten = -1, g = 0;
    if (slot < 16) { normed = true; gain = q_gain; }
    else { int kk = slot - 16; ten = kk >> 1; g = kk & 1; if (ten == 2) { normed = true; gain = k_gain + 64; } if (ten == 4) { normed = true; gain = k_gain + 128; } }
    if (normed) { float ss = wave_sum(v * v); v = v * rsqrtf(ss / 64.f + 1e-6f) * gain[lane];
        float other = __shfl_xor(v, 8); if (lane < 16) { int j = lane & 7; float cs = rope[s * 16 + j], sn = rope[s * 16 + 8 + j]; v = (lane < 8) ? (v * cs - other * sn) : (v * cs + other * sn); } }
    if (slot < 16) q[(size_t)row * D + slot * 64 + lane] = f2bf(v);
    else kv[(size_t)ten * T * 128 + ((size_t)(b * 2 + g) * S + s) * 64 + lane] = f2bf(v);
}
__global__ void k_cmp_bias(const float* pe, const float* w1, const float* b1, float* cb1) {
    int idx = blockIdx.x * blockDim.x + threadIdx.x; if (idx >= 512) return; int w = idx >> 8, j = idx & 255; float acc = b1[idx];
    for (int k = 0; k < 2048; ++k) acc += pe[w * 2048 + k] * w1[((size_t)w * 2048 + k) * 256 + j];
    cb1[idx] = acc;
}
__global__ void __launch_bounds__(64) k_cmp2(const float* tmp, const float* cb1, const float* w2, const float* b2, const float* kgain0, const float* rope, int is_k, bf16_t* out) {
    int row = blockIdx.x, lane = threadIdx.x; int c = row & 127; __shared__ float hid[256];
    const bf16_t* hb = (const bf16_t*)tmp;
    for (int j = lane; j < 256; j += 64) { if (cb1) { float x = tmp[(size_t)row * 256 + j] + cb1[j]; hid[j] = 0.5f * x * (1.f + tanhf(0.7978845608028654f * (x + 0.044715f * x * x * x))); } else hid[j] = bf2f(hb[(size_t)row * 256 + j]); }
    __syncthreads();
    float acc = b2[lane]; for (int j = 0; j < 256; ++j) acc += hid[j] * w2[j * 64 + lane];
    float v = acc;
    if (is_k) { float ss = wave_sum(v * v); v = v * rsqrtf(ss / 64.f + 1e-6f) * kgain0[lane]; int pos = c * 16 + 31; if (pos > 2047) pos = 2047;
        float other = __shfl_xor(v, 8); if (lane < 16) { int j = lane & 7; float cs = rope[pos * 16 + j], sn = rope[pos * 16 + 8 + j]; v = (lane < 8) ? (v * cs - other * sn) : (v * cs + other * sn); } }
    if (c == 127) v = 0.f;
    out[(size_t)row * 64 + lane] = f2bf(v);
}

__device__ __forceinline__ float dot64(const float* qs, const bf16_t* kr) { float acc = 0.f;
#pragma unroll
    for (int i = 0; i < 8; ++i) { uint4 u = *(const uint4*)(kr + i * 8); const unsigned w[4] = {u.x, u.y, u.z, u.w};
#pragma unroll
        for (int e = 0; e < 4; ++e) { acc += qs[i * 8 + e * 2] * __uint_as_float(w[e] << 16); acc += qs[i * 8 + e * 2 + 1] * __uint_as_float(w[e] & 0xFFFF0000u); } }
    return acc; }
__global__ void __launch_bounds__(512) k_nsa_attn(const bf16_t* q, const bf16_t* kv, const bf16_t* kcmp, const bf16_t* vcmp, const float* gates, bf16_t* o) {
    const int t = blockIdx.x, g = blockIdx.y, b = t / S, s = t % S; const int w = threadIdx.x >> 6, lane = threadIdx.x & 63, head = g * 8 + w;
    __shared__ float qs[8][64]; __shared__ float pc[8][128]; __shared__ float ps[8][512]; __shared__ int sel[8]; __shared__ float imps[32];
    qs[w][lane] = bf2f(q[(size_t)t * D + head * 64 + lane]);
    __syncthreads();
    const float scale = 0.125f; const size_t bg = (size_t)(b * 2 + g);
    const bf16_t* kc = kcmp + bg * 128 * 64; const bf16_t* vc = vcmp + bg * 128 * 64;
    const bf16_t* ks = kv + (size_t)2 * T * 128 + bg * S * 64; const bf16_t* vs = kv + (size_t)3 * T * 128 + bg * S * 64;
    const bf16_t* kw = kv + (size_t)4 * T * 128 + bg * S * 64; const bf16_t* vw = kv + (size_t)5 * T * 128 + bg * S * 64;
    float sc[2]; bool vl[2]; float mx = -3e38f;
#pragma unroll
    for (int i = 0; i < 2; ++i) { int c = lane + 64 * i; vl[i] = (c < 127) && (c * 16 + 31 <= s); sc[i] = vl[i] ? dot64(qs[w], kc + c * 64) * scale : -3e38f; mx = fmaxf(mx, sc[i]); }
    mx = wave_max(mx); float p[2], sum = 0.f;
#pragma unroll
    for (int i = 0; i < 2; ++i) { p[i] = vl[i] ? expf(sc[i] - mx) : 0.f; sum += p[i]; }
    sum = wave_sum(sum); float inv = sum > 0.f ? 1.f / sum : 0.f;
    pc[w][lane] = p[0] * inv; pc[w][lane + 64] = p[1] * inv;
    __syncthreads();
    float oc = 0.f; for (int c = 0; c < 127; ++c) oc += pc[w][c] * bf2f(vc[c * 64 + lane]);
    const int cur = s >> 6;
    if (threadIdx.x < 32) { int j = threadIdx.x; float im = 0.f;
        for (int r = 0; r < 8; ++r) { const float* pr = pc[r]; im += pr[4 * j] + 2.f * pr[4 * j + 1] + 2.f * pr[4 * j + 2] + 2.f * pr[4 * j + 3] + ((4 * j + 4 < 127) ? pr[4 * j + 4] : 0.f); }
        bool forced = (j == 0) || (j == cur) || (j == cur - 1); bool allowed = j <= cur;
        imps[j] = allowed ? (forced ? 1e9f : im) : -1e9f; }
    __syncthreads();
    if (threadIdx.x == 0) { unsigned used = 0u; for (int i = 0; i < 8; ++i) { int best = -1; float bv = -3e38f; for (int j = 0; j < 32; ++j) if (!((used >> j) & 1u) && imps[j] > bv) { bv = imps[j]; best = j; } used |= 1u << best; sel[i] = best; } }
    __syncthreads();
    float ss8[8]; mx = -3e38f;
#pragma unroll
    for (int i = 0; i < 8; ++i) { int key = sel[i] * 64 + lane; bool v = key <= s; ss8[i] = v ? dot64(qs[w], ks + (size_t)key * 64) * scale : -3e38f; mx = fmaxf(mx, ss8[i]); }
    mx = wave_max(mx); sum = 0.f;
#pragma unroll
    for (int i = 0; i < 8; ++i) { float e = (ss8[i] > -1e38f) ? expf(ss8[i] - mx) : 0.f; ps[w][i * 64 + lane] = e; sum += e; }
    sum = wave_sum(sum); inv = 1.f / sum;
    __syncthreads();
    float os = 0.f; for (int i = 0; i < 8; ++i) { const bf16_t* vb = vs + (size_t)sel[i] * 64 * 64; for (int kk = 0; kk < 64; ++kk) os += ps[w][i * 64 + kk] * bf2f(vb[kk * 64 + lane]); }
    os *= inv;
    __syncthreads();
    mx = -3e38f;
#pragma unroll
    for (int i = 0; i < 8; ++i) { int key = s - 511 + i * 64 + lane; bool v = key >= 0; ss8[i] = v ? dot64(qs[w], kw + (size_t)key * 64) * scale : -3e38f; mx = fmaxf(mx, ss8[i]); }
    mx = wave_max(mx); sum = 0.f;
#pragma unroll
    for (int i = 0; i < 8; ++i) { float e = (ss8[i] > -1e38f) ? expf(ss8[i] - mx) : 0.f; ps[w][i * 64 + lane] = e; sum += e; }
    sum = wave_sum(sum); inv = 1.f / sum;
    __syncthreads();
    float ow = 0.f; for (int kk = 0; kk < 512; ++kk) { int key = s - 511 + kk; if (key >= 0) ow += ps[w][kk] * bf2f(vw[(size_t)key * 64 + lane]); }
    ow *= inv;
    const float* gt = gates + (size_t)t * 48;
    o[(size_t)t * D + head * 64 + lane] = f2bf(gt[head] * oc + gt[16 + head] * os + gt[32 + head] * ow);
}

__global__ void __launch_bounds__(256) k_router(const float* x, const float* rstd, const float* gain, const float* mod_sh, const float* mod_sc, const float* rw, float* aff) {
    int e = threadIdx.x & 31; int t = blockIdx.x * 8 + (threadIdx.x >> 5); int b = t / S; float r = rstd[t]; float acc = 0.f;
    for (int k = 0; k < D; ++k) { float hf = x[(size_t)t * D + k] * r * gain[k] * (1.f + mod_sc[b * 6144 + k]) + mod_sh[b * 6144 + k]; acc += hf * rw[k * NE + e]; }
    aff[(size_t)t * NE + e] = sigmoidf_(acc);
}
__global__ void k_route(const float* aff, const float* rb, float* tokw, int* cnt, int* list) {
    int t = blockIdx.x * blockDim.x + threadIdx.x; if (t >= T) return;
    float bestgs = -3e38f; int be0 = 0, be1 = 0; float ba0 = 0.f, ba1 = 0.f;
#pragma unroll
    for (int g = 0; g < 4; ++g) { float v1 = -3e38f, v2 = -3e38f, a1 = 0.f, a2 = 0.f; int i1 = 0, i2 = 0;
#pragma unroll
        for (int i = 0; i < 8; ++i) { float a = aff[(size_t)t * NE + g * 8 + i]; float ch = a + rb[g * 8 + i];
            if (ch > v1) { v2 = v1; a2 = a1; i2 = i1; v1 = ch; a1 = a; i1 = i; } else if (ch > v2) { v2 = ch; a2 = a; i2 = i; } }
        float gs = v1 + v2; if (gs > bestgs) { bestgs = gs; be0 = g * 8 + i1; be1 = g * 8 + i2; ba0 = a1; ba1 = a2; } }
    float sum = ba0 + ba1; tokw[t * 2] = ba0 / sum; tokw[t * 2 + 1] = ba1 / sum;
    int p0 = atomicAdd(&cnt[be0], 1); list[(size_t)be0 * T + p0] = t * 2;
    int p1 = atomicAdd(&cnt[be1], 1); list[(size_t)be1 * T + p1] = t * 2 + 1;
}
__global__ void k_moe_plan(const int* cnt, int* pstart, int* total, int* tile_e) {
    if (threadIdx.x == 0) { int acc = 0; for (int e = 0; e < NE; ++e) { pstart[e] = acc; int pc = (cnt[e] + 255) / 256 * 256; for (int i = 0; i < pc / 256; ++i) tile_e[acc / 256 + i] = e; acc += pc; } pstart[NE] = acc; total[0] = acc; total[1] = acc / 256; }
}
__global__ void k_moe_fill(const int* cnt, const int* pstart, const int* list, int* rowtok) {
    int e = blockIdx.y; int i = blockIdx.x * blockDim.x + threadIdx.x; int n = pstart[e + 1] - pstart[e]; if (i >= n) return;
    rowtok[pstart[e] + i] = (i < cnt[e]) ? list[(size_t)e * T + i] : -1;
}

__global__ void __launch_bounds__(256) k_ml_gates(const float* x, const float* rstd, const float* gain, const float* mod_sh, const float* mod_sc, const float* w_in, const float* bi, const float* bfg, float* li, float* lf) {
    int j = threadIdx.x & 7; int t = blockIdx.x * 32 + (threadIdx.x >> 3); int b = t / S; float r = rstd[t]; float acc = 0.f;
    for (int k = 0; k < D; ++k) { float hf = x[(size_t)t * D + k] * r * gain[k] * (1.f + mod_sc[b * 6144 + k]) + mod_sh[b * 6144 + k]; acc += hf * w_in[(size_t)k * ML_COLS + 3072 + j]; }
    if (j < 4) { float a = acc + bi[j]; li[t * 4 + j] = 15.f * tanhf(a / 15.f); }
    else { float a = acc + bfg[j - 4]; float c = 15.f * tanhf(a / 15.f); lf[t * 4 + j - 4] = (c >= 0.f) ? -log1pf(expf(-c)) : (c - log1pf(expf(c))); }
}
__global__ void k_ml_epi(const float* tmp, int row0, bf16_t* proj) {
    size_t i = (size_t)blockIdx.x * blockDim.x + threadIdx.x; if (i >= (size_t)MC * 3072) return; int m = i / 3072, n = i % 3072;
    float v = tmp[(size_t)m * ML_COLS + n]; if (n >= 512 && n < 1024) v *= 0.08838834764831845f; if (n >= 2048) v = sigmoidf_(v);
    proj[(size_t)(row0 + m) * 3072 + n] = f2bf(v);
}
__global__ void __launch_bounds__(256) k_ml_scan(bf16_t* proj, const float* li, const float* lf) {
    const int b = blockIdx.x >> 2, h = blockIdx.x & 3, v = threadIdx.x, lane = v & 63, wv = v >> 6;
    __shared__ float qs[128], ks[128], red[4];
    float C[128];
#pragma unroll
    for (int d = 0; d < 128; ++d) C[d] = 0.f;
    float nd = 0.f, m = 0.f;
    for (int s = 0; s < S; ++s) { const size_t t = (size_t)b * S + s; bf16_t* pr = proj + t * 3072;
        __syncthreads();
        if (v < 128) { qs[v] = bf2f(pr[h * 128 + v]); ks[v] = bf2f(pr[512 + h * 128 + v]); }
        const float vv = bf2f(pr[1024 + h * 256 + v]); const float lft = lf[t * 4 + h], lit = li[t * 4 + h];
        const float mn = fmaxf(lft + m, lit); const float fd = expf(lft + m - mn), ig = expf(lit - mn); m = mn;
        __syncthreads();
        float num = 0.f; const float iv = ig * vv;
#pragma unroll
        for (int d = 0; d < 128; ++d) { C[d] = fd * C[d] + ks[d] * iv; num += qs[d] * C[d]; }
        float part = 0.f; if (v < 128) { nd = fd * nd + ig * ks[v]; part = qs[v] * nd; }
        part = wave_sum(part); if (lane == 0) red[wv] = part;
        __syncthreads();
        const float den = red[0] + red[1] + red[2] + red[3];
        pr[1024 + h * 256 + v] = f2bf(num / fmaxf(fabsf(den), expf(-m)));
    }
}
__global__ void __launch_bounds__(256) k_ml_gate(bf16_t* proj, const float* ngain) {
    int gw = blockIdx.x * 4 + (threadIdx.x >> 6), lane = threadIdx.x & 63; int t = gw >> 2, h = gw & 3; bf16_t* pr = proj + (size_t)t * 3072;
    float hv[4]; float ss = 0.f;
#pragma unroll
    for (int i = 0; i < 4; ++i) { hv[i] = bf2f(pr[1024 + h * 256 + i * 64 + lane]); ss += hv[i] * hv[i]; }
    ss = wave_sum(ss); float r = rsqrtf(ss / 256.f + 1e-6f);
#pragma unroll
    for (int i = 0; i < 4; ++i) { int c = h * 256 + i * 64 + lane; pr[2048 + c] = f2bf(bf2f(pr[2048 + c]) * hv[i] * r * ngain[c]); }
}

#define LAS __attribute__((address_space(3)))
typedef short bf16x8 __attribute__((ext_vector_type(8)));
typedef float f32x4 __attribute__((ext_vector_type(4)));
namespace ge {
constexpr int BM = 256, BK = 64, HALF = 128, HTB = HALF * BK * 2, STAGE_BYTES = 8 * HTB;
__host__ __device__ __forceinline__ int lds_byte(int r, int c) { const int st = (r >> 4) * 2 + (c >> 5), rr = r & 15, cc = c & 31, ob = rr * 64 + cc * 2; return st * 1024 + (ob ^ (((ob >> 9) & 1) << 5)); }
__host__ __device__ __forceinline__ void stage_rc(int b, int& R, int& C) { const int st = b / 1024, sb = b % 1024, swz = sb ^ (((sb >> 9) & 1) << 5); R = (st >> 1) * 16 + swz / 64; C = (st & 1) * 32 + (swz % 64) / 2; }
struct Unit { int pm, pn, bt; };
__host__ __device__ __forceinline__ int logical_col(int c) { const int pn = c >> 8, bj = (c >> 7) & 1, wc = (c >> 5) & 3, n = (c >> 4) & 1, fq = (c >> 2) & 3, j = c & 3; return (4 * pn + wc) * 64 + 16 * fq + 8 * bj + 4 * n + j; }
struct DenseOrder {
    int nM, nN, nwg, G, c;
    __device__ void init(int M, int N, int G_, int c_) { nM = M / BM; nN = N / BM; nwg = nM * nN; G = G_; c = c_; }
    __device__ bool next(int i, Unit& u) const {
        const long L = (long)i * G + c; if (L >= nwg) return false;
        int wgid = (int)L; { const int q = nwg / 8, r = nwg % 8, xcd = wgid % 8, off = wgid / 8; wgid = (xcd < r ? xcd * (q + 1) : r * (q + 1) + (xcd - r) * q) + off; }
        const int nig = 8 * nN, gid = wgid / nig, fm = gid * 8, gsz = (nM - fm) < 8 ? (nM - fm) : 8;
        u.pm = fm + ((wgid % nig) % gsz); u.pn = (wgid % nig) / gsz; u.bt = u.pn; return true;
    }
};
struct DenseRows { unsigned ldab; __device__ __forceinline__ unsigned operator()(int row) const { return (unsigned)row * ldab; } };

template <class Sched, class RowMap, class Epi>
__device__ __forceinline__ void gemm_phase(LAS unsigned char* lds, const bf16_t* A, const bf16_t* Bt, const int K, const Sched& S, const RowMap& RM, const Epi& E) {
    const int tid = threadIdx.x, wid = __builtin_amdgcn_readfirstlane(tid >> 6), lane = tid & 63, wr = wid >> 2, wc = wid & 3, fr = lane & 15, fq = lane >> 4;
    const int nt = K / BK;
    int sR[2], sC[2]; unsigned voffB[2];
#pragma unroll
    for (int i = 0; i < 2; ++i) { stage_rc(tid * 16 + i * 8192, sR[i], sC[i]); voffB[i] = (unsigned)(sR[i] * K + sC[i]) * 2u; }
    const size_t kstep = (size_t)(BK * 2), hstepB = (size_t)HALF * K * 2, tstepB = 2 * hstepB;
    const unsigned ldsw = (unsigned)wid * 1024u;
    const int aoff = lds_byte(wr * 64 + fr, fq * 8), boff = lds_byte(wc * 32 + fr, fq * 8);
    const char* Ab = (const char*)A;
#define GE_SA(b, h) (((b) * 2 + (h)) * ge::HTB)
#define GE_SB(b, h) ((4 + (b) * 2 + (h)) * ge::HTB)
#define GE_STB(bufoff, gbase) do { _Pragma("unroll") for (int _i = 0; _i < 2; ++_i) \
        __builtin_amdgcn_global_load_lds((const unsigned*)((const char*)(gbase) + voffB[_i]), (LAS unsigned*)(lds + (bufoff) + ldsw + _i * 8192), 16, 0, 0); } while (0)
#define GE_STA(bufoff, kb, OFF, h) do { _Pragma("unroll") for (int _i = 0; _i < 2; ++_i) \
        __builtin_amdgcn_global_load_lds((const unsigned*)(Ab + (kb) + (OFF)[h][_i]), (LAS unsigned*)(lds + (bufoff) + ldsw + _i * 8192), 16, 0, 0); } while (0)
#define GE_LDA(dst, b, h) do { _Pragma("unroll") for (int m = 0; m < 4; ++m) _Pragma("unroll") for (int k = 0; k < 2; ++k) dst[m][k] = *(const LAS bf16x8*)(lds + GE_SA(b, h) + aoff + m * 2048 + k * 1024); } while (0)
#define GE_LDB(dst, b, h) do { _Pragma("unroll") for (int n = 0; n < 2; ++n) _Pragma("unroll") for (int k = 0; k < 2; ++k) dst[n][k] = *(const LAS bf16x8*)(lds + GE_SB(b, h) + boff + n * 2048 + k * 1024); } while (0)
#define GE_MMA(ai, bj, At, Bt_) do { __builtin_amdgcn_s_setprio(1); _Pragma("unroll") for (int m = 0; m < 4; ++m) _Pragma("unroll") for (int n = 0; n < 2; ++n) _Pragma("unroll") for (int k = 0; k < 2; ++k) \
        acc[ai][bj][m][n] = __builtin_amdgcn_mfma_f32_16x16x32_bf16(Bt_[n][k], At[m][k], acc[ai][bj][m][n], 0, 0, 0); __builtin_amdgcn_s_setprio(0); } while (0)
#define GE_WAIT_V(n) asm volatile("s_waitcnt vmcnt(" #n ")" ::: "memory")
#define GE_WAIT_L(n) asm volatile("s_waitcnt lgkmcnt(" #n ")" ::: "memory")
#define GE_BAR __builtin_amdgcn_s_barrier()
#define GE_SCHED __builtin_amdgcn_sched_barrier(0)
#define GE_OFFS(OFF, u) do { _Pragma("unroll") for (int _h = 0; _h < 2; ++_h) _Pragma("unroll") for (int _i = 0; _i < 2; ++_i) (OFF)[_h][_i] = RM((u).pm * 256 + _h * 128 + sR[_i]) + (unsigned)sC[_i] * 2u; \
        asm volatile("" : "+v"((OFF)[0][0]), "+v"((OFF)[0][1]), "+v"((OFF)[1][0]), "+v"((OFF)[1][1])); } while (0)
    Unit cur, nxt; int ui = 0;
    if (!S.next(0, cur)) return;
    unsigned offC[2][2], offN[2][2];
    GE_OFFS(offC, cur);
    f32x4 acc[2][2][4][2];
#pragma unroll
    for (int a = 0; a < 2; ++a)
#pragma unroll
        for (int b = 0; b < 2; ++b)
#pragma unroll
            for (int m = 0; m < 4; ++m)
#pragma unroll
                for (int n = 0; n < 2; ++n) acc[a][b][m][n] = (f32x4){0.f, 0.f, 0.f, 0.f};
    bf16x8 At[4][2], B0[2][2], B1[2][2];
    const char* cB = (const char*)Bt + (size_t)cur.bt * tstepB;
    GE_STB(GE_SB(0, 0), cB); GE_STA(GE_SA(0, 0), 0, offC, 0); GE_STB(GE_SB(0, 1), cB + hstepB); GE_STA(GE_SA(0, 1), 0, offC, 1);
    if (wr == 1) GE_BAR;
    GE_WAIT_V(4); GE_BAR;
    GE_STB(GE_SB(1, 0), cB + kstep); GE_STA(GE_SA(1, 0), kstep, offC, 0); GE_STB(GE_SB(1, 1), cB + hstepB + kstep);
    GE_WAIT_V(6); GE_BAR;
    for (;;) {
        const bool has_next = S.next(ui + 1, nxt);
        if (has_next) { GE_OFFS(offN, nxt); }
        else {
#pragma unroll
            for (int _h = 0; _h < 2; ++_h)
#pragma unroll
                for (int _i = 0; _i < 2; ++_i) offN[_h][_i] = offC[_h][_i]; }
        const char* nB = has_next ? (const char*)Bt + (size_t)nxt.bt * tstepB : cB;
        for (int t = 0; t < nt; t += 2) {
            const bool last = (t == nt - 2);
            const size_t k1 = (size_t)(t + 1) * kstep;
            const size_t k2 = last ? 0 : (size_t)(t + 2) * kstep, k3 = k2 + kstep;
            const char* b2 = last ? nB : cB + (size_t)(t + 2) * kstep; const char* b3 = b2 + kstep;
            unsigned o2[2][2];
#pragma unroll
            for (int _h = 0; _h < 2; ++_h)
#pragma unroll
                for (int _i = 0; _i < 2; ++_i) o2[_h][_i] = last ? offN[_h][_i] : offC[_h][_i];
            GE_LDB(B0, 0, 0); GE_SCHED; GE_LDA(At, 0, 0); GE_STA(GE_SA(1, 1), k1, offC, 1);
            GE_WAIT_L(8); GE_BAR; GE_WAIT_L(0); GE_MMA(0, 0, At, B0); GE_BAR; GE_SCHED;
            GE_LDB(B1, 0, 1); GE_STB(GE_SB(0, 0), b2);
            GE_BAR; GE_WAIT_L(0); GE_MMA(0, 1, At, B1); GE_BAR;
            GE_LDA(At, 0, 1); GE_STA(GE_SA(0, 0), k2, o2, 0);
            GE_BAR; GE_WAIT_L(0); GE_MMA(1, 0, At, B0); GE_BAR; GE_SCHED;
            GE_STB(GE_SB(0, 1), b2 + hstepB);
            GE_WAIT_V(6); GE_BAR; GE_MMA(1, 1, At, B1); GE_BAR;
            GE_LDB(B0, 1, 0); GE_SCHED; GE_LDA(At, 1, 0); GE_STA(GE_SA(0, 1), k2, o2, 1);
            GE_WAIT_L(8); GE_BAR; GE_WAIT_L(0); GE_MMA(0, 0, At, B0); GE_BAR; GE_SCHED;
            GE_LDB(B1, 1, 1); GE_STB(GE_SB(1, 0), b3);
            GE_BAR; GE_WAIT_L(0); GE_MMA(0, 1, At, B1); GE_BAR;
            GE_LDA(At, 1, 1); GE_STA(GE_SA(1, 0), k3, o2, 0);
            GE_BAR; GE_WAIT_L(0); GE_MMA(1, 0, At, B0); GE_BAR; GE_SCHED;
            GE_STB(GE_SB(1, 1), b3 + hstepB);
            GE_WAIT_V(6); GE_BAR; GE_MMA(1, 1, At, B1); GE_BAR;
        }
        E(acc, cur, wr, wc, fr, fq);
        if (!has_next) break;
#pragma unroll
        for (int a = 0; a < 2; ++a)
#pragma unroll
            for (int b = 0; b < 2; ++b)
#pragma unroll
                for (int m = 0; m < 4; ++m)
#pragma unroll
                    for (int n = 0; n < 2; ++n) acc[a][b][m][n] = (f32x4){0.f, 0.f, 0.f, 0.f};
        cur = nxt; cB = nB; ++ui;
#pragma unroll
        for (int _h = 0; _h < 2; ++_h)
#pragma unroll
            for (int _i = 0; _i < 2; ++_i) offC[_h][_i] = offN[_h][_i];
    }
    GE_WAIT_V(0);
    if (wr == 0) GE_BAR;
    GE_BAR;
}
#define GE_VALS(v, acc, ai, m) do { _Pragma("unroll") for (int _b = 0; _b < 2; ++_b) _Pragma("unroll") for (int _n = 0; _n < 2; ++_n) _Pragma("unroll") for (int _j = 0; _j < 4; ++_j) (v)[8 * _b + 4 * _n + _j] = (acc)[ai][_b][m][_n][_j]; } while (0)
}

template <class ColF>
__global__ void __launch_bounds__(256) k_prep_w(bf16_t* Bt, int N, int K, int ldw, ColF cf) {
    __shared__ float tile[64][65];
    const int c0 = blockIdx.x * 64, k0 = blockIdx.y * 64, tid = threadIdx.x;
    { const int cc = tid & 63; const float* p = cf(c0 + cc);
#pragma unroll
        for (int i = 0; i < 16; ++i) { const int kk = (tid >> 6) + 4 * i; tile[kk][cc] = p ? p[(size_t)(k0 + kk) * ldw] : 0.f; } }
    __syncthreads();
    { const int cc = tid >> 2, ch = (tid & 3) * 16; unsigned w[8];
#pragma unroll
        for (int i = 0; i < 8; ++i) w[i] = (unsigned)f2bf(tile[ch + 2 * i][cc]) | ((unsigned)f2bf(tile[ch + 2 * i + 1][cc]) << 16);
        uint4* dst = (uint4*)(Bt + (size_t)(c0 + cc) * K + k0 + ch); dst[0] = make_uint4(w[0], w[1], w[2], w[3]); dst[1] = make_uint4(w[4], w[5], w[6], w[7]); }
}
struct ColPlain { const float* W; int ncols; int pad; __device__ const float* operator()(int c) const { const int L = ge::logical_col(c); return L < ncols ? W + L : nullptr; } };

struct EpiResid { const float* xin; const float* mod_g; float* xout;
    __device__ __forceinline__ void operator()(const f32x4 (&acc)[2][2][4][2], const ge::Unit& u, int wr, int wc, int fr, int fq) const {
        const int col0 = (4 * u.pn + wc) * 64 + 16 * fq;
#pragma unroll
        for (int ai = 0; ai < 2; ++ai)
#pragma unroll
            for (int m = 0; m < 4; ++m) { const int row = u.pm * 256 + ai * 128 + wr * 64 + m * 16 + fr; const int b = row / S; float v[16]; GE_VALS(v, acc, ai, m);
                const float* gp = mod_g + b * 6144 + col0; const float* xp = xin + (size_t)row * D + col0; float* op = xout + (size_t)row * D + col0;
#pragma unroll
                for (int q4 = 0; q4 < 4; ++q4) { const float4 g = *(const float4*)(gp + 4 * q4); const float4 xv = *(const float4*)(xp + 4 * q4);
                    *(float4*)(op + 4 * q4) = make_float4(xv.x + g.x * v[4 * q4], xv.y + g.y * v[4 * q4 + 1], xv.z + g.z * v[4 * q4 + 2], xv.w + g.w * v[4 * q4 + 3]); } }
    } };
__device__ __forceinline__ void store16_bf16(bf16_t* dst, const float (&v)[16]) {
    unsigned w[8];
#pragma unroll
    for (int i = 0; i < 8; ++i) w[i] = (unsigned)f2bf(v[2 * i]) | ((unsigned)f2bf(v[2 * i + 1]) << 16);
    uint4* d4 = (uint4*)dst; d4[0] = make_uint4(w[0], w[1], w[2], w[3]); d4[1] = make_uint4(w[4], w[5], w[6], w[7]);
}
struct EpiNsaIn { const float* q_gain; const float* k_gain; const float* rope; bf16_t* q; bf16_t* kv; float* gates;
    __device__ __forceinline__ void operator()(const f32x4 (&acc)[2][2][4][2], const ge::Unit& u, int wr, int wc, int fr, int fq) const {
        const int slot = 4 * u.pn + wc; if (slot > 28) return;
        const bool normed = (slot < 16) || slot == 20 || slot == 21 || slot == 24 || slot == 25;
        const float* gain = (slot < 16) ? q_gain : ((slot < 22) ? k_gain + 64 : k_gain + 128);
        float gv[16];
        if (normed) {
#pragma unroll
            for (int i = 0; i < 16; ++i) gv[i] = gain[16 * fq + i]; }
#pragma unroll
        for (int ai = 0; ai < 2; ++ai)
#pragma unroll
            for (int m = 0; m < 4; ++m) { const int row = u.pm * 256 + ai * 128 + wr * 64 + m * 16 + fr; const int b = row / S, s = row % S; float v[16]; GE_VALS(v, acc, ai, m);
                if (slot == 28) { if (fq < 3) { float* gp = gates + (size_t)row * 48 + 16 * fq;
#pragma unroll
                        for (int q4 = 0; q4 < 4; ++q4) *(float4*)(gp + 4 * q4) = make_float4(sigmoidf_(v[4 * q4]), sigmoidf_(v[4 * q4 + 1]), sigmoidf_(v[4 * q4 + 2]), sigmoidf_(v[4 * q4 + 3])); }
                    continue; }
                if (normed) { float ss = 0.f;
#pragma unroll
                    for (int i = 0; i < 16; ++i) ss += v[i] * v[i];
                    ss += __shfl_xor(ss, 16); ss += __shfl_xor(ss, 32); const float r = rsqrtf(ss * (1.f / 64.f) + 1e-6f);
#pragma unroll
                    for (int i = 0; i < 16; ++i) v[i] *= r * gv[i];
                    if (fq == 0) { const float* rp = rope + s * 16;
#pragma unroll
                        for (int i = 0; i < 8; ++i) { const float cs = rp[i], sn = rp[8 + i], a = v[i], bb = v[i + 8]; v[i] = a * cs - bb * sn; v[i + 8] = bb * cs + a * sn; } } }
                bf16_t* dst;
                if (slot < 16) dst = q + (size_t)row * D + slot * 64 + 16 * fq;
                else { const int kk = slot - 16, ten = kk >> 1, g = kk & 1; dst = kv + (size_t)ten * T * 128 + ((size_t)(b * 2 + g) * S + s) * 64 + 16 * fq; }
                store16_bf16(dst, v); }
    } };
struct EpiMlIn { bf16_t* proj;
    __device__ __forceinline__ void operator()(const f32x4 (&acc)[2][2][4][2], const ge::Unit& u, int wr, int wc, int fr, int fq) const {
        const int slot = 4 * u.pn + wc; const int L0 = slot * 64 + 16 * fq;
#pragma unroll
        for (int ai = 0; ai < 2; ++ai)
#pragma unroll
            for (int m = 0; m < 4; ++m) { const int row = u.pm * 256 + ai * 128 + wr * 64 + m * 16 + fr; float v[16]; GE_VALS(v, acc, ai, m);
                if (slot >= 8 && slot < 16) {
#pragma unroll
                    for (int i = 0; i < 16; ++i) v[i] *= 0.08838834764831845f; }
                if (slot >= 32) {
#pragma unroll
                    for (int i = 0; i < 16; ++i) v[i] = sigmoidf_(v[i]); }
                store16_bf16(proj + (size_t)row * 3072 + L0, v); }
    } };
struct EpiCmp1 { const float* cb1; bf16_t* hid;
    __device__ __forceinline__ void operator()(const f32x4 (&acc)[2][2][4][2], const ge::Unit& u, int wr, int wc, int fr, int fq) const {
        const int L0 = (4 * u.pn + wc) * 64 + 16 * fq; float bv[16];
#pragma unroll
        for (int i = 0; i < 16; ++i) bv[i] = cb1[L0 + i];
#pragma unroll
        for (int ai = 0; ai < 2; ++ai)
#pragma unroll
            for (int m = 0; m < 4; ++m) { const int row = u.pm * 256 + ai * 128 + wr * 64 + m * 16 + fr; float v[16]; GE_VALS(v, acc, ai, m);
#pragma unroll
                for (int i = 0; i < 16; ++i) { const float x = v[i] + bv[i]; v[i] = 0.5f * x * (1.f + tanhf(0.7978845608028654f * (x + 0.044715f * x * x * x))); }
                store16_bf16(hid + (size_t)row * 256 + L0, v); }
    } };
struct MoeOrder { const int* tile_e; const int* total; int G, c, npn, pad;
    __device__ bool next(int i, ge::Unit& u) const { const int L = i * G + c; const int nt = total[1]; if (L >= nt * npn) return false; const int mt = L / npn, pn = L % npn;
        u.pm = mt; u.pn = pn; u.bt = __builtin_amdgcn_readfirstlane(tile_e[mt]) * npn + pn; return true; } };
struct MoeRows { const int* rowtok; __device__ __forceinline__ unsigned operator()(int row) const { const int tk = rowtok[row]; return (unsigned)(tk < 0 ? T : (tk >> 1)) * (unsigned)(D * 2); } };
struct EpiMoe1 { bf16_t* hid;
    __device__ __forceinline__ void operator()(const f32x4 (&acc)[2][2][4][2], const ge::Unit& u, int wr, int wc, int fr, int fq) const {
        const int h0 = (4 * u.pn + wc) * 32 + 8 * fq;
#pragma unroll
        for (int ai = 0; ai < 2; ++ai)
#pragma unroll
            for (int m = 0; m < 4; ++m) { const int row = u.pm * 256 + ai * 128 + wr * 64 + m * 16 + fr; unsigned w[4];
#pragma unroll
                for (int n = 0; n < 2; ++n)
#pragma unroll
                    for (int jj = 0; jj < 2; ++jj) { const float g0 = acc[ai][0][m][n][2 * jj], g1 = acc[ai][0][m][n][2 * jj + 1], u0 = acc[ai][1][m][n][2 * jj], u1 = acc[ai][1][m][n][2 * jj + 1];
                        const float r0 = g0 / (1.f + expf(-g0)) * u0, r1 = g1 / (1.f + expf(-g1)) * u1; w[2 * n + jj] = (unsigned)f2bf(r0) | ((unsigned)f2bf(r1) << 16); }
                *(uint4*)(hid + (size_t)row * DE + h0) = make_uint4(w[0], w[1], w[2], w[3]); }
    } };
struct EpiMoe2 { bf16_t* outk; const int* rowtok; const float* tokw;
    __device__ __forceinline__ void operator()(const f32x4 (&acc)[2][2][4][2], const ge::Unit& u, int wr, int wc, int fr, int fq) const {
        const int L0 = (4 * u.pn + wc) * 64 + 16 * fq;
#pragma unroll
        for (int ai = 0; ai < 2; ++ai)
#pragma unroll
            for (int m = 0; m < 4; ++m) { const int row = u.pm * 256 + ai * 128 + wr * 64 + m * 16 + fr; const int tk = rowtok[row]; if (tk < 0) continue; const float w = tokw[tk]; float v[16]; GE_VALS(v, acc, ai, m);
#pragma unroll
                for (int i = 0; i < 16; ++i) v[i] *= w;
                store16_bf16(outk + (size_t)(tk & 1) * T * D + (size_t)(tk >> 1) * D + L0, v); }
    } };
struct ColGateUp { const float* wg; const float* wu; __device__ const float* operator()(int c) const { const int e = c >> 10, cc = c & 1023; const int pn = cc >> 8, bj = (cc >> 7) & 1, wc = (cc >> 5) & 3, n = (cc >> 4) & 1, fq = (cc >> 2) & 3, j = cc & 3;
        const int hidx = 32 * (4 * pn + wc) + 8 * fq + 4 * n + j; return (bj ? wu : wg) + (size_t)e * D * DE + hidx; } };
struct ColDown { const float* wd; __device__ const float* operator()(int c) const { const int e = c >> 10; return wd + (size_t)e * DE * D + ge::logical_col(c & 1023); } };
template <class RowMap, class Epi>
__global__ void __launch_bounds__(512, 2) k_gemm_moe(const bf16_t* A, const bf16_t* Bt, int K, int npn, const int* tile_e, const int* total, RowMap RM, Epi E) {
    extern __shared__ __attribute__((aligned(16))) unsigned char shm[];
    MoeOrder So{tile_e, total, (int)gridDim.x, (int)blockIdx.x, npn, 0};
    ge::gemm_phase<MoeOrder, RowMap, Epi>((LAS unsigned char*)shm, A, Bt, K, So, RM, E);
}
template <class RowMap, class Epi>
__global__ void __launch_bounds__(512, 2) k_gemm_dense(const bf16_t* A, const bf16_t* Bt, int M, int N, int K, RowMap RM, Epi E) {
    extern __shared__ __attribute__((aligned(16))) unsigned char shm[];
    ge::DenseOrder So; So.init(M, N, (int)gridDim.x, (int)blockIdx.x);
    ge::gemm_phase<ge::DenseOrder, RowMap, Epi>((LAS unsigned char*)shm, A, Bt, K, So, RM, E);
}

static inline size_t al(size_t x) { return (x + 255) & ~(size_t)255; }
extern "C" void kernel_launch(void* const* d_in, const int* in_sizes, int n_in, void* d_out, int out_size, void* d_ws, size_t ws_size, hipStream_t stream) {
    const float* x = (const float*)d_in[0]; const float* c = (const float*)d_in[1]; const float* ada_w = (const float*)d_in[2]; const float* ada_b = (const float*)d_in[3];
    const float* g_mix = (const float*)d_in[4]; const float* g_ffn = (const float*)d_in[5];
    const float* nsa_w_in = (const float*)d_in[6]; const float* nsa_w_out = (const float*)d_in[7]; const float* q_gain = (const float*)d_in[8]; const float* k_gain = (const float*)d_in[9];
    const float* cmp_pe = (const float*)d_in[10]; const float* cmp_w1 = (const float*)d_in[11]; const float* cmp_b1 = (const float*)d_in[12]; const float* cmp_w2 = (const float*)d_in[13]; const float* cmp_b2 = (const float*)d_in[14];
    const float* ml_w_in = (const float*)d_in[15]; const float* ml_bi = (const float*)d_in[16]; const float* ml_bf = (const float*)d_in[17]; const float* ml_ng = (const float*)d_in[18]; const float* ml_w_out = (const float*)d_in[19];
    const float* router_w = (const float*)d_in[20]; const float* router_b = (const float*)d_in[21]; const float* w_gate = (const float*)d_in[22]; const float* w_up = (const float*)d_in[23]; const float* w_down = (const float*)d_in[24];
    float* out = (float*)d_out; char* ws = (char*)d_ws;
    size_t off = 0;
    auto take = [&](size_t bytes) { size_t o = off; off = al(off + bytes); return o; };
    int* cnt = (int*)(ws + take(2 * 64 * 4));
    float* mod = (float*)(ws + take((size_t)2 * 16 * 6144 * 4));
    float* rope = (float*)(ws + take(2048 * 16 * 4));
    float* rstd = (float*)(ws + take((size_t)T * 4));
    float* cb1 = (float*)(ws + take(512 * 4));
    int* pstart = (int*)(ws + take(64 * 4)); int* total = (int*)(ws + take(64)); int* tile_e = (int*)(ws + take(2048 * 4));
    int* rowtok = (int*)(ws + take((size_t)(65536 + 8192) * 4)); float* tokw = (float*)(ws + take((size_t)T * 2 * 4)); int* list = (int*)(ws + take((size_t)NE * T * 4));
    float* aff = (float*)(ws + take((size_t)T * NE * 4)); float* li = (float*)(ws + take((size_t)T * 4 * 4)); float* lf = (float*)(ws + take((size_t)T * 4 * 4));
    bf16_t* h = (bf16_t*)(ws + take((size_t)(T + 8) * D * 2));
    float* tmp = (float*)(ws + take((size_t)4096 * 256 * 4));
    float* xa = (float*)(ws + take((size_t)T * D * 4));
    bf16_t* wo_nsa_t = (bf16_t*)(ws + take((size_t)D * D * 2)); bf16_t* wo_ml_t = (bf16_t*)(ws + take((size_t)D * D * 2));
    bf16_t* win_nsa_t = (bf16_t*)(ws + take((size_t)2048 * D * 2)); bf16_t* win_ml_t = (bf16_t*)(ws + take((size_t)3072 * D * 2)); bf16_t* w1c_t = (bf16_t*)(ws + take((size_t)2 * 256 * 2048 * 2));
    bf16_t* gu_t = (bf16_t*)(ws + take((size_t)NE * 1024 * D * 2)); bf16_t* dn_t = (bf16_t*)(ws + take((size_t)NE * D * DE * 2));
    size_t r1 = off;
    bf16_t* q = (bf16_t*)(ws + take((size_t)T * D * 2)); bf16_t* kv = (bf16_t*)(ws + take((size_t)6 * T * 128 * 2 + (1 << 20)));
    float* gates = (float*)(ws + take((size_t)T * 48 * 4)); bf16_t* kcmp = (bf16_t*)(ws + take((size_t)32 * 128 * 64 * 2)); bf16_t* vcmp = (bf16_t*)(ws + take((size_t)32 * 128 * 64 * 2));
    size_t end_nsa = off; off = r1;
    bf16_t* proj = (bf16_t*)(ws + take((size_t)T * 3072 * 2)); size_t end_ml = off; off = r1;
    bf16_t* hid = (bf16_t*)(ws + take((size_t)(65536 + 8192) * DE * 2)); bf16_t* outk = (bf16_t*)(ws + take((size_t)2 * T * D * 2)); size_t end_moe = off;
    size_t need = end_nsa > end_ml ? end_nsa : end_ml; if (end_moe > need) need = end_moe;
    if (need > ws_size) return;

    hipMemsetAsync(cnt, 0, 2 * 64 * 4, stream);
    k_rope_table<<<(2048 * 8 + 255) / 256, 256, 0, stream>>>(rope);
    k_mod<<<(2 * 16 * 6144 + 255) / 256, 256, 0, stream>>>(c, ada_w, ada_b, mod);
    static bool attr_done = false;
    if (!attr_done) { (void)hipFuncSetAttribute((const void*)k_gemm_dense<ge::DenseRows, EpiResid>, hipFuncAttributeMaxDynamicSharedMemorySize, ge::STAGE_BYTES);
        (void)hipFuncSetAttribute((const void*)k_gemm_dense<ge::DenseRows, EpiNsaIn>, hipFuncAttributeMaxDynamicSharedMemorySize, ge::STAGE_BYTES);
        (void)hipFuncSetAttribute((const void*)k_gemm_dense<ge::DenseRows, EpiMlIn>, hipFuncAttributeMaxDynamicSharedMemorySize, ge::STAGE_BYTES);
        (void)hipFuncSetAttribute((const void*)k_gemm_dense<ge::DenseRows, EpiCmp1>, hipFuncAttributeMaxDynamicSharedMemorySize, ge::STAGE_BYTES);
        (void)hipFuncSetAttribute((const void*)k_gemm_moe<MoeRows, EpiMoe1>, hipFuncAttributeMaxDynamicSharedMemorySize, ge::STAGE_BYTES);
        (void)hipFuncSetAttribute((const void*)k_gemm_moe<ge::DenseRows, EpiMoe2>, hipFuncAttributeMaxDynamicSharedMemorySize, ge::STAGE_BYTES); attr_done = true; }
    k_prep_w<<<dim3(D / 64, D / 64), 256, 0, stream>>>(wo_nsa_t, D, D, D, ColPlain{nsa_w_out, D});
    k_prep_w<<<dim3(D / 64, D / 64), 256, 0, stream>>>(wo_ml_t, D, D, D, ColPlain{ml_w_out, D});
    k_prep_w<<<dim3(2048 / 64, D / 64), 256, 0, stream>>>(win_nsa_t, 2048, D, NSA_COLS, ColPlain{nsa_w_in, NSA_COLS});
    k_prep_w<<<dim3(3072 / 64, D / 64), 256, 0, stream>>>(win_ml_t, 3072, D, ML_COLS, ColPlain{ml_w_in, 3072});
    for (int w = 0; w < 2; ++w) k_prep_w<<<dim3(256 / 64, 2048 / 64), 256, 0, stream>>>(w1c_t + (size_t)w * 256 * 2048, 256, 2048, 256, ColPlain{cmp_w1 + (size_t)w * 2048 * 256, 256});
    (void)hipMemsetAsync(h + (size_t)T * D, 0, 8 * D * 2, stream);

    auto moe = [&](int layer, const float* xin  , float* xout) {
        const float* m = mod + (size_t)layer * 16 * 6144;
        k_norm<<<T / 4, 256, 0, stream>>>(xin, g_ffn + layer * D, m + 3 * D, m + 4 * D, h, rstd);
        k_router<<<T / 8, 256, 0, stream>>>(xin, rstd, g_ffn + layer * D, m + 3 * D, m + 4 * D, router_w, aff);
        int* cn = cnt + layer * 64;
        k_route<<<T / 256, 256, 0, stream>>>(aff, router_b, tokw, cn, list);
        k_moe_plan<<<1, 64, 0, stream>>>(cn, pstart, total, tile_e);
        k_moe_fill<<<dim3(T / 256, NE), 256, 0, stream>>>(cn, pstart, list, rowtok);
        const size_t wo = (size_t)layer * NE * D * DE;
        k_prep_w<<<dim3(NE * 1024 / 64, D / 64), 256, 0, stream>>>(gu_t, NE * 1024, D, DE, ColGateUp{w_gate + wo, w_up + wo});
        k_prep_w<<<dim3(NE * 1024 / 64, DE / 64), 256, 0, stream>>>(dn_t, NE * 1024, DE, D, ColDown{w_down + wo});
        k_gemm_moe<<<256, 512, ge::STAGE_BYTES, stream>>>(h, gu_t, D, 4, tile_e, total, MoeRows{rowtok}, EpiMoe1{hid});
        k_gemm_moe<<<256, 512, ge::STAGE_BYTES, stream>>>(hid, dn_t, DE, 4, tile_e, total, ge::DenseRows{(unsigned)DE * 2u}, EpiMoe2{outk, rowtok, tokw});
        k_combine<<<(unsigned)(((size_t)T * D + 255) / 256), 256, 0, stream>>>(xin, m + 5 * D, outk, xout);
    };

    {
        const float* m = mod;
        k_norm<<<T / 4, 256, 0, stream>>>(x, g_mix, m + 0 * D, m + 1 * D, h, rstd);
        k_gemm_dense<<<256, 512, ge::STAGE_BYTES, stream>>>(h, win_nsa_t, T, 2048, D, ge::DenseRows{(unsigned)D * 2u}, EpiNsaIn{q_gain, k_gain, rope, q, kv, gates});
        k_cmp_bias<<<2, 256, 0, stream>>>(cmp_pe, cmp_w1, cmp_b1, cb1);
        for (int w = 0; w < 2; ++w) {
            const bf16_t* raw = kv + (size_t)w * T * 128;
            k_gemm_dense<<<256, 512, ge::STAGE_BYTES, stream>>>(raw, w1c_t + (size_t)w * 256 * 2048, 4096, 256, 2048, ge::DenseRows{2048u}, EpiCmp1{cb1 + w * 256, (bf16_t*)tmp});
            k_cmp2<<<4096, 64, 0, stream>>>(tmp, nullptr, cmp_w2 + (size_t)w * 256 * 64, cmp_b2 + w * 64, k_gain, rope, w == 0, w == 0 ? kcmp : vcmp);
        }
        k_nsa_attn<<<dim3(T, 2), 512, 0, stream>>>(q, kv, kcmp, vcmp, gates, h);
        k_gemm_dense<<<256, 512, ge::STAGE_BYTES, stream>>>(h, wo_nsa_t, T, D, D, ge::DenseRows{(unsigned)D * 2u}, EpiResid{x, m + 2 * D, out});
        moe(0, out, xa);
    }
    {
        const float* m = mod + (size_t)16 * 6144;
        k_norm<<<T / 4, 256, 0, stream>>>(xa, g_mix + D, m + 0 * D, m + 1 * D, h, rstd);
        k_ml_gates<<<T / 32, 256, 0, stream>>>(xa, rstd, g_mix + D, m + 0 * D, m + 1 * D, ml_w_in, ml_bi, ml_bf, li, lf);
        k_gemm_dense<<<256, 512, ge::STAGE_BYTES, stream>>>(h, win_ml_t, T, 3072, D, ge::DenseRows{(unsigned)D * 2u}, EpiMlIn{proj});
        k_ml_scan<<<64, 256, 0, stream>>>(proj, li, lf);
        k_ml_gate<<<T, 256, 0, stream>>>(proj, ml_ng);
        k_gemm_dense<<<256, 512, ge::STAGE_BYTES, stream>>>(proj + 2048, wo_ml_t, T, D, D, ge::DenseRows{3072u * 2u}, EpiResid{xa, m + 2 * D, out});
        moe(1, out, out);
    }
}
```

```cpp
#include <hip/hip_runtime.h>
#include <stdint.h>

typedef unsigned short bf16_t;
__device__ __forceinline__ float bf2f(bf16_t v) { return __uint_as_float(((unsigned)v) << 16); }
typedef float f32x2_t __attribute__((ext_vector_type(2)));
__device__ __forceinline__ unsigned pk2g(float a, float b) { typedef __bf16 b2 __attribute__((ext_vector_type(2))); b2 r = __builtin_convertvector((f32x2_t){a, b}, b2); return __builtin_bit_cast(unsigned, r); }
__device__ __forceinline__ bf16_t f2bf(float f) { return (bf16_t)pk2g(f, f); }

constexpr int Bn = 16, S = 2048, D = 1024, T = Bn * S;
constexpr int NSA_COLS = 1840, ML_COLS = 3080;
constexpr int NE = 32, DE = 512;
constexpr int NWG = 256, NTHR = 512;

template <int M> __device__ __forceinline__ float sx(float v) { return __int_as_float(__builtin_amdgcn_ds_swizzle(__float_as_int(v), (M << 10) | 0x1F)); }
template <int M> __device__ __forceinline__ unsigned sxu(unsigned v) { return (unsigned)__builtin_amdgcn_ds_swizzle((int)v, (M << 10) | 0x1F); }
__device__ __forceinline__ float sum32(float v) { const auto r = __builtin_amdgcn_permlane32_swap(__float_as_uint(v), __float_as_uint(v), false, false); return __uint_as_float(r[0]) + __uint_as_float(r[1]); }
__device__ __forceinline__ float max32(float v) { const auto r = __builtin_amdgcn_permlane32_swap(__float_as_uint(v), __float_as_uint(v), false, false); return fmaxf(__uint_as_float(r[0]), __uint_as_float(r[1])); }
__device__ __forceinline__ float other32(float v, bool hi) { const auto r = __builtin_amdgcn_permlane32_swap(__float_as_uint(v), __float_as_uint(v), false, false); return __uint_as_float(hi ? r[0] : r[1]); }
template <int CTRL> __device__ __forceinline__ float dppf(float v) { return __int_as_float(__builtin_amdgcn_update_dpp(0, __float_as_int(v), CTRL, 0xF, 0xF, true)); }
__device__ __forceinline__ float sum16(float v) { const auto r = __builtin_amdgcn_permlane16_swap(__float_as_uint(v), __float_as_uint(v), false, false); return __uint_as_float(r[0]) + __uint_as_float(r[1]); }
__device__ __forceinline__ float max16(float v) { const auto r = __builtin_amdgcn_permlane16_swap(__float_as_uint(v), __float_as_uint(v), false, false); return fmaxf(__uint_as_float(r[0]), __uint_as_float(r[1])); }
__device__ __forceinline__ float wave_sum(float v) { v += dppf<0xB1>(v); v += dppf<0x4E>(v); v += dppf<0x141>(v); v += dppf<0x140>(v); v = sum16(v); return sum32(v); }
__device__ __forceinline__ float wave_max(float v) { v = fmaxf(v, dppf<0xB1>(v)); v = fmaxf(v, dppf<0x4E>(v)); v = fmaxf(v, dppf<0x141>(v)); v = fmaxf(v, dppf<0x140>(v)); v = max16(v); return max32(v); }
__device__ __forceinline__ float rdlane(float v, int l) { return __int_as_float(__builtin_amdgcn_readlane(__float_as_int(v), l)); }
__device__ __forceinline__ float sigmoidf_(float x) { return 1.f / (1.f + expf(-x)); }
__device__ __forceinline__ float fsigmoid(float x) { return __builtin_amdgcn_rcpf(1.f + __builtin_amdgcn_exp2f(-1.4426950408889634f * x)); }
__device__ __forceinline__ float ftanh(float x) { return 1.f - 2.f * __builtin_amdgcn_rcpf(1.f + __builtin_amdgcn_exp2f(2.8853900817779268f * x)); }

#define XB_TMO      128
#define XB_XCNT(j)  (256  + 64 * (j))
#define XB_XSUB(j)  (1280 + 64 * (j))
#define XB_XGEN(j)  (2304 + 64 * (j))
#define XB_TOP      3328
#define XB_TOPGEN   3392
#define XCD_BAR_WORDS 3456
#define XB_SPIN_CAP (1u << 18)
#define LAS __attribute__((address_space(3)))
__device__ __forceinline__ unsigned xb_ld(unsigned* p)              { return __hip_atomic_load(p, __ATOMIC_RELAXED, __HIP_MEMORY_SCOPE_AGENT); }
__device__ __forceinline__ unsigned xb_add(unsigned* p, unsigned v) { return __hip_atomic_fetch_add(p, v, __ATOMIC_RELAXED, __HIP_MEMORY_SCOPE_AGENT); }
__device__ __forceinline__ unsigned xb_xcc_id() { return (unsigned)__builtin_amdgcn_s_getreg((3 << 11) | 20) & 0xFu; }
#define XB_SPIN(cond, bar) do { unsigned _sp = 0; while (cond) { __builtin_amdgcn_s_sleep(1); \
    if ((++_sp & 255u) == 0u) { if (xb_ld(&(bar)[XB_TMO])) break; if (_sp > XB_SPIN_CAP) { atomicAdd(&(bar)[XB_TMO], 1u); break; } } } } while (0)
struct XcdBarrier { unsigned* bar; unsigned x; volatile LAS unsigned* st; };
__device__ __forceinline__ XcdBarrier xcd_barrier_post(unsigned* bar, volatile LAS unsigned* st) {
    XcdBarrier b; b.bar = bar; b.x = xb_xcc_id(); b.st = st;
    if (threadIdx.x == 0) (void)xb_add(&bar[XB_XCNT(b.x)], 1u);
    return b;
}
__device__ __forceinline__ void xcd_barrier_complete(unsigned* bar, unsigned x, unsigned& nloc, unsigned& nx) {
    const unsigned G = gridDim.x * gridDim.y * gridDim.z;
    unsigned sum, cnt, mine, sp = 0u;
    for (;;) {
        sum = 0u; cnt = 0u; mine = 0u;
#pragma unroll
        for (unsigned j = 0; j < 16; ++j) { const unsigned c = xb_ld(&bar[XB_XCNT(j)]); sum += c; cnt += (c > 0u) ? 1u : 0u; mine = (j == x) ? c : mine; }
        if (sum == G) break;
        __builtin_amdgcn_s_sleep(1);
        if ((++sp & 255u) == 0u) { if (xb_ld(&bar[XB_TMO])) break; if (sp > XB_SPIN_CAP) { atomicAdd(&bar[XB_TMO], 1u); break; } }
    }
    nloc = mine > 0u ? mine : 1u; nx = cnt > 0u ? cnt : 1u;
}
__device__ __forceinline__ void xcd_barrier(const XcdBarrier& b, const bool leader  ) {
    asm volatile("s_waitcnt vmcnt(0)" ::: "memory");
    __syncthreads();
    if (leader) {
        unsigned* bar = b.bar;
        __builtin_amdgcn_s_waitcnt(0);
        unsigned nloc = b.st[0], nx = b.st[1];
        if (nloc == 0u) { xcd_barrier_complete(bar, b.x, nloc, nx); b.st[0] = nloc; b.st[1] = nx; }
        const unsigned old = xb_add(&bar[XB_XSUB(b.x)], 1u);
        const unsigned gen = old / nloc;
        if (old + 1u == (gen + 1u) * nloc) {
            __builtin_amdgcn_fence(__ATOMIC_RELEASE, "agent");
            asm volatile("s_waitcnt vmcnt(0)" ::: "memory");
            const unsigned og = xb_add(&bar[XB_TOP], 1u);
            const unsigned tg = og / nx;
            if (og + 1u == (tg + 1u) * nx) xb_add(&bar[XB_TOPGEN], 1u);
            else XB_SPIN(xb_ld(&bar[XB_TOPGEN]) == tg, bar);
            __builtin_amdgcn_fence(__ATOMIC_ACQUIRE, "agent");
            xb_add(&bar[XB_XGEN(b.x)], 1u);
            asm volatile("s_waitcnt vmcnt(0)" ::: "memory");
        } else {
            XB_SPIN(xb_ld(&bar[XB_XGEN(b.x)]) == gen, bar);
            __builtin_amdgcn_fence(__ATOMIC_ACQUIRE, "agent");
            asm volatile("s_waitcnt vmcnt(0)" ::: "memory");
        }
    }
    __syncthreads();
}

typedef short bf16x8 __attribute__((ext_vector_type(8)));
typedef float f32x4 __attribute__((ext_vector_type(4)));
namespace ge {
constexpr int BM = 256, BK = 64, HALF = 128, HTB = HALF * BK * 2, STAGE_BYTES = 8 * HTB;
__host__ __device__ __forceinline__ int lds_byte(int r, int c) { const int st = (r >> 4) * 2 + (c >> 5), rr = r & 15, cc = c & 31, ob = rr * 64 + cc * 2; return st * 1024 + (ob ^ (((ob >> 9) & 1) << 5)); }
__host__ __device__ __forceinline__ void stage_rc(int b, int& R, int& C) { const int st = b / 1024, sb = b % 1024, swz = sb ^ (((sb >> 9) & 1) << 5); R = (st >> 1) * 16 + swz / 64; C = (st & 1) * 32 + (swz % 64) / 2; }
struct Unit { int pm, pn, bt, aux; };
__host__ __device__ __forceinline__ int logical_col(int c) { const int pn = c >> 8, bj = (c >> 7) & 1, wc = (c >> 5) & 3, n = (c >> 4) & 1, fq = (c >> 2) & 3, j = c & 3; return (4 * pn + wc) * 64 + 16 * fq + 8 * bj + 4 * n + j; }
struct DenseOrder {
    int nM, nN, nwg, G, c;
    __device__ void init(int M, int N, int G_, int c_) { nM = M / BM; nN = N / BM; nwg = nM * nN; G = G_; c = c_; }
    __device__ bool next(int i, Unit& u) const {
        const long L = (long)i * G + c; if (L >= nwg) return false;
        int wgid = (int)L; { const int q = nwg / 8, r = nwg % 8, xcd = wgid % 8, off = wgid / 8; wgid = (xcd < r ? xcd * (q + 1) : r * (q + 1) + (xcd - r) * q) + off; }
        const int nig = 8 * nN, gid = wgid / nig, fm = gid * 8, gsz = (nM - fm) < 8 ? (nM - fm) : 8;
        u.pm = fm + ((wgid % nig) % gsz); u.pn = (wgid % nig) / gsz; u.bt = u.pn; u.aux = 0; return true;
    }
};
struct DenseRows { static constexpr bool dense = true; unsigned ldab; __device__ __forceinline__ unsigned operator()(const Unit& u, int r) const { return (unsigned)(u.pm * 256 + r) * ldab; } };
template <class Tp> __device__ __forceinline__ Tp* uni(Tp* v) { const unsigned long long u = (unsigned long long)v; const unsigned lo = __builtin_amdgcn_readfirstlane((unsigned)u), hi = __builtin_amdgcn_readfirstlane((unsigned)(u >> 32)); return (Tp*)(((unsigned long long)hi << 32) | lo); }

typedef int i32x8 __attribute__((ext_vector_type(8)));
typedef int i32x4 __attribute__((ext_vector_type(4)));
template <bool F8> struct Frag;
template <> struct Frag<false> { bf16x8 v[2]; };
template <> struct Frag<true> { i32x8 v; };
template <bool F8> __device__ __forceinline__ void load_frag(Frag<F8>& f, const LAS unsigned char* p0) {
    if constexpr (F8) { const i32x4 lo = *(const LAS i32x4*)p0, hi = *(const LAS i32x4*)(p0 + 16); f.v = __builtin_shufflevector(lo, hi, 0, 1, 2, 3, 4, 5, 6, 7); }
    else { f.v[0] = *(const LAS bf16x8*)p0; f.v[1] = *(const LAS bf16x8*)(p0 + 1024); }
}
template <bool F8> __device__ __forceinline__ f32x4 mma_kt(const Frag<F8>& b, const Frag<F8>& a, f32x4 c) {
    if constexpr (F8) return __builtin_amdgcn_mfma_scale_f32_16x16x128_f8f6f4(b.v, a.v, c, 0, 0, 0, 0x7F7F7F7F, 0, 0x7F7F7F7F);
    else { c = __builtin_amdgcn_mfma_f32_16x16x32_bf16(b.v[0], a.v[0], c, 0, 0, 0); return __builtin_amdgcn_mfma_f32_16x16x32_bf16(b.v[1], a.v[1], c, 0, 0, 0); }
}
template <bool F8 = false, class Sched, class RowMap, class Epi>
__device__ __forceinline__ void gemm_phase(LAS unsigned char* lds, const void* A, const void* Bt, const int K, const Sched& S, const RowMap& RM, const Epi& E, const int wave_id, const int ldb_ = 0  ) {
    int tid_; asm volatile("v_mbcnt_lo_u32_b32 %0, -1, 0\n\tv_mbcnt_hi_u32_b32 %0, -1, %0" : "=v"(tid_)); tid_ += wave_id * 64;
    const int tid = tid_, wid = __builtin_amdgcn_readfirstlane(tid >> 6), lane = tid & 63, wr = wid >> 2, wc = wid & 3, fr = lane & 15, fq = lane >> 4;
    const int nt = K / (F8 ? 2 * BK : BK);
    constexpr bool DR = RowMap::dense;
    int sR[2], sC[2];
    const int ldb = ldb_ ? ldb_ : K;
#pragma unroll
    for (int i = 0; i < 2; ++i) stage_rc(tid * 16 + i * 8192, sR[i], sC[i]);
    const unsigned voffB = F8 ? (unsigned)(sR[0] * ldb + sC[0] * 2) : (unsigned)(sR[0] * ldb + sC[0]) * 2u;
    unsigned ldab_ = 0, voffA = 0; if constexpr (DR) { ldab_ = RM.ldab; voffA = (unsigned)sR[0] * ldab_ + (unsigned)sC[0] * 2u; }
    const size_t kstep = (size_t)(BK * 2), hstepB = (size_t)HALF * ldb * (F8 ? 1 : 2), tstepB = 2 * hstepB, qstepB = hstepB / 2;
    const unsigned ldsw = (unsigned)wid * 1024u;
    const int aoff = lds_byte(wr * 64 + fr, fq * (F8 ? 16 : 8)), boff = lds_byte(wc * 32 + fr, fq * (F8 ? 16 : 8));
    const char* Ab = (const char*)A;
#define GE_SA(b, h) (((b) * 2 + (h)) * ge::HTB)
#define GE_SB(b, h) ((4 + (b) * 2 + (h)) * ge::HTB)
#define GE_GLD(sp, vo, ldsoff) do { unsigned _v = (vo); asm volatile("" : "+v"(_v));     \
        __builtin_amdgcn_global_load_lds((const unsigned*)(uni((const char*)(sp)) + _v), (LAS unsigned*)(lds + (ldsoff)), 16, 0, 0); } while (0)
#define GE_STB(bufoff, gbase) do { _Pragma("unroll") for (int _i = 0; _i < 2; ++_i) GE_GLD((gbase) + _i * qstepB, voffB, (bufoff) + ldsw + _i * 8192); } while (0)
#define GE_STA(bufoff, sp, OFF, h) do { _Pragma("unroll") for (int _i = 0; _i < 2; ++_i) { \
        if constexpr (DR) GE_GLD((sp) + (size_t)((h) * 128 + _i * 64) * ldab_, voffA, (bufoff) + ldsw + _i * 8192); \
        else GE_GLD((sp), (OFF)[h][_i], (bufoff) + ldsw + _i * 8192); } } while (0)
#define GE_LDA(dst, b, h) do { _Pragma("unroll") for (int m = 0; m < 4; ++m) load_frag<F8>(dst[m], lds + GE_SA(b, h) + aoff + m * 2048); } while (0)
#define GE_LDB(dst, b, h) do { _Pragma("unroll") for (int n = 0; n < 2; ++n) load_frag<F8>(dst[n], lds + GE_SB(b, h) + boff + n * 2048); } while (0)
#define GE_MMA(ai, bj, At, Bt_) do { __builtin_amdgcn_s_setprio(1); _Pragma("unroll") for (int m = 0; m < 4; ++m) _Pragma("unroll") for (int n = 0; n < 2; ++n) \
        acc[ai][bj][m][n] = mma_kt<F8>(Bt_[n], At[m], acc[ai][bj][m][n]); __builtin_amdgcn_s_setprio(0); } while (0)
#define GE_WAIT_V(n) asm volatile("s_waitcnt vmcnt(" #n ")" ::: "memory")
#define GE_WAIT_L(n) asm volatile("s_waitcnt lgkmcnt(" #n ")" ::: "memory")
#define GE_BAR __builtin_amdgcn_s_barrier()
#define GE_SCHED __builtin_amdgcn_sched_barrier(0)
#define GE_OFFS(OFF, u) do { int _l; asm volatile("v_mbcnt_lo_u32_b32 %0, -1, 0\n\tv_mbcnt_hi_u32_b32 %0, -1, %0" : "=v"(_l)); int _r0, _c0; stage_rc((wave_id * 64 + _l) * 16, _r0, _c0);     \
        _Pragma("unroll") for (int _h = 0; _h < 2; ++_h) _Pragma("unroll") for (int _i = 0; _i < 2; ++_i) (OFF)[_h][_i] = RM((u), _h * 128 + _i * 64 + _r0) + (unsigned)_c0 * 2u; \
        asm volatile("" : "+v"((OFF)[0][0]), "+v"((OFF)[0][1]), "+v"((OFF)[1][0]), "+v"((OFF)[1][1])); } while (0)
    Unit cur, nxt; int ui = 0;
    if (!S.next(0, cur)) return;
    unsigned offC[2][2];
    const char* aC = Ab; const char* aN = Ab;
    if constexpr (DR) aC = Ab + (size_t)cur.pm * 256 * ldab_; else GE_OFFS(offC, cur);
    f32x4 acc[2][2][4][2];
#pragma unroll
    for (int a = 0; a < 2; ++a)
#pragma unroll
        for (int b = 0; b < 2; ++b)
#pragma unroll
            for (int m = 0; m < 4; ++m)
#pragma unroll
                for (int n = 0; n < 2; ++n) acc[a][b][m][n] = (f32x4){0.f, 0.f, 0.f, 0.f};
    Frag<F8> At[4], B0[2], B1[2];
    const char* cB = (const char*)Bt + (size_t)cur.bt * tstepB;
    GE_STB(GE_SB(0, 0), cB); GE_STA(GE_SA(0, 0), aC, offC, 0); GE_STB(GE_SB(0, 1), cB + hstepB); GE_STA(GE_SA(0, 1), aC, offC, 1);
    if (wr == 1) GE_BAR;
    GE_WAIT_V(4); GE_BAR;
    GE_STB(GE_SB(1, 0), cB + kstep); GE_STA(GE_SA(1, 0), aC + kstep, offC, 0); GE_STB(GE_SB(1, 1), cB + hstepB + kstep);
    GE_WAIT_V(6); GE_BAR;
    for (;;) {
        const bool has_next = S.next(ui + 1, nxt);
        if constexpr (DR) aN = has_next ? Ab + (size_t)nxt.pm * 256 * ldab_ : aC;
        const char* nB = has_next ? (const char*)Bt + (size_t)nxt.bt * tstepB : cB;
#pragma unroll 1
        for (int t = 0; t < nt; t += 2) {
            const bool last = (t == nt - 2);
            const size_t k1 = (size_t)(t + 1) * kstep;
            const size_t k2 = last ? 0 : (size_t)(t + 2) * kstep, k3 = k2 + kstep;
            const char* b2 = last ? nB : cB + (size_t)(t + 2) * kstep; const char* b3 = b2 + kstep;
            const char* a2 = last ? aN : aC;
            GE_LDB(B0, 0, 0); GE_SCHED; GE_LDA(At, 0, 0); GE_STA(GE_SA(1, 1), aC + k1, offC, 1);
            GE_WAIT_L(8); GE_BAR; GE_WAIT_L(0); GE_MMA(0, 0, At, B0); GE_BAR; GE_SCHED;
            GE_LDB(B1, 0, 1); GE_STB(GE_SB(0, 0), b2);
            GE_BAR; GE_WAIT_L(0); GE_MMA(0, 1, At, B1); GE_BAR;
            GE_LDA(At, 0, 1);
            if constexpr (!DR) { if (last && has_next) GE_OFFS(offC, nxt); }
            GE_STA(GE_SA(0, 0), a2 + k2, offC, 0);
            GE_BAR; GE_WAIT_L(0); GE_MMA(1, 0, At, B0); GE_BAR; GE_SCHED;
            GE_STB(GE_SB(0, 1), b2 + hstepB);
            GE_WAIT_V(6); GE_BAR; GE_MMA(1, 1, At, B1); GE_BAR;
            GE_LDB(B0, 1, 0); GE_SCHED; GE_LDA(At, 1, 0); GE_STA(GE_SA(0, 1), a2 + k2, offC, 1);
            GE_WAIT_L(8); GE_BAR; GE_WAIT_L(0); GE_MMA(0, 0, At, B0); GE_BAR; GE_SCHED;
            GE_LDB(B1, 1, 1); GE_STB(GE_SB(1, 0), b3);
            GE_BAR; GE_WAIT_L(0); GE_MMA(0, 1, At, B1); GE_BAR;
            GE_LDA(At, 1, 1); GE_STA(GE_SA(1, 0), a2 + k3, offC, 0);
            GE_BAR; GE_WAIT_L(0); GE_MMA(1, 0, At, B0); GE_BAR; GE_SCHED;
            GE_STB(GE_SB(1, 1), b3 + hstepB);
            GE_WAIT_V(6); GE_BAR; GE_MMA(1, 1, At, B1); GE_BAR;
        }
#pragma unroll
        for (int a = 0; a < 2; ++a)
#pragma unroll
            for (int b = 0; b < 2; ++b) asm volatile("" : "+v"(acc[a][b][0][0]), "+v"(acc[a][b][0][1]), "+v"(acc[a][b][1][0]), "+v"(acc[a][b][1][1]), "+v"(acc[a][b][2][0]), "+v"(acc[a][b][2][1]), "+v"(acc[a][b][3][0]), "+v"(acc[a][b][3][1]));
        { int l2; asm volatile("v_mbcnt_lo_u32_b32 %0, -1, 0\n\tv_mbcnt_hi_u32_b32 %0, -1, %0" : "=v"(l2)); E(acc, cur, wr, wc, l2 & 15, l2 >> 4); }
        if (!has_next) break;
#pragma unroll
        for (int a = 0; a < 2; ++a)
#pragma unroll
            for (int b = 0; b < 2; ++b)
#pragma unroll
                for (int m = 0; m < 4; ++m)
#pragma unroll
                    for (int n = 0; n < 2; ++n) acc[a][b][m][n] = (f32x4){0.f, 0.f, 0.f, 0.f};
        cur = nxt; cB = nB; aC = aN; ++ui;
    }
    GE_WAIT_V(0);
    if (wr == 0) GE_BAR;
    GE_BAR;
}
#define GE_VALS(v, acc, ai, m) do { _Pragma("unroll") for (int _b = 0; _b < 2; ++_b) _Pragma("unroll") for (int _n = 0; _n < 2; ++_n) _Pragma("unroll") for (int _j = 0; _j < 4; ++_j) (v)[8 * _b + 4 * _n + _j] = (acc)[ai][_b][m][_n][_j]; } while (0)
}
__device__ __forceinline__ void store16_bf16(bf16_t* dst, const float (&v)[16]) {
    unsigned w[8];
#pragma unroll
    for (int i = 0; i < 8; ++i) w[i] = pk2g(v[2 * i], v[2 * i + 1]);
    uint4* d4 = (uint4*)dst; d4[0] = make_uint4(w[0], w[1], w[2], w[3]); d4[1] = make_uint4(w[4], w[5], w[6], w[7]);
}
template <bool IN_BF16>
struct EpiResid { const void* xin; const float* mod_g; bf16_t* xout; float inscale;
    __device__ __forceinline__ void operator()(const f32x4 (&acc)[2][2][4][2], const ge::Unit& u, int wr, int wc, int fr, int fq) const {
        const int col0 = (4 * u.pn + wc) * 64 + 16 * fq; const int b = (u.pm * 256) / S;
        float4 gq[4];
#pragma unroll
        for (int q4 = 0; q4 < 4; ++q4) { gq[q4] = *(const float4*)(mod_g + b * 6144 + col0 + 4 * q4); gq[q4].x *= inscale; gq[q4].y *= inscale; gq[q4].z *= inscale; gq[q4].w *= inscale; }
        if constexpr (IN_BF16) {
            uint4 xh[2][4][2];
#pragma unroll
            for (int ai = 0; ai < 2; ++ai)
#pragma unroll
                for (int m = 0; m < 4; ++m) { const size_t o = (size_t)(u.pm * 256 + ai * 128 + wr * 64 + m * 16 + fr) * D + col0; xh[ai][m][0] = *(const uint4*)((const bf16_t*)xin + o); xh[ai][m][1] = *(const uint4*)((const bf16_t*)xin + o + 8); }
            const float g16[16] = {gq[0].x, gq[0].y, gq[0].z, gq[0].w, gq[1].x, gq[1].y, gq[1].z, gq[1].w, gq[2].x, gq[2].y, gq[2].z, gq[2].w, gq[3].x, gq[3].y, gq[3].z, gq[3].w};
#pragma unroll
            for (int ai = 0; ai < 2; ++ai)
#pragma unroll
                for (int m = 0; m < 4; ++m) { float v[16]; GE_VALS(v, acc, ai, m);
                    const unsigned w8[8] = {xh[ai][m][0].x, xh[ai][m][0].y, xh[ai][m][0].z, xh[ai][m][0].w, xh[ai][m][1].x, xh[ai][m][1].y, xh[ai][m][1].z, xh[ai][m][1].w};
#pragma unroll
                    for (int k = 0; k < 8; ++k) { v[2 * k] = __uint_as_float(w8[k] << 16) + g16[2 * k] * v[2 * k]; v[2 * k + 1] = __uint_as_float(w8[k] & 0xFFFF0000u) + g16[2 * k + 1] * v[2 * k + 1]; }
                    store16_bf16(xout + (size_t)(u.pm * 256 + ai * 128 + wr * 64 + m * 16 + fr) * D + col0, v); }
        } else {
#pragma unroll
        for (int ai = 0; ai < 2; ++ai) { float4 xv[4][4];
#pragma unroll
            for (int m = 0; m < 4; ++m) { const size_t o = (size_t)(u.pm * 256 + ai * 128 + wr * 64 + m * 16 + fr) * D + col0;
#pragma unroll
                for (int q4 = 0; q4 < 4; ++q4) xv[m][q4] = *(const float4*)((const float*)xin + o + 4 * q4); }
#pragma unroll
            for (int m = 0; m < 4; ++m) { float v[16]; GE_VALS(v, acc, ai, m); float xr[16];
#pragma unroll
                for (int q4 = 0; q4 < 4; ++q4) { xr[4 * q4] = xv[m][q4].x; xr[4 * q4 + 1] = xv[m][q4].y; xr[4 * q4 + 2] = xv[m][q4].z; xr[4 * q4 + 3] = xv[m][q4].w; }
                const float g16[16] = {gq[0].x, gq[0].y, gq[0].z, gq[0].w, gq[1].x, gq[1].y, gq[1].z, gq[1].w, gq[2].x, gq[2].y, gq[2].z, gq[2].w, gq[3].x, gq[3].y, gq[3].z, gq[3].w};
#pragma unroll
                for (int k = 0; k < 16; ++k) v[k] = xr[k] + g16[k] * v[k];
                store16_bf16(xout + (size_t)(u.pm * 256 + ai * 128 + wr * 64 + m * 16 + fr) * D + col0, v); } }
        }
    } };
struct EpiNsaIn { const float* q_gain; const float* k_gain; const float* rope; bf16_t* q; bf16_t* kv; float* gates; float inscale;
    __device__ __forceinline__ void operator()(const f32x4 (&acc)[2][2][4][2], const ge::Unit& u, int wr, int wc, int fr, int fq) const {
        const int slot = 4 * u.pn + wc; if (slot > 28) return;
        const bool normed = (slot < 16) || slot == 20 || slot == 21 || slot == 24 || slot == 25;
        const float* gain = (slot < 16) ? q_gain : ((slot < 22) ? k_gain + 64 : k_gain + 128);
        float gv[16];
        if (normed) {
#pragma unroll
            for (int i = 0; i < 16; ++i) gv[i] = gain[16 * fq + i]; }
#pragma unroll
        for (int ai = 0; ai < 2; ++ai)
#pragma unroll
            for (int m = 0; m < 4; ++m) { const int row = u.pm * 256 + ai * 128 + wr * 64 + m * 16 + fr; const int b = row / S, s = row % S; float v[16]; GE_VALS(v, acc, ai, m);
#pragma unroll
                for (int i = 0; i < 16; ++i) v[i] *= inscale;
                if (slot == 28) { if (fq < 3) { float* gp = gates + (size_t)row * 48 + 16 * fq;
#pragma unroll
                        for (int q4 = 0; q4 < 4; ++q4) *(float4*)(gp + 4 * q4) = make_float4(fsigmoid(v[4 * q4]), fsigmoid(v[4 * q4 + 1]), fsigmoid(v[4 * q4 + 2]), fsigmoid(v[4 * q4 + 3])); }
                    continue; }
                if (normed) { float ss = 0.f;
#pragma unroll
                    for (int i = 0; i < 16; ++i) ss += v[i] * v[i];
                    ss = sum16(ss); ss = sum32(ss); const float r = rsqrtf(ss * (1.f / 64.f) + 1e-6f);
#pragma unroll
                    for (int i = 0; i < 16; ++i) v[i] *= r * gv[i];
                    if (fq == 0) { const float sf = (float)s;
                        constexpr float IFR[8] = {0.15915494309189535f, 0.030863763158420102f, 0.00598518567638293f, 0.001160663620968869f, 0.00022507907904105153f, 4.364795481173399e-05f, 8.464330549652592e-06f, 1.6414262419538367e-06f};
#pragma unroll
                        for (int i = 0; i < 8; ++i) { const float rev = __builtin_amdgcn_fractf(sf * IFR[i]); const float cs = __builtin_amdgcn_cosf(rev), sn = __builtin_amdgcn_sinf(rev), a = v[i], bb = v[i + 8]; v[i] = a * cs - bb * sn; v[i + 8] = bb * cs + a * sn; } } }
                bf16_t* dst;
                if (slot < 16) dst = q + (size_t)row * D + slot * 64 + 16 * fq;
                else { const int kk = slot - 16, ten = kk >> 1, g = kk & 1; dst = kv + (size_t)ten * T * 128 + ((size_t)(b * 2 + g) * S + s) * 64 + 16 * fq; }
                store16_bf16(dst, v); }
    } };
struct EpiMlIn { bf16_t* proj; float inscale;
    __device__ __forceinline__ void operator()(const f32x4 (&acc)[2][2][4][2], const ge::Unit& u, int wr, int wc, int fr, int fq) const {
        const int slot = 4 * u.pn + wc; const int L0 = slot * 64 + 16 * fq;
#pragma unroll
        for (int ai = 0; ai < 2; ++ai)
#pragma unroll
            for (int m = 0; m < 4; ++m) { const int row = u.pm * 256 + ai * 128 + wr * 64 + m * 16 + fr; float v[16]; GE_VALS(v, acc, ai, m);
                { const float sc = (slot >= 8 && slot < 16) ? 0.08838834764831845f * inscale : inscale;
#pragma unroll
                    for (int i = 0; i < 16; ++i) v[i] *= sc; }
                if (slot >= 32) {
#pragma unroll
                    for (int i = 0; i < 16; ++i) v[i] = fsigmoid(v[i]); }
                store16_bf16(proj + (size_t)row * 3072 + L0, v); }
    } };
struct OneUnit { int pm; __device__ bool next(int i, ge::Unit& u) const { if (i) return false; u.pm = pm; u.pn = 0; u.bt = 0; u.aux = 0; return true; } };
struct EpiCmpPart { float* part;
    __device__ __forceinline__ void operator()(const f32x4 (&acc)[2][2][4][2], const ge::Unit& u, int wr, int wc, int fr, int fq) const {
        const int L0 = (4 * u.pn + wc) * 64 + 16 * fq;
#pragma unroll
        for (int ai = 0; ai < 2; ++ai)
#pragma unroll
            for (int m = 0; m < 4; ++m) { const int row = u.pm * 256 + ai * 128 + wr * 64 + m * 16 + fr; float v[16]; GE_VALS(v, acc, ai, m); float* op = part + (size_t)row * 256 + L0;
#pragma unroll
                for (int q4 = 0; q4 < 4; ++q4) *(float4*)(op + 4 * q4) = make_float4(v[4 * q4], v[4 * q4 + 1], v[4 * q4 + 2], v[4 * q4 + 3]); }
    } };
struct EpiCmp1 { const float* cb1; bf16_t* hid;
    __device__ __forceinline__ void operator()(const f32x4 (&acc)[2][2][4][2], const ge::Unit& u, int wr, int wc, int fr, int fq) const {
        const int L0 = (4 * u.pn + wc) * 64 + 16 * fq; float bv[16];
#pragma unroll
        for (int i = 0; i < 16; ++i) bv[i] = cb1[L0 + i];
#pragma unroll
        for (int ai = 0; ai < 2; ++ai)
#pragma unroll
            for (int m = 0; m < 4; ++m) { const int row = u.pm * 256 + ai * 128 + wr * 64 + m * 16 + fr; float v[16]; GE_VALS(v, acc, ai, m);
#pragma unroll
                for (int i = 0; i < 16; ++i) { const float x = v[i] + bv[i]; v[i] = 0.5f * x * (1.f + ftanh(0.7978845608028654f * (x + 0.044715f * x * x * x))); }
                store16_bf16(hid + (size_t)row * 256 + L0, v); }
    } };

#define PARAM_LIST(X) \
    X(const float*, x) X(const float*, c) X(const float*, ada_w) X(const float*, ada_b) X(const float*, g_mix) X(const float*, g_ffn) X(const float*, nsa_w_in) X(const float*, nsa_w_out) \
    X(const float*, q_gain) X(const float*, k_gain) X(const float*, cmp_pe) X(const float*, cmp_w1) X(const float*, cmp_b1) X(const float*, cmp_w2) X(const float*, cmp_b2) \
    X(const float*, ml_w_in) X(const float*, ml_bi) X(const float*, ml_bf) X(const float*, ml_ng) X(const float*, ml_w_out) X(const float*, router_w) X(const float*, router_b) \
    X(const float*, w_gate) X(const float*, w_up) X(const float*, w_down) \
    X(float*, out) X(unsigned*, bar) X(int*, cnt) X(float*, mod) X(float*, rope) X(float*, cb1) X(float*, tokw) X(int*, list) X(float*, li) X(float*, lf) \
    X(bf16_t*, h) X(bf16_t*, hidc) X(bf16_t*, xb13) X(bf16_t*, xb2) X(bf16_t*, wo_nsa_t) X(bf16_t*, wo_ml_t) X(bf16_t*, win_nsa_t) X(bf16_t*, win_ml_t) X(bf16_t*, w1c_t) X(bf16_t*, gu_t) X(bf16_t*, dn_t) \
    X(bf16_t*, q) X(bf16_t*, kv) X(float*, gates) X(bf16_t*, kcmp) X(bf16_t*, vcmp) X(bf16_t*, proj) X(bf16_t*, hid) X(bf16_t*, outk) X(int*, dcnt) X(int*, dlist) X(float*, cpart)
struct Params {
#define X(t, n) t n;
    PARAM_LIST(X)
#undef X
};
template <class Tp> __device__ __forceinline__ Tp* uni_ptr(Tp* v) { const unsigned long long u = (unsigned long long)v; const unsigned lo = __builtin_amdgcn_readfirstlane((unsigned)u), hi = __builtin_amdgcn_readfirstlane((unsigned)(u >> 32)); typedef Tp __attribute__((address_space(1))) * GP; return (Tp*)(GP)(((unsigned long long)hi << 32) | lo); }
#define LP(n) q.n = uni_ptr(P->n)
struct Frame { LAS unsigned char* lds; int tid, lane, wave, bid, G; };
__device__ __forceinline__ int lane_id_asm() { int l; asm volatile("v_mbcnt_lo_u32_b32 %0, -1, 0\n\tv_mbcnt_hi_u32_b32 %0, -1, %0" : "=v"(l)); return l; }
__device__ __forceinline__ Frame launder(const Frame& F) { Frame R = F; const int l = lane_id_asm(); int wv = F.wave, bd = F.bid; asm volatile("" : "+s"(wv), "+s"(bd)); R.wave = wv; R.bid = bd; R.tid = wv * 64 + l; R.lane = l; return R; }
constexpr int LDS_GEN = 143872;
constexpr int LDS_MISC = LDS_GEN;
constexpr int LDS_PARAMS = LDS_GEN + 4096;
constexpr int LDS_CONST = LDS_GEN + 6144;
constexpr int LDS_BYTES = LDS_GEN + 18432;

__device__ __forceinline__ unsigned pk4_fp8(float a, float b, float c, float d) { int w = 0;
    w = __builtin_amdgcn_cvt_pk_fp8_f32(__builtin_amdgcn_fmed3f(a, -448.f, 448.f), __builtin_amdgcn_fmed3f(b, -448.f, 448.f), w, false);
    w = __builtin_amdgcn_cvt_pk_fp8_f32(__builtin_amdgcn_fmed3f(c, -448.f, 448.f), __builtin_amdgcn_fmed3f(d, -448.f, 448.f), w, true); return (unsigned)w; }
constexpr float F8_SA = 8.f, F8_SW = 32.f, F8_SH = 4.f, F8_SW2 = 32.f;
template <int NB>
__device__ __forceinline__ void colgemv(const Frame& F, const LAS float* vec, LAS float* part, const float* W, int ldw, int K, int n0, const float* bias, float* out, int out_stride) {
    const int kper = K / 8, kb = F.wave * kper, c4 = F.lane & 15, kq = F.lane >> 4; float acc[NB][4];
#pragma unroll
    for (int b = 0; b < NB; ++b)
#pragma unroll
        for (int j = 0; j < 4; ++j) acc[b][j] = 0.f;
    const float* wp = W + (size_t)(kb + kq) * ldw + n0 + 4 * c4;
#pragma unroll 4
    for (int k = 0; k < kper; k += 4) { const float4 wv = *(const float4*)(wp + (size_t)k * ldw);
#pragma unroll
        for (int b = 0; b < NB; ++b) { const float x = vec[(kb + k + kq) * NB + b]; acc[b][0] += x * wv.x; acc[b][1] += x * wv.y; acc[b][2] += x * wv.z; acc[b][3] += x * wv.w; } }
#pragma unroll
    for (int b = 0; b < NB; ++b)
#pragma unroll
        for (int j = 0; j < 4; ++j) { const float t = sum32(sum16(acc[b][j])); if (kq == 0) part[(F.wave * NB + b) * 64 + 4 * c4 + j] = t; }
    __syncthreads();
    for (int idx = F.tid; idx < NB * 64; idx += NTHR) { const int b = idx >> 6, l = idx & 63; float s = bias[n0 + l];
#pragma unroll
        for (int w = 0; w < 8; ++w) s += part[(w * NB + b) * 64 + l];
        out[(size_t)b * out_stride + n0 + l] = s; }
    __syncthreads();
}
struct ColPlain { const float* W; int ncols; int pad; __device__ const float* operator()(int c) const { const int L = ge::logical_col(c); return L < ncols ? W + L : nullptr; } };
struct ColGateUp { const float* wg; const float* wu; __device__ const float* operator()(int c) const { const int e = c >> 10, cc = c & 1023; const int pn = cc >> 8, bj = (cc >> 7) & 1, wc = (cc >> 5) & 3, n = (cc >> 4) & 1, fq = (cc >> 2) & 3, j = cc & 3;
        const int hidx = 32 * (4 * pn + wc) + 8 * fq + 4 * n + j; const unsigned long long a = (unsigned long long)wg, d = (unsigned long long)wu - a;
        return (const float*)(a + (bj ? d : 0ull)) + (size_t)e * D * DE + hidx; } };
struct ColDown { const float* wd; __device__ const float* operator()(int c) const { const int e = c >> 10; return wd + (size_t)e * DE * D + ge::logical_col(c & 1023); } };
template <bool F8 = false, class ColF>
__device__ __forceinline__ void prep_weights(const Frame& F, void* Bt_, int N, int K, int ldw, const ColF cf, int start, int stride, const float wscale = 1.f) {
    bf16_t* Bt = (bf16_t*)Bt_;
    LAS float* tile = (LAS float*)(F.lds) + (F.tid >> 8) * (128 * 65);
    const int ntx = N / 64, ntiles = ntx * (K / 128), htid = F.tid & 255, half = F.tid >> 8;
    float r[32];
#define PW_LOAD(it_) do { const int tl_ = (it_) * 2 + half; if (tl_ < ntiles) { const int c0_ = (tl_ % ntx) * 64, k0_ = (tl_ / ntx) * 128; const float* p_ = cf(c0_ + (htid & 63)); \
        if (p_) { p_ += (size_t)(k0_ + (htid >> 6)) * ldw; _Pragma("unroll") for (int i_ = 0; i_ < 32; ++i_) r[i_] = p_[(size_t)(4 * i_) * ldw]; } \
        else { _Pragma("unroll") for (int i_ = 0; i_ < 32; ++i_) r[i_] = 0.f; } } } while (0)
    int it = start;
    if (it * 2 < ntiles) PW_LOAD(it);
    for (; it * 2 < ntiles; it += stride) {
        const int tl = it * 2 + half; const bool act = tl < ntiles; const int c0 = (tl % ntx) * 64, k0 = (tl / ntx) * 128;
        if (act) { const int cc = htid & 63;
#pragma unroll
            for (int i = 0; i < 32; ++i) tile[((htid >> 6) + 4 * i) * 65 + cc] = r[i]; }
        __syncthreads();
        if ((it + stride) * 2 < ntiles) PW_LOAD(it + stride);
        if (act) { const int cc = htid >> 2, ch = (htid & 3) * 32;
            if (F8) { unsigned w[8];
#pragma unroll
                for (int i = 0; i < 8; ++i) w[i] = pk4_fp8(tile[(ch + 4 * i) * 65 + cc] * wscale, tile[(ch + 4 * i + 1) * 65 + cc] * wscale, tile[(ch + 4 * i + 2) * 65 + cc] * wscale, tile[(ch + 4 * i + 3) * 65 + cc] * wscale);
                uint4* dst = (uint4*)((unsigned char*)Bt_ + (size_t)(c0 + cc) * K + k0 + ch); dst[0] = make_uint4(w[0], w[1], w[2], w[3]); dst[1] = make_uint4(w[4], w[5], w[6], w[7]); }
            else { unsigned w[16];
#pragma unroll
                for (int i = 0; i < 16; ++i) w[i] = pk2g(tile[(ch + 2 * i) * 65 + cc], tile[(ch + 2 * i + 1) * 65 + cc]);
                uint4* dst = (uint4*)(Bt + (size_t)(c0 + cc) * K + k0 + ch);
#pragma unroll
                for (int q4 = 0; q4 < 4; ++q4) dst[q4] = make_uint4(w[4 * q4], w[4 * q4 + 1], w[4 * q4 + 2], w[4 * q4 + 3]); } }
        __syncthreads();
    }
#undef PW_LOAD
}
__device__ __forceinline__ void prep_moe_weights(const Params& p, const Frame& F, int layer, int start, int stride) {
    const size_t wo = (size_t)layer * NE * D * DE;
    prep_weights<true>(F, p.gu_t, NE * 1024, D, DE, ColGateUp{p.w_gate + wo, p.w_up + wo}, start, stride, F8_SW);
    prep_weights<true>(F, p.dn_t, NE * 1024, DE, D, ColDown{p.w_down + wo}, start, stride, F8_SW2);
}

__device__ __forceinline__ void phase_prologue_a(const Params& p, const Frame& F) {
    for (int i = (F.bid - 200) * NTHR + F.tid; F.bid >= 200 && i < 2048 * 8; i += (F.G - 200) * NTHR) { const int pos = i >> 3, j = i & 7; const float inv = (float)pow(500000.0, -(double)j / 8.0); const float ang = (float)pos * inv;
        p.rope[pos * 16 + j] = (float)cos((double)ang); p.rope[pos * 16 + 8 + j] = (float)sin((double)ang); }
    if (F.bid == F.G - 1) for (int i = F.tid; i < 8 * D / 2; i += NTHR) ((unsigned*)(p.h + (size_t)T * D))[i] = 0u;
}
__device__ __forceinline__ void phase_prologue_b(const Params& p, const Frame& F) {
    LAS float* vec = (LAS float*)F.lds; LAS float* part = (LAS float*)(F.lds + 65536 + 16384);
    if (F.bid < 192) {
        for (int idx = F.tid; idx < 16 * D; idx += NTHR) { const int b = idx >> 10, k = idx & 1023; const float cv = p.c[idx]; vec[k * 16 + b] = cv / (1.f + expf(-cv)); }
        __syncthreads();
        const int i = F.bid / 96, n0 = (F.bid % 96) * 64;
        colgemv<16>(F, vec, part, p.ada_w + (size_t)i * D * 6144, 6144, D, n0, p.ada_b + i * 6144, p.mod + (size_t)i * 16 * 6144, 6144);
    } else if (F.bid < 200) {
        const int it = F.bid - 192, w = it >> 2, n0 = (it & 3) * 64;
        for (int idx = F.tid; idx < 2048; idx += NTHR) vec[idx] = p.cmp_pe[w * 2048 + idx];
        __syncthreads();
        colgemv<1>(F, vec, part, p.cmp_w1 + (size_t)w * 2048 * 256, 256, 2048, n0, p.cmp_b1 + w * 256, p.cb1 + w * 256, 0);
    }
    __syncthreads();
}

template <int MODE, bool XBF>
__device__ __forceinline__ void phase_norm(const Params& p, const Frame& F, const void* xin_, bf16_t* xout, const float* gain, const float* mod_sh, const float* mod_sc, const float* mod_gprev, int layer) {
    constexpr int rows_per_wg = T / NWG, rpw = rows_per_wg / 8;
    constexpr int TP = (MODE == 1) ? 34 : 10;
    const int row0 = F.bid * rows_per_wg;
    LAS float* rw = (LAS float*)F.lds;
    LAS int* lcnt = (LAS int*)(F.lds + LDS_MISC + 64); LAS int* gbase = lcnt + 32; LAS int* ent = gbase + 32;
    if (MODE == 1) { for (int idx = F.tid; idx < D * NE; idx += NTHR) { const int c = idx >> 5; rw[((c & 3) * 256 + (c >> 2)) * TP + (idx & 31)] = p.router_w[idx]; } if (F.tid < 32) lcnt[F.tid] = 0; }
    if (MODE == 2) { for (int idx = F.tid; idx < D * 8; idx += NTHR) { const int c = idx >> 3; rw[((c & 3) * 256 + (c >> 2)) * TP + (idx & 7)] = p.ml_w_in[(size_t)c * ML_COLS + 3072 + (idx & 7)]; } }
    const int b = row0 / S;
    LAS float* cg = (LAS float*)(F.lds + LDS_CONST); LAS float* csh = cg + D; LAS float* cgp = csh + D;
    for (int col = F.tid; col < D; col += NTHR) { cg[col] = gain[col] * (1.f + mod_sc[b * 6144 + col]); csh[col] = mod_sh[b * 6144 + col]; if (MODE == 2) cgp[col] = mod_gprev[b * 6144 + col]; }
    __syncthreads();
    const int rbase = row0 + F.wave * rpw;
    float4 xn[4]; uint2 on0[4], on1[4];
#define NORM_LOAD(r_) do { if (XBF) { const bf16_t* xr_ = (const bf16_t*)xin_ + (size_t)(r_) * D + 4 * F.lane; _Pragma("unroll") for (int j_ = 0; j_ < 4; ++j_) { const uint2 t_ = *(const uint2*)(xr_ + 256 * j_); \
            xn[j_] = make_float4(__uint_as_float(t_.x << 16), __uint_as_float(t_.x & 0xFFFF0000u), __uint_as_float(t_.y << 16), __uint_as_float(t_.y & 0xFFFF0000u)); } } \
        else { const float* xr_ = (const float*)xin_ + (size_t)(r_) * D + 4 * F.lane; _Pragma("unroll") for (int j_ = 0; j_ < 4; ++j_) xn[j_] = *(const float4*)(xr_ + 256 * j_); } \
        if (MODE == 2) { const bf16_t* o0_ = p.outk + (size_t)(r_) * D + 4 * F.lane; _Pragma("unroll") for (int j_ = 0; j_ < 4; ++j_) { on0[j_] = *(const uint2*)(o0_ + 256 * j_); on1[j_] = *(const uint2*)(o0_ + (size_t)T * D + 256 * j_); } } } while (0)
    NORM_LOAD(rbase);
#pragma unroll 1
    for (int ri = 0; ri < rpw; ++ri) {
        const int row = rbase + ri; float v[16];
#pragma unroll
        for (int j = 0; j < 4; ++j) { v[4 * j] = xn[j].x; v[4 * j + 1] = xn[j].y; v[4 * j + 2] = xn[j].z; v[4 * j + 3] = xn[j].w; }
        if (MODE == 2) {
#pragma unroll
            for (int j = 0; j < 4; ++j) { const f32x4 gq = *(const LAS f32x4*)(cgp + 4 * F.lane + 256 * j);
                v[4 * j] += gq[0] * (__uint_as_float(on0[j].x << 16) + __uint_as_float(on1[j].x << 16)); v[4 * j + 1] += gq[1] * (__uint_as_float(on0[j].x & 0xFFFF0000u) + __uint_as_float(on1[j].x & 0xFFFF0000u));
                v[4 * j + 2] += gq[2] * (__uint_as_float(on0[j].y << 16) + __uint_as_float(on1[j].y << 16)); v[4 * j + 3] += gq[3] * (__uint_as_float(on0[j].y & 0xFFFF0000u) + __uint_as_float(on1[j].y & 0xFFFF0000u));
                uint2 xo_; xo_.x = pk2g(v[4 * j], v[4 * j + 1]); xo_.y = pk2g(v[4 * j + 2], v[4 * j + 3]); *(uint2*)(xout + (size_t)row * D + 4 * F.lane + 256 * j) = xo_; } }
        if (ri + 1 < rpw) NORM_LOAD(row + 1);
        float ss = 0.f;
#pragma unroll
        for (int i = 0; i < 16; ++i) ss += v[i] * v[i];
        ss = wave_sum(ss); const float r = rsqrtf(ss * (1.f / D) + 1e-6f);
#pragma unroll
        for (int j = 0; j < 4; ++j) { const f32x4 g4 = *(const LAS f32x4*)(cg + 4 * F.lane + 256 * j), s4 = *(const LAS f32x4*)(csh + 4 * F.lane + 256 * j);
#pragma unroll
            for (int e = 0; e < 4; ++e) v[4 * j + e] = v[4 * j + e] * r * g4[e] + s4[e];
            if (MODE == 2 || MODE == 0) *(unsigned*)((unsigned char*)p.h + (size_t)row * D + 4 * F.lane + 256 * j) = pk4_fp8(v[4 * j] * F8_SA, v[4 * j + 1] * F8_SA, v[4 * j + 2] * F8_SA, v[4 * j + 3] * F8_SA);
            else { uint2 pk; pk.x = pk2g(v[4 * j], v[4 * j + 1]); pk.y = pk2g(v[4 * j + 2], v[4 * j + 3]); *(uint2*)(p.h + (size_t)row * D + 4 * F.lane + 256 * j) = pk; } }
        if (MODE == 2) { float a8[8];
#pragma unroll
            for (int j = 0; j < 8; ++j) a8[j] = 0.f;
#pragma unroll
            for (int j = 0; j < 4; ++j)
#pragma unroll
                for (int e = 0; e < 4; ++e) { const LAS float* wr_ = rw + (e * 256 + 64 * j + F.lane) * TP; const float hv = v[4 * j + e];
#pragma unroll
                    for (int q2 = 0; q2 < 4; ++q2) { const f32x2_t w2 = *(const LAS f32x2_t*)(wr_ + 2 * q2); a8[2 * q2] += hv * w2[0]; a8[2 * q2 + 1] += hv * w2[1]; } }
#pragma unroll
            for (int j = 0; j < 8; ++j) a8[j] = wave_sum(a8[j]);
            if (F.lane < 8) { float a = 0.f;
#pragma unroll
                for (int j = 0; j < 8; ++j) a = (F.lane == j) ? a8[j] : a;
                if (F.lane < 4) { a += p.ml_bi[F.lane]; p.li[row * 4 + F.lane] = 15.f * tanhf(a / 15.f); }
                else { a += p.ml_bf[F.lane - 4]; const float cc = 15.f * tanhf(a / 15.f); p.lf[row * 4 + F.lane - 4] = (cc >= 0.f) ? -log1pf(expf(-cc)) : (cc - log1pf(expf(cc))); } } }
        if (MODE == 1) { float acc[32];
#pragma unroll
            for (int e = 0; e < 32; ++e) acc[e] = 0.f;
#pragma unroll
            for (int j = 0; j < 4; ++j)
#pragma unroll
                for (int e = 0; e < 4; ++e) { const LAS float* wr_ = rw + (e * 256 + 64 * j + F.lane) * TP; const float hv = v[4 * j + e]; asm volatile("" ::: "memory");
#pragma unroll
                    for (int q2 = 0; q2 < 16; ++q2) { const f32x2_t w2 = *(const LAS f32x2_t*)(wr_ + 2 * q2); acc[2 * q2] += hv * w2[0]; acc[2 * q2 + 1] += hv * w2[1]; } }
            float r16[16], r8[8], r4[4], r2[2], r1;
            { const bool hi = (F.lane & 32) != 0;
#pragma unroll
              for (int i = 0; i < 16; ++i) { const float keep = hi ? acc[16 + i] : acc[i], send = hi ? acc[i] : acc[16 + i]; r16[i] = keep + other32(send, hi); } }
            { const bool hi = (F.lane & 16) != 0;
#pragma unroll
              for (int i = 0; i < 8; ++i) { const float keep = hi ? r16[8 + i] : r16[i], send = hi ? r16[i] : r16[8 + i]; r8[i] = keep + sx<16>(send); } }
            { const bool hi = (F.lane & 8) != 0;
#pragma unroll
              for (int i = 0; i < 4; ++i) { const float keep = hi ? r8[4 + i] : r8[i], send = hi ? r8[i] : r8[4 + i]; r4[i] = keep + sx<8>(send); } }
            { const bool hi = (F.lane & 4) != 0;
#pragma unroll
              for (int i = 0; i < 2; ++i) { const float keep = hi ? r4[2 + i] : r4[i], send = hi ? r4[i] : r4[2 + i]; r2[i] = keep + sx<4>(send); } }
            { const bool hi = (F.lane & 2) != 0; const float keep = hi ? r2[1] : r2[0], send = hi ? r2[0] : r2[1]; r1 = keep + sx<2>(send); }
            r1 += sx<1>(r1);
            const float aff = sigmoidf_(r1); const float ch = aff + p.router_b[F.lane >> 1];
            float bestgs = -3e38f; int be0 = 0, be1 = 0; float ba0 = 0.f, ba1 = 0.f;
#pragma unroll
            for (int g = 0; g < 4; ++g) { float v1 = -3e38f, v2 = -3e38f, a1 = 0.f, a2 = 0.f; int i1 = 0, i2 = 0;
#pragma unroll
                for (int i = 0; i < 8; ++i) { const float a = rdlane(aff, 2 * (g * 8 + i)), c_ = rdlane(ch, 2 * (g * 8 + i));
                    if (c_ > v1) { v2 = v1; a2 = a1; i2 = i1; v1 = c_; a1 = a; i1 = i; } else if (c_ > v2) { v2 = c_; a2 = a; i2 = i; } }
                const float gs = v1 + v2; if (gs > bestgs) { bestgs = gs; be0 = g * 8 + i1; be1 = g * 8 + i2; ba0 = a1; ba1 = a2; } }
            if (F.lane == 0) { const float sum = ba0 + ba1; p.tokw[row * 2] = ba0 / sum; p.tokw[row * 2 + 1] = ba1 / sum;
                const int lr = row - row0; const int r0_ = atomicAdd((int*)&lcnt[be0], 1); const int r1_ = atomicAdd((int*)&lcnt[be1], 1);
                ent[lr * 4 + 0] = be0 | (r0_ << 8); ent[lr * 4 + 1] = row * 2; ent[lr * 4 + 2] = be1 | (r1_ << 8); ent[lr * 4 + 3] = row * 2 + 1; } }
    }
#undef NORM_LOAD
    if (MODE == 1) { __syncthreads();
        if (F.tid < 32) gbase[F.tid] = atomicAdd(&p.cnt[layer * 64 + F.tid], lcnt[F.tid]);
        __syncthreads();
        for (int idx = F.tid; idx < rows_per_wg * 2; idx += NTHR) { const int er = ent[idx * 2], tk = ent[idx * 2 + 1]; const int e = er & 255, rk = er >> 8; p.list[(size_t)e * T + gbase[e] + rk] = tk; }
        __syncthreads(); }
}

__device__ __forceinline__ void phase_norm_route(const Params& p, const Frame& F, const bf16_t* xin, const float* gain, const float* mod_sh, const float* mod_sc, int layer) {
    constexpr int rows_per_wg = T / NWG;
    const int row0 = F.bid * rows_per_wg, b = row0 / S, lane = F.lane, i16 = lane & 15, g = lane >> 4;
    LAS float* rwl = (LAS float*)F.lds;
    LAS float* cg = (LAS float*)(F.lds + LDS_CONST); LAS float* csh = cg + D; LAS float* bias = csh + D; LAS float* bpart = bias + 32;
    LAS int* lcnt = (LAS int*)(F.lds + LDS_MISC + 64); LAS int* gbase = lcnt + 32; LAS int* ent = gbase + 32;
    for (int i4 = F.tid; i4 < D * NE / 4; i4 += NTHR) { const int k = i4 >> 3, e = (i4 & 7) * 4; const float4 w4 = *(const float4*)(p.router_w + 4 * i4); *(LAS f32x4*)(rwl + k * 32 + ((e + 16 * ((k >> 2) & 1)) & 31)) = (f32x4){w4.x, w4.y, w4.z, w4.w}; }
    for (int col = F.tid; col < D; col += NTHR) { cg[col] = gain[col] * (1.f + mod_sc[b * 6144 + col]); csh[col] = mod_sh[b * 6144 + col]; }
    if (F.tid < 32) lcnt[F.tid] = 0;
    __syncthreads();
    { const int e = F.tid & 31, part = F.tid >> 5; float a = 0.f;
#pragma unroll 8
      for (int k = part * 64; k < part * 64 + 64; ++k) a += csh[k] * rwl[k * 32 + ((e + 16 * ((k >> 2) & 1)) & 31)];
      bpart[part * 32 + e] = a; }
    __syncthreads();
    if (F.tid < 32) { float a = 0.f;
#pragma unroll
        for (int q = 0; q < 16; ++q) a += bpart[q * 32 + F.tid];
        bias[F.tid] = a; }
    const int rbase = row0 + F.wave * 16;
    const bf16_t* xr = xin + (size_t)(rbase + i16) * D + 4 * g;
    const int rot = 16 * (g & 1);
    const LAS float* b0p = rwl + (4 * g) * 32 + ((i16 + rot) & 31); const LAS float* b1p = rwl + (4 * g) * 32 + ((i16 + 16 + rot) & 31); const LAS float* cgp_ = cg + 4 * g;
    f32x4 acc0 = (f32x4){0.f, 0.f, 0.f, 0.f}, acc1 = (f32x4){0.f, 0.f, 0.f, 0.f}; float ss = 0.f;
    uint2 xa[2][16];
#define RT_LOAD(s_, q_) do { _Pragma("unroll") for (int u_ = 0; u_ < 16; ++u_) xa[s_][u_] = *(const uint2*)(xr + 16 * (16 * (q_) + u_)); } while (0)
    RT_LOAD(0, 0);
#pragma unroll
    for (int qd = 0; qd < 4; ++qd) {
        if (qd + 1 < 4) RT_LOAD((qd + 1) & 1, qd + 1);
#pragma unroll
        for (int u = 0; u < 16; ++u) { const int so = (16 * qd + u) * 16; const f32x4 c4 = *(const LAS f32x4*)(cgp_ + so); const uint2 xc = xa[qd & 1][u]; const float xe[4] = {__uint_as_float(xc.x << 16), __uint_as_float(xc.x & 0xFFFF0000u), __uint_as_float(xc.y << 16), __uint_as_float(xc.y & 0xFFFF0000u)};
#pragma unroll
            for (int e = 0; e < 4; ++e) { const float zz = xe[e] * c4[e]; ss += xe[e] * xe[e];
                acc0 = __builtin_amdgcn_mfma_f32_16x16x4f32(zz, b0p[(so + e) * 32], acc0, 0, 0, 0); acc1 = __builtin_amdgcn_mfma_f32_16x16x4f32(zz, b1p[(so + e) * 32], acc1, 0, 0, 0); } }
    }
#undef RT_LOAD
    ss = sum16(ss); ss = sum32(ss); const float r = rsqrtf(ss * (1.f / D) + 1e-6f);
    float af0[4], af1[4];
#pragma unroll
    for (int rr = 0; rr < 4; ++rr) { const float rrow = __int_as_float(__builtin_amdgcn_ds_bpermute((4 * g + rr) * 4, __float_as_int(r)));
        af0[rr] = sigmoidf_(rrow * acc0[rr] + bias[i16]); af1[rr] = sigmoidf_(rrow * acc1[rr] + bias[16 + i16]); }
    __syncthreads();
    LAS float* affl = (LAS float*)F.lds + F.wave * 512;
#pragma unroll
    for (int rr = 0; rr < 4; ++rr) { affl[(4 * g + rr) * 32 + i16] = af0[rr]; affl[(4 * g + rr) * 32 + 16 + i16] = af1[rr]; }
    asm volatile("s_waitcnt lgkmcnt(0)" ::: "memory");
    if (lane < 16) { const int row = rbase + lane; const LAS float* ar = affl + lane * 32;
        float bestgs = -3e38f; int be0 = 0, be1 = 0; float ba0 = 0.f, ba1 = 0.f;
#pragma unroll
        for (int gg = 0; gg < 4; ++gg) { float v1 = -3e38f, v2 = -3e38f, a1 = 0.f, a2 = 0.f; int i1 = 0, i2 = 0;
#pragma unroll
            for (int i = 0; i < 8; ++i) { const float a = ar[gg * 8 + i], c_ = a + p.router_b[gg * 8 + i];
                if (c_ > v1) { v2 = v1; a2 = a1; i2 = i1; v1 = c_; a1 = a; i1 = i; } else if (c_ > v2) { v2 = c_; a2 = a; i2 = i; } }
            const float gs = v1 + v2; if (gs > bestgs) { bestgs = gs; be0 = gg * 8 + i1; be1 = gg * 8 + i2; ba0 = a1; ba1 = a2; } }
        const float sum = ba0 + ba1; p.tokw[row * 2] = ba0 / sum; p.tokw[row * 2 + 1] = ba1 / sum;
        const int lr = row - row0; const int r0_ = atomicAdd((int*)&lcnt[be0], 1); const int r1_ = atomicAdd((int*)&lcnt[be1], 1);
        ent[lr * 4 + 0] = be0 | (r0_ << 8); ent[lr * 4 + 1] = row * 2; ent[lr * 4 + 2] = be1 | (r1_ << 8); ent[lr * 4 + 3] = row * 2 + 1; }
    { uint2 xq[2][4][4];
#define NR_LOAD(s_, r_) do { _Pragma("unroll") for (int k_ = 0; k_ < 4; ++k_) { const bf16_t* xq_ = xin + (size_t)((r_) + k_) * D + 4 * lane; _Pragma("unroll") for (int j_ = 0; j_ < 4; ++j_) xq[s_][k_][j_] = *(const uint2*)(xq_ + 256 * j_); } } while (0)
      NR_LOAD(0, rbase);
#pragma unroll
      for (int g4 = 0; g4 < 4; ++g4) {
          if (g4 + 1 < 4) NR_LOAD((g4 + 1) & 1, rbase + 4 * (g4 + 1));
#pragma unroll
          for (int k = 0; k < 4; ++k) { const int row = rbase + 4 * g4 + k; const float rr_ = rdlane(r, 4 * g4 + k);
#pragma unroll
              for (int j = 0; j < 4; ++j) { const f32x4 g4v = *(const LAS f32x4*)(cg + 4 * lane + 256 * j), s4_ = *(const LAS f32x4*)(csh + 4 * lane + 256 * j); const uint2 xc = xq[g4 & 1][k][j];
                  const float x0 = __uint_as_float(xc.x << 16), x1 = __uint_as_float(xc.x & 0xFFFF0000u), x2 = __uint_as_float(xc.y << 16), x3 = __uint_as_float(xc.y & 0xFFFF0000u);
                  *(unsigned*)((unsigned char*)p.h + (size_t)row * D + 4 * lane + 256 * j) = pk4_fp8((x0 * rr_ * g4v[0] + s4_[0]) * F8_SA, (x1 * rr_ * g4v[1] + s4_[1]) * F8_SA, (x2 * rr_ * g4v[2] + s4_[2]) * F8_SA, (x3 * rr_ * g4v[3] + s4_[3]) * F8_SA); } } }
#undef NR_LOAD
    }
    __syncthreads();
    if (F.tid < 32) gbase[F.tid] = atomicAdd(&p.cnt[layer * 64 + F.tid], lcnt[F.tid]);
    __syncthreads();
    for (int idx = F.tid; idx < rows_per_wg * 2; idx += NTHR) { const int er = ent[idx * 2], tk = ent[idx * 2 + 1]; const int e = er & 255, rk = er >> 8; p.list[(size_t)e * T + gbase[e] + rk] = tk; }
    __syncthreads();
}

struct MoeOrder { const LAS int* tab;
    __device__ bool next(int i, ge::Unit& u) const { if (i >= 8) return false; const int pm = __builtin_amdgcn_readfirstlane(tab[4 * i]); if (pm < 0) return false;
        u.pm = pm; u.pn = __builtin_amdgcn_readfirstlane(tab[4 * i + 1]); u.bt = __builtin_amdgcn_readfirstlane(tab[4 * i + 2]); u.aux = __builtin_amdgcn_readfirstlane(tab[4 * i + 3]); return true; } };
__device__ __forceinline__ void moe_plan(const Frame& F, const int* cnt, const int* list, LAS int* tab, LAS int* tkt  , int npn, const float* tokw = nullptr, LAS float* tkw = nullptr  , const float wscale = 1.f) {
    LAS int* lc = tab + 32;
    __syncthreads();
    if (F.tid < 32) lc[F.tid] = cnt[F.tid];
    __syncthreads();
    if (F.tid < 8) { const int L = F.tid * F.G + F.bid, mt = L / npn, pn = L % npn; int acc = 0, e_f = -1, mi_f = 0;
#pragma unroll 1
        for (int e = 0; e < NE; ++e) { const int nte = (lc[e] + 255) >> 8; if (e_f < 0 && mt < acc + nte) { e_f = e; mi_f = mt - acc; } acc += nte; }
        tab[4 * F.tid] = e_f < 0 ? -1 : mt; tab[4 * F.tid + 1] = pn; tab[4 * F.tid + 2] = e_f * npn + pn; tab[4 * F.tid + 3] = e_f | (mi_f << 8) | (F.tid << 24); }
    __syncthreads();
#pragma unroll
    for (int q = 0; q < 4; ++q) { const int idx = F.tid + NTHR * q, i = idx >> 8, r = idx & 255; int v = -1;
        if (tab[4 * i] >= 0) { const int aux = tab[4 * i + 3], e = aux & 255, ii = ((aux >> 8) & 0xFFFF) * 256 + r; if (ii < lc[e]) v = list[(size_t)e * T + ii]; }
        tkt[idx] = v; if (tkw) tkw[idx] = v >= 0 ? tokw[v] * wscale : 0.f; }
    __syncthreads();
}
struct MoeRows { static constexpr bool dense = false; const LAS int* tkt; __device__ __forceinline__ unsigned operator()(const ge::Unit& u, int r) const { const int tk = tkt[(u.aux >> 24) * 256 + r]; return tk < 0 ? (unsigned)T * (unsigned)(D * 2) : (unsigned)(tk >> 1) * (unsigned)D; } };
struct EpiMoe1 { unsigned char* hid8; float inscale;
    __device__ __forceinline__ void operator()(const f32x4 (&acc)[2][2][4][2], const ge::Unit& u, int wr, int wc, int fr, int fq) const {
        const int h0 = (4 * u.pn + wc) * 32 + 8 * fq;
#pragma unroll
        for (int ai = 0; ai < 2; ++ai)
#pragma unroll
            for (int m = 0; m < 4; ++m) { const int row = u.pm * 256 + ai * 128 + wr * 64 + m * 16 + fr; unsigned w[2];
#pragma unroll
                for (int n = 0; n < 2; ++n) { float r4[4];
#pragma unroll
                    for (int j = 0; j < 4; ++j) { const float g = acc[ai][0][m][n][j] * inscale, uu = acc[ai][1][m][n][j] * inscale; r4[j] = g * fsigmoid(g) * uu * F8_SH; }
                    w[n] = pk4_fp8(r4[0], r4[1], r4[2], r4[3]); }
                *(uint2*)(hid8 + (size_t)row * DE + h0) = make_uint2(w[0], w[1]); }
    } };
struct EpiMoe2 { bf16_t* outk; const LAS int* tkt; const LAS float* tkw;
    __device__ __forceinline__ void operator()(const f32x4 (&acc)[2][2][4][2], const ge::Unit& u, int wr, int wc, int fr, int fq) const {
        const int L0 = (4 * u.pn + wc) * 64 + 16 * fq; const int ub = (u.aux >> 24) * 256 + wr * 64 + fr; int tk[2][4]; float wt[2][4];
#pragma unroll
        for (int ai = 0; ai < 2; ++ai)
#pragma unroll
            for (int m = 0; m < 4; ++m) { tk[ai][m] = tkt[ub + ai * 128 + m * 16]; wt[ai][m] = tkw[ub + ai * 128 + m * 16]; }
#pragma unroll
        for (int ai = 0; ai < 2; ++ai)
#pragma unroll
            for (int m = 0; m < 4; ++m) { const int t_ = tk[ai][m]; if (t_ < 0) continue; const float w = wt[ai][m]; float v[16]; GE_VALS(v, acc, ai, m);
#pragma unroll
                for (int k = 0; k < 16; ++k) v[k] *= w;
                store16_bf16(outk + (size_t)(t_ & 1) * T * D + (size_t)(t_ >> 1) * D + L0, v); }
    } };

__device__ __forceinline__ void phase_cmp2(const Params& p, const Frame& F) {
    LAS float* w2l = (LAS float*)F.lds; const int base = F.bid * 8 + F.wave;
#pragma unroll 1
    for (int w = 0; w < 2; ++w) {
        __syncthreads();
        for (int i4 = F.tid; i4 < 256 * 64 / 4; i4 += NTHR) { const float4 t4 = *(const float4*)(p.cmp_w2 + (size_t)w * 256 * 64 + 4 * i4); *(LAS f32x4*)(w2l + 4 * i4) = (f32x4){t4.x, t4.y, t4.z, t4.w}; }
        float hv[2][4];
#pragma unroll
        for (int k = 0; k < 2; ++k) { const int row = (base + (2 * w + k) * 2048) & 4095;
#pragma unroll
            for (int i = 0; i < 4; ++i) { float x = p.cb1[w * 256 + i * 64 + F.lane];
#pragma unroll
                for (int ks = 0; ks < 8; ++ks) x += p.cpart[((size_t)(w * 8 + ks) * 4096 + row) * 256 + i * 64 + F.lane];
                hv[k][i] = 0.5f * x * (1.f + ftanh(0.7978845608028654f * (x + 0.044715f * x * x * x))); } }
        __syncthreads();
        float acc0 = p.cmp_b2[w * 64 + F.lane], acc1 = acc0;
#pragma unroll
        for (int i = 0; i < 4; ++i)
#pragma unroll 8
            for (int l = 0; l < 64; ++l) { const float wv = w2l[(i * 64 + l) * 64 + F.lane]; acc0 += rdlane(hv[0][i], l) * wv; acc1 += rdlane(hv[1][i], l) * wv; }
#pragma unroll
        for (int k = 0; k < 2; ++k) { const int row = (base + (2 * w + k) * 2048) & 4095, c = row & 127; float v = k ? acc1 : acc0;
            if (w == 0) { const float ss = wave_sum(v * v); v = v * rsqrtf(ss * (1.f / 64.f) + 1e-6f) * p.k_gain[F.lane]; int pos = c * 16 + 31; if (pos > 2047) pos = 2047;
                const float other = sx<8>(v); if (F.lane < 16) { const int j = F.lane & 7; const float cs = p.rope[pos * 16 + j], sn = p.rope[pos * 16 + 8 + j]; v = (F.lane < 8) ? (v * cs - other * sn) : (v * cs + other * sn); } }
            if (c == 127) v = 0.f;
            (w == 0 ? p.kcmp : p.vcmp)[(size_t)row * 64 + F.lane] = f2bf(v); }
    }
}

typedef float f32x16 __attribute__((ext_vector_type(16)));
typedef short s16x4 __attribute__((ext_vector_type(4)));
namespace at {
constexpr int KP = 144, VP = 192;
constexpr int KBUF = 64 * KP, VBUF = 64 * VP;
constexpr int OFF_K0 = 0, OFF_K1 = KBUF, OFF_V0 = 4 * KBUF, OFF_V1 = 4 * KBUF + VBUF, OFF_IMP = 4 * KBUF + 4 * VBUF;
constexpr int IMP_PITCH = 33, OFF_SEL = OFF_IMP + 8 * 32 * IMP_PITCH * 4;
constexpr float SC = 0.125f * 1.4426950408889634f;
constexpr float NEG = -1e30f, THR = 8.0f;
__device__ __forceinline__ unsigned pk2(float a, float b) { typedef float f2 __attribute__((ext_vector_type(2))); typedef __bf16 b2 __attribute__((ext_vector_type(2))); b2 r = __builtin_convertvector((f2){a, b}, b2); return __builtin_bit_cast(unsigned, r); }
template <int OFF> __device__ __forceinline__ s16x4 tr_read(unsigned addr) { s16x4 r; asm volatile("ds_read_b64_tr_b16 %0, %1 offset:%2" : "=&v"(r) : "v"(addr), "i"(OFF) : "memory"); return r; }
struct St { f32x16 o[2]; float m, l; };

__device__ __forceinline__ void qk_tile(const LAS unsigned char* kb, int r32, int hi, const bf16x8 (&qf)[4], f32x16& s0, f32x16& s1) {
#pragma unroll
    for (int e = 0; e < 16; ++e) { s0[e] = 0.f; s1[e] = 0.f; }
#pragma unroll
    for (int ks = 0; ks < 4; ++ks) {
        const bf16x8 a0 = *(const LAS bf16x8*)(kb + r32 * KP + (16 * ks + 8 * hi) * 2);
        const bf16x8 a1 = *(const LAS bf16x8*)(kb + (32 + r32) * KP + (16 * ks + 8 * hi) * 2);
        s0 = __builtin_amdgcn_mfma_f32_32x32x16_bf16(a0, qf[ks], s0, 0, 0, 0);
        s1 = __builtin_amdgcn_mfma_f32_32x32x16_bf16(a1, qf[ks], s1, 0, 0, 0);
    }
}
template <int MODE>
__device__ __forceinline__ bool elem_valid(int kt, int e, int hi, int qloc, int t, int key0) {
    const int kl = kt * 32 + (e & 3) + 8 * (e >> 2) + 4 * hi;
    if (MODE == 1) { const int c = key0 + kl; return (c < 127) && (16 * c + 31 <= t); }
    if (MODE == 2) return kl <= qloc;
    if (MODE == 3) return kl > qloc;
    return true;
}
template <int DT> __device__ __forceinline__ void pv_read(unsigned vb_lane, s16x4 (&va)[4][2]) {
    va[0][0] = tr_read<0 * VP + 64 * DT>(vb_lane); va[0][1] = tr_read<8 * VP + 64 * DT>(vb_lane); va[1][0] = tr_read<16 * VP + 64 * DT>(vb_lane); va[1][1] = tr_read<24 * VP + 64 * DT>(vb_lane);
    va[2][0] = tr_read<32 * VP + 64 * DT>(vb_lane); va[2][1] = tr_read<40 * VP + 64 * DT>(vb_lane); va[3][0] = tr_read<48 * VP + 64 * DT>(vb_lane); va[3][1] = tr_read<56 * VP + 64 * DT>(vb_lane);
}
__device__ __forceinline__ void pv_mma(const s16x4 (&va)[4][2], const unsigned (&pp)[16], f32x16& o) {
#pragma unroll
    for (int kk = 0; kk < 4; ++kk) {
        const bf16x8 af = (bf16x8){va[kk][0][0], va[kk][0][1], va[kk][0][2], va[kk][0][3], va[kk][1][0], va[kk][1][1], va[kk][1][2], va[kk][1][3]};
        typedef unsigned u32x4 __attribute__((ext_vector_type(4)));
        const u32x4 pw = (u32x4){pp[4 * kk], pp[4 * kk + 1], pp[4 * kk + 2], pp[4 * kk + 3]};
        o = __builtin_amdgcn_mfma_f32_32x32x16_bf16(af, __builtin_bit_cast(bf16x8, pw), o, 0, 0, 0);
    }
}
__device__ __forceinline__ void pv_tile(unsigned vb_lane, const unsigned (&pp)[16], St& st) {
    s16x4 va[4][2];
    pv_read<0>(vb_lane, va); asm volatile("s_waitcnt lgkmcnt(0)" ::: "memory"); __builtin_amdgcn_sched_barrier(0); pv_mma(va, pp, st.o[0]);
    pv_read<1>(vb_lane, va); asm volatile("s_waitcnt lgkmcnt(0)" ::: "memory"); __builtin_amdgcn_sched_barrier(0); pv_mma(va, pp, st.o[1]);
}
__device__ __forceinline__ float max3f(float a, float b, float c) { float r; asm("v_max3_f32 %0, %1, %2, %3" : "=v"(r) : "v"(a), "v"(b), "v"(c)); return r; }
template <int MODE, bool GATED, bool FIXED>
__device__ __forceinline__ void attend_tile(const LAS unsigned char* kb, unsigned vb_lane, int r32, int hi, const bf16x8 (&qf)[4], St& st, int qloc, bool en, float mfix) {
    f32x16 s0, s1; qk_tile(kb, r32, hi, qf, s0, s1);
    s16x4 va0[4][2]; pv_read<0>(vb_lane, va0);
    if (MODE != 0) {
#pragma unroll
        for (int e = 0; e < 16; ++e) { s0[e] = elem_valid<MODE>(0, e, hi, qloc, 0, 0) ? s0[e] : NEG; s1[e] = elem_valid<MODE>(1, e, hi, qloc, 0, 0) ? s1[e] : NEG; }
    }
    float mc = 0.f;
    if (FIXED) {
    } else {
        float mx = max3f(s0[0], s0[1], s1[0]);
#pragma unroll
        for (int e = 2; e < 16; e += 2) mx = max3f(mx, s0[e], s0[e + 1]);
#pragma unroll
        for (int e = 1; e < 15; e += 2) mx = max3f(mx, s1[e], s1[e + 1]);
        mx = fmaxf(mx, s1[15]);
        if (GATED) mx = en ? mx : NEG;
        mx = max32(mx);
        float mold = st.m;
        if (__any((mx - mold) * SC > THR)) {
            const float mnew = fmaxf(mold, mx); const float al = __builtin_amdgcn_exp2f((mold - mnew) * SC);
#pragma unroll
            for (int e = 0; e < 16; ++e) { st.o[0][e] *= al; st.o[1][e] *= al; }
            st.l *= al; st.m = mnew; mold = mnew;
        }
        mc = fmaxf(mold, -1e20f) * SC; if (GATED) mc = en ? mc : 3e38f;
    }
    float rs = 0.f; unsigned pp[16];
#pragma unroll
    for (int e = 0; e < 16; e += 2) {
        float a0, a1, b0, b1;
        if (FIXED) { a0 = __builtin_amdgcn_exp2f(s0[e]); a1 = __builtin_amdgcn_exp2f(s0[e + 1]); b0 = __builtin_amdgcn_exp2f(s1[e]); b1 = __builtin_amdgcn_exp2f(s1[e + 1]); }
        else { a0 = __builtin_amdgcn_exp2f(__builtin_fmaf(s0[e], SC, -mc)); a1 = __builtin_amdgcn_exp2f(__builtin_fmaf(s0[e + 1], SC, -mc)); b0 = __builtin_amdgcn_exp2f(__builtin_fmaf(s1[e], SC, -mc)); b1 = __builtin_amdgcn_exp2f(__builtin_fmaf(s1[e + 1], SC, -mc)); }
        rs += (a0 + a1) + (b0 + b1); pp[e >> 1] = pk2(a0, a1); pp[8 + (e >> 1)] = pk2(b0, b1); }
    if (FIXED && GATED) {
#pragma unroll
        for (int i = 0; i < 16; ++i) pp[i] = en ? pp[i] : 0u;
        rs = en ? rs : 0.f; }
    if (!FIXED) rs = sum32(rs);
    st.l += rs;
    asm volatile("s_waitcnt lgkmcnt(0)" ::: "memory"); __builtin_amdgcn_sched_barrier(0); pv_mma(va0, pp, st.o[0]);
    { s16x4 va1[4][2]; pv_read<1>(vb_lane, va1); asm volatile("s_waitcnt lgkmcnt(0)" ::: "memory"); __builtin_amdgcn_sched_barrier(0); pv_mma(va1, pp, st.o[1]); }
}
__device__ __forceinline__ void st_reset(St& st) {
#pragma unroll
    for (int a = 0; a < 2; ++a)
#pragma unroll
        for (int e = 0; e < 16; ++e) st.o[a][e] = 0.f;
    st.m = NEG; st.l = 0.f;
}
__device__ __forceinline__ void st_flush(const St& st, unsigned (&ofin)[2][8], float g, bool first) {
    const float f = (st.l > 0.f ? 1.f / st.l : 0.f) * g;
#pragma unroll
    for (int dt = 0; dt < 2; ++dt)
#pragma unroll
        for (int e = 0; e < 16; e += 2) { float a = st.o[dt][e] * f, b = st.o[dt][e + 1] * f;
            if (!first) { const unsigned w = ofin[dt][e >> 1]; a += __uint_as_float(w << 16); b += __uint_as_float(w & 0xFFFF0000u); }
            ofin[dt][e >> 1] = pk2(a, b); }
#pragma unroll
    for (int dt = 0; dt < 2; ++dt) asm volatile("" : "+v"(ofin[dt][0]), "+v"(ofin[dt][1]), "+v"(ofin[dt][2]), "+v"(ofin[dt][3]), "+v"(ofin[dt][4]), "+v"(ofin[dt][5]), "+v"(ofin[dt][6]), "+v"(ofin[dt][7]));
}
__device__ __forceinline__ void tile_load(const bf16_t* kbase, const bf16_t* vbase, int key0, int tid, uint4& kr, uint4& vr) {
    const size_t o = (size_t)(key0 + (tid >> 3)) * 64 + (tid & 7) * 8; kr = *(const uint4*)(kbase + o); vr = *(const uint4*)(vbase + o); }
typedef unsigned u32x4_t __attribute__((ext_vector_type(4)));
__device__ __forceinline__ void tile_store(LAS unsigned char* lds, int buf, int tid, const uint4& kr, const uint4& vr) {
    *(LAS u32x4_t*)(lds + OFF_K0 + buf * KBUF + (tid >> 3) * KP + (tid & 7) * 16) = (u32x4_t){kr.x, kr.y, kr.z, kr.w}; *(LAS u32x4_t*)(lds + OFF_V0 + buf * VBUF + (tid >> 3) * VP + (tid & 7) * 16) = (u32x4_t){vr.x, vr.y, vr.z, vr.w}; }
}

template <bool FIXED>
__device__ __forceinline__ void phase_attn_t(const Params& p, const Frame& F, const float mfix) {
    using namespace at;
    LAS unsigned char* lds = F.lds;
    const int tid = F.tid, lane = F.lane, w = F.wave, r32 = lane & 31, hi = lane >> 5;
    const unsigned vlane = (unsigned)((4 * hi + ((lane & 15) >> 2)) * VP + (16 * ((lane >> 4) & 1) + 4 * (lane & 3)) * 2);
    LAS float* impw = (LAS float*)(lds + OFF_IMP) + w * 32 * IMP_PITCH;
    LAS unsigned* selm = (LAS unsigned*)(lds + OFF_SEL);
    LAS float* invl = (LAS float*)(lds + OFF_SEL + 512);
#define AT_UNIT(ui_, qb_, bg_, qoff_) const int idx_##qb_ = ((ui_) & 1) ? ((ui_) * 256 + 255 - F.bid) : ((ui_) * 256 + F.bid); const int qb_ = 31 - (idx_##qb_ >> 6), bg_ = (idx_##qb_ >> 1) & 31, qoff_ = (idx_##qb_ & 1) * 32
    bf16x8 qf[4]; float gt[3]; uint4 kr, vr, kr1, vr1;
    { AT_UNIT(0, qb, bg, qoff);
      const bf16_t* kc = p.kcmp + (size_t)bg * 128 * 64; const bf16_t* vc = p.vcmp + (size_t)bg * 128 * 64;
      tile_load(kc, vc, 0, tid, kr, vr); if (qb >= 16) tile_load(kc, vc, 64, tid, kr1, vr1); }
#pragma unroll 1
    for (int ui = 0; ui < 8; ++ui) {
        AT_UNIT(ui, qb, bg, qoff);
        const int b = bg >> 1, g = bg & 1, head = g * 8 + w, s0 = qb * 64;
        const int qloc = qoff + r32, t = s0 + qloc;
        const bf16_t* ksel = p.kv + (size_t)2 * T * 128 + (size_t)bg * S * 64; const bf16_t* vsel = p.kv + (size_t)3 * T * 128 + (size_t)bg * S * 64;
        const bf16_t* kwin = p.kv + (size_t)4 * T * 128 + (size_t)bg * S * 64; const bf16_t* vwin = p.kv + (size_t)5 * T * 128 + (size_t)bg * S * 64;
        unsigned ofin[2][8]; St st;
        { const size_t tok = (size_t)b * S + t;
#pragma unroll
          for (int ks = 0; ks < 4; ++ks) { qf[ks] = *(const bf16x8*)(p.q + tok * D + head * 64 + 16 * ks + 8 * hi);
              if (FIXED) { typedef unsigned u32x4q __attribute__((ext_vector_type(4))); const u32x4q w4 = __builtin_bit_cast(u32x4q, qf[ks]); u32x4q r4;
#pragma unroll
                  for (int i = 0; i < 4; ++i) r4[i] = pk2(__uint_as_float(w4[i] << 16) * SC, __uint_as_float(w4[i] & 0xFFFF0000u) * SC);
                  qf[ks] = __builtin_bit_cast(bf16x8, r4); } }
#pragma unroll
          for (int br = 0; br < 3; ++br) gt[br] = p.gates[tok * 48 + br * 16 + head]; }
        const int nct = (qb >= 16) ? 2 : 1;
        __syncthreads();
        tile_store(lds, 0, tid, kr, vr); if (nct == 2) tile_store(lds, 1, tid, kr1, vr1);
        tile_load(ksel, vsel, qb * 64, tid, kr, vr);
        __syncthreads();
        float cm = NEG, cl = 0.f;
        if (!FIXED) {
#pragma unroll 1
        for (int ct = 0; ct < nct; ++ct) { const LAS unsigned char* kb = lds + (ct ? OFF_K1 : OFF_K0);
            f32x16 a0, a1; qk_tile(kb, r32, hi, qf, a0, a1); float mx = NEG;
#pragma unroll
            for (int e = 0; e < 16; ++e) { a0[e] = elem_valid<1>(0, e, hi, qloc, t, ct * 64) ? a0[e] : NEG; a1[e] = elem_valid<1>(1, e, hi, qloc, t, ct * 64) ? a1[e] : NEG; mx = fmaxf(mx, fmaxf(a0[e], a1[e])); }
            mx = max32(mx); const float mnew = fmaxf(cm, mx); float rs = 0.f;
#pragma unroll
            for (int e = 0; e < 16; ++e) { rs += (a0[e] > -1e29f ? __builtin_amdgcn_exp2f((a0[e] - mnew) * SC) : 0.f) + (a1[e] > -1e29f ? __builtin_amdgcn_exp2f((a1[e] - mnew) * SC) : 0.f); }
            rs = sum32(rs); cl = cl * __builtin_amdgcn_exp2f((cm - mnew) * SC) + rs; cm = mnew; }
        }
        st_reset(st); if (FIXED) cm = mfix / SC; else st.m = cm;
        const float icl = FIXED ? 1.f : (cl > 0.f ? 1.f / cl : 0.f);
        LAS float* irow = impw + r32 * IMP_PITCH;
        if (nct == 1) {
#pragma unroll 1
            for (int j = 16; j < 32; ++j) irow[j] = 0.f; }
#pragma unroll 1
        for (int ct = 0; ct < nct; ++ct) { const LAS unsigned char* kb = lds + (ct ? OFF_K1 : OFF_K0); const unsigned vb = (unsigned)(unsigned long)(lds + (ct ? OFF_V1 : OFF_V0)) + vlane;
            f32x16 a0, a1; qk_tile(kb, r32, hi, qf, a0, a1); const float mc = cm * SC; unsigned pp[16]; float rs = 0.f; float Ai[8], Fi[8];
#pragma unroll
            for (int kt = 0; kt < 2; ++kt)
#pragma unroll
                for (int gq = 0; gq < 4; ++gq) { float pv[4];
#pragma unroll
                    for (int e2 = 0; e2 < 4; ++e2) { const int e = gq * 4 + e2; const float sv = kt ? a1[e] : a0[e]; pv[e2] = elem_valid<1>(kt, e, hi, qloc, t, ct * 64) ? (FIXED ? __builtin_amdgcn_exp2f(sv) : __builtin_amdgcn_exp2f(sv * SC - mc)) : 0.f; }
                    pp[kt * 8 + gq * 2] = pk2(pv[0], pv[1]); pp[kt * 8 + gq * 2 + 1] = pk2(pv[2], pv[3]); rs += (pv[0] + pv[1]) + (pv[2] + pv[3]);
                    Ai[kt * 4 + gq] = (pv[0] + 2.f * (pv[1] + pv[2] + pv[3])) * icl; Fi[kt * 4 + gq] = pv[0] * icl; }
            st.l += rs;
            float Fr[8];
#pragma unroll
            for (int g8 = 0; g8 < 8; ++g8) Fr[g8] = other32(Fi[g8], hi != 0);
#pragma unroll
            for (int g8 = 0; g8 < 8; ++g8) { const float nxt = (g8 < 7) ? Fr[g8 + 1] : 0.f;
                irow[ct * 16 + 2 * g8 + hi] = Ai[g8] + (hi ? nxt : Fr[g8]); }
            if (ct == 1 && hi) irow[15] += Fr[0];
            pv_tile(vb, pp, st); }
        st.l = sum32(st.l);
        if (hi == 0) invl[w * 32 + r32] = FIXED ? (st.l > 0.f ? 1.f / st.l : 0.f) : 1.f;
        tile_store(lds, 2, tid, kr, vr);
        st_flush(st, ofin, gt[0], true);
        __syncthreads();
        if (w == 0) { unsigned mask;
            if (qb < 8) mask = (2u << qb) - 1u;
            else { mask = 1u | (1u << qb) | (1u << (qb - 1));
                const LAS float* ib = (const LAS float*)(lds + OFF_IMP) + r32 * IMP_PITCH; float iv[32];
#pragma unroll
                for (int j = 0; j < 32; ++j) { float v = 0.f;
#pragma unroll
                    for (int ww = 0; ww < 8; ++ww) v += ib[ww * 32 * IMP_PITCH + j] * invl[ww * 32 + r32];
                    iv[j] = (j >= 1 && j <= qb - 2) ? v : -3e38f; }
#pragma unroll 1
                for (int pick = 0; pick < 5; ++pick) { int best = -1; float bv = -3e38f;
#pragma unroll
                    for (int j = 1; j < 31; ++j) { const bool take = !((mask >> j) & 1u) && iv[j] > bv; bv = take ? iv[j] : bv; best = take ? j : best; }
                    if (best >= 0) mask |= 1u << best; } }
            if (hi == 0) selm[r32] = mask; unsigned um = mask;
            um |= sxu<16>(um); um |= sxu<8>(um); um |= sxu<4>(um); um |= sxu<2>(um); um |= sxu<1>(um);
            if (lane == 0) selm[32] = um; }
        __syncthreads();
        const int jlo = qb >= 8 ? qb - 8 : 0;
        { const unsigned um = selm[32]; const unsigned mq = selm[r32];
          st_reset(st);
          unsigned rem = um & ~(1u << qb);
#define SEL_POP(dst) do { if (rem) { dst = 31 - __builtin_clz(rem); rem &= ~(1u << dst); } else dst = -1; } while (0)
          int jA = qb, jB = -1, sb = 1;
          for (;;) {
              int nA, nB = -1; SEL_POP(nA); if (nA >= 0) SEL_POP(nB);
              if (nA >= 0) tile_load(ksel, vsel, nA * 64, tid, kr, vr);
              if (nB >= 0) tile_load(ksel, vsel, nB * 64, tid, kr1, vr1);
              if (nA < 0) { tile_load(kwin, vwin, qb * 64, tid, kr, vr); if (qb - 1 >= jlo) tile_load(kwin, vwin, (qb - 1) * 64, tid, kr1, vr1); }
              { const LAS unsigned char* kb = lds + OFF_K0 + (2 * sb) * KBUF; const unsigned vb = (unsigned)(unsigned long)(lds + OFF_V0 + (2 * sb) * VBUF) + vlane;
                if (jA == qb) attend_tile<2, false, FIXED>(kb, vb, r32, hi, qf, st, qloc, true, mfix);
                else attend_tile<0, true, FIXED>(kb, vb, r32, hi, qf, st, qloc, (mq >> jA) & 1u, mfix); }
              if (jB >= 0) { const LAS unsigned char* kb = lds + OFF_K0 + (2 * sb + 1) * KBUF; const unsigned vb = (unsigned)(unsigned long)(lds + OFF_V0 + (2 * sb + 1) * VBUF) + vlane;
                attend_tile<0, true, FIXED>(kb, vb, r32, hi, qf, st, qloc, (mq >> jB) & 1u, mfix); }
              if (nA < 0) break;
              tile_store(lds, 2 * (sb ^ 1), tid, kr, vr); if (nB >= 0) tile_store(lds, 2 * (sb ^ 1) + 1, tid, kr1, vr1);
              __syncthreads();
              jA = nA; jB = nB; sb ^= 1;
          }
#undef SEL_POP
          if (FIXED) st.l = sum32(st.l);
          st_flush(st, ofin, gt[1], false); }
        __syncthreads();
        { st_reset(st);
          int jA = qb, jB = (qb - 1 >= jlo) ? qb - 1 : -1, sb = 0;
          tile_store(lds, 0, tid, kr, vr); if (jB >= 0) tile_store(lds, 1, tid, kr1, vr1);
          __syncthreads();
          for (;;) {
              const int nA = (jB >= 0 && jB - 1 >= jlo) ? jB - 1 : -1, nB = (nA >= 0 && nA - 1 >= jlo) ? nA - 1 : -1;
              if (nA >= 0) tile_load(kwin, vwin, nA * 64, tid, kr, vr);
              if (nB >= 0) tile_load(kwin, vwin, nB * 64, tid, kr1, vr1);
              if (nA < 0 && ui + 1 < 8) {
                  AT_UNIT(ui + 1, qbn, bgn, qoffn);
                  const bf16_t* kcn = p.kcmp + (size_t)bgn * 128 * 64; const bf16_t* vcn = p.vcmp + (size_t)bgn * 128 * 64;
                  tile_load(kcn, vcn, 0, tid, kr, vr); if (qbn >= 16) tile_load(kcn, vcn, 64, tid, kr1, vr1); }
#define WIN_TILE(j_, bi_) do { const LAS unsigned char* kb = lds + OFF_K0 + (bi_) * KBUF; const unsigned vb = (unsigned)(unsigned long)(lds + OFF_V0 + (bi_) * VBUF) + vlane; \
                if ((j_) == qb) attend_tile<2, false, FIXED>(kb, vb, r32, hi, qf, st, qloc, true, mfix); else if ((j_) == qb - 8) attend_tile<3, false, FIXED>(kb, vb, r32, hi, qf, st, qloc, true, mfix); else attend_tile<0, false, FIXED>(kb, vb, r32, hi, qf, st, qloc, true, mfix); } while (0)
              WIN_TILE(jA, 2 * sb);
              if (jB >= 0) WIN_TILE(jB, 2 * sb + 1);
#undef WIN_TILE
              if (nA < 0) break;
              tile_store(lds, 2 * (sb ^ 1), tid, kr, vr); if (nB >= 0) tile_store(lds, 2 * (sb ^ 1) + 1, tid, kr1, vr1);
              __syncthreads();
              jA = nA; jB = nB; sb ^= 1;
          }
          if (FIXED) st.l = sum32(st.l);
          st_flush(st, ofin, gt[2], false); }
        { int l2 = lane; asm volatile("" : "+v"(l2)); unsigned char* op = (unsigned char*)p.h + ((size_t)b * S + s0 + qoff + (l2 & 31)) * D + head * 64 + 4 * (l2 >> 5);
#pragma unroll
          for (int dt = 0; dt < 2; ++dt)
#pragma unroll
            for (int gq = 0; gq < 4; ++gq) { const unsigned w0 = ofin[dt][2 * gq], w1 = ofin[dt][2 * gq + 1];
                *(unsigned*)(op + dt * 32 + 8 * gq) = pk4_fp8(__uint_as_float(w0 << 16) * F8_SA, __uint_as_float(w0 & 0xFFFF0000u) * F8_SA, __uint_as_float(w1 << 16) * F8_SA, __uint_as_float(w1 & 0xFFFF0000u) * F8_SA); } }
    }
#undef AT_UNIT
}

__device__ __forceinline__ void phase_attn(const Params& p, const Frame& F) {
    const float gq = wave_max(fabsf(p.q_gain[F.lane])); const float gk = wave_max(fmaxf(fabsf(p.k_gain[F.lane]), fmaxf(fabsf(p.k_gain[64 + F.lane]), fabsf(p.k_gain[128 + F.lane]))));
    const float mfix = 64.f * 1.02f * gq * gk * at::SC;
    if (mfix < 60.f) phase_attn_t<true>(p, F, mfix);
    else phase_attn_t<false>(p, F, 0.f);
}

namespace ml {
constexpr int QP = 272, VP = 192;
constexpr int OFF_Q = 0, OFF_K = 64 * QP, OFF_V = 2 * 64 * QP, OFF_WV = OFF_V + 64 * VP, OFF_CB = OFF_WV + 64 * VP, OFF_GA = OFF_CB + 128 * VP, OFF_GAM = OFF_GA + 8192, OFF_GB = OFF_GAM + 8192,
              OFF_MP = OFF_GB + 8192, OFF_W = OFF_MP + 256, OFF_N = OFF_W + 256, OFF_RS = OFF_N + 512, OFF_QN = OFF_RS + 256, OFF_END = OFF_QN + 256;
typedef unsigned u32x4_t __attribute__((ext_vector_type(4)));
}
__device__ __forceinline__ void phase_scan(const Params& p, const Frame& F, bf16_t* hs_base  , const int hs_stride) {
    using namespace ml; using at::tr_read; using at::pk2;
    LAS unsigned char* lds = F.lds;
    const int tid = F.tid, lane = F.lane, w = F.wave, i16 = lane & 15, g = lane >> 4, r32 = lane & 31, hi = lane >> 5;
    const int b = F.bid >> 4, h = (F.bid >> 2) & 3, vs = F.bid & 3;
    LAS float* ga = (LAS float*)(lds + OFF_GA); LAS float* gam = (LAS float*)(lds + OFF_GAM); LAS float* gb = (LAS float*)(lds + OFF_GB); LAS float* mp = (LAS float*)(lds + OFF_MP);
    LAS float* wl = (LAS float*)(lds + OFF_W); LAS float* nl = (LAS float*)(lds + OFF_N); LAS float* rsl = (LAS float*)(lds + OFF_RS); LAS float* qnl = (LAS float*)(lds + OFF_QN);
    for (int ck = w; ck < 32; ck += 8) { const int pos = ck * 64 + lane; const size_t tg = ((size_t)b * S + pos) * 4 + h; const float lfv = p.lf[tg], liv = p.li[tg];
        float bs = lfv;
#pragma unroll
        for (int o = 1; o < 64; o <<= 1) { const float x = __int_as_float(__builtin_amdgcn_ds_bpermute((lane - o) * 4, __float_as_int(bs))); if (lane >= o) bs += x; }
        const float av = liv - bs; float am = av;
#pragma unroll
        for (int o = 1; o < 64; o <<= 1) { const float x = __int_as_float(__builtin_amdgcn_ds_bpermute((lane - o) * 4, __float_as_int(am))); if (lane >= o) am = fmaxf(am, x); }
        ga[pos] = av; gam[pos] = am; gb[pos] = bs; }
    for (int idx = tid; idx < 128 * VP / 4; idx += NTHR) ((LAS unsigned*)(lds + OFF_CB))[idx] = 0u;
    if (tid < 128) nl[tid] = 0.f;
    __syncthreads();
    if (tid == 0) { float m = 0.f;
#pragma unroll 1
        for (int k = 0; k < 32; ++k) { mp[k] = m; m = gb[k * 64 + 63] + fmaxf(m, gam[k * 64 + 63]); } }
    __syncthreads();
    const bf16_t* pq = p.proj + (size_t)b * S * 3072 + h * 128; const bf16_t* pk = pq + 512; bf16_t* pv = p.proj + (size_t)b * S * 3072 + 1024 + h * 256 + vs * 64;
    uint4 rq[2], rk[2], rv;
#define ML_LOAD(ck_) do { const size_t t0_ = (size_t)(ck_) * 64; _Pragma("unroll") for (int i_ = 0; i_ < 2; ++i_) { const int idx_ = tid + 512 * i_; const size_t o_ = (t0_ + (idx_ >> 4)) * 3072 + (idx_ & 15) * 8; rq[i_] = *(const uint4*)(pq + o_); rk[i_] = *(const uint4*)(pk + o_); } \
        rv = *(const uint4*)(pv + (t0_ + (tid >> 3)) * 3072 + (tid & 7) * 8); } while (0)
#define ML_STORE(ck_) do { _Pragma("unroll") for (int i_ = 0; i_ < 2; ++i_) { const int idx_ = tid + 512 * i_; const int o_ = (idx_ >> 4) * QP + (idx_ & 15) * 16; \
            *(LAS u32x4_t*)(lds + OFF_Q + o_) = (u32x4_t){rq[i_].x, rq[i_].y, rq[i_].z, rq[i_].w}; *(LAS u32x4_t*)(lds + OFF_K + o_) = (u32x4_t){rk[i_].x, rk[i_].y, rk[i_].z, rk[i_].w}; } \
        { const int s_ = tid >> 3; const float m63_ = fmaxf(mp[ck_], gam[(ck_) * 64 + 63]); const float ws_ = __expf(ga[(ck_) * 64 + s_] - m63_); if ((tid & 7) == 0) wl[s_] = ws_; \
          const int o_ = s_ * VP + (tid & 7) * 16; *(LAS u32x4_t*)(lds + OFF_V + o_) = (u32x4_t){rv.x, rv.y, rv.z, rv.w}; const unsigned vv_[4] = {rv.x, rv.y, rv.z, rv.w}; unsigned ww_[4]; \
          _Pragma("unroll") for (int e_ = 0; e_ < 4; ++e_) ww_[e_] = pk2(__uint_as_float(vv_[e_] << 16) * ws_, __uint_as_float(vv_[e_] & 0xFFFF0000u) * ws_); \
          *(LAS u32x4_t*)(lds + OFF_WV + o_) = (u32x4_t){ww_[0], ww_[1], ww_[2], ww_[3]}; } } while (0)
    ML_LOAD(0); ML_STORE(0);
    __syncthreads();
    const int tt = w >> 1, vh = w & 1;
    const int dt = w >> 1, vt2 = w & 1;
    const unsigned trl16 = (unsigned)(((lane & 15) >> 2) * VP + (4 * (lane & 3)) * 2);
    const unsigned trl32v = (unsigned)(((lane & 15) >> 2) * VP + (16 * ((lane >> 4) & 1) + 4 * (lane & 3)) * 2);
    const unsigned trl32k = (unsigned)(((lane & 15) >> 2) * QP + (16 * ((lane >> 4) & 1) + 4 * (lane & 3)) * 2);
    f32x16 cacc;
#pragma unroll
    for (int e = 0; e < 16; ++e) cacc[e] = 0.f;
    float nreg = 0.f;
    bf16_t* const hs_out = hs_base + (size_t)b * S * hs_stride + h * 256 + vs * 64 + 32 * vh + i16;
    const size_t wo1 = (size_t)NE * D * DE; const ColGateUp cgu{p.w_gate + wo1, p.w_up + wo1}; const ColDown cdn{p.w_down + wo1};
    LAS float* ptile = (LAS float*)(lds + OFF_END) + (tid >> 8) * (64 * 65); const int htid = tid & 255, half = tid >> 8;
    float pr_[16];
#define PREP_LOAD(s_) do { const bool gu_ = (s_) < 16; const int tl_ = (((gu_ ? (s_) : (s_) - 16) * F.G + F.bid) * 2 + half); const int c0_ = (tl_ & 511) * 64, k0_ = (tl_ >> 9) * 64; \
        const float* p_ = gu_ ? cgu(c0_ + (htid & 63)) : cdn(c0_ + (htid & 63)); const int ldw_ = gu_ ? DE : D; p_ += (size_t)(k0_ + (htid >> 6)) * ldw_; \
        _Pragma("unroll") for (int i_ = 0; i_ < 16; ++i_) pr_[i_] = p_[(size_t)(4 * i_) * ldw_]; } while (0)
#define PREP_WRITE() do { _Pragma("unroll") for (int i_ = 0; i_ < 16; ++i_) ptile[((htid >> 6) + 4 * i_) * 65 + (htid & 63)] = pr_[i_]; } while (0)
#define PREP_STORE(s_) do { const bool gu_ = (s_) < 16; const int tl_ = (((gu_ ? (s_) : (s_) - 16) * F.G + F.bid) * 2 + half); const int c0_ = (tl_ & 511) * 64, k0_ = (tl_ >> 9) * 64; \
        const int cc_ = htid >> 2, ch_ = (htid & 3) * 16; \
        { const float sc_ = gu_ ? F8_SW : F8_SW2; const unsigned long long a_ = (unsigned long long)p.gu_t, d_ = (unsigned long long)p.dn_t - a_; unsigned char* base_ = (unsigned char*)(a_ + (gu_ ? 0ull : d_)); const int kp_ = gu_ ? D : DE; \
          unsigned w_[4]; _Pragma("unroll") for (int i_ = 0; i_ < 4; ++i_) w_[i_] = pk4_fp8(ptile[(ch_ + 4 * i_) * 65 + cc_] * sc_, ptile[(ch_ + 4 * i_ + 1) * 65 + cc_] * sc_, ptile[(ch_ + 4 * i_ + 2) * 65 + cc_] * sc_, ptile[(ch_ + 4 * i_ + 3) * 65 + cc_] * sc_); \
          *(uint4*)(base_ + (size_t)(c0_ + cc_) * kp_ + k0_ + ch_) = make_uint4(w_[0], w_[1], w_[2], w_[3]); } } while (0)
    PREP_LOAD(0);
#pragma unroll 1
    for (int ck = 0; ck < 32; ++ck) {
        if (ck + 1 < 32) ML_LOAD(ck + 1);
        const float mprev = mp[ck]; const int c0 = ck * 64;
        bf16x8 qf[4];
#pragma unroll
        for (int ks = 0; ks < 4; ++ks) qf[ks] = *(const LAS bf16x8*)(lds + OFF_Q + (16 * tt + i16) * QP + (32 * ks + 8 * g) * 2);
        f32x4 st[4];
#pragma unroll
        for (int jt = 0; jt < 4; ++jt) { st[jt] = (f32x4){0.f, 0.f, 0.f, 0.f};
#pragma unroll
            for (int ks = 0; ks < 4; ++ks) { const bf16x8 kf = *(const LAS bf16x8*)(lds + OFF_K + (16 * jt + i16) * QP + (32 * ks + 8 * g) * 2); st[jt] = __builtin_amdgcn_mfma_f32_16x16x32_bf16(kf, qf[ks], st[jt], 0, 0, 0); } }
        const int tl = 16 * tt + i16; const float Mt = fmaxf(mprev, gam[c0 + tl]); float rs = 0.f; unsigned ap[8];
#pragma unroll
        for (int jt = 0; jt < 4; ++jt) { float v4[4]; const f32x4 ga4 = *(const LAS f32x4*)(ga + c0 + 16 * jt + 4 * g);
#pragma unroll
            for (int r = 0; r < 4; ++r) { const int j = 16 * jt + 4 * g + r; const float e = __expf(ga4[r] - Mt) * st[jt][r]; v4[r] = (j <= tl) ? e : 0.f; rs += v4[r]; }
            ap[jt * 2] = pk2(v4[0], v4[1]); ap[jt * 2 + 1] = pk2(v4[2], v4[3]); }
        rs = sum16(rs); rs = sum32(rs);
        float qn = 0.f;
#pragma unroll
        for (int ks = 0; ks < 4; ++ks) { const f32x4 n0 = *(const LAS f32x4*)(nl + 32 * ks + 8 * g), n1 = *(const LAS f32x4*)(nl + 32 * ks + 8 * g + 4);
#pragma unroll
            for (int e = 0; e < 4; ++e) { qn += bf2f((bf16_t)qf[ks][e]) * n0[e]; qn += bf2f((bf16_t)qf[ks][4 + e]) * n1[e]; } }
        qn = sum16(qn); qn = sum32(qn);
        if (vh == 0 && g == 0) { rsl[tl] = rs; qnl[tl] = qn; }
        f32x4 av[2], qc[2];
#pragma unroll
        for (int vt = 0; vt < 2; ++vt) { av[vt] = (f32x4){0.f, 0.f, 0.f, 0.f}; qc[vt] = (f32x4){0.f, 0.f, 0.f, 0.f}; }
        {   const unsigned vb = (unsigned)(unsigned long)(lds + OFF_V) + trl16 + (unsigned)(4 * g * VP + (32 * vh) * 2);
            const unsigned cb = (unsigned)(unsigned long)(lds + OFF_CB) + trl16 + (unsigned)(8 * g * VP + (32 * vh) * 2);
            s16x4 va[2][2][2], ca[4][2][2];
#pragma unroll
            for (int vt = 0; vt < 2; ++vt) {
                if (vt == 0) { va[0][0][0] = tr_read<0 * VP>(vb); va[0][0][1] = tr_read<16 * VP>(vb); va[1][0][0] = tr_read<32 * VP>(vb); va[1][0][1] = tr_read<48 * VP>(vb);
                    ca[0][0][0] = tr_read<0 * VP>(cb); ca[0][0][1] = tr_read<4 * VP>(cb); ca[1][0][0] = tr_read<32 * VP>(cb); ca[1][0][1] = tr_read<36 * VP>(cb);
                    ca[2][0][0] = tr_read<64 * VP>(cb); ca[2][0][1] = tr_read<68 * VP>(cb); ca[3][0][0] = tr_read<96 * VP>(cb); ca[3][0][1] = tr_read<100 * VP>(cb); }
                else { va[0][1][0] = tr_read<0 * VP + 32>(vb); va[0][1][1] = tr_read<16 * VP + 32>(vb); va[1][1][0] = tr_read<32 * VP + 32>(vb); va[1][1][1] = tr_read<48 * VP + 32>(vb);
                    ca[0][1][0] = tr_read<0 * VP + 32>(cb); ca[0][1][1] = tr_read<4 * VP + 32>(cb); ca[1][1][0] = tr_read<32 * VP + 32>(cb); ca[1][1][1] = tr_read<36 * VP + 32>(cb);
                    ca[2][1][0] = tr_read<64 * VP + 32>(cb); ca[2][1][1] = tr_read<68 * VP + 32>(cb); ca[3][1][0] = tr_read<96 * VP + 32>(cb); ca[3][1][1] = tr_read<100 * VP + 32>(cb); } }
            asm volatile("s_waitcnt lgkmcnt(0)" ::: "memory"); __builtin_amdgcn_sched_barrier(0);
#pragma unroll
            for (int vt = 0; vt < 2; ++vt) {
#pragma unroll
                for (int pp = 0; pp < 2; ++pp) { const bf16x8 bfv = (bf16x8){va[pp][vt][0][0], va[pp][vt][0][1], va[pp][vt][0][2], va[pp][vt][0][3], va[pp][vt][1][0], va[pp][vt][1][1], va[pp][vt][1][2], va[pp][vt][1][3]};
                    const u32x4_t aw = (u32x4_t){ap[4 * pp], ap[4 * pp + 1], ap[4 * pp + 2], ap[4 * pp + 3]};
                    av[vt] = __builtin_amdgcn_mfma_f32_16x16x32_bf16(__builtin_bit_cast(bf16x8, aw), bfv, av[vt], 0, 0, 0); }
#pragma unroll
                for (int ks = 0; ks < 4; ++ks) { const bf16x8 bfc = (bf16x8){ca[ks][vt][0][0], ca[ks][vt][0][1], ca[ks][vt][0][2], ca[ks][vt][0][3], ca[ks][vt][1][0], ca[ks][vt][1][1], ca[ks][vt][1][2], ca[ks][vt][1][3]};
                    qc[vt] = __builtin_amdgcn_mfma_f32_16x16x32_bf16(qf[ks], bfc, qc[vt], 0, 0, 0); } }
        }
        const float M63 = fmaxf(mprev, gam[c0 + 63]); const float decay = __expf(mprev - M63);
        {   const unsigned kb = (unsigned)(unsigned long)(lds + OFF_K) + trl32k + (unsigned)(8 * hi * QP + (32 * dt) * 2);
            const unsigned wb = (unsigned)(unsigned long)(lds + OFF_WV) + trl32v + (unsigned)(8 * hi * VP + (32 * vt2) * 2);
            s16x4 ka[4][2], wa[4][2];
            ka[0][0] = tr_read<0 * QP>(kb); ka[0][1] = tr_read<4 * QP>(kb); ka[1][0] = tr_read<16 * QP>(kb); ka[1][1] = tr_read<20 * QP>(kb);
            ka[2][0] = tr_read<32 * QP>(kb); ka[2][1] = tr_read<36 * QP>(kb); ka[3][0] = tr_read<48 * QP>(kb); ka[3][1] = tr_read<52 * QP>(kb);
            wa[0][0] = tr_read<0 * VP>(wb); wa[0][1] = tr_read<4 * VP>(wb); wa[1][0] = tr_read<16 * VP>(wb); wa[1][1] = tr_read<20 * VP>(wb);
            wa[2][0] = tr_read<32 * VP>(wb); wa[2][1] = tr_read<36 * VP>(wb); wa[3][0] = tr_read<48 * VP>(wb); wa[3][1] = tr_read<52 * VP>(wb);
            asm volatile("s_waitcnt lgkmcnt(0)" ::: "memory"); __builtin_amdgcn_sched_barrier(0);
#pragma unroll
            for (int e = 0; e < 16; ++e) cacc[e] *= decay;
#pragma unroll
            for (int ks = 0; ks < 4; ++ks) { const bf16x8 fa = (bf16x8){ka[ks][0][0], ka[ks][0][1], ka[ks][0][2], ka[ks][0][3], ka[ks][1][0], ka[ks][1][1], ka[ks][1][2], ka[ks][1][3]};
                const bf16x8 fb = (bf16x8){wa[ks][0][0], wa[ks][0][1], wa[ks][0][2], wa[ks][0][3], wa[ks][1][0], wa[ks][1][1], wa[ks][1][2], wa[ks][1][3]};
                cacc = __builtin_amdgcn_mfma_f32_32x32x16_bf16(fa, fb, cacc, 0, 0, 0); } }
        { const int d_ = tid & 127, part_ = tid >> 7; float acc = 0.f;
#pragma unroll
            for (int s = 0; s < 16; ++s) acc += wl[16 * part_ + s] * bf2f(*(const LAS bf16_t*)(lds + OFF_K + (16 * part_ + s) * QP + d_ * 2));
            ((LAS float*)(lds + LDS_CONST))[part_ * 128 + d_] = acc; }
        if (ck < 24) { PREP_WRITE(); if (ck + 1 < 24) PREP_LOAD(ck + 1); }
        __syncthreads();
        if (ck < 24) PREP_STORE(ck);
        { const int tr0 = 16 * tt + 4 * g;
          const f32x4 gam4 = *(const LAS f32x4*)(gam + c0 + tr0), gb4 = *(const LAS f32x4*)(gb + c0 + tr0), rs4 = *(const LAS f32x4*)(rsl + tr0), qn4 = *(const LAS f32x4*)(qnl + tr0);
          bf16_t* hp = hs_out + (size_t)(c0 + tr0) * hs_stride;
#pragma unroll
          for (int r = 0; r < 4; ++r) { const float Mr = fmaxf(mprev, gam4[r]); const float inter = __expf(mprev - Mr), mt = gb4[r] + Mr;
            const float den = rs4[r] + inter * qn4[r]; const float dd = __builtin_amdgcn_rcpf(fmaxf(fabsf(den), __expf(-mt)));
#pragma unroll
            for (int vt = 0; vt < 2; ++vt) { const float hv = (av[vt][r] + inter * qc[vt][r]) * dd; hp[(size_t)r * hs_stride + 16 * vt] = f2bf(hv); } } }
#pragma unroll
        for (int e = 0; e < 16; ++e) { const int d = 32 * dt + (e & 3) + 8 * (e >> 2) + 4 * hi; *(LAS bf16_t*)(lds + OFF_CB + d * VP + (32 * vt2 + r32) * 2) = f2bf(cacc[e]); }
        if (tid < 128) { const LAS float* np_ = (const LAS float*)(lds + LDS_CONST); nreg = decay * nreg + ((np_[tid] + np_[128 + tid]) + (np_[256 + tid] + np_[384 + tid])); nl[tid] = nreg; }
        if (ck + 1 < 32) ML_STORE(ck + 1);
        __syncthreads();
    }
#undef ML_LOAD
#undef ML_STORE
#undef PREP_LOAD
#undef PREP_WRITE
#undef PREP_STORE
}

__device__ __forceinline__ void phase_ml_gate(const Params& p, const Frame& F, unsigned char* a8) {
    const int step = F.G * 8;
#pragma unroll 1
    for (int gw = F.bid * 8 + F.wave; gw < T * 4; gw += 4 * step) { uint2 hv2[4], ov2[4];
#pragma unroll
        for (int k = 0; k < 4; ++k) { const int g_ = gw + k * step; const bf16_t* pr = p.proj + (size_t)(g_ >> 2) * 3072 + (g_ & 3) * 256 + 4 * F.lane; hv2[k] = *(const uint2*)(pr + 1024); ov2[k] = *(const uint2*)(pr + 2048); }
#pragma unroll
        for (int k = 0; k < 4; ++k) { const int g_ = gw + k * step, t = g_ >> 2, h = g_ & 3; const float4 g4 = *(const float4*)(p.ml_ng + h * 256 + 4 * F.lane);
            const float h0 = __uint_as_float(hv2[k].x << 16), h1 = __uint_as_float(hv2[k].x & 0xFFFF0000u), h2 = __uint_as_float(hv2[k].y << 16), h3 = __uint_as_float(hv2[k].y & 0xFFFF0000u);
            float ss = h0 * h0 + h1 * h1 + h2 * h2 + h3 * h3; ss = wave_sum(ss); const float rs = rsqrtf(ss * (1.f / 256.f) + 1e-6f) * F8_SA;
            *(unsigned*)(a8 + (size_t)t * D + h * 256 + 4 * F.lane) = pk4_fp8(__uint_as_float(ov2[k].x << 16) * h0 * rs * g4.x, __uint_as_float(ov2[k].x & 0xFFFF0000u) * h1 * rs * g4.y, __uint_as_float(ov2[k].y << 16) * h2 * rs * g4.z, __uint_as_float(ov2[k].y & 0xFFFF0000u) * h3 * rs * g4.w); } }
}
__device__ __forceinline__ void phase_final(const Params& p, const Frame& F, float* dst) {
    const float* mg = p.mod + (size_t)16 * 6144 + 5 * D;
    for (size_t i4 = (size_t)F.bid * NTHR + F.tid; i4 < (size_t)T * D / 4; i4 += (size_t)F.G * NTHR) { const size_t i = i4 * 4; const int col = (int)(i % D), row = (int)(i / D), b = row / S;
        const uint2 xw = *(const uint2*)(p.xb13 + i); const float4 xv = make_float4(__uint_as_float(xw.x << 16), __uint_as_float(xw.x & 0xFFFF0000u), __uint_as_float(xw.y << 16), __uint_as_float(xw.y & 0xFFFF0000u)); const float4 g = *(const float4*)(mg + b * 6144 + col); const uint2 a0 = *(const uint2*)(p.outk + i), a1 = *(const uint2*)(p.outk + (size_t)T * D + i);
        float4 o; o.x = xv.x + g.x * (__uint_as_float(a0.x << 16) + __uint_as_float(a1.x << 16)); o.y = xv.y + g.y * (__uint_as_float(a0.x & 0xFFFF0000u) + __uint_as_float(a1.x & 0xFFFF0000u));
        o.z = xv.z + g.z * (__uint_as_float(a0.y << 16) + __uint_as_float(a1.y << 16)); o.w = xv.w + g.w * (__uint_as_float(a0.y & 0xFFFF0000u) + __uint_as_float(a1.y & 0xFFFF0000u));
        *(float4*)(dst + i) = o; }
}

__global__ void __launch_bounds__(NTHR, 2) mega_fwd(Params p) {
    extern __shared__ __attribute__((aligned(16))) unsigned char lds_raw[];
    Frame F; F.lds = (LAS unsigned char*)lds_raw; F.tid = threadIdx.x; F.lane = F.tid & 63; F.wave = __builtin_amdgcn_readfirstlane(F.tid >> 6); F.bid = blockIdx.x; F.G = gridDim.x;
    volatile LAS unsigned* misc = (volatile LAS unsigned*)(F.lds + LDS_MISC);
    LAS Params* P = (LAS Params*)(F.lds + LDS_PARAMS);
    if (F.tid < 16) misc[F.tid] = 0u;
    if (F.tid == 64) {
#define X(t, n) P->n = p.n;
        PARAM_LIST(X)
#undef X
    }
    __syncthreads();
    { XcdBarrier b0 = xcd_barrier_post(uni_ptr(P->bar), misc); if (F.tid == 0) misc[2] = b0.x; }
    __syncthreads();
#define GRID_BAR() do { XcdBarrier bb_; bb_.bar = uni_ptr(P->bar); bb_.x = (unsigned)__builtin_amdgcn_readfirstlane((int)misc[2]); bb_.st = misc; xcd_barrier(bb_, F.wave == 0 && lane_id_asm() == 0); } while (0)
    LAS unsigned char* stage = F.lds;
#define MOD0 (q.mod)
#define MOD1 (q.mod + (size_t)16 * 6144)

    { Params q; LP(rope); LP(h); phase_prologue_a(q, launder(F)); }
    { Params q; LP(c); LP(ada_w); LP(ada_b); LP(mod); LP(cmp_pe); LP(cmp_w1); LP(cmp_b1); LP(cb1); phase_prologue_b(q, launder(F)); }
    { Params q; LP(nsa_w_in); LP(win_nsa_t); prep_weights<true>(launder(F), q.win_nsa_t, 2048, D, NSA_COLS, ColPlain{q.nsa_w_in, NSA_COLS, 0}, F.bid, F.G, F8_SW); }
    { Params q; LP(nsa_w_out); LP(wo_nsa_t); prep_weights<true>(launder(F), q.wo_nsa_t, D, D, D, ColPlain{q.nsa_w_out, D, 0}, F.bid, F.G, F8_SW); }
    { Params q; LP(ml_w_in); LP(win_ml_t); prep_weights<true>(launder(F), q.win_ml_t, 3072, D, ML_COLS, ColPlain{q.ml_w_in, 3072, 0}, F.bid, F.G, F8_SW); }
    { Params q; LP(ml_w_out); LP(wo_ml_t); prep_weights<true>(launder(F), q.wo_ml_t, D, D, D, ColPlain{q.ml_w_out, D, 0}, F.bid, F.G, F8_SW); }
    { Params q; LP(cmp_w1); LP(w1c_t); prep_weights(launder(F), q.w1c_t, 256, 2048, 256, ColPlain{q.cmp_w1, 256, 0}, F.bid, F.G);
      prep_weights(launder(F), q.w1c_t + (size_t)256 * 2048, 256, 2048, 256, ColPlain{q.cmp_w1 + (size_t)2048 * 256, 256, 0}, F.bid, F.G); }
    { Params q; LP(w_gate); LP(w_up); LP(w_down); LP(gu_t); LP(dn_t); prep_moe_weights(q, launder(F), 0, F.bid, F.G); }
    GRID_BAR();
    { Params q; LP(x); LP(g_mix); LP(mod); LP(h);
      phase_norm<0, false>(q, launder(F), q.x, nullptr, q.g_mix, MOD0 + 0 * D, MOD0 + 1 * D, nullptr, 0); }
    GRID_BAR();
    { Params q; LP(h); LP(win_nsa_t); LP(q_gain); LP(k_gain); LP(rope); LP(q); LP(kv); LP(gates);
      ge::DenseOrder So; So.init(T, 2048, F.G, F.bid);
      ge::gemm_phase<true>(stage, q.h, q.win_nsa_t, D, So, ge::DenseRows{(unsigned)D}, EpiNsaIn{q.q_gain, q.k_gain, q.rope, q.q, q.kv, q.gates, 1.f / (F8_SA * F8_SW)}, F.wave); }
    GRID_BAR();
    {
      Params q; LP(kv); LP(w1c_t); LP(cpart);
      const int w = F.bid >> 7, mt = (F.bid >> 3) & 15, ks = F.bid & 7; OneUnit So{mt};
      ge::gemm_phase(stage, q.kv + (size_t)w * T * 128 + ks * 256, q.w1c_t + (size_t)w * 256 * 2048 + ks * 256, 256, So, ge::DenseRows{2048u}, EpiCmpPart{q.cpart + (size_t)(w * 8 + ks) * 4096 * 256}, F.wave, 2048); }
    GRID_BAR();
    { Params q; LP(cpart); LP(cb1); LP(cmp_w2); LP(cmp_b2); LP(k_gain); LP(rope); LP(kcmp); LP(vcmp);
      phase_cmp2(q, launder(F)); }
    GRID_BAR();
    { Params q; LP(q); LP(kv); LP(kcmp); LP(vcmp); LP(gates); LP(h); LP(q_gain); LP(k_gain);
      phase_attn(q, launder(F)); }
    GRID_BAR();
    { Params q; LP(h); LP(wo_nsa_t); LP(x); LP(mod); LP(xb13);
      ge::DenseOrder So; So.init(T, D, F.G, F.bid);
      ge::gemm_phase<true>(stage, q.h, q.wo_nsa_t, D, So, ge::DenseRows{(unsigned)D}, EpiResid<false>{q.x, MOD0 + 2 * D, q.xb13, 1.f / (F8_SA * F8_SW)}, F.wave); }
    GRID_BAR();
    { Params q; LP(xb13); LP(g_ffn); LP(mod); LP(h); LP(router_w); LP(router_b); LP(tokw); LP(cnt); LP(list);
      phase_norm_route(q, launder(F), q.xb13, q.g_ffn, MOD0 + 3 * D, MOD0 + 4 * D, 0); }
    GRID_BAR();
    { Params q; LP(cnt); LP(list); LP(h); LP(gu_t); LP(hid);
      LAS int* mtab = (LAS int*)(F.lds + LDS_MISC + 64); LAS int* tkt = (LAS int*)(F.lds + LDS_CONST); moe_plan(launder(F), q.cnt, q.list, mtab, tkt, 4); MoeOrder So{mtab};
      ge::gemm_phase<true>(stage, q.h, q.gu_t, D, So, MoeRows{tkt}, EpiMoe1{(unsigned char*)q.hid, 1.f / (F8_SA * F8_SW)}, F.wave); }
    GRID_BAR();
    { Params q; LP(cnt); LP(list); LP(hid); LP(dn_t); LP(outk); LP(tokw);
      LAS int* mtab = (LAS int*)(F.lds + LDS_MISC + 64); LAS int* tkt = (LAS int*)(F.lds + LDS_CONST); LAS float* tkw = (LAS float*)(F.lds + 131072); moe_plan(launder(F), q.cnt, q.list, mtab, tkt, 4, q.tokw, tkw, 1.f / (F8_SH * F8_SW2)); MoeOrder So{mtab};
      ge::gemm_phase<true>(stage, q.hid, q.dn_t, DE, So, ge::DenseRows{(unsigned)DE}, EpiMoe2{q.outk, tkt, tkw}, F.wave); }
    GRID_BAR();
    { Params q; LP(xb13); LP(xb2); LP(g_mix); LP(mod); LP(h); LP(outk); LP(ml_w_in); LP(ml_bi); LP(ml_bf); LP(li); LP(lf);
      phase_norm<2, true>(q, launder(F), q.xb13, q.xb2, q.g_mix + D, MOD1 + 0 * D, MOD1 + 1 * D, MOD0 + 5 * D, 1); }
    GRID_BAR();
    { Params q; LP(h); LP(win_ml_t); LP(proj);
      ge::DenseOrder So; So.init(T, 3072, F.G, F.bid);
      ge::gemm_phase<true>(stage, q.h, q.win_ml_t, D, So, ge::DenseRows{(unsigned)D}, EpiMlIn{q.proj, 1.f / (F8_SA * F8_SW)}, F.wave); }
    GRID_BAR();
    { Params q; LP(proj); LP(li); LP(lf); LP(w_gate); LP(w_up); LP(w_down); LP(gu_t); LP(dn_t);
      phase_scan(q, launder(F), q.proj + 1024, 3072); }
    GRID_BAR();
    { Params q; LP(proj); LP(ml_ng); LP(h);
      phase_ml_gate(q, launder(F), (unsigned char*)q.h); }
    GRID_BAR();
    { Params q; LP(h); LP(wo_ml_t); LP(xb2); LP(mod); LP(xb13);
      ge::DenseOrder So; So.init(T, D, F.G, F.bid);
      ge::gemm_phase<true>(stage, q.h, q.wo_ml_t, D, So, ge::DenseRows{(unsigned)D}, EpiResid<true>{q.xb2, MOD1 + 2 * D, q.xb13, 1.f / (F8_SA * F8_SW)}, F.wave); }
    GRID_BAR();
    { Params q; LP(xb13); LP(g_ffn); LP(mod); LP(h); LP(router_w); LP(router_b); LP(tokw); LP(cnt); LP(list);
      phase_norm_route(q, launder(F), q.xb13, q.g_ffn + D, MOD1 + 3 * D, MOD1 + 4 * D, 1); }
    GRID_BAR();
    { Params q; LP(cnt); LP(list); LP(h); LP(gu_t); LP(hid);
      LAS int* mtab = (LAS int*)(F.lds + LDS_MISC + 64); LAS int* tkt = (LAS int*)(F.lds + LDS_CONST); moe_plan(launder(F), q.cnt + 64, q.list, mtab, tkt, 4); MoeOrder So{mtab};
      ge::gemm_phase<true>(stage, q.h, q.gu_t, D, So, MoeRows{tkt}, EpiMoe1{(unsigned char*)q.hid, 1.f / (F8_SA * F8_SW)}, F.wave); }
    GRID_BAR();
    { Params q; LP(cnt); LP(list); LP(hid); LP(dn_t); LP(outk); LP(tokw);
      LAS int* mtab = (LAS int*)(F.lds + LDS_MISC + 64); LAS int* tkt = (LAS int*)(F.lds + LDS_CONST); LAS float* tkw = (LAS float*)(F.lds + 131072); moe_plan(launder(F), q.cnt + 64, q.list, mtab, tkt, 4, q.tokw, tkw, 1.f / (F8_SH * F8_SW2)); MoeOrder So{mtab};
      ge::gemm_phase<true>(stage, q.hid, q.dn_t, DE, So, ge::DenseRows{(unsigned)DE}, EpiMoe2{q.outk, tkt, tkw}, F.wave); }
    GRID_BAR();
    { Params q; LP(mod); LP(out); LP(outk); LP(xb13);
      phase_final(q, launder(F), q.out); }
}

static inline size_t al(size_t x) { return (x + 255) & ~(size_t)255; }
extern "C" void kernel_launch(void* const* d_in, const int* in_sizes, int n_in, void* d_out, int out_size, void* d_ws, size_t ws_size, hipStream_t stream) {
    char* ws = (char*)d_ws; size_t off = 0;
    auto take = [&](size_t bytes) { size_t o = off; off = al(off + bytes); return o; };
    Params p{};
    const float** pin = (const float**)&p;
    for (int i = 0; i < 25; ++i) pin[i] = (const float*)d_in[i];
    p.out = (float*)d_out;
    const size_t ctl_bytes = (size_t)XCD_BAR_WORDS * 4 + 1024;
    p.bar = (unsigned*)(ws + take(ctl_bytes)); p.cnt = (int*)(p.bar + XCD_BAR_WORDS); p.dcnt = p.cnt + 128;
    p.mod = (float*)(ws + take((size_t)2 * 16 * 6144 * 4)); p.rope = (float*)(ws + take(2048 * 16 * 4)); p.cb1 = (float*)(ws + take(512 * 4));
    p.tokw = (float*)(ws + take((size_t)T * 2 * 4)); p.list = (int*)(ws + take((size_t)NE * T * 4)); p.dlist = (int*)(ws + take((size_t)NE * T * 4)); p.li = (float*)(ws + take((size_t)T * 4 * 4)); p.lf = (float*)(ws + take((size_t)T * 4 * 4));
    p.h = (bf16_t*)(ws + take((size_t)(T + 8) * D * 2)); p.hidc = (bf16_t*)(ws + take((size_t)2 * 4096 * 256 * 2)); p.xb13 = (bf16_t*)(ws + take((size_t)T * D * 2)); p.xb2 = (bf16_t*)(ws + take((size_t)T * D * 2));
    p.wo_nsa_t = (bf16_t*)(ws + take((size_t)D * D * 2)); p.wo_ml_t = (bf16_t*)(ws + take((size_t)D * D * 2));
    p.win_nsa_t = (bf16_t*)(ws + take((size_t)2048 * D * 2)); p.win_ml_t = (bf16_t*)(ws + take((size_t)3072 * D * 2)); p.w1c_t = (bf16_t*)(ws + take((size_t)2 * 256 * 2048 * 2));
    p.gu_t = (bf16_t*)(ws + take((size_t)NE * 1024 * D * 2)); p.dn_t = (bf16_t*)(ws + take((size_t)NE * D * DE * 2));
    const size_t r1 = off;
    p.q = (bf16_t*)(ws + take((size_t)T * D * 2)); p.kv = (bf16_t*)(ws + take((size_t)6 * T * 128 * 2 + (1 << 20)));
    p.gates = (float*)(ws + take((size_t)T * 48 * 4)); p.kcmp = (bf16_t*)(ws + take((size_t)32 * 128 * 64 * 2)); p.vcmp = (bf16_t*)(ws + take((size_t)32 * 128 * 64 * 2));
    p.cpart = (float*)(ws + take((size_t)2 * 8 * 4096 * 256 * 4));
    const size_t end_nsa = off; off = r1;
    p.proj = (bf16_t*)(ws + take((size_t)T * 3072 * 2)); const size_t end_ml = off; off = r1;
    p.hid = (bf16_t*)(ws + take((size_t)(65536 + 8192) * DE * 2)); p.outk = (bf16_t*)(ws + take((size_t)2 * T * D * 2)); const size_t end_moe = off;
    size_t need = end_nsa > end_ml ? end_nsa : end_ml; if (end_moe > need) need = end_moe;
    if (need > ws_size || n_in != 25) return;
    static bool attr_done = false;
    if (!attr_done) { (void)hipFuncSetAttribute((const void*)mega_fwd, hipFuncAttributeMaxDynamicSharedMemorySize, LDS_BYTES); attr_done = true; }
    (void)hipMemsetAsync(p.bar, 0, ctl_bytes, stream);
    hipLaunchKernelGGL(mega_fwd, dim3(NWG), dim3(NTHR), LDS_BYTES, stream, p);
}
```

```cpp
#include <hip/hip_runtime.h>
#include <stdint.h>

typedef unsigned short bf16_t;
__device__ __forceinline__ float bf2f(bf16_t v) { return __uint_as_float(((unsigned)v) << 16); }
typedef float f32x2_t __attribute__((ext_vector_type(2)));
__device__ __forceinline__ unsigned pk2g(float a, float b) { typedef __bf16 b2 __attribute__((ext_vector_type(2))); b2 r = __builtin_convertvector((f32x2_t){a, b}, b2); return __builtin_bit_cast(unsigned, r); }
__device__ __forceinline__ bf16_t f2bf(float f) { return (bf16_t)pk2g(f, f); }

constexpr int Bn = 16, S = 2048, D = 1024, T = Bn * S;
constexpr int NSA_COLS = 1840, ML_COLS = 3080;
constexpr int NE = 32, DE = 512;
constexpr int NWG = 256, NTHR = 512;

template <int M> __device__ __forceinline__ float sx(float v) { return __int_as_float(__builtin_amdgcn_ds_swizzle(__float_as_int(v), (M << 10) | 0x1F)); }
template <int M> __device__ __forceinline__ unsigned sxu(unsigned v) { return (unsigned)__builtin_amdgcn_ds_swizzle((int)v, (M << 10) | 0x1F); }
__device__ __forceinline__ float sum32(float v) { const auto r = __builtin_amdgcn_permlane32_swap(__float_as_uint(v), __float_as_uint(v), false, false); return __uint_as_float(r[0]) + __uint_as_float(r[1]); }
__device__ __forceinline__ float max32(float v) { const auto r = __builtin_amdgcn_permlane32_swap(__float_as_uint(v), __float_as_uint(v), false, false); return fmaxf(__uint_as_float(r[0]), __uint_as_float(r[1])); }
__device__ __forceinline__ float other32(float v, bool hi) { const auto r = __builtin_amdgcn_permlane32_swap(__float_as_uint(v), __float_as_uint(v), false, false); return __uint_as_float(hi ? r[0] : r[1]); }
template <int CTRL> __device__ __forceinline__ float dppf(float v) { return __int_as_float(__builtin_amdgcn_update_dpp(0, __float_as_int(v), CTRL, 0xF, 0xF, true)); }
__device__ __forceinline__ float sum16(float v) { const auto r = __builtin_amdgcn_permlane16_swap(__float_as_uint(v), __float_as_uint(v), false, false); return __uint_as_float(r[0]) + __uint_as_float(r[1]); }
__device__ __forceinline__ float max16(float v) { const auto r = __builtin_amdgcn_permlane16_swap(__float_as_uint(v), __float_as_uint(v), false, false); return fmaxf(__uint_as_float(r[0]), __uint_as_float(r[1])); }
__device__ __forceinline__ float wave_sum(float v) { v += dppf<0xB1>(v); v += dppf<0x4E>(v); v += dppf<0x141>(v); v += dppf<0x140>(v); v = sum16(v); return sum32(v); }
__device__ __forceinline__ float wave_max(float v) { v = fmaxf(v, dppf<0xB1>(v)); v = fmaxf(v, dppf<0x4E>(v)); v = fmaxf(v, dppf<0x141>(v)); v = fmaxf(v, dppf<0x140>(v)); v = max16(v); return max32(v); }
__device__ __forceinline__ float rdlane(float v, int l) { return __int_as_float(__builtin_amdgcn_readlane(__float_as_int(v), l)); }
__device__ __forceinline__ float sigmoidf_(float x) { return 1.f / (1.f + expf(-x)); }
__device__ __forceinline__ float fsigmoid(float x) { return __builtin_amdgcn_rcpf(1.f + __builtin_amdgcn_exp2f(-1.4426950408889634f * x)); }
__device__ __forceinline__ float ftanh(float x) { return 1.f - 2.f * __builtin_amdgcn_rcpf(1.f + __builtin_amdgcn_exp2f(2.8853900817779268f * x)); }

#define XB_TMO      128
#define XB_XCNT(j)  (256  + 64 * (j))
#define XB_XSUB(j)  (1280 + 64 * (j))
#define XB_XGEN(j)  (2304 + 64 * (j))
#define XB_TOP      3328
#define XB_TOPGEN   3392
#define XCD_BAR_WORDS 3456
#define XB_SPIN_CAP (1u << 18)
#define LAS __attribute__((address_space(3)))
__device__ __forceinline__ unsigned xb_ld(unsigned* p)              { return __hip_atomic_load(p, __ATOMIC_RELAXED, __HIP_MEMORY_SCOPE_AGENT); }
__device__ __forceinline__ unsigned xb_add(unsigned* p, unsigned v) { return __hip_atomic_fetch_add(p, v, __ATOMIC_RELAXED, __HIP_MEMORY_SCOPE_AGENT); }
__device__ __forceinline__ unsigned xb_xcc_id() { return (unsigned)__builtin_amdgcn_s_getreg((3 << 11) | 20) & 0xFu; }
#define XB_SPIN(cond, bar) do { unsigned _sp = 0; while (cond) { __builtin_amdgcn_s_sleep(1); \
    if ((++_sp & 255u) == 0u) { if (xb_ld(&(bar)[XB_TMO])) break; if (_sp > XB_SPIN_CAP) { atomicAdd(&(bar)[XB_TMO], 1u); break; } } } } while (0)
struct XcdBarrier { unsigned* bar; unsigned x; volatile LAS unsigned* st; };
__device__ __forceinline__ XcdBarrier xcd_barrier_post(unsigned* bar, volatile LAS unsigned* st) {
    XcdBarrier b; b.bar = bar; b.x = xb_xcc_id(); b.st = st;
    if (threadIdx.x == 0) (void)xb_add(&bar[XB_XCNT(b.x)], 1u);
    return b;
}
__device__ __forceinline__ void xcd_barrier_complete(unsigned* bar, unsigned x, unsigned& nloc, unsigned& nx) {
    const unsigned G = gridDim.x * gridDim.y * gridDim.z;
    unsigned sum, cnt, mine, sp = 0u;
    for (;;) {
        sum = 0u; cnt = 0u; mine = 0u;
#pragma unroll
        for (unsigned j = 0; j < 16; ++j) { const unsigned c = xb_ld(&bar[XB_XCNT(j)]); sum += c; cnt += (c > 0u) ? 1u : 0u; mine = (j == x) ? c : mine; }
        if (sum == G) break;
        __builtin_amdgcn_s_sleep(1);
        if ((++sp & 255u) == 0u) { if (xb_ld(&bar[XB_TMO])) break; if (sp > XB_SPIN_CAP) { atomicAdd(&bar[XB_TMO], 1u); break; } }
    }
    nloc = mine > 0u ? mine : 1u; nx = cnt > 0u ? cnt : 1u;
}
__device__ __forceinline__ void xcd_barrier(const XcdBarrier& b, const bool leader  ) {
    asm volatile("s_waitcnt vmcnt(0)" ::: "memory");
    __syncthreads();
    if (leader) {
        unsigned* bar = b.bar;
        __builtin_amdgcn_s_waitcnt(0);
        unsigned nloc = b.st[0], nx = b.st[1];
        if (nloc == 0u) { xcd_barrier_complete(bar, b.x, nloc, nx); b.st[0] = nloc; b.st[1] = nx; }
        const unsigned old = xb_add(&bar[XB_XSUB(b.x)], 1u);
        const unsigned gen = old / nloc;
        if (old + 1u == (gen + 1u) * nloc) {
            __builtin_amdgcn_fence(__ATOMIC_RELEASE, "agent");
            asm volatile("s_waitcnt vmcnt(0)" ::: "memory");
            const unsigned og = xb_add(&bar[XB_TOP], 1u);
            const unsigned tg = og / nx;
            if (og + 1u == (tg + 1u) * nx) xb_add(&bar[XB_TOPGEN], 1u);
            else XB_SPIN(xb_ld(&bar[XB_TOPGEN]) == tg, bar);
            __builtin_amdgcn_fence(__ATOMIC_ACQUIRE, "agent");
            xb_add(&bar[XB_XGEN(b.x)], 1u);
            asm volatile("s_waitcnt vmcnt(0)" ::: "memory");
        } else {
            XB_SPIN(xb_ld(&bar[XB_XGEN(b.x)]) == gen, bar);
            __builtin_amdgcn_fence(__ATOMIC_ACQUIRE, "agent");
            asm volatile("s_waitcnt vmcnt(0)" ::: "memory");
        }
    }
    __syncthreads();
}

typedef short bf16x8 __attribute__((ext_vector_type(8)));
typedef float f32x4 __attribute__((ext_vector_type(4)));
namespace ge {
constexpr int BM = 256, BK = 64, HALF = 128, HTB = HALF * BK * 2, STAGE_BYTES = 8 * HTB;
__host__ __device__ __forceinline__ int lds_byte(int r, int c) { const int st = (r >> 4) * 2 + (c >> 5), rr = r & 15, cc = c & 31, ob = rr * 64 + cc * 2; return st * 1024 + (ob ^ (((ob >> 9) & 1) << 5)); }
__host__ __device__ __forceinline__ void stage_rc(int b, int& R, int& C) { const int st = b / 1024, sb = b % 1024, swz = sb ^ (((sb >> 9) & 1) << 5); R = (st >> 1) * 16 + swz / 64; C = (st & 1) * 32 + (swz % 64) / 2; }
struct Unit { int pm, pn, bt, aux; };
__host__ __device__ __forceinline__ int logical_col(int c) { const int pn = c >> 8, bj = (c >> 7) & 1, wc = (c >> 5) & 3, n = (c >> 4) & 1, fq = (c >> 2) & 3, j = c & 3; return (4 * pn + wc) * 64 + 16 * fq + 8 * bj + 4 * n + j; }
struct DenseOrder {
    int nM, nN, nwg, G, c;
    __device__ void init(int M, int N, int G_, int c_) { nM = M / BM; nN = N / BM; nwg = nM * nN; G = G_; c = c_; }
    __device__ bool next(int i, Unit& u) const {
        const long L = (long)i * G + c; if (L >= nwg) return false;
        int wgid = (int)L; { const int q = nwg / 8, r = nwg % 8, xcd = wgid % 8, off = wgid / 8; wgid = (xcd < r ? xcd * (q + 1) : r * (q + 1) + (xcd - r) * q) + off; }
        const int nig = 8 * nN, gid = wgid / nig, fm = gid * 8, gsz = (nM - fm) < 8 ? (nM - fm) : 8;
        u.pm = fm + ((wgid % nig) % gsz); u.pn = (wgid % nig) / gsz; u.bt = u.pn; u.aux = 0; return true;
    }
};
struct DenseRows { static constexpr bool dense = true; unsigned ldab; __device__ __forceinline__ unsigned operator()(const Unit& u, int r) const { return (unsigned)(u.pm * 256 + r) * ldab; } };
template <class Tp> __device__ __forceinline__ Tp* uni(Tp* v) { const unsigned long long u = (unsigned long long)v; const unsigned lo = __builtin_amdgcn_readfirstlane((unsigned)u), hi = __builtin_amdgcn_readfirstlane((unsigned)(u >> 32)); return (Tp*)(((unsigned long long)hi << 32) | lo); }

typedef int i32x8 __attribute__((ext_vector_type(8)));
typedef int i32x4 __attribute__((ext_vector_type(4)));
template <bool F8> struct Frag;
template <> struct Frag<false> { bf16x8 v[2]; };
template <> struct Frag<true> { i32x8 v; };
template <bool F8> __device__ __forceinline__ void load_frag(Frag<F8>& f, const LAS unsigned char* p0) {
    if constexpr (F8) { const i32x4 lo = *(const LAS i32x4*)p0, hi = *(const LAS i32x4*)(p0 + 16); f.v = __builtin_shufflevector(lo, hi, 0, 1, 2, 3, 4, 5, 6, 7); }
    else { f.v[0] = *(const LAS bf16x8*)p0; f.v[1] = *(const LAS bf16x8*)(p0 + 1024); }
}
template <bool F8> __device__ __forceinline__ f32x4 mma_kt(const Frag<F8>& b, const Frag<F8>& a, f32x4 c) {
    if constexpr (F8) return __builtin_amdgcn_mfma_scale_f32_16x16x128_f8f6f4(b.v, a.v, c, 0, 0, 0, 0x7F7F7F7F, 0, 0x7F7F7F7F);
    else { c = __builtin_amdgcn_mfma_f32_16x16x32_bf16(b.v[0], a.v[0], c, 0, 0, 0); return __builtin_amdgcn_mfma_f32_16x16x32_bf16(b.v[1], a.v[1], c, 0, 0, 0); }
}
template <bool F8 = false, class Sched, class RowMap, class Epi>
__device__ __forceinline__ void gemm_phase(LAS unsigned char* lds, const void* A, const void* Bt, const int K, const Sched& S, const RowMap& RM, const Epi& E, const int wave_id, const int ldb_ = 0  ) {
    int tid_; asm volatile("v_mbcnt_lo_u32_b32 %0, -1, 0\n\tv_mbcnt_hi_u32_b32 %0, -1, %0" : "=v"(tid_)); tid_ += wave_id * 64;
    const int tid = tid_, wid = __builtin_amdgcn_readfirstlane(tid >> 6), lane = tid & 63, wr = wid >> 2, wc = wid & 3, fr = lane & 15, fq = lane >> 4;
    const int nt = K / (F8 ? 2 * BK : BK);
    constexpr bool DR = RowMap::dense;
    int sR[2], sC[2];
    const int ldb = ldb_ ? ldb_ : K;
#pragma unroll
    for (int i = 0; i < 2; ++i) stage_rc(tid * 16 + i * 8192, sR[i], sC[i]);
    const unsigned voffB = F8 ? (unsigned)(sR[0] * ldb + sC[0] * 2) : (unsigned)(sR[0] * ldb + sC[0]) * 2u;
    unsigned ldab_ = 0, voffA = 0; if constexpr (DR) { ldab_ = RM.ldab; voffA = (unsigned)sR[0] * ldab_ + (unsigned)sC[0] * 2u; }
    const size_t kstep = (size_t)(BK * 2), hstepB = (size_t)HALF * ldb * (F8 ? 1 : 2), tstepB = 2 * hstepB, qstepB = hstepB / 2;
    const unsigned ldsw = (unsigned)wid * 1024u;
    const int aoff = lds_byte(wr * 64 + fr, fq * (F8 ? 16 : 8)), boff = lds_byte(wc * 32 + fr, fq * (F8 ? 16 : 8));
    const char* Ab = (const char*)A;
#define GE_SA(b, h) (((b) * 2 + (h)) * ge::HTB)
#define GE_SB(b, h) ((4 + (b) * 2 + (h)) * ge::HTB)
#define GE_GLD(sp, vo, ldsoff) do { unsigned _v = (vo); asm volatile("" : "+v"(_v));     \
        __builtin_amdgcn_global_load_lds((const unsigned*)(uni((const char*)(sp)) + _v), (LAS unsigned*)(lds + (ldsoff)), 16, 0, 0); } while (0)
#define GE_STB(bufoff, gbase) do { _Pragma("unroll") for (int _i = 0; _i < 2; ++_i) GE_GLD((gbase) + _i * qstepB, voffB, (bufoff) + ldsw + _i * 8192); } while (0)
#define GE_STA(bufoff, sp, OFF, h) do { _Pragma("unroll") for (int _i = 0; _i < 2; ++_i) { \
        if constexpr (DR) GE_GLD((sp) + (size_t)((h) * 128 + _i * 64) * ldab_, voffA, (bufoff) + ldsw + _i * 8192); \
        else GE_GLD((sp), (OFF)[h][_i], (bufoff) + ldsw + _i * 8192); } } while (0)
#define GE_LDA(dst, b, h) do { _Pragma("unroll") for (int m = 0; m < 4; ++m) load_frag<F8>(dst[m], lds + GE_SA(b, h) + aoff + m * 2048); } while (0)
#define GE_LDB(dst, b, h) do { _Pragma("unroll") for (int n = 0; n < 2; ++n) load_frag<F8>(dst[n], lds + GE_SB(b, h) + boff + n * 2048); } while (0)
#define GE_MMA(ai, bj, At, Bt_) do { __builtin_amdgcn_s_setprio(1); _Pragma("unroll") for (int m = 0; m < 4; ++m) _Pragma("unroll") for (int n = 0; n < 2; ++n) \
        acc[ai][bj][m][n] = mma_kt<F8>(Bt_[n], At[m], acc[ai][bj][m][n]); __builtin_amdgcn_s_setprio(0); } while (0)
#define GE_WAIT_V(n) asm volatile("s_waitcnt vmcnt(" #n ")" ::: "memory")
#define GE_WAIT_L(n) asm volatile("s_waitcnt lgkmcnt(" #n ")" ::: "memory")
#define GE_BAR __builtin_amdgcn_s_barrier()
#define GE_SCHED __builtin_amdgcn_sched_barrier(0)
#define GE_OFFS(OFF, u) do { int _l; asm volatile("v_mbcnt_lo_u32_b32 %0, -1, 0\n\tv_mbcnt_hi_u32_b32 %0, -1, %0" : "=v"(_l)); int _r0, _c0; stage_rc((wave_id * 64 + _l) * 16, _r0, _c0);     \
        _Pragma("unroll") for (int _h = 0; _h < 2; ++_h) _Pragma("unroll") for (int _i = 0; _i < 2; ++_i) (OFF)[_h][_i] = RM((u), _h * 128 + _i * 64 + _r0) + (unsigned)_c0 * 2u; \
        asm volatile("" : "+v"((OFF)[0][0]), "+v"((OFF)[0][1]), "+v"((OFF)[1][0]), "+v"((OFF)[1][1])); } while (0)
    Unit cur, nxt; int ui = 0;
    if (!S.next(0, cur)) return;
    unsigned offC[2][2];
    const char* aC = Ab; const char* aN = Ab;
    if constexpr (DR) aC = Ab + (size_t)cur.pm * 256 * ldab_; else GE_OFFS(offC, cur);
    f32x4 acc[2][2][4][2];
#pragma unroll
    for (int a = 0; a < 2; ++a)
#pragma unroll
        for (int b = 0; b < 2; ++b)
#pragma unroll
            for (int m = 0; m < 4; ++m)
#pragma unroll
                for (int n = 0; n < 2; ++n) acc[a][b][m][n] = (f32x4){0.f, 0.f, 0.f, 0.f};
    Frag<F8> At[4], B0[2], B1[2];
    const char* cB = (const char*)Bt + (size_t)cur.bt * tstepB;
    GE_STB(GE_SB(0, 0), cB); GE_STA(GE_SA(0, 0), aC, offC, 0); GE_STB(GE_SB(0, 1), cB + hstepB); GE_STA(GE_SA(0, 1), aC, offC, 1);
    if (wr == 1) GE_BAR;
    GE_WAIT_V(4); GE_BAR;
    GE_STB(GE_SB(1, 0), cB + kstep); GE_STA(GE_SA(1, 0), aC + kstep, offC, 0); GE_STB(GE_SB(1, 1), cB + hstepB + kstep);
    GE_WAIT_V(6); GE_BAR;
    for (;;) {
        const bool has_next = S.next(ui + 1, nxt);
        if constexpr (DR) aN = has_next ? Ab + (size_t)nxt.pm * 256 * ldab_ : aC;
        const char* nB = has_next ? (const char*)Bt + (size_t)nxt.bt * tstepB : cB;
#pragma unroll 1
        for (int t = 0; t < nt; t += 2) {
            const bool last = (t == nt - 2);
            const size_t k1 = (size_t)(t + 1) * kstep;
            const size_t k2 = last ? 0 : (size_t)(t + 2) * kstep, k3 = k2 + kstep;
            const char* b2 = last ? nB : cB + (size_t)(t + 2) * kstep; const char* b3 = b2 + kstep;
            const char* a2 = last ? aN : aC;
            GE_LDB(B0, 0, 0); GE_SCHED; GE_LDA(At, 0, 0); GE_STA(GE_SA(1, 1), aC + k1, offC, 1);
            GE_WAIT_L(8); GE_BAR; GE_WAIT_L(0); GE_MMA(0, 0, At, B0); GE_BAR; GE_SCHED;
            GE_LDB(B1, 0, 1); GE_STB(GE_SB(0, 0), b2);
            GE_BAR; GE_WAIT_L(0); GE_MMA(0, 1, At, B1); GE_BAR;
            GE_LDA(At, 0, 1);
            if constexpr (!DR) { if (last && has_next) GE_OFFS(offC, nxt); }
            GE_STA(GE_SA(0, 0), a2 + k2, offC, 0);
            GE_BAR; GE_WAIT_L(0); GE_MMA(1, 0, At, B0); GE_BAR; GE_SCHED;
            GE_STB(GE_SB(0, 1), b2 + hstepB);
            GE_WAIT_V(6); GE_BAR; GE_MMA(1, 1, At, B1); GE_BAR;
            GE_LDB(B0, 1, 0); GE_SCHED; GE_LDA(At, 1, 0); GE_STA(GE_SA(0, 1), a2 + k2, offC, 1);
            GE_WAIT_L(8); GE_BAR; GE_WAIT_L(0); GE_MMA(0, 0, At, B0); GE_BAR; GE_SCHED;
            GE_LDB(B1, 1, 1); GE_STB(GE_SB(1, 0), b3);
            GE_BAR; GE_WAIT_L(0); GE_MMA(0, 1, At, B1); GE_BAR;
            GE_LDA(At, 1, 1); GE_STA(GE_SA(1, 0), a2 + k3, offC, 0);
            GE_BAR; GE_WAIT_L(0); GE_MMA(1, 0, At, B0); GE_BAR; GE_SCHED;
            GE_STB(GE_SB(1, 1), b3 + hstepB);
            GE_WAIT_V(6); GE_BAR; GE_MMA(1, 1, At, B1); GE_BAR;
        }
#pragma unroll
        for (int a = 0; a < 2; ++a)
#pragma unroll
            for (int b = 0; b < 2; ++b) asm volatile("" : "+v"(acc[a][b][0][0]), "+v"(acc[a][b][0][1]), "+v"(acc[a][b][1][0]), "+v"(acc[a][b][1][1]), "+v"(acc[a][b][2][0]), "+v"(acc[a][b][2][1]), "+v"(acc[a][b][3][0]), "+v"(acc[a][b][3][1]));
        { int l2; asm volatile("v_mbcnt_lo_u32_b32 %0, -1, 0\n\tv_mbcnt_hi_u32_b32 %0, -1, %0" : "=v"(l2)); E(acc, cur, wr, wc, l2 & 15, l2 >> 4); }
        if (!has_next) break;
#pragma unroll
        for (int a = 0; a < 2; ++a)
#pragma unroll
            for (int b = 0; b < 2; ++b)
#pragma unroll
                for (int m = 0; m < 4; ++m)
#pragma unroll
                    for (int n = 0; n < 2; ++n) acc[a][b][m][n] = (f32x4){0.f, 0.f, 0.f, 0.f};
        cur = nxt; cB = nB; aC = aN; ++ui;
    }
    GE_WAIT_V(0);
    if (wr == 0) GE_BAR;
    GE_BAR;
}
#define GE_VALS(v, acc, ai, m) do { _Pragma("unroll") for (int _b = 0; _b < 2; ++_b) _Pragma("unroll") for (int _n = 0; _n < 2; ++_n) _Pragma("unroll") for (int _j = 0; _j < 4; ++_j) (v)[8 * _b + 4 * _n + _j] = (acc)[ai][_b][m][_n][_j]; } while (0)
}
__device__ __forceinline__ void store16_bf16(bf16_t* dst, const float (&v)[16]) {
    unsigned w[8];
#pragma unroll
    for (int i = 0; i < 8; ++i) w[i] = pk2g(v[2 * i], v[2 * i + 1]);
    uint4* d4 = (uint4*)dst; d4[0] = make_uint4(w[0], w[1], w[2], w[3]); d4[1] = make_uint4(w[4], w[5], w[6], w[7]);
}
template <bool IN_BF16>
struct EpiResid { const void* xin; const float* mod_g; bf16_t* xout; float inscale;
    __device__ __forceinline__ void operator()(const f32x4 (&acc)[2][2][4][2], const ge::Unit& u, int wr, int wc, int fr, int fq) const {
        const int col0 = (4 * u.pn + wc) * 64 + 16 * fq; const int b = (u.pm * 256) / S;
        float4 gq[4];
#pragma unroll
        for (int q4 = 0; q4 < 4; ++q4) { gq[q4] = *(const float4*)(mod_g + b * 6144 + col0 + 4 * q4); gq[q4].x *= inscale; gq[q4].y *= inscale; gq[q4].z *= inscale; gq[q4].w *= inscale; }
        if constexpr (IN_BF16) {
            uint4 xh[2][4][2];
#pragma unroll
            for (int ai = 0; ai < 2; ++ai)
#pragma unroll
                for (int m = 0; m < 4; ++m) { const size_t o = (size_t)(u.pm * 256 + ai * 128 + wr * 64 + m * 16 + fr) * D + col0; xh[ai][m][0] = *(const uint4*)((const bf16_t*)xin + o); xh[ai][m][1] = *(const uint4*)((const bf16_t*)xin + o + 8); }
            const float g16[16] = {gq[0].x, gq[0].y, gq[0].z, gq[0].w, gq[1].x, gq[1].y, gq[1].z, gq[1].w, gq[2].x, gq[2].y, gq[2].z, gq[2].w, gq[3].x, gq[3].y, gq[3].z, gq[3].w};
#pragma unroll
            for (int ai = 0; ai < 2; ++ai)
#pragma unroll
                for (int m = 0; m < 4; ++m) { float v[16]; GE_VALS(v, acc, ai, m);
                    const unsigned w8[8] = {xh[ai][m][0].x, xh[ai][m][0].y, xh[ai][m][0].z, xh[ai][m][0].w, xh[ai][m][1].x, xh[ai][m][1].y, xh[ai][m][1].z, xh[ai][m][1].w};
#pragma unroll
                    for (int k = 0; k < 8; ++k) { v[2 * k] = __uint_as_float(w8[k] << 16) + g16[2 * k] * v[2 * k]; v[2 * k + 1] = __uint_as_float(w8[k] & 0xFFFF0000u) + g16[2 * k + 1] * v[2 * k + 1]; }
                    store16_bf16(xout + (size_t)(u.pm * 256 + ai * 128 + wr * 64 + m * 16 + fr) * D + col0, v); }
        } else {
#pragma unroll
        for (int ai = 0; ai < 2; ++ai) { float4 xv[4][4];
#pragma unroll
            for (int m = 0; m < 4; ++m) { const size_t o = (size_t)(u.pm * 256 + ai * 128 + wr * 64 + m * 16 + fr) * D + col0;
#pragma unroll
                for (int q4 = 0; q4 < 4; ++q4) xv[m][q4] = *(const float4*)((const float*)xin + o + 4 * q4); }
#pragma unroll
            for (int m = 0; m < 4; ++m) { float v[16]; GE_VALS(v, acc, ai, m); float xr[16];
#pragma unroll
                for (int q4 = 0; q4 < 4; ++q4) { xr[4 * q4] = xv[m][q4].x; xr[4 * q4 + 1] = xv[m][q4].y; xr[4 * q4 + 2] = xv[m][q4].z; xr[4 * q4 + 3] = xv[m][q4].w; }
                const float g16[16] = {gq[0].x, gq[0].y, gq[0].z, gq[0].w, gq[1].x, gq[1].y, gq[1].z, gq[1].w, gq[2].x, gq[2].y, gq[2].z, gq[2].w, gq[3].x, gq[3].y, gq[3].z, gq[3].w};
#pragma unroll
                for (int k = 0; k < 16; ++k) v[k] = xr[k] + g16[k] * v[k];
                store16_bf16(xout + (size_t)(u.pm * 256 + ai * 128 + wr * 64 + m * 16 + fr) * D + col0, v); } }
        }
    } };
struct EpiNsaIn { const float* q_gain; const float* k_gain; const float* rope; bf16_t* q; bf16_t* kv; float* gates; float inscale;
    __device__ __forceinline__ void operator()(const f32x4 (&acc)[2][2][4][2], const ge::Unit& u, int wr, int wc, int fr, int fq) const {
        const int slot = 4 * u.pn + wc; if (slot > 28) return;
        const bool normed = (slot < 16) || slot == 20 || slot == 21 || slot == 24 || slot == 25;
        const float* gain = (slot < 16) ? q_gain : ((slot < 22) ? k_gain + 64 : k_gain + 128);
        float gv[16];
        if (normed) {
#pragma unroll
            for (int i = 0; i < 16; ++i) gv[i] = gain[16 * fq + i]; }
#pragma unroll
        for (int ai = 0; ai < 2; ++ai)
#pragma unroll
            for (int m = 0; m < 4; ++m) { const int row = u.pm * 256 + ai * 128 + wr * 64 + m * 16 + fr; const int b = row / S, s = row % S; float v[16]; GE_VALS(v, acc, ai, m);
#pragma unroll
                for (int i = 0; i < 16; ++i) v[i] *= inscale;
                if (slot == 28) { if (fq < 3) { float* gp = gates + (size_t)row * 48 + 16 * fq;
#pragma unroll
                        for (int q4 = 0; q4 < 4; ++q4) *(float4*)(gp + 4 * q4) = make_float4(fsigmoid(v[4 * q4]), fsigmoid(v[4 * q4 + 1]), fsigmoid(v[4 * q4 + 2]), fsigmoid(v[4 * q4 + 3])); }
                    continue; }
                if (normed) { float ss = 0.f;
#pragma unroll
                    for (int i = 0; i < 16; ++i) ss += v[i] * v[i];
                    ss = sum16(ss); ss = sum32(ss); const float r = rsqrtf(ss * (1.f / 64.f) + 1e-6f);
#pragma unroll
                    for (int i = 0; i < 16; ++i) v[i] *= r * gv[i];
                    if (fq == 0) { const float sf = (float)s;
                        constexpr float IFR[8] = {0.15915494309189535f, 0.030863763158420102f, 0.00598518567638293f, 0.001160663620968869f, 0.00022507907904105153f, 4.364795481173399e-05f, 8.464330549652592e-06f, 1.6414262419538367e-06f};
#pragma unroll
                        for (int i = 0; i < 8; ++i) { const float rev = __builtin_amdgcn_fractf(sf * IFR[i]); const float cs = __builtin_amdgcn_cosf(rev), sn = __builtin_amdgcn_sinf(rev), a = v[i], bb = v[i + 8]; v[i] = a * cs - bb * sn; v[i + 8] = bb * cs + a * sn; } } }
                bf16_t* dst;
                if (slot < 16) dst = q + (size_t)row * D + slot * 64 + 16 * fq;
                else { const int kk = slot - 16, ten = kk >> 1, g = kk & 1; dst = kv + (size_t)ten * T * 128 + ((size_t)(b * 2 + g) * S + s) * 64 + 16 * fq; }
                store16_bf16(dst, v); }
    } };
struct EpiMlIn { bf16_t* proj; float inscale;
    __device__ __forceinline__ void operator()(const f32x4 (&acc)[2][2][4][2], const ge::Unit& u, int wr, int wc, int fr, int fq) const {
        const int slot = 4 * u.pn + wc; const int L0 = slot * 64 + 16 * fq;
#pragma unroll
        for (int ai = 0; ai < 2; ++ai)
#pragma unroll
            for (int m = 0; m < 4; ++m) { const int row = u.pm * 256 + ai * 128 + wr * 64 + m * 16 + fr; float v[16]; GE_VALS(v, acc, ai, m);
                { const float sc = (slot >= 8 && slot < 16) ? 0.08838834764831845f * inscale : inscale;
#pragma unroll
                    for (int i = 0; i < 16; ++i) v[i] *= sc; }
                if (slot >= 32) {
#pragma unroll
                    for (int i = 0; i < 16; ++i) v[i] = fsigmoid(v[i]); }
                store16_bf16(proj + (size_t)row * 3072 + L0, v); }
    } };
struct OneUnit { int pm; __device__ bool next(int i, ge::Unit& u) const { if (i) return false; u.pm = pm; u.pn = 0; u.bt = 0; u.aux = 0; return true; } };
struct EpiCmpPart { float* part;
    __device__ __forceinline__ void operator()(const f32x4 (&acc)[2][2][4][2], const ge::Unit& u, int wr, int wc, int fr, int fq) const {
        const int L0 = (4 * u.pn + wc) * 64 + 16 * fq;
#pragma unroll
        for (int ai = 0; ai < 2; ++ai)
#pragma unroll
            for (int m = 0; m < 4; ++m) { const int row = u.pm * 256 + ai * 128 + wr * 64 + m * 16 + fr; float v[16]; GE_VALS(v, acc, ai, m); float* op = part + (size_t)row * 256 + L0;
#pragma unroll
                for (int q4 = 0; q4 < 4; ++q4) *(float4*)(op + 4 * q4) = make_float4(v[4 * q4], v[4 * q4 + 1], v[4 * q4 + 2], v[4 * q4 + 3]); }
    } };
struct EpiCmp1 { const float* cb1; bf16_t* hid;
    __device__ __forceinline__ void operator()(const f32x4 (&acc)[2][2][4][2], const ge::Unit& u, int wr, int wc, int fr, int fq) const {
        const int L0 = (4 * u.pn + wc) * 64 + 16 * fq; float bv[16];
#pragma unroll
        for (int i = 0; i < 16; ++i) bv[i] = cb1[L0 + i];
#pragma unroll
        for (int ai = 0; ai < 2; ++ai)
#pragma unroll
            for (int m = 0; m < 4; ++m) { const int row = u.pm * 256 + ai * 128 + wr * 64 + m * 16 + fr; float v[16]; GE_VALS(v, acc, ai, m);
#pragma unroll
                for (int i = 0; i < 16; ++i) { const float x = v[i] + bv[i]; v[i] = 0.5f * x * (1.f + ftanh(0.7978845608028654f * (x + 0.044715f * x * x * x))); }
                store16_bf16(hid + (size_t)row * 256 + L0, v); }
    } };

#define PARAM_LIST(X) \
    X(const float*, x) X(const float*, c) X(const float*, ada_w) X(const float*, ada_b) X(const float*, g_mix) X(const float*, g_ffn) X(const float*, nsa_w_in) X(const float*, nsa_w_out) \
    X(const float*, q_gain) X(const float*, k_gain) X(const float*, cmp_pe) X(const float*, cmp_w1) X(const float*, cmp_b1) X(const float*, cmp_w2) X(const float*, cmp_b2) \
    X(const float*, ml_w_in) X(const float*, ml_bi) X(const float*, ml_bf) X(const float*, ml_ng) X(const float*, ml_w_out) X(const float*, router_w) X(const float*, router_b) \
    X(const float*, w_gate) X(const float*, w_up) X(const float*, w_down) \
    X(float*, out) X(unsigned*, bar) X(int*, cnt) X(float*, mod) X(float*, rope) X(float*, cb1) X(float*, tokw) X(int*, list) X(float*, li) X(float*, lf) \
    X(bf16_t*, h) X(bf16_t*, hidc) X(bf16_t*, xb13) X(bf16_t*, xb2) X(bf16_t*, wo_nsa_t) X(bf16_t*, wo_ml_t) X(bf16_t*, win_nsa_t) X(bf16_t*, win_ml_t) X(bf16_t*, w1c_t) X(bf16_t*, gu_t) X(bf16_t*, dn_t) \
    X(bf16_t*, q) X(bf16_t*, kv) X(float*, gates) X(bf16_t*, kcmp) X(bf16_t*, vcmp) X(bf16_t*, proj) X(bf16_t*, hid) X(bf16_t*, outk) X(int*, dcnt) X(int*, dlist) X(float*, cpart)
struct Params {
#define X(t, n) t n;
    PARAM_LIST(X)
#undef X
};
template <class Tp> __device__ __forceinline__ Tp* uni_ptr(Tp* v) { const unsigned long long u = (unsigned long long)v; const unsigned lo = __builtin_amdgcn_readfirstlane((unsigned)u), hi = __builtin_amdgcn_readfirstlane((unsigned)(u >> 32)); typedef Tp __attribute__((address_space(1))) * GP; return (Tp*)(GP)(((unsigned long long)hi << 32) | lo); }
#define LP(n) q.n = uni_ptr(P->n)
struct Frame { LAS unsigned char* lds; int tid, lane, wave, bid, G; };
__device__ __forceinline__ int lane_id_asm() { int l; asm volatile("v_mbcnt_lo_u32_b32 %0, -1, 0\n\tv_mbcnt_hi_u32_b32 %0, -1, %0" : "=v"(l)); return l; }
__device__ __forceinline__ Frame launder(const Frame& F) { Frame R = F; const int l = lane_id_asm(); int wv = F.wave, bd = F.bid; asm volatile("" : "+s"(wv), "+s"(bd)); R.wave = wv; R.bid = bd; R.tid = wv * 64 + l; R.lane = l; return R; }
constexpr int LDS_GEN = 143872;
constexpr int LDS_MISC = LDS_GEN;
constexpr int LDS_PARAMS = LDS_GEN + 4096;
constexpr int LDS_CONST = LDS_GEN + 6144;
constexpr int LDS_BYTES = LDS_GEN + 18432;

__device__ __forceinline__ unsigned pk4_fp8(float a, float b, float c, float d) { int w = 0;
    w = __builtin_amdgcn_cvt_pk_fp8_f32(__builtin_amdgcn_fmed3f(a, -448.f, 448.f), __builtin_amdgcn_fmed3f(b, -448.f, 448.f), w, false);
    w = __builtin_amdgcn_cvt_pk_fp8_f32(__builtin_amdgcn_fmed3f(c, -448.f, 448.f), __builtin_amdgcn_fmed3f(d, -448.f, 448.f), w, true); return (unsigned)w; }
constexpr float F8_SA = 8.f, F8_SW = 32.f, F8_SH = 4.f, F8_SW2 = 32.f;
template <int NB>
__device__ __forceinline__ void colgemv(const Frame& F, const LAS float* vec, LAS float* part, const float* W, int ldw, int K, int n0, const float* bias, float* out, int out_stride) {
    const int kper = K / 8, kb = F.wave * kper, c4 = F.lane & 15, kq = F.lane >> 4; float acc[NB][4];
#pragma unroll
    for (int b = 0; b < NB; ++b)
#pragma unroll
        for (int j = 0; j < 4; ++j) acc[b][j] = 0.f;
    const float* wp = W + (size_t)(kb + kq) * ldw + n0 + 4 * c4;
#pragma unroll 4
    for (int k = 0; k < kper; k += 4) { const float4 wv = *(const float4*)(wp + (size_t)k * ldw);
#pragma unroll
        for (int b = 0; b < NB; ++b) { const float x = vec[(kb + k + kq) * NB + b]; acc[b][0] += x * wv.x; acc[b][1] += x * wv.y; acc[b][2] += x * wv.z; acc[b][3] += x * wv.w; } }
#pragma unroll
    for (int b = 0; b < NB; ++b)
#pragma unroll
        for (int j = 0; j < 4; ++j) { const float t = sum32(sum16(acc[b][j])); if (kq == 0) part[(F.wave * NB + b) * 64 + 4 * c4 + j] = t; }
    __syncthreads();
    for (int idx = F.tid; idx < NB * 64; idx += NTHR) { const int b = idx >> 6, l = idx & 63; float s = bias[n0 + l];
#pragma unroll
        for (int w = 0; w < 8; ++w) s += part[(w * NB + b) * 64 + l];
        out[(size_t)b * out_stride + n0 + l] = s; }
    __syncthreads();
}
struct ColPlain { const float* W; int ncols; int pad; __device__ const float* operator()(int c) const { const int L = ge::logical_col(c); return L < ncols ? W + L : nullptr; } };
struct ColGateUp { const float* wg; const float* wu; __device__ const float* operator()(int c) const { const int e = c >> 10, cc = c & 1023; const int pn = cc >> 8, bj = (cc >> 7) & 1, wc = (cc >> 5) & 3, n = (cc >> 4) & 1, fq = (cc >> 2) & 3, j = cc & 3;
        const int hidx = 32 * (4 * pn + wc) + 8 * fq + 4 * n + j; const unsigned long long a = (unsigned long long)wg, d = (unsigned long long)wu - a;
        return (const float*)(a + (bj ? d : 0ull)) + (size_t)e * D * DE + hidx; } };
struct ColDown { const float* wd; __device__ const float* operator()(int c) const { const int e = c >> 10; return wd + (size_t)e * DE * D + ge::logical_col(c & 1023); } };
template <bool F8 = false, class ColF>
__device__ __forceinline__ void prep_weights(const Frame& F, void* Bt_, int N, int K, int ldw, const ColF cf, int start, int stride, const float wscale = 1.f) {
    bf16_t* Bt = (bf16_t*)Bt_;
    LAS float* tile = (LAS float*)(F.lds) + (F.tid >> 8) * (128 * 65);
    const int ntx = N / 64, ntiles = ntx * (K / 128), htid = F.tid & 255, half = F.tid >> 8;
    float r[32];
#define PW_LOAD(it_) do { const int tl_ = (it_) * 2 + half; if (tl_ < ntiles) { const int c0_ = (tl_ % ntx) * 64, k0_ = (tl_ / ntx) * 128; const float* p_ = cf(c0_ + (htid & 63)); \
        if (p_) { p_ += (size_t)(k0_ + (htid >> 6)) * ldw; _Pragma("unroll") for (int i_ = 0; i_ < 32; ++i_) r[i_] = p_[(size_t)(4 * i_) * ldw]; } \
        else { _Pragma("unroll") for (int i_ = 0; i_ < 32; ++i_) r[i_] = 0.f; } } } while (0)
    int it = start;
    if (it * 2 < ntiles) PW_LOAD(it);
    for (; it * 2 < ntiles; it += stride) {
        const int tl = it * 2 + half; const bool act = tl < ntiles; const int c0 = (tl % ntx) * 64, k0 = (tl / ntx) * 128;
        if (act) { const int cc = htid & 63;
#pragma unroll
            for (int i = 0; i < 32; ++i) tile[((htid >> 6) + 4 * i) * 65 + cc] = r[i]; }
        __syncthreads();
        if ((it + stride) * 2 < ntiles) PW_LOAD(it + stride);
        if (act) { const int cc = htid >> 2, ch = (htid & 3) * 32;
            if (F8) { unsigned w[8];
#pragma unroll
                for (int i = 0; i < 8; ++i) w[i] = pk4_fp8(tile[(ch + 4 * i) * 65 + cc] * wscale, tile[(ch + 4 * i + 1) * 65 + cc] * wscale, tile[(ch + 4 * i + 2) * 65 + cc] * wscale, tile[(ch + 4 * i + 3) * 65 + cc] * wscale);
                uint4* dst = (uint4*)((unsigned char*)Bt_ + (size_t)(c0 + cc) * K + k0 + ch); dst[0] = make_uint4(w[0], w[1], w[2], w[3]); dst[1] = make_uint4(w[4], w[5], w[6], w[7]); }
            else { unsigned w[16];
#pragma unroll
                for (int i = 0; i < 16; ++i) w[i] = pk2g(tile[(ch + 2 * i) * 65 + cc], tile[(ch + 2 * i + 1) * 65 + cc]);
                uint4* dst = (uint4*)(Bt + (size_t)(c0 + cc) * K + k0 + ch);
#pragma unroll
                for (int q4 = 0; q4 < 4; ++q4) dst[q4] = make_uint4(w[4 * q4], w[4 * q4 + 1], w[4 * q4 + 2], w[4 * q4 + 3]); } }
        __syncthreads();
    }
#undef PW_LOAD
}
__device__ __forceinline__ void prep_moe_weights(const Params& p, const Frame& F, int layer, int start, int stride) {
    const size_t wo = (size_t)layer * NE * D * DE;
    prep_weights<true>(F, p.gu_t, NE * 1024, D, DE, ColGateUp{p.w_gate + wo, p.w_up + wo}, start, stride, F8_SW);
    prep_weights<true>(F, p.dn_t, NE * 1024, DE, D, ColDown{p.w_down + wo}, start, stride, F8_SW2);
}

__device__ __forceinline__ void phase_prologue_a(const Params& p, const Frame& F) {
    for (int i = (F.bid - 200) * NTHR + F.tid; F.bid >= 200 && i < 2048 * 8; i += (F.G - 200) * NTHR) { const int pos = i >> 3, j = i & 7; const float inv = (float)pow(500000.0, -(double)j / 8.0); const float ang = (float)pos * inv;
        p.rope[pos * 16 + j] = (float)cos((double)ang); p.rope[pos * 16 + 8 + j] = (float)sin((double)ang); }
    if (F.bid == F.G - 1) for (int i = F.tid; i < 8 * D / 2; i += NTHR) ((unsigned*)(p.h + (size_t)T * D))[i] = 0u;
}
__device__ __forceinline__ void phase_prologue_b(const Params& p, const Frame& F) {
    LAS float* vec = (LAS float*)F.lds; LAS float* part = (LAS float*)(F.lds + 65536 + 16384);
    if (F.bid < 192) {
        for (int idx = F.tid; idx < 16 * D; idx += NTHR) { const int b = idx >> 10, k = idx & 1023; const float cv = p.c[idx]; vec[k * 16 + b] = cv / (1.f + expf(-cv)); }
        __syncthreads();
        const int i = F.bid / 96, n0 = (F.bid % 96) * 64;
        colgemv<16>(F, vec, part, p.ada_w + (size_t)i * D * 6144, 6144, D, n0, p.ada_b + i * 6144, p.mod + (size_t)i * 16 * 6144, 6144);
    } else if (F.bid < 200) {
        const int it = F.bid - 192, w = it >> 2, n0 = (it & 3) * 64;
        for (int idx = F.tid; idx < 2048; idx += NTHR) vec[idx] = p.cmp_pe[w * 2048 + idx];
        __syncthreads();
        colgemv<1>(F, vec, part, p.cmp_w1 + (size_t)w * 2048 * 256, 256, 2048, n0, p.cmp_b1 + w * 256, p.cb1 + w * 256, 0);
    }
    __syncthreads();
}

template <int MODE, bool XBF>
__device__ __forceinline__ void phase_norm(const Params& p, const Frame& F, const void* xin_, bf16_t* xout, const float* gain, const float* mod_sh, const float* mod_sc, const float* mod_gprev, int layer) {
    constexpr int rows_per_wg = T / NWG, rpw = rows_per_wg / 8;
    constexpr int TP = (MODE == 1) ? 34 : 10;
    const int row0 = F.bid * rows_per_wg;
    LAS float* rw = (LAS float*)F.lds;
    LAS int* lcnt = (LAS int*)(F.lds + LDS_MISC + 64); LAS int* gbase = lcnt + 32; LAS int* ent = gbase + 32;
    if (MODE == 1) { for (int idx = F.tid; idx < D * NE; idx += NTHR) { const int c = idx >> 5; rw[((c & 3) * 256 + (c >> 2)) * TP + (idx & 31)] = p.router_w[idx]; } if (F.tid < 32) lcnt[F.tid] = 0; }
    if (MODE == 2) { for (int idx = F.tid; idx < D * 8; idx += NTHR) { const int c = idx >> 3; rw[((c & 3) * 256 + (c >> 2)) * TP + (idx & 7)] = p.ml_w_in[(size_t)c * ML_COLS + 3072 + (idx & 7)]; } }
    const int b = row0 / S;
    LAS float* cg = (LAS float*)(F.lds + LDS_CONST); LAS float* csh = cg + D; LAS float* cgp = csh + D;
    for (int col = F.tid; col < D; col += NTHR) { cg[col] = gain[col] * (1.f + mod_sc[b * 6144 + col]); csh[col] = mod_sh[b * 6144 + col]; if (MODE == 2) cgp[col] = mod_gprev[b * 6144 + col]; }
    __syncthreads();
    const int rbase = row0 + F.wave * rpw;
    float4 xn[4]; uint2 on0[4], on1[4];
#define NORM_LOAD(r_) do { if (XBF) { const bf16_t* xr_ = (const bf16_t*)xin_ + (size_t)(r_) * D + 4 * F.lane; _Pragma("unroll") for (int j_ = 0; j_ < 4; ++j_) { const uint2 t_ = *(const uint2*)(xr_ + 256 * j_); \
            xn[j_] = make_float4(__uint_as_float(t_.x << 16), __uint_as_float(t_.x & 0xFFFF0000u), __uint_as_float(t_.y << 16), __uint_as_float(t_.y & 0xFFFF0000u)); } } \
        else { const float* xr_ = (const float*)xin_ + (size_t)(r_) * D + 4 * F.lane; _Pragma("unroll") for (int j_ = 0; j_ < 4; ++j_) xn[j_] = *(const float4*)(xr_ + 256 * j_); } \
        if (MODE == 2) { const bf16_t* o0_ = p.outk + (size_t)(r_) * D + 4 * F.lane; _Pragma("unroll") for (int j_ = 0; j_ < 4; ++j_) { on0[j_] = *(const uint2*)(o0_ + 256 * j_); on1[j_] = *(const uint2*)(o0_ + (size_t)T * D + 256 * j_); } } } while (0)
    NORM_LOAD(rbase);
#pragma unroll 1
    for (int ri = 0; ri < rpw; ++ri) {
        const int row = rbase + ri; float v[16];
#pragma unroll
        for (int j = 0; j < 4; ++j) { v[4 * j] = xn[j].x; v[4 * j + 1] = xn[j].y; v[4 * j + 2] = xn[j].z; v[4 * j + 3] = xn[j].w; }
        if (MODE == 2) {
#pragma unroll
            for (int j = 0; j < 4; ++j) { const f32x4 gq = *(const LAS f32x4*)(cgp + 4 * F.lane + 256 * j);
                v[4 * j] += gq[0] * (__uint_as_float(on0[j].x << 16) + __uint_as_float(on1[j].x << 16)); v[4 * j + 1] += gq[1] * (__uint_as_float(on0[j].x & 0xFFFF0000u) + __uint_as_float(on1[j].x & 0xFFFF0000u));
                v[4 * j + 2] += gq[2] * (__uint_as_float(on0[j].y << 16) + __uint_as_float(on1[j].y << 16)); v[4 * j + 3] += gq[3] * (__uint_as_float(on0[j].y & 0xFFFF0000u) + __uint_as_float(on1[j].y & 0xFFFF0000u));
                uint2 xo_; xo_.x = pk2g(v[4 * j], v[4 * j + 1]); xo_.y = pk2g(v[4 * j + 2], v[4 * j + 3]); *(uint2*)(xout + (size_t)row * D + 4 * F.lane + 256 * j) = xo_; } }
        if (ri + 1 < rpw) NORM_LOAD(row + 1);
        float ss = 0.f;
#pragma unroll
        for (int i = 0; i < 16; ++i) ss += v[i] * v[i];
        ss = wave_sum(ss); const float r = rsqrtf(ss * (1.f / D) + 1e-6f);
#pragma unroll
        for (int j = 0; j < 4; ++j) { const f32x4 g4 = *(const LAS f32x4*)(cg + 4 * F.lane + 256 * j), s4 = *(const LAS f32x4*)(csh + 4 * F.lane + 256 * j);
#pragma unroll
            for (int e = 0; e < 4; ++e) v[4 * j + e] = v[4 * j + e] * r * g4[e] + s4[e];
            if (MODE == 2 || MODE == 0) *(unsigned*)((unsigned char*)p.h + (size_t)row * D + 4 * F.lane + 256 * j) = pk4_fp8(v[4 * j] * F8_SA, v[4 * j + 1] * F8_SA, v[4 * j + 2] * F8_SA, v[4 * j + 3] * F8_SA);
            else { uint2 pk; pk.x = pk2g(v[4 * j], v[4 * j + 1]); pk.y = pk2g(v[4 * j + 2], v[4 * j + 3]); *(uint2*)(p.h + (size_t)row * D + 4 * F.lane + 256 * j) = pk; } }
        if (MODE == 2) { float a8[8];
#pragma unroll
            for (int j = 0; j < 8; ++j) a8[j] = 0.f;
#pragma unroll
            for (int j = 0; j < 4; ++j)
#pragma unroll
                for (int e = 0; e < 4; ++e) { const LAS float* wr_ = rw + (e * 256 + 64 * j + F.lane) * TP; const float hv = v[4 * j + e];
#pragma unroll
                    for (int q2 = 0; q2 < 4; ++q2) { const f32x2_t w2 = *(const LAS f32x2_t*)(wr_ + 2 * q2); a8[2 * q2] += hv * w2[0]; a8[2 * q2 + 1] += hv * w2[1]; } }
#pragma unroll
            for (int j = 0; j < 8; ++j) a8[j] = wave_sum(a8[j]);
            if (F.lane < 8) { float a = 0.f;
#pragma unroll
                for (int j = 0; j < 8; ++j) a = (F.lane == j) ? a8[j] : a;
                if (F.lane < 4) { a += p.ml_bi[F.lane]; p.li[row * 4 + F.lane] = 15.f * tanhf(a / 15.f); }
                else { a += p.ml_bf[F.lane - 4]; const float cc = 15.f * tanhf(a / 15.f); p.lf[row * 4 + F.lane - 4] = (cc >= 0.f) ? -log1pf(expf(-cc)) : (cc - log1pf(expf(cc))); } } }
        if (MODE == 1) { float acc[32];
#pragma unroll
            for (int e = 0; e < 32; ++e) acc[e] = 0.f;
#pragma unroll
            for (int j = 0; j < 4; ++j)
#pragma unroll
                for (int e = 0; e < 4; ++e) { const LAS float* wr_ = rw + (e * 256 + 64 * j + F.lane) * TP; const float hv = v[4 * j + e]; asm volatile("" ::: "memory");
#pragma unroll
                    for (int q2 = 0; q2 < 16; ++q2) { const f32x2_t w2 = *(const LAS f32x2_t*)(wr_ + 2 * q2); acc[2 * q2] += hv * w2[0]; acc[2 * q2 + 1] += hv * w2[1]; } }
            float r16[16], r8[8], r4[4], r2[2], r1;
            { const bool hi = (F.lane & 32) != 0;
#pragma unroll
              for (int i = 0; i < 16; ++i) { const float keep = hi ? acc[16 + i] : acc[i], send = hi ? acc[i] : acc[16 + i]; r16[i] = keep + other32(send, hi); } }
            { const bool hi = (F.lane & 16) != 0;
#pragma unroll
              for (int i = 0; i < 8; ++i) { const float keep = hi ? r16[8 + i] : r16[i], send = hi ? r16[i] : r16[8 + i]; r8[i] = keep + sx<16>(send); } }
            { const bool hi = (F.lane & 8) != 0;
#pragma unroll
              for (int i = 0; i < 4; ++i) { const float keep = hi ? r8[4 + i] : r8[i], send = hi ? r8[i] : r8[4 + i]; r4[i] = keep + sx<8>(send); } }
            { const bool hi = (F.lane & 4) != 0;
#pragma unroll
              for (int i = 0; i < 2; ++i) { const float keep = hi ? r4[2 + i] : r4[i], send = hi ? r4[i] : r4[2 + i]; r2[i] = keep + sx<4>(send); } }
            { const bool hi = (F.lane & 2) != 0; const float keep = hi ? r2[1] : r2[0], send = hi ? r2[0] : r2[1]; r1 = keep + sx<2>(send); }
            r1 += sx<1>(r1);
            const float aff = sigmoidf_(r1); const float ch = aff + p.router_b[F.lane >> 1];
            float bestgs = -3e38f; int be0 = 0, be1 = 0; float ba0 = 0.f, ba1 = 0.f;
#pragma unroll
            for (int g = 0; g < 4; ++g) { float v1 = -3e38f, v2 = -3e38f, a1 = 0.f, a2 = 0.f; int i1 = 0, i2 = 0;
#pragma unroll
                for (int i = 0; i < 8; ++i) { const float a = rdlane(aff, 2 * (g * 8 + i)), c_ = rdlane(ch, 2 * (g * 8 + i));
                    if (c_ > v1) { v2 = v1; a2 = a1; i2 = i1; v1 = c_; a1 = a; i1 = i; } else if (c_ > v2) { v2 = c_; a2 = a; i2 = i; } }
                const float gs = v1 + v2; if (gs > bestgs) { bestgs = gs; be0 = g * 8 + i1; be1 = g * 8 + i2; ba0 = a1; ba1 = a2; } }
            if (F.lane == 0) { const float sum = ba0 + ba1; p.tokw[row * 2] = ba0 / sum; p.tokw[row * 2 + 1] = ba1 / sum;
                const int lr = row - row0; const int r0_ = atomicAdd((int*)&lcnt[be0], 1); const int r1_ = atomicAdd((int*)&lcnt[be1], 1);
                ent[lr * 4 + 0] = be0 | (r0_ << 8); ent[lr * 4 + 1] = row * 2; ent[lr * 4 + 2] = be1 | (r1_ << 8); ent[lr * 4 + 3] = row * 2 + 1; } }
    }
#undef NORM_LOAD
    if (MODE == 1) { __syncthreads();
        if (F.tid < 32) gbase[F.tid] = atomicAdd(&p.cnt[layer * 64 + F.tid], lcnt[F.tid]);
        __syncthreads();
        for (int idx = F.tid; idx < rows_per_wg * 2; idx += NTHR) { const int er = ent[idx * 2], tk = ent[idx * 2 + 1]; const int e = er & 255, rk = er >> 8; p.list[(size_t)e * T + gbase[e] + rk] = tk; }
        __syncthreads(); }
}

__device__ __forceinline__ void phase_norm_route(const Params& p, const Frame& F, const bf16_t* xin, const float* gain, const float* mod_sh, const float* mod_sc, int layer) {
    constexpr int rows_per_wg = T / NWG;
    const int row0 = F.bid * rows_per_wg, b = row0 / S, lane = F.lane, i16 = lane & 15, g = lane >> 4;
    constexpr int RTP = 2064;
    LAS unsigned char* thi = F.lds; LAS unsigned char* tlo = F.lds + 32 * RTP;
    LAS float* cg = (LAS float*)(F.lds + LDS_CONST); LAS float* csh = cg + D; LAS float* bias = csh + D; LAS float* bpart = bias + 32;
    LAS int* lcnt = (LAS int*)(F.lds + LDS_MISC + 64); LAS int* gbase = lcnt + 32; LAS int* ent = gbase + 32;
    for (int col = F.tid; col < D; col += NTHR) { cg[col] = gain[col] * (1.f + mod_sc[b * 6144 + col]); csh[col] = mod_sh[b * 6144 + col]; }
    if (F.tid < 32) lcnt[F.tid] = 0;
    __syncthreads();
    { const int e = F.tid & 31, part = F.tid >> 5; float a = 0.f;
#pragma unroll 8
      for (int k = part * 64; k < part * 64 + 64; k += 2) { const float w0 = p.router_w[k * 32 + e], w1 = p.router_w[(k + 1) * 32 + e];
          a += csh[k] * w0 + csh[k + 1] * w1;
          const float s0 = w0 * cg[k] * 256.f, s1 = w1 * cg[k + 1] * 256.f; const _Float16 h0 = (_Float16)s0, h1 = (_Float16)s1; const _Float16 l0 = (_Float16)(s0 - (float)h0), l1 = (_Float16)(s1 - (float)h1);
          *(LAS unsigned*)(thi + e * RTP + k * 2) = (unsigned)__builtin_bit_cast(unsigned short, h0) | ((unsigned)__builtin_bit_cast(unsigned short, h1) << 16);
          *(LAS unsigned*)(tlo + e * RTP + k * 2) = (unsigned)__builtin_bit_cast(unsigned short, l0) | ((unsigned)__builtin_bit_cast(unsigned short, l1) << 16); }
      bpart[part * 32 + e] = a; }
    __syncthreads();
    if (F.tid < 32) { float a = 0.f;
#pragma unroll
        for (int q = 0; q < 16; ++q) a += bpart[q * 32 + F.tid];
        bias[F.tid] = a; }
    const int rbase = row0 + F.wave * 16;
    const bf16_t* xr = xin + (size_t)(rbase + i16) * D + 8 * g;
    typedef _Float16 f16x8 __attribute__((ext_vector_type(8))); typedef unsigned u32x4r __attribute__((ext_vector_type(4)));
    const LAS unsigned char* bh0 = thi + i16 * RTP + 16 * g; const LAS unsigned char* bh1 = bh0 + 16 * RTP; const LAS unsigned char* bl0 = tlo + i16 * RTP + 16 * g; const LAS unsigned char* bl1 = bl0 + 16 * RTP;
    f32x4 acc0 = (f32x4){0.f, 0.f, 0.f, 0.f}, acc1 = (f32x4){0.f, 0.f, 0.f, 0.f}; float ss = 0.f;
    uint4 xa[2][8];
#define RT_LOAD(s_, q_) do { _Pragma("unroll") for (int u_ = 0; u_ < 8; ++u_) xa[s_][u_] = *(const uint4*)(xr + 32 * (8 * (q_) + u_)); } while (0)
    RT_LOAD(0, 0);
#pragma unroll
    for (int qd = 0; qd < 4; ++qd) {
        if (qd + 1 < 4) RT_LOAD((qd + 1) & 1, qd + 1);
#pragma unroll
        for (int u = 0; u < 8; ++u) { const int so = (8 * qd + u) * 64;
            const uint4 xc = xa[qd & 1][u]; const unsigned xw[4] = {xc.x, xc.y, xc.z, xc.w}; u32x4r ap;
#pragma unroll
            for (int i = 0; i < 4; ++i) { const float f0 = __uint_as_float(xw[i] << 16), f1 = __uint_as_float(xw[i] & 0xFFFF0000u); ss += f0 * f0 + f1 * f1; ap[i] = __builtin_bit_cast(unsigned, __builtin_amdgcn_cvt_pkrtz(f0, f1)); }
            const f16x8 a8 = __builtin_bit_cast(f16x8, ap);
            const f16x8 b0h = *(const LAS f16x8*)(bh0 + so), b0l = *(const LAS f16x8*)(bl0 + so), b1h = *(const LAS f16x8*)(bh1 + so), b1l = *(const LAS f16x8*)(bl1 + so);
            acc0 = __builtin_amdgcn_mfma_f32_16x16x32_f16(a8, b0h, acc0, 0, 0, 0); acc1 = __builtin_amdgcn_mfma_f32_16x16x32_f16(a8, b1h, acc1, 0, 0, 0);
            acc0 = __builtin_amdgcn_mfma_f32_16x16x32_f16(a8, b0l, acc0, 0, 0, 0); acc1 = __builtin_amdgcn_mfma_f32_16x16x32_f16(a8, b1l, acc1, 0, 0, 0); }
    }
#undef RT_LOAD
    ss = sum16(ss); ss = sum32(ss); const float r = rsqrtf(ss * (1.f / D) + 1e-6f);
    float af0[4], af1[4];
#pragma unroll
    for (int rr = 0; rr < 4; ++rr) { const float rrow = __int_as_float(__builtin_amdgcn_ds_bpermute((4 * g + rr) * 4, __float_as_int(r)));
        af0[rr] = sigmoidf_(rrow * (1.f / 256.f) * acc0[rr] + bias[i16]); af1[rr] = sigmoidf_(rrow * (1.f / 256.f) * acc1[rr] + bias[16 + i16]); }
    __syncthreads();
    LAS float* affl = (LAS float*)F.lds + F.wave * 512;
#pragma unroll
    for (int rr = 0; rr < 4; ++rr) { affl[(4 * g + rr) * 32 + i16] = af0[rr]; affl[(4 * g + rr) * 32 + 16 + i16] = af1[rr]; }
    asm volatile("s_waitcnt lgkmcnt(0)" ::: "memory");
    if (lane < 16) { const int row = rbase + lane; const LAS float* ar = affl + lane * 32;
        float bestgs = -3e38f; int be0 = 0, be1 = 0; float ba0 = 0.f, ba1 = 0.f;
#pragma unroll
        for (int gg = 0; gg < 4; ++gg) { float v1 = -3e38f, v2 = -3e38f, a1 = 0.f, a2 = 0.f; int i1 = 0, i2 = 0;
#pragma unroll
            for (int i = 0; i < 8; ++i) { const float a = ar[gg * 8 + i], c_ = a + p.router_b[gg * 8 + i];
                if (c_ > v1) { v2 = v1; a2 = a1; i2 = i1; v1 = c_; a1 = a; i1 = i; } else if (c_ > v2) { v2 = c_; a2 = a; i2 = i; } }
            const float gs = v1 + v2; if (gs > bestgs) { bestgs = gs; be0 = gg * 8 + i1; be1 = gg * 8 + i2; ba0 = a1; ba1 = a2; } }
        const float sum = ba0 + ba1; p.tokw[row * 2] = ba0 / sum; p.tokw[row * 2 + 1] = ba1 / sum;
        const int lr = row - row0; const int r0_ = atomicAdd((int*)&lcnt[be0], 1); const int r1_ = atomicAdd((int*)&lcnt[be1], 1);
        ent[lr * 4 + 0] = be0 | (r0_ << 8); ent[lr * 4 + 1] = row * 2; ent[lr * 4 + 2] = be1 | (r1_ << 8); ent[lr * 4 + 3] = row * 2 + 1; }
    { uint2 xq[2][4][4];
#define NR_LOAD(s_, r_) do { _Pragma("unroll") for (int k_ = 0; k_ < 4; ++k_) { const bf16_t* xq_ = xin + (size_t)((r_) + k_) * D + 4 * lane; _Pragma("unroll") for (int j_ = 0; j_ < 4; ++j_) xq[s_][k_][j_] = *(const uint2*)(xq_ + 256 * j_); } } while (0)
      NR_LOAD(0, rbase);
#pragma unroll
      for (int g4 = 0; g4 < 4; ++g4) {
          if (g4 + 1 < 4) NR_LOAD((g4 + 1) & 1, rbase + 4 * (g4 + 1));
#pragma unroll
          for (int k = 0; k < 4; ++k) { const int row = rbase + 4 * g4 + k; const float rr_ = rdlane(r, 4 * g4 + k);
#pragma unroll
              for (int j = 0; j < 4; ++j) { const f32x4 g4v = *(const LAS f32x4*)(cg + 4 * lane + 256 * j), s4_ = *(const LAS f32x4*)(csh + 4 * lane + 256 * j); const uint2 xc = xq[g4 & 1][k][j];
                  const float x0 = __uint_as_float(xc.x << 16), x1 = __uint_as_float(xc.x & 0xFFFF0000u), x2 = __uint_as_float(xc.y << 16), x3 = __uint_as_float(xc.y & 0xFFFF0000u);
                  *(unsigned*)((unsigned char*)p.h + (size_t)row * D + 4 * lane + 256 * j) = pk4_fp8((x0 * rr_ * g4v[0] + s4_[0]) * F8_SA, (x1 * rr_ * g4v[1] + s4_[1]) * F8_SA, (x2 * rr_ * g4v[2] + s4_[2]) * F8_SA, (x3 * rr_ * g4v[3] + s4_[3]) * F8_SA); } } }
#undef NR_LOAD
    }
    __syncthreads();
    if (F.tid < 32) gbase[F.tid] = atomicAdd(&p.cnt[layer * 64 + F.tid], lcnt[F.tid]);
    __syncthreads();
    for (int idx = F.tid; idx < rows_per_wg * 2; idx += NTHR) { const int er = ent[idx * 2], tk = ent[idx * 2 + 1]; const int e = er & 255, rk = er >> 8; p.list[(size_t)e * T + gbase[e] + rk] = tk; }
    __syncthreads();
}

struct MoeOrder { const LAS int* tab;
    __device__ bool next(int i, ge::Unit& u) const { if (i >= 8) return false; const int pm = __builtin_amdgcn_readfirstlane(tab[4 * i]); if (pm < 0) return false;
        u.pm = pm; u.pn = __builtin_amdgcn_readfirstlane(tab[4 * i + 1]); u.bt = __builtin_amdgcn_readfirstlane(tab[4 * i + 2]); u.aux = __builtin_amdgcn_readfirstlane(tab[4 * i + 3]); return true; } };
__device__ __forceinline__ void moe_plan(const Frame& F, const int* cnt, const int* list, LAS int* tab, LAS int* tkt  , int npn, const float* tokw = nullptr, LAS float* tkw = nullptr  , const float wscale = 1.f) {
    LAS int* lc = tab + 32;
    __syncthreads();
    if (F.tid < 32) lc[F.tid] = cnt[F.tid];
    __syncthreads();
    if (F.tid < 8) { const int L = F.tid * F.G + F.bid, mt = L / npn, pn = L % npn; int acc = 0, e_f = -1, mi_f = 0;
#pragma unroll 1
        for (int e = 0; e < NE; ++e) { const int nte = (lc[e] + 255) >> 8; if (e_f < 0 && mt < acc + nte) { e_f = e; mi_f = mt - acc; } acc += nte; }
        tab[4 * F.tid] = e_f < 0 ? -1 : mt; tab[4 * F.tid + 1] = pn; tab[4 * F.tid + 2] = e_f * npn + pn; tab[4 * F.tid + 3] = e_f | (mi_f << 8) | (F.tid << 24); }
    __syncthreads();
#pragma unroll
    for (int q = 0; q < 4; ++q) { const int idx = F.tid + NTHR * q, i = idx >> 8, r = idx & 255; int v = -1;
        if (tab[4 * i] >= 0) { const int aux = tab[4 * i + 3], e = aux & 255, ii = ((aux >> 8) & 0xFFFF) * 256 + r; if (ii < lc[e]) v = list[(size_t)e * T + ii]; }
        tkt[idx] = v; if (tkw) tkw[idx] = v >= 0 ? tokw[v] * wscale : 0.f; }
    __syncthreads();
}
struct MoeRows { static constexpr bool dense = false; const LAS int* tkt; __device__ __forceinline__ unsigned operator()(const ge::Unit& u, int r) const { const int tk = tkt[(u.aux >> 24) * 256 + r]; return tk < 0 ? (unsigned)T * (unsigned)(D * 2) : (unsigned)(tk >> 1) * (unsigned)D; } };
struct EpiMoe1 { unsigned char* hid8; float inscale;
    __device__ __forceinline__ void operator()(const f32x4 (&acc)[2][2][4][2], const ge::Unit& u, int wr, int wc, int fr, int fq) const {
        const int h0 = (4 * u.pn + wc) * 32 + 8 * fq;
#pragma unroll
        for (int ai = 0; ai < 2; ++ai)
#pragma unroll
            for (int m = 0; m < 4; ++m) { const int row = u.pm * 256 + ai * 128 + wr * 64 + m * 16 + fr; unsigned w[2];
#pragma unroll
                for (int n = 0; n < 2; ++n) { float r4[4];
#pragma unroll
                    for (int j = 0; j < 4; ++j) { const float g = acc[ai][0][m][n][j] * inscale, uu = acc[ai][1][m][n][j] * inscale; r4[j] = g * fsigmoid(g) * uu * F8_SH; }
                    w[n] = pk4_fp8(r4[0], r4[1], r4[2], r4[3]); }
                *(uint2*)(hid8 + (size_t)row * DE + h0) = make_uint2(w[0], w[1]); }
    } };
struct EpiMoe2 { bf16_t* outk; const LAS int* tkt; const LAS float* tkw;
    __device__ __forceinline__ void operator()(const f32x4 (&acc)[2][2][4][2], const ge::Unit& u, int wr, int wc, int fr, int fq) const {
        const int L0 = (4 * u.pn + wc) * 64 + 16 * fq; const int ub = (u.aux >> 24) * 256 + wr * 64 + fr; int tk[2][4]; float wt[2][4];
#pragma unroll
        for (int ai = 0; ai < 2; ++ai)
#pragma unroll
            for (int m = 0; m < 4; ++m) { tk[ai][m] = tkt[ub + ai * 128 + m * 16]; wt[ai][m] = tkw[ub + ai * 128 + m * 16]; }
#pragma unroll
        for (int ai = 0; ai < 2; ++ai)
#pragma unroll
            for (int m = 0; m < 4; ++m) { const int t_ = tk[ai][m]; if (t_ < 0) continue; const float w = wt[ai][m]; float v[16]; GE_VALS(v, acc, ai, m);
#pragma unroll
                for (int k = 0; k < 16; ++k) v[k] *= w;
                store16_bf16(outk + (size_t)(t_ & 1) * T * D + (size_t)(t_ >> 1) * D + L0, v); }
    } };

__device__ __forceinline__ void phase_cmp2(const Params& p, const Frame& F) {
    LAS float* w2l = (LAS float*)F.lds; const int base = F.bid * 8 + F.wave;
#pragma unroll 1
    for (int w = 0; w < 2; ++w) {
        __syncthreads();
        for (int i4 = F.tid; i4 < 256 * 64 / 4; i4 += NTHR) { const float4 t4 = *(const float4*)(p.cmp_w2 + (size_t)w * 256 * 64 + 4 * i4); *(LAS f32x4*)(w2l + 4 * i4) = (f32x4){t4.x, t4.y, t4.z, t4.w}; }
        float hv[2][4];
#pragma unroll
        for (int k = 0; k < 2; ++k) { const int row = (base + (2 * w + k) * 2048) & 4095;
#pragma unroll
            for (int i = 0; i < 4; ++i) { float x = p.cb1[w * 256 + i * 64 + F.lane];
#pragma unroll
                for (int ks = 0; ks < 8; ++ks) x += p.cpart[((size_t)(w * 8 + ks) * 4096 + row) * 256 + i * 64 + F.lane];
                hv[k][i] = 0.5f * x * (1.f + ftanh(0.7978845608028654f * (x + 0.044715f * x * x * x))); } }
        __syncthreads();
        float acc0 = p.cmp_b2[w * 64 + F.lane], acc1 = acc0;
#pragma unroll
        for (int i = 0; i < 4; ++i)
#pragma unroll 8
            for (int l = 0; l < 64; ++l) { const float wv = w2l[(i * 64 + l) * 64 + F.lane]; acc0 += rdlane(hv[0][i], l) * wv; acc1 += rdlane(hv[1][i], l) * wv; }
#pragma unroll
        for (int k = 0; k < 2; ++k) { const int row = (base + (2 * w + k) * 2048) & 4095, c = row & 127; float v = k ? acc1 : acc0;
            if (w == 0) { const float ss = wave_sum(v * v); v = v * rsqrtf(ss * (1.f / 64.f) + 1e-6f) * p.k_gain[F.lane]; int pos = c * 16 + 31; if (pos > 2047) pos = 2047;
                const float other = sx<8>(v); if (F.lane < 16) { const int j = F.lane & 7; const float cs = p.rope[pos * 16 + j], sn = p.rope[pos * 16 + 8 + j]; v = (F.lane < 8) ? (v * cs - other * sn) : (v * cs + other * sn); } }
            if (c == 127) v = 0.f;
            (w == 0 ? p.kcmp : p.vcmp)[(size_t)row * 64 + F.lane] = f2bf(v); }
    }
}

typedef float f32x16 __attribute__((ext_vector_type(16)));
typedef short s16x4 __attribute__((ext_vector_type(4)));
namespace at {
constexpr int KP = 144, VP = 192;
constexpr int KBUF = 64 * KP, VBUF = 64 * VP;
constexpr int OFF_K0 = 0, OFF_K1 = KBUF, OFF_V0 = 4 * KBUF, OFF_V1 = 4 * KBUF + VBUF, OFF_IMP = 4 * KBUF + 4 * VBUF;
constexpr int IMP_PITCH = 33, OFF_SEL = OFF_IMP + 8 * 32 * IMP_PITCH * 4;
constexpr float SC = 0.125f * 1.4426950408889634f;
constexpr float NEG = -1e30f, THR = 8.0f;
__device__ __forceinline__ unsigned pk2(float a, float b) { typedef float f2 __attribute__((ext_vector_type(2))); typedef __bf16 b2 __attribute__((ext_vector_type(2))); b2 r = __builtin_convertvector((f2){a, b}, b2); return __builtin_bit_cast(unsigned, r); }
template <int OFF> __device__ __forceinline__ s16x4 tr_read(unsigned addr) { s16x4 r; asm volatile("ds_read_b64_tr_b16 %0, %1 offset:%2" : "=&v"(r) : "v"(addr), "i"(OFF) : "memory"); return r; }
struct St { f32x16 o[2]; float m, l; };

__device__ __forceinline__ void qk_tile(const LAS unsigned char* kb, int r32, int hi, const bf16x8 (&qf)[4], f32x16& s0, f32x16& s1) {
#pragma unroll
    for (int e = 0; e < 16; ++e) { s0[e] = 0.f; s1[e] = 0.f; }
#pragma unroll
    for (int ks = 0; ks < 4; ++ks) {
        const bf16x8 a0 = *(const LAS bf16x8*)(kb + r32 * KP + (16 * ks + 8 * hi) * 2);
        const bf16x8 a1 = *(const LAS bf16x8*)(kb + (32 + r32) * KP + (16 * ks + 8 * hi) * 2);
        s0 = __builtin_amdgcn_mfma_f32_32x32x16_bf16(a0, qf[ks], s0, 0, 0, 0);
        s1 = __builtin_amdgcn_mfma_f32_32x32x16_bf16(a1, qf[ks], s1, 0, 0, 0);
    }
}
template <int MODE>
__device__ __forceinline__ bool elem_valid(int kt, int e, int hi, int qloc, int t, int key0) {
    const int kl = kt * 32 + (e & 3) + 8 * (e >> 2) + 4 * hi;
    if (MODE == 1) { const int c = key0 + kl; return (c < 127) && (16 * c + 31 <= t); }
    if (MODE == 2) return kl <= qloc;
    if (MODE == 3) return kl > qloc;
    return true;
}
template <int DT> __device__ __forceinline__ void pv_read(unsigned vb_lane, s16x4 (&va)[4][2]) {
    va[0][0] = tr_read<0 * VP + 64 * DT>(vb_lane); va[0][1] = tr_read<8 * VP + 64 * DT>(vb_lane); va[1][0] = tr_read<16 * VP + 64 * DT>(vb_lane); va[1][1] = tr_read<24 * VP + 64 * DT>(vb_lane);
    va[2][0] = tr_read<32 * VP + 64 * DT>(vb_lane); va[2][1] = tr_read<40 * VP + 64 * DT>(vb_lane); va[3][0] = tr_read<48 * VP + 64 * DT>(vb_lane); va[3][1] = tr_read<56 * VP + 64 * DT>(vb_lane);
}
__device__ __forceinline__ void pv_mma(const s16x4 (&va)[4][2], const unsigned (&pp)[16], f32x16& o) {
#pragma unroll
    for (int kk = 0; kk < 4; ++kk) {
        const bf16x8 af = (bf16x8){va[kk][0][0], va[kk][0][1], va[kk][0][2], va[kk][0][3], va[kk][1][0], va[kk][1][1], va[kk][1][2], va[kk][1][3]};
        typedef unsigned u32x4 __attribute__((ext_vector_type(4)));
        const u32x4 pw = (u32x4){pp[4 * kk], pp[4 * kk + 1], pp[4 * kk + 2], pp[4 * kk + 3]};
        o = __builtin_amdgcn_mfma_f32_32x32x16_bf16(af, __builtin_bit_cast(bf16x8, pw), o, 0, 0, 0);
    }
}
__device__ __forceinline__ void pv_tile(unsigned vb_lane, const unsigned (&pp)[16], St& st) {
    s16x4 va[4][2];
    pv_read<0>(vb_lane, va); asm volatile("s_waitcnt lgkmcnt(0)" ::: "memory"); __builtin_amdgcn_sched_barrier(0); pv_mma(va, pp, st.o[0]);
    pv_read<1>(vb_lane, va); asm volatile("s_waitcnt lgkmcnt(0)" ::: "memory"); __builtin_amdgcn_sched_barrier(0); pv_mma(va, pp, st.o[1]);
}
__device__ __forceinline__ float max3f(float a, float b, float c) { float r; asm("v_max3_f32 %0, %1, %2, %3" : "=v"(r) : "v"(a), "v"(b), "v"(c)); return r; }
template <int MODE, bool GATED, bool FIXED>
__device__ __forceinline__ void attend_tile(const LAS unsigned char* kb, unsigned vb_lane, int r32, int hi, const bf16x8 (&qf)[4], St& st, int qloc, bool en, float mfix) {
    f32x16 s0, s1; qk_tile(kb, r32, hi, qf, s0, s1);
    s16x4 va0[4][2]; pv_read<0>(vb_lane, va0);
    if (MODE != 0) {
#pragma unroll
        for (int e = 0; e < 16; ++e) { s0[e] = elem_valid<MODE>(0, e, hi, qloc, 0, 0) ? s0[e] : NEG; s1[e] = elem_valid<MODE>(1, e, hi, qloc, 0, 0) ? s1[e] : NEG; }
    }
    float mc = 0.f;
    if (FIXED) {
    } else {
        float mx = max3f(s0[0], s0[1], s1[0]);
#pragma unroll
        for (int e = 2; e < 16; e += 2) mx = max3f(mx, s0[e], s0[e + 1]);
#pragma unroll
        for (int e = 1; e < 15; e += 2) mx = max3f(mx, s1[e], s1[e + 1]);
        mx = fmaxf(mx, s1[15]);
        if (GATED) mx = en ? mx : NEG;
        mx = max32(mx);
        float mold = st.m;
        if (__any((mx - mold) * SC > THR)) {
            const float mnew = fmaxf(mold, mx); const float al = __builtin_amdgcn_exp2f((mold - mnew) * SC);
#pragma unroll
            for (int e = 0; e < 16; ++e) { st.o[0][e] *= al; st.o[1][e] *= al; }
            st.l *= al; st.m = mnew; mold = mnew;
        }
        mc = fmaxf(mold, -1e20f) * SC; if (GATED) mc = en ? mc : 3e38f;
    }
    float rs = 0.f; unsigned pp[16];
#pragma unroll
    for (int e = 0; e < 16; e += 2) {
        float a0, a1, b0, b1;
        if (FIXED) { a0 = __builtin_amdgcn_exp2f(s0[e]); a1 = __builtin_amdgcn_exp2f(s0[e + 1]); b0 = __builtin_amdgcn_exp2f(s1[e]); b1 = __builtin_amdgcn_exp2f(s1[e + 1]); }
        else { a0 = __builtin_amdgcn_exp2f(__builtin_fmaf(s0[e], SC, -mc)); a1 = __builtin_amdgcn_exp2f(__builtin_fmaf(s0[e + 1], SC, -mc)); b0 = __builtin_amdgcn_exp2f(__builtin_fmaf(s1[e], SC, -mc)); b1 = __builtin_amdgcn_exp2f(__builtin_fmaf(s1[e + 1], SC, -mc)); }
        rs += (a0 + a1) + (b0 + b1); pp[e >> 1] = pk2(a0, a1); pp[8 + (e >> 1)] = pk2(b0, b1); }
    if (FIXED && GATED) {
#pragma unroll
        for (int i = 0; i < 16; ++i) pp[i] = en ? pp[i] : 0u;
        rs = en ? rs : 0.f; }
    if (!FIXED) rs = sum32(rs);
    st.l += rs;
    asm volatile("s_waitcnt lgkmcnt(0)" ::: "memory"); __builtin_amdgcn_sched_barrier(0); pv_mma(va0, pp, st.o[0]);
    { s16x4 va1[4][2]; pv_read<1>(vb_lane, va1); asm volatile("s_waitcnt lgkmcnt(0)" ::: "memory"); __builtin_amdgcn_sched_barrier(0); pv_mma(va1, pp, st.o[1]); }
}
__device__ __forceinline__ void st_reset(St& st) {
#pragma unroll
    for (int a = 0; a < 2; ++a)
#pragma unroll
        for (int e = 0; e < 16; ++e) st.o[a][e] = 0.f;
    st.m = NEG; st.l = 0.f;
}
__device__ __forceinline__ void st_flush(const St& st, unsigned (&ofin)[2][8], float g, bool first) {
    const float f = (st.l > 0.f ? 1.f / st.l : 0.f) * g;
#pragma unroll
    for (int dt = 0; dt < 2; ++dt)
#pragma unroll
        for (int e = 0; e < 16; e += 2) { float a = st.o[dt][e] * f, b = st.o[dt][e + 1] * f;
            if (!first) { const unsigned w = ofin[dt][e >> 1]; a += __uint_as_float(w << 16); b += __uint_as_float(w & 0xFFFF0000u); }
            ofin[dt][e >> 1] = pk2(a, b); }
#pragma unroll
    for (int dt = 0; dt < 2; ++dt) asm volatile("" : "+v"(ofin[dt][0]), "+v"(ofin[dt][1]), "+v"(ofin[dt][2]), "+v"(ofin[dt][3]), "+v"(ofin[dt][4]), "+v"(ofin[dt][5]), "+v"(ofin[dt][6]), "+v"(ofin[dt][7]));
}
__device__ __forceinline__ void tile_load(const bf16_t* kbase, const bf16_t* vbase, int key0, int tid, uint4& kr, uint4& vr) {
    const size_t o = (size_t)(key0 + (tid >> 3)) * 64 + (tid & 7) * 8; kr = *(const uint4*)(kbase + o); vr = *(const uint4*)(vbase + o); }
typedef unsigned u32x4_t __attribute__((ext_vector_type(4)));
__device__ __forceinline__ void tile_store(LAS unsigned char* lds, int buf, int tid, const uint4& kr, const uint4& vr) {
    *(LAS u32x4_t*)(lds + OFF_K0 + buf * KBUF + (tid >> 3) * KP + (tid & 7) * 16) = (u32x4_t){kr.x, kr.y, kr.z, kr.w}; *(LAS u32x4_t*)(lds + OFF_V0 + buf * VBUF + (tid >> 3) * VP + (tid & 7) * 16) = (u32x4_t){vr.x, vr.y, vr.z, vr.w}; }
}

template <bool FIXED>
__device__ __forceinline__ void phase_attn_t(const Params& p, const Frame& F, const float mfix) {
    using namespace at;
    LAS unsigned char* lds = F.lds;
    const int tid = F.tid, lane = F.lane, w = F.wave, r32 = lane & 31, hi = lane >> 5;
    const unsigned vlane = (unsigned)((4 * hi + ((lane & 15) >> 2)) * VP + (16 * ((lane >> 4) & 1) + 4 * (lane & 3)) * 2);
    LAS float* impw = (LAS float*)(lds + OFF_IMP) + w * 32 * IMP_PITCH;
    LAS unsigned* selm = (LAS unsigned*)(lds + OFF_SEL);
    LAS float* invl = (LAS float*)(lds + OFF_SEL + 512);
#define AT_UNIT(ui_, qb_, bg_, qoff_) const int idx_##qb_ = ((ui_) & 1) ? ((ui_) * 256 + 255 - F.bid) : ((ui_) * 256 + F.bid); const int qb_ = 31 - (idx_##qb_ >> 6), bg_ = (idx_##qb_ >> 1) & 31, qoff_ = (idx_##qb_ & 1) * 32
    bf16x8 qf[4]; float gt[3]; uint4 kr, vr, kr1, vr1;
    { AT_UNIT(0, qb, bg, qoff);
      const bf16_t* kc = p.kcmp + (size_t)bg * 128 * 64; const bf16_t* vc = p.vcmp + (size_t)bg * 128 * 64;
      tile_load(kc, vc, 0, tid, kr, vr); if (qb >= 16) tile_load(kc, vc, 64, tid, kr1, vr1); }
#pragma unroll 1
    for (int ui = 0; ui < 8; ++ui) {
        AT_UNIT(ui, qb, bg, qoff);
        const int b = bg >> 1, g = bg & 1, head = g * 8 + w, s0 = qb * 64;
        const int qloc = qoff + r32, t = s0 + qloc;
        const bf16_t* ksel = p.kv + (size_t)2 * T * 128 + (size_t)bg * S * 64; const bf16_t* vsel = p.kv + (size_t)3 * T * 128 + (size_t)bg * S * 64;
        const bf16_t* kwin = p.kv + (size_t)4 * T * 128 + (size_t)bg * S * 64; const bf16_t* vwin = p.kv + (size_t)5 * T * 128 + (size_t)bg * S * 64;
        unsigned ofin[2][8]; St st;
        { const size_t tok = (size_t)b * S + t;
#pragma unroll
          for (int ks = 0; ks < 4; ++ks) { qf[ks] = *(const bf16x8*)(p.q + tok * D + head * 64 + 16 * ks + 8 * hi);
              if (FIXED) { typedef unsigned u32x4q __attribute__((ext_vector_type(4))); const u32x4q w4 = __builtin_bit_cast(u32x4q, qf[ks]); u32x4q r4;
#pragma unroll
                  for (int i = 0; i < 4; ++i) r4[i] = pk2(__uint_as_float(w4[i] << 16) * SC, __uint_as_float(w4[i] & 0xFFFF0000u) * SC);
                  qf[ks] = __builtin_bit_cast(bf16x8, r4); } }
#pragma unroll
          for (int br = 0; br < 3; ++br) gt[br] = p.gates[tok * 48 + br * 16 + head]; }
        const int nct = (qb >= 16) ? 2 : 1;
        __syncthreads();
        tile_store(lds, 0, tid, kr, vr); if (nct == 2) tile_store(lds, 1, tid, kr1, vr1);
        tile_load(ksel, vsel, qb * 64, tid, kr, vr);
        __syncthreads();
        float cm = NEG, cl = 0.f;
        if (!FIXED) {
#pragma unroll 1
        for (int ct = 0; ct < nct; ++ct) { const LAS unsigned char* kb = lds + (ct ? OFF_K1 : OFF_K0);
            f32x16 a0, a1; qk_tile(kb, r32, hi, qf, a0, a1); float mx = NEG;
#pragma unroll
            for (int e = 0; e < 16; ++e) { a0[e] = elem_valid<1>(0, e, hi, qloc, t, ct * 64) ? a0[e] : NEG; a1[e] = elem_valid<1>(1, e, hi, qloc, t, ct * 64) ? a1[e] : NEG; mx = fmaxf(mx, fmaxf(a0[e], a1[e])); }
            mx = max32(mx); const float mnew = fmaxf(cm, mx); float rs = 0.f;
#pragma unroll
            for (int e = 0; e < 16; ++e) { rs += (a0[e] > -1e29f ? __builtin_amdgcn_exp2f((a0[e] - mnew) * SC) : 0.f) + (a1[e] > -1e29f ? __builtin_amdgcn_exp2f((a1[e] - mnew) * SC) : 0.f); }
            rs = sum32(rs); cl = cl * __builtin_amdgcn_exp2f((cm - mnew) * SC) + rs; cm = mnew; }
        }
        st_reset(st); if (FIXED) cm = mfix / SC; else st.m = cm;
        const float icl = FIXED ? 1.f : (cl > 0.f ? 1.f / cl : 0.f);
        LAS float* irow = impw + r32 * IMP_PITCH;
        if (nct == 1) {
#pragma unroll 1
            for (int j = 16; j < 32; ++j) irow[j] = 0.f; }
#pragma unroll 1
        for (int ct = 0; ct < nct; ++ct) { const LAS unsigned char* kb = lds + (ct ? OFF_K1 : OFF_K0); const unsigned vb = (unsigned)(unsigned long)(lds + (ct ? OFF_V1 : OFF_V0)) + vlane;
            f32x16 a0, a1; qk_tile(kb, r32, hi, qf, a0, a1); const float mc = cm * SC; unsigned pp[16]; float rs = 0.f; float Ai[8], Fi[8];
#pragma unroll
            for (int kt = 0; kt < 2; ++kt)
#pragma unroll
                for (int gq = 0; gq < 4; ++gq) { float pv[4];
#pragma unroll
                    for (int e2 = 0; e2 < 4; ++e2) { const int e = gq * 4 + e2; const float sv = kt ? a1[e] : a0[e]; pv[e2] = elem_valid<1>(kt, e, hi, qloc, t, ct * 64) ? (FIXED ? __builtin_amdgcn_exp2f(sv) : __builtin_amdgcn_exp2f(sv * SC - mc)) : 0.f; }
                    pp[kt * 8 + gq * 2] = pk2(pv[0], pv[1]); pp[kt * 8 + gq * 2 + 1] = pk2(pv[2], pv[3]); rs += (pv[0] + pv[1]) + (pv[2] + pv[3]);
                    Ai[kt * 4 + gq] = (pv[0] + 2.f * (pv[1] + pv[2] + pv[3])) * icl; Fi[kt * 4 + gq] = pv[0] * icl; }
            st.l += rs;
            float Fr[8];
#pragma unroll
            for (int g8 = 0; g8 < 8; ++g8) Fr[g8] = other32(Fi[g8], hi != 0);
#pragma unroll
            for (int g8 = 0; g8 < 8; ++g8) { const float nxt = (g8 < 7) ? Fr[g8 + 1] : 0.f;
                irow[ct * 16 + 2 * g8 + hi] = Ai[g8] + (hi ? nxt : Fr[g8]); }
            if (ct == 1 && hi) irow[15] += Fr[0];
            pv_tile(vb, pp, st); }
        st.l = sum32(st.l);
        if (hi == 0) invl[w * 32 + r32] = FIXED ? (st.l > 0.f ? 1.f / st.l : 0.f) : 1.f;
        tile_store(lds, 2, tid, kr, vr);
        st_flush(st, ofin, gt[0], true);
        __syncthreads();
        if (w == 0) { unsigned mask;
            if (qb < 8) mask = (2u << qb) - 1u;
            else { mask = 1u | (1u << qb) | (1u << (qb - 1));
                const LAS float* ib = (const LAS float*)(lds + OFF_IMP) + r32 * IMP_PITCH; float iv[32];
#pragma unroll
                for (int j = 0; j < 32; ++j) { float v = 0.f;
#pragma unroll
                    for (int ww = 0; ww < 8; ++ww) v += ib[ww * 32 * IMP_PITCH + j] * invl[ww * 32 + r32];
                    iv[j] = (j >= 1 && j <= qb - 2) ? v : -3e38f; }
#pragma unroll 1
                for (int pick = 0; pick < 5; ++pick) { int best = -1; float bv = -3e38f;
#pragma unroll
                    for (int j = 1; j < 31; ++j) { const bool take = !((mask >> j) & 1u) && iv[j] > bv; bv = take ? iv[j] : bv; best = take ? j : best; }
                    if (best >= 0) mask |= 1u << best; } }
            if (hi == 0) selm[r32] = mask; unsigned um = mask;
            um |= sxu<16>(um); um |= sxu<8>(um); um |= sxu<4>(um); um |= sxu<2>(um); um |= sxu<1>(um);
            if (lane == 0) selm[32] = um; }
        __syncthreads();
        const int jlo = qb >= 8 ? qb - 8 : 0;
        { const unsigned um = selm[32]; const unsigned mq = selm[r32];
          st_reset(st);
          unsigned rem = um & ~(1u << qb);
#define SEL_POP(dst) do { if (rem) { dst = 31 - __builtin_clz(rem); rem &= ~(1u << dst); } else dst = -1; } while (0)
          int jA = qb, jB = -1, sb = 1;
          for (;;) {
              int nA, nB = -1; SEL_POP(nA); if (nA >= 0) SEL_POP(nB);
              if (nA >= 0) tile_load(ksel, vsel, nA * 64, tid, kr, vr);
              if (nB >= 0) tile_load(ksel, vsel, nB * 64, tid, kr1, vr1);
              if (nA < 0) { tile_load(kwin, vwin, qb * 64, tid, kr, vr); if (qb - 1 >= jlo) tile_load(kwin, vwin, (qb - 1) * 64, tid, kr1, vr1); }
              { const LAS unsigned char* kb = lds + OFF_K0 + (2 * sb) * KBUF; const unsigned vb = (unsigned)(unsigned long)(lds + OFF_V0 + (2 * sb) * VBUF) + vlane;
                if (jA == qb) attend_tile<2, false, FIXED>(kb, vb, r32, hi, qf, st, qloc, true, mfix);
                else attend_tile<0, true, FIXED>(kb, vb, r32, hi, qf, st, qloc, (mq >> jA) & 1u, mfix); }
              if (jB >= 0) { const LAS unsigned char* kb = lds + OFF_K0 + (2 * sb + 1) * KBUF; const unsigned vb = (unsigned)(unsigned long)(lds + OFF_V0 + (2 * sb + 1) * VBUF) + vlane;
                attend_tile<0, true, FIXED>(kb, vb, r32, hi, qf, st, qloc, (mq >> jB) & 1u, mfix); }
              if (nA < 0) break;
              tile_store(lds, 2 * (sb ^ 1), tid, kr, vr); if (nB >= 0) tile_store(lds, 2 * (sb ^ 1) + 1, tid, kr1, vr1);
              __syncthreads();
              jA = nA; jB = nB; sb ^= 1;
          }
#undef SEL_POP
          if (FIXED) st.l = sum32(st.l);
          st_flush(st, ofin, gt[1], false); }
        __syncthreads();
        { st_reset(st);
          int jA = qb, jB = (qb - 1 >= jlo) ? qb - 1 : -1, sb = 0;
          tile_store(lds, 0, tid, kr, vr); if (jB >= 0) tile_store(lds, 1, tid, kr1, vr1);
          __syncthreads();
          for (;;) {
              const int nA = (jB >= 0 && jB - 1 >= jlo) ? jB - 1 : -1, nB = (nA >= 0 && nA - 1 >= jlo) ? nA - 1 : -1;
              if (nA >= 0) tile_load(kwin, vwin, nA * 64, tid, kr, vr);
              if (nB >= 0) tile_load(kwin, vwin, nB * 64, tid, kr1, vr1);
              if (nA < 0 && ui + 1 < 8) {
                  AT_UNIT(ui + 1, qbn, bgn, qoffn);
                  const bf16_t* kcn = p.kcmp + (size_t)bgn * 128 * 64; const bf16_t* vcn = p.vcmp + (size_t)bgn * 128 * 64;
                  tile_load(kcn, vcn, 0, tid, kr, vr); if (qbn >= 16) tile_load(kcn, vcn, 64, tid, kr1, vr1); }
#define WIN_TILE(j_, bi_) do { const LAS unsigned char* kb = lds + OFF_K0 + (bi_) * KBUF; const unsigned vb = (unsigned)(unsigned long)(lds + OFF_V0 + (bi_) * VBUF) + vlane; \
                if ((j_) == qb) attend_tile<2, false, FIXED>(kb, vb, r32, hi, qf, st, qloc, true, mfix); else if ((j_) == qb - 8) attend_tile<3, false, FIXED>(kb, vb, r32, hi, qf, st, qloc, true, mfix); else attend_tile<0, false, FIXED>(kb, vb, r32, hi, qf, st, qloc, true, mfix); } while (0)
              WIN_TILE(jA, 2 * sb);
              if (jB >= 0) WIN_TILE(jB, 2 * sb + 1);
#undef WIN_TILE
              if (nA < 0) break;
              tile_store(lds, 2 * (sb ^ 1), tid, kr, vr); if (nB >= 0) tile_store(lds, 2 * (sb ^ 1) + 1, tid, kr1, vr1);
              __syncthreads();
              jA = nA; jB = nB; sb ^= 1;
          }
          if (FIXED) st.l = sum32(st.l);
          st_flush(st, ofin, gt[2], false); }
        { int l2 = lane; asm volatile("" : "+v"(l2)); unsigned char* op = (unsigned char*)p.h + ((size_t)b * S + s0 + qoff + (l2 & 31)) * D + head * 64 + 4 * (l2 >> 5);
#pragma unroll
          for (int dt = 0; dt < 2; ++dt)
#pragma unroll
            for (int gq = 0; gq < 4; ++gq) { const unsigned w0 = ofin[dt][2 * gq], w1 = ofin[dt][2 * gq + 1];
                *(unsigned*)(op + dt * 32 + 8 * gq) = pk4_fp8(__uint_as_float(w0 << 16) * F8_SA, __uint_as_float(w0 & 0xFFFF0000u) * F8_SA, __uint_as_float(w1 << 16) * F8_SA, __uint_as_float(w1 & 0xFFFF0000u) * F8_SA); } }
    }
#undef AT_UNIT
}

__device__ __forceinline__ void phase_attn(const Params& p, const Frame& F) {
    const float gq = wave_max(fabsf(p.q_gain[F.lane])); const float gk = wave_max(fmaxf(fabsf(p.k_gain[F.lane]), fmaxf(fabsf(p.k_gain[64 + F.lane]), fabsf(p.k_gain[128 + F.lane]))));
    const float mfix = 64.f * 1.02f * gq * gk * at::SC;
    if (mfix < 60.f) phase_attn_t<true>(p, F, mfix);
    else phase_attn_t<false>(p, F, 0.f);
}

namespace ml {
constexpr int QP = 272, VP = 192;
constexpr int OFF_Q = 0, OFF_K = 64 * QP, OFF_V = 2 * 64 * QP, OFF_WV = OFF_V + 64 * VP, OFF_CB = OFF_WV + 64 * VP, OFF_GA = OFF_CB + 128 * VP, OFF_GAM = OFF_GA + 8192, OFF_GB = OFF_GAM + 8192,
              OFF_MP = OFF_GB + 8192, OFF_W = OFF_MP + 256, OFF_N = OFF_W + 256, OFF_RS = OFF_N + 512, OFF_QN = OFF_RS + 256, OFF_END = OFF_QN + 256;
typedef unsigned u32x4_t __attribute__((ext_vector_type(4)));
}
__device__ __forceinline__ void phase_scan(const Params& p, const Frame& F, bf16_t* hs_base  , const int hs_stride) {
    using namespace ml; using at::tr_read; using at::pk2;
    LAS unsigned char* lds = F.lds;
    const int tid = F.tid, lane = F.lane, w = F.wave, i16 = lane & 15, g = lane >> 4, r32 = lane & 31, hi = lane >> 5;
    const int b = F.bid >> 4, h = (F.bid >> 2) & 3, vs = F.bid & 3;
    LAS float* ga = (LAS float*)(lds + OFF_GA); LAS float* gam = (LAS float*)(lds + OFF_GAM); LAS float* gb = (LAS float*)(lds + OFF_GB); LAS float* mp = (LAS float*)(lds + OFF_MP);
    LAS float* wl = (LAS float*)(lds + OFF_W); LAS float* nl = (LAS float*)(lds + OFF_N); LAS float* rsl = (LAS float*)(lds + OFF_RS); LAS float* qnl = (LAS float*)(lds + OFF_QN);
    for (int ck = w; ck < 32; ck += 8) { const int pos = ck * 64 + lane; const size_t tg = ((size_t)b * S + pos) * 4 + h; const float lfv = p.lf[tg], liv = p.li[tg];
        float bs = lfv;
#pragma unroll
        for (int o = 1; o < 64; o <<= 1) { const float x = __int_as_float(__builtin_amdgcn_ds_bpermute((lane - o) * 4, __float_as_int(bs))); if (lane >= o) bs += x; }
        const float av = liv - bs; float am = av;
#pragma unroll
        for (int o = 1; o < 64; o <<= 1) { const float x = __int_as_float(__builtin_amdgcn_ds_bpermute((lane - o) * 4, __float_as_int(am))); if (lane >= o) am = fmaxf(am, x); }
        ga[pos] = av; gam[pos] = am; gb[pos] = bs; }
    for (int idx = tid; idx < 128 * VP / 4; idx += NTHR) ((LAS unsigned*)(lds + OFF_CB))[idx] = 0u;
    if (tid < 128) nl[tid] = 0.f;
    __syncthreads();
    if (tid == 0) { float m = 0.f;
#pragma unroll 1
        for (int k = 0; k < 32; ++k) { mp[k] = m; m = gb[k * 64 + 63] + fmaxf(m, gam[k * 64 + 63]); } }
    __syncthreads();
    const bf16_t* pq = p.proj + (size_t)b * S * 3072 + h * 128; const bf16_t* pk = pq + 512; bf16_t* pv = p.proj + (size_t)b * S * 3072 + 1024 + h * 256 + vs * 64;
    uint4 rq[2], rk[2], rv;
#define ML_LOAD(ck_) do { const size_t t0_ = (size_t)(ck_) * 64; _Pragma("unroll") for (int i_ = 0; i_ < 2; ++i_) { const int idx_ = tid + 512 * i_; const size_t o_ = (t0_ + (idx_ >> 4)) * 3072 + (idx_ & 15) * 8; rq[i_] = *(const uint4*)(pq + o_); rk[i_] = *(const uint4*)(pk + o_); } \
        rv = *(const uint4*)(pv + (t0_ + (tid >> 3)) * 3072 + (tid & 7) * 8); } while (0)
#define ML_STORE(ck_) do { _Pragma("unroll") for (int i_ = 0; i_ < 2; ++i_) { const int idx_ = tid + 512 * i_; const int o_ = (idx_ >> 4) * QP + (idx_ & 15) * 16; \
            *(LAS u32x4_t*)(lds + OFF_Q + o_) = (u32x4_t){rq[i_].x, rq[i_].y, rq[i_].z, rq[i_].w}; *(LAS u32x4_t*)(lds + OFF_K + o_) = (u32x4_t){rk[i_].x, rk[i_].y, rk[i_].z, rk[i_].w}; } \
        { const int s_ = tid >> 3; const float m63_ = fmaxf(mp[ck_], gam[(ck_) * 64 + 63]); const float ws_ = __expf(ga[(ck_) * 64 + s_] - m63_); if ((tid & 7) == 0) wl[s_] = ws_; \
          const int o_ = s_ * VP + (tid & 7) * 16; *(LAS u32x4_t*)(lds + OFF_V + o_) = (u32x4_t){rv.x, rv.y, rv.z, rv.w}; const unsigned vv_[4] = {rv.x, rv.y, rv.z, rv.w}; unsigned ww_[4]; \
          _Pragma("unroll") for (int e_ = 0; e_ < 4; ++e_) ww_[e_] = pk2(__uint_as_float(vv_[e_] << 16) * ws_, __uint_as_float(vv_[e_] & 0xFFFF0000u) * ws_); \
          *(LAS u32x4_t*)(lds + OFF_WV + o_) = (u32x4_t){ww_[0], ww_[1], ww_[2], ww_[3]}; } } while (0)
    ML_LOAD(0); ML_STORE(0);
    __syncthreads();
    const int tt = w >> 1, vh = w & 1;
    const int dt = w >> 1, vt2 = w & 1;
    const unsigned trl16 = (unsigned)(((lane & 15) >> 2) * VP + (4 * (lane & 3)) * 2);
    const unsigned trl32v = (unsigned)(((lane & 15) >> 2) * VP + (16 * ((lane >> 4) & 1) + 4 * (lane & 3)) * 2);
    const unsigned trl32k = (unsigned)(((lane & 15) >> 2) * QP + (16 * ((lane >> 4) & 1) + 4 * (lane & 3)) * 2);
    f32x16 cacc;
#pragma unroll
    for (int e = 0; e < 16; ++e) cacc[e] = 0.f;
    float nreg = 0.f;
    bf16_t* const hs_out = hs_base + (size_t)b * S * hs_stride + h * 256 + vs * 64 + 32 * vh + i16;
    const size_t wo1 = (size_t)NE * D * DE; const ColGateUp cgu{p.w_gate + wo1, p.w_up + wo1}; const ColDown cdn{p.w_down + wo1};
    LAS float* ptile = (LAS float*)(lds + OFF_END) + (tid >> 8) * (64 * 65); const int htid = tid & 255, half = tid >> 8;
    float pr_[16];
#define PREP_LOAD(s_) do { const bool gu_ = (s_) < 16; const int tl_ = (((gu_ ? (s_) : (s_) - 16) * F.G + F.bid) * 2 + half); const int c0_ = (tl_ & 511) * 64, k0_ = (tl_ >> 9) * 64; \
        const float* p_ = gu_ ? cgu(c0_ + (htid & 63)) : cdn(c0_ + (htid & 63)); const int ldw_ = gu_ ? DE : D; p_ += (size_t)(k0_ + (htid >> 6)) * ldw_; \
        _Pragma("unroll") for (int i_ = 0; i_ < 16; ++i_) pr_[i_] = p_[(size_t)(4 * i_) * ldw_]; } while (0)
#define PREP_WRITE() do { _Pragma("unroll") for (int i_ = 0; i_ < 16; ++i_) ptile[((htid >> 6) + 4 * i_) * 65 + (htid & 63)] = pr_[i_]; } while (0)
#define PREP_STORE(s_) do { const bool gu_ = (s_) < 16; const int tl_ = (((gu_ ? (s_) : (s_) - 16) * F.G + F.bid) * 2 + half); const int c0_ = (tl_ & 511) * 64, k0_ = (tl_ >> 9) * 64; \
        const int cc_ = htid >> 2, ch_ = (htid & 3) * 16; \
        { const float sc_ = gu_ ? F8_SW : F8_SW2; const unsigned long long a_ = (unsigned long long)p.gu_t, d_ = (unsigned long long)p.dn_t - a_; unsigned char* base_ = (unsigned char*)(a_ + (gu_ ? 0ull : d_)); const int kp_ = gu_ ? D : DE; \
          unsigned w_[4]; _Pragma("unroll") for (int i_ = 0; i_ < 4; ++i_) w_[i_] = pk4_fp8(ptile[(ch_ + 4 * i_) * 65 + cc_] * sc_, ptile[(ch_ + 4 * i_ + 1) * 65 + cc_] * sc_, ptile[(ch_ + 4 * i_ + 2) * 65 + cc_] * sc_, ptile[(ch_ + 4 * i_ + 3) * 65 + cc_] * sc_); \
          *(uint4*)(base_ + (size_t)(c0_ + cc_) * kp_ + k0_ + ch_) = make_uint4(w_[0], w_[1], w_[2], w_[3]); } } while (0)
    PREP_LOAD(0);
#pragma unroll 1
    for (int ck = 0; ck < 32; ++ck) {
        if (ck + 1 < 32) ML_LOAD(ck + 1);
        const float mprev = mp[ck]; const int c0 = ck * 64;
        bf16x8 qf[4];
#pragma unroll
        for (int ks = 0; ks < 4; ++ks) qf[ks] = *(const LAS bf16x8*)(lds + OFF_Q + (16 * tt + i16) * QP + (32 * ks + 8 * g) * 2);
        f32x4 st[4];
#pragma unroll
        for (int jt = 0; jt < 4; ++jt) { st[jt] = (f32x4){0.f, 0.f, 0.f, 0.f};
#pragma unroll
            for (int ks = 0; ks < 4; ++ks) { const bf16x8 kf = *(const LAS bf16x8*)(lds + OFF_K + (16 * jt + i16) * QP + (32 * ks + 8 * g) * 2); st[jt] = __builtin_amdgcn_mfma_f32_16x16x32_bf16(kf, qf[ks], st[jt], 0, 0, 0); } }
        const int tl = 16 * tt + i16; const float Mt = fmaxf(mprev, gam[c0 + tl]); float rs = 0.f; unsigned ap[8];
#pragma unroll
        for (int jt = 0; jt < 4; ++jt) { float v4[4]; const f32x4 ga4 = *(const LAS f32x4*)(ga + c0 + 16 * jt + 4 * g);
#pragma unroll
            for (int r = 0; r < 4; ++r) { const int j = 16 * jt + 4 * g + r; const float e = __expf(ga4[r] - Mt) * st[jt][r]; v4[r] = (j <= tl) ? e : 0.f; rs += v4[r]; }
            ap[jt * 2] = pk2(v4[0], v4[1]); ap[jt * 2 + 1] = pk2(v4[2], v4[3]); }
        rs = sum16(rs); rs = sum32(rs);
        float qn = 0.f;
#pragma unroll
        for (int ks = 0; ks < 4; ++ks) { const f32x4 n0 = *(const LAS f32x4*)(nl + 32 * ks + 8 * g), n1 = *(const LAS f32x4*)(nl + 32 * ks + 8 * g + 4);
#pragma unroll
            for (int e = 0; e < 4; ++e) { qn += bf2f((bf16_t)qf[ks][e]) * n0[e]; qn += bf2f((bf16_t)qf[ks][4 + e]) * n1[e]; } }
        qn = sum16(qn); qn = sum32(qn);
        if (vh == 0 && g == 0) { rsl[tl] = rs; qnl[tl] = qn; }
        f32x4 av[2], qc[2];
#pragma unroll
        for (int vt = 0; vt < 2; ++vt) { av[vt] = (f32x4){0.f, 0.f, 0.f, 0.f}; qc[vt] = (f32x4){0.f, 0.f, 0.f, 0.f}; }
        {   const unsigned vb = (unsigned)(unsigned long)(lds + OFF_V) + trl16 + (unsigned)(4 * g * VP + (32 * vh) * 2);
            const unsigned cb = (unsigned)(unsigned long)(lds + OFF_CB) + trl16 + (unsigned)(8 * g * VP + (32 * vh) * 2);
            s16x4 va[2][2][2], ca[4][2][2];
#pragma unroll
            for (int vt = 0; vt < 2; ++vt) {
                if (vt == 0) { va[0][0][0] = tr_read<0 * VP>(vb); va[0][0][1] = tr_read<16 * VP>(vb); va[1][0][0] = tr_read<32 * VP>(vb); va[1][0][1] = tr_read<48 * VP>(vb);
                    ca[0][0][0] = tr_read<0 * VP>(cb); ca[0][0][1] = tr_read<4 * VP>(cb); ca[1][0][0] = tr_read<32 * VP>(cb); ca[1][0][1] = tr_read<36 * VP>(cb);
                    ca[2][0][0] = tr_read<64 * VP>(cb); ca[2][0][1] = tr_read<68 * VP>(cb); ca[3][0][0] = tr_read<96 * VP>(cb); ca[3][0][1] = tr_read<100 * VP>(cb); }
                else { va[0][1][0] = tr_read<0 * VP + 32>(vb); va[0][1][1] = tr_read<16 * VP + 32>(vb); va[1][1][0] = tr_read<32 * VP + 32>(vb); va[1][1][1] = tr_read<48 * VP + 32>(vb);
                    ca[0][1][0] = tr_read<0 * VP + 32>(cb); ca[0][1][1] = tr_read<4 * VP + 32>(cb); ca[1][1][0] = tr_read<32 * VP + 32>(cb); ca[1][1][1] = tr_read<36 * VP + 32>(cb);
                    ca[2][1][0] = tr_read<64 * VP + 32>(cb); ca[2][1][1] = tr_read<68 * VP + 32>(cb); ca[3][1][0] = tr_read<96 * VP + 32>(cb); ca[3][1][1] = tr_read<100 * VP + 32>(cb); } }
            asm volatile("s_waitcnt lgkmcnt(0)" ::: "memory"); __builtin_amdgcn_sched_barrier(0);
#pragma unroll
            for (int vt = 0; vt < 2; ++vt) {
#pragma unroll
                for (int pp = 0; pp < 2; ++pp) { const bf16x8 bfv = (bf16x8){va[pp][vt][0][0], va[pp][vt][0][1], va[pp][vt][0][2], va[pp][vt][0][3], va[pp][vt][1][0], va[pp][vt][1][1], va[pp][vt][1][2], va[pp][vt][1][3]};
                    const u32x4_t aw = (u32x4_t){ap[4 * pp], ap[4 * pp + 1], ap[4 * pp + 2], ap[4 * pp + 3]};
                    av[vt] = __builtin_amdgcn_mfma_f32_16x16x32_bf16(__builtin_bit_cast(bf16x8, aw), bfv, av[vt], 0, 0, 0); }
#pragma unroll
                for (int ks = 0; ks < 4; ++ks) { const bf16x8 bfc = (bf16x8){ca[ks][vt][0][0], ca[ks][vt][0][1], ca[ks][vt][0][2], ca[ks][vt][0][3], ca[ks][vt][1][0], ca[ks][vt][1][1], ca[ks][vt][1][2], ca[ks][vt][1][3]};
                    qc[vt] = __builtin_amdgcn_mfma_f32_16x16x32_bf16(qf[ks], bfc, qc[vt], 0, 0, 0); } }
        }
        const float M63 = fmaxf(mprev, gam[c0 + 63]); const float decay = __expf(mprev - M63);
        {   const unsigned kb = (unsigned)(unsigned long)(lds + OFF_K) + trl32k + (unsigned)(8 * hi * QP + (32 * dt) * 2);
            const unsigned wb = (unsigned)(unsigned long)(lds + OFF_WV) + trl32v + (unsigned)(8 * hi * VP + (32 * vt2) * 2);
            s16x4 ka[4][2], wa[4][2];
            ka[0][0] = tr_read<0 * QP>(kb); ka[0][1] = tr_read<4 * QP>(kb); ka[1][0] = tr_read<16 * QP>(kb); ka[1][1] = tr_read<20 * QP>(kb);
            ka[2][0] = tr_read<32 * QP>(kb); ka[2][1] = tr_read<36 * QP>(kb); ka[3][0] = tr_read<48 * QP>(kb); ka[3][1] = tr_read<52 * QP>(kb);
            wa[0][0] = tr_read<0 * VP>(wb); wa[0][1] = tr_read<4 * VP>(wb); wa[1][0] = tr_read<16 * VP>(wb); wa[1][1] = tr_read<20 * VP>(wb);
            wa[2][0] = tr_read<32 * VP>(wb); wa[2][1] = tr_read<36 * VP>(wb); wa[3][0] = tr_read<48 * VP>(wb); wa[3][1] = tr_read<52 * VP>(wb);
            asm volatile("s_waitcnt lgkmcnt(0)" ::: "memory"); __builtin_amdgcn_sched_barrier(0);
#pragma unroll
            for (int e = 0; e < 16; ++e) cacc[e] *= decay;
#pragma unroll
            for (int ks = 0; ks < 4; ++ks) { const bf16x8 fa = (bf16x8){ka[ks][0][0], ka[ks][0][1], ka[ks][0][2], ka[ks][0][3], ka[ks][1][0], ka[ks][1][1], ka[ks][1][2], ka[ks][1][3]};
                const bf16x8 fb = (bf16x8){wa[ks][0][0], wa[ks][0][1], wa[ks][0][2], wa[ks][0][3], wa[ks][1][0], wa[ks][1][1], wa[ks][1][2], wa[ks][1][3]};
                cacc = __builtin_amdgcn_mfma_f32_32x32x16_bf16(fa, fb, cacc, 0, 0, 0); } }
        { const int d_ = tid & 127, part_ = tid >> 7; float acc = 0.f;
#pragma unroll
            for (int s = 0; s < 16; ++s) acc += wl[16 * part_ + s] * bf2f(*(const LAS bf16_t*)(lds + OFF_K + (16 * part_ + s) * QP + d_ * 2));
            ((LAS float*)(lds + LDS_CONST))[part_ * 128 + d_] = acc; }
        if (ck < 24) { PREP_WRITE(); if (ck + 1 < 24) PREP_LOAD(ck + 1); }
        __syncthreads();
        if (ck < 24) PREP_STORE(ck);
        { const int tr0 = 16 * tt + 4 * g;
          const f32x4 gam4 = *(const LAS f32x4*)(gam + c0 + tr0), gb4 = *(const LAS f32x4*)(gb + c0 + tr0), rs4 = *(const LAS f32x4*)(rsl + tr0), qn4 = *(const LAS f32x4*)(qnl + tr0);
          bf16_t* hp = hs_out + (size_t)(c0 + tr0) * hs_stride;
#pragma unroll
          for (int r = 0; r < 4; ++r) { const float Mr = fmaxf(mprev, gam4[r]); const float inter = __expf(mprev - Mr), mt = gb4[r] + Mr;
            const float den = rs4[r] + inter * qn4[r]; const float dd = __builtin_amdgcn_rcpf(fmaxf(fabsf(den), __expf(-mt)));
#pragma unroll
            for (int vt = 0; vt < 2; ++vt) { const float hv = (av[vt][r] + inter * qc[vt][r]) * dd; hp[(size_t)r * hs_stride + 16 * vt] = f2bf(hv); } } }
#pragma unroll
        for (int e = 0; e < 16; ++e) { const int d = 32 * dt + (e & 3) + 8 * (e >> 2) + 4 * hi; *(LAS bf16_t*)(lds + OFF_CB + d * VP + (32 * vt2 + r32) * 2) = f2bf(cacc[e]); }
        if (tid < 128) { const LAS float* np_ = (const LAS float*)(lds + LDS_CONST); nreg = decay * nreg + ((np_[tid] + np_[128 + tid]) + (np_[256 + tid] + np_[384 + tid])); nl[tid] = nreg; }
        if (ck + 1 < 32) ML_STORE(ck + 1);
        __syncthreads();
    }
#undef ML_LOAD
#undef ML_STORE
#undef PREP_LOAD
#undef PREP_WRITE
#undef PREP_STORE
}

__device__ __forceinline__ void phase_ml_gate(const Params& p, const Frame& F, unsigned char* a8) {
    const int step = F.G * 8;
#pragma unroll 1
    for (int gw = F.bid * 8 + F.wave; gw < T * 4; gw += 4 * step) { uint2 hv2[4], ov2[4];
#pragma unroll
        for (int k = 0; k < 4; ++k) { const int g_ = gw + k * step; const bf16_t* pr = p.proj + (size_t)(g_ >> 2) * 3072 + (g_ & 3) * 256 + 4 * F.lane; hv2[k] = *(const uint2*)(pr + 1024); ov2[k] = *(const uint2*)(pr + 2048); }
#pragma unroll
        for (int k = 0; k < 4; ++k) { const int g_ = gw + k * step, t = g_ >> 2, h = g_ & 3; const float4 g4 = *(const float4*)(p.ml_ng + h * 256 + 4 * F.lane);
            const float h0 = __uint_as_float(hv2[k].x << 16), h1 = __uint_as_float(hv2[k].x & 0xFFFF0000u), h2 = __uint_as_float(hv2[k].y << 16), h3 = __uint_as_float(hv2[k].y & 0xFFFF0000u);
            float ss = h0 * h0 + h1 * h1 + h2 * h2 + h3 * h3; ss = wave_sum(ss); const float rs = rsqrtf(ss * (1.f / 256.f) + 1e-6f) * F8_SA;
            *(unsigned*)(a8 + (size_t)t * D + h * 256 + 4 * F.lane) = pk4_fp8(__uint_as_float(ov2[k].x << 16) * h0 * rs * g4.x, __uint_as_float(ov2[k].x & 0xFFFF0000u) * h1 * rs * g4.y, __uint_as_float(ov2[k].y << 16) * h2 * rs * g4.z, __uint_as_float(ov2[k].y & 0xFFFF0000u) * h3 * rs * g4.w); } }
}
__device__ __forceinline__ void phase_final(const Params& p, const Frame& F, float* dst) {
    const float* mg = p.mod + (size_t)16 * 6144 + 5 * D;
    for (size_t i4 = (size_t)F.bid * NTHR + F.tid; i4 < (size_t)T * D / 4; i4 += (size_t)F.G * NTHR) { const size_t i = i4 * 4; const int col = (int)(i % D), row = (int)(i / D), b = row / S;
        const uint2 xw = *(const uint2*)(p.xb13 + i); const float4 xv = make_float4(__uint_as_float(xw.x << 16), __uint_as_float(xw.x & 0xFFFF0000u), __uint_as_float(xw.y << 16), __uint_as_float(xw.y & 0xFFFF0000u)); const float4 g = *(const float4*)(mg + b * 6144 + col); const uint2 a0 = *(const uint2*)(p.outk + i), a1 = *(const uint2*)(p.outk + (size_t)T * D + i);
        float4 o; o.x = xv.x + g.x * (__uint_as_float(a0.x << 16) + __uint_as_float(a1.x << 16)); o.y = xv.y + g.y * (__uint_as_float(a0.x & 0xFFFF0000u) + __uint_as_float(a1.x & 0xFFFF0000u));
        o.z = xv.z + g.z * (__uint_as_float(a0.y << 16) + __uint_as_float(a1.y << 16)); o.w = xv.w + g.w * (__uint_as_float(a0.y & 0xFFFF0000u) + __uint_as_float(a1.y & 0xFFFF0000u));
        *(float4*)(dst + i) = o; }
}

__global__ void __launch_bounds__(NTHR, 2) mega_fwd(Params p) {
    extern __shared__ __attribute__((aligned(16))) unsigned char lds_raw[];
    Frame F; F.lds = (LAS unsigned char*)lds_raw; F.tid = threadIdx.x; F.lane = F.tid & 63; F.wave = __builtin_amdgcn_readfirstlane(F.tid >> 6); F.bid = blockIdx.x; F.G = gridDim.x;
    volatile LAS unsigned* misc = (volatile LAS unsigned*)(F.lds + LDS_MISC);
    LAS Params* P = (LAS Params*)(F.lds + LDS_PARAMS);
    if (F.tid < 16) misc[F.tid] = 0u;
    if (F.tid == 64) {
#define X(t, n) P->n = p.n;
        PARAM_LIST(X)
#undef X
    }
    __syncthreads();
    { XcdBarrier b0 = xcd_barrier_post(uni_ptr(P->bar), misc); if (F.tid == 0) misc[2] = b0.x; }
    __syncthreads();
#define GRID_BAR() do { XcdBarrier bb_; bb_.bar = uni_ptr(P->bar); bb_.x = (unsigned)__builtin_amdgcn_readfirstlane((int)misc[2]); bb_.st = misc; xcd_barrier(bb_, F.wave == 0 && lane_id_asm() == 0); } while (0)
    LAS unsigned char* stage = F.lds;
#define MOD0 (q.mod)
#define MOD1 (q.mod + (size_t)16 * 6144)

    { Params q; LP(rope); LP(h); phase_prologue_a(q, launder(F)); }
    { Params q; LP(c); LP(ada_w); LP(ada_b); LP(mod); LP(cmp_pe); LP(cmp_w1); LP(cmp_b1); LP(cb1); phase_prologue_b(q, launder(F)); }
    { Params q; LP(nsa_w_in); LP(win_nsa_t); prep_weights<true>(launder(F), q.win_nsa_t, 2048, D, NSA_COLS, ColPlain{q.nsa_w_in, NSA_COLS, 0}, F.bid, F.G, F8_SW); }
    { Params q; LP(nsa_w_out); LP(wo_nsa_t); prep_weights<true>(launder(F), q.wo_nsa_t, D, D, D, ColPlain{q.nsa_w_out, D, 0}, F.bid, F.G, F8_SW); }
    { Params q; LP(ml_w_in); LP(win_ml_t); prep_weights<true>(launder(F), q.win_ml_t, 3072, D, ML_COLS, ColPlain{q.ml_w_in, 3072, 0}, F.bid, F.G, F8_SW); }
    { Params q; LP(ml_w_out); LP(wo_ml_t); prep_weights<true>(launder(F), q.wo_ml_t, D, D, D, ColPlain{q.ml_w_out, D, 0}, F.bid, F.G, F8_SW); }
    { Params q; LP(cmp_w1); LP(w1c_t); prep_weights(launder(F), q.w1c_t, 256, 2048, 256, ColPlain{q.cmp_w1, 256, 0}, F.bid, F.G);
      prep_weights(launder(F), q.w1c_t + (size_t)256 * 2048, 256, 2048, 256, ColPlain{q.cmp_w1 + (size_t)2048 * 256, 256, 0}, F.bid, F.G); }
    { Params q; LP(w_gate); LP(w_up); LP(w_down); LP(gu_t); LP(dn_t); prep_moe_weights(q, launder(F), 0, F.bid, F.G); }
    GRID_BAR();
    { Params q; LP(x); LP(g_mix); LP(mod); LP(h);
      phase_norm<0, false>(q, launder(F), q.x, nullptr, q.g_mix, MOD0 + 0 * D, MOD0 + 1 * D, nullptr, 0); }
    GRID_BAR();
    { Params q; LP(h); LP(win_nsa_t); LP(q_gain); LP(k_gain); LP(rope); LP(q); LP(kv); LP(gates);
      ge::DenseOrder So; So.init(T, 2048, F.G, F.bid);
      ge::gemm_phase<true>(stage, q.h, q.win_nsa_t, D, So, ge::DenseRows{(unsigned)D}, EpiNsaIn{q.q_gain, q.k_gain, q.rope, q.q, q.kv, q.gates, 1.f / (F8_SA * F8_SW)}, F.wave); }
    GRID_BAR();
    {
      Params q; LP(kv); LP(w1c_t); LP(cpart);
      const int w = F.bid >> 7, mt = (F.bid >> 3) & 15, ks = F.bid & 7; OneUnit So{mt};
      ge::gemm_phase(stage, q.kv + (size_t)w * T * 128 + ks * 256, q.w1c_t + (size_t)w * 256 * 2048 + ks * 256, 256, So, ge::DenseRows{2048u}, EpiCmpPart{q.cpart + (size_t)(w * 8 + ks) * 4096 * 256}, F.wave, 2048); }
    GRID_BAR();
    { Params q; LP(cpart); LP(cb1); LP(cmp_w2); LP(cmp_b2); LP(k_gain); LP(rope); LP(kcmp); LP(vcmp);
      phase_cmp2(q, launder(F)); }
    GRID_BAR();
    { Params q; LP(q); LP(kv); LP(kcmp); LP(vcmp); LP(gates); LP(h); LP(q_gain); LP(k_gain);
      phase_attn(q, launder(F)); }
    GRID_BAR();
    { Params q; LP(h); LP(wo_nsa_t); LP(x); LP(mod); LP(xb13);
      ge::DenseOrder So; So.init(T, D, F.G, F.bid);
      ge::gemm_phase<true>(stage, q.h, q.wo_nsa_t, D, So, ge::DenseRows{(unsigned)D}, EpiResid<false>{q.x, MOD0 + 2 * D, q.xb13, 1.f / (F8_SA * F8_SW)}, F.wave); }
    GRID_BAR();
    { Params q; LP(xb13); LP(g_ffn); LP(mod); LP(h); LP(router_w); LP(router_b); LP(tokw); LP(cnt); LP(list);
      phase_norm_route(q, launder(F), q.xb13, q.g_ffn, MOD0 + 3 * D, MOD0 + 4 * D, 0); }
    GRID_BAR();
    { Params q; LP(cnt); LP(list); LP(h); LP(gu_t); LP(hid);
      LAS int* mtab = (LAS int*)(F.lds + LDS_MISC + 64); LAS int* tkt = (LAS int*)(F.lds + LDS_CONST); moe_plan(launder(F), q.cnt, q.list, mtab, tkt, 4); MoeOrder So{mtab};
      ge::gemm_phase<true>(stage, q.h, q.gu_t, D, So, MoeRows{tkt}, EpiMoe1{(unsigned char*)q.hid, 1.f / (F8_SA * F8_SW)}, F.wave); }
    GRID_BAR();
    { Params q; LP(cnt); LP(list); LP(hid); LP(dn_t); LP(outk); LP(tokw);
      LAS int* mtab = (LAS int*)(F.lds + LDS_MISC + 64); LAS int* tkt = (LAS int*)(F.lds + LDS_CONST); LAS float* tkw = (LAS float*)(F.lds + 131072); moe_plan(launder(F), q.cnt, q.list, mtab, tkt, 4, q.tokw, tkw, 1.f / (F8_SH * F8_SW2)); MoeOrder So{mtab};
      ge::gemm_phase<true>(stage, q.hid, q.dn_t, DE, So, ge::DenseRows{(unsigned)DE}, EpiMoe2{q.outk, tkt, tkw}, F.wave); }
    GRID_BAR();
    { Params q; LP(xb13); LP(xb2); LP(g_mix); LP(mod); LP(h); LP(outk); LP(ml_w_in); LP(ml_bi); LP(ml_bf); LP(li); LP(lf);
      phase_norm<2, true>(q, launder(F), q.xb13, q.xb2, q.g_mix + D, MOD1 + 0 * D, MOD1 + 1 * D, MOD0 + 5 * D, 1); }
    GRID_BAR();
    { Params q; LP(h); LP(win_ml_t); LP(proj);
      ge::DenseOrder So; So.init(T, 3072, F.G, F.bid);
      ge::gemm_phase<true>(stage, q.h, q.win_ml_t, D, So, ge::DenseRows{(unsigned)D}, EpiMlIn{q.proj, 1.f / (F8_SA * F8_SW)}, F.wave); }
    GRID_BAR();
    { Params q; LP(proj); LP(li); LP(lf); LP(w_gate); LP(w_up); LP(w_down); LP(gu_t); LP(dn_t);
      phase_scan(q, launder(F), q.proj + 1024, 3072); }
    GRID_BAR();
    { Params q; LP(proj); LP(ml_ng); LP(h);
      phase_ml_gate(q, launder(F), (unsigned char*)q.h); }
    GRID_BAR();
    { Params q; LP(h); LP(wo_ml_t); LP(xb2); LP(mod); LP(xb13);
      ge::DenseOrder So; So.init(T, D, F.G, F.bid);
      ge::gemm_phase<true>(stage, q.h, q.wo_ml_t, D, So, ge::DenseRows{(unsigned)D}, EpiResid<true>{q.xb2, MOD1 + 2 * D, q.xb13, 1.f / (F8_SA * F8_SW)}, F.wave); }
    GRID_BAR();
    { Params q; LP(xb13); LP(g_ffn); LP(mod); LP(h); LP(router_w); LP(router_b); LP(tokw); LP(cnt); LP(list);
      phase_norm_route(q, launder(F), q.xb13, q.g_ffn + D, MOD1 + 3 * D, MOD1 + 4 * D, 1); }
    GRID_BAR();
    { Params q; LP(cnt); LP(list); LP(h); LP(gu_t); LP(hid);
      LAS int* mtab = (LAS int*)(F.lds + LDS_MISC + 64); LAS int* tkt = (LAS int*)(F.lds + LDS_CONST); moe_plan(launder(F), q.cnt + 64, q.list, mtab, tkt, 4); MoeOrder So{mtab};
      ge::gemm_phase<true>(stage, q.h, q.gu_t, D, So, MoeRows{tkt}, EpiMoe1{(unsigned char*)q.hid, 1.f / (F8_SA * F8_SW)}, F.wave); }
    GRID_BAR();
    { Params q; LP(cnt); LP(list); LP(hid); LP(dn_t); LP(outk); LP(tokw);
      LAS int* mtab = (LAS int*)(F.lds + LDS_MISC + 64); LAS int* tkt = (LAS int*)(F.lds + LDS_CONST); LAS float* tkw = (LAS float*)(F.lds + 131072); moe_plan(launder(F), q.cnt + 64, q.list, mtab, tkt, 4, q.tokw, tkw, 1.f / (F8_SH * F8_SW2)); MoeOrder So{mtab};
      ge::gemm_phase<true>(stage, q.hid, q.dn_t, DE, So, ge::DenseRows{(unsigned)DE}, EpiMoe2{q.outk, tkt, tkw}, F.wave); }
    GRID_BAR();
    { Params q; LP(mod); LP(out); LP(outk); LP(xb13);
      phase_final(q, launder(F), q.out); }
}

static inline size_t al(size_t x) { return (x + 255) & ~(size_t)255; }
extern "C" void kernel_launch(void* const* d_in, const int* in_sizes, int n_in, void* d_out, int out_size, void* d_ws, size_t ws_size, hipStream_t stream) {
    char* ws = (char*)d_ws; size_t off = 0;
    auto take = [&](size_t bytes) { size_t o = off; off = al(off + bytes); return o; };
    Params p{};
    const float** pin = (const float**)&p;
    for (int i = 0; i < 25; ++i) pin[i] = (const float*)d_in[i];
    p.out = (float*)d_out;
    const size_t ctl_bytes = (size_t)XCD_BAR_WORDS * 4 + 1024;
    p.bar = (unsigned*)(ws + take(ctl_bytes)); p.cnt = (int*)(p.bar + XCD_BAR_WORDS); p.dcnt = p.cnt + 128;
    p.mod = (float*)(ws + take((size_t)2 * 16 * 6144 * 4)); p.rope = (float*)(ws + take(2048 * 16 * 4)); p.cb1 = (float*)(ws + take(512 * 4));
    p.tokw = (float*)(ws + take((size_t)T * 2 * 4)); p.list = (int*)(ws + take((size_t)NE * T * 4)); p.dlist = (int*)(ws + take((size_t)NE * T * 4)); p.li = (float*)(ws + take((size_t)T * 4 * 4)); p.lf = (float*)(ws + take((size_t)T * 4 * 4));
    p.h = (bf16_t*)(ws + take((size_t)(T + 8) * D * 2)); p.hidc = (bf16_t*)(ws + take((size_t)2 * 4096 * 256 * 2)); p.xb13 = (bf16_t*)(ws + take((size_t)T * D * 2)); p.xb2 = (bf16_t*)(ws + take((size_t)T * D * 2));
    p.wo_nsa_t = (bf16_t*)(ws + take((size_t)D * D * 2)); p.wo_ml_t = (bf16_t*)(ws + take((size_t)D * D * 2));
    p.win_nsa_t = (bf16_t*)(ws + take((size_t)2048 * D * 2)); p.win_ml_t = (bf16_t*)(ws + take((size_t)3072 * D * 2)); p.w1c_t = (bf16_t*)(ws + take((size_t)2 * 256 * 2048 * 2));
    p.gu_t = (bf16_t*)(ws + take((size_t)NE * 1024 * D * 2)); p.dn_t = (bf16_t*)(ws + take((size_t)NE * D * DE * 2));
    const size_t r1 = off;
    p.q = (bf16_t*)(ws + take((size_t)T * D * 2)); p.kv = (bf16_t*)(ws + take((size_t)6 * T * 128 * 2 + (1 << 20)));
    p.gates = (float*)(ws + take((size_t)T * 48 * 4)); p.kcmp = (bf16_t*)(ws + take((size_t)32 * 128 * 64 * 2)); p.vcmp = (bf16_t*)(ws + take((size_t)32 * 128 * 64 * 2));
    p.cpart = (float*)(ws + take((size_t)2 * 8 * 4096 * 256 * 4));
    const size_t end_nsa = off; off = r1;
    p.proj = (bf16_t*)(ws + take((size_t)T * 3072 * 2)); const size_t end_ml = off; off = r1;
    p.hid = (bf16_t*)(ws + take((size_t)(65536 + 8192) * DE * 2)); p.outk = (bf16_t*)(ws + take((size_t)2 * T * D * 2)); const size_t end_moe = off;
    size_t need = end_nsa > end_ml ? end_nsa : end_ml; if (end_moe > need) need = end_moe;
    if (need > ws_size || n_in != 25) return;
    static bool attr_done = false;
    if (!attr_done) { (void)hipFuncSetAttribute((const void*)mega_fwd, hipFuncAttributeMaxDynamicSharedMemorySize, LDS_BYTES); attr_done = true; }
    (void)hipMemsetAsync(p.bar, 0, ctl_bytes, stream);
    hipLaunchKernelGGL(mega_fwd, dim3(NWG), dim3(NTHR), LDS_BYTES, stream, p);
}
```

```cpp
#include <hip/hip_runtime.h>
#include <stdint.h>

typedef unsigned short bf16_t;
__device__ __forceinline__ float bf2f(bf16_t v) { return __uint_as_float(((unsigned)v) << 16); }
typedef float f32x2_t __attribute__((ext_vector_type(2)));
__device__ __forceinline__ unsigned pk2g(float a, float b) { typedef __bf16 b2 __attribute__((ext_vector_type(2))); b2 r = __builtin_convertvector((f32x2_t){a, b}, b2); return __builtin_bit_cast(unsigned, r); }
__device__ __forceinline__ bf16_t f2bf(float f) { return (bf16_t)pk2g(f, f); }

constexpr int Bn = 16, S = 2048, D = 1024, T = Bn * S;
constexpr int NSA_COLS = 1840, ML_COLS = 3080;
constexpr int NE = 32, DE = 512;
constexpr int NWG = 256, NTHR = 512;

template <int M> __device__ __forceinline__ float sx(float v) { return __int_as_float(__builtin_amdgcn_ds_swizzle(__float_as_int(v), (M << 10) | 0x1F)); }
template <int M> __device__ __forceinline__ unsigned sxu(unsigned v) { return (unsigned)__builtin_amdgcn_ds_swizzle((int)v, (M << 10) | 0x1F); }
__device__ __forceinline__ float sum32(float v) { const auto r = __builtin_amdgcn_permlane32_swap(__float_as_uint(v), __float_as_uint(v), false, false); return __uint_as_float(r[0]) + __uint_as_float(r[1]); }
__device__ __forceinline__ float max32(float v) { const auto r = __builtin_amdgcn_permlane32_swap(__float_as_uint(v), __float_as_uint(v), false, false); return fmaxf(__uint_as_float(r[0]), __uint_as_float(r[1])); }
__device__ __forceinline__ float other32(float v, bool hi) { const auto r = __builtin_amdgcn_permlane32_swap(__float_as_uint(v), __float_as_uint(v), false, false); return __uint_as_float(hi ? r[0] : r[1]); }
template <int CTRL> __device__ __forceinline__ float dppf(float v) { return __int_as_float(__builtin_amdgcn_update_dpp(0, __float_as_int(v), CTRL, 0xF, 0xF, true)); }
__device__ __forceinline__ float sum16(float v) { const auto r = __builtin_amdgcn_permlane16_swap(__float_as_uint(v), __float_as_uint(v), false, false); return __uint_as_float(r[0]) + __uint_as_float(r[1]); }
__device__ __forceinline__ float max16(float v) { const auto r = __builtin_amdgcn_permlane16_swap(__float_as_uint(v), __float_as_uint(v), false, false); return fmaxf(__uint_as_float(r[0]), __uint_as_float(r[1])); }
__device__ __forceinline__ float wave_sum(float v) { v += dppf<0xB1>(v); v += dppf<0x4E>(v); v += dppf<0x141>(v); v += dppf<0x140>(v); v = sum16(v); return sum32(v); }
__device__ __forceinline__ float wave_max(float v) { v = fmaxf(v, dppf<0xB1>(v)); v = fmaxf(v, dppf<0x4E>(v)); v = fmaxf(v, dppf<0x141>(v)); v = fmaxf(v, dppf<0x140>(v)); v = max16(v); return max32(v); }
__device__ __forceinline__ float rdlane(float v, int l) { return __int_as_float(__builtin_amdgcn_readlane(__float_as_int(v), l)); }
__device__ __forceinline__ float sigmoidf_(float x) { return 1.f / (1.f + expf(-x)); }
__device__ __forceinline__ float fsigmoid(float x) { return __builtin_amdgcn_rcpf(1.f + __builtin_amdgcn_exp2f(-1.4426950408889634f * x)); }
__device__ __forceinline__ float ftanh(float x) { return 1.f - 2.f * __builtin_amdgcn_rcpf(1.f + __builtin_amdgcn_exp2f(2.8853900817779268f * x)); }

#define XB_TMO      128
#define XB_XCNT(j)  (256  + 64 * (j))
#define XB_XSUB(j)  (1280 + 64 * (j))
#define XB_XGEN(j)  (2304 + 64 * (j))
#define XB_TOP      3328
#define XB_TOPGEN   3392
#define XCD_BAR_WORDS 3456
#define XB_SPIN_CAP (1u << 18)
#define LAS __attribute__((address_space(3)))
__device__ __forceinline__ unsigned xb_ld(unsigned* p)              { return __hip_atomic_load(p, __ATOMIC_RELAXED, __HIP_MEMORY_SCOPE_AGENT); }
__device__ __forceinline__ unsigned xb_add(unsigned* p, unsigned v) { return __hip_atomic_fetch_add(p, v, __ATOMIC_RELAXED, __HIP_MEMORY_SCOPE_AGENT); }
__device__ __forceinline__ unsigned xb_xcc_id() { return (unsigned)__builtin_amdgcn_s_getreg((3 << 11) | 20) & 0xFu; }
#define XB_SPIN(cond, bar) do { unsigned _sp = 0; while (cond) { __builtin_amdgcn_s_sleep(1); \
    if ((++_sp & 255u) == 0u) { if (xb_ld(&(bar)[XB_TMO])) break; if (_sp > XB_SPIN_CAP) { atomicAdd(&(bar)[XB_TMO], 1u); break; } } } } while (0)
struct XcdBarrier { unsigned* bar; unsigned x; volatile LAS unsigned* st; };
__device__ __forceinline__ XcdBarrier xcd_barrier_post(unsigned* bar, volatile LAS unsigned* st) {
    XcdBarrier b; b.bar = bar; b.x = xb_xcc_id(); b.st = st;
    if (threadIdx.x == 0) (void)xb_add(&bar[XB_XCNT(b.x)], 1u);
    return b;
}
__device__ __forceinline__ void xcd_barrier_complete(unsigned* bar, unsigned x, unsigned& nloc, unsigned& nx) {
    const unsigned G = gridDim.x * gridDim.y * gridDim.z;
    unsigned sum, cnt, mine, sp = 0u;
    for (;;) {
        sum = 0u; cnt = 0u; mine = 0u;
#pragma unroll
        for (unsigned j = 0; j < 16; ++j) { const unsigned c = xb_ld(&bar[XB_XCNT(j)]); sum += c; cnt += (c > 0u) ? 1u : 0u; mine = (j == x) ? c : mine; }
        if (sum == G) break;
        __builtin_amdgcn_s_sleep(1);
        if ((++sp & 255u) == 0u) { if (xb_ld(&bar[XB_TMO])) break; if (sp > XB_SPIN_CAP) { atomicAdd(&bar[XB_TMO], 1u); break; } }
    }
    nloc = mine > 0u ? mine : 1u; nx = cnt > 0u ? cnt : 1u;
}
__device__ __forceinline__ void xcd_barrier(const XcdBarrier& b, const bool leader  ) {
    asm volatile("s_waitcnt vmcnt(0)" ::: "memory");
    __syncthreads();
    if (leader) {
        unsigned* bar = b.bar;
        __builtin_amdgcn_s_waitcnt(0);
        unsigned nloc = b.st[0], nx = b.st[1];
        if (nloc == 0u) { xcd_barrier_complete(bar, b.x, nloc, nx); b.st[0] = nloc; b.st[1] = nx; }
        const unsigned old = xb_add(&bar[XB_XSUB(b.x)], 1u);
        const unsigned gen = old / nloc;
        if (old + 1u == (gen + 1u) * nloc) {
            __builtin_amdgcn_fence(__ATOMIC_RELEASE, "agent");
            asm volatile("s_waitcnt vmcnt(0)" ::: "memory");
            const unsigned og = xb_add(&bar[XB_TOP], 1u);
            const unsigned tg = og / nx;
            if (og + 1u == (tg + 1u) * nx) xb_add(&bar[XB_TOPGEN], 1u);
            else XB_SPIN(xb_ld(&bar[XB_TOPGEN]) == tg, bar);
            __builtin_amdgcn_fence(__ATOMIC_ACQUIRE, "agent");
            xb_add(&bar[XB_XGEN(b.x)], 1u);
            asm volatile("s_waitcnt vmcnt(0)" ::: "memory");
        } else {
            XB_SPIN(xb_ld(&bar[XB_XGEN(b.x)]) == gen, bar);
            __builtin_amdgcn_fence(__ATOMIC_ACQUIRE, "agent");
            asm volatile("s_waitcnt vmcnt(0)" ::: "memory");
        }
    }
    __syncthreads();
}

typedef short bf16x8 __attribute__((ext_vector_type(8)));
typedef float f32x4 __attribute__((ext_vector_type(4)));
namespace ge {
constexpr int BM = 256, BK = 64, HALF = 128, HTB = HALF * BK * 2, STAGE_BYTES = 8 * HTB;
__host__ __device__ __forceinline__ int lds_byte(int r, int c) { const int st = (r >> 4) * 2 + (c >> 5), rr = r & 15, cc = c & 31, ob = rr * 64 + cc * 2; return st * 1024 + (ob ^ (((ob >> 9) & 1) << 5)); }
__host__ __device__ __forceinline__ void stage_rc(int b, int& R, int& C) { const int st = b / 1024, sb = b % 1024, swz = sb ^ (((sb >> 9) & 1) << 5); R = (st >> 1) * 16 + swz / 64; C = (st & 1) * 32 + (swz % 64) / 2; }
struct Unit { int pm, pn, bt, aux; };
__host__ __device__ __forceinline__ int logical_col(int c) { const int pn = c >> 8, bj = (c >> 7) & 1, wc = (c >> 5) & 3, n = (c >> 4) & 1, fq = (c >> 2) & 3, j = c & 3; return (4 * pn + wc) * 64 + 16 * fq + 8 * bj + 4 * n + j; }
struct DenseOrder {
    int nM, nN, nwg, G, c;
    __device__ void init(int M, int N, int G_, int c_) { nM = M / BM; nN = N / BM; nwg = nM * nN; G = G_; c = c_; }
    __device__ bool next(int i, Unit& u) const {
        const long L = (long)i * G + c; if (L >= nwg) return false;
        int wgid = (int)L; { const int q = nwg / 8, r = nwg % 8, xcd = wgid % 8, off = wgid / 8; wgid = (xcd < r ? xcd * (q + 1) : r * (q + 1) + (xcd - r) * q) + off; }
        const int nig = 8 * nN, gid = wgid / nig, fm = gid * 8, gsz = (nM - fm) < 8 ? (nM - fm) : 8;
        u.pm = fm + ((wgid % nig) % gsz); u.pn = (wgid % nig) / gsz; u.bt = u.pn; u.aux = 0; return true;
    }
};
struct DenseRows { static constexpr bool dense = true; unsigned ldab; __device__ __forceinline__ unsigned operator()(const Unit& u, int r) const { return (unsigned)(u.pm * 256 + r) * ldab; } };
template <class Tp> __device__ __forceinline__ Tp* uni(Tp* v) { const unsigned long long u = (unsigned long long)v; const unsigned lo = __builtin_amdgcn_readfirstlane((unsigned)u), hi = __builtin_amdgcn_readfirstlane((unsigned)(u >> 32)); return (Tp*)(((unsigned long long)hi << 32) | lo); }

typedef int i32x8 __attribute__((ext_vector_type(8)));
typedef int i32x4 __attribute__((ext_vector_type(4)));
template <bool F8> struct Frag;
template <> struct Frag<false> { bf16x8 v[2]; };
template <> struct Frag<true> { i32x8 v; };
template <bool F8> __device__ __forceinline__ void load_frag(Frag<F8>& f, const LAS unsigned char* p0) {
    if constexpr (F8) { const i32x4 lo = *(const LAS i32x4*)p0, hi = *(const LAS i32x4*)(p0 + 16); f.v = __builtin_shufflevector(lo, hi, 0, 1, 2, 3, 4, 5, 6, 7); }
    else { f.v[0] = *(const LAS bf16x8*)p0; f.v[1] = *(const LAS bf16x8*)(p0 + 1024); }
}
template <bool F8> __device__ __forceinline__ f32x4 mma_kt(const Frag<F8>& b, const Frag<F8>& a, f32x4 c) {
    if constexpr (F8) return __builtin_amdgcn_mfma_scale_f32_16x16x128_f8f6f4(b.v, a.v, c, 0, 0, 0, 0x7F7F7F7F, 0, 0x7F7F7F7F);
    else { c = __builtin_amdgcn_mfma_f32_16x16x32_bf16(b.v[0], a.v[0], c, 0, 0, 0); return __builtin_amdgcn_mfma_f32_16x16x32_bf16(b.v[1], a.v[1], c, 0, 0, 0); }
}
template <bool F8 = false, class Sched, class RowMap, class Epi>
__device__ __forceinline__ void gemm_phase(LAS unsigned char* lds, const void* A, const void* Bt, const int K, const Sched& S, const RowMap& RM, const Epi& E, const int wave_id, const int ldb_ = 0  ) {
    int tid_; asm volatile("v_mbcnt_lo_u32_b32 %0, -1, 0\n\tv_mbcnt_hi_u32_b32 %0, -1, %0" : "=v"(tid_)); tid_ += wave_id * 64;
    const int tid = tid_, wid = __builtin_amdgcn_readfirstlane(tid >> 6), lane = tid & 63, wr = wid >> 2, wc = wid & 3, fr = lane & 15, fq = lane >> 4;
    const int nt = K / (F8 ? 2 * BK : BK);
    constexpr bool DR = RowMap::dense;
    int sR[2], sC[2];
    const int ldb = ldb_ ? ldb_ : K;
#pragma unroll
    for (int i = 0; i < 2; ++i) stage_rc(tid * 16 + i * 8192, sR[i], sC[i]);
    const unsigned voffB = F8 ? (unsigned)(sR[0] * ldb + sC[0] * 2) : (unsigned)(sR[0] * ldb + sC[0]) * 2u;
    unsigned ldab_ = 0, voffA = 0; if constexpr (DR) { ldab_ = RM.ldab; voffA = (unsigned)sR[0] * ldab_ + (unsigned)sC[0] * 2u; }
    const size_t kstep = (size_t)(BK * 2), hstepB = (size_t)HALF * ldb * (F8 ? 1 : 2), tstepB = 2 * hstepB, qstepB = hstepB / 2;
    const unsigned ldsw = (unsigned)wid * 1024u;
    const int aoff = lds_byte(wr * 64 + fr, fq * (F8 ? 16 : 8)), boff = lds_byte(wc * 32 + fr, fq * (F8 ? 16 : 8));
    const char* Ab = (const char*)A;
#define GE_SA(b, h) (((b) * 2 + (h)) * ge::HTB)
#define GE_SB(b, h) ((4 + (b) * 2 + (h)) * ge::HTB)
#define GE_GLD(sp, vo, ldsoff) do { unsigned _v = (vo); asm volatile("" : "+v"(_v));     \
        __builtin_amdgcn_global_load_lds((const unsigned*)(uni((const char*)(sp)) + _v), (LAS unsigned*)(lds + (ldsoff)), 16, 0, 0); } while (0)
#define GE_STB(bufoff, gbase) do { _Pragma("unroll") for (int _i = 0; _i < 2; ++_i) GE_GLD((gbase) + _i * qstepB, voffB, (bufoff) + ldsw + _i * 8192); } while (0)
#define GE_STA(bufoff, sp, OFF, h) do { _Pragma("unroll") for (int _i = 0; _i < 2; ++_i) { \
        if constexpr (DR) GE_GLD((sp) + (size_t)((h) * 128 + _i * 64) * ldab_, voffA, (bufoff) + ldsw + _i * 8192); \
        else GE_GLD((sp), (OFF)[h][_i], (bufoff) + ldsw + _i * 8192); } } while (0)
#define GE_LDA(dst, b, h) do { _Pragma("unroll") for (int m = 0; m < 4; ++m) load_frag<F8>(dst[m], lds + GE_SA(b, h) + aoff + m * 2048); } while (0)
#define GE_LDB(dst, b, h) do { _Pragma("unroll") for (int n = 0; n < 2; ++n) load_frag<F8>(dst[n], lds + GE_SB(b, h) + boff + n * 2048); } while (0)
#define GE_MMA(ai, bj, At, Bt_) do { __builtin_amdgcn_s_setprio(1); _Pragma("unroll") for (int m = 0; m < 4; ++m) _Pragma("unroll") for (int n = 0; n < 2; ++n) \
        acc[ai][bj][m][n] = mma_kt<F8>(Bt_[n], At[m], acc[ai][bj][m][n]); __builtin_amdgcn_s_setprio(0); } while (0)
#define GE_WAIT_V(n) asm volatile("s_waitcnt vmcnt(" #n ")" ::: "memory")
#define GE_WAIT_L(n) asm volatile("s_waitcnt lgkmcnt(" #n ")" ::: "memory")
#define GE_BAR __builtin_amdgcn_s_barrier()
#define GE_SCHED __builtin_amdgcn_sched_barrier(0)
#define GE_OFFS(OFF, u) do { int _l; asm volatile("v_mbcnt_lo_u32_b32 %0, -1, 0\n\tv_mbcnt_hi_u32_b32 %0, -1, %0" : "=v"(_l)); int _r0, _c0; stage_rc((wave_id * 64 + _l) * 16, _r0, _c0);     \
        _Pragma("unroll") for (int _h = 0; _h < 2; ++_h) _Pragma("unroll") for (int _i = 0; _i < 2; ++_i) (OFF)[_h][_i] = RM((u), _h * 128 + _i * 64 + _r0) + (unsigned)_c0 * 2u; \
        asm volatile("" : "+v"((OFF)[0][0]), "+v"((OFF)[0][1]), "+v"((OFF)[1][0]), "+v"((OFF)[1][1])); } while (0)
    Unit cur, nxt; int ui = 0;
    if (!S.next(0, cur)) return;
    unsigned offC[2][2];
    const char* aC = Ab; const char* aN = Ab;
    if constexpr (DR) aC = Ab + (size_t)cur.pm * 256 * ldab_; else GE_OFFS(offC, cur);
    f32x4 acc[2][2][4][2];
#pragma unroll
    for (int a = 0; a < 2; ++a)
#pragma unroll
        for (int b = 0; b < 2; ++b)
#pragma unroll
            for (int m = 0; m < 4; ++m)
#pragma unroll
                for (int n = 0; n < 2; ++n) acc[a][b][m][n] = (f32x4){0.f, 0.f, 0.f, 0.f};
    Frag<F8> At[4], B0[2], B1[2];
    const char* cB = (const char*)Bt + (size_t)cur.bt * tstepB;
    GE_STB(GE_SB(0, 0), cB); GE_STA(GE_SA(0, 0), aC, offC, 0); GE_STB(GE_SB(0, 1), cB + hstepB); GE_STA(GE_SA(0, 1), aC, offC, 1);
    if (wr == 1) GE_BAR;
    GE_WAIT_V(4); GE_BAR;
    GE_STB(GE_SB(1, 0), cB + kstep); GE_STA(GE_SA(1, 0), aC + kstep, offC, 0); GE_STB(GE_SB(1, 1), cB + hstepB + kstep);
    GE_WAIT_V(6); GE_BAR;
    for (;;) {
        const bool has_next = S.next(ui + 1, nxt);
        if constexpr (DR) aN = has_next ? Ab + (size_t)nxt.pm * 256 * ldab_ : aC;
        const char* nB = has_next ? (const char*)Bt + (size_t)nxt.bt * tstepB : cB;
#pragma unroll 1
        for (int t = 0; t < nt; t += 2) {
            const bool last = (t == nt - 2);
            const size_t k1 = (size_t)(t + 1) * kstep;
            const size_t k2 = last ? 0 : (size_t)(t + 2) * kstep, k3 = k2 + kstep;
            const char* b2 = last ? nB : cB + (size_t)(t + 2) * kstep; const char* b3 = b2 + kstep;
            const char* a2 = last ? aN : aC;
            GE_LDB(B0, 0, 0); GE_SCHED; GE_LDA(At, 0, 0); GE_STA(GE_SA(1, 1), aC + k1, offC, 1);
            GE_WAIT_L(8); GE_BAR; GE_WAIT_L(0); GE_MMA(0, 0, At, B0); GE_BAR; GE_SCHED;
            GE_LDB(B1, 0, 1); GE_STB(GE_SB(0, 0), b2);
            GE_BAR; GE_WAIT_L(0); GE_MMA(0, 1, At, B1); GE_BAR;
            GE_LDA(At, 0, 1);
            if constexpr (!DR) { if (last && has_next) GE_OFFS(offC, nxt); }
            GE_STA(GE_SA(0, 0), a2 + k2, offC, 0);
            GE_BAR; GE_WAIT_L(0); GE_MMA(1, 0, At, B0); GE_BAR; GE_SCHED;
            GE_STB(GE_SB(0, 1), b2 + hstepB);
            GE_WAIT_V(6); GE_BAR; GE_MMA(1, 1, At, B1); GE_BAR;
            GE_LDB(B0, 1, 0); GE_SCHED; GE_LDA(At, 1, 0); GE_STA(GE_SA(0, 1), a2 + k2, offC, 1);
            GE_WAIT_L(8); GE_BAR; GE_WAIT_L(0); GE_MMA(0, 0, At, B0); GE_BAR; GE_SCHED;
            GE_LDB(B1, 1, 1); GE_STB(GE_SB(1, 0), b3);
            GE_BAR; GE_WAIT_L(0); GE_MMA(0, 1, At, B1); GE_BAR;
            GE_LDA(At, 1, 1); GE_STA(GE_SA(1, 0), a2 + k3, offC, 0);
            GE_BAR; GE_WAIT_L(0); GE_MMA(1, 0, At, B0); GE_BAR; GE_SCHED;
            GE_STB(GE_SB(1, 1), b3 + hstepB);
            GE_WAIT_V(6); GE_BAR; GE_MMA(1, 1, At, B1); GE_BAR;
        }
#pragma unroll
        for (int a = 0; a < 2; ++a)
#pragma unroll
            for (int b = 0; b < 2; ++b) asm volatile("" : "+v"(acc[a][b][0][0]), "+v"(acc[a][b][0][1]), "+v"(acc[a][b][1][0]), "+v"(acc[a][b][1][1]), "+v"(acc[a][b][2][0]), "+v"(acc[a][b][2][1]), "+v"(acc[a][b][3][0]), "+v"(acc[a][b][3][1]));
        { int l2; asm volatile("v_mbcnt_lo_u32_b32 %0, -1, 0\n\tv_mbcnt_hi_u32_b32 %0, -1, %0" : "=v"(l2)); E(acc, cur, wr, wc, l2 & 15, l2 >> 4); }
        if (!has_next) break;
#pragma unroll
        for (int a = 0; a < 2; ++a)
#pragma unroll
            for (int b = 0; b < 2; ++b)
#pragma unroll
                for (int m = 0; m < 4; ++m)
#pragma unroll
                    for (int n = 0; n < 2; ++n) acc[a][b][m][n] = (f32x4){0.f, 0.f, 0.f, 0.f};
        cur = nxt; cB = nB; aC = aN; ++ui;
    }
    GE_WAIT_V(0);
    if (wr == 0) GE_BAR;
    GE_BAR;
}
#define GE_VALS(v, acc, ai, m) do { _Pragma("unroll") for (int _b = 0; _b < 2; ++_b) _Pragma("unroll") for (int _n = 0; _n < 2; ++_n) _Pragma("unroll") for (int _j = 0; _j < 4; ++_j) (v)[8 * _b + 4 * _n + _j] = (acc)[ai][_b][m][_n][_j]; } while (0)
}
__device__ __forceinline__ void store16_bf16(bf16_t* dst, const float (&v)[16]) {
    unsigned w[8];
#pragma unroll
    for (int i = 0; i < 8; ++i) w[i] = pk2g(v[2 * i], v[2 * i + 1]);
    uint4* d4 = (uint4*)dst; d4[0] = make_uint4(w[0], w[1], w[2], w[3]); d4[1] = make_uint4(w[4], w[5], w[6], w[7]);
}
template <bool IN_BF16>
struct EpiResid { const void* xin; const float* mod_g; bf16_t* xout; float inscale;
    __device__ __forceinline__ void operator()(const f32x4 (&acc)[2][2][4][2], const ge::Unit& u, int wr, int wc, int fr, int fq) const {
        const int col0 = (4 * u.pn + wc) * 64 + 16 * fq; const int b = (u.pm * 256) / S;
        float4 gq[4];
#pragma unroll
        for (int q4 = 0; q4 < 4; ++q4) { gq[q4] = *(const float4*)(mod_g + b * 6144 + col0 + 4 * q4); gq[q4].x *= inscale; gq[q4].y *= inscale; gq[q4].z *= inscale; gq[q4].w *= inscale; }
        if constexpr (IN_BF16) {
            uint4 xh[2][4][2];
#pragma unroll
            for (int ai = 0; ai < 2; ++ai)
#pragma unroll
                for (int m = 0; m < 4; ++m) { const size_t o = (size_t)(u.pm * 256 + ai * 128 + wr * 64 + m * 16 + fr) * D + col0; xh[ai][m][0] = *(const uint4*)((const bf16_t*)xin + o); xh[ai][m][1] = *(const uint4*)((const bf16_t*)xin + o + 8); }
            const float g16[16] = {gq[0].x, gq[0].y, gq[0].z, gq[0].w, gq[1].x, gq[1].y, gq[1].z, gq[1].w, gq[2].x, gq[2].y, gq[2].z, gq[2].w, gq[3].x, gq[3].y, gq[3].z, gq[3].w};
#pragma unroll
            for (int ai = 0; ai < 2; ++ai)
#pragma unroll
                for (int m = 0; m < 4; ++m) { float v[16]; GE_VALS(v, acc, ai, m);
                    const unsigned w8[8] = {xh[ai][m][0].x, xh[ai][m][0].y, xh[ai][m][0].z, xh[ai][m][0].w, xh[ai][m][1].x, xh[ai][m][1].y, xh[ai][m][1].z, xh[ai][m][1].w};
#pragma unroll
                    for (int k = 0; k < 8; ++k) { v[2 * k] = __uint_as_float(w8[k] << 16) + g16[2 * k] * v[2 * k]; v[2 * k + 1] = __uint_as_float(w8[k] & 0xFFFF0000u) + g16[2 * k + 1] * v[2 * k + 1]; }
                    store16_bf16(xout + (size_t)(u.pm * 256 + ai * 128 + wr * 64 + m * 16 + fr) * D + col0, v); }
        } else {
#pragma unroll
        for (int ai = 0; ai < 2; ++ai) { float4 xv[4][4];
#pragma unroll
            for (int m = 0; m < 4; ++m) { const size_t o = (size_t)(u.pm * 256 + ai * 128 + wr * 64 + m * 16 + fr) * D + col0;
#pragma unroll
                for (int q4 = 0; q4 < 4; ++q4) xv[m][q4] = *(const float4*)((const float*)xin + o + 4 * q4); }
#pragma unroll
            for (int m = 0; m < 4; ++m) { float v[16]; GE_VALS(v, acc, ai, m); float xr[16];
#pragma unroll
                for (int q4 = 0; q4 < 4; ++q4) { xr[4 * q4] = xv[m][q4].x; xr[4 * q4 + 1] = xv[m][q4].y; xr[4 * q4 + 2] = xv[m][q4].z; xr[4 * q4 + 3] = xv[m][q4].w; }
                const float g16[16] = {gq[0].x, gq[0].y, gq[0].z, gq[0].w, gq[1].x, gq[1].y, gq[1].z, gq[1].w, gq[2].x, gq[2].y, gq[2].z, gq[2].w, gq[3].x, gq[3].y, gq[3].z, gq[3].w};
#pragma unroll
                for (int k = 0; k < 16; ++k) v[k] = xr[k] + g16[k] * v[k];
                store16_bf16(xout + (size_t)(u.pm * 256 + ai * 128 + wr * 64 + m * 16 + fr) * D + col0, v); } }
        }
    } };
struct EpiNsaIn { const float* q_gain; const float* k_gain; const float* rope; bf16_t* q; bf16_t* kv; float* gates; float inscale;
    __device__ __forceinline__ void operator()(const f32x4 (&acc)[2][2][4][2], const ge::Unit& u, int wr, int wc, int fr, int fq) const {
        const int slot = 4 * u.pn + wc; if (slot > 28) return;
        const bool normed = (slot < 16) || slot == 20 || slot == 21 || slot == 24 || slot == 25;
        const float* gain = (slot < 16) ? q_gain : ((slot < 22) ? k_gain + 64 : k_gain + 128);
        float gv[16];
        if (normed) {
#pragma unroll
            for (int i = 0; i < 16; ++i) gv[i] = gain[16 * fq + i]; }
#pragma unroll
        for (int ai = 0; ai < 2; ++ai)
#pragma unroll
            for (int m = 0; m < 4; ++m) { const int row = u.pm * 256 + ai * 128 + wr * 64 + m * 16 + fr; const int b = row / S, s = row % S; float v[16]; GE_VALS(v, acc, ai, m);
#pragma unroll
                for (int i = 0; i < 16; ++i) v[i] *= inscale;
                if (slot == 28) { if (fq < 3) { float* gp = gates + (size_t)row * 48 + 16 * fq;
#pragma unroll
                        for (int q4 = 0; q4 < 4; ++q4) *(float4*)(gp + 4 * q4) = make_float4(fsigmoid(v[4 * q4]), fsigmoid(v[4 * q4 + 1]), fsigmoid(v[4 * q4 + 2]), fsigmoid(v[4 * q4 + 3])); }
                    continue; }
                if (normed) { float ss = 0.f;
#pragma unroll
                    for (int i = 0; i < 16; ++i) ss += v[i] * v[i];
                    ss = sum16(ss); ss = sum32(ss); const float r = rsqrtf(ss * (1.f / 64.f) + 1e-6f);
#pragma unroll
                    for (int i = 0; i < 16; ++i) v[i] *= r * gv[i];
                    if (fq == 0) { const float sf = (float)s;
                        constexpr float IFR[8] = {0.15915494309189535f, 0.030863763158420102f, 0.00598518567638293f, 0.001160663620968869f, 0.00022507907904105153f, 4.364795481173399e-05f, 8.464330549652592e-06f, 1.6414262419538367e-06f};
#pragma unroll
                        for (int i = 0; i < 8; ++i) { const float rev = __builtin_amdgcn_fractf(sf * IFR[i]); const float cs = __builtin_amdgcn_cosf(rev), sn = __builtin_amdgcn_sinf(rev), a = v[i], bb = v[i + 8]; v[i] = a * cs - bb * sn; v[i + 8] = bb * cs + a * sn; } } }
                bf16_t* dst;
                if (slot < 16) dst = q + (size_t)row * D + slot * 64 + 16 * fq;
                else { const int kk = slot - 16, ten = kk >> 1, g = kk & 1; dst = kv + (size_t)ten * T * 128 + ((size_t)(b * 2 + g) * S + s) * 64 + 16 * fq; }
                store16_bf16(dst, v); }
    } };
struct EpiMlIn { bf16_t* proj; float inscale;
    __device__ __forceinline__ void operator()(const f32x4 (&acc)[2][2][4][2], const ge::Unit& u, int wr, int wc, int fr, int fq) const {
        const int slot = 4 * u.pn + wc; const int L0 = slot * 64 + 16 * fq;
#pragma unroll
        for (int ai = 0; ai < 2; ++ai)
#pragma unroll
            for (int m = 0; m < 4; ++m) { const int row = u.pm * 256 + ai * 128 + wr * 64 + m * 16 + fr; float v[16]; GE_VALS(v, acc, ai, m);
                { const float sc = (slot >= 8 && slot < 16) ? 0.08838834764831845f * inscale : inscale;
#pragma unroll
                    for (int i = 0; i < 16; ++i) v[i] *= sc; }
                if (slot >= 32) {
#pragma unroll
                    for (int i = 0; i < 16; ++i) v[i] = fsigmoid(v[i]); }
                store16_bf16(proj + (size_t)row * 3072 + L0, v); }
    } };
struct OneUnit { int pm; __device__ bool next(int i, ge::Unit& u) const { if (i) return false; u.pm = pm; u.pn = 0; u.bt = 0; u.aux = 0; return true; } };
struct EpiCmpPart { float* part;
    __device__ __forceinline__ void operator()(const f32x4 (&acc)[2][2][4][2], const ge::Unit& u, int wr, int wc, int fr, int fq) const {
        const int L0 = (4 * u.pn + wc) * 64 + 16 * fq;
#pragma unroll
        for (int ai = 0; ai < 2; ++ai)
#pragma unroll
            for (int m = 0; m < 4; ++m) { const int row = u.pm * 256 + ai * 128 + wr * 64 + m * 16 + fr; float v[16]; GE_VALS(v, acc, ai, m); float* op = part + (size_t)row * 256 + L0;
#pragma unroll
                for (int q4 = 0; q4 < 4; ++q4) *(float4*)(op + 4 * q4) = make_float4(v[4 * q4], v[4 * q4 + 1], v[4 * q4 + 2], v[4 * q4 + 3]); }
    } };
struct EpiCmp1 { const float* cb1; bf16_t* hid;
    __device__ __forceinline__ void operator()(const f32x4 (&acc)[2][2][4][2], const ge::Unit& u, int wr, int wc, int fr, int fq) const {
        const int L0 = (4 * u.pn + wc) * 64 + 16 * fq; float bv[16];
#pragma unroll
        for (int i = 0; i < 16; ++i) bv[i] = cb1[L0 + i];
#pragma unroll
        for (int ai = 0; ai < 2; ++ai)
#pragma unroll
            for (int m = 0; m < 4; ++m) { const int row = u.pm * 256 + ai * 128 + wr * 64 + m * 16 + fr; float v[16]; GE_VALS(v, acc, ai, m);
#pragma unroll
                for (int i = 0; i < 16; ++i) { const float x = v[i] + bv[i]; v[i] = 0.5f * x * (1.f + ftanh(0.7978845608028654f * (x + 0.044715f * x * x * x))); }
                store16_bf16(hid + (size_t)row * 256 + L0, v); }
    } };

#define PARAM_LIST(X) \
    X(const float*, x) X(const float*, c) X(const float*, ada_w) X(const float*, ada_b) X(const float*, g_mix) X(const float*, g_ffn) X(const float*, nsa_w_in) X(const float*, nsa_w_out) \
    X(const float*, q_gain) X(const float*, k_gain) X(const float*, cmp_pe) X(const float*, cmp_w1) X(const float*, cmp_b1) X(const float*, cmp_w2) X(const float*, cmp_b2) \
    X(const float*, ml_w_in) X(const float*, ml_bi) X(const float*, ml_bf) X(const float*, ml_ng) X(const float*, ml_w_out) X(const float*, router_w) X(const float*, router_b) \
    X(const float*, w_gate) X(const float*, w_up) X(const float*, w_down) \
    X(float*, out) X(unsigned*, bar) X(int*, cnt) X(float*, mod) X(float*, rope) X(float*, cb1) X(float*, tokw) X(int*, list) X(float*, li) X(float*, lf) \
    X(bf16_t*, h) X(bf16_t*, hidc) X(bf16_t*, xb13) X(bf16_t*, xb2) X(bf16_t*, wo_nsa_t) X(bf16_t*, wo_ml_t) X(bf16_t*, win_nsa_t) X(bf16_t*, win_ml_t) X(bf16_t*, w1c_t) X(bf16_t*, gu_t) X(bf16_t*, dn_t) \
    X(bf16_t*, q) X(bf16_t*, kv) X(float*, gates) X(bf16_t*, kcmp) X(bf16_t*, vcmp) X(bf16_t*, proj) X(bf16_t*, hid) X(bf16_t*, outk) X(int*, dcnt) X(int*, dlist) X(float*, cpart)
struct Params {
#define X(t, n) t n;
    PARAM_LIST(X)
#undef X
};
template <class Tp> __device__ __forceinline__ Tp* uni_ptr(Tp* v) { const unsigned long long u = (unsigned long long)v; const unsigned lo = __builtin_amdgcn_readfirstlane((unsigned)u), hi = __builtin_amdgcn_readfirstlane((unsigned)(u >> 32)); typedef Tp __attribute__((address_space(1))) * GP; return (Tp*)(GP)(((unsigned long long)hi << 32) | lo); }
#define LP(n) q.n = uni_ptr(P->n)
struct Frame { LAS unsigned char* lds; int tid, lane, wave, bid, G; };
__device__ __forceinline__ int lane_id_asm() { int l; asm volatile("v_mbcnt_lo_u32_b32 %0, -1, 0\n\tv_mbcnt_hi_u32_b32 %0, -1, %0" : "=v"(l)); return l; }
__device__ __forceinline__ Frame launder(const Frame& F) { Frame R = F; const int l = lane_id_asm(); int wv = F.wave, bd = F.bid; asm volatile("" : "+s"(wv), "+s"(bd)); R.wave = wv; R.bid = bd; R.tid = wv * 64 + l; R.lane = l; return R; }
constexpr int LDS_GEN = 143872;
constexpr int LDS_MISC = LDS_GEN;
constexpr int LDS_PARAMS = LDS_GEN + 4096;
constexpr int LDS_CONST = LDS_GEN + 6144;
constexpr int LDS_BYTES = LDS_GEN + 18432;

__device__ __forceinline__ unsigned pk4_fp8(float a, float b, float c, float d) { int w = 0;
    w = __builtin_amdgcn_cvt_pk_fp8_f32(__builtin_amdgcn_fmed3f(a, -448.f, 448.f), __builtin_amdgcn_fmed3f(b, -448.f, 448.f), w, false);
    w = __builtin_amdgcn_cvt_pk_fp8_f32(__builtin_amdgcn_fmed3f(c, -448.f, 448.f), __builtin_amdgcn_fmed3f(d, -448.f, 448.f), w, true); return (unsigned)w; }
constexpr float F8_SA = 8.f, F8_SW = 32.f, F8_SH = 4.f, F8_SW2 = 32.f;
template <int NB>
__device__ __forceinline__ void colgemv(const Frame& F, const LAS float* vec, LAS float* part, const float* W, int ldw, int K, int n0, const float* bias, float* out, int out_stride) {
    const int kper = K / 8, kb = F.wave * kper, c4 = F.lane & 15, kq = F.lane >> 4; float acc[NB][4];
#pragma unroll
    for (int b = 0; b < NB; ++b)
#pragma unroll
        for (int j = 0; j < 4; ++j) acc[b][j] = 0.f;
    const float* wp = W + (size_t)(kb + kq) * ldw + n0 + 4 * c4;
#pragma unroll 4
    for (int k = 0; k < kper; k += 4) { const float4 wv = *(const float4*)(wp + (size_t)k * ldw);
#pragma unroll
        for (int b = 0; b < NB; ++b) { const float x = vec[(kb + k + kq) * NB + b]; acc[b][0] += x * wv.x; acc[b][1] += x * wv.y; acc[b][2] += x * wv.z; acc[b][3] += x * wv.w; } }
#pragma unroll
    for (int b = 0; b < NB; ++b)
#pragma unroll
        for (int j = 0; j < 4; ++j) { const float t = sum32(sum16(acc[b][j])); if (kq == 0) part[(F.wave * NB + b) * 64 + 4 * c4 + j] = t; }
    __syncthreads();
    for (int idx = F.tid; idx < NB * 64; idx += NTHR) { const int b = idx >> 6, l = idx & 63; float s = bias[n0 + l];
#pragma unroll
        for (int w = 0; w < 8; ++w) s += part[(w * NB + b) * 64 + l];
        out[(size_t)b * out_stride + n0 + l] = s; }
    __syncthreads();
}
struct ColPlain { const float* W; int ncols; int pad; __device__ const float* operator()(int c) const { const int L = ge::logical_col(c); return L < ncols ? W + L : nullptr; } };
struct ColGateUp { const float* wg; const float* wu; __device__ const float* operator()(int c) const { const int e = c >> 10, cc = c & 1023; const int pn = cc >> 8, bj = (cc >> 7) & 1, wc = (cc >> 5) & 3, n = (cc >> 4) & 1, fq = (cc >> 2) & 3, j = cc & 3;
        const int hidx = 32 * (4 * pn + wc) + 8 * fq + 4 * n + j; const unsigned long long a = (unsigned long long)wg, d = (unsigned long long)wu - a;
        return (const float*)(a + (bj ? d : 0ull)) + (size_t)e * D * DE + hidx; } };
struct ColDown { const float* wd; __device__ const float* operator()(int c) const { const int e = c >> 10; return wd + (size_t)e * DE * D + ge::logical_col(c & 1023); } };
template <bool F8 = false, class ColF>
__device__ __forceinline__ void prep_weights(const Frame& F, void* Bt_, int N, int K, int ldw, const ColF cf, int start, int stride, const float wscale = 1.f) {
    bf16_t* Bt = (bf16_t*)Bt_;
    LAS float* tile = (LAS float*)(F.lds) + (F.tid >> 8) * (128 * 65);
    const int ntx = N / 64, ntiles = ntx * (K / 128), htid = F.tid & 255, half = F.tid >> 8;
    float r[32];
#define PW_LOAD(it_) do { const int tl_ = (it_) * 2 + half; if (tl_ < ntiles) { const int c0_ = (tl_ % ntx) * 64, k0_ = (tl_ / ntx) * 128; const float* p_ = cf(c0_ + (htid & 63)); \
        if (p_) { p_ += (size_t)(k0_ + (htid >> 6)) * ldw; _Pragma("unroll") for (int i_ = 0; i_ < 32; ++i_) r[i_] = p_[(size_t)(4 * i_) * ldw]; } \
        else { _Pragma("unroll") for (int i_ = 0; i_ < 32; ++i_) r[i_] = 0.f; } } } while (0)
    int it = start;
    if (it * 2 < ntiles) PW_LOAD(it);
    for (; it * 2 < ntiles; it += stride) {
        const int tl = it * 2 + half; const bool act = tl < ntiles; const int c0 = (tl % ntx) * 64, k0 = (tl / ntx) * 128;
        if (act) { const int cc = htid & 63;
#pragma unroll
            for (int i = 0; i < 32; ++i) tile[((htid >> 6) + 4 * i) * 65 + cc] = r[i]; }
        __syncthreads();
        if ((it + stride) * 2 < ntiles) PW_LOAD(it + stride);
        if (act) { const int cc = htid >> 2, ch = (htid & 3) * 32;
            if (F8) { unsigned w[8];
#pragma unroll
                for (int i = 0; i < 8; ++i) w[i] = pk4_fp8(tile[(ch + 4 * i) * 65 + cc] * wscale, tile[(ch + 4 * i + 1) * 65 + cc] * wscale, tile[(ch + 4 * i + 2) * 65 + cc] * wscale, tile[(ch + 4 * i + 3) * 65 + cc] * wscale);
                uint4* dst = (uint4*)((unsigned char*)Bt_ + (size_t)(c0 + cc) * K + k0 + ch); dst[0] = make_uint4(w[0], w[1], w[2], w[3]); dst[1] = make_uint4(w[4], w[5], w[6], w[7]); }
            else { unsigned w[16];
#pragma unroll
                for (int i = 0; i < 16; ++i) w[i] = pk2g(tile[(ch + 2 * i) * 65 + cc], tile[(ch + 2 * i + 1) * 65 + cc]);
                uint4* dst = (uint4*)(Bt + (size_t)(c0 + cc) * K + k0 + ch);
#pragma unroll
                for (int q4 = 0; q4 < 4; ++q4) dst[q4] = make_uint4(w[4 * q4], w[4 * q4 + 1], w[4 * q4 + 2], w[4 * q4 + 3]); } }
        __syncthreads();
    }
#undef PW_LOAD
}
__device__ __forceinline__ void prep_moe_weights(const Params& p, const Frame& F, int layer, int start, int stride) {
    const size_t wo = (size_t)layer * NE * D * DE;
    prep_weights<true>(F, p.gu_t, NE * 1024, D, DE, ColGateUp{p.w_gate + wo, p.w_up + wo}, start, stride, F8_SW);
    prep_weights<true>(F, p.dn_t, NE * 1024, DE, D, ColDown{p.w_down + wo}, start, stride, F8_SW2);
}

__device__ __forceinline__ void phase_prologue_a(const Params& p, const Frame& F) {
    for (int i = (F.bid - 200) * NTHR + F.tid; F.bid >= 200 && i < 2048 * 8; i += (F.G - 200) * NTHR) { const int pos = i >> 3, j = i & 7; const float inv = (float)pow(500000.0, -(double)j / 8.0); const float ang = (float)pos * inv;
        p.rope[pos * 16 + j] = (float)cos((double)ang); p.rope[pos * 16 + 8 + j] = (float)sin((double)ang); }
    if (F.bid == F.G - 1) for (int i = F.tid; i < 8 * D / 2; i += NTHR) ((unsigned*)(p.h + (size_t)T * D))[i] = 0u;
}
__device__ __forceinline__ void phase_prologue_b(const Params& p, const Frame& F) {
    LAS float* vec = (LAS float*)F.lds; LAS float* part = (LAS float*)(F.lds + 65536 + 16384);
    if (F.bid < 192) {
        for (int idx = F.tid; idx < 16 * D; idx += NTHR) { const int b = idx >> 10, k = idx & 1023; const float cv = p.c[idx]; vec[k * 16 + b] = cv / (1.f + expf(-cv)); }
        __syncthreads();
        const int i = F.bid / 96, n0 = (F.bid % 96) * 64;
        colgemv<16>(F, vec, part, p.ada_w + (size_t)i * D * 6144, 6144, D, n0, p.ada_b + i * 6144, p.mod + (size_t)i * 16 * 6144, 6144);
    } else if (F.bid < 200) {
        const int it = F.bid - 192, w = it >> 2, n0 = (it & 3) * 64;
        for (int idx = F.tid; idx < 2048; idx += NTHR) vec[idx] = p.cmp_pe[w * 2048 + idx];
        __syncthreads();
        colgemv<1>(F, vec, part, p.cmp_w1 + (size_t)w * 2048 * 256, 256, 2048, n0, p.cmp_b1 + w * 256, p.cb1 + w * 256, 0);
    }
    __syncthreads();
}

template <int MODE, bool XBF>
__device__ __forceinline__ void phase_norm(const Params& p, const Frame& F, const void* xin_, bf16_t* xout, const float* gain, const float* mod_sh, const float* mod_sc, const float* mod_gprev, int layer) {
    constexpr int rows_per_wg = T / NWG, rpw = rows_per_wg / 8;
    constexpr int TP = (MODE == 1) ? 34 : 10;
    const int row0 = F.bid * rows_per_wg;
    LAS float* rw = (LAS float*)F.lds;
    LAS int* lcnt = (LAS int*)(F.lds + LDS_MISC + 64); LAS int* gbase = lcnt + 32; LAS int* ent = gbase + 32;
    if (MODE == 1) { for (int idx = F.tid; idx < D * NE; idx += NTHR) { const int c = idx >> 5; rw[((c & 3) * 256 + (c >> 2)) * TP + (idx & 31)] = p.router_w[idx]; } if (F.tid < 32) lcnt[F.tid] = 0; }
    if (MODE == 2) { for (int idx = F.tid; idx < D * 8; idx += NTHR) { const int c = idx >> 3; rw[((c & 3) * 256 + (c >> 2)) * TP + (idx & 7)] = p.ml_w_in[(size_t)c * ML_COLS + 3072 + (idx & 7)]; } }
    const int b = row0 / S;
    LAS float* cg = (LAS float*)(F.lds + LDS_CONST); LAS float* csh = cg + D; LAS float* cgp = csh + D;
    for (int col = F.tid; col < D; col += NTHR) { cg[col] = gain[col] * (1.f + mod_sc[b * 6144 + col]); csh[col] = mod_sh[b * 6144 + col]; if (MODE == 2) cgp[col] = mod_gprev[b * 6144 + col]; }
    __syncthreads();
    const int rbase = row0 + F.wave * rpw;
    float4 xn[4]; uint2 on0[4], on1[4];
#define NORM_LOAD(r_) do { if (XBF) { const bf16_t* xr_ = (const bf16_t*)xin_ + (size_t)(r_) * D + 4 * F.lane; _Pragma("unroll") for (int j_ = 0; j_ < 4; ++j_) { const uint2 t_ = *(const uint2*)(xr_ + 256 * j_); \
            xn[j_] = make_float4(__uint_as_float(t_.x << 16), __uint_as_float(t_.x & 0xFFFF0000u), __uint_as_float(t_.y << 16), __uint_as_float(t_.y & 0xFFFF0000u)); } } \
        else { const float* xr_ = (const float*)xin_ + (size_t)(r_) * D + 4 * F.lane; _Pragma("unroll") for (int j_ = 0; j_ < 4; ++j_) xn[j_] = *(const float4*)(xr_ + 256 * j_); } \
        if (MODE == 2) { const bf16_t* o0_ = p.outk + (size_t)(r_) * D + 4 * F.lane; _Pragma("unroll") for (int j_ = 0; j_ < 4; ++j_) { on0[j_] = *(const uint2*)(o0_ + 256 * j_); on1[j_] = *(const uint2*)(o0_ + (size_t)T * D + 256 * j_); } } } while (0)
    NORM_LOAD(rbase);
#pragma unroll 1
    for (int ri = 0; ri < rpw; ++ri) {
        const int row = rbase + ri; float v[16];
#pragma unroll
        for (int j = 0; j < 4; ++j) { v[4 * j] = xn[j].x; v[4 * j + 1] = xn[j].y; v[4 * j + 2] = xn[j].z; v[4 * j + 3] = xn[j].w; }
        if (MODE == 2) {
#pragma unroll
            for (int j = 0; j < 4; ++j) { const f32x4 gq = *(const LAS f32x4*)(cgp + 4 * F.lane + 256 * j);
                v[4 * j] += gq[0] * (__uint_as_float(on0[j].x << 16) + __uint_as_float(on1[j].x << 16)); v[4 * j + 1] += gq[1] * (__uint_as_float(on0[j].x & 0xFFFF0000u) + __uint_as_float(on1[j].x & 0xFFFF0000u));
                v[4 * j + 2] += gq[2] * (__uint_as_float(on0[j].y << 16) + __uint_as_float(on1[j].y << 16)); v[4 * j + 3] += gq[3] * (__uint_as_float(on0[j].y & 0xFFFF0000u) + __uint_as_float(on1[j].y & 0xFFFF0000u));
                uint2 xo_; xo_.x = pk2g(v[4 * j], v[4 * j + 1]); xo_.y = pk2g(v[4 * j + 2], v[4 * j + 3]); *(uint2*)(xout + (size_t)row * D + 4 * F.lane + 256 * j) = xo_; } }
        if (ri + 1 < rpw) NORM_LOAD(row + 1);
        float ss = 0.f;
#pragma unroll
        for (int i = 0; i < 16; ++i) ss += v[i] * v[i];
        ss = wave_sum(ss); const float r = rsqrtf(ss * (1.f / D) + 1e-6f);
#pragma unroll
        for (int j = 0; j < 4; ++j) { const f32x4 g4 = *(const LAS f32x4*)(cg + 4 * F.lane + 256 * j), s4 = *(const LAS f32x4*)(csh + 4 * F.lane + 256 * j);
#pragma unroll
            for (int e = 0; e < 4; ++e) v[4 * j + e] = v[4 * j + e] * r * g4[e] + s4[e];
            if (MODE == 2 || MODE == 0) *(unsigned*)((unsigned char*)p.h + (size_t)row * D + 4 * F.lane + 256 * j) = pk4_fp8(v[4 * j] * F8_SA, v[4 * j + 1] * F8_SA, v[4 * j + 2] * F8_SA, v[4 * j + 3] * F8_SA);
            else { uint2 pk; pk.x = pk2g(v[4 * j], v[4 * j + 1]); pk.y = pk2g(v[4 * j + 2], v[4 * j + 3]); *(uint2*)(p.h + (size_t)row * D + 4 * F.lane + 256 * j) = pk; } }
        if (MODE == 2) { float a8[8];
#pragma unroll
            for (int j = 0; j < 8; ++j) a8[j] = 0.f;
#pragma unroll
            for (int j = 0; j < 4; ++j)
#pragma unroll
                for (int e = 0; e < 4; ++e) { const LAS float* wr_ = rw + (e * 256 + 64 * j + F.lane) * TP; const float hv = v[4 * j + e];
#pragma unroll
                    for (int q2 = 0; q2 < 4; ++q2) { const f32x2_t w2 = *(const LAS f32x2_t*)(wr_ + 2 * q2); a8[2 * q2] += hv * w2[0]; a8[2 * q2 + 1] += hv * w2[1]; } }
#pragma unroll
            for (int j = 0; j < 8; ++j) a8[j] = wave_sum(a8[j]);
            if (F.lane < 8) { float a = 0.f;
#pragma unroll
                for (int j = 0; j < 8; ++j) a = (F.lane == j) ? a8[j] : a;
                if (F.lane < 4) { a += p.ml_bi[F.lane]; p.li[row * 4 + F.lane] = 15.f * tanhf(a / 15.f); }
                else { a += p.ml_bf[F.lane - 4]; const float cc = 15.f * tanhf(a / 15.f); p.lf[row * 4 + F.lane - 4] = (cc >= 0.f) ? -log1pf(expf(-cc)) : (cc - log1pf(expf(cc))); } } }
        if (MODE == 1) { float acc[32];
#pragma unroll
            for (int e = 0; e < 32; ++e) acc[e] = 0.f;
#pragma unroll
            for (int j = 0; j < 4; ++j)
#pragma unroll
                for (int e = 0; e < 4; ++e) { const LAS float* wr_ = rw + (e * 256 + 64 * j + F.lane) * TP; const float hv = v[4 * j + e]; asm volatile("" ::: "memory");
#pragma unroll
                    for (int q2 = 0; q2 < 16; ++q2) { const f32x2_t w2 = *(const LAS f32x2_t*)(wr_ + 2 * q2); acc[2 * q2] += hv * w2[0]; acc[2 * q2 + 1] += hv * w2[1]; } }
            float r16[16], r8[8], r4[4], r2[2], r1;
            { const bool hi = (F.lane & 32) != 0;
#pragma unroll
              for (int i = 0; i < 16; ++i) { const float keep = hi ? acc[16 + i] : acc[i], send = hi ? acc[i] : acc[16 + i]; r16[i] = keep + other32(send, hi); } }
            { const bool hi = (F.lane & 16) != 0;
#pragma unroll
              for (int i = 0; i < 8; ++i) { const float keep = hi ? r16[8 + i] : r16[i], send = hi ? r16[i] : r16[8 + i]; r8[i] = keep + sx<16>(send); } }
            { const bool hi = (F.lane & 8) != 0;
#pragma unroll
              for (int i = 0; i < 4; ++i) { const float keep = hi ? r8[4 + i] : r8[i], send = hi ? r8[i] : r8[4 + i]; r4[i] = keep + sx<8>(send); } }
            { const bool hi = (F.lane & 4) != 0;
#pragma unroll
              for (int i = 0; i < 2; ++i) { const float keep = hi ? r4[2 + i] : r4[i], send = hi ? r4[i] : r4[2 + i]; r2[i] = keep + sx<4>(send); } }
            { const bool hi = (F.lane & 2) != 0; const float keep = hi ? r2[1] : r2[0], send = hi ? r2[0] : r2[1]; r1 = keep + sx<2>(send); }
            r1 += sx<1>(r1);
            const float aff = sigmoidf_(r1); const float ch = aff + p.router_b[F.lane >> 1];
            float bestgs = -3e38f; int be0 = 0, be1 = 0; float ba0 = 0.f, ba1 = 0.f;
#pragma unroll
            for (int g = 0; g < 4; ++g) { float v1 = -3e38f, v2 = -3e38f, a1 = 0.f, a2 = 0.f; int i1 = 0, i2 = 0;
#pragma unroll
                for (int i = 0; i < 8; ++i) { const float a = rdlane(aff, 2 * (g * 8 + i)), c_ = rdlane(ch, 2 * (g * 8 + i));
                    if (c_ > v1) { v2 = v1; a2 = a1; i2 = i1; v1 = c_; a1 = a; i1 = i; } else if (c_ > v2) { v2 = c_; a2 = a; i2 = i; } }
                const float gs = v1 + v2; if (gs > bestgs) { bestgs = gs; be0 = g * 8 + i1; be1 = g * 8 + i2; ba0 = a1; ba1 = a2; } }
            if (F.lane == 0) { const float sum = ba0 + ba1; p.tokw[row * 2] = ba0 / sum; p.tokw[row * 2 + 1] = ba1 / sum;
                const int lr = row - row0; const int r0_ = atomicAdd((int*)&lcnt[be0], 1); const int r1_ = atomicAdd((int*)&lcnt[be1], 1);
                ent[lr * 4 + 0] = be0 | (r0_ << 8); ent[lr * 4 + 1] = row * 2; ent[lr * 4 + 2] = be1 | (r1_ << 8); ent[lr * 4 + 3] = row * 2 + 1; } }
    }
#undef NORM_LOAD
    if (MODE == 1) { __syncthreads();
        if (F.tid < 32) gbase[F.tid] = atomicAdd(&p.cnt[layer * 64 + F.tid], lcnt[F.tid]);
        __syncthreads();
        for (int idx = F.tid; idx < rows_per_wg * 2; idx += NTHR) { const int er = ent[idx * 2], tk = ent[idx * 2 + 1]; const int e = er & 255, rk = er >> 8; p.list[(size_t)e * T + gbase[e] + rk] = tk; }
        __syncthreads(); }
}

__device__ __forceinline__ void phase_norm_route(const Params& p, const Frame& F, const bf16_t* xin, const float* gain, const float* mod_sh, const float* mod_sc, int layer) {
    constexpr int rows_per_wg = T / NWG;
    const int row0 = F.bid * rows_per_wg, b = row0 / S, lane = F.lane, i16 = lane & 15, g = lane >> 4;
    constexpr int RTP = 2064;
    LAS unsigned char* thi = F.lds; LAS unsigned char* tlo = F.lds + 32 * RTP;
    LAS float* cg = (LAS float*)(F.lds + LDS_CONST); LAS float* csh = cg + D; LAS float* bias = csh + D; LAS float* bpart = bias + 32;
    LAS int* lcnt = (LAS int*)(F.lds + LDS_MISC + 64); LAS int* gbase = lcnt + 32; LAS int* ent = gbase + 32;
    for (int col = F.tid; col < D; col += NTHR) { cg[col] = gain[col] * (1.f + mod_sc[b * 6144 + col]); csh[col] = mod_sh[b * 6144 + col]; }
    if (F.tid < 32) lcnt[F.tid] = 0;
    __syncthreads();
    { const int e = F.tid & 31, part = F.tid >> 5; float a = 0.f;
#pragma unroll 8
      for (int k = part * 64; k < part * 64 + 64; k += 2) { const float w0 = p.router_w[k * 32 + e], w1 = p.router_w[(k + 1) * 32 + e];
          a += csh[k] * w0 + csh[k + 1] * w1;
          const float s0 = w0 * cg[k] * 256.f, s1 = w1 * cg[k + 1] * 256.f; const _Float16 h0 = (_Float16)s0, h1 = (_Float16)s1; const _Float16 l0 = (_Float16)(s0 - (float)h0), l1 = (_Float16)(s1 - (float)h1);
          *(LAS unsigned*)(thi + e * RTP + k * 2) = (unsigned)__builtin_bit_cast(unsigned short, h0) | ((unsigned)__builtin_bit_cast(unsigned short, h1) << 16);
          *(LAS unsigned*)(tlo + e * RTP + k * 2) = (unsigned)__builtin_bit_cast(unsigned short, l0) | ((unsigned)__builtin_bit_cast(unsigned short, l1) << 16); }
      bpart[part * 32 + e] = a; }
    __syncthreads();
    if (F.tid < 32) { float a = 0.f;
#pragma unroll
        for (int q = 0; q < 16; ++q) a += bpart[q * 32 + F.tid];
        bias[F.tid] = a; }
    const int rbase = row0 + F.wave * 16;
    const bf16_t* xr = xin + (size_t)(rbase + i16) * D + 8 * g;
    typedef _Float16 f16x8 __attribute__((ext_vector_type(8))); typedef unsigned u32x4r __attribute__((ext_vector_type(4)));
    const LAS unsigned char* bh0 = thi + i16 * RTP + 16 * g; const LAS unsigned char* bh1 = bh0 + 16 * RTP; const LAS unsigned char* bl0 = tlo + i16 * RTP + 16 * g; const LAS unsigned char* bl1 = bl0 + 16 * RTP;
    f32x4 acc0 = (f32x4){0.f, 0.f, 0.f, 0.f}, acc1 = (f32x4){0.f, 0.f, 0.f, 0.f}; float ss = 0.f;
    uint4 xa[2][8];
#define RT_LOAD(s_, q_) do { _Pragma("unroll") for (int u_ = 0; u_ < 8; ++u_) xa[s_][u_] = *(const uint4*)(xr + 32 * (8 * (q_) + u_)); } while (0)
    RT_LOAD(0, 0);
#pragma unroll
    for (int qd = 0; qd < 4; ++qd) {
        if (qd + 1 < 4) RT_LOAD((qd + 1) & 1, qd + 1);
#pragma unroll
        for (int u = 0; u < 8; ++u) { const int so = (8 * qd + u) * 64;
            const uint4 xc = xa[qd & 1][u]; const unsigned xw[4] = {xc.x, xc.y, xc.z, xc.w}; u32x4r ap;
#pragma unroll
            for (int i = 0; i < 4; ++i) { const float f0 = __uint_as_float(xw[i] << 16), f1 = __uint_as_float(xw[i] & 0xFFFF0000u); ss += f0 * f0 + f1 * f1; ap[i] = __builtin_bit_cast(unsigned, __builtin_amdgcn_cvt_pkrtz(f0, f1)); }
            const f16x8 a8 = __builtin_bit_cast(f16x8, ap);
            const f16x8 b0h = *(const LAS f16x8*)(bh0 + so), b0l = *(const LAS f16x8*)(bl0 + so), b1h = *(const LAS f16x8*)(bh1 + so), b1l = *(const LAS f16x8*)(bl1 + so);
            acc0 = __builtin_amdgcn_mfma_f32_16x16x32_f16(a8, b0h, acc0, 0, 0, 0); acc1 = __builtin_amdgcn_mfma_f32_16x16x32_f16(a8, b1h, acc1, 0, 0, 0);
            acc0 = __builtin_amdgcn_mfma_f32_16x16x32_f16(a8, b0l, acc0, 0, 0, 0); acc1 = __builtin_amdgcn_mfma_f32_16x16x32_f16(a8, b1l, acc1, 0, 0, 0); }
    }
#undef RT_LOAD
    ss = sum16(ss); ss = sum32(ss); const float r = rsqrtf(ss * (1.f / D) + 1e-6f);
    float af0[4], af1[4];
#pragma unroll
    for (int rr = 0; rr < 4; ++rr) { const float rrow = __int_as_float(__builtin_amdgcn_ds_bpermute((4 * g + rr) * 4, __float_as_int(r)));
        af0[rr] = sigmoidf_(rrow * (1.f / 256.f) * acc0[rr] + bias[i16]); af1[rr] = sigmoidf_(rrow * (1.f / 256.f) * acc1[rr] + bias[16 + i16]); }
    __syncthreads();
    LAS float* affl = (LAS float*)F.lds + F.wave * 512;
#pragma unroll
    for (int rr = 0; rr < 4; ++rr) { affl[(4 * g + rr) * 32 + i16] = af0[rr]; affl[(4 * g + rr) * 32 + 16 + i16] = af1[rr]; }
    asm volatile("s_waitcnt lgkmcnt(0)" ::: "memory");
    if (lane < 16) { const int row = rbase + lane; const LAS float* ar = affl + lane * 32;
        float bestgs = -3e38f; int be0 = 0, be1 = 0; float ba0 = 0.f, ba1 = 0.f;
#pragma unroll
        for (int gg = 0; gg < 4; ++gg) { float v1 = -3e38f, v2 = -3e38f, a1 = 0.f, a2 = 0.f; int i1 = 0, i2 = 0;
#pragma unroll
            for (int i = 0; i < 8; ++i) { const float a = ar[gg * 8 + i], c_ = a + p.router_b[gg * 8 + i];
                if (c_ > v1) { v2 = v1; a2 = a1; i2 = i1; v1 = c_; a1 = a; i1 = i; } else if (c_ > v2) { v2 = c_; a2 = a; i2 = i; } }
            const float gs = v1 + v2; if (gs > bestgs) { bestgs = gs; be0 = gg * 8 + i1; be1 = gg * 8 + i2; ba0 = a1; ba1 = a2; } }
        const float sum = ba0 + ba1; p.tokw[row * 2] = ba0 / sum; p.tokw[row * 2 + 1] = ba1 / sum;
        const int lr = row - row0; const int r0_ = atomicAdd((int*)&lcnt[be0], 1); const int r1_ = atomicAdd((int*)&lcnt[be1], 1);
        ent[lr * 4 + 0] = be0 | (r0_ << 8); ent[lr * 4 + 1] = row * 2; ent[lr * 4 + 2] = be1 | (r1_ << 8); ent[lr * 4 + 3] = row * 2 + 1; }
    { uint2 xq[2][4][4];
#define NR_LOAD(s_, r_) do { _Pragma("unroll") for (int k_ = 0; k_ < 4; ++k_) { const bf16_t* xq_ = xin + (size_t)((r_) + k_) * D + 4 * lane; _Pragma("unroll") for (int j_ = 0; j_ < 4; ++j_) xq[s_][k_][j_] = *(const uint2*)(xq_ + 256 * j_); } } while (0)
      NR_LOAD(0, rbase);
#pragma unroll
      for (int g4 = 0; g4 < 4; ++g4) {
          if (g4 + 1 < 4) NR_LOAD((g4 + 1) & 1, rbase + 4 * (g4 + 1));
#pragma unroll
          for (int k = 0; k < 4; ++k) { const int row = rbase + 4 * g4 + k; const float rr_ = rdlane(r, 4 * g4 + k);
#pragma unroll
              for (int j = 0; j < 4; ++j) { const f32x4 g4v = *(const LAS f32x4*)(cg + 4 * lane + 256 * j), s4_ = *(const LAS f32x4*)(csh + 4 * lane + 256 * j); const uint2 xc = xq[g4 & 1][k][j];
                  const float x0 = __uint_as_float(xc.x << 16), x1 = __uint_as_float(xc.x & 0xFFFF0000u), x2 = __uint_as_float(xc.y << 16), x3 = __uint_as_float(xc.y & 0xFFFF0000u);
                  *(unsigned*)((unsigned char*)p.h + (size_t)row * D + 4 * lane + 256 * j) = pk4_fp8((x0 * rr_ * g4v[0] + s4_[0]) * F8_SA, (x1 * rr_ * g4v[1] + s4_[1]) * F8_SA, (x2 * rr_ * g4v[2] + s4_[2]) * F8_SA, (x3 * rr_ * g4v[3] + s4_[3]) * F8_SA); } } }
#undef NR_LOAD
    }
    __syncthreads();
    if (F.tid < 32) gbase[F.tid] = atomicAdd(&p.cnt[layer * 64 + F.tid], lcnt[F.tid]);
    __syncthreads();
    for (int idx = F.tid; idx < rows_per_wg * 2; idx += NTHR) { const int er = ent[idx * 2], tk = ent[idx * 2 + 1]; const int e = er & 255, rk = er >> 8; p.list[(size_t)e * T + gbase[e] + rk] = tk; }
    __syncthreads();
}

struct MoeOrder { const LAS int* tab;
    __device__ bool next(int i, ge::Unit& u) const { if (i >= 8) return false; const int pm = __builtin_amdgcn_readfirstlane(tab[4 * i]); if (pm < 0) return false;
        u.pm = pm; u.pn = __builtin_amdgcn_readfirstlane(tab[4 * i + 1]); u.bt = __builtin_amdgcn_readfirstlane(tab[4 * i + 2]); u.aux = __builtin_amdgcn_readfirstlane(tab[4 * i + 3]); return true; } };
__device__ __forceinline__ void moe_plan(const Frame& F, const int* cnt, const int* list, LAS int* tab, LAS int* tkt  , int npn, const float* tokw = nullptr, LAS float* tkw = nullptr  , const float wscale = 1.f) {
    LAS int* lc = tab + 32;
    __syncthreads();
    if (F.tid < 32) lc[F.tid] = cnt[F.tid];
    __syncthreads();
    if (F.tid < 8) { const int L = F.tid * F.G + F.bid, mt = L / npn, pn = L % npn; int acc = 0, e_f = -1, mi_f = 0;
#pragma unroll 1
        for (int e = 0; e < NE; ++e) { const int nte = (lc[e] + 255) >> 8; if (e_f < 0 && mt < acc + nte) { e_f = e; mi_f = mt - acc; } acc += nte; }
        tab[4 * F.tid] = e_f < 0 ? -1 : mt; tab[4 * F.tid + 1] = pn; tab[4 * F.tid + 2] = e_f * npn + pn; tab[4 * F.tid + 3] = e_f | (mi_f << 8) | (F.tid << 24); }
    __syncthreads();
#pragma unroll
    for (int q = 0; q < 4; ++q) { const int idx = F.tid + NTHR * q, i = idx >> 8, r = idx & 255; int v = -1;
        if (tab[4 * i] >= 0) { const int aux = tab[4 * i + 3], e = aux & 255, ii = ((aux >> 8) & 0xFFFF) * 256 + r; if (ii < lc[e]) v = list[(size_t)e * T + ii]; }
        tkt[idx] = v; if (tkw) tkw[idx] = v >= 0 ? tokw[v] * wscale : 0.f; }
    __syncthreads();
}
struct MoeRows { static constexpr bool dense = false; const LAS int* tkt; __device__ __forceinline__ unsigned operator()(const ge::Unit& u, int r) const { const int tk = tkt[(u.aux >> 24) * 256 + r]; return tk < 0 ? (unsigned)T * (unsigned)(D * 2) : (unsigned)(tk >> 1) * (unsigned)D; } };
struct EpiMoe1 { unsigned char* hid8; float inscale;
    __device__ __forceinline__ void operator()(const f32x4 (&acc)[2][2][4][2], const ge::Unit& u, int wr, int wc, int fr, int fq) const {
        const int h0 = (4 * u.pn + wc) * 32 + 8 * fq;
#pragma unroll
        for (int ai = 0; ai < 2; ++ai)
#pragma unroll
            for (int m = 0; m < 4; ++m) { const int row = u.pm * 256 + ai * 128 + wr * 64 + m * 16 + fr; unsigned w[2];
#pragma unroll
                for (int n = 0; n < 2; ++n) { float r4[4];
#pragma unroll
                    for (int j = 0; j < 4; ++j) { const float g = acc[ai][0][m][n][j] * inscale, uu = acc[ai][1][m][n][j] * inscale; r4[j] = g * fsigmoid(g) * uu * F8_SH; }
                    w[n] = pk4_fp8(r4[0], r4[1], r4[2], r4[3]); }
                *(uint2*)(hid8 + (size_t)row * DE + h0) = make_uint2(w[0], w[1]); }
    } };
struct EpiMoe2 { bf16_t* outk; const LAS int* tkt; const LAS float* tkw;
    __device__ __forceinline__ void operator()(const f32x4 (&acc)[2][2][4][2], const ge::Unit& u, int wr, int wc, int fr, int fq) const {
        const int L0 = (4 * u.pn + wc) * 64 + 16 * fq; const int ub = (u.aux >> 24) * 256 + wr * 64 + fr; int tk[2][4]; float wt[2][4];
#pragma unroll
        for (int ai = 0; ai < 2; ++ai)
#pragma unroll
            for (int m = 0; m < 4; ++m) { tk[ai][m] = tkt[ub + ai * 128 + m * 16]; wt[ai][m] = tkw[ub + ai * 128 + m * 16]; }
#pragma unroll
        for (int ai = 0; ai < 2; ++ai)
#pragma unroll
            for (int m = 0; m < 4; ++m) { const int t_ = tk[ai][m]; if (t_ < 0) continue; const float w = wt[ai][m]; float v[16]; GE_VALS(v, acc, ai, m);
#pragma unroll
                for (int k = 0; k < 16; ++k) v[k] *= w;
                store16_bf16(outk + (size_t)(t_ & 1) * T * D + (size_t)(t_ >> 1) * D + L0, v); }
    } };

__device__ __forceinline__ void phase_cmp2(const Params& p, const Frame& F) {
    LAS float* w2l = (LAS float*)F.lds; const int base = F.bid * 8 + F.wave;
#pragma unroll 1
    for (int w = 0; w < 2; ++w) {
        __syncthreads();
        for (int i4 = F.tid; i4 < 256 * 64 / 4; i4 += NTHR) { const float4 t4 = *(const float4*)(p.cmp_w2 + (size_t)w * 256 * 64 + 4 * i4); *(LAS f32x4*)(w2l + 4 * i4) = (f32x4){t4.x, t4.y, t4.z, t4.w}; }
        float hv[2][4];
#pragma unroll
        for (int k = 0; k < 2; ++k) { const int row = (base + (2 * w + k) * 2048) & 4095;
#pragma unroll
            for (int i = 0; i < 4; ++i) { float x = p.cb1[w * 256 + i * 64 + F.lane];
#pragma unroll
                for (int ks = 0; ks < 8; ++ks) x += p.cpart[((size_t)(w * 8 + ks) * 4096 + row) * 256 + i * 64 + F.lane];
                hv[k][i] = 0.5f * x * (1.f + ftanh(0.7978845608028654f * (x + 0.044715f * x * x * x))); } }
        __syncthreads();
        float acc0 = p.cmp_b2[w * 64 + F.lane], acc1 = acc0;
#pragma unroll
        for (int i = 0; i < 4; ++i)
#pragma unroll 8
            for (int l = 0; l < 64; ++l) { const float wv = w2l[(i * 64 + l) * 64 + F.lane]; acc0 += rdlane(hv[0][i], l) * wv; acc1 += rdlane(hv[1][i], l) * wv; }
#pragma unroll
        for (int k = 0; k < 2; ++k) { const int row = (base + (2 * w + k) * 2048) & 4095, c = row & 127; float v = k ? acc1 : acc0;
            if (w == 0) { const float ss = wave_sum(v * v); v = v * rsqrtf(ss * (1.f / 64.f) + 1e-6f) * p.k_gain[F.lane]; int pos = c * 16 + 31; if (pos > 2047) pos = 2047;
                const float other = sx<8>(v); if (F.lane < 16) { const int j = F.lane & 7; const float cs = p.rope[pos * 16 + j], sn = p.rope[pos * 16 + 8 + j]; v = (F.lane < 8) ? (v * cs - other * sn) : (v * cs + other * sn); } }
            if (c == 127) v = 0.f;
            (w == 0 ? p.kcmp : p.vcmp)[(size_t)row * 64 + F.lane] = f2bf(v); }
    }
}

typedef float f32x16 __attribute__((ext_vector_type(16)));
typedef short s16x4 __attribute__((ext_vector_type(4)));
namespace at {
constexpr int KP = 144, VP = 192;
constexpr int KBUF = 64 * KP, VBUF = 64 * VP;
constexpr int OFF_K0 = 0, OFF_K1 = KBUF, OFF_V0 = 4 * KBUF, OFF_V1 = 4 * KBUF + VBUF, OFF_IMP = 4 * KBUF + 4 * VBUF;
constexpr int IMP_PITCH = 33, OFF_SEL = OFF_IMP + 8 * 32 * IMP_PITCH * 4;
constexpr float SC = 0.125f * 1.4426950408889634f;
constexpr float NEG = -1e30f, THR = 8.0f;
__device__ __forceinline__ unsigned pk2(float a, float b) { typedef float f2 __attribute__((ext_vector_type(2))); typedef __bf16 b2 __attribute__((ext_vector_type(2))); b2 r = __builtin_convertvector((f2){a, b}, b2); return __builtin_bit_cast(unsigned, r); }
template <int OFF> __device__ __forceinline__ s16x4 tr_read(unsigned addr) { s16x4 r; asm volatile("ds_read_b64_tr_b16 %0, %1 offset:%2" : "=&v"(r) : "v"(addr), "i"(OFF) : "memory"); return r; }
struct St { f32x16 o[2]; float m, l; };

__device__ __forceinline__ void qk_tile(const LAS unsigned char* kb, int r32, int hi, const bf16x8 (&qf)[4], f32x16& s0, f32x16& s1) {
#pragma unroll
    for (int e = 0; e < 16; ++e) { s0[e] = 0.f; s1[e] = 0.f; }
#pragma unroll
    for (int ks = 0; ks < 4; ++ks) {
        const bf16x8 a0 = *(const LAS bf16x8*)(kb + r32 * KP + (16 * ks + 8 * hi) * 2);
        const bf16x8 a1 = *(const LAS bf16x8*)(kb + (32 + r32) * KP + (16 * ks + 8 * hi) * 2);
        s0 = __builtin_amdgcn_mfma_f32_32x32x16_bf16(a0, qf[ks], s0, 0, 0, 0);
        s1 = __builtin_amdgcn_mfma_f32_32x32x16_bf16(a1, qf[ks], s1, 0, 0, 0);
    }
}
template <int MODE>
__device__ __forceinline__ bool elem_valid(int kt, int e, int hi, int qloc, int t, int key0) {
    const int kl = kt * 32 + (e & 3) + 8 * (e >> 2) + 4 * hi;
    if (MODE == 1) { const int c = key0 + kl; return (c < 127) && (16 * c + 31 <= t); }
    if (MODE == 2) return kl <= qloc;
    if (MODE == 3) return kl > qloc;
    return true;
}
template <int DT> __device__ __forceinline__ void pv_read(unsigned vb_lane, s16x4 (&va)[4][2]) {
    va[0][0] = tr_read<0 * VP + 64 * DT>(vb_lane); va[0][1] = tr_read<8 * VP + 64 * DT>(vb_lane); va[1][0] = tr_read<16 * VP + 64 * DT>(vb_lane); va[1][1] = tr_read<24 * VP + 64 * DT>(vb_lane);
    va[2][0] = tr_read<32 * VP + 64 * DT>(vb_lane); va[2][1] = tr_read<40 * VP + 64 * DT>(vb_lane); va[3][0] = tr_read<48 * VP + 64 * DT>(vb_lane); va[3][1] = tr_read<56 * VP + 64 * DT>(vb_lane);
}
__device__ __forceinline__ void pv_mma(const s16x4 (&va)[4][2], const unsigned (&pp)[16], f32x16& o) {
#pragma unroll
    for (int kk = 0; kk < 4; ++kk) {
        const bf16x8 af = (bf16x8){va[kk][0][0], va[kk][0][1], va[kk][0][2], va[kk][0][3], va[kk][1][0], va[kk][1][1], va[kk][1][2], va[kk][1][3]};
        typedef unsigned u32x4 __attribute__((ext_vector_type(4)));
        const u32x4 pw = (u32x4){pp[4 * kk], pp[4 * kk + 1], pp[4 * kk + 2], pp[4 * kk + 3]};
        o = __builtin_amdgcn_mfma_f32_32x32x16_bf16(af, __builtin_bit_cast(bf16x8, pw), o, 0, 0, 0);
    }
}
__device__ __forceinline__ void pv_tile(unsigned vb_lane, const unsigned (&pp)[16], St& st) {
    s16x4 va[4][2];
    pv_read<0>(vb_lane, va); asm volatile("s_waitcnt lgkmcnt(0)" ::: "memory"); __builtin_amdgcn_sched_barrier(0); pv_mma(va, pp, st.o[0]);
    pv_read<1>(vb_lane, va); asm volatile("s_waitcnt lgkmcnt(0)" ::: "memory"); __builtin_amdgcn_sched_barrier(0); pv_mma(va, pp, st.o[1]);
}
__device__ __forceinline__ float max3f(float a, float b, float c) { float r; asm("v_max3_f32 %0, %1, %2, %3" : "=v"(r) : "v"(a), "v"(b), "v"(c)); return r; }
template <int MODE, bool GATED, bool FIXED>
__device__ __forceinline__ void attend_tile(const LAS unsigned char* kb, unsigned vb_lane, int r32, int hi, const bf16x8 (&qf)[4], St& st, int qloc, bool en, float mfix) {
    f32x16 s0, s1; qk_tile(kb, r32, hi, qf, s0, s1);
    s16x4 va0[4][2]; pv_read<0>(vb_lane, va0);
    if (MODE != 0) {
#pragma unroll
        for (int e = 0; e < 16; ++e) { s0[e] = elem_valid<MODE>(0, e, hi, qloc, 0, 0) ? s0[e] : NEG; s1[e] = elem_valid<MODE>(1, e, hi, qloc, 0, 0) ? s1[e] : NEG; }
    }
    float mc = 0.f;
    if (FIXED) {
    } else {
        float mx = max3f(s0[0], s0[1], s1[0]);
#pragma unroll
        for (int e = 2; e < 16; e += 2) mx = max3f(mx, s0[e], s0[e + 1]);
#pragma unroll
        for (int e = 1; e < 15; e += 2) mx = max3f(mx, s1[e], s1[e + 1]);
        mx = fmaxf(mx, s1[15]);
        if (GATED) mx = en ? mx : NEG;
        mx = max32(mx);
        float mold = st.m;
        if (__any((mx - mold) * SC > THR)) {
            const float mnew = fmaxf(mold, mx); const float al = __builtin_amdgcn_exp2f((mold - mnew) * SC);
#pragma unroll
            for (int e = 0; e < 16; ++e) { st.o[0][e] *= al; st.o[1][e] *= al; }
            st.l *= al; st.m = mnew; mold = mnew;
        }
        mc = fmaxf(mold, -1e20f) * SC; if (GATED) mc = en ? mc : 3e38f;
    }
    float rs = 0.f; unsigned pp[16];
#pragma unroll
    for (int e = 0; e < 16; e += 2) {
        float a0, a1, b0, b1;
        if (FIXED) { a0 = __builtin_amdgcn_exp2f(s0[e]); a1 = __builtin_amdgcn_exp2f(s0[e + 1]); b0 = __builtin_amdgcn_exp2f(s1[e]); b1 = __builtin_amdgcn_exp2f(s1[e + 1]); }
        else { a0 = __builtin_amdgcn_exp2f(__builtin_fmaf(s0[e], SC, -mc)); a1 = __builtin_amdgcn_exp2f(__builtin_fmaf(s0[e + 1], SC, -mc)); b0 = __builtin_amdgcn_exp2f(__builtin_fmaf(s1[e], SC, -mc)); b1 = __builtin_amdgcn_exp2f(__builtin_fmaf(s1[e + 1], SC, -mc)); }
        rs += (a0 + a1) + (b0 + b1); pp[e >> 1] = pk2(a0, a1); pp[8 + (e >> 1)] = pk2(b0, b1); }
    if (FIXED && GATED) {
#pragma unroll
        for (int i = 0; i < 16; ++i) pp[i] = en ? pp[i] : 0u;
        rs = en ? rs : 0.f; }
    if (!FIXED) rs = sum32(rs);
    st.l += rs;
    asm volatile("s_waitcnt lgkmcnt(0)" ::: "memory"); __builtin_amdgcn_sched_barrier(0); pv_mma(va0, pp, st.o[0]);
    { s16x4 va1[4][2]; pv_read<1>(vb_lane, va1); asm volatile("s_waitcnt lgkmcnt(0)" ::: "memory"); __builtin_amdgcn_sched_barrier(0); pv_mma(va1, pp, st.o[1]); }
}
__device__ __forceinline__ void st_reset(St& st) {
#pragma unroll
    for (int a = 0; a < 2; ++a)
#pragma unroll
        for (int e = 0; e < 16; ++e) st.o[a][e] = 0.f;
    st.m = NEG; st.l = 0.f;
}
__device__ __forceinline__ void st_flush(const St& st, unsigned (&ofin)[2][8], float g, bool first) {
    const float f = (st.l > 0.f ? 1.f / st.l : 0.f) * g;
#pragma unroll
    for (int dt = 0; dt < 2; ++dt)
#pragma unroll
        for (int e = 0; e < 16; e += 2) { float a = st.o[dt][e] * f, b = st.o[dt][e + 1] * f;
            if (!first) { const unsigned w = ofin[dt][e >> 1]; a += __uint_as_float(w << 16); b += __uint_as_float(w & 0xFFFF0000u); }
            ofin[dt][e >> 1] = pk2(a, b); }
#pragma unroll
    for (int dt = 0; dt < 2; ++dt) asm volatile("" : "+v"(ofin[dt][0]), "+v"(ofin[dt][1]), "+v"(ofin[dt][2]), "+v"(ofin[dt][3]), "+v"(ofin[dt][4]), "+v"(ofin[dt][5]), "+v"(ofin[dt][6]), "+v"(ofin[dt][7]));
}
__device__ __forceinline__ void tile_load(const bf16_t* kbase, const bf16_t* vbase, int key0, int tid, uint4& kr, uint4& vr) {
    const size_t o = (size_t)(key0 + (tid >> 3)) * 64 + (tid & 7) * 8; kr = *(const uint4*)(kbase + o); vr = *(const uint4*)(vbase + o); }
typedef unsigned u32x4_t __attribute__((ext_vector_type(4)));
__device__ __forceinline__ void tile_store(LAS unsigned char* lds, int buf, int tid, const uint4& kr, const uint4& vr) {
    *(LAS u32x4_t*)(lds + OFF_K0 + buf * KBUF + (tid >> 3) * KP + (tid & 7) * 16) = (u32x4_t){kr.x, kr.y, kr.z, kr.w}; *(LAS u32x4_t*)(lds + OFF_V0 + buf * VBUF + (tid >> 3) * VP + (tid & 7) * 16) = (u32x4_t){vr.x, vr.y, vr.z, vr.w}; }
}

template <bool FIXED>
__device__ __forceinline__ void phase_attn_t(const Params& p, const Frame& F, const float mfix) {
    using namespace at;
    LAS unsigned char* lds = F.lds;
    const int tid = F.tid, lane = F.lane, w = F.wave, r32 = lane & 31, hi = lane >> 5;
    const unsigned vlane = (unsigned)((4 * hi + ((lane & 15) >> 2)) * VP + (16 * ((lane >> 4) & 1) + 4 * (lane & 3)) * 2);
    LAS float* impw = (LAS float*)(lds + OFF_IMP) + w * 32 * IMP_PITCH;
    LAS unsigned* selm = (LAS unsigned*)(lds + OFF_SEL);
    LAS float* invl = (LAS float*)(lds + OFF_SEL + 512);
#define AT_UNIT(ui_, qb_, bg_, qoff_) const int idx_##qb_ = ((ui_) & 1) ? ((ui_) * 256 + 255 - F.bid) : ((ui_) * 256 + F.bid); const int qb_ = 31 - (idx_##qb_ >> 6), bg_ = (idx_##qb_ >> 1) & 31, qoff_ = (idx_##qb_ & 1) * 32
    bf16x8 qf[4]; float gt[3]; uint4 kr, vr, kr1, vr1;
    { AT_UNIT(0, qb, bg, qoff);
      const bf16_t* kc = p.kcmp + (size_t)bg * 128 * 64; const bf16_t* vc = p.vcmp + (size_t)bg * 128 * 64;
      tile_load(kc, vc, 0, tid, kr, vr); if (qb >= 16) tile_load(kc, vc, 64, tid, kr1, vr1); }
#pragma unroll 1
    for (int ui = 0; ui < 8; ++ui) {
        AT_UNIT(ui, qb, bg, qoff);
        const int b = bg >> 1, g = bg & 1, head = g * 8 + w, s0 = qb * 64;
        const int qloc = qoff + r32, t = s0 + qloc;
        const bf16_t* ksel = p.kv + (size_t)2 * T * 128 + (size_t)bg * S * 64; const bf16_t* vsel = p.kv + (size_t)3 * T * 128 + (size_t)bg * S * 64;
        const bf16_t* kwin = p.kv + (size_t)4 * T * 128 + (size_t)bg * S * 64; const bf16_t* vwin = p.kv + (size_t)5 * T * 128 + (size_t)bg * S * 64;
        unsigned ofin[2][8]; St st;
        { const size_t tok = (size_t)b * S + t;
#pragma unroll
          for (int ks = 0; ks < 4; ++ks) { qf[ks] = *(const bf16x8*)(p.q + tok * D + head * 64 + 16 * ks + 8 * hi);
              if (FIXED) { typedef unsigned u32x4q __attribute__((ext_vector_type(4))); const u32x4q w4 = __builtin_bit_cast(u32x4q, qf[ks]); u32x4q r4;
#pragma unroll
                  for (int i = 0; i < 4; ++i) r4[i] = pk2(__uint_as_float(w4[i] << 16) * SC, __uint_as_float(w4[i] & 0xFFFF0000u) * SC);
                  qf[ks] = __builtin_bit_cast(bf16x8, r4); } }
#pragma unroll
          for (int br = 0; br < 3; ++br) gt[br] = p.gates[tok * 48 + br * 16 + head]; }
        const int nct = (qb >= 16) ? 2 : 1;
        __syncthreads();
        tile_store(lds, 0, tid, kr, vr); if (nct == 2) tile_store(lds, 1, tid, kr1, vr1);
        tile_load(ksel, vsel, qb * 64, tid, kr, vr);
        __syncthreads();
        float cm = NEG, cl = 0.f;
        if (!FIXED) {
#pragma unroll 1
        for (int ct = 0; ct < nct; ++ct) { const LAS unsigned char* kb = lds + (ct ? OFF_K1 : OFF_K0);
            f32x16 a0, a1; qk_tile(kb, r32, hi, qf, a0, a1); float mx = NEG;
#pragma unroll
            for (int e = 0; e < 16; ++e) { a0[e] = elem_valid<1>(0, e, hi, qloc, t, ct * 64) ? a0[e] : NEG; a1[e] = elem_valid<1>(1, e, hi, qloc, t, ct * 64) ? a1[e] : NEG; mx = fmaxf(mx, fmaxf(a0[e], a1[e])); }
            mx = max32(mx); const float mnew = fmaxf(cm, mx); float rs = 0.f;
#pragma unroll
            for (int e = 0; e < 16; ++e) { rs += (a0[e] > -1e29f ? __builtin_amdgcn_exp2f((a0[e] - mnew) * SC) : 0.f) + (a1[e] > -1e29f ? __builtin_amdgcn_exp2f((a1[e] - mnew) * SC) : 0.f); }
            rs = sum32(rs); cl = cl * __builtin_amdgcn_exp2f((cm - mnew) * SC) + rs; cm = mnew; }
        }
        st_reset(st); if (FIXED) cm = mfix / SC; else st.m = cm;
        const float icl = FIXED ? 1.f : (cl > 0.f ? 1.f / cl : 0.f);
        LAS float* irow = impw + r32 * IMP_PITCH;
        if (nct == 1) {
#pragma unroll 1
            for (int j = 16; j < 32; ++j) irow[j] = 0.f; }
#pragma unroll 1
        for (int ct = 0; ct < nct; ++ct) { const LAS unsigned char* kb = lds + (ct ? OFF_K1 : OFF_K0); const unsigned vb = (unsigned)(unsigned long)(lds + (ct ? OFF_V1 : OFF_V0)) + vlane;
            f32x16 a0, a1; qk_tile(kb, r32, hi, qf, a0, a1); const float mc = cm * SC; unsigned pp[16]; float rs = 0.f; float Ai[8], Fi[8];
            int clim = (t - 31) >> 4; clim = (clim > 126 ? 126 : clim) - 4 * hi - ct * 64;
#pragma unroll
            for (int kt = 0; kt < 2; ++kt)
#pragma unroll
                for (int gq = 0; gq < 4; ++gq) { float pv[4];
#pragma unroll
                    for (int e2 = 0; e2 < 4; ++e2) { const int e = gq * 4 + e2; const float sv = kt ? a1[e] : a0[e]; pv[e2] = (kt * 32 + (e & 3) + 8 * (e >> 2) <= clim) ? (FIXED ? __builtin_amdgcn_exp2f(sv) : __builtin_amdgcn_exp2f(sv * SC - mc)) : 0.f; }
                    pp[kt * 8 + gq * 2] = pk2(pv[0], pv[1]); pp[kt * 8 + gq * 2 + 1] = pk2(pv[2], pv[3]); rs += (pv[0] + pv[1]) + (pv[2] + pv[3]);
                    Ai[kt * 4 + gq] = (pv[0] + 2.f * (pv[1] + pv[2] + pv[3])) * icl; Fi[kt * 4 + gq] = pv[0] * icl; }
            st.l += rs;
            float Fr[8];
#pragma unroll
            for (int g8 = 0; g8 < 8; ++g8) Fr[g8] = other32(Fi[g8], hi != 0);
#pragma unroll
            for (int g8 = 0; g8 < 8; ++g8) { const float nxt = (g8 < 7) ? Fr[g8 + 1] : 0.f;
                irow[ct * 16 + 2 * g8 + hi] = Ai[g8] + (hi ? nxt : Fr[g8]); }
            if (ct == 1 && hi) irow[15] += Fr[0];
            pv_tile(vb, pp, st); }
        st.l = sum32(st.l);
        if (hi == 0) invl[w * 32 + r32] = FIXED ? (st.l > 0.f ? 1.f / st.l : 0.f) : 1.f;
        tile_store(lds, 2, tid, kr, vr);
        st_flush(st, ofin, gt[0], true);
        __syncthreads();
        if (w == 0) { unsigned mask;
            if (qb < 8) mask = (2u << qb) - 1u;
            else { mask = 1u | (1u << qb) | (1u << (qb - 1));
                const LAS float* ib = (const LAS float*)(lds + OFF_IMP) + r32 * IMP_PITCH; float iv[32];
#pragma unroll
                for (int j = 0; j < 32; ++j) { float v = 0.f;
#pragma unroll
                    for (int ww = 0; ww < 8; ++ww) v += ib[ww * 32 * IMP_PITCH + j] * invl[ww * 32 + r32];
                    iv[j] = (j >= 1 && j <= qb - 2) ? v : -3e38f; }
#pragma unroll 1
                for (int pick = 0; pick < 5; ++pick) { int best = -1; float bv = -3e38f;
#pragma unroll
                    for (int j = 1; j < 31; ++j) { const bool take = !((mask >> j) & 1u) && iv[j] > bv; bv = take ? iv[j] : bv; best = take ? j : best; }
                    if (best >= 0) mask |= 1u << best; } }
            if (hi == 0) selm[r32] = mask; unsigned um = mask;
            um |= sxu<16>(um); um |= sxu<8>(um); um |= sxu<4>(um); um |= sxu<2>(um); um |= sxu<1>(um);
            if (lane == 0) selm[32] = um; }
        __syncthreads();
        const int jlo = qb >= 8 ? qb - 8 : 0;
        { const unsigned um = selm[32]; const unsigned mq = selm[r32];
          st_reset(st);
          unsigned rem = um & ~(1u << qb);
#define SEL_POP(dst) do { if (rem) { dst = 31 - __builtin_clz(rem); rem &= ~(1u << dst); } else dst = -1; } while (0)
          int jA = qb, jB = -1, sb = 1;
          for (;;) {
              int nA, nB = -1; SEL_POP(nA); if (nA >= 0) SEL_POP(nB);
              if (nA >= 0) tile_load(ksel, vsel, nA * 64, tid, kr, vr);
              if (nB >= 0) tile_load(ksel, vsel, nB * 64, tid, kr1, vr1);
              if (nA < 0) { tile_load(kwin, vwin, qb * 64, tid, kr, vr); if (qb - 1 >= jlo) tile_load(kwin, vwin, (qb - 1) * 64, tid, kr1, vr1); }
              { const LAS unsigned char* kb = lds + OFF_K0 + (2 * sb) * KBUF; const unsigned vb = (unsigned)(unsigned long)(lds + OFF_V0 + (2 * sb) * VBUF) + vlane;
                if (jA == qb) attend_tile<2, false, FIXED>(kb, vb, r32, hi, qf, st, qloc, true, mfix);
                else attend_tile<0, true, FIXED>(kb, vb, r32, hi, qf, st, qloc, (mq >> jA) & 1u, mfix); }
              if (jB >= 0) { const LAS unsigned char* kb = lds + OFF_K0 + (2 * sb + 1) * KBUF; const unsigned vb = (unsigned)(unsigned long)(lds + OFF_V0 + (2 * sb + 1) * VBUF) + vlane;
                attend_tile<0, true, FIXED>(kb, vb, r32, hi, qf, st, qloc, (mq >> jB) & 1u, mfix); }
              if (nA < 0) break;
              tile_store(lds, 2 * (sb ^ 1), tid, kr, vr); if (nB >= 0) tile_store(lds, 2 * (sb ^ 1) + 1, tid, kr1, vr1);
              __syncthreads();
              jA = nA; jB = nB; sb ^= 1;
          }
#undef SEL_POP
          if (FIXED) st.l = sum32(st.l);
          st_flush(st, ofin, gt[1], false); }
        __syncthreads();
        { st_reset(st);
          int jA = qb, jB = (qb - 1 >= jlo) ? qb - 1 : -1, sb = 0;
          tile_store(lds, 0, tid, kr, vr); if (jB >= 0) tile_store(lds, 1, tid, kr1, vr1);
          __syncthreads();
          for (;;) {
              const int nA = (jB >= 0 && jB - 1 >= jlo) ? jB - 1 : -1, nB = (nA >= 0 && nA - 1 >= jlo) ? nA - 1 : -1;
              if (nA >= 0) tile_load(kwin, vwin, nA * 64, tid, kr, vr);
              if (nB >= 0) tile_load(kwin, vwin, nB * 64, tid, kr1, vr1);
              if (nA < 0 && ui + 1 < 8) {
                  AT_UNIT(ui + 1, qbn, bgn, qoffn);
                  const bf16_t* kcn = p.kcmp + (size_t)bgn * 128 * 64; const bf16_t* vcn = p.vcmp + (size_t)bgn * 128 * 64;
                  tile_load(kcn, vcn, 0, tid, kr, vr); if (qbn >= 16) tile_load(kcn, vcn, 64, tid, kr1, vr1); }
#define WIN_TILE(j_, bi_) do { const LAS unsigned char* kb = lds + OFF_K0 + (bi_) * KBUF; const unsigned vb = (unsigned)(unsigned long)(lds + OFF_V0 + (bi_) * VBUF) + vlane; \
                if ((j_) == qb) attend_tile<2, false, FIXED>(kb, vb, r32, hi, qf, st, qloc, true, mfix); else if ((j_) == qb - 8) attend_tile<3, false, FIXED>(kb, vb, r32, hi, qf, st, qloc, true, mfix); else attend_tile<0, false, FIXED>(kb, vb, r32, hi, qf, st, qloc, true, mfix); } while (0)
              WIN_TILE(jA, 2 * sb);
              if (jB >= 0) WIN_TILE(jB, 2 * sb + 1);
#undef WIN_TILE
              if (nA < 0) break;
              tile_store(lds, 2 * (sb ^ 1), tid, kr, vr); if (nB >= 0) tile_store(lds, 2 * (sb ^ 1) + 1, tid, kr1, vr1);
              __syncthreads();
              jA = nA; jB = nB; sb ^= 1;
          }
          if (FIXED) st.l = sum32(st.l);
          st_flush(st, ofin, gt[2], false); }
        { int l2 = lane; asm volatile("" : "+v"(l2)); unsigned char* op = (unsigned char*)p.h + ((size_t)b * S + s0 + qoff + (l2 & 31)) * D + head * 64 + 4 * (l2 >> 5);
#pragma unroll
          for (int dt = 0; dt < 2; ++dt)
#pragma unroll
            for (int gq = 0; gq < 4; ++gq) { const unsigned w0 = ofin[dt][2 * gq], w1 = ofin[dt][2 * gq + 1];
                *(unsigned*)(op + dt * 32 + 8 * gq) = pk4_fp8(__uint_as_float(w0 << 16) * F8_SA, __uint_as_float(w0 & 0xFFFF0000u) * F8_SA, __uint_as_float(w1 << 16) * F8_SA, __uint_as_float(w1 & 0xFFFF0000u) * F8_SA); } }
    }
#undef AT_UNIT
}

__device__ __forceinline__ void phase_attn(const Params& p, const Frame& F) {
    const float gq = wave_max(fabsf(p.q_gain[F.lane])); const float gk = wave_max(fmaxf(fabsf(p.k_gain[F.lane]), fmaxf(fabsf(p.k_gain[64 + F.lane]), fabsf(p.k_gain[128 + F.lane]))));
    const float mfix = 64.f * 1.02f * gq * gk * at::SC;
    if (mfix < 60.f) phase_attn_t<true>(p, F, mfix);
    else phase_attn_t<false>(p, F, 0.f);
}

namespace ml {
constexpr int QP = 272, VP = 192;
constexpr int OFF_Q = 0, OFF_K = 64 * QP, OFF_V = 2 * 64 * QP, OFF_WV = OFF_V + 64 * VP, OFF_CB = OFF_WV + 64 * VP, OFF_GA = OFF_CB + 128 * VP, OFF_GAM = OFF_GA + 8192, OFF_GB = OFF_GAM + 8192,
              OFF_MP = OFF_GB + 8192, OFF_W = OFF_MP + 256, OFF_N = OFF_W + 256, OFF_RS = OFF_N + 512, OFF_QN = OFF_RS + 256, OFF_END = OFF_QN + 256;
typedef unsigned u32x4_t __attribute__((ext_vector_type(4)));
}
__device__ __forceinline__ void phase_scan(const Params& p, const Frame& F, bf16_t* hs_base  , const int hs_stride) {
    using namespace ml; using at::tr_read; using at::pk2;
    LAS unsigned char* lds = F.lds;
    const int tid = F.tid, lane = F.lane, w = F.wave, i16 = lane & 15, g = lane >> 4, r32 = lane & 31, hi = lane >> 5;
    const int b = F.bid >> 4, h = (F.bid >> 2) & 3, vs = F.bid & 3;
    LAS float* ga = (LAS float*)(lds + OFF_GA); LAS float* gam = (LAS float*)(lds + OFF_GAM); LAS float* gb = (LAS float*)(lds + OFF_GB); LAS float* mp = (LAS float*)(lds + OFF_MP);
    LAS float* wl = (LAS float*)(lds + OFF_W); LAS float* nl = (LAS float*)(lds + OFF_N); LAS float* rsl = (LAS float*)(lds + OFF_RS); LAS float* qnl = (LAS float*)(lds + OFF_QN);
    for (int ck = w; ck < 32; ck += 8) { const int pos = ck * 64 + lane; const size_t tg = ((size_t)b * S + pos) * 4 + h; const float lfv = p.lf[tg], liv = p.li[tg];
        float bs = lfv;
#pragma unroll
        for (int o = 1; o < 64; o <<= 1) { const float x = __int_as_float(__builtin_amdgcn_ds_bpermute((lane - o) * 4, __float_as_int(bs))); if (lane >= o) bs += x; }
        const float av = liv - bs; float am = av;
#pragma unroll
        for (int o = 1; o < 64; o <<= 1) { const float x = __int_as_float(__builtin_amdgcn_ds_bpermute((lane - o) * 4, __float_as_int(am))); if (lane >= o) am = fmaxf(am, x); }
        ga[pos] = av; gam[pos] = am; gb[pos] = bs; }
    for (int idx = tid; idx < 128 * VP / 4; idx += NTHR) ((LAS unsigned*)(lds + OFF_CB))[idx] = 0u;
    if (tid < 128) nl[tid] = 0.f;
    __syncthreads();
    if (tid == 0) { float m = 0.f;
#pragma unroll 1
        for (int k = 0; k < 32; ++k) { mp[k] = m; m = gb[k * 64 + 63] + fmaxf(m, gam[k * 64 + 63]); } }
    __syncthreads();
    const bf16_t* pq = p.proj + (size_t)b * S * 3072 + h * 128; const bf16_t* pk = pq + 512; bf16_t* pv = p.proj + (size_t)b * S * 3072 + 1024 + h * 256 + vs * 64;
    uint4 rq[2], rk[2], rv;
#define ML_LOAD(ck_) do { const size_t t0_ = (size_t)(ck_) * 64; _Pragma("unroll") for (int i_ = 0; i_ < 2; ++i_) { const int idx_ = tid + 512 * i_; const size_t o_ = (t0_ + (idx_ >> 4)) * 3072 + (idx_ & 15) * 8; rq[i_] = *(const uint4*)(pq + o_); rk[i_] = *(const uint4*)(pk + o_); } \
        rv = *(const uint4*)(pv + (t0_ + (tid >> 3)) * 3072 + (tid & 7) * 8); } while (0)
#define ML_STORE(ck_) do { _Pragma("unroll") for (int i_ = 0; i_ < 2; ++i_) { const int idx_ = tid + 512 * i_; const int o_ = (idx_ >> 4) * QP + (idx_ & 15) * 16; \
            *(LAS u32x4_t*)(lds + OFF_Q + o_) = (u32x4_t){rq[i_].x, rq[i_].y, rq[i_].z, rq[i_].w}; *(LAS u32x4_t*)(lds + OFF_K + o_) = (u32x4_t){rk[i_].x, rk[i_].y, rk[i_].z, rk[i_].w}; } \
        { const int s_ = tid >> 3; const float m63_ = fmaxf(mp[ck_], gam[(ck_) * 64 + 63]); const float ws_ = __expf(ga[(ck_) * 64 + s_] - m63_); if ((tid & 7) == 0) wl[s_] = ws_; \
          const int o_ = s_ * VP + (tid & 7) * 16; *(LAS u32x4_t*)(lds + OFF_V + o_) = (u32x4_t){rv.x, rv.y, rv.z, rv.w}; const unsigned vv_[4] = {rv.x, rv.y, rv.z, rv.w}; unsigned ww_[4]; \
          _Pragma("unroll") for (int e_ = 0; e_ < 4; ++e_) ww_[e_] = pk2(__uint_as_float(vv_[e_] << 16) * ws_, __uint_as_float(vv_[e_] & 0xFFFF0000u) * ws_); \
          *(LAS u32x4_t*)(lds + OFF_WV + o_) = (u32x4_t){ww_[0], ww_[1], ww_[2], ww_[3]}; } } while (0)
    ML_LOAD(0); ML_STORE(0);
    __syncthreads();
    const int tt = w >> 1, vh = w & 1;
    const int dt = w >> 1, vt2 = w & 1;
    const unsigned trl16 = (unsigned)(((lane & 15) >> 2) * VP + (4 * (lane & 3)) * 2);
    const unsigned trl32v = (unsigned)(((lane & 15) >> 2) * VP + (16 * ((lane >> 4) & 1) + 4 * (lane & 3)) * 2);
    const unsigned trl32k = (unsigned)(((lane & 15) >> 2) * QP + (16 * ((lane >> 4) & 1) + 4 * (lane & 3)) * 2);
    f32x16 cacc;
#pragma unroll
    for (int e = 0; e < 16; ++e) cacc[e] = 0.f;
    float nreg = 0.f;
    bf16_t* const hs_out = hs_base + (size_t)b * S * hs_stride + h * 256 + vs * 64 + 32 * vh + i16;
    const size_t wo1 = (size_t)NE * D * DE; const ColGateUp cgu{p.w_gate + wo1, p.w_up + wo1}; const ColDown cdn{p.w_down + wo1};
    LAS float* ptile = (LAS float*)(lds + OFF_END) + (tid >> 8) * (64 * 65); const int htid = tid & 255, half = tid >> 8;
    float pr_[16];
#define PREP_LOAD(s_) do { const bool gu_ = (s_) < 16; const int tl_ = (((gu_ ? (s_) : (s_) - 16) * F.G + F.bid) * 2 + half); const int c0_ = (tl_ & 511) * 64, k0_ = (tl_ >> 9) * 64; \
        const float* p_ = gu_ ? cgu(c0_ + (htid & 63)) : cdn(c0_ + (htid & 63)); const int ldw_ = gu_ ? DE : D; p_ += (size_t)(k0_ + (htid >> 6)) * ldw_; \
        _Pragma("unroll") for (int i_ = 0; i_ < 16; ++i_) pr_[i_] = p_[(size_t)(4 * i_) * ldw_]; } while (0)
#define PREP_WRITE() do { _Pragma("unroll") for (int i_ = 0; i_ < 16; ++i_) ptile[((htid >> 6) + 4 * i_) * 65 + (htid & 63)] = pr_[i_]; } while (0)
#define PREP_STORE(s_) do { const bool gu_ = (s_) < 16; const int tl_ = (((gu_ ? (s_) : (s_) - 16) * F.G + F.bid) * 2 + half); const int c0_ = (tl_ & 511) * 64, k0_ = (tl_ >> 9) * 64; \
        const int cc_ = htid >> 2, ch_ = (htid & 3) * 16; \
        { const float sc_ = gu_ ? F8_SW : F8_SW2; const unsigned long long a_ = (unsigned long long)p.gu_t, d_ = (unsigned long long)p.dn_t - a_; unsigned char* base_ = (unsigned char*)(a_ + (gu_ ? 0ull : d_)); const int kp_ = gu_ ? D : DE; \
          unsigned w_[4]; _Pragma("unroll") for (int i_ = 0; i_ < 4; ++i_) w_[i_] = pk4_fp8(ptile[(ch_ + 4 * i_) * 65 + cc_] * sc_, ptile[(ch_ + 4 * i_ + 1) * 65 + cc_] * sc_, ptile[(ch_ + 4 * i_ + 2) * 65 + cc_] * sc_, ptile[(ch_ + 4 * i_ + 3) * 65 + cc_] * sc_); \
          *(uint4*)(base_ + (size_t)(c0_ + cc_) * kp_ + k0_ + ch_) = make_uint4(w_[0], w_[1], w_[2], w_[3]); } } while (0)
    PREP_LOAD(0);
#pragma unroll 1
    for (int ck = 0; ck < 32; ++ck) {
        if (ck + 1 < 32) ML_LOAD(ck + 1);
        const float mprev = mp[ck]; const int c0 = ck * 64;
        bf16x8 qf[4];
#pragma unroll
        for (int ks = 0; ks < 4; ++ks) qf[ks] = *(const LAS bf16x8*)(lds + OFF_Q + (16 * tt + i16) * QP + (32 * ks + 8 * g) * 2);
        f32x4 st[4];
#pragma unroll
        for (int jt = 0; jt < 4; ++jt) { st[jt] = (f32x4){0.f, 0.f, 0.f, 0.f};
#pragma unroll
            for (int ks = 0; ks < 4; ++ks) { const bf16x8 kf = *(const LAS bf16x8*)(lds + OFF_K + (16 * jt + i16) * QP + (32 * ks + 8 * g) * 2); st[jt] = __builtin_amdgcn_mfma_f32_16x16x32_bf16(kf, qf[ks], st[jt], 0, 0, 0); } }
        const int tl = 16 * tt + i16; const float Mt = fmaxf(mprev, gam[c0 + tl]); float rs = 0.f; unsigned ap[8];
#pragma unroll
        for (int jt = 0; jt < 4; ++jt) { float v4[4]; const f32x4 ga4 = *(const LAS f32x4*)(ga + c0 + 16 * jt + 4 * g);
#pragma unroll
            for (int r = 0; r < 4; ++r) { const int j = 16 * jt + 4 * g + r; const float e = __expf(ga4[r] - Mt) * st[jt][r]; v4[r] = (j <= tl) ? e : 0.f; rs += v4[r]; }
            ap[jt * 2] = pk2(v4[0], v4[1]); ap[jt * 2 + 1] = pk2(v4[2], v4[3]); }
        rs = sum16(rs); rs = sum32(rs);
        float qn = 0.f;
#pragma unroll
        for (int ks = 0; ks < 4; ++ks) { const f32x4 n0 = *(const LAS f32x4*)(nl + 32 * ks + 8 * g), n1 = *(const LAS f32x4*)(nl + 32 * ks + 8 * g + 4);
#pragma unroll
            for (int e = 0; e < 4; ++e) { qn += bf2f((bf16_t)qf[ks][e]) * n0[e]; qn += bf2f((bf16_t)qf[ks][4 + e]) * n1[e]; } }
        qn = sum16(qn); qn = sum32(qn);
        if (vh == 0 && g == 0) { rsl[tl] = rs; qnl[tl] = qn; }
        f32x4 av[2], qc[2];
#pragma unroll
        for (int vt = 0; vt < 2; ++vt) { av[vt] = (f32x4){0.f, 0.f, 0.f, 0.f}; qc[vt] = (f32x4){0.f, 0.f, 0.f, 0.f}; }
        {   const unsigned vb = (unsigned)(unsigned long)(lds + OFF_V) + trl16 + (unsigned)(4 * g * VP + (32 * vh) * 2);
            const unsigned cb = (unsigned)(unsigned long)(lds + OFF_CB) + trl16 + (unsigned)(8 * g * VP + (32 * vh) * 2);
            s16x4 va[2][2][2], ca[4][2][2];
#pragma unroll
            for (int vt = 0; vt < 2; ++vt) {
                if (vt == 0) { va[0][0][0] = tr_read<0 * VP>(vb); va[0][0][1] = tr_read<16 * VP>(vb); va[1][0][0] = tr_read<32 * VP>(vb); va[1][0][1] = tr_read<48 * VP>(vb);
                    ca[0][0][0] = tr_read<0 * VP>(cb); ca[0][0][1] = tr_read<4 * VP>(cb); ca[1][0][0] = tr_read<32 * VP>(cb); ca[1][0][1] = tr_read<36 * VP>(cb);
                    ca[2][0][0] = tr_read<64 * VP>(cb); ca[2][0][1] = tr_read<68 * VP>(cb); ca[3][0][0] = tr_read<96 * VP>(cb); ca[3][0][1] = tr_read<100 * VP>(cb); }
                else { va[0][1][0] = tr_read<0 * VP + 32>(vb); va[0][1][1] = tr_read<16 * VP + 32>(vb); va[1][1][0] = tr_read<32 * VP + 32>(vb); va[1][1][1] = tr_read<48 * VP + 32>(vb);
                    ca[0][1][0] = tr_read<0 * VP + 32>(cb); ca[0][1][1] = tr_read<4 * VP + 32>(cb); ca[1][1][0] = tr_read<32 * VP + 32>(cb); ca[1][1][1] = tr_read<36 * VP + 32>(cb);
                    ca[2][1][0] = tr_read<64 * VP + 32>(cb); ca[2][1][1] = tr_read<68 * VP + 32>(cb); ca[3][1][0] = tr_read<96 * VP + 32>(cb); ca[3][1][1] = tr_read<100 * VP + 32>(cb); } }
            asm volatile("s_waitcnt lgkmcnt(0)" ::: "memory"); __builtin_amdgcn_sched_barrier(0);
#pragma unroll
            for (int vt = 0; vt < 2; ++vt) {
#pragma unroll
                for (int pp = 0; pp < 2; ++pp) { const bf16x8 bfv = (bf16x8){va[pp][vt][0][0], va[pp][vt][0][1], va[pp][vt][0][2], va[pp][vt][0][3], va[pp][vt][1][0], va[pp][vt][1][1], va[pp][vt][1][2], va[pp][vt][1][3]};
                    const u32x4_t aw = (u32x4_t){ap[4 * pp], ap[4 * pp + 1], ap[4 * pp + 2], ap[4 * pp + 3]};
                    av[vt] = __builtin_amdgcn_mfma_f32_16x16x32_bf16(__builtin_bit_cast(bf16x8, aw), bfv, av[vt], 0, 0, 0); }
#pragma unroll
                for (int ks = 0; ks < 4; ++ks) { const bf16x8 bfc = (bf16x8){ca[ks][vt][0][0], ca[ks][vt][0][1], ca[ks][vt][0][2], ca[ks][vt][0][3], ca[ks][vt][1][0], ca[ks][vt][1][1], ca[ks][vt][1][2], ca[ks][vt][1][3]};
                    qc[vt] = __builtin_amdgcn_mfma_f32_16x16x32_bf16(qf[ks], bfc, qc[vt], 0, 0, 0); } }
        }
        const float M63 = fmaxf(mprev, gam[c0 + 63]); const float decay = __expf(mprev - M63);
        {   const unsigned kb = (unsigned)(unsigned long)(lds + OFF_K) + trl32k + (unsigned)(8 * hi * QP + (32 * dt) * 2);
            const unsigned wb = (unsigned)(unsigned long)(lds + OFF_WV) + trl32v + (unsigned)(8 * hi * VP + (32 * vt2) * 2);
            s16x4 ka[4][2], wa[4][2];
            ka[0][0] = tr_read<0 * QP>(kb); ka[0][1] = tr_read<4 * QP>(kb); ka[1][0] = tr_read<16 * QP>(kb); ka[1][1] = tr_read<20 * QP>(kb);
            ka[2][0] = tr_read<32 * QP>(kb); ka[2][1] = tr_read<36 * QP>(kb); ka[3][0] = tr_read<48 * QP>(kb); ka[3][1] = tr_read<52 * QP>(kb);
            wa[0][0] = tr_read<0 * VP>(wb); wa[0][1] = tr_read<4 * VP>(wb); wa[1][0] = tr_read<16 * VP>(wb); wa[1][1] = tr_read<20 * VP>(wb);
            wa[2][0] = tr_read<32 * VP>(wb); wa[2][1] = tr_read<36 * VP>(wb); wa[3][0] = tr_read<48 * VP>(wb); wa[3][1] = tr_read<52 * VP>(wb);
            asm volatile("s_waitcnt lgkmcnt(0)" ::: "memory"); __builtin_amdgcn_sched_barrier(0);
#pragma unroll
            for (int e = 0; e < 16; ++e) cacc[e] *= decay;
#pragma unroll
            for (int ks = 0; ks < 4; ++ks) { const bf16x8 fa = (bf16x8){ka[ks][0][0], ka[ks][0][1], ka[ks][0][2], ka[ks][0][3], ka[ks][1][0], ka[ks][1][1], ka[ks][1][2], ka[ks][1][3]};
                const bf16x8 fb = (bf16x8){wa[ks][0][0], wa[ks][0][1], wa[ks][0][2], wa[ks][0][3], wa[ks][1][0], wa[ks][1][1], wa[ks][1][2], wa[ks][1][3]};
                cacc = __builtin_amdgcn_mfma_f32_32x32x16_bf16(fa, fb, cacc, 0, 0, 0); } }
        { const int d_ = tid & 127, part_ = tid >> 7; float acc = 0.f;
#pragma unroll
            for (int s = 0; s < 16; ++s) acc += wl[16 * part_ + s] * bf2f(*(const LAS bf16_t*)(lds + OFF_K + (16 * part_ + s) * QP + d_ * 2));
            ((LAS float*)(lds + LDS_CONST))[part_ * 128 + d_] = acc; }
        if (ck < 24) { PREP_WRITE(); if (ck + 1 < 24) PREP_LOAD(ck + 1); }
        __syncthreads();
        if (ck < 24) PREP_STORE(ck);
        { const int tr0 = 16 * tt + 4 * g;
          const f32x4 gam4 = *(const LAS f32x4*)(gam + c0 + tr0), gb4 = *(const LAS f32x4*)(gb + c0 + tr0), rs4 = *(const LAS f32x4*)(rsl + tr0), qn4 = *(const LAS f32x4*)(qnl + tr0);
          bf16_t* hp = hs_out + (size_t)(c0 + tr0) * hs_stride;
#pragma unroll
          for (int r = 0; r < 4; ++r) { const float Mr = fmaxf(mprev, gam4[r]); const float inter = __expf(mprev - Mr), mt = gb4[r] + Mr;
            const float den = rs4[r] + inter * qn4[r]; const float dd = __builtin_amdgcn_rcpf(fmaxf(fabsf(den), __expf(-mt)));
#pragma unroll
            for (int vt = 0; vt < 2; ++vt) { const float hv = (av[vt][r] + inter * qc[vt][r]) * dd; hp[(size_t)r * hs_stride + 16 * vt] = f2bf(hv); } } }
#pragma unroll
        for (int e = 0; e < 16; ++e) { const int d = 32 * dt + (e & 3) + 8 * (e >> 2) + 4 * hi; *(LAS bf16_t*)(lds + OFF_CB + d * VP + (32 * vt2 + r32) * 2) = f2bf(cacc[e]); }
        if (tid < 128) { const LAS float* np_ = (const LAS float*)(lds + LDS_CONST); nreg = decay * nreg + ((np_[tid] + np_[128 + tid]) + (np_[256 + tid] + np_[384 + tid])); nl[tid] = nreg; }
        if (ck + 1 < 32) ML_STORE(ck + 1);
        __syncthreads();
    }
#undef ML_LOAD
#undef ML_STORE
#undef PREP_LOAD
#undef PREP_WRITE
#undef PREP_STORE
}

__device__ __forceinline__ void phase_ml_gate(const Params& p, const Frame& F, unsigned char* a8) {
    const int step = F.G * 8;
#pragma unroll 1
    for (int gw = F.bid * 8 + F.wave; gw < T * 4; gw += 4 * step) { uint2 hv2[4], ov2[4];
#pragma unroll
        for (int k = 0; k < 4; ++k) { const int g_ = gw + k * step; const bf16_t* pr = p.proj + (size_t)(g_ >> 2) * 3072 + (g_ & 3) * 256 + 4 * F.lane; hv2[k] = *(const uint2*)(pr + 1024); ov2[k] = *(const uint2*)(pr + 2048); }
#pragma unroll
        for (int k = 0; k < 4; ++k) { const int g_ = gw + k * step, t = g_ >> 2, h = g_ & 3; const float4 g4 = *(const float4*)(p.ml_ng + h * 256 + 4 * F.lane);
            const float h0 = __uint_as_float(hv2[k].x << 16), h1 = __uint_as_float(hv2[k].x & 0xFFFF0000u), h2 = __uint_as_float(hv2[k].y << 16), h3 = __uint_as_float(hv2[k].y & 0xFFFF0000u);
            float ss = h0 * h0 + h1 * h1 + h2 * h2 + h3 * h3; ss = wave_sum(ss); const float rs = rsqrtf(ss * (1.f / 256.f) + 1e-6f) * F8_SA;
            *(unsigned*)(a8 + (size_t)t * D + h * 256 + 4 * F.lane) = pk4_fp8(__uint_as_float(ov2[k].x << 16) * h0 * rs * g4.x, __uint_as_float(ov2[k].x & 0xFFFF0000u) * h1 * rs * g4.y, __uint_as_float(ov2[k].y << 16) * h2 * rs * g4.z, __uint_as_float(ov2[k].y & 0xFFFF0000u) * h3 * rs * g4.w); } }
}
__device__ __forceinline__ void phase_final(const Params& p, const Frame& F, float* dst) {
    const float* mg = p.mod + (size_t)16 * 6144 + 5 * D;
    for (size_t i4 = (size_t)F.bid * NTHR + F.tid; i4 < (size_t)T * D / 4; i4 += (size_t)F.G * NTHR) { const size_t i = i4 * 4; const int col = (int)(i % D), row = (int)(i / D), b = row / S;
        const uint2 xw = *(const uint2*)(p.xb13 + i); const float4 xv = make_float4(__uint_as_float(xw.x << 16), __uint_as_float(xw.x & 0xFFFF0000u), __uint_as_float(xw.y << 16), __uint_as_float(xw.y & 0xFFFF0000u)); const float4 g = *(const float4*)(mg + b * 6144 + col); const uint2 a0 = *(const uint2*)(p.outk + i), a1 = *(const uint2*)(p.outk + (size_t)T * D + i);
        float4 o; o.x = xv.x + g.x * (__uint_as_float(a0.x << 16) + __uint_as_float(a1.x << 16)); o.y = xv.y + g.y * (__uint_as_float(a0.x & 0xFFFF0000u) + __uint_as_float(a1.x & 0xFFFF0000u));
        o.z = xv.z + g.z * (__uint_as_float(a0.y << 16) + __uint_as_float(a1.y << 16)); o.w = xv.w + g.w * (__uint_as_float(a0.y & 0xFFFF0000u) + __uint_as_float(a1.y & 0xFFFF0000u));
        *(float4*)(dst + i) = o; }
}

__global__ void __launch_bounds__(NTHR, 2) mega_fwd(Params p) {
    extern __shared__ __attribute__((aligned(16))) unsigned char lds_raw[];
    Frame F; F.lds = (LAS unsigned char*)lds_raw; F.tid = threadIdx.x; F.lane = F.tid & 63; F.wave = __builtin_amdgcn_readfirstlane(F.tid >> 6); F.bid = blockIdx.x; F.G = gridDim.x;
    volatile LAS unsigned* misc = (volatile LAS unsigned*)(F.lds + LDS_MISC);
    LAS Params* P = (LAS Params*)(F.lds + LDS_PARAMS);
    if (F.tid < 16) misc[F.tid] = 0u;
    if (F.tid == 64) {
#define X(t, n) P->n = p.n;
        PARAM_LIST(X)
#undef X
    }
    __syncthreads();
    { XcdBarrier b0 = xcd_barrier_post(uni_ptr(P->bar), misc); if (F.tid == 0) misc[2] = b0.x; }
    __syncthreads();
#define GRID_BAR() do { XcdBarrier bb_; bb_.bar = uni_ptr(P->bar); bb_.x = (unsigned)__builtin_amdgcn_readfirstlane((int)misc[2]); bb_.st = misc; xcd_barrier(bb_, F.wave == 0 && lane_id_asm() == 0); } while (0)
    LAS unsigned char* stage = F.lds;
#define MOD0 (q.mod)
#define MOD1 (q.mod + (size_t)16 * 6144)

    { Params q; LP(rope); LP(h); phase_prologue_a(q, launder(F)); }
    { Params q; LP(c); LP(ada_w); LP(ada_b); LP(mod); LP(cmp_pe); LP(cmp_w1); LP(cmp_b1); LP(cb1); phase_prologue_b(q, launder(F)); }
    { Params q; LP(nsa_w_in); LP(win_nsa_t); prep_weights<true>(launder(F), q.win_nsa_t, 2048, D, NSA_COLS, ColPlain{q.nsa_w_in, NSA_COLS, 0}, F.bid, F.G, F8_SW); }
    { Params q; LP(nsa_w_out); LP(wo_nsa_t); prep_weights<true>(launder(F), q.wo_nsa_t, D, D, D, ColPlain{q.nsa_w_out, D, 0}, F.bid, F.G, F8_SW); }
    { Params q; LP(ml_w_in); LP(win_ml_t); prep_weights<true>(launder(F), q.win_ml_t, 3072, D, ML_COLS, ColPlain{q.ml_w_in, 3072, 0}, F.bid, F.G, F8_SW); }
    { Params q; LP(ml_w_out); LP(wo_ml_t); prep_weights<true>(launder(F), q.wo_ml_t, D, D, D, ColPlain{q.ml_w_out, D, 0}, F.bid, F.G, F8_SW); }
    { Params q; LP(cmp_w1); LP(w1c_t); prep_weights(launder(F), q.w1c_t, 256, 2048, 256, ColPlain{q.cmp_w1, 256, 0}, F.bid, F.G);
      prep_weights(launder(F), q.w1c_t + (size_t)256 * 2048, 256, 2048, 256, ColPlain{q.cmp_w1 + (size_t)2048 * 256, 256, 0}, F.bid, F.G); }
    { Params q; LP(w_gate); LP(w_up); LP(w_down); LP(gu_t); LP(dn_t); prep_moe_weights(q, launder(F), 0, F.bid, F.G); }
    GRID_BAR();
    { Params q; LP(x); LP(g_mix); LP(mod); LP(h);
      phase_norm<0, false>(q, launder(F), q.x, nullptr, q.g_mix, MOD0 + 0 * D, MOD0 + 1 * D, nullptr, 0); }
    GRID_BAR();
    { Params q; LP(h); LP(win_nsa_t); LP(q_gain); LP(k_gain); LP(rope); LP(q); LP(kv); LP(gates);
      ge::DenseOrder So; So.init(T, 2048, F.G, F.bid);
      ge::gemm_phase<true>(stage, q.h, q.win_nsa_t, D, So, ge::DenseRows{(unsigned)D}, EpiNsaIn{q.q_gain, q.k_gain, q.rope, q.q, q.kv, q.gates, 1.f / (F8_SA * F8_SW)}, F.wave); }
    GRID_BAR();
    {
      Params q; LP(kv); LP(w1c_t); LP(cpart);
      const int w = F.bid >> 7, mt = (F.bid >> 3) & 15, ks = F.bid & 7; OneUnit So{mt};
      ge::gemm_phase(stage, q.kv + (size_t)w * T * 128 + ks * 256, q.w1c_t + (size_t)w * 256 * 2048 + ks * 256, 256, So, ge::DenseRows{2048u}, EpiCmpPart{q.cpart + (size_t)(w * 8 + ks) * 4096 * 256}, F.wave, 2048); }
    GRID_BAR();
    { Params q; LP(cpart); LP(cb1); LP(cmp_w2); LP(cmp_b2); LP(k_gain); LP(rope); LP(kcmp); LP(vcmp);
      phase_cmp2(q, launder(F)); }
    GRID_BAR();
    { Params q; LP(q); LP(kv); LP(kcmp); LP(vcmp); LP(gates); LP(h); LP(q_gain); LP(k_gain);
      phase_attn(q, launder(F)); }
    GRID_BAR();
    { Params q; LP(h); LP(wo_nsa_t); LP(x); LP(mod); LP(xb13);
      ge::DenseOrder So; So.init(T, D, F.G, F.bid);
      ge::gemm_phase<true>(stage, q.h, q.wo_nsa_t, D, So, ge::DenseRows{(unsigned)D}, EpiResid<false>{q.x, MOD0 + 2 * D, q.xb13, 1.f / (F8_SA * F8_SW)}, F.wave); }
    GRID_BAR();
    { Params q; LP(xb13); LP(g_ffn); LP(mod); LP(h); LP(router_w); LP(router_b); LP(tokw); LP(cnt); LP(list);
      phase_norm_route(q, launder(F), q.xb13, q.g_ffn, MOD0 + 3 * D, MOD0 + 4 * D, 0); }
    GRID_BAR();
    { Params q; LP(cnt); LP(list); LP(h); LP(gu_t); LP(hid);
      LAS int* mtab = (LAS int*)(F.lds + LDS_MISC + 64); LAS int* tkt = (LAS int*)(F.lds + LDS_CONST); moe_plan(launder(F), q.cnt, q.list, mtab, tkt, 4); MoeOrder So{mtab};
      ge::gemm_phase<true>(stage, q.h, q.gu_t, D, So, MoeRows{tkt}, EpiMoe1{(unsigned char*)q.hid, 1.f / (F8_SA * F8_SW)}, F.wave); }
    GRID_BAR();
    { Params q; LP(cnt); LP(list); LP(hid); LP(dn_t); LP(outk); LP(tokw);
      LAS int* mtab = (LAS int*)(F.lds + LDS_MISC + 64); LAS int* tkt = (LAS int*)(F.lds + LDS_CONST); LAS float* tkw = (LAS float*)(F.lds + 131072); moe_plan(launder(F), q.cnt, q.list, mtab, tkt, 4, q.tokw, tkw, 1.f / (F8_SH * F8_SW2)); MoeOrder So{mtab};
      ge::gemm_phase<true>(stage, q.hid, q.dn_t, DE, So, ge::DenseRows{(unsigned)DE}, EpiMoe2{q.outk, tkt, tkw}, F.wave); }
    GRID_BAR();
    { Params q; LP(xb13); LP(xb2); LP(g_mix); LP(mod); LP(h); LP(outk); LP(ml_w_in); LP(ml_bi); LP(ml_bf); LP(li); LP(lf);
      phase_norm<2, true>(q, launder(F), q.xb13, q.xb2, q.g_mix + D, MOD1 + 0 * D, MOD1 + 1 * D, MOD0 + 5 * D, 1); }
    GRID_BAR();
    { Params q; LP(h); LP(win_ml_t); LP(proj);
      ge::DenseOrder So; So.init(T, 3072, F.G, F.bid);
      ge::gemm_phase<true>(stage, q.h, q.win_ml_t, D, So, ge::DenseRows{(unsigned)D}, EpiMlIn{q.proj, 1.f / (F8_SA * F8_SW)}, F.wave); }
    GRID_BAR();
    { Params q; LP(proj); LP(li); LP(lf); LP(w_gate); LP(w_up); LP(w_down); LP(gu_t); LP(dn_t);
      phase_scan(q, launder(F), q.proj + 1024, 3072); }
    GRID_BAR();
    { Params q; LP(proj); LP(ml_ng); LP(h);
      phase_ml_gate(q, launder(F), (unsigned char*)q.h); }
    GRID_BAR();
    { Params q; LP(h); LP(wo_ml_t); LP(xb2); LP(mod); LP(xb13);
      ge::DenseOrder So; So.init(T, D, F.G, F.bid);
      ge::gemm_phase<true>(stage, q.h, q.wo_ml_t, D, So, ge::DenseRows{(unsigned)D}, EpiResid<true>{q.xb2, MOD1 + 2 * D, q.xb13, 1.f / (F8_SA * F8_SW)}, F.wave); }
    GRID_BAR();
    { Params q; LP(xb13); LP(g_ffn); LP(mod); LP(h); LP(router_w); LP(router_b); LP(tokw); LP(cnt); LP(list);
      phase_norm_route(q, launder(F), q.xb13, q.g_ffn + D, MOD1 + 3 * D, MOD1 + 4 * D, 1); }
    GRID_BAR();
    { Params q; LP(cnt); LP(list); LP(h); LP(gu_t); LP(hid);
      LAS int* mtab = (LAS int*)(F.lds + LDS_MISC + 64); LAS int* tkt = (LAS int*)(F.lds + LDS_CONST); moe_plan(launder(F), q.cnt + 64, q.list, mtab, tkt, 4); MoeOrder So{mtab};
      ge::gemm_phase<true>(stage, q.h, q.gu_t, D, So, MoeRows{tkt}, EpiMoe1{(unsigned char*)q.hid, 1.f / (F8_SA * F8_SW)}, F.wave); }
    GRID_BAR();
    { Params q; LP(cnt); LP(list); LP(hid); LP(dn_t); LP(outk); LP(tokw);
      LAS int* mtab = (LAS int*)(F.lds + LDS_MISC + 64); LAS int* tkt = (LAS int*)(F.lds + LDS_CONST); LAS float* tkw = (LAS float*)(F.lds + 131072); moe_plan(launder(F), q.cnt + 64, q.list, mtab, tkt, 4, q.tokw, tkw, 1.f / (F8_SH * F8_SW2)); MoeOrder So{mtab};
      ge::gemm_phase<true>(stage, q.hid, q.dn_t, DE, So, ge::DenseRows{(unsigned)DE}, EpiMoe2{q.outk, tkt, tkw}, F.wave); }
    GRID_BAR();
    { Params q; LP(mod); LP(out); LP(outk); LP(xb13);
      phase_final(q, launder(F), q.out); }
}

static inline size_t al(size_t x) { return (x + 255) & ~(size_t)255; }
extern "C" void kernel_launch(void* const* d_in, const int* in_sizes, int n_in, void* d_out, int out_size, void* d_ws, size_t ws_size, hipStream_t stream) {
    char* ws = (char*)d_ws; size_t off = 0;
    auto take = [&](size_t bytes) { size_t o = off; off = al(off + bytes); return o; };
    Params p{};
    const float** pin = (const float**)&p;
    for (int i = 0; i < 25; ++i) pin[i] = (const float*)d_in[i];
    p.out = (float*)d_out;
    const size_t ctl_bytes = (size_t)XCD_BAR_WORDS * 4 + 1024;
    p.bar = (unsigned*)(ws + take(ctl_bytes)); p.cnt = (int*)(p.bar + XCD_BAR_WORDS); p.dcnt = p.cnt + 128;
    p.mod = (float*)(ws + take((size_t)2 * 16 * 6144 * 4)); p.rope = (float*)(ws + take(2048 * 16 * 4)); p.cb1 = (float*)(ws + take(512 * 4));
    p.tokw = (float*)(ws + take((size_t)T * 2 * 4)); p.list = (int*)(ws + take((size_t)NE * T * 4)); p.dlist = (int*)(ws + take((size_t)NE * T * 4)); p.li = (float*)(ws + take((size_t)T * 4 * 4)); p.lf = (float*)(ws + take((size_t)T * 4 * 4));
    p.h = (bf16_t*)(ws + take((size_t)(T + 8) * D * 2)); p.hidc = (bf16_t*)(ws + take((size_t)2 * 4096 * 256 * 2)); p.xb13 = (bf16_t*)(ws + take((size_t)T * D * 2)); p.xb2 = (bf16_t*)(ws + take((size_t)T * D * 2));
    p.wo_nsa_t = (bf16_t*)(ws + take((size_t)D * D * 2)); p.wo_ml_t = (bf16_t*)(ws + take((size_t)D * D * 2));
    p.win_nsa_t = (bf16_t*)(ws + take((size_t)2048 * D * 2)); p.win_ml_t = (bf16_t*)(ws + take((size_t)3072 * D * 2)); p.w1c_t = (bf16_t*)(ws + take((size_t)2 * 256 * 2048 * 2));
    p.gu_t = (bf16_t*)(ws + take((size_t)NE * 1024 * D * 2)); p.dn_t = (bf16_t*)(ws + take((size_t)NE * D * DE * 2));
    const size_t r1 = off;
    p.q = (bf16_t*)(ws + take((size_t)T * D * 2)); p.kv = (bf16_t*)(ws + take((size_t)6 * T * 128 * 2 + (1 << 20)));
    p.gates = (float*)(ws + take((size_t)T * 48 * 4)); p.kcmp = (bf16_t*)(ws + take((size_t)32 * 128 * 64 * 2)); p.vcmp = (bf16_t*)(ws + take((size_t)32 * 128 * 64 * 2));
    p.cpart = (float*)(ws + take((size_t)2 * 8 * 4096 * 256 * 4));
    const size_t end_nsa = off; off = r1;
    p.proj = (bf16_t*)(ws + take((size_t)T * 3072 * 2)); const size_t end_ml = off; off = r1;
    p.hid = (bf16_t*)(ws + take((size_t)(65536 + 8192) * DE * 2)); p.outk = (bf16_t*)(ws + take((size_t)2 * T * D * 2)); const size_t end_moe = off;
    size_t need = end_nsa > end_ml ? end_nsa : end_ml; if (end_moe > need) need = end_moe;
    if (need > ws_size || n_in != 25) return;
    static bool attr_done = false;
    if (!attr_done) { (void)hipFuncSetAttribute((const void*)mega_fwd, hipFuncAttributeMaxDynamicSharedMemorySize, LDS_BYTES); attr_done = true; }
    (void)hipMemsetAsync(p.bar, 0, ctl_bytes, stream);
    hipLaunchKernelGGL(mega_fwd, dim3(NWG), dim3(NTHR), LDS_BYTES, stream, p);
}
```

```cpp
#include <hip/hip_runtime.h>
#include <stdint.h>

typedef unsigned short bf16_t;
__device__ __forceinline__ float bf2f(bf16_t v) { return __uint_as_float(((unsigned)v) << 16); }
typedef float f32x2_t __attribute__((ext_vector_type(2)));
__device__ __forceinline__ unsigned pk2g(float a, float b) { typedef __bf16 b2 __attribute__((ext_vector_type(2))); b2 r = __builtin_convertvector((f32x2_t){a, b}, b2); return __builtin_bit_cast(unsigned, r); }
__device__ __forceinline__ bf16_t f2bf(float f) { return (bf16_t)pk2g(f, f); }

constexpr int Bn = 16, S = 2048, D = 1024, T = Bn * S;
constexpr int NSA_COLS = 1840, ML_COLS = 3080;
constexpr int NE = 32, DE = 512;
constexpr int NWG = 256, NTHR = 512;

template <int M> __device__ __forceinline__ float sx(float v) { return __int_as_float(__builtin_amdgcn_ds_swizzle(__float_as_int(v), (M << 10) | 0x1F)); }
template <int M> __device__ __forceinline__ unsigned sxu(unsigned v) { return (unsigned)__builtin_amdgcn_ds_swizzle((int)v, (M << 10) | 0x1F); }
__device__ __forceinline__ float sum32(float v) { const auto r = __builtin_amdgcn_permlane32_swap(__float_as_uint(v), __float_as_uint(v), false, false); return __uint_as_float(r[0]) + __uint_as_float(r[1]); }
__device__ __forceinline__ float max32(float v) { const auto r = __builtin_amdgcn_permlane32_swap(__float_as_uint(v), __float_as_uint(v), false, false); return fmaxf(__uint_as_float(r[0]), __uint_as_float(r[1])); }
__device__ __forceinline__ float other32(float v, bool hi) { const auto r = __builtin_amdgcn_permlane32_swap(__float_as_uint(v), __float_as_uint(v), false, false); return __uint_as_float(hi ? r[0] : r[1]); }
template <int CTRL> __device__ __forceinline__ float dppf(float v) { return __int_as_float(__builtin_amdgcn_update_dpp(0, __float_as_int(v), CTRL, 0xF, 0xF, true)); }
__device__ __forceinline__ float sum16(float v) { const auto r = __builtin_amdgcn_permlane16_swap(__float_as_uint(v), __float_as_uint(v), false, false); return __uint_as_float(r[0]) + __uint_as_float(r[1]); }
__device__ __forceinline__ float max16(float v) { const auto r = __builtin_amdgcn_permlane16_swap(__float_as_uint(v), __float_as_uint(v), false, false); return fmaxf(__uint_as_float(r[0]), __uint_as_float(r[1])); }
__device__ __forceinline__ float wave_sum(float v) { v += dppf<0xB1>(v); v += dppf<0x4E>(v); v += dppf<0x141>(v); v += dppf<0x140>(v); v = sum16(v); return sum32(v); }
__device__ __forceinline__ float wave_max(float v) { v = fmaxf(v, dppf<0xB1>(v)); v = fmaxf(v, dppf<0x4E>(v)); v = fmaxf(v, dppf<0x141>(v)); v = fmaxf(v, dppf<0x140>(v)); v = max16(v); return max32(v); }
__device__ __forceinline__ float rdlane(float v, int l) { return __int_as_float(__builtin_amdgcn_readlane(__float_as_int(v), l)); }
__device__ __forceinline__ float sigmoidf_(float x) { return 1.f / (1.f + expf(-x)); }
__device__ __forceinline__ float fsigmoid(float x) { return __builtin_amdgcn_rcpf(1.f + __builtin_amdgcn_exp2f(-1.4426950408889634f * x)); }
__device__ __forceinline__ float ftanh(float x) { return 1.f - 2.f * __builtin_amdgcn_rcpf(1.f + __builtin_amdgcn_exp2f(2.8853900817779268f * x)); }

#define XB_TMO      128
#define XB_XCNT(j)  (256  + 64 * (j))
#define XB_XSUB(j)  (1280 + 64 * (j))
#define XB_XGEN(j)  (2304 + 64 * (j))
#define XB_TOP      3328
#define XB_TOPGEN   3392
#define XCD_BAR_WORDS 3456
#define XB_SPIN_CAP (1u << 18)
#define LAS __attribute__((address_space(3)))
__device__ __forceinline__ unsigned xb_ld(unsigned* p)              { return __hip_atomic_load(p, __ATOMIC_RELAXED, __HIP_MEMORY_SCOPE_AGENT); }
__device__ __forceinline__ unsigned xb_add(unsigned* p, unsigned v) { return __hip_atomic_fetch_add(p, v, __ATOMIC_RELAXED, __HIP_MEMORY_SCOPE_AGENT); }
__device__ __forceinline__ unsigned xb_xcc_id() { return (unsigned)__builtin_amdgcn_s_getreg((3 << 11) | 20) & 0xFu; }
#define XB_SPIN(cond, bar) do { unsigned _sp = 0; while (cond) { __builtin_amdgcn_s_sleep(1); \
    if ((++_sp & 255u) == 0u) { if (xb_ld(&(bar)[XB_TMO])) break; if (_sp > XB_SPIN_CAP) { atomicAdd(&(bar)[XB_TMO], 1u); break; } } } } while (0)
struct XcdBarrier { unsigned* bar; unsigned x; volatile LAS unsigned* st; };
__device__ __forceinline__ XcdBarrier xcd_barrier_post(unsigned* bar, volatile LAS unsigned* st) {
    XcdBarrier b; b.bar = bar; b.x = xb_xcc_id(); b.st = st;
    if (threadIdx.x == 0) (void)xb_add(&bar[XB_XCNT(b.x)], 1u);
    return b;
}
__device__ __forceinline__ void xcd_barrier_complete(unsigned* bar, unsigned x, unsigned& nloc, unsigned& nx) {
    const unsigned G = gridDim.x * gridDim.y * gridDim.z;
    unsigned sum, cnt, mine, sp = 0u;
    for (;;) {
        sum = 0u; cnt = 0u; mine = 0u;
#pragma unroll
        for (unsigned j = 0; j < 16; ++j) { const unsigned c = xb_ld(&bar[XB_XCNT(j)]); sum += c; cnt += (c > 0u) ? 1u : 0u; mine = (j == x) ? c : mine; }
        if (sum == G) break;
        __builtin_amdgcn_s_sleep(1);
        if ((++sp & 255u) == 0u) { if (xb_ld(&bar[XB_TMO])) break; if (sp > XB_SPIN_CAP) { atomicAdd(&bar[XB_TMO], 1u); break; } }
    }
    nloc = mine > 0u ? mine : 1u; nx = cnt > 0u ? cnt : 1u;
}
__device__ __forceinline__ void xcd_barrier(const XcdBarrier& b, const bool leader  ) {
    asm volatile("s_waitcnt vmcnt(0)" ::: "memory");
    __syncthreads();
    if (leader) {
        unsigned* bar = b.bar;
        __builtin_amdgcn_s_waitcnt(0);
        unsigned nloc = b.st[0], nx = b.st[1];
        if (nloc == 0u) { xcd_barrier_complete(bar, b.x, nloc, nx); b.st[0] = nloc; b.st[1] = nx; }
        const unsigned old = xb_add(&bar[XB_XSUB(b.x)], 1u);
        const unsigned gen = old / nloc;
        if (old + 1u == (gen + 1u) * nloc) {
            __builtin_amdgcn_fence(__ATOMIC_RELEASE, "agent");
            asm volatile("s_waitcnt vmcnt(0)" ::: "memory");
            const unsigned og = xb_add(&bar[XB_TOP], 1u);
            const unsigned tg = og / nx;
            if (og + 1u == (tg + 1u) * nx) xb_add(&bar[XB_TOPGEN], 1u);
            else XB_SPIN(xb_ld(&bar[XB_TOPGEN]) == tg, bar);
            __builtin_amdgcn_fence(__ATOMIC_ACQUIRE, "agent");
            xb_add(&bar[XB_XGEN(b.x)], 1u);
            asm volatile("s_waitcnt vmcnt(0)" ::: "memory");
        } else {
            XB_SPIN(xb_ld(&bar[XB_XGEN(b.x)]) == gen, bar);
            __builtin_amdgcn_fence(__ATOMIC_ACQUIRE, "agent");
            asm volatile("s_waitcnt vmcnt(0)" ::: "memory");
        }
    }
    __syncthreads();
}

typedef short bf16x8 __attribute__((ext_vector_type(8)));
typedef float f32x4 __attribute__((ext_vector_type(4)));
namespace ge {
constexpr int BM = 256, BK = 64, HALF = 128, HTB = HALF * BK * 2, STAGE_BYTES = 8 * HTB;
__host__ __device__ __forceinline__ int lds_byte(int r, int c) { const int st = (r >> 4) * 2 + (c >> 5), rr = r & 15, cc = c & 31, ob = rr * 64 + cc * 2; return st * 1024 + (ob ^ (((ob >> 9) & 1) << 5)); }
__host__ __device__ __forceinline__ void stage_rc(int b, int& R, int& C) { const int st = b / 1024, sb = b % 1024, swz = sb ^ (((sb >> 9) & 1) << 5); R = (st >> 1) * 16 + swz / 64; C = (st & 1) * 32 + (swz % 64) / 2; }
struct Unit { int pm, pn, bt, aux; };
__host__ __device__ __forceinline__ int logical_col(int c) { const int pn = c >> 8, bj = (c >> 7) & 1, wc = (c >> 5) & 3, n = (c >> 4) & 1, fq = (c >> 2) & 3, j = c & 3; return (4 * pn + wc) * 64 + 16 * fq + 8 * bj + 4 * n + j; }
struct DenseOrder {
    int nM, nN, nwg, G, c;
    __device__ void init(int M, int N, int G_, int c_) { nM = M / BM; nN = N / BM; nwg = nM * nN; G = G_; c = c_; }
    __device__ bool next(int i, Unit& u) const {
        const long L = (long)i * G + c; if (L >= nwg) return false;
        int wgid = (int)L; { const int q = nwg / 8, r = nwg % 8, xcd = wgid % 8, off = wgid / 8; wgid = (xcd < r ? xcd * (q + 1) : r * (q + 1) + (xcd - r) * q) + off; }
        const int nig = 8 * nN, gid = wgid / nig, fm = gid * 8, gsz = (nM - fm) < 8 ? (nM - fm) : 8;
        u.pm = fm + ((wgid % nig) % gsz); u.pn = (wgid % nig) / gsz; u.bt = u.pn; u.aux = 0; return true;
    }
};
struct DenseRows { static constexpr bool dense = true; unsigned ldab; __device__ __forceinline__ unsigned operator()(const Unit& u, int r) const { return (unsigned)(u.pm * 256 + r) * ldab; } };
template <class Tp> __device__ __forceinline__ Tp* uni(Tp* v) { const unsigned long long u = (unsigned long long)v; const unsigned lo = __builtin_amdgcn_readfirstlane((unsigned)u), hi = __builtin_amdgcn_readfirstlane((unsigned)(u >> 32)); return (Tp*)(((unsigned long long)hi << 32) | lo); }

typedef int i32x8 __attribute__((ext_vector_type(8)));
typedef int i32x4 __attribute__((ext_vector_type(4)));
template <bool F8> struct Frag;
template <> struct Frag<false> { bf16x8 v[2]; };
template <> struct Frag<true> { i32x8 v; };
template <bool F8> __device__ __forceinline__ void load_frag(Frag<F8>& f, const LAS unsigned char* p0) {
    if constexpr (F8) { const i32x4 lo = *(const LAS i32x4*)p0, hi = *(const LAS i32x4*)(p0 + 16); f.v = __builtin_shufflevector(lo, hi, 0, 1, 2, 3, 4, 5, 6, 7); }
    else { f.v[0] = *(const LAS bf16x8*)p0; f.v[1] = *(const LAS bf16x8*)(p0 + 1024); }
}
template <bool F8> __device__ __forceinline__ f32x4 mma_kt(const Frag<F8>& b, const Frag<F8>& a, f32x4 c) {
    if constexpr (F8) return __builtin_amdgcn_mfma_scale_f32_16x16x128_f8f6f4(b.v, a.v, c, 0, 0, 0, 0x7F7F7F7F, 0, 0x7F7F7F7F);
    else { c = __builtin_amdgcn_mfma_f32_16x16x32_bf16(b.v[0], a.v[0], c, 0, 0, 0); return __builtin_amdgcn_mfma_f32_16x16x32_bf16(b.v[1], a.v[1], c, 0, 0, 0); }
}
template <bool F8 = false, class Sched, class RowMap, class Epi>
__device__ __forceinline__ void gemm_phase(LAS unsigned char* lds, const void* A, const void* Bt, const int K, const Sched& S, const RowMap& RM, const Epi& E, const int wave_id, const int ldb_ = 0  ) {
    int tid_; asm volatile("v_mbcnt_lo_u32_b32 %0, -1, 0\n\tv_mbcnt_hi_u32_b32 %0, -1, %0" : "=v"(tid_)); tid_ += wave_id * 64;
    const int tid = tid_, wid = __builtin_amdgcn_readfirstlane(tid >> 6), lane = tid & 63, wr = wid >> 2, wc = wid & 3, fr = lane & 15, fq = lane >> 4;
    const int nt = K / (F8 ? 2 * BK : BK);
    constexpr bool DR = RowMap::dense;
    int sR[2], sC[2];
    const int ldb = ldb_ ? ldb_ : K;
#pragma unroll
    for (int i = 0; i < 2; ++i) stage_rc(tid * 16 + i * 8192, sR[i], sC[i]);
    const unsigned voffB = F8 ? (unsigned)(sR[0] * ldb + sC[0] * 2) : (unsigned)(sR[0] * ldb + sC[0]) * 2u;
    unsigned ldab_ = 0, voffA = 0; if constexpr (DR) { ldab_ = RM.ldab; voffA = (unsigned)sR[0] * ldab_ + (unsigned)sC[0] * 2u; }
    const size_t kstep = (size_t)(BK * 2), hstepB = (size_t)HALF * ldb * (F8 ? 1 : 2), tstepB = 2 * hstepB, qstepB = hstepB / 2;
    const unsigned ldsw = (unsigned)wid * 1024u;
    const int aoff = lds_byte(wr * 64 + fr, fq * (F8 ? 16 : 8)), boff = lds_byte(wc * 32 + fr, fq * (F8 ? 16 : 8));
    const char* Ab = (const char*)A;
#define GE_SA(b, h) (((b) * 2 + (h)) * ge::HTB)
#define GE_SB(b, h) ((4 + (b) * 2 + (h)) * ge::HTB)
#define GE_GLD(sp, vo, ldsoff) do { unsigned _v = (vo); asm volatile("" : "+v"(_v));     \
        __builtin_amdgcn_global_load_lds((const unsigned*)(uni((const char*)(sp)) + _v), (LAS unsigned*)(lds + (ldsoff)), 16, 0, 0); } while (0)
#define GE_STB(bufoff, gbase) do { _Pragma("unroll") for (int _i = 0; _i < 2; ++_i) GE_GLD((gbase) + _i * qstepB, voffB, (bufoff) + ldsw + _i * 8192); } while (0)
#define GE_STA(bufoff, sp, OFF, h) do { _Pragma("unroll") for (int _i = 0; _i < 2; ++_i) { \
        if constexpr (DR) GE_GLD((sp) + (size_t)((h) * 128 + _i * 64) * ldab_, voffA, (bufoff) + ldsw + _i * 8192); \
        else GE_GLD((sp), (OFF)[h][_i], (bufoff) + ldsw + _i * 8192); } } while (0)
#define GE_LDA(dst, b, h) do { _Pragma("unroll") for (int m = 0; m < 4; ++m) load_frag<F8>(dst[m], lds + GE_SA(b, h) + aoff + m * 2048); } while (0)
#define GE_LDB(dst, b, h) do { _Pragma("unroll") for (int n = 0; n < 2; ++n) load_frag<F8>(dst[n], lds + GE_SB(b, h) + boff + n * 2048); } while (0)
#define GE_MMA(ai, bj, At, Bt_) do { __builtin_amdgcn_s_setprio(1); _Pragma("unroll") for (int m = 0; m < 4; ++m) _Pragma("unroll") for (int n = 0; n < 2; ++n) \
        acc[ai][bj][m][n] = mma_kt<F8>(Bt_[n], At[m], acc[ai][bj][m][n]); __builtin_amdgcn_s_setprio(0); } while (0)
#define GE_WAIT_V(n) asm volatile("s_waitcnt vmcnt(" #n ")" ::: "memory")
#define GE_WAIT_L(n) asm volatile("s_waitcnt lgkmcnt(" #n ")" ::: "memory")
#define GE_BAR __builtin_amdgcn_s_barrier()
#define GE_SCHED __builtin_amdgcn_sched_barrier(0)
#define GE_OFFS(OFF, u) do { int _l; asm volatile("v_mbcnt_lo_u32_b32 %0, -1, 0\n\tv_mbcnt_hi_u32_b32 %0, -1, %0" : "=v"(_l)); int _r0, _c0; stage_rc((wave_id * 64 + _l) * 16, _r0, _c0);     \
        _Pragma("unroll") for (int _h = 0; _h < 2; ++_h) _Pragma("unroll") for (int _i = 0; _i < 2; ++_i) (OFF)[_h][_i] = RM((u), _h * 128 + _i * 64 + _r0) + (unsigned)_c0 * 2u; \
        asm volatile("" : "+v"((OFF)[0][0]), "+v"((OFF)[0][1]), "+v"((OFF)[1][0]), "+v"((OFF)[1][1])); } while (0)
    Unit cur, nxt; int ui = 0;
    if (!S.next(0, cur)) return;
    unsigned offC[2][2];
    const char* aC = Ab; const char* aN = Ab;
    if constexpr (DR) aC = Ab + (size_t)cur.pm * 256 * ldab_; else GE_OFFS(offC, cur);
    f32x4 acc[2][2][4][2];
#pragma unroll
    for (int a = 0; a < 2; ++a)
#pragma unroll
        for (int b = 0; b < 2; ++b)
#pragma unroll
            for (int m = 0; m < 4; ++m)
#pragma unroll
                for (int n = 0; n < 2; ++n) acc[a][b][m][n] = (f32x4){0.f, 0.f, 0.f, 0.f};
    Frag<F8> At[4], B0[2], B1[2];
    const char* cB = (const char*)Bt + (size_t)cur.bt * tstepB;
    GE_STB(GE_SB(0, 0), cB); GE_STA(GE_SA(0, 0), aC, offC, 0); GE_STB(GE_SB(0, 1), cB + hstepB); GE_STA(GE_SA(0, 1), aC, offC, 1);
    if (wr == 1) GE_BAR;
    GE_WAIT_V(4); GE_BAR;
    GE_STB(GE_SB(1, 0), cB + kstep); GE_STA(GE_SA(1, 0), aC + kstep, offC, 0); GE_STB(GE_SB(1, 1), cB + hstepB + kstep);
    GE_WAIT_V(6); GE_BAR;
    for (;;) {
        const bool has_next = S.next(ui + 1, nxt);
        if constexpr (DR) aN = has_next ? Ab + (size_t)nxt.pm * 256 * ldab_ : aC;
        const char* nB = has_next ? (const char*)Bt + (size_t)nxt.bt * tstepB : cB;
#pragma unroll 1
        for (int t = 0; t < nt; t += 2) {
            const bool last = (t == nt - 2);
            const size_t k1 = (size_t)(t + 1) * kstep;
            const size_t k2 = last ? 0 : (size_t)(t + 2) * kstep, k3 = k2 + kstep;
            const char* b2 = last ? nB : cB + (size_t)(t + 2) * kstep; const char* b3 = b2 + kstep;
            const char* a2 = last ? aN : aC;
            GE_LDB(B0, 0, 0); GE_SCHED; GE_LDA(At, 0, 0); GE_STA(GE_SA(1, 1), aC + k1, offC, 1);
            GE_WAIT_L(8); GE_BAR; GE_WAIT_L(0); GE_MMA(0, 0, At, B0); GE_BAR; GE_SCHED;
            GE_LDB(B1, 0, 1); GE_STB(GE_SB(0, 0), b2);
            GE_BAR; GE_WAIT_L(0); GE_MMA(0, 1, At, B1); GE_BAR;
            GE_LDA(At, 0, 1);
            if constexpr (!DR) { if (last && has_next) GE_OFFS(offC, nxt); }
            GE_STA(GE_SA(0, 0), a2 + k2, offC, 0);
            GE_BAR; GE_WAIT_L(0); GE_MMA(1, 0, At, B0); GE_BAR; GE_SCHED;
            GE_STB(GE_SB(0, 1), b2 + hstepB);
            GE_WAIT_V(6); GE_BAR; GE_MMA(1, 1, At, B1); GE_BAR;
            GE_LDB(B0, 1, 0); GE_SCHED; GE_LDA(At, 1, 0); GE_STA(GE_SA(0, 1), a2 + k2, offC, 1);
            GE_WAIT_L(8); GE_BAR; GE_WAIT_L(0); GE_MMA(0, 0, At, B0); GE_BAR; GE_SCHED;
            GE_LDB(B1, 1, 1); GE_STB(GE_SB(1, 0), b3);
            GE_BAR; GE_WAIT_L(0); GE_MMA(0, 1, At, B1); GE_BAR;
            GE_LDA(At, 1, 1); GE_STA(GE_SA(1, 0), a2 + k3, offC, 0);
            GE_BAR; GE_WAIT_L(0); GE_MMA(1, 0, At, B0); GE_BAR; GE_SCHED;
            GE_STB(GE_SB(1, 1), b3 + hstepB);
            GE_WAIT_V(6); GE_BAR; GE_MMA(1, 1, At, B1); GE_BAR;
        }
#pragma unroll
        for (int a = 0; a < 2; ++a)
#pragma unroll
            for (int b = 0; b < 2; ++b) asm volatile("" : "+v"(acc[a][b][0][0]), "+v"(acc[a][b][0][1]), "+v"(acc[a][b][1][0]), "+v"(acc[a][b][1][1]), "+v"(acc[a][b][2][0]), "+v"(acc[a][b][2][1]), "+v"(acc[a][b][3][0]), "+v"(acc[a][b][3][1]));
        { int l2; asm volatile("v_mbcnt_lo_u32_b32 %0, -1, 0\n\tv_mbcnt_hi_u32_b32 %0, -1, %0" : "=v"(l2)); E(acc, cur, wr, wc, l2 & 15, l2 >> 4); }
        if (!has_next) break;
#pragma unroll
        for (int a = 0; a < 2; ++a)
#pragma unroll
            for (int b = 0; b < 2; ++b)
#pragma unroll
                for (int m = 0; m < 4; ++m)
#pragma unroll
                    for (int n = 0; n < 2; ++n) acc[a][b][m][n] = (f32x4){0.f, 0.f, 0.f, 0.f};
        cur = nxt; cB = nB; aC = aN; ++ui;
    }
    GE_WAIT_V(0);
    if (wr == 0) GE_BAR;
    GE_BAR;
}
#define GE_VALS(v, acc, ai, m) do { _Pragma("unroll") for (int _b = 0; _b < 2; ++_b) _Pragma("unroll") for (int _n = 0; _n < 2; ++_n) _Pragma("unroll") for (int _j = 0; _j < 4; ++_j) (v)[8 * _b + 4 * _n + _j] = (acc)[ai][_b][m][_n][_j]; } while (0)
}
__device__ __forceinline__ void store16_bf16(bf16_t* dst, const float (&v)[16]) {
    unsigned w[8];
#pragma unroll
    for (int i = 0; i < 8; ++i) w[i] = pk2g(v[2 * i], v[2 * i + 1]);
    uint4* d4 = (uint4*)dst; d4[0] = make_uint4(w[0], w[1], w[2], w[3]); d4[1] = make_uint4(w[4], w[5], w[6], w[7]);
}
template <bool IN_BF16>
struct EpiResid { const void* xin; const float* mod_g; bf16_t* xout; float inscale;
    __device__ __forceinline__ void operator()(const f32x4 (&acc)[2][2][4][2], const ge::Unit& u, int wr, int wc, int fr, int fq) const {
        const int col0 = (4 * u.pn + wc) * 64 + 16 * fq; const int b = (u.pm * 256) / S;
        float4 gq[4];
#pragma unroll
        for (int q4 = 0; q4 < 4; ++q4) { gq[q4] = *(const float4*)(mod_g + b * 6144 + col0 + 4 * q4); gq[q4].x *= inscale; gq[q4].y *= inscale; gq[q4].z *= inscale; gq[q4].w *= inscale; }
        if constexpr (IN_BF16) {
            uint4 xh[2][4][2];
#pragma unroll
            for (int ai = 0; ai < 2; ++ai)
#pragma unroll
                for (int m = 0; m < 4; ++m) { const size_t o = (size_t)(u.pm * 256 + ai * 128 + wr * 64 + m * 16 + fr) * D + col0; xh[ai][m][0] = *(const uint4*)((const bf16_t*)xin + o); xh[ai][m][1] = *(const uint4*)((const bf16_t*)xin + o + 8); }
            const float g16[16] = {gq[0].x, gq[0].y, gq[0].z, gq[0].w, gq[1].x, gq[1].y, gq[1].z, gq[1].w, gq[2].x, gq[2].y, gq[2].z, gq[2].w, gq[3].x, gq[3].y, gq[3].z, gq[3].w};
#pragma unroll
            for (int ai = 0; ai < 2; ++ai)
#pragma unroll
                for (int m = 0; m < 4; ++m) { float v[16]; GE_VALS(v, acc, ai, m);
                    const unsigned w8[8] = {xh[ai][m][0].x, xh[ai][m][0].y, xh[ai][m][0].z, xh[ai][m][0].w, xh[ai][m][1].x, xh[ai][m][1].y, xh[ai][m][1].z, xh[ai][m][1].w};
#pragma unroll
                    for (int k = 0; k < 8; ++k) { v[2 * k] = __uint_as_float(w8[k] << 16) + g16[2 * k] * v[2 * k]; v[2 * k + 1] = __uint_as_float(w8[k] & 0xFFFF0000u) + g16[2 * k + 1] * v[2 * k + 1]; }
                    store16_bf16(xout + (size_t)(u.pm * 256 + ai * 128 + wr * 64 + m * 16 + fr) * D + col0, v); }
        } else {
#pragma unroll
        for (int ai = 0; ai < 2; ++ai) { float4 xv[4][4];
#pragma unroll
            for (int m = 0; m < 4; ++m) { const size_t o = (size_t)(u.pm * 256 + ai * 128 + wr * 64 + m * 16 + fr) * D + col0;
#pragma unroll
                for (int q4 = 0; q4 < 4; ++q4) xv[m][q4] = *(const float4*)((const float*)xin + o + 4 * q4); }
#pragma unroll
            for (int m = 0; m < 4; ++m) { float v[16]; GE_VALS(v, acc, ai, m); float xr[16];
#pragma unroll
                for (int q4 = 0; q4 < 4; ++q4) { xr[4 * q4] = xv[m][q4].x; xr[4 * q4 + 1] = xv[m][q4].y; xr[4 * q4 + 2] = xv[m][q4].z; xr[4 * q4 + 3] = xv[m][q4].w; }
                const float g16[16] = {gq[0].x, gq[0].y, gq[0].z, gq[0].w, gq[1].x, gq[1].y, gq[1].z, gq[1].w, gq[2].x, gq[2].y, gq[2].z, gq[2].w, gq[3].x, gq[3].y, gq[3].z, gq[3].w};
#pragma unroll
                for (int k = 0; k < 16; ++k) v[k] = xr[k] + g16[k] * v[k];
                store16_bf16(xout + (size_t)(u.pm * 256 + ai * 128 + wr * 64 + m * 16 + fr) * D + col0, v); } }
        }
    } };
struct EpiNsaIn { const float* q_gain; const float* k_gain; const float* rope; bf16_t* q; bf16_t* kv; float* gates; float inscale;
    __device__ __forceinline__ void operator()(const f32x4 (&acc)[2][2][4][2], const ge::Unit& u, int wr, int wc, int fr, int fq) const {
        const int slot = 4 * u.pn + wc; if (slot > 28) return;
        const bool normed = (slot < 16) || slot == 20 || slot == 21 || slot == 24 || slot == 25;
        const float* gain = (slot < 16) ? q_gain : ((slot < 22) ? k_gain + 64 : k_gain + 128);
        float gv[16];
        if (normed) {
#pragma unroll
            for (int i = 0; i < 16; ++i) gv[i] = gain[16 * fq + i]; }
#pragma unroll
        for (int ai = 0; ai < 2; ++ai)
#pragma unroll
            for (int m = 0; m < 4; ++m) { const int row = u.pm * 256 + ai * 128 + wr * 64 + m * 16 + fr; const int b = row / S, s = row % S; float v[16]; GE_VALS(v, acc, ai, m);
#pragma unroll
                for (int i = 0; i < 16; ++i) v[i] *= inscale;
                if (slot == 28) { if (fq < 3) { float* gp = gates + (size_t)row * 48 + 16 * fq;
#pragma unroll
                        for (int q4 = 0; q4 < 4; ++q4) *(float4*)(gp + 4 * q4) = make_float4(fsigmoid(v[4 * q4]), fsigmoid(v[4 * q4 + 1]), fsigmoid(v[4 * q4 + 2]), fsigmoid(v[4 * q4 + 3])); }
                    continue; }
                if (normed) { float ss = 0.f;
#pragma unroll
                    for (int i = 0; i < 16; ++i) ss += v[i] * v[i];
                    ss = sum16(ss); ss = sum32(ss); const float r = rsqrtf(ss * (1.f / 64.f) + 1e-6f);
#pragma unroll
                    for (int i = 0; i < 16; ++i) v[i] *= r * gv[i];
                    if (fq == 0) { const float sf = (float)s;
                        constexpr float IFR[8] = {0.15915494309189535f, 0.030863763158420102f, 0.00598518567638293f, 0.001160663620968869f, 0.00022507907904105153f, 4.364795481173399e-05f, 8.464330549652592e-06f, 1.6414262419538367e-06f};
#pragma unroll
                        for (int i = 0; i < 8; ++i) { const float rev = __builtin_amdgcn_fractf(sf * IFR[i]); const float cs = __builtin_amdgcn_cosf(rev), sn = __builtin_amdgcn_sinf(rev), a = v[i], bb = v[i + 8]; v[i] = a * cs - bb * sn; v[i + 8] = bb * cs + a * sn; } } }
                bf16_t* dst;
                if (slot < 16) dst = q + (size_t)row * D + slot * 64 + 16 * fq;
                else { const int kk = slot - 16, ten = kk >> 1, g = kk & 1; dst = kv + (size_t)ten * T * 128 + ((size_t)(b * 2 + g) * S + s) * 64 + 16 * fq; }
                store16_bf16(dst, v); }
    } };
struct EpiMlIn { bf16_t* proj; float inscale;
    __device__ __forceinline__ void operator()(const f32x4 (&acc)[2][2][4][2], const ge::Unit& u, int wr, int wc, int fr, int fq) const {
        const int slot = 4 * u.pn + wc; const int L0 = slot * 64 + 16 * fq;
#pragma unroll
        for (int ai = 0; ai < 2; ++ai)
#pragma unroll
            for (int m = 0; m < 4; ++m) { const int row = u.pm * 256 + ai * 128 + wr * 64 + m * 16 + fr; float v[16]; GE_VALS(v, acc, ai, m);
                { const float sc = (slot >= 8 && slot < 16) ? 0.08838834764831845f * inscale : inscale;
#pragma unroll
                    for (int i = 0; i < 16; ++i) v[i] *= sc; }
                if (slot >= 32) {
#pragma unroll
                    for (int i = 0; i < 16; ++i) v[i] = fsigmoid(v[i]); }
                store16_bf16(proj + (size_t)row * 3072 + L0, v); }
    } };
struct OneUnit { int pm; __device__ bool next(int i, ge::Unit& u) const { if (i) return false; u.pm = pm; u.pn = 0; u.bt = 0; u.aux = 0; return true; } };
struct EpiCmpPart { float* part;
    __device__ __forceinline__ void operator()(const f32x4 (&acc)[2][2][4][2], const ge::Unit& u, int wr, int wc, int fr, int fq) const {
        const int L0 = (4 * u.pn + wc) * 64 + 16 * fq;
#pragma unroll
        for (int ai = 0; ai < 2; ++ai)
#pragma unroll
            for (int m = 0; m < 4; ++m) { const int row = u.pm * 256 + ai * 128 + wr * 64 + m * 16 + fr; float v[16]; GE_VALS(v, acc, ai, m); float* op = part + (size_t)row * 256 + L0;
#pragma unroll
                for (int q4 = 0; q4 < 4; ++q4) *(float4*)(op + 4 * q4) = make_float4(v[4 * q4], v[4 * q4 + 1], v[4 * q4 + 2], v[4 * q4 + 3]); }
    } };
struct EpiCmp1 { const float* cb1; bf16_t* hid;
    __device__ __forceinline__ void operator()(const f32x4 (&acc)[2][2][4][2], const ge::Unit& u, int wr, int wc, int fr, int fq) const {
        const int L0 = (4 * u.pn + wc) * 64 + 16 * fq; float bv[16];
#pragma unroll
        for (int i = 0; i < 16; ++i) bv[i] = cb1[L0 + i];
#pragma unroll
        for (int ai = 0; ai < 2; ++ai)
#pragma unroll
            for (int m = 0; m < 4; ++m) { const int row = u.pm * 256 + ai * 128 + wr * 64 + m * 16 + fr; float v[16]; GE_VALS(v, acc, ai, m);
#pragma unroll
                for (int i = 0; i < 16; ++i) { const float x = v[i] + bv[i]; v[i] = 0.5f * x * (1.f + ftanh(0.7978845608028654f * (x + 0.044715f * x * x * x))); }
                store16_bf16(hid + (size_t)row * 256 + L0, v); }
    } };

#define PARAM_LIST(X) \
    X(const float*, x) X(const float*, c) X(const float*, ada_w) X(const float*, ada_b) X(const float*, g_mix) X(const float*, g_ffn) X(const float*, nsa_w_in) X(const float*, nsa_w_out) \
    X(const float*, q_gain) X(const float*, k_gain) X(const float*, cmp_pe) X(const float*, cmp_w1) X(const float*, cmp_b1) X(const float*, cmp_w2) X(const float*, cmp_b2) \
    X(const float*, ml_w_in) X(const float*, ml_bi) X(const float*, ml_bf) X(const float*, ml_ng) X(const float*, ml_w_out) X(const float*, router_w) X(const float*, router_b) \
    X(const float*, w_gate) X(const float*, w_up) X(const float*, w_down) \
    X(float*, out) X(unsigned*, bar) X(int*, cnt) X(float*, mod) X(float*, rope) X(float*, cb1) X(float*, tokw) X(int*, list) X(float*, li) X(float*, lf) \
    X(bf16_t*, h) X(bf16_t*, hidc) X(bf16_t*, xb13) X(bf16_t*, xb2) X(bf16_t*, wo_nsa_t) X(bf16_t*, wo_ml_t) X(bf16_t*, win_nsa_t) X(bf16_t*, win_ml_t) X(bf16_t*, w1c_t) X(bf16_t*, gu_t) X(bf16_t*, dn_t) \
    X(bf16_t*, q) X(bf16_t*, kv) X(float*, gates) X(bf16_t*, kcmp) X(bf16_t*, vcmp) X(bf16_t*, proj) X(bf16_t*, hid) X(bf16_t*, outk) X(int*, dcnt) X(int*, dlist) X(float*, cpart)
struct Params {
#define X(t, n) t n;
    PARAM_LIST(X)
#undef X
};
template <class Tp> __device__ __forceinline__ Tp* uni_ptr(Tp* v) { const unsigned long long u = (unsigned long long)v; const unsigned lo = __builtin_amdgcn_readfirstlane((unsigned)u), hi = __builtin_amdgcn_readfirstlane((unsigned)(u >> 32)); typedef Tp __attribute__((address_space(1))) * GP; return (Tp*)(GP)(((unsigned long long)hi << 32) | lo); }
#define LP(n) q.n = uni_ptr(P->n)
struct Frame { LAS unsigned char* lds; int tid, lane, wave, bid, G; };
__device__ __forceinline__ int lane_id_asm() { int l; asm volatile("v_mbcnt_lo_u32_b32 %0, -1, 0\n\tv_mbcnt_hi_u32_b32 %0, -1, %0" : "=v"(l)); return l; }
__device__ __forceinline__ Frame launder(const Frame& F) { Frame R = F; const int l = lane_id_asm(); int wv = F.wave, bd = F.bid; asm volatile("" : "+s"(wv), "+s"(bd)); R.wave = wv; R.bid = bd; R.tid = wv * 64 + l; R.lane = l; return R; }
constexpr int LDS_GEN = 143872;
constexpr int LDS_MISC = LDS_GEN;
constexpr int LDS_PARAMS = LDS_GEN + 4096;
constexpr int LDS_CONST = LDS_GEN + 6144;
constexpr int LDS_BYTES = LDS_GEN + 18432;

__device__ __forceinline__ unsigned pk4_fp8(float a, float b, float c, float d) { int w = 0;
    w = __builtin_amdgcn_cvt_pk_fp8_f32(__builtin_amdgcn_fmed3f(a, -448.f, 448.f), __builtin_amdgcn_fmed3f(b, -448.f, 448.f), w, false);
    w = __builtin_amdgcn_cvt_pk_fp8_f32(__builtin_amdgcn_fmed3f(c, -448.f, 448.f), __builtin_amdgcn_fmed3f(d, -448.f, 448.f), w, true); return (unsigned)w; }
constexpr float F8_SA = 8.f, F8_SW = 32.f, F8_SH = 4.f, F8_SW2 = 32.f, F8_SO = 16.f;
__device__ __forceinline__ float fp8f(unsigned w, int i) { return i == 0 ? __builtin_amdgcn_cvt_f32_fp8((int)w, 0) : i == 1 ? __builtin_amdgcn_cvt_f32_fp8((int)w, 1) : i == 2 ? __builtin_amdgcn_cvt_f32_fp8((int)w, 2) : __builtin_amdgcn_cvt_f32_fp8((int)w, 3); }
template <int NB>
__device__ __forceinline__ void colgemv(const Frame& F, const LAS float* vec, LAS float* part, const float* W, int ldw, int K, int n0, const float* bias, float* out, int out_stride) {
    const int kper = K / 8, kb = F.wave * kper, c4 = F.lane & 15, kq = F.lane >> 4; float acc[NB][4];
#pragma unroll
    for (int b = 0; b < NB; ++b)
#pragma unroll
        for (int j = 0; j < 4; ++j) acc[b][j] = 0.f;
    const float* wp = W + (size_t)(kb + kq) * ldw + n0 + 4 * c4;
#pragma unroll 4
    for (int k = 0; k < kper; k += 4) { const float4 wv = *(const float4*)(wp + (size_t)k * ldw);
#pragma unroll
        for (int b = 0; b < NB; ++b) { const float x = vec[(kb + k + kq) * NB + b]; acc[b][0] += x * wv.x; acc[b][1] += x * wv.y; acc[b][2] += x * wv.z; acc[b][3] += x * wv.w; } }
#pragma unroll
    for (int b = 0; b < NB; ++b)
#pragma unroll
        for (int j = 0; j < 4; ++j) { const float t = sum32(sum16(acc[b][j])); if (kq == 0) part[(F.wave * NB + b) * 64 + 4 * c4 + j] = t; }
    __syncthreads();
    for (int idx = F.tid; idx < NB * 64; idx += NTHR) { const int b = idx >> 6, l = idx & 63; float s = bias[n0 + l];
#pragma unroll
        for (int w = 0; w < 8; ++w) s += part[(w * NB + b) * 64 + l];
        out[(size_t)b * out_stride + n0 + l] = s; }
    __syncthreads();
}
struct ColPlain { const float* W; int ncols; int pad; __device__ const float* operator()(int c) const { const int L = ge::logical_col(c); return L < ncols ? W + L : nullptr; } };
struct ColGateUp { const float* wg; const float* wu; __device__ const float* operator()(int c) const { const int e = c >> 10, cc = c & 1023; const int pn = cc >> 8, bj = (cc >> 7) & 1, wc = (cc >> 5) & 3, n = (cc >> 4) & 1, fq = (cc >> 2) & 3, j = cc & 3;
        const int hidx = 32 * (4 * pn + wc) + 8 * fq + 4 * n + j; const unsigned long long a = (unsigned long long)wg, d = (unsigned long long)wu - a;
        return (const float*)(a + (bj ? d : 0ull)) + (size_t)e * D * DE + hidx; } };
struct ColDown { const float* wd; __device__ const float* operator()(int c) const { const int e = c >> 10; return wd + (size_t)e * DE * D + ge::logical_col(c & 1023); } };
template <bool F8 = false, class ColF>
__device__ __forceinline__ void prep_weights(const Frame& F, void* Bt_, int N, int K, int ldw, const ColF cf, int start, int stride, const float wscale = 1.f) {
    bf16_t* Bt = (bf16_t*)Bt_;
    LAS float* tile = (LAS float*)(F.lds) + (F.tid >> 8) * (128 * 65);
    const int ntx = N / 64, ntiles = ntx * (K / 128), htid = F.tid & 255, half = F.tid >> 8;
    float r[32];
#define PW_LOAD(it_) do { const int tl_ = (it_) * 2 + half; if (tl_ < ntiles) { const int c0_ = (tl_ % ntx) * 64, k0_ = (tl_ / ntx) * 128; const float* p_ = cf(c0_ + (htid & 63)); \
        if (p_) { p_ += (size_t)(k0_ + (htid >> 6)) * ldw; _Pragma("unroll") for (int i_ = 0; i_ < 32; ++i_) r[i_] = p_[(size_t)(4 * i_) * ldw]; } \
        else { _Pragma("unroll") for (int i_ = 0; i_ < 32; ++i_) r[i_] = 0.f; } } } while (0)
    int it = start;
    if (it * 2 < ntiles) PW_LOAD(it);
    for (; it * 2 < ntiles; it += stride) {
        const int tl = it * 2 + half; const bool act = tl < ntiles; const int c0 = (tl % ntx) * 64, k0 = (tl / ntx) * 128;
        if (act) { const int cc = htid & 63;
#pragma unroll
            for (int i = 0; i < 32; ++i) tile[((htid >> 6) + 4 * i) * 65 + cc] = r[i]; }
        __syncthreads();
        if ((it + stride) * 2 < ntiles) PW_LOAD(it + stride);
        if (act) { const int cc = htid >> 2, ch = (htid & 3) * 32;
            if (F8) { unsigned w[8];
#pragma unroll
                for (int i = 0; i < 8; ++i) w[i] = pk4_fp8(tile[(ch + 4 * i) * 65 + cc] * wscale, tile[(ch + 4 * i + 1) * 65 + cc] * wscale, tile[(ch + 4 * i + 2) * 65 + cc] * wscale, tile[(ch + 4 * i + 3) * 65 + cc] * wscale);
                uint4* dst = (uint4*)((unsigned char*)Bt_ + (size_t)(c0 + cc) * K + k0 + ch); dst[0] = make_uint4(w[0], w[1], w[2], w[3]); dst[1] = make_uint4(w[4], w[5], w[6], w[7]); }
            else { unsigned w[16];
#pragma unroll
                for (int i = 0; i < 16; ++i) w[i] = pk2g(tile[(ch + 2 * i) * 65 + cc], tile[(ch + 2 * i + 1) * 65 + cc]);
                uint4* dst = (uint4*)(Bt + (size_t)(c0 + cc) * K + k0 + ch);
#pragma unroll
                for (int q4 = 0; q4 < 4; ++q4) dst[q4] = make_uint4(w[4 * q4], w[4 * q4 + 1], w[4 * q4 + 2], w[4 * q4 + 3]); } }
        __syncthreads();
    }
#undef PW_LOAD
}
__device__ __forceinline__ void prep_moe_weights(const Params& p, const Frame& F, int layer, int start, int stride) {
    const size_t wo = (size_t)layer * NE * D * DE;
    prep_weights<true>(F, p.gu_t, NE * 1024, D, DE, ColGateUp{p.w_gate + wo, p.w_up + wo}, start, stride, F8_SW);
    prep_weights<true>(F, p.dn_t, NE * 1024, DE, D, ColDown{p.w_down + wo}, start, stride, F8_SW2);
}

__device__ __forceinline__ void phase_prologue_a(const Params& p, const Frame& F) {
    for (int i = (F.bid - 200) * NTHR + F.tid; F.bid >= 200 && i < 2048 * 8; i += (F.G - 200) * NTHR) { const int pos = i >> 3, j = i & 7; const float inv = (float)pow(500000.0, -(double)j / 8.0); const float ang = (float)pos * inv;
        p.rope[pos * 16 + j] = (float)cos((double)ang); p.rope[pos * 16 + 8 + j] = (float)sin((double)ang); }
    if (F.bid == F.G - 1) for (int i = F.tid; i < 8 * D / 2; i += NTHR) ((unsigned*)(p.h + (size_t)T * D))[i] = 0u;
}
__device__ __forceinline__ void phase_prologue_b(const Params& p, const Frame& F) {
    LAS float* vec = (LAS float*)F.lds; LAS float* part = (LAS float*)(F.lds + 65536 + 16384);
    if (F.bid < 192) {
        for (int idx = F.tid; idx < 16 * D; idx += NTHR) { const int b = idx >> 10, k = idx & 1023; const float cv = p.c[idx]; vec[k * 16 + b] = cv / (1.f + expf(-cv)); }
        __syncthreads();
        const int i = F.bid / 96, n0 = (F.bid % 96) * 64;
        colgemv<16>(F, vec, part, p.ada_w + (size_t)i * D * 6144, 6144, D, n0, p.ada_b + i * 6144, p.mod + (size_t)i * 16 * 6144, 6144);
    } else if (F.bid < 200) {
        const int it = F.bid - 192, w = it >> 2, n0 = (it & 3) * 64;
        for (int idx = F.tid; idx < 2048; idx += NTHR) vec[idx] = p.cmp_pe[w * 2048 + idx];
        __syncthreads();
        colgemv<1>(F, vec, part, p.cmp_w1 + (size_t)w * 2048 * 256, 256, 2048, n0, p.cmp_b1 + w * 256, p.cb1 + w * 256, 0);
    }
    __syncthreads();
}

template <int MODE, bool XBF>
__device__ __forceinline__ void phase_norm(const Params& p, const Frame& F, const void* xin_, bf16_t* xout, const float* gain, const float* mod_sh, const float* mod_sc, const float* mod_gprev, int layer) {
    constexpr int rows_per_wg = T / NWG, rpw = rows_per_wg / 8;
    constexpr int TP = (MODE == 1) ? 34 : 10;
    const int row0 = F.bid * rows_per_wg;
    LAS float* rw = (LAS float*)F.lds;
    LAS int* lcnt = (LAS int*)(F.lds + LDS_MISC + 64); LAS int* gbase = lcnt + 32; LAS int* ent = gbase + 32;
    if (MODE == 1) { for (int idx = F.tid; idx < D * NE; idx += NTHR) { const int c = idx >> 5; rw[((c & 3) * 256 + (c >> 2)) * TP + (idx & 31)] = p.router_w[idx]; } if (F.tid < 32) lcnt[F.tid] = 0; }
    if (MODE == 2) { for (int idx = F.tid; idx < D * 8; idx += NTHR) { const int c = idx >> 3; rw[((c & 3) * 256 + (c >> 2)) * TP + (idx & 7)] = p.ml_w_in[(size_t)c * ML_COLS + 3072 + (idx & 7)]; } }
    const int b = row0 / S;
    LAS float* cg = (LAS float*)(F.lds + LDS_CONST); LAS float* csh = cg + D; LAS float* cgp = csh + D;
    for (int col = F.tid; col < D; col += NTHR) { cg[col] = gain[col] * (1.f + mod_sc[b * 6144 + col]); csh[col] = mod_sh[b * 6144 + col]; if (MODE == 2) cgp[col] = mod_gprev[b * 6144 + col] * (1.f / F8_SO); }
    __syncthreads();
    const int rbase = row0 + F.wave * rpw;
    float4 xn[4]; unsigned on0[4], on1[4];
#define NORM_LOAD(r_) do { if (XBF) { const bf16_t* xr_ = (const bf16_t*)xin_ + (size_t)(r_) * D + 4 * F.lane; _Pragma("unroll") for (int j_ = 0; j_ < 4; ++j_) { const uint2 t_ = *(const uint2*)(xr_ + 256 * j_); \
            xn[j_] = make_float4(__uint_as_float(t_.x << 16), __uint_as_float(t_.x & 0xFFFF0000u), __uint_as_float(t_.y << 16), __uint_as_float(t_.y & 0xFFFF0000u)); } } \
        else { const float* xr_ = (const float*)xin_ + (size_t)(r_) * D + 4 * F.lane; _Pragma("unroll") for (int j_ = 0; j_ < 4; ++j_) xn[j_] = *(const float4*)(xr_ + 256 * j_); } \
        if (MODE == 2) { const unsigned char* o0_ = (const unsigned char*)p.outk + (size_t)(r_) * D + 4 * F.lane; _Pragma("unroll") for (int j_ = 0; j_ < 4; ++j_) { on0[j_] = *(const unsigned*)(o0_ + 256 * j_); on1[j_] = *(const unsigned*)(o0_ + (size_t)T * D + 256 * j_); } } } while (0)
    NORM_LOAD(rbase);
#pragma unroll 1
    for (int ri = 0; ri < rpw; ++ri) {
        const int row = rbase + ri; float v[16];
#pragma unroll
        for (int j = 0; j < 4; ++j) { v[4 * j] = xn[j].x; v[4 * j + 1] = xn[j].y; v[4 * j + 2] = xn[j].z; v[4 * j + 3] = xn[j].w; }
        if (MODE == 2) {
#pragma unroll
            for (int j = 0; j < 4; ++j) { const f32x4 gq = *(const LAS f32x4*)(cgp + 4 * F.lane + 256 * j);
                v[4 * j] += gq[0] * (fp8f(on0[j], 0) + fp8f(on1[j], 0)); v[4 * j + 1] += gq[1] * (fp8f(on0[j], 1) + fp8f(on1[j], 1));
                v[4 * j + 2] += gq[2] * (fp8f(on0[j], 2) + fp8f(on1[j], 2)); v[4 * j + 3] += gq[3] * (fp8f(on0[j], 3) + fp8f(on1[j], 3));
                uint2 xo_; xo_.x = pk2g(v[4 * j], v[4 * j + 1]); xo_.y = pk2g(v[4 * j + 2], v[4 * j + 3]); *(uint2*)(xout + (size_t)row * D + 4 * F.lane + 256 * j) = xo_; } }
        if (ri + 1 < rpw) NORM_LOAD(row + 1);
        float ss = 0.f;
#pragma unroll
        for (int i = 0; i < 16; ++i) ss += v[i] * v[i];
        ss = wave_sum(ss); const float r = rsqrtf(ss * (1.f / D) + 1e-6f);
#pragma unroll
        for (int j = 0; j < 4; ++j) { const f32x4 g4 = *(const LAS f32x4*)(cg + 4 * F.lane + 256 * j), s4 = *(const LAS f32x4*)(csh + 4 * F.lane + 256 * j);
#pragma unroll
            for (int e = 0; e < 4; ++e) v[4 * j + e] = v[4 * j + e] * r * g4[e] + s4[e];
            if (MODE == 2 || MODE == 0) *(unsigned*)((unsigned char*)p.h + (size_t)row * D + 4 * F.lane + 256 * j) = pk4_fp8(v[4 * j] * F8_SA, v[4 * j + 1] * F8_SA, v[4 * j + 2] * F8_SA, v[4 * j + 3] * F8_SA);
            else { uint2 pk; pk.x = pk2g(v[4 * j], v[4 * j + 1]); pk.y = pk2g(v[4 * j + 2], v[4 * j + 3]); *(uint2*)(p.h + (size_t)row * D + 4 * F.lane + 256 * j) = pk; } }
        if (MODE == 2) { float a8[8];
#pragma unroll
            for (int j = 0; j < 8; ++j) a8[j] = 0.f;
#pragma unroll
            for (int j = 0; j < 4; ++j)
#pragma unroll
                for (int e = 0; e < 4; ++e) { const LAS float* wr_ = rw + (e * 256 + 64 * j + F.lane) * TP; const float hv = v[4 * j + e];
#pragma unroll
                    for (int q2 = 0; q2 < 4; ++q2) { const f32x2_t w2 = *(const LAS f32x2_t*)(wr_ + 2 * q2); a8[2 * q2] += hv * w2[0]; a8[2 * q2 + 1] += hv * w2[1]; } }
#pragma unroll
            for (int j = 0; j < 8; ++j) a8[j] = wave_sum(a8[j]);
            if (F.lane < 8) { float a = 0.f;
#pragma unroll
                for (int j = 0; j < 8; ++j) a = (F.lane == j) ? a8[j] : a;
                if (F.lane < 4) { a += p.ml_bi[F.lane]; p.li[row * 4 + F.lane] = 15.f * tanhf(a / 15.f); }
                else { a += p.ml_bf[F.lane - 4]; const float cc = 15.f * tanhf(a / 15.f); p.lf[row * 4 + F.lane - 4] = (cc >= 0.f) ? -log1pf(expf(-cc)) : (cc - log1pf(expf(cc))); } } }
        if (MODE == 1) { float acc[32];
#pragma unroll
            for (int e = 0; e < 32; ++e) acc[e] = 0.f;
#pragma unroll
            for (int j = 0; j < 4; ++j)
#pragma unroll
                for (int e = 0; e < 4; ++e) { const LAS float* wr_ = rw + (e * 256 + 64 * j + F.lane) * TP; const float hv = v[4 * j + e]; asm volatile("" ::: "memory");
#pragma unroll
                    for (int q2 = 0; q2 < 16; ++q2) { const f32x2_t w2 = *(const LAS f32x2_t*)(wr_ + 2 * q2); acc[2 * q2] += hv * w2[0]; acc[2 * q2 + 1] += hv * w2[1]; } }
            float r16[16], r8[8], r4[4], r2[2], r1;
            { const bool hi = (F.lane & 32) != 0;
#pragma unroll
              for (int i = 0; i < 16; ++i) { const float keep = hi ? acc[16 + i] : acc[i], send = hi ? acc[i] : acc[16 + i]; r16[i] = keep + other32(send, hi); } }
            { const bool hi = (F.lane & 16) != 0;
#pragma unroll
              for (int i = 0; i < 8; ++i) { const float keep = hi ? r16[8 + i] : r16[i], send = hi ? r16[i] : r16[8 + i]; r8[i] = keep + sx<16>(send); } }
            { const bool hi = (F.lane & 8) != 0;
#pragma unroll
              for (int i = 0; i < 4; ++i) { const float keep = hi ? r8[4 + i] : r8[i], send = hi ? r8[i] : r8[4 + i]; r4[i] = keep + sx<8>(send); } }
            { const bool hi = (F.lane & 4) != 0;
#pragma unroll
              for (int i = 0; i < 2; ++i) { const float keep = hi ? r4[2 + i] : r4[i], send = hi ? r4[i] : r4[2 + i]; r2[i] = keep + sx<4>(send); } }
            { const bool hi = (F.lane & 2) != 0; const float keep = hi ? r2[1] : r2[0], send = hi ? r2[0] : r2[1]; r1 = keep + sx<2>(send); }
            r1 += sx<1>(r1);
            const float aff = sigmoidf_(r1); const float ch = aff + p.router_b[F.lane >> 1];
            float bestgs = -3e38f; int be0 = 0, be1 = 0; float ba0 = 0.f, ba1 = 0.f;
#pragma unroll
            for (int g = 0; g < 4; ++g) { float v1 = -3e38f, v2 = -3e38f, a1 = 0.f, a2 = 0.f; int i1 = 0, i2 = 0;
#pragma unroll
                for (int i = 0; i < 8; ++i) { const float a = rdlane(aff, 2 * (g * 8 + i)), c_ = rdlane(ch, 2 * (g * 8 + i));
                    if (c_ > v1) { v2 = v1; a2 = a1; i2 = i1; v1 = c_; a1 = a; i1 = i; } else if (c_ > v2) { v2 = c_; a2 = a; i2 = i; } }
                const float gs = v1 + v2; if (gs > bestgs) { bestgs = gs; be0 = g * 8 + i1; be1 = g * 8 + i2; ba0 = a1; ba1 = a2; } }
            if (F.lane == 0) { const float sum = ba0 + ba1; p.tokw[row * 2] = ba0 / sum; p.tokw[row * 2 + 1] = ba1 / sum;
                const int lr = row - row0; const int r0_ = atomicAdd((int*)&lcnt[be0], 1); const int r1_ = atomicAdd((int*)&lcnt[be1], 1);
                ent[lr * 4 + 0] = be0 | (r0_ << 8); ent[lr * 4 + 1] = row * 2; ent[lr * 4 + 2] = be1 | (r1_ << 8); ent[lr * 4 + 3] = row * 2 + 1; } }
    }
#undef NORM_LOAD
    if (MODE == 1) { __syncthreads();
        if (F.tid < 32) gbase[F.tid] = atomicAdd(&p.cnt[layer * 64 + F.tid], lcnt[F.tid]);
        __syncthreads();
        for (int idx = F.tid; idx < rows_per_wg * 2; idx += NTHR) { const int er = ent[idx * 2], tk = ent[idx * 2 + 1]; const int e = er & 255, rk = er >> 8; p.list[(size_t)e * T + gbase[e] + rk] = tk; }
        __syncthreads(); }
}

__device__ __forceinline__ void phase_norm_route(const Params& p, const Frame& F, const bf16_t* xin, const float* gain, const float* mod_sh, const float* mod_sc, int layer) {
    constexpr int rows_per_wg = T / NWG;
    const int row0 = F.bid * rows_per_wg, b = row0 / S, lane = F.lane, i16 = lane & 15, g = lane >> 4;
    constexpr int RTP = 2064;
    LAS unsigned char* thi = F.lds; LAS unsigned char* tlo = F.lds + 32 * RTP;
    LAS float* cg = (LAS float*)(F.lds + LDS_CONST); LAS float* csh = cg + D; LAS float* bias = csh + D; LAS float* bpart = bias + 32;
    LAS int* lcnt = (LAS int*)(F.lds + LDS_MISC + 64); LAS int* gbase = lcnt + 32; LAS int* ent = gbase + 32;
    for (int col = F.tid; col < D; col += NTHR) { cg[col] = gain[col] * (1.f + mod_sc[b * 6144 + col]); csh[col] = mod_sh[b * 6144 + col]; }
    if (F.tid < 32) lcnt[F.tid] = 0;
    __syncthreads();
    { const int e = F.tid & 31, part = F.tid >> 5; float a = 0.f;
#pragma unroll 8
      for (int k = part * 64; k < part * 64 + 64; k += 2) { const float w0 = p.router_w[k * 32 + e], w1 = p.router_w[(k + 1) * 32 + e];
          a += csh[k] * w0 + csh[k + 1] * w1;
          const float s0 = w0 * cg[k] * 256.f, s1 = w1 * cg[k + 1] * 256.f; const _Float16 h0 = (_Float16)s0, h1 = (_Float16)s1; const _Float16 l0 = (_Float16)(s0 - (float)h0), l1 = (_Float16)(s1 - (float)h1);
          *(LAS unsigned*)(thi + e * RTP + k * 2) = (unsigned)__builtin_bit_cast(unsigned short, h0) | ((unsigned)__builtin_bit_cast(unsigned short, h1) << 16);
          *(LAS unsigned*)(tlo + e * RTP + k * 2) = (unsigned)__builtin_bit_cast(unsigned short, l0) | ((unsigned)__builtin_bit_cast(unsigned short, l1) << 16); }
      bpart[part * 32 + e] = a; }
    __syncthreads();
    if (F.tid < 32) { float a = 0.f;
#pragma unroll
        for (int q = 0; q < 16; ++q) a += bpart[q * 32 + F.tid];
        bias[F.tid] = a; }
    const int rbase = row0 + F.wave * 16;
    const bf16_t* xr = xin + (size_t)(rbase + i16) * D + 8 * g;
    typedef _Float16 f16x8 __attribute__((ext_vector_type(8))); typedef unsigned u32x4r __attribute__((ext_vector_type(4)));
    const LAS unsigned char* bh0 = thi + i16 * RTP + 16 * g; const LAS unsigned char* bh1 = bh0 + 16 * RTP; const LAS unsigned char* bl0 = tlo + i16 * RTP + 16 * g; const LAS unsigned char* bl1 = bl0 + 16 * RTP;
    f32x4 acc0 = (f32x4){0.f, 0.f, 0.f, 0.f}, acc1 = (f32x4){0.f, 0.f, 0.f, 0.f}; float ss = 0.f;
    uint4 xa[2][8];
#define RT_LOAD(s_, q_) do { _Pragma("unroll") for (int u_ = 0; u_ < 8; ++u_) xa[s_][u_] = *(const uint4*)(xr + 32 * (8 * (q_) + u_)); } while (0)
    RT_LOAD(0, 0);
#pragma unroll
    for (int qd = 0; qd < 4; ++qd) {
        if (qd + 1 < 4) RT_LOAD((qd + 1) & 1, qd + 1);
#pragma unroll
        for (int u = 0; u < 8; ++u) { const int so = (8 * qd + u) * 64;
            const uint4 xc = xa[qd & 1][u]; const unsigned xw[4] = {xc.x, xc.y, xc.z, xc.w}; u32x4r ap;
#pragma unroll
            for (int i = 0; i < 4; ++i) { const float f0 = __uint_as_float(xw[i] << 16), f1 = __uint_as_float(xw[i] & 0xFFFF0000u); ss += f0 * f0 + f1 * f1; ap[i] = __builtin_bit_cast(unsigned, __builtin_amdgcn_cvt_pkrtz(f0, f1)); }
            const f16x8 a8 = __builtin_bit_cast(f16x8, ap);
            const f16x8 b0h = *(const LAS f16x8*)(bh0 + so), b0l = *(const LAS f16x8*)(bl0 + so), b1h = *(const LAS f16x8*)(bh1 + so), b1l = *(const LAS f16x8*)(bl1 + so);
            acc0 = __builtin_amdgcn_mfma_f32_16x16x32_f16(a8, b0h, acc0, 0, 0, 0); acc1 = __builtin_amdgcn_mfma_f32_16x16x32_f16(a8, b1h, acc1, 0, 0, 0);
            acc0 = __builtin_amdgcn_mfma_f32_16x16x32_f16(a8, b0l, acc0, 0, 0, 0); acc1 = __builtin_amdgcn_mfma_f32_16x16x32_f16(a8, b1l, acc1, 0, 0, 0); }
    }
#undef RT_LOAD
    ss = sum16(ss); ss = sum32(ss); const float r = rsqrtf(ss * (1.f / D) + 1e-6f);
    float af0[4], af1[4];
#pragma unroll
    for (int rr = 0; rr < 4; ++rr) { const float rrow = __int_as_float(__builtin_amdgcn_ds_bpermute((4 * g + rr) * 4, __float_as_int(r)));
        af0[rr] = sigmoidf_(rrow * (1.f / 256.f) * acc0[rr] + bias[i16]); af1[rr] = sigmoidf_(rrow * (1.f / 256.f) * acc1[rr] + bias[16 + i16]); }
    __syncthreads();
    LAS float* affl = (LAS float*)F.lds + F.wave * 512;
#pragma unroll
    for (int rr = 0; rr < 4; ++rr) { affl[(4 * g + rr) * 32 + i16] = af0[rr]; affl[(4 * g + rr) * 32 + 16 + i16] = af1[rr]; }
    asm volatile("s_waitcnt lgkmcnt(0)" ::: "memory");
    if (lane < 16) { const int row = rbase + lane; const LAS float* ar = affl + lane * 32;
        float bestgs = -3e38f; int be0 = 0, be1 = 0; float ba0 = 0.f, ba1 = 0.f;
#pragma unroll
        for (int gg = 0; gg < 4; ++gg) { float v1 = -3e38f, v2 = -3e38f, a1 = 0.f, a2 = 0.f; int i1 = 0, i2 = 0;
#pragma unroll
            for (int i = 0; i < 8; ++i) { const float a = ar[gg * 8 + i], c_ = a + p.router_b[gg * 8 + i];
                if (c_ > v1) { v2 = v1; a2 = a1; i2 = i1; v1 = c_; a1 = a; i1 = i; } else if (c_ > v2) { v2 = c_; a2 = a; i2 = i; } }
            const float gs = v1 + v2; if (gs > bestgs) { bestgs = gs; be0 = gg * 8 + i1; be1 = gg * 8 + i2; ba0 = a1; ba1 = a2; } }
        const float sum = ba0 + ba1; p.tokw[row * 2] = ba0 / sum; p.tokw[row * 2 + 1] = ba1 / sum;
        const int lr = row - row0; const int r0_ = atomicAdd((int*)&lcnt[be0], 1); const int r1_ = atomicAdd((int*)&lcnt[be1], 1);
        ent[lr * 4 + 0] = be0 | (r0_ << 8); ent[lr * 4 + 1] = row * 2; ent[lr * 4 + 2] = be1 | (r1_ << 8); ent[lr * 4 + 3] = row * 2 + 1; }
    { uint2 xq[2][4][4];
#define NR_LOAD(s_, r_) do { _Pragma("unroll") for (int k_ = 0; k_ < 4; ++k_) { const bf16_t* xq_ = xin + (size_t)((r_) + k_) * D + 4 * lane; _Pragma("unroll") for (int j_ = 0; j_ < 4; ++j_) xq[s_][k_][j_] = *(const uint2*)(xq_ + 256 * j_); } } while (0)
      NR_LOAD(0, rbase);
#pragma unroll
      for (int g4 = 0; g4 < 4; ++g4) {
          if (g4 + 1 < 4) NR_LOAD((g4 + 1) & 1, rbase + 4 * (g4 + 1));
#pragma unroll
          for (int k = 0; k < 4; ++k) { const int row = rbase + 4 * g4 + k; const float rr_ = rdlane(r, 4 * g4 + k);
#pragma unroll
              for (int j = 0; j < 4; ++j) { const f32x4 g4v = *(const LAS f32x4*)(cg + 4 * lane + 256 * j), s4_ = *(const LAS f32x4*)(csh + 4 * lane + 256 * j); const uint2 xc = xq[g4 & 1][k][j];
                  const float x0 = __uint_as_float(xc.x << 16), x1 = __uint_as_float(xc.x & 0xFFFF0000u), x2 = __uint_as_float(xc.y << 16), x3 = __uint_as_float(xc.y & 0xFFFF0000u);
                  *(unsigned*)((unsigned char*)p.h + (size_t)row * D + 4 * lane + 256 * j) = pk4_fp8((x0 * rr_ * g4v[0] + s4_[0]) * F8_SA, (x1 * rr_ * g4v[1] + s4_[1]) * F8_SA, (x2 * rr_ * g4v[2] + s4_[2]) * F8_SA, (x3 * rr_ * g4v[3] + s4_[3]) * F8_SA); } } }
#undef NR_LOAD
    }
    __syncthreads();
    if (F.tid < 32) gbase[F.tid] = atomicAdd(&p.cnt[layer * 64 + F.tid], lcnt[F.tid]);
    __syncthreads();
    for (int idx = F.tid; idx < rows_per_wg * 2; idx += NTHR) { const int er = ent[idx * 2], tk = ent[idx * 2 + 1]; const int e = er & 255, rk = er >> 8; p.list[(size_t)e * T + gbase[e] + rk] = tk; }
    __syncthreads();
}

struct MoeOrder { const LAS int* tab;
    __device__ bool next(int i, ge::Unit& u) const { if (i >= 8) return false; const int pm = __builtin_amdgcn_readfirstlane(tab[4 * i]); if (pm < 0) return false;
        u.pm = pm; u.pn = __builtin_amdgcn_readfirstlane(tab[4 * i + 1]); u.bt = __builtin_amdgcn_readfirstlane(tab[4 * i + 2]); u.aux = __builtin_amdgcn_readfirstlane(tab[4 * i + 3]); return true; } };
__device__ __forceinline__ void moe_plan(const Frame& F, const int* cnt, const int* list, LAS int* tab, LAS int* tkt  , int npn, const float* tokw = nullptr, LAS float* tkw = nullptr  , const float wscale = 1.f) {
    LAS int* lc = tab + 32;
    __syncthreads();
    if (F.tid < 32) lc[F.tid] = cnt[F.tid];
    __syncthreads();
    if (F.tid < 8) { const int L = F.tid * F.G + F.bid, mt = L / npn, pn = L % npn; int acc = 0, e_f = -1, mi_f = 0;
#pragma unroll 1
        for (int e = 0; e < NE; ++e) { const int nte = (lc[e] + 255) >> 8; if (e_f < 0 && mt < acc + nte) { e_f = e; mi_f = mt - acc; } acc += nte; }
        tab[4 * F.tid] = e_f < 0 ? -1 : mt; tab[4 * F.tid + 1] = pn; tab[4 * F.tid + 2] = e_f * npn + pn; tab[4 * F.tid + 3] = e_f | (mi_f << 8) | (F.tid << 24); }
    __syncthreads();
#pragma unroll
    for (int q = 0; q < 4; ++q) { const int idx = F.tid + NTHR * q, i = idx >> 8, r = idx & 255; int v = -1;
        if (tab[4 * i] >= 0) { const int aux = tab[4 * i + 3], e = aux & 255, ii = ((aux >> 8) & 0xFFFF) * 256 + r; if (ii < lc[e]) v = list[(size_t)e * T + ii]; }
        tkt[idx] = v; if (tkw) tkw[idx] = v >= 0 ? tokw[v] * wscale : 0.f; }
    __syncthreads();
}
struct MoeRows { static constexpr bool dense = false; const LAS int* tkt; __device__ __forceinline__ unsigned operator()(const ge::Unit& u, int r) const { const int tk = tkt[(u.aux >> 24) * 256 + r]; return tk < 0 ? (unsigned)T * (unsigned)(D * 2) : (unsigned)(tk >> 1) * (unsigned)D; } };
struct EpiMoe1 { unsigned char* hid8; float inscale;
    __device__ __forceinline__ void operator()(const f32x4 (&acc)[2][2][4][2], const ge::Unit& u, int wr, int wc, int fr, int fq) const {
        const int h0 = (4 * u.pn + wc) * 32 + 8 * fq;
#pragma unroll
        for (int ai = 0; ai < 2; ++ai)
#pragma unroll
            for (int m = 0; m < 4; ++m) { const int row = u.pm * 256 + ai * 128 + wr * 64 + m * 16 + fr; unsigned w[2];
#pragma unroll
                for (int n = 0; n < 2; ++n) { float r4[4];
#pragma unroll
                    for (int j = 0; j < 4; ++j) { const float g = acc[ai][0][m][n][j] * inscale, uu = acc[ai][1][m][n][j] * inscale; r4[j] = g * fsigmoid(g) * uu * F8_SH; }
                    w[n] = pk4_fp8(r4[0], r4[1], r4[2], r4[3]); }
                *(uint2*)(hid8 + (size_t)row * DE + h0) = make_uint2(w[0], w[1]); }
    } };
struct EpiMoe2 { bf16_t* outk; const LAS int* tkt; const LAS float* tkw;
    __device__ __forceinline__ void operator()(const f32x4 (&acc)[2][2][4][2], const ge::Unit& u, int wr, int wc, int fr, int fq) const {
        const int L0 = (4 * u.pn + wc) * 64 + 16 * fq; const int ub = (u.aux >> 24) * 256 + wr * 64 + fr; int tk[2][4]; float wt[2][4];
#pragma unroll
        for (int ai = 0; ai < 2; ++ai)
#pragma unroll
            for (int m = 0; m < 4; ++m) { tk[ai][m] = tkt[ub + ai * 128 + m * 16]; wt[ai][m] = tkw[ub + ai * 128 + m * 16]; }
#pragma unroll
        for (int ai = 0; ai < 2; ++ai)
#pragma unroll
            for (int m = 0; m < 4; ++m) { const int t_ = tk[ai][m]; if (t_ < 0) continue; const float w = wt[ai][m]; float v[16]; GE_VALS(v, acc, ai, m);
#pragma unroll
                for (int k = 0; k < 16; ++k) v[k] *= w;
                *(uint4*)((unsigned char*)outk + (size_t)(t_ & 1) * T * D + (size_t)(t_ >> 1) * D + L0) = make_uint4(pk4_fp8(v[0], v[1], v[2], v[3]), pk4_fp8(v[4], v[5], v[6], v[7]), pk4_fp8(v[8], v[9], v[10], v[11]), pk4_fp8(v[12], v[13], v[14], v[15])); }
    } };

__device__ __forceinline__ void phase_cmp2(const Params& p, const Frame& F) {
    LAS float* w2l = (LAS float*)F.lds; const int base = F.bid * 8 + F.wave;
#pragma unroll 1
    for (int w = 0; w < 2; ++w) {
        __syncthreads();
        for (int i4 = F.tid; i4 < 256 * 64 / 4; i4 += NTHR) { const float4 t4 = *(const float4*)(p.cmp_w2 + (size_t)w * 256 * 64 + 4 * i4); *(LAS f32x4*)(w2l + 4 * i4) = (f32x4){t4.x, t4.y, t4.z, t4.w}; }
        float hv[2][4];
#pragma unroll
        for (int k = 0; k < 2; ++k) { const int row = (base + (2 * w + k) * 2048) & 4095;
#pragma unroll
            for (int i = 0; i < 4; ++i) { float x = p.cb1[w * 256 + i * 64 + F.lane];
#pragma unroll
                for (int ks = 0; ks < 8; ++ks) x += p.cpart[((size_t)(w * 8 + ks) * 4096 + row) * 256 + i * 64 + F.lane];
                hv[k][i] = 0.5f * x * (1.f + ftanh(0.7978845608028654f * (x + 0.044715f * x * x * x))); } }
        __syncthreads();
        float acc0 = p.cmp_b2[w * 64 + F.lane], acc1 = acc0;
#pragma unroll
        for (int i = 0; i < 4; ++i)
#pragma unroll 8
            for (int l = 0; l < 64; ++l) { const float wv = w2l[(i * 64 + l) * 64 + F.lane]; acc0 += rdlane(hv[0][i], l) * wv; acc1 += rdlane(hv[1][i], l) * wv; }
#pragma unroll
        for (int k = 0; k < 2; ++k) { const int row = (base + (2 * w + k) * 2048) & 4095, c = row & 127; float v = k ? acc1 : acc0;
            if (w == 0) { const float ss = wave_sum(v * v); v = v * rsqrtf(ss * (1.f / 64.f) + 1e-6f) * p.k_gain[F.lane]; int pos = c * 16 + 31; if (pos > 2047) pos = 2047;
                const float other = sx<8>(v); if (F.lane < 16) { const int j = F.lane & 7; const float cs = p.rope[pos * 16 + j], sn = p.rope[pos * 16 + 8 + j]; v = (F.lane < 8) ? (v * cs - other * sn) : (v * cs + other * sn); } }
            if (c == 127) v = 0.f;
            (w == 0 ? p.kcmp : p.vcmp)[(size_t)row * 64 + F.lane] = f2bf(v); }
    }
}

typedef float f32x16 __attribute__((ext_vector_type(16)));
typedef short s16x4 __attribute__((ext_vector_type(4)));
namespace at {
constexpr int KP = 144, VP = 192;
constexpr int KBUF = 64 * KP, VBUF = 64 * VP;
constexpr int OFF_K0 = 0, OFF_K1 = KBUF, OFF_V0 = 4 * KBUF, OFF_V1 = 4 * KBUF + VBUF, OFF_IMP = 4 * KBUF + 4 * VBUF;
constexpr int IMP_PITCH = 33, OFF_SEL = OFF_IMP + 8 * 32 * IMP_PITCH * 4;
constexpr float SC = 0.125f * 1.4426950408889634f;
constexpr float NEG = -1e30f, THR = 8.0f;
__device__ __forceinline__ unsigned pk2(float a, float b) { typedef float f2 __attribute__((ext_vector_type(2))); typedef __bf16 b2 __attribute__((ext_vector_type(2))); b2 r = __builtin_convertvector((f2){a, b}, b2); return __builtin_bit_cast(unsigned, r); }
template <int OFF> __device__ __forceinline__ s16x4 tr_read(unsigned addr) { s16x4 r; asm volatile("ds_read_b64_tr_b16 %0, %1 offset:%2" : "=&v"(r) : "v"(addr), "i"(OFF) : "memory"); return r; }
struct St { f32x16 o[2]; float m, l; };

__device__ __forceinline__ void qk_tile(const LAS unsigned char* kb, int r32, int hi, const bf16x8 (&qf)[4], f32x16& s0, f32x16& s1) {
#pragma unroll
    for (int e = 0; e < 16; ++e) { s0[e] = 0.f; s1[e] = 0.f; }
#pragma unroll
    for (int ks = 0; ks < 4; ++ks) {
        const bf16x8 a0 = *(const LAS bf16x8*)(kb + r32 * KP + (16 * ks + 8 * hi) * 2);
        const bf16x8 a1 = *(const LAS bf16x8*)(kb + (32 + r32) * KP + (16 * ks + 8 * hi) * 2);
        s0 = __builtin_amdgcn_mfma_f32_32x32x16_bf16(a0, qf[ks], s0, 0, 0, 0);
        s1 = __builtin_amdgcn_mfma_f32_32x32x16_bf16(a1, qf[ks], s1, 0, 0, 0);
    }
}
template <int MODE>
__device__ __forceinline__ bool elem_valid(int kt, int e, int hi, int qloc, int t, int key0) {
    const int kl = kt * 32 + (e & 3) + 8 * (e >> 2) + 4 * hi;
    if (MODE == 1) { const int c = key0 + kl; return (c < 127) && (16 * c + 31 <= t); }
    if (MODE == 2) return kl <= qloc;
    if (MODE == 3) return kl > qloc;
    return true;
}
template <int DT> __device__ __forceinline__ void pv_read(unsigned vb_lane, s16x4 (&va)[4][2]) {
    va[0][0] = tr_read<0 * VP + 64 * DT>(vb_lane); va[0][1] = tr_read<8 * VP + 64 * DT>(vb_lane); va[1][0] = tr_read<16 * VP + 64 * DT>(vb_lane); va[1][1] = tr_read<24 * VP + 64 * DT>(vb_lane);
    va[2][0] = tr_read<32 * VP + 64 * DT>(vb_lane); va[2][1] = tr_read<40 * VP + 64 * DT>(vb_lane); va[3][0] = tr_read<48 * VP + 64 * DT>(vb_lane); va[3][1] = tr_read<56 * VP + 64 * DT>(vb_lane);
}
__device__ __forceinline__ void pv_mma(const s16x4 (&va)[4][2], const unsigned (&pp)[16], f32x16& o) {
#pragma unroll
    for (int kk = 0; kk < 4; ++kk) {
        const bf16x8 af = (bf16x8){va[kk][0][0], va[kk][0][1], va[kk][0][2], va[kk][0][3], va[kk][1][0], va[kk][1][1], va[kk][1][2], va[kk][1][3]};
        typedef unsigned u32x4 __attribute__((ext_vector_type(4)));
        const u32x4 pw = (u32x4){pp[4 * kk], pp[4 * kk + 1], pp[4 * kk + 2], pp[4 * kk + 3]};
        o = __builtin_amdgcn_mfma_f32_32x32x16_bf16(af, __builtin_bit_cast(bf16x8, pw), o, 0, 0, 0);
    }
}
__device__ __forceinline__ void pv_tile(unsigned vb_lane, const unsigned (&pp)[16], St& st) {
    s16x4 va[4][2];
    pv_read<0>(vb_lane, va); asm volatile("s_waitcnt lgkmcnt(0)" ::: "memory"); __builtin_amdgcn_sched_barrier(0); pv_mma(va, pp, st.o[0]);
    pv_read<1>(vb_lane, va); asm volatile("s_waitcnt lgkmcnt(0)" ::: "memory"); __builtin_amdgcn_sched_barrier(0); pv_mma(va, pp, st.o[1]);
}
__device__ __forceinline__ float max3f(float a, float b, float c) { float r; asm("v_max3_f32 %0, %1, %2, %3" : "=v"(r) : "v"(a), "v"(b), "v"(c)); return r; }
template <int MODE, bool GATED, bool FIXED>
__device__ __forceinline__ void attend_tile(const LAS unsigned char* kb, unsigned vb_lane, int r32, int hi, const bf16x8 (&qf)[4], St& st, int qloc, bool en, float mfix) {
    f32x16 s0, s1; qk_tile(kb, r32, hi, qf, s0, s1);
    s16x4 va0[4][2]; pv_read<0>(vb_lane, va0);
    if (MODE != 0) {
#pragma unroll
        for (int e = 0; e < 16; ++e) { s0[e] = elem_valid<MODE>(0, e, hi, qloc, 0, 0) ? s0[e] : NEG; s1[e] = elem_valid<MODE>(1, e, hi, qloc, 0, 0) ? s1[e] : NEG; }
    }
    float mc = 0.f;
    if (FIXED) {
    } else {
        float mx = max3f(s0[0], s0[1], s1[0]);
#pragma unroll
        for (int e = 2; e < 16; e += 2) mx = max3f(mx, s0[e], s0[e + 1]);
#pragma unroll
        for (int e = 1; e < 15; e += 2) mx = max3f(mx, s1[e], s1[e + 1]);
        mx = fmaxf(mx, s1[15]);
        if (GATED) mx = en ? mx : NEG;
        mx = max32(mx);
        float mold = st.m;
        if (__any((mx - mold) * SC > THR)) {
            const float mnew = fmaxf(mold, mx); const float al = __builtin_amdgcn_exp2f((mold - mnew) * SC);
#pragma unroll
            for (int e = 0; e < 16; ++e) { st.o[0][e] *= al; st.o[1][e] *= al; }
            st.l *= al; st.m = mnew; mold = mnew;
        }
        mc = fmaxf(mold, -1e20f) * SC; if (GATED) mc = en ? mc : 3e38f;
    }
    float rs = 0.f; unsigned pp[16];
#pragma unroll
    for (int e = 0; e < 16; e += 2) {
        float a0, a1, b0, b1;
        if (FIXED) { a0 = __builtin_amdgcn_exp2f(s0[e]); a1 = __builtin_amdgcn_exp2f(s0[e + 1]); b0 = __builtin_amdgcn_exp2f(s1[e]); b1 = __builtin_amdgcn_exp2f(s1[e + 1]); }
        else { a0 = __builtin_amdgcn_exp2f(__builtin_fmaf(s0[e], SC, -mc)); a1 = __builtin_amdgcn_exp2f(__builtin_fmaf(s0[e + 1], SC, -mc)); b0 = __builtin_amdgcn_exp2f(__builtin_fmaf(s1[e], SC, -mc)); b1 = __builtin_amdgcn_exp2f(__builtin_fmaf(s1[e + 1], SC, -mc)); }
        rs += (a0 + a1) + (b0 + b1); pp[e >> 1] = pk2(a0, a1); pp[8 + (e >> 1)] = pk2(b0, b1); }
    if (FIXED && GATED) {
#pragma unroll
        for (int i = 0; i < 16; ++i) pp[i] = en ? pp[i] : 0u;
        rs = en ? rs : 0.f; }
    if (!FIXED) rs = sum32(rs);
    st.l += rs;
    asm volatile("s_waitcnt lgkmcnt(0)" ::: "memory"); __builtin_amdgcn_sched_barrier(0); pv_mma(va0, pp, st.o[0]);
    { s16x4 va1[4][2]; pv_read<1>(vb_lane, va1); asm volatile("s_waitcnt lgkmcnt(0)" ::: "memory"); __builtin_amdgcn_sched_barrier(0); pv_mma(va1, pp, st.o[1]); }
}
__device__ __forceinline__ void st_reset(St& st) {
#pragma unroll
    for (int a = 0; a < 2; ++a)
#pragma unroll
        for (int e = 0; e < 16; ++e) st.o[a][e] = 0.f;
    st.m = NEG; st.l = 0.f;
}
__device__ __forceinline__ void st_flush(const St& st, unsigned (&ofin)[2][8], float g, bool first) {
    const float f = (st.l > 0.f ? 1.f / st.l : 0.f) * g;
#pragma unroll
    for (int dt = 0; dt < 2; ++dt)
#pragma unroll
        for (int e = 0; e < 16; e += 2) { float a = st.o[dt][e] * f, b = st.o[dt][e + 1] * f;
            if (!first) { const unsigned w = ofin[dt][e >> 1]; a += __uint_as_float(w << 16); b += __uint_as_float(w & 0xFFFF0000u); }
            ofin[dt][e >> 1] = pk2(a, b); }
#pragma unroll
    for (int dt = 0; dt < 2; ++dt) asm volatile("" : "+v"(ofin[dt][0]), "+v"(ofin[dt][1]), "+v"(ofin[dt][2]), "+v"(ofin[dt][3]), "+v"(ofin[dt][4]), "+v"(ofin[dt][5]), "+v"(ofin[dt][6]), "+v"(ofin[dt][7]));
}
__device__ __forceinline__ void tile_load(const bf16_t* kbase, const bf16_t* vbase, int key0, int tid, uint4& kr, uint4& vr) {
    const size_t o = (size_t)(key0 + (tid >> 3)) * 64 + (tid & 7) * 8; kr = *(const uint4*)(kbase + o); vr = *(const uint4*)(vbase + o); }
typedef unsigned u32x4_t __attribute__((ext_vector_type(4)));
__device__ __forceinline__ void tile_store(LAS unsigned char* lds, int buf, int tid, const uint4& kr, const uint4& vr) {
    *(LAS u32x4_t*)(lds + OFF_K0 + buf * KBUF + (tid >> 3) * KP + (tid & 7) * 16) = (u32x4_t){kr.x, kr.y, kr.z, kr.w}; *(LAS u32x4_t*)(lds + OFF_V0 + buf * VBUF + (tid >> 3) * VP + (tid & 7) * 16) = (u32x4_t){vr.x, vr.y, vr.z, vr.w}; }
}

template <bool FIXED>
__device__ __forceinline__ void phase_attn_t(const Params& p, const Frame& F, const float mfix) {
    using namespace at;
    LAS unsigned char* lds = F.lds;
    const int tid = F.tid, lane = F.lane, w = F.wave, r32 = lane & 31, hi = lane >> 5;
    const unsigned vlane = (unsigned)((4 * hi + ((lane & 15) >> 2)) * VP + (16 * ((lane >> 4) & 1) + 4 * (lane & 3)) * 2);
    LAS float* impw = (LAS float*)(lds + OFF_IMP) + w * 32 * IMP_PITCH;
    LAS unsigned* selm = (LAS unsigned*)(lds + OFF_SEL);
    LAS float* invl = (LAS float*)(lds + OFF_SEL + 512);
#define AT_UNIT(ui_, qb_, bg_, qoff_) const int idx_##qb_ = ((ui_) & 1) ? ((ui_) * 256 + 255 - F.bid) : ((ui_) * 256 + F.bid); const int qb_ = 31 - (idx_##qb_ >> 6), bg_ = (idx_##qb_ >> 1) & 31, qoff_ = (idx_##qb_ & 1) * 32
    bf16x8 qf[4]; float gt[3]; uint4 kr, vr, kr1, vr1;
    { AT_UNIT(0, qb, bg, qoff);
      const bf16_t* kc = p.kcmp + (size_t)bg * 128 * 64; const bf16_t* vc = p.vcmp + (size_t)bg * 128 * 64;
      tile_load(kc, vc, 0, tid, kr, vr); if (qb >= 16) tile_load(kc, vc, 64, tid, kr1, vr1); }
#pragma unroll 1
    for (int ui = 0; ui < 8; ++ui) {
        AT_UNIT(ui, qb, bg, qoff);
        const int b = bg >> 1, g = bg & 1, head = g * 8 + w, s0 = qb * 64;
        const int qloc = qoff + r32, t = s0 + qloc;
        const bf16_t* ksel = p.kv + (size_t)2 * T * 128 + (size_t)bg * S * 64; const bf16_t* vsel = p.kv + (size_t)3 * T * 128 + (size_t)bg * S * 64;
        const bf16_t* kwin = p.kv + (size_t)4 * T * 128 + (size_t)bg * S * 64; const bf16_t* vwin = p.kv + (size_t)5 * T * 128 + (size_t)bg * S * 64;
        unsigned ofin[2][8]; St st;
        { const size_t tok = (size_t)b * S + t;
#pragma unroll
          for (int ks = 0; ks < 4; ++ks) { qf[ks] = *(const bf16x8*)(p.q + tok * D + head * 64 + 16 * ks + 8 * hi);
              if (FIXED) { typedef unsigned u32x4q __attribute__((ext_vector_type(4))); const u32x4q w4 = __builtin_bit_cast(u32x4q, qf[ks]); u32x4q r4;
#pragma unroll
                  for (int i = 0; i < 4; ++i) r4[i] = pk2(__uint_as_float(w4[i] << 16) * SC, __uint_as_float(w4[i] & 0xFFFF0000u) * SC);
                  qf[ks] = __builtin_bit_cast(bf16x8, r4); } }
#pragma unroll
          for (int br = 0; br < 3; ++br) gt[br] = p.gates[tok * 48 + br * 16 + head]; }
        const int nct = (qb >= 16) ? 2 : 1;
        __syncthreads();
        tile_store(lds, 0, tid, kr, vr); if (nct == 2) tile_store(lds, 1, tid, kr1, vr1);
        tile_load(ksel, vsel, qb * 64, tid, kr, vr);
        __syncthreads();
        float cm = NEG, cl = 0.f;
        if (!FIXED) {
#pragma unroll 1
        for (int ct = 0; ct < nct; ++ct) { const LAS unsigned char* kb = lds + (ct ? OFF_K1 : OFF_K0);
            f32x16 a0, a1; qk_tile(kb, r32, hi, qf, a0, a1); float mx = NEG;
#pragma unroll
            for (int e = 0; e < 16; ++e) { a0[e] = elem_valid<1>(0, e, hi, qloc, t, ct * 64) ? a0[e] : NEG; a1[e] = elem_valid<1>(1, e, hi, qloc, t, ct * 64) ? a1[e] : NEG; mx = fmaxf(mx, fmaxf(a0[e], a1[e])); }
            mx = max32(mx); const float mnew = fmaxf(cm, mx); float rs = 0.f;
#pragma unroll
            for (int e = 0; e < 16; ++e) { rs += (a0[e] > -1e29f ? __builtin_amdgcn_exp2f((a0[e] - mnew) * SC) : 0.f) + (a1[e] > -1e29f ? __builtin_amdgcn_exp2f((a1[e] - mnew) * SC) : 0.f); }
            rs = sum32(rs); cl = cl * __builtin_amdgcn_exp2f((cm - mnew) * SC) + rs; cm = mnew; }
        }
        st_reset(st); if (FIXED) cm = mfix / SC; else st.m = cm;
        const float icl = FIXED ? 1.f : (cl > 0.f ? 1.f / cl : 0.f);
        LAS float* irow = impw + r32 * IMP_PITCH;
        if (nct == 1) {
#pragma unroll 1
            for (int j = 16; j < 32; ++j) irow[j] = 0.f; }
#pragma unroll 1
        for (int ct = 0; ct < nct; ++ct) { const LAS unsigned char* kb = lds + (ct ? OFF_K1 : OFF_K0); const unsigned vb = (unsigned)(unsigned long)(lds + (ct ? OFF_V1 : OFF_V0)) + vlane;
            f32x16 a0, a1; qk_tile(kb, r32, hi, qf, a0, a1); const float mc = cm * SC; unsigned pp[16]; float rs = 0.f; float Ai[8], Fi[8];
            int clim = (t - 31) >> 4; clim = (clim > 126 ? 126 : clim) - 4 * hi - ct * 64;
#pragma unroll
            for (int kt = 0; kt < 2; ++kt)
#pragma unroll
                for (int gq = 0; gq < 4; ++gq) { float pv[4];
#pragma unroll
                    for (int e2 = 0; e2 < 4; ++e2) { const int e = gq * 4 + e2; const float sv = kt ? a1[e] : a0[e]; pv[e2] = (kt * 32 + (e & 3) + 8 * (e >> 2) <= clim) ? (FIXED ? __builtin_amdgcn_exp2f(sv) : __builtin_amdgcn_exp2f(sv * SC - mc)) : 0.f; }
                    pp[kt * 8 + gq * 2] = pk2(pv[0], pv[1]); pp[kt * 8 + gq * 2 + 1] = pk2(pv[2], pv[3]); rs += (pv[0] + pv[1]) + (pv[2] + pv[3]);
                    Ai[kt * 4 + gq] = (pv[0] + 2.f * (pv[1] + pv[2] + pv[3])) * icl; Fi[kt * 4 + gq] = pv[0] * icl; }
            st.l += rs;
            float Fr[8];
#pragma unroll
            for (int g8 = 0; g8 < 8; ++g8) Fr[g8] = other32(Fi[g8], hi != 0);
#pragma unroll
            for (int g8 = 0; g8 < 8; ++g8) { const float nxt = (g8 < 7) ? Fr[g8 + 1] : 0.f;
                irow[ct * 16 + 2 * g8 + hi] = Ai[g8] + (hi ? nxt : Fr[g8]); }
            if (ct == 1 && hi) irow[15] += Fr[0];
            pv_tile(vb, pp, st); }
        st.l = sum32(st.l);
        if (hi == 0) invl[w * 32 + r32] = FIXED ? (st.l > 0.f ? 1.f / st.l : 0.f) : 1.f;
        tile_store(lds, 2, tid, kr, vr);
        st_flush(st, ofin, gt[0], true);
        __syncthreads();
        if (w == 0) { unsigned mask;
            if (qb < 8) mask = (2u << qb) - 1u;
            else { mask = 1u | (1u << qb) | (1u << (qb - 1));
                const LAS float* ib = (const LAS float*)(lds + OFF_IMP) + r32 * IMP_PITCH; float iv[32];
#pragma unroll
                for (int j = 0; j < 32; ++j) { float v = 0.f;
#pragma unroll
                    for (int ww = 0; ww < 8; ++ww) v += ib[ww * 32 * IMP_PITCH + j] * invl[ww * 32 + r32];
                    iv[j] = (j >= 1 && j <= qb - 2) ? v : -3e38f; }
#pragma unroll 1
                for (int pick = 0; pick < 5; ++pick) { int best = -1; float bv = -3e38f;
#pragma unroll
                    for (int j = 1; j < 31; ++j) { const bool take = !((mask >> j) & 1u) && iv[j] > bv; bv = take ? iv[j] : bv; best = take ? j : best; }
                    if (best >= 0) mask |= 1u << best; } }
            if (hi == 0) selm[r32] = mask; unsigned um = mask;
            um |= sxu<16>(um); um |= sxu<8>(um); um |= sxu<4>(um); um |= sxu<2>(um); um |= sxu<1>(um);
            if (lane == 0) selm[32] = um; }
        __syncthreads();
        const int jlo = qb >= 8 ? qb - 8 : 0;
        { const unsigned um = selm[32]; const unsigned mq = selm[r32];
          st_reset(st);
          unsigned rem = um & ~(1u << qb);
#define SEL_POP(dst) do { if (rem) { dst = 31 - __builtin_clz(rem); rem &= ~(1u << dst); } else dst = -1; } while (0)
          int jA = qb, jB = -1, sb = 1;
          for (;;) {
              int nA, nB = -1; SEL_POP(nA); if (nA >= 0) SEL_POP(nB);
              if (nA >= 0) tile_load(ksel, vsel, nA * 64, tid, kr, vr);
              if (nB >= 0) tile_load(ksel, vsel, nB * 64, tid, kr1, vr1);
              if (nA < 0) { tile_load(kwin, vwin, qb * 64, tid, kr, vr); if (qb - 1 >= jlo) tile_load(kwin, vwin, (qb - 1) * 64, tid, kr1, vr1); }
              { const LAS unsigned char* kb = lds + OFF_K0 + (2 * sb) * KBUF; const unsigned vb = (unsigned)(unsigned long)(lds + OFF_V0 + (2 * sb) * VBUF) + vlane;
                if (jA == qb) attend_tile<2, false, FIXED>(kb, vb, r32, hi, qf, st, qloc, true, mfix);
                else attend_tile<0, true, FIXED>(kb, vb, r32, hi, qf, st, qloc, (mq >> jA) & 1u, mfix); }
              if (jB >= 0) { const LAS unsigned char* kb = lds + OFF_K0 + (2 * sb + 1) * KBUF; const unsigned vb = (unsigned)(unsigned long)(lds + OFF_V0 + (2 * sb + 1) * VBUF) + vlane;
                attend_tile<0, true, FIXED>(kb, vb, r32, hi, qf, st, qloc, (mq >> jB) & 1u, mfix); }
              if (nA < 0) break;
              tile_store(lds, 2 * (sb ^ 1), tid, kr, vr); if (nB >= 0) tile_store(lds, 2 * (sb ^ 1) + 1, tid, kr1, vr1);
              __syncthreads();
              jA = nA; jB = nB; sb ^= 1;
          }
#undef SEL_POP
          if (FIXED) st.l = sum32(st.l);
          st_flush(st, ofin, gt[1], false); }
        __syncthreads();
        { st_reset(st);
          int jA = qb, jB = (qb - 1 >= jlo) ? qb - 1 : -1, sb = 0;
          tile_store(lds, 0, tid, kr, vr); if (jB >= 0) tile_store(lds, 1, tid, kr1, vr1);
          __syncthreads();
          for (;;) {
              const int nA = (jB >= 0 && jB - 1 >= jlo) ? jB - 1 : -1, nB = (nA >= 0 && nA - 1 >= jlo) ? nA - 1 : -1;
              if (nA >= 0) tile_load(kwin, vwin, nA * 64, tid, kr, vr);
              if (nB >= 0) tile_load(kwin, vwin, nB * 64, tid, kr1, vr1);
              if (nA < 0 && ui + 1 < 8) {
                  AT_UNIT(ui + 1, qbn, bgn, qoffn);
                  const bf16_t* kcn = p.kcmp + (size_t)bgn * 128 * 64; const bf16_t* vcn = p.vcmp + (size_t)bgn * 128 * 64;
                  tile_load(kcn, vcn, 0, tid, kr, vr); if (qbn >= 16) tile_load(kcn, vcn, 64, tid, kr1, vr1); }
#define WIN_TILE(j_, bi_) do { const LAS unsigned char* kb = lds + OFF_K0 + (bi_) * KBUF; const unsigned vb = (unsigned)(unsigned long)(lds + OFF_V0 + (bi_) * VBUF) + vlane; \
                if ((j_) == qb) attend_tile<2, false, FIXED>(kb, vb, r32, hi, qf, st, qloc, true, mfix); else if ((j_) == qb - 8) attend_tile<3, false, FIXED>(kb, vb, r32, hi, qf, st, qloc, true, mfix); else attend_tile<0, false, FIXED>(kb, vb, r32, hi, qf, st, qloc, true, mfix); } while (0)
              WIN_TILE(jA, 2 * sb);
              if (jB >= 0) WIN_TILE(jB, 2 * sb + 1);
#undef WIN_TILE
              if (nA < 0) break;
              tile_store(lds, 2 * (sb ^ 1), tid, kr, vr); if (nB >= 0) tile_store(lds, 2 * (sb ^ 1) + 1, tid, kr1, vr1);
              __syncthreads();
              jA = nA; jB = nB; sb ^= 1;
          }
          if (FIXED) st.l = sum32(st.l);
          st_flush(st, ofin, gt[2], false); }
        { int l2 = lane; asm volatile("" : "+v"(l2)); unsigned char* op = (unsigned char*)p.h + ((size_t)b * S + s0 + qoff + (l2 & 31)) * D + head * 64 + 4 * (l2 >> 5);
#pragma unroll
          for (int dt = 0; dt < 2; ++dt)
#pragma unroll
            for (int gq = 0; gq < 4; ++gq) { const unsigned w0 = ofin[dt][2 * gq], w1 = ofin[dt][2 * gq + 1];
                *(unsigned*)(op + dt * 32 + 8 * gq) = pk4_fp8(__uint_as_float(w0 << 16) * F8_SA, __uint_as_float(w0 & 0xFFFF0000u) * F8_SA, __uint_as_float(w1 << 16) * F8_SA, __uint_as_float(w1 & 0xFFFF0000u) * F8_SA); } }
    }
#undef AT_UNIT
}

__device__ __forceinline__ void phase_attn(const Params& p, const Frame& F) {
    const float gq = wave_max(fabsf(p.q_gain[F.lane])); const float gk = wave_max(fmaxf(fabsf(p.k_gain[F.lane]), fmaxf(fabsf(p.k_gain[64 + F.lane]), fabsf(p.k_gain[128 + F.lane]))));
    const float mfix = 64.f * 1.02f * gq * gk * at::SC;
    if (mfix < 60.f) phase_attn_t<true>(p, F, mfix);
    else phase_attn_t<false>(p, F, 0.f);
}

namespace ml {
constexpr int QP = 272, VP = 192;
constexpr int OFF_Q = 0, OFF_K = 64 * QP, OFF_V = 2 * 64 * QP, OFF_WV = OFF_V + 64 * VP, OFF_CB = OFF_WV + 64 * VP, OFF_GA = OFF_CB + 128 * VP, OFF_GAM = OFF_GA + 8192, OFF_GB = OFF_GAM + 8192,
              OFF_MP = OFF_GB + 8192, OFF_W = OFF_MP + 256, OFF_N = OFF_W + 256, OFF_RS = OFF_N + 512, OFF_QN = OFF_RS + 256, OFF_END = OFF_QN + 256;
typedef unsigned u32x4_t __attribute__((ext_vector_type(4)));
}
__device__ __forceinline__ void phase_scan(const Params& p, const Frame& F, bf16_t* hs_base  , const int hs_stride) {
    using namespace ml; using at::tr_read; using at::pk2;
    LAS unsigned char* lds = F.lds;
    const int tid = F.tid, lane = F.lane, w = F.wave, i16 = lane & 15, g = lane >> 4, r32 = lane & 31, hi = lane >> 5;
    const int b = F.bid >> 4, h = (F.bid >> 2) & 3, vs = F.bid & 3;
    LAS float* ga = (LAS float*)(lds + OFF_GA); LAS float* gam = (LAS float*)(lds + OFF_GAM); LAS float* gb = (LAS float*)(lds + OFF_GB); LAS float* mp = (LAS float*)(lds + OFF_MP);
    LAS float* wl = (LAS float*)(lds + OFF_W); LAS float* nl = (LAS float*)(lds + OFF_N); LAS float* rsl = (LAS float*)(lds + OFF_RS); LAS float* qnl = (LAS float*)(lds + OFF_QN);
    for (int ck = w; ck < 32; ck += 8) { const int pos = ck * 64 + lane; const size_t tg = ((size_t)b * S + pos) * 4 + h; const float lfv = p.lf[tg], liv = p.li[tg];
        float bs = lfv;
#pragma unroll
        for (int o = 1; o < 64; o <<= 1) { const float x = __int_as_float(__builtin_amdgcn_ds_bpermute((lane - o) * 4, __float_as_int(bs))); if (lane >= o) bs += x; }
        const float av = liv - bs; float am = av;
#pragma unroll
        for (int o = 1; o < 64; o <<= 1) { const float x = __int_as_float(__builtin_amdgcn_ds_bpermute((lane - o) * 4, __float_as_int(am))); if (lane >= o) am = fmaxf(am, x); }
        ga[pos] = av; gam[pos] = am; gb[pos] = bs; }
    for (int idx = tid; idx < 128 * VP / 4; idx += NTHR) ((LAS unsigned*)(lds + OFF_CB))[idx] = 0u;
    if (tid < 128) nl[tid] = 0.f;
    __syncthreads();
    if (tid == 0) { float m = 0.f;
#pragma unroll 1
        for (int k = 0; k < 32; ++k) { mp[k] = m; m = gb[k * 64 + 63] + fmaxf(m, gam[k * 64 + 63]); } }
    __syncthreads();
    const bf16_t* pq = p.proj + (size_t)b * S * 3072 + h * 128; const bf16_t* pk = pq + 512; bf16_t* pv = p.proj + (size_t)b * S * 3072 + 1024 + h * 256 + vs * 64;
    uint4 rq[2], rk[2], rv;
#define ML_LOAD(ck_) do { const size_t t0_ = (size_t)(ck_) * 64; _Pragma("unroll") for (int i_ = 0; i_ < 2; ++i_) { const int idx_ = tid + 512 * i_; const size_t o_ = (t0_ + (idx_ >> 4)) * 3072 + (idx_ & 15) * 8; rq[i_] = *(const uint4*)(pq + o_); rk[i_] = *(const uint4*)(pk + o_); } \
        rv = *(const uint4*)(pv + (t0_ + (tid >> 3)) * 3072 + (tid & 7) * 8); } while (0)
#define ML_STORE(ck_) do { _Pragma("unroll") for (int i_ = 0; i_ < 2; ++i_) { const int idx_ = tid + 512 * i_; const int o_ = (idx_ >> 4) * QP + (idx_ & 15) * 16; \
            *(LAS u32x4_t*)(lds + OFF_Q + o_) = (u32x4_t){rq[i_].x, rq[i_].y, rq[i_].z, rq[i_].w}; *(LAS u32x4_t*)(lds + OFF_K + o_) = (u32x4_t){rk[i_].x, rk[i_].y, rk[i_].z, rk[i_].w}; } \
        { const int s_ = tid >> 3; const float m63_ = fmaxf(mp[ck_], gam[(ck_) * 64 + 63]); const float ws_ = __expf(ga[(ck_) * 64 + s_] - m63_); if ((tid & 7) == 0) wl[s_] = ws_; \
          const int o_ = s_ * VP + (tid & 7) * 16; *(LAS u32x4_t*)(lds + OFF_V + o_) = (u32x4_t){rv.x, rv.y, rv.z, rv.w}; const unsigned vv_[4] = {rv.x, rv.y, rv.z, rv.w}; unsigned ww_[4]; \
          _Pragma("unroll") for (int e_ = 0; e_ < 4; ++e_) ww_[e_] = pk2(__uint_as_float(vv_[e_] << 16) * ws_, __uint_as_float(vv_[e_] & 0xFFFF0000u) * ws_); \
          *(LAS u32x4_t*)(lds + OFF_WV + o_) = (u32x4_t){ww_[0], ww_[1], ww_[2], ww_[3]}; } } while (0)
    ML_LOAD(0); ML_STORE(0);
    __syncthreads();
    const int tt = w >> 1, vh = w & 1;
    const int dt = w >> 1, vt2 = w & 1;
    const unsigned trl16 = (unsigned)(((lane & 15) >> 2) * VP + (4 * (lane & 3)) * 2);
    const unsigned trl32v = (unsigned)(((lane & 15) >> 2) * VP + (16 * ((lane >> 4) & 1) + 4 * (lane & 3)) * 2);
    const unsigned trl32k = (unsigned)(((lane & 15) >> 2) * QP + (16 * ((lane >> 4) & 1) + 4 * (lane & 3)) * 2);
    f32x16 cacc;
#pragma unroll
    for (int e = 0; e < 16; ++e) cacc[e] = 0.f;
    float nreg = 0.f;
    bf16_t* const hs_out = hs_base + (size_t)b * S * hs_stride + h * 256 + vs * 64 + 32 * vh + i16;
    const size_t wo1 = (size_t)NE * D * DE; const ColGateUp cgu{p.w_gate + wo1, p.w_up + wo1}; const ColDown cdn{p.w_down + wo1};
    LAS float* ptile = (LAS float*)(lds + OFF_END) + (tid >> 8) * (64 * 65); const int htid = tid & 255, half = tid >> 8;
    float pr_[16];
#define PREP_LOAD(s_) do { const bool gu_ = (s_) < 16; const int tl_ = (((gu_ ? (s_) : (s_) - 16) * F.G + F.bid) * 2 + half); const int c0_ = (tl_ & 511) * 64, k0_ = (tl_ >> 9) * 64; \
        const float* p_ = gu_ ? cgu(c0_ + (htid & 63)) : cdn(c0_ + (htid & 63)); const int ldw_ = gu_ ? DE : D; p_ += (size_t)(k0_ + (htid >> 6)) * ldw_; \
        _Pragma("unroll") for (int i_ = 0; i_ < 16; ++i_) pr_[i_] = p_[(size_t)(4 * i_) * ldw_]; } while (0)
#define PREP_WRITE() do { _Pragma("unroll") for (int i_ = 0; i_ < 16; ++i_) ptile[((htid >> 6) + 4 * i_) * 65 + (htid & 63)] = pr_[i_]; } while (0)
#define PREP_STORE(s_) do { const bool gu_ = (s_) < 16; const int tl_ = (((gu_ ? (s_) : (s_) - 16) * F.G + F.bid) * 2 + half); const int c0_ = (tl_ & 511) * 64, k0_ = (tl_ >> 9) * 64; \
        const int cc_ = htid >> 2, ch_ = (htid & 3) * 16; \
        { const float sc_ = gu_ ? F8_SW : F8_SW2; const unsigned long long a_ = (unsigned long long)p.gu_t, d_ = (unsigned long long)p.dn_t - a_; unsigned char* base_ = (unsigned char*)(a_ + (gu_ ? 0ull : d_)); const int kp_ = gu_ ? D : DE; \
          unsigned w_[4]; _Pragma("unroll") for (int i_ = 0; i_ < 4; ++i_) w_[i_] = pk4_fp8(ptile[(ch_ + 4 * i_) * 65 + cc_] * sc_, ptile[(ch_ + 4 * i_ + 1) * 65 + cc_] * sc_, ptile[(ch_ + 4 * i_ + 2) * 65 + cc_] * sc_, ptile[(ch_ + 4 * i_ + 3) * 65 + cc_] * sc_); \
          *(uint4*)(base_ + (size_t)(c0_ + cc_) * kp_ + k0_ + ch_) = make_uint4(w_[0], w_[1], w_[2], w_[3]); } } while (0)
    PREP_LOAD(0);
#pragma unroll 1
    for (int ck = 0; ck < 32; ++ck) {
        if (ck + 1 < 32) ML_LOAD(ck + 1);
        const float mprev = mp[ck]; const int c0 = ck * 64;
        bf16x8 qf[4];
#pragma unroll
        for (int ks = 0; ks < 4; ++ks) qf[ks] = *(const LAS bf16x8*)(lds + OFF_Q + (16 * tt + i16) * QP + (32 * ks + 8 * g) * 2);
        f32x4 st[4];
#pragma unroll
        for (int jt = 0; jt < 4; ++jt) { st[jt] = (f32x4){0.f, 0.f, 0.f, 0.f};
#pragma unroll
            for (int ks = 0; ks < 4; ++ks) { const bf16x8 kf = *(const LAS bf16x8*)(lds + OFF_K + (16 * jt + i16) * QP + (32 * ks + 8 * g) * 2); st[jt] = __builtin_amdgcn_mfma_f32_16x16x32_bf16(kf, qf[ks], st[jt], 0, 0, 0); } }
        const int tl = 16 * tt + i16; const float Mt = fmaxf(mprev, gam[c0 + tl]); float rs = 0.f; unsigned ap[8];
#pragma unroll
        for (int jt = 0; jt < 4; ++jt) { float v4[4]; const f32x4 ga4 = *(const LAS f32x4*)(ga + c0 + 16 * jt + 4 * g);
#pragma unroll
            for (int r = 0; r < 4; ++r) { const int j = 16 * jt + 4 * g + r; const float e = __expf(ga4[r] - Mt) * st[jt][r]; v4[r] = (j <= tl) ? e : 0.f; rs += v4[r]; }
            ap[jt * 2] = pk2(v4[0], v4[1]); ap[jt * 2 + 1] = pk2(v4[2], v4[3]); }
        rs = sum16(rs); rs = sum32(rs);
        float qn = 0.f;
#pragma unroll
        for (int ks = 0; ks < 4; ++ks) { const f32x4 n0 = *(const LAS f32x4*)(nl + 32 * ks + 8 * g), n1 = *(const LAS f32x4*)(nl + 32 * ks + 8 * g + 4);
#pragma unroll
            for (int e = 0; e < 4; ++e) { qn += bf2f((bf16_t)qf[ks][e]) * n0[e]; qn += bf2f((bf16_t)qf[ks][4 + e]) * n1[e]; } }
        qn = sum16(qn); qn = sum32(qn);
        if (vh == 0 && g == 0) { rsl[tl] = rs; qnl[tl] = qn; }
        f32x4 av[2], qc[2];
#pragma unroll
        for (int vt = 0; vt < 2; ++vt) { av[vt] = (f32x4){0.f, 0.f, 0.f, 0.f}; qc[vt] = (f32x4){0.f, 0.f, 0.f, 0.f}; }
        {   const unsigned vb = (unsigned)(unsigned long)(lds + OFF_V) + trl16 + (unsigned)(4 * g * VP + (32 * vh) * 2);
            const unsigned cb = (unsigned)(unsigned long)(lds + OFF_CB) + trl16 + (unsigned)(8 * g * VP + (32 * vh) * 2);
            s16x4 va[2][2][2], ca[4][2][2];
#pragma unroll
            for (int vt = 0; vt < 2; ++vt) {
                if (vt == 0) { va[0][0][0] = tr_read<0 * VP>(vb); va[0][0][1] = tr_read<16 * VP>(vb); va[1][0][0] = tr_read<32 * VP>(vb); va[1][0][1] = tr_read<48 * VP>(vb);
                    ca[0][0][0] = tr_read<0 * VP>(cb); ca[0][0][1] = tr_read<4 * VP>(cb); ca[1][0][0] = tr_read<32 * VP>(cb); ca[1][0][1] = tr_read<36 * VP>(cb);
                    ca[2][0][0] = tr_read<64 * VP>(cb); ca[2][0][1] = tr_read<68 * VP>(cb); ca[3][0][0] = tr_read<96 * VP>(cb); ca[3][0][1] = tr_read<100 * VP>(cb); }
                else { va[0][1][0] = tr_read<0 * VP + 32>(vb); va[0][1][1] = tr_read<16 * VP + 32>(vb); va[1][1][0] = tr_read<32 * VP + 32>(vb); va[1][1][1] = tr_read<48 * VP + 32>(vb);
                    ca[0][1][0] = tr_read<0 * VP + 32>(cb); ca[0][1][1] = tr_read<4 * VP + 32>(cb); ca[1][1][0] = tr_read<32 * VP + 32>(cb); ca[1][1][1] = tr_read<36 * VP + 32>(cb);
                    ca[2][1][0] = tr_read<64 * VP + 32>(cb); ca[2][1][1] = tr_read<68 * VP + 32>(cb); ca[3][1][0] = tr_read<96 * VP + 32>(cb); ca[3][1][1] = tr_read<100 * VP + 32>(cb); } }
            asm volatile("s_waitcnt lgkmcnt(0)" ::: "memory"); __builtin_amdgcn_sched_barrier(0);
#pragma unroll
            for (int vt = 0; vt < 2; ++vt) {
#pragma unroll
                for (int pp = 0; pp < 2; ++pp) { const bf16x8 bfv = (bf16x8){va[pp][vt][0][0], va[pp][vt][0][1], va[pp][vt][0][2], va[pp][vt][0][3], va[pp][vt][1][0], va[pp][vt][1][1], va[pp][vt][1][2], va[pp][vt][1][3]};
                    const u32x4_t aw = (u32x4_t){ap[4 * pp], ap[4 * pp + 1], ap[4 * pp + 2], ap[4 * pp + 3]};
                    av[vt] = __builtin_amdgcn_mfma_f32_16x16x32_bf16(__builtin_bit_cast(bf16x8, aw), bfv, av[vt], 0, 0, 0); }
#pragma unroll
                for (int ks = 0; ks < 4; ++ks) { const bf16x8 bfc = (bf16x8){ca[ks][vt][0][0], ca[ks][vt][0][1], ca[ks][vt][0][2], ca[ks][vt][0][3], ca[ks][vt][1][0], ca[ks][vt][1][1], ca[ks][vt][1][2], ca[ks][vt][1][3]};
                    qc[vt] = __builtin_amdgcn_mfma_f32_16x16x32_bf16(qf[ks], bfc, qc[vt], 0, 0, 0); } }
        }
        const float M63 = fmaxf(mprev, gam[c0 + 63]); const float decay = __expf(mprev - M63);
        {   const unsigned kb = (unsigned)(unsigned long)(lds + OFF_K) + trl32k + (unsigned)(8 * hi * QP + (32 * dt) * 2);
            const unsigned wb = (unsigned)(unsigned long)(lds + OFF_WV) + trl32v + (unsigned)(8 * hi * VP + (32 * vt2) * 2);
            s16x4 ka[4][2], wa[4][2];
            ka[0][0] = tr_read<0 * QP>(kb); ka[0][1] = tr_read<4 * QP>(kb); ka[1][0] = tr_read<16 * QP>(kb); ka[1][1] = tr_read<20 * QP>(kb);
            ka[2][0] = tr_read<32 * QP>(kb); ka[2][1] = tr_read<36 * QP>(kb); ka[3][0] = tr_read<48 * QP>(kb); ka[3][1] = tr_read<52 * QP>(kb);
            wa[0][0] = tr_read<0 * VP>(wb); wa[0][1] = tr_read<4 * VP>(wb); wa[1][0] = tr_read<16 * VP>(wb); wa[1][1] = tr_read<20 * VP>(wb);
            wa[2][0] = tr_read<32 * VP>(wb); wa[2][1] = tr_read<36 * VP>(wb); wa[3][0] = tr_read<48 * VP>(wb); wa[3][1] = tr_read<52 * VP>(wb);
            asm volatile("s_waitcnt lgkmcnt(0)" ::: "memory"); __builtin_amdgcn_sched_barrier(0);
#pragma unroll
            for (int e = 0; e < 16; ++e) cacc[e] *= decay;
#pragma unroll
            for (int ks = 0; ks < 4; ++ks) { const bf16x8 fa = (bf16x8){ka[ks][0][0], ka[ks][0][1], ka[ks][0][2], ka[ks][0][3], ka[ks][1][0], ka[ks][1][1], ka[ks][1][2], ka[ks][1][3]};
                const bf16x8 fb = (bf16x8){wa[ks][0][0], wa[ks][0][1], wa[ks][0][2], wa[ks][0][3], wa[ks][1][0], wa[ks][1][1], wa[ks][1][2], wa[ks][1][3]};
                cacc = __builtin_amdgcn_mfma_f32_32x32x16_bf16(fa, fb, cacc, 0, 0, 0); } }
        { const int d_ = tid & 127, part_ = tid >> 7; float acc = 0.f;
#pragma unroll
            for (int s = 0; s < 16; ++s) acc += wl[16 * part_ + s] * bf2f(*(const LAS bf16_t*)(lds + OFF_K + (16 * part_ + s) * QP + d_ * 2));
            ((LAS float*)(lds + LDS_CONST))[part_ * 128 + d_] = acc; }
        if (ck < 24) { PREP_WRITE(); if (ck + 1 < 24) PREP_LOAD(ck + 1); }
        __syncthreads();
        if (ck < 24) PREP_STORE(ck);
        { const int tr0 = 16 * tt + 4 * g;
          const f32x4 gam4 = *(const LAS f32x4*)(gam + c0 + tr0), gb4 = *(const LAS f32x4*)(gb + c0 + tr0), rs4 = *(const LAS f32x4*)(rsl + tr0), qn4 = *(const LAS f32x4*)(qnl + tr0);
          bf16_t* hp = hs_out + (size_t)(c0 + tr0) * hs_stride;
#pragma unroll
          for (int r = 0; r < 4; ++r) { const float Mr = fmaxf(mprev, gam4[r]); const float inter = __expf(mprev - Mr), mt = gb4[r] + Mr;
            const float den = rs4[r] + inter * qn4[r]; const float dd = __builtin_amdgcn_rcpf(fmaxf(fabsf(den), __expf(-mt)));
#pragma unroll
            for (int vt = 0; vt < 2; ++vt) { const float hv = (av[vt][r] + inter * qc[vt][r]) * dd; hp[(size_t)r * hs_stride + 16 * vt] = f2bf(hv); } } }
#pragma unroll
        for (int e = 0; e < 16; ++e) { const int d = 32 * dt + (e & 3) + 8 * (e >> 2) + 4 * hi; *(LAS bf16_t*)(lds + OFF_CB + d * VP + (32 * vt2 + r32) * 2) = f2bf(cacc[e]); }
        if (tid < 128) { const LAS float* np_ = (const LAS float*)(lds + LDS_CONST); nreg = decay * nreg + ((np_[tid] + np_[128 + tid]) + (np_[256 + tid] + np_[384 + tid])); nl[tid] = nreg; }
        if (ck + 1 < 32) ML_STORE(ck + 1);
        __syncthreads();
    }
#undef ML_LOAD
#undef ML_STORE
#undef PREP_LOAD
#undef PREP_WRITE
#undef PREP_STORE
}

__device__ __forceinline__ void phase_ml_gate(const Params& p, const Frame& F, unsigned char* a8) {
    const int step = F.G * 8;
#pragma unroll 1
    for (int gw = F.bid * 8 + F.wave; gw < T * 4; gw += 4 * step) { uint2 hv2[4], ov2[4];
#pragma unroll
        for (int k = 0; k < 4; ++k) { const int g_ = gw + k * step; const bf16_t* pr = p.proj + (size_t)(g_ >> 2) * 3072 + (g_ & 3) * 256 + 4 * F.lane; hv2[k] = *(const uint2*)(pr + 1024); ov2[k] = *(const uint2*)(pr + 2048); }
#pragma unroll
        for (int k = 0; k < 4; ++k) { const int g_ = gw + k * step, t = g_ >> 2, h = g_ & 3; const float4 g4 = *(const float4*)(p.ml_ng + h * 256 + 4 * F.lane);
            const float h0 = __uint_as_float(hv2[k].x << 16), h1 = __uint_as_float(hv2[k].x & 0xFFFF0000u), h2 = __uint_as_float(hv2[k].y << 16), h3 = __uint_as_float(hv2[k].y & 0xFFFF0000u);
            float ss = h0 * h0 + h1 * h1 + h2 * h2 + h3 * h3; ss = wave_sum(ss); const float rs = rsqrtf(ss * (1.f / 256.f) + 1e-6f) * F8_SA;
            *(unsigned*)(a8 + (size_t)t * D + h * 256 + 4 * F.lane) = pk4_fp8(__uint_as_float(ov2[k].x << 16) * h0 * rs * g4.x, __uint_as_float(ov2[k].x & 0xFFFF0000u) * h1 * rs * g4.y, __uint_as_float(ov2[k].y << 16) * h2 * rs * g4.z, __uint_as_float(ov2[k].y & 0xFFFF0000u) * h3 * rs * g4.w); } }
}
__device__ __forceinline__ void phase_final(const Params& p, const Frame& F, float* dst) {
    const float* mg = p.mod + (size_t)16 * 6144 + 5 * D;
    for (size_t i4 = (size_t)F.bid * NTHR + F.tid; i4 < (size_t)T * D / 4; i4 += (size_t)F.G * NTHR) { const size_t i = i4 * 4; const int col = (int)(i % D), row = (int)(i / D), b = row / S;
        const uint2 xw = *(const uint2*)(p.xb13 + i); const float4 xv = make_float4(__uint_as_float(xw.x << 16), __uint_as_float(xw.x & 0xFFFF0000u), __uint_as_float(xw.y << 16), __uint_as_float(xw.y & 0xFFFF0000u)); float4 g = *(const float4*)(mg + b * 6144 + col); g.x *= 1.f / F8_SO; g.y *= 1.f / F8_SO; g.z *= 1.f / F8_SO; g.w *= 1.f / F8_SO; const unsigned a0 = *(const unsigned*)((const unsigned char*)p.outk + i), a1 = *(const unsigned*)((const unsigned char*)p.outk + (size_t)T * D + i);
        float4 o; o.x = xv.x + g.x * (fp8f(a0, 0) + fp8f(a1, 0)); o.y = xv.y + g.y * (fp8f(a0, 1) + fp8f(a1, 1));
        o.z = xv.z + g.z * (fp8f(a0, 2) + fp8f(a1, 2)); o.w = xv.w + g.w * (fp8f(a0, 3) + fp8f(a1, 3));
        *(float4*)(dst + i) = o; }
}

__global__ void __launch_bounds__(NTHR, 2) mega_fwd(Params p) {
    extern __shared__ __attribute__((aligned(16))) unsigned char lds_raw[];
    Frame F; F.lds = (LAS unsigned char*)lds_raw; F.tid = threadIdx.x; F.lane = F.tid & 63; F.wave = __builtin_amdgcn_readfirstlane(F.tid >> 6); F.bid = blockIdx.x; F.G = gridDim.x;
    volatile LAS unsigned* misc = (volatile LAS unsigned*)(F.lds + LDS_MISC);
    LAS Params* P = (LAS Params*)(F.lds + LDS_PARAMS);
    if (F.tid < 16) misc[F.tid] = 0u;
    if (F.tid == 64) {
#define X(t, n) P->n = p.n;
        PARAM_LIST(X)
#undef X
    }
    __syncthreads();
    { XcdBarrier b0 = xcd_barrier_post(uni_ptr(P->bar), misc); if (F.tid == 0) misc[2] = b0.x; }
    __syncthreads();
#define GRID_BAR() do { XcdBarrier bb_; bb_.bar = uni_ptr(P->bar); bb_.x = (unsigned)__builtin_amdgcn_readfirstlane((int)misc[2]); bb_.st = misc; xcd_barrier(bb_, F.wave == 0 && lane_id_asm() == 0); } while (0)
    LAS unsigned char* stage = F.lds;
#define MOD0 (q.mod)
#define MOD1 (q.mod + (size_t)16 * 6144)

    { Params q; LP(rope); LP(h); phase_prologue_a(q, launder(F)); }
    { Params q; LP(c); LP(ada_w); LP(ada_b); LP(mod); LP(cmp_pe); LP(cmp_w1); LP(cmp_b1); LP(cb1); phase_prologue_b(q, launder(F)); }
    { Params q; LP(nsa_w_in); LP(win_nsa_t); prep_weights<true>(launder(F), q.win_nsa_t, 2048, D, NSA_COLS, ColPlain{q.nsa_w_in, NSA_COLS, 0}, F.bid, F.G, F8_SW); }
    { Params q; LP(nsa_w_out); LP(wo_nsa_t); prep_weights<true>(launder(F), q.wo_nsa_t, D, D, D, ColPlain{q.nsa_w_out, D, 0}, F.bid, F.G, F8_SW); }
    { Params q; LP(ml_w_in); LP(win_ml_t); prep_weights<true>(launder(F), q.win_ml_t, 3072, D, ML_COLS, ColPlain{q.ml_w_in, 3072, 0}, F.bid, F.G, F8_SW); }
    { Params q; LP(ml_w_out); LP(wo_ml_t); prep_weights<true>(launder(F), q.wo_ml_t, D, D, D, ColPlain{q.ml_w_out, D, 0}, F.bid, F.G, F8_SW); }
    { Params q; LP(cmp_w1); LP(w1c_t); prep_weights(launder(F), q.w1c_t, 256, 2048, 256, ColPlain{q.cmp_w1, 256, 0}, F.bid, F.G);
      prep_weights(launder(F), q.w1c_t + (size_t)256 * 2048, 256, 2048, 256, ColPlain{q.cmp_w1 + (size_t)2048 * 256, 256, 0}, F.bid, F.G); }
    { Params q; LP(w_gate); LP(w_up); LP(w_down); LP(gu_t); LP(dn_t); prep_moe_weights(q, launder(F), 0, F.bid, F.G); }
    GRID_BAR();
    { Params q; LP(x); LP(g_mix); LP(mod); LP(h);
      phase_norm<0, false>(q, launder(F), q.x, nullptr, q.g_mix, MOD0 + 0 * D, MOD0 + 1 * D, nullptr, 0); }
    GRID_BAR();
    { Params q; LP(h); LP(win_nsa_t); LP(q_gain); LP(k_gain); LP(rope); LP(q); LP(kv); LP(gates);
      ge::DenseOrder So; So.init(T, 2048, F.G, F.bid);
      ge::gemm_phase<true>(stage, q.h, q.win_nsa_t, D, So, ge::DenseRows{(unsigned)D}, EpiNsaIn{q.q_gain, q.k_gain, q.rope, q.q, q.kv, q.gates, 1.f / (F8_SA * F8_SW)}, F.wave); }
    GRID_BAR();
    {
      Params q; LP(kv); LP(w1c_t); LP(cpart);
      const int w = F.bid >> 7, mt = (F.bid >> 3) & 15, ks = F.bid & 7; OneUnit So{mt};
      ge::gemm_phase(stage, q.kv + (size_t)w * T * 128 + ks * 256, q.w1c_t + (size_t)w * 256 * 2048 + ks * 256, 256, So, ge::DenseRows{2048u}, EpiCmpPart{q.cpart + (size_t)(w * 8 + ks) * 4096 * 256}, F.wave, 2048); }
    GRID_BAR();
    { Params q; LP(cpart); LP(cb1); LP(cmp_w2); LP(cmp_b2); LP(k_gain); LP(rope); LP(kcmp); LP(vcmp);
      phase_cmp2(q, launder(F)); }
    GRID_BAR();
    { Params q; LP(q); LP(kv); LP(kcmp); LP(vcmp); LP(gates); LP(h); LP(q_gain); LP(k_gain);
      phase_attn(q, launder(F)); }
    GRID_BAR();
    { Params q; LP(h); LP(wo_nsa_t); LP(x); LP(mod); LP(xb13);
      ge::DenseOrder So; So.init(T, D, F.G, F.bid);
      ge::gemm_phase<true>(stage, q.h, q.wo_nsa_t, D, So, ge::DenseRows{(unsigned)D}, EpiResid<false>{q.x, MOD0 + 2 * D, q.xb13, 1.f / (F8_SA * F8_SW)}, F.wave); }
    GRID_BAR();
    { Params q; LP(xb13); LP(g_ffn); LP(mod); LP(h); LP(router_w); LP(router_b); LP(tokw); LP(cnt); LP(list);
      phase_norm_route(q, launder(F), q.xb13, q.g_ffn, MOD0 + 3 * D, MOD0 + 4 * D, 0); }
    GRID_BAR();
    { Params q; LP(cnt); LP(list); LP(h); LP(gu_t); LP(hid);
      LAS int* mtab = (LAS int*)(F.lds + LDS_MISC + 64); LAS int* tkt = (LAS int*)(F.lds + LDS_CONST); moe_plan(launder(F), q.cnt, q.list, mtab, tkt, 4); MoeOrder So{mtab};
      ge::gemm_phase<true>(stage, q.h, q.gu_t, D, So, MoeRows{tkt}, EpiMoe1{(unsigned char*)q.hid, 1.f / (F8_SA * F8_SW)}, F.wave); }
    GRID_BAR();
    { Params q; LP(cnt); LP(list); LP(hid); LP(dn_t); LP(outk); LP(tokw);
      LAS int* mtab = (LAS int*)(F.lds + LDS_MISC + 64); LAS int* tkt = (LAS int*)(F.lds + LDS_CONST); LAS float* tkw = (LAS float*)(F.lds + 131072); moe_plan(launder(F), q.cnt, q.list, mtab, tkt, 4, q.tokw, tkw, F8_SO / (F8_SH * F8_SW2)); MoeOrder So{mtab};
      ge::gemm_phase<true>(stage, q.hid, q.dn_t, DE, So, ge::DenseRows{(unsigned)DE}, EpiMoe2{q.outk, tkt, tkw}, F.wave); }
    GRID_BAR();
    { Params q; LP(xb13); LP(xb2); LP(g_mix); LP(mod); LP(h); LP(outk); LP(ml_w_in); LP(ml_bi); LP(ml_bf); LP(li); LP(lf);
      phase_norm<2, true>(q, launder(F), q.xb13, q.xb2, q.g_mix + D, MOD1 + 0 * D, MOD1 + 1 * D, MOD0 + 5 * D, 1); }
    GRID_BAR();
    { Params q; LP(h); LP(win_ml_t); LP(proj);
      ge::DenseOrder So; So.init(T, 3072, F.G, F.bid);
      ge::gemm_phase<true>(stage, q.h, q.win_ml_t, D, So, ge::DenseRows{(unsigned)D}, EpiMlIn{q.proj, 1.f / (F8_SA * F8_SW)}, F.wave); }
    GRID_BAR();
    { Params q; LP(proj); LP(li); LP(lf); LP(w_gate); LP(w_up); LP(w_down); LP(gu_t); LP(dn_t);
      phase_scan(q, launder(F), q.proj + 1024, 3072); }
    GRID_BAR();
    { Params q; LP(proj); LP(ml_ng); LP(h);
      phase_ml_gate(q, launder(F), (unsigned char*)q.h); }
    GRID_BAR();
    { Params q; LP(h); LP(wo_ml_t); LP(xb2); LP(mod); LP(xb13);
      ge::DenseOrder So; So.init(T, D, F.G, F.bid);
      ge::gemm_phase<true>(stage, q.h, q.wo_ml_t, D, So, ge::DenseRows{(unsigned)D}, EpiResid<true>{q.xb2, MOD1 + 2 * D, q.xb13, 1.f / (F8_SA * F8_SW)}, F.wave); }
    GRID_BAR();
    { Params q; LP(xb13); LP(g_ffn); LP(mod); LP(h); LP(router_w); LP(router_b); LP(tokw); LP(cnt); LP(list);
      phase_norm_route(q, launder(F), q.xb13, q.g_ffn + D, MOD1 + 3 * D, MOD1 + 4 * D, 1); }
    GRID_BAR();
    { Params q; LP(cnt); LP(list); LP(h); LP(gu_t); LP(hid);
      LAS int* mtab = (LAS int*)(F.lds + LDS_MISC + 64); LAS int* tkt = (LAS int*)(F.lds + LDS_CONST); moe_plan(launder(F), q.cnt + 64, q.list, mtab, tkt, 4); MoeOrder So{mtab};
      ge::gemm_phase<true>(stage, q.h, q.gu_t, D, So, MoeRows{tkt}, EpiMoe1{(unsigned char*)q.hid, 1.f / (F8_SA * F8_SW)}, F.wave); }
    GRID_BAR();
    { Params q; LP(cnt); LP(list); LP(hid); LP(dn_t); LP(outk); LP(tokw);
      LAS int* mtab = (LAS int*)(F.lds + LDS_MISC + 64); LAS int* tkt = (LAS int*)(F.lds + LDS_CONST); LAS float* tkw = (LAS float*)(F.lds + 131072); moe_plan(launder(F), q.cnt + 64, q.list, mtab, tkt, 4, q.tokw, tkw, F8_SO / (F8_SH * F8_SW2)); MoeOrder So{mtab};
      ge::gemm_phase<true>(stage, q.hid, q.dn_t, DE, So, ge::DenseRows{(unsigned)DE}, EpiMoe2{q.outk, tkt, tkw}, F.wave); }
    GRID_BAR();
    { Params q; LP(mod); LP(out); LP(outk); LP(xb13);
      phase_final(q, launder(F), q.out); }
}

static inline size_t al(size_t x) { return (x + 255) & ~(size_t)255; }
extern "C" void kernel_launch(void* const* d_in, const int* in_sizes, int n_in, void* d_out, int out_size, void* d_ws, size_t ws_size, hipStream_t stream) {
    char* ws = (char*)d_ws; size_t off = 0;
    auto take = [&](size_t bytes) { size_t o = off; off = al(off + bytes); return o; };
    Params p{};
    const float** pin = (const float**)&p;
    for (int i = 0; i < 25; ++i) pin[i] = (const float*)d_in[i];
    p.out = (float*)d_out;
    const size_t ctl_bytes = (size_t)XCD_BAR_WORDS * 4 + 1024;
    p.bar = (unsigned*)(ws + take(ctl_bytes)); p.cnt = (int*)(p.bar + XCD_BAR_WORDS); p.dcnt = p.cnt + 128;
    p.mod = (float*)(ws + take((size_t)2 * 16 * 6144 * 4)); p.rope = (float*)(ws + take(2048 * 16 * 4)); p.cb1 = (float*)(ws + take(512 * 4));
    p.tokw = (float*)(ws + take((size_t)T * 2 * 4)); p.list = (int*)(ws + take((size_t)NE * T * 4)); p.dlist = (int*)(ws + take((size_t)NE * T * 4)); p.li = (float*)(ws + take((size_t)T * 4 * 4)); p.lf = (float*)(ws + take((size_t)T * 4 * 4));
    p.h = (bf16_t*)(ws + take((size_t)(T + 8) * D * 2)); p.hidc = (bf16_t*)(ws + take((size_t)2 * 4096 * 256 * 2)); p.xb13 = (bf16_t*)(ws + take((size_t)T * D * 2)); p.xb2 = (bf16_t*)(ws + take((size_t)T * D * 2));
    p.wo_nsa_t = (bf16_t*)(ws + take((size_t)D * D * 2)); p.wo_ml_t = (bf16_t*)(ws + take((size_t)D * D * 2));
    p.win_nsa_t = (bf16_t*)(ws + take((size_t)2048 * D * 2)); p.win_ml_t = (bf16_t*)(ws + take((size_t)3072 * D * 2)); p.w1c_t = (bf16_t*)(ws + take((size_t)2 * 256 * 2048 * 2));
    p.gu_t = (bf16_t*)(ws + take((size_t)NE * 1024 * D * 2)); p.dn_t = (bf16_t*)(ws + take((size_t)NE * D * DE * 2));
    const size_t r1 = off;
    p.q = (bf16_t*)(ws + take((size_t)T * D * 2)); p.kv = (bf16_t*)(ws + take((size_t)6 * T * 128 * 2 + (1 << 20)));
    p.gates = (float*)(ws + take((size_t)T * 48 * 4)); p.kcmp = (bf16_t*)(ws + take((size_t)32 * 128 * 64 * 2)); p.vcmp = (bf16_t*)(ws + take((size_t)32 * 128 * 64 * 2));
    p.cpart = (float*)(ws + take((size_t)2 * 8 * 4096 * 256 * 4));
    const size_t end_nsa = off; off = r1;
    p.proj = (bf16_t*)(ws + take((size_t)T * 3072 * 2)); const size_t end_ml = off; off = r1;
    p.hid = (bf16_t*)(ws + take((size_t)(65536 + 8192) * DE * 2)); p.outk = (bf16_t*)(ws + take((size_t)2 * T * D * 2)); const size_t end_moe = off;
    size_t need = end_nsa > end_ml ? end_nsa : end_ml; if (end_moe > need) need = end_moe;
    if (need > ws_size || n_in != 25) return;
    static bool attr_done = false;
    if (!attr_done) { (void)hipFuncSetAttribute((const void*)mega_fwd, hipFuncAttributeMaxDynamicSharedMemorySize, LDS_BYTES); attr_done = true; }
    (void)hipMemsetAsync(p.bar, 0, ctl_bytes, stream);
    hipLaunchKernelGGL(mega_fwd, dim3(NWG), dim3(NTHR), LDS_BYTES, stream, p);
}
```

```cpp
#include <hip/hip_runtime.h>
#include <stdint.h>

typedef unsigned short bf16_t;
__device__ __forceinline__ float bf2f(bf16_t v) { return __uint_as_float(((unsigned)v) << 16); }
typedef float f32x2_t __attribute__((ext_vector_type(2)));
__device__ __forceinline__ unsigned pk2g(float a, float b) { typedef __bf16 b2 __attribute__((ext_vector_type(2))); b2 r = __builtin_convertvector((f32x2_t){a, b}, b2); return __builtin_bit_cast(unsigned, r); }
__device__ __forceinline__ bf16_t f2bf(float f) { return (bf16_t)pk2g(f, f); }
__device__ __forceinline__ unsigned pk4_fp8(float a, float b, float c, float d) { int w = 0;
    w = __builtin_amdgcn_cvt_pk_fp8_f32(__builtin_amdgcn_fmed3f(a, -448.f, 448.f), __builtin_amdgcn_fmed3f(b, -448.f, 448.f), w, false);
    w = __builtin_amdgcn_cvt_pk_fp8_f32(__builtin_amdgcn_fmed3f(c, -448.f, 448.f), __builtin_amdgcn_fmed3f(d, -448.f, 448.f), w, true); return (unsigned)w; }

constexpr int Bn = 16, S = 2048, D = 1024, T = Bn * S;
constexpr int NSA_COLS = 1840, ML_COLS = 3080;
constexpr int NE = 32, DE = 512;
constexpr int NWG = 256, NTHR = 512;

template <int M> __device__ __forceinline__ float sx(float v) { return __int_as_float(__builtin_amdgcn_ds_swizzle(__float_as_int(v), (M << 10) | 0x1F)); }
template <int M> __device__ __forceinline__ unsigned sxu(unsigned v) { return (unsigned)__builtin_amdgcn_ds_swizzle((int)v, (M << 10) | 0x1F); }
__device__ __forceinline__ float sum32(float v) { const auto r = __builtin_amdgcn_permlane32_swap(__float_as_uint(v), __float_as_uint(v), false, false); return __uint_as_float(r[0]) + __uint_as_float(r[1]); }
__device__ __forceinline__ float max32(float v) { const auto r = __builtin_amdgcn_permlane32_swap(__float_as_uint(v), __float_as_uint(v), false, false); return fmaxf(__uint_as_float(r[0]), __uint_as_float(r[1])); }
__device__ __forceinline__ float other32(float v, bool hi) { const auto r = __builtin_amdgcn_permlane32_swap(__float_as_uint(v), __float_as_uint(v), false, false); return __uint_as_float(hi ? r[0] : r[1]); }
template <int CTRL> __device__ __forceinline__ float dppf(float v) { return __int_as_float(__builtin_amdgcn_update_dpp(0, __float_as_int(v), CTRL, 0xF, 0xF, true)); }
__device__ __forceinline__ float sum16(float v) { const auto r = __builtin_amdgcn_permlane16_swap(__float_as_uint(v), __float_as_uint(v), false, false); return __uint_as_float(r[0]) + __uint_as_float(r[1]); }
__device__ __forceinline__ float max16(float v) { const auto r = __builtin_amdgcn_permlane16_swap(__float_as_uint(v), __float_as_uint(v), false, false); return fmaxf(__uint_as_float(r[0]), __uint_as_float(r[1])); }
__device__ __forceinline__ float wave_sum(float v) { v += dppf<0xB1>(v); v += dppf<0x4E>(v); v += dppf<0x141>(v); v += dppf<0x140>(v); v = sum16(v); return sum32(v); }
__device__ __forceinline__ float wave_max(float v) { v = fmaxf(v, dppf<0xB1>(v)); v = fmaxf(v, dppf<0x4E>(v)); v = fmaxf(v, dppf<0x141>(v)); v = fmaxf(v, dppf<0x140>(v)); v = max16(v); return max32(v); }
__device__ __forceinline__ float rdlane(float v, int l) { return __int_as_float(__builtin_amdgcn_readlane(__float_as_int(v), l)); }
__device__ __forceinline__ float sigmoidf_(float x) { return 1.f / (1.f + expf(-x)); }
__device__ __forceinline__ float fsigmoid(float x) { return __builtin_amdgcn_rcpf(1.f + __builtin_amdgcn_exp2f(-1.4426950408889634f * x)); }
__device__ __forceinline__ float ftanh(float x) { return 1.f - 2.f * __builtin_amdgcn_rcpf(1.f + __builtin_amdgcn_exp2f(2.8853900817779268f * x)); }

#define XB_TMO      128
#define XB_XCNT(j)  (256  + 64 * (j))
#define XB_XSUB(j)  (1280 + 64 * (j))
#define XB_XGEN(j)  (2304 + 64 * (j))
#define XB_TOP      3328
#define XB_TOPGEN   3392
#define XCD_BAR_WORDS 3456
#define XB_SPIN_CAP (1u << 18)
#define LAS __attribute__((address_space(3)))
__device__ __forceinline__ unsigned xb_ld(unsigned* p)              { return __hip_atomic_load(p, __ATOMIC_RELAXED, __HIP_MEMORY_SCOPE_AGENT); }
__device__ __forceinline__ unsigned xb_add(unsigned* p, unsigned v) { return __hip_atomic_fetch_add(p, v, __ATOMIC_RELAXED, __HIP_MEMORY_SCOPE_AGENT); }
__device__ __forceinline__ unsigned xb_xcc_id() { return (unsigned)__builtin_amdgcn_s_getreg((3 << 11) | 20) & 0xFu; }
#define XB_SPIN(cond, bar) do { unsigned _sp = 0; while (cond) { __builtin_amdgcn_s_sleep(1); \
    if ((++_sp & 255u) == 0u) { if (xb_ld(&(bar)[XB_TMO])) break; if (_sp > XB_SPIN_CAP) { atomicAdd(&(bar)[XB_TMO], 1u); break; } } } } while (0)
struct XcdBarrier { unsigned* bar; unsigned x; volatile LAS unsigned* st; };
__device__ __forceinline__ XcdBarrier xcd_barrier_post(unsigned* bar, volatile LAS unsigned* st) {
    XcdBarrier b; b.bar = bar; b.x = xb_xcc_id(); b.st = st;
    if (threadIdx.x == 0) (void)xb_add(&bar[XB_XCNT(b.x)], 1u);
    return b;
}
__device__ __forceinline__ void xcd_barrier_complete(unsigned* bar, unsigned x, unsigned& nloc, unsigned& nx) {
    const unsigned G = gridDim.x * gridDim.y * gridDim.z;
    unsigned sum, cnt, mine, sp = 0u;
    for (;;) {
        sum = 0u; cnt = 0u; mine = 0u;
#pragma unroll
        for (unsigned j = 0; j < 16; ++j) { const unsigned c = xb_ld(&bar[XB_XCNT(j)]); sum += c; cnt += (c > 0u) ? 1u : 0u; mine = (j == x) ? c : mine; }
        if (sum == G) break;
        __builtin_amdgcn_s_sleep(1);
        if ((++sp & 255u) == 0u) { if (xb_ld(&bar[XB_TMO])) break; if (sp > XB_SPIN_CAP) { atomicAdd(&bar[XB_TMO], 1u); break; } }
    }
    nloc = mine > 0u ? mine : 1u; nx = cnt > 0u ? cnt : 1u;
}
__device__ __forceinline__ void xcd_barrier(const XcdBarrier& b, const bool leader  ) {
    asm volatile("s_waitcnt vmcnt(0)" ::: "memory");
    __syncthreads();
    if (leader) {
        unsigned* bar = b.bar;
        __builtin_amdgcn_s_waitcnt(0);
        unsigned nloc = b.st[0], nx = b.st[1];
        if (nloc == 0u) { xcd_barrier_complete(bar, b.x, nloc, nx); b.st[0] = nloc; b.st[1] = nx; }
        const unsigned old = xb_add(&bar[XB_XSUB(b.x)], 1u);
        const unsigned gen = old / nloc;
        if (old + 1u == (gen + 1u) * nloc) {
            __builtin_amdgcn_fence(__ATOMIC_RELEASE, "agent");
            asm volatile("s_waitcnt vmcnt(0)" ::: "memory");
            const unsigned og = xb_add(&bar[XB_TOP], 1u);
            const unsigned tg = og / nx;
            if (og + 1u == (tg + 1u) * nx) xb_add(&bar[XB_TOPGEN], 1u);
            else XB_SPIN(xb_ld(&bar[XB_TOPGEN]) == tg, bar);
            __builtin_amdgcn_fence(__ATOMIC_ACQUIRE, "agent");
            xb_add(&bar[XB_XGEN(b.x)], 1u);
            asm volatile("s_waitcnt vmcnt(0)" ::: "memory");
        } else {
            XB_SPIN(xb_ld(&bar[XB_XGEN(b.x)]) == gen, bar);
            __builtin_amdgcn_fence(__ATOMIC_ACQUIRE, "agent");
            asm volatile("s_waitcnt vmcnt(0)" ::: "memory");
        }
    }
    __syncthreads();
}

typedef short bf16x8 __attribute__((ext_vector_type(8)));
typedef float f32x4 __attribute__((ext_vector_type(4)));
namespace ge {
constexpr int BM = 256, BK = 64, HALF = 128, HTB = HALF * BK * 2, STAGE_BYTES = 8 * HTB;
__host__ __device__ __forceinline__ int lds_byte(int r, int c) { const int st = (r >> 4) * 2 + (c >> 5), rr = r & 15, cc = c & 31, ob = rr * 64 + cc * 2; return st * 1024 + (ob ^ (((ob >> 9) & 1) << 5)); }
__host__ __device__ __forceinline__ void stage_rc(int b, int& R, int& C) { const int st = b / 1024, sb = b % 1024, swz = sb ^ (((sb >> 9) & 1) << 5); R = (st >> 1) * 16 + swz / 64; C = (st & 1) * 32 + (swz % 64) / 2; }
struct Unit { int pm, pn, bt, aux; };
__host__ __device__ __forceinline__ int logical_col(int c) { const int pn = c >> 8, bj = (c >> 7) & 1, wc = (c >> 5) & 3, n = (c >> 4) & 1, fq = (c >> 2) & 3, j = c & 3; return (4 * pn + wc) * 64 + 16 * fq + 8 * bj + 4 * n + j; }
struct DenseOrder {
    int nM, nN, nwg, G, c;
    __device__ void init(int M, int N, int G_, int c_) { nM = M / BM; nN = N / BM; nwg = nM * nN; G = G_; c = c_; }
    __device__ bool next(int i, Unit& u) const {
        const long L = (long)i * G + c; if (L >= nwg) return false;
        int wgid = (int)L; { const int q = nwg / 8, r = nwg % 8, xcd = wgid % 8, off = wgid / 8; wgid = (xcd < r ? xcd * (q + 1) : r * (q + 1) + (xcd - r) * q) + off; }
        const int nig = 8 * nN, gid = wgid / nig, fm = gid * 8, gsz = (nM - fm) < 8 ? (nM - fm) : 8;
        u.pm = fm + ((wgid % nig) % gsz); u.pn = (wgid % nig) / gsz; u.bt = u.pn; u.aux = 0; return true;
    }
};
struct DenseRows { static constexpr bool dense = true; unsigned ldab; __device__ __forceinline__ unsigned operator()(const Unit& u, int r) const { return (unsigned)(u.pm * 256 + r) * ldab; } };
template <class Tp> __device__ __forceinline__ Tp* uni(Tp* v) { const unsigned long long u = (unsigned long long)v; const unsigned lo = __builtin_amdgcn_readfirstlane((unsigned)u), hi = __builtin_amdgcn_readfirstlane((unsigned)(u >> 32)); return (Tp*)(((unsigned long long)hi << 32) | lo); }

typedef int i32x8 __attribute__((ext_vector_type(8)));
typedef int i32x4 __attribute__((ext_vector_type(4)));
template <bool F8> struct Frag;
template <> struct Frag<false> { bf16x8 v[2]; };
template <> struct Frag<true> { i32x8 v; };
template <bool F8> __device__ __forceinline__ void load_frag(Frag<F8>& f, const LAS unsigned char* p0) {
    if constexpr (F8) { const i32x4 lo = *(const LAS i32x4*)p0, hi = *(const LAS i32x4*)(p0 + 16); f.v = __builtin_shufflevector(lo, hi, 0, 1, 2, 3, 4, 5, 6, 7); }
    else { f.v[0] = *(const LAS bf16x8*)p0; f.v[1] = *(const LAS bf16x8*)(p0 + 1024); }
}
template <bool F8> __device__ __forceinline__ f32x4 mma_kt(const Frag<F8>& b, const Frag<F8>& a, f32x4 c) {
    if constexpr (F8) return __builtin_amdgcn_mfma_scale_f32_16x16x128_f8f6f4(b.v, a.v, c, 0, 0, 0, 0x7F7F7F7F, 0, 0x7F7F7F7F);
    else { c = __builtin_amdgcn_mfma_f32_16x16x32_bf16(b.v[0], a.v[0], c, 0, 0, 0); return __builtin_amdgcn_mfma_f32_16x16x32_bf16(b.v[1], a.v[1], c, 0, 0, 0); }
}
template <bool F8 = false, class Sched, class RowMap, class Epi>
__device__ __forceinline__ void gemm_phase(LAS unsigned char* lds, const void* A, const void* Bt, const int K, const Sched& S, const RowMap& RM, const Epi& E, const int wave_id, const int ldb_ = 0  ) {
    int tid_; asm volatile("v_mbcnt_lo_u32_b32 %0, -1, 0\n\tv_mbcnt_hi_u32_b32 %0, -1, %0" : "=v"(tid_)); tid_ += wave_id * 64;
    const int tid = tid_, wid = __builtin_amdgcn_readfirstlane(tid >> 6), lane = tid & 63, wr = wid >> 2, wc = wid & 3, fr = lane & 15, fq = lane >> 4;
    const int nt = K / (F8 ? 2 * BK : BK);
    constexpr bool DR = RowMap::dense;
    int sR[2], sC[2];
    const int ldb = ldb_ ? ldb_ : K;
#pragma unroll
    for (int i = 0; i < 2; ++i) stage_rc(tid * 16 + i * 8192, sR[i], sC[i]);
    const unsigned voffB = F8 ? (unsigned)(sR[0] * ldb + sC[0] * 2) : (unsigned)(sR[0] * ldb + sC[0]) * 2u;
    unsigned ldab_ = 0, voffA = 0; if constexpr (DR) { ldab_ = RM.ldab; voffA = (unsigned)sR[0] * ldab_ + (unsigned)sC[0] * 2u; }
    const size_t kstep = (size_t)(BK * 2), hstepB = (size_t)HALF * ldb * (F8 ? 1 : 2), tstepB = 2 * hstepB, qstepB = hstepB / 2;
    const unsigned ldsw = (unsigned)wid * 1024u;
    const int aoff = lds_byte(wr * 64 + fr, fq * (F8 ? 16 : 8)), boff = lds_byte(wc * 32 + fr, fq * (F8 ? 16 : 8));
    const char* Ab = (const char*)A;
#define GE_SA(b, h) (((b) * 2 + (h)) * ge::HTB)
#define GE_SB(b, h) ((4 + (b) * 2 + (h)) * ge::HTB)
#define GE_GLD(sp, vo, ldsoff) do { unsigned _v = (vo); asm volatile("" : "+v"(_v));     \
        __builtin_amdgcn_global_load_lds((const unsigned*)(uni((const char*)(sp)) + _v), (LAS unsigned*)(lds + (ldsoff)), 16, 0, 0); } while (0)
#define GE_STB(bufoff, gbase) do { _Pragma("unroll") for (int _i = 0; _i < 2; ++_i) GE_GLD((gbase) + _i * qstepB, voffB, (bufoff) + ldsw + _i * 8192); } while (0)
#define GE_STA(bufoff, sp, OFF, h) do { _Pragma("unroll") for (int _i = 0; _i < 2; ++_i) { \
        if constexpr (DR) GE_GLD((sp) + (size_t)((h) * 128 + _i * 64) * ldab_, voffA, (bufoff) + ldsw + _i * 8192); \
        else GE_GLD((sp), (OFF)[h][_i], (bufoff) + ldsw + _i * 8192); } } while (0)
#define GE_LDA(dst, b, h) do { _Pragma("unroll") for (int m = 0; m < 4; ++m) load_frag<F8>(dst[m], lds + GE_SA(b, h) + aoff + m * 2048); } while (0)
#define GE_LDB(dst, b, h) do { _Pragma("unroll") for (int n = 0; n < 2; ++n) load_frag<F8>(dst[n], lds + GE_SB(b, h) + boff + n * 2048); } while (0)
#define GE_MMA(ai, bj, At, Bt_) do { __builtin_amdgcn_s_setprio(1); _Pragma("unroll") for (int m = 0; m < 4; ++m) _Pragma("unroll") for (int n = 0; n < 2; ++n) \
        acc[ai][bj][m][n] = mma_kt<F8>(Bt_[n], At[m], acc[ai][bj][m][n]); __builtin_amdgcn_s_setprio(0); } while (0)
#define GE_WAIT_V(n) asm volatile("s_waitcnt vmcnt(" #n ")" ::: "memory")
#define GE_WAIT_L(n) asm volatile("s_waitcnt lgkmcnt(" #n ")" ::: "memory")
#define GE_BAR __builtin_amdgcn_s_barrier()
#define GE_SCHED __builtin_amdgcn_sched_barrier(0)
#define GE_OFFS(OFF, u) do { int _l; asm volatile("v_mbcnt_lo_u32_b32 %0, -1, 0\n\tv_mbcnt_hi_u32_b32 %0, -1, %0" : "=v"(_l)); int _r0, _c0; stage_rc((wave_id * 64 + _l) * 16, _r0, _c0);     \
        _Pragma("unroll") for (int _h = 0; _h < 2; ++_h) _Pragma("unroll") for (int _i = 0; _i < 2; ++_i) (OFF)[_h][_i] = RM((u), _h * 128 + _i * 64 + _r0) + (unsigned)_c0 * 2u; \
        asm volatile("" : "+v"((OFF)[0][0]), "+v"((OFF)[0][1]), "+v"((OFF)[1][0]), "+v"((OFF)[1][1])); } while (0)
    Unit cur, nxt; int ui = 0;
    if (!S.next(0, cur)) return;
    unsigned offC[2][2];
    const char* aC = Ab; const char* aN = Ab;
    if constexpr (DR) aC = Ab + (size_t)cur.pm * 256 * ldab_; else GE_OFFS(offC, cur);
    f32x4 acc[2][2][4][2];
#pragma unroll
    for (int a = 0; a < 2; ++a)
#pragma unroll
        for (int b = 0; b < 2; ++b)
#pragma unroll
            for (int m = 0; m < 4; ++m)
#pragma unroll
                for (int n = 0; n < 2; ++n) acc[a][b][m][n] = (f32x4){0.f, 0.f, 0.f, 0.f};
    Frag<F8> At[4], B0[2], B1[2];
    const char* cB = (const char*)Bt + (size_t)cur.bt * tstepB;
    GE_STB(GE_SB(0, 0), cB); GE_STA(GE_SA(0, 0), aC, offC, 0); GE_STB(GE_SB(0, 1), cB + hstepB); GE_STA(GE_SA(0, 1), aC, offC, 1);
    if (wr == 1) GE_BAR;
    GE_WAIT_V(4); GE_BAR;
    GE_STB(GE_SB(1, 0), cB + kstep); GE_STA(GE_SA(1, 0), aC + kstep, offC, 0); GE_STB(GE_SB(1, 1), cB + hstepB + kstep);
    GE_WAIT_V(6); GE_BAR;
    for (;;) {
        const bool has_next = S.next(ui + 1, nxt);
        if constexpr (DR) aN = has_next ? Ab + (size_t)nxt.pm * 256 * ldab_ : aC;
        const char* nB = has_next ? (const char*)Bt + (size_t)nxt.bt * tstepB : cB;
#pragma unroll 1
        for (int t = 0; t < nt; t += 2) {
            const bool last = (t == nt - 2);
            const size_t k1 = (size_t)(t + 1) * kstep;
            const size_t k2 = last ? 0 : (size_t)(t + 2) * kstep, k3 = k2 + kstep;
            const char* b2 = last ? nB : cB + (size_t)(t + 2) * kstep; const char* b3 = b2 + kstep;
            const char* a2 = last ? aN : aC;
            GE_LDB(B0, 0, 0); GE_SCHED; GE_LDA(At, 0, 0); GE_STA(GE_SA(1, 1), aC + k1, offC, 1);
            GE_WAIT_L(8); GE_BAR; GE_WAIT_L(0); GE_MMA(0, 0, At, B0); GE_BAR; GE_SCHED;
            GE_LDB(B1, 0, 1); GE_STB(GE_SB(0, 0), b2);
            GE_BAR; GE_WAIT_L(0); GE_MMA(0, 1, At, B1); GE_BAR;
            GE_LDA(At, 0, 1);
            if constexpr (!DR) { if (last && has_next) GE_OFFS(offC, nxt); }
            GE_STA(GE_SA(0, 0), a2 + k2, offC, 0);
            GE_BAR; GE_WAIT_L(0); GE_MMA(1, 0, At, B0); GE_BAR; GE_SCHED;
            GE_STB(GE_SB(0, 1), b2 + hstepB);
            GE_WAIT_V(6); GE_BAR; GE_MMA(1, 1, At, B1); GE_BAR;
            GE_LDB(B0, 1, 0); GE_SCHED; GE_LDA(At, 1, 0); GE_STA(GE_SA(0, 1), a2 + k2, offC, 1);
            GE_WAIT_L(8); GE_BAR; GE_WAIT_L(0); GE_MMA(0, 0, At, B0); GE_BAR; GE_SCHED;
            GE_LDB(B1, 1, 1); GE_STB(GE_SB(1, 0), b3);
            GE_BAR; GE_WAIT_L(0); GE_MMA(0, 1, At, B1); GE_BAR;
            GE_LDA(At, 1, 1); GE_STA(GE_SA(1, 0), a2 + k3, offC, 0);
            GE_BAR; GE_WAIT_L(0); GE_MMA(1, 0, At, B0); GE_BAR; GE_SCHED;
            GE_STB(GE_SB(1, 1), b3 + hstepB);
            GE_WAIT_V(6); GE_BAR; GE_MMA(1, 1, At, B1); GE_BAR;
        }
#pragma unroll
        for (int a = 0; a < 2; ++a)
#pragma unroll
            for (int b = 0; b < 2; ++b) asm volatile("" : "+v"(acc[a][b][0][0]), "+v"(acc[a][b][0][1]), "+v"(acc[a][b][1][0]), "+v"(acc[a][b][1][1]), "+v"(acc[a][b][2][0]), "+v"(acc[a][b][2][1]), "+v"(acc[a][b][3][0]), "+v"(acc[a][b][3][1]));
        { int l2; asm volatile("v_mbcnt_lo_u32_b32 %0, -1, 0\n\tv_mbcnt_hi_u32_b32 %0, -1, %0" : "=v"(l2)); E(acc, cur, wr, wc, l2 & 15, l2 >> 4); }
        if (!has_next) break;
#pragma unroll
        for (int a = 0; a < 2; ++a)
#pragma unroll
            for (int b = 0; b < 2; ++b)
#pragma unroll
                for (int m = 0; m < 4; ++m)
#pragma unroll
                    for (int n = 0; n < 2; ++n) acc[a][b][m][n] = (f32x4){0.f, 0.f, 0.f, 0.f};
        cur = nxt; cB = nB; aC = aN; ++ui;
    }
    GE_WAIT_V(0);
    if (wr == 0) GE_BAR;
    GE_BAR;
}
#define GE_VALS(v, acc, ai, m) do { _Pragma("unroll") for (int _b = 0; _b < 2; ++_b) _Pragma("unroll") for (int _n = 0; _n < 2; ++_n) _Pragma("unroll") for (int _j = 0; _j < 4; ++_j) (v)[8 * _b + 4 * _n + _j] = (acc)[ai][_b][m][_n][_j]; } while (0)
}
__device__ __forceinline__ void store16_bf16(bf16_t* dst, const float (&v)[16]) {
    unsigned w[8];
#pragma unroll
    for (int i = 0; i < 8; ++i) w[i] = pk2g(v[2 * i], v[2 * i + 1]);
    uint4* d4 = (uint4*)dst; d4[0] = make_uint4(w[0], w[1], w[2], w[3]); d4[1] = make_uint4(w[4], w[5], w[6], w[7]);
}
template <bool IN_BF16>
struct EpiResid { const void* xin; const float* mod_g; bf16_t* xout; float inscale;
    __device__ __forceinline__ void operator()(const f32x4 (&acc)[2][2][4][2], const ge::Unit& u, int wr, int wc, int fr, int fq) const {
        const int col0 = (4 * u.pn + wc) * 64 + 16 * fq; const int b = (u.pm * 256) / S;
        float4 gq[4];
#pragma unroll
        for (int q4 = 0; q4 < 4; ++q4) { gq[q4] = *(const float4*)(mod_g + b * 6144 + col0 + 4 * q4); gq[q4].x *= inscale; gq[q4].y *= inscale; gq[q4].z *= inscale; gq[q4].w *= inscale; }
        if constexpr (IN_BF16) {
            uint4 xh[2][4][2];
#pragma unroll
            for (int ai = 0; ai < 2; ++ai)
#pragma unroll
                for (int m = 0; m < 4; ++m) { const size_t o = (size_t)(u.pm * 256 + ai * 128 + wr * 64 + m * 16 + fr) * D + col0; xh[ai][m][0] = *(const uint4*)((const bf16_t*)xin + o); xh[ai][m][1] = *(const uint4*)((const bf16_t*)xin + o + 8); }
            const float g16[16] = {gq[0].x, gq[0].y, gq[0].z, gq[0].w, gq[1].x, gq[1].y, gq[1].z, gq[1].w, gq[2].x, gq[2].y, gq[2].z, gq[2].w, gq[3].x, gq[3].y, gq[3].z, gq[3].w};
#pragma unroll
            for (int ai = 0; ai < 2; ++ai)
#pragma unroll
                for (int m = 0; m < 4; ++m) { float v[16]; GE_VALS(v, acc, ai, m);
                    const unsigned w8[8] = {xh[ai][m][0].x, xh[ai][m][0].y, xh[ai][m][0].z, xh[ai][m][0].w, xh[ai][m][1].x, xh[ai][m][1].y, xh[ai][m][1].z, xh[ai][m][1].w};
#pragma unroll
                    for (int k = 0; k < 8; ++k) { v[2 * k] = __uint_as_float(w8[k] << 16) + g16[2 * k] * v[2 * k]; v[2 * k + 1] = __uint_as_float(w8[k] & 0xFFFF0000u) + g16[2 * k + 1] * v[2 * k + 1]; }
                    store16_bf16(xout + (size_t)(u.pm * 256 + ai * 128 + wr * 64 + m * 16 + fr) * D + col0, v); }
        } else {
#pragma unroll
        for (int ai = 0; ai < 2; ++ai) { float4 xv[4][4];
#pragma unroll
            for (int m = 0; m < 4; ++m) { const size_t o = (size_t)(u.pm * 256 + ai * 128 + wr * 64 + m * 16 + fr) * D + col0;
#pragma unroll
                for (int q4 = 0; q4 < 4; ++q4) xv[m][q4] = *(const float4*)((const float*)xin + o + 4 * q4); }
#pragma unroll
            for (int m = 0; m < 4; ++m) { float v[16]; GE_VALS(v, acc, ai, m); float xr[16];
#pragma unroll
                for (int q4 = 0; q4 < 4; ++q4) { xr[4 * q4] = xv[m][q4].x; xr[4 * q4 + 1] = xv[m][q4].y; xr[4 * q4 + 2] = xv[m][q4].z; xr[4 * q4 + 3] = xv[m][q4].w; }
                const float g16[16] = {gq[0].x, gq[0].y, gq[0].z, gq[0].w, gq[1].x, gq[1].y, gq[1].z, gq[1].w, gq[2].x, gq[2].y, gq[2].z, gq[2].w, gq[3].x, gq[3].y, gq[3].z, gq[3].w};
#pragma unroll
                for (int k = 0; k < 16; ++k) v[k] = xr[k] + g16[k] * v[k];
                store16_bf16(xout + (size_t)(u.pm * 256 + ai * 128 + wr * 64 + m * 16 + fr) * D + col0, v); } }
        }
    } };
struct EpiNsaIn { const float* q_gain; const float* k_gain; const float* rope; bf16_t* q; bf16_t* kv; float* gates; float inscale;
    __device__ __forceinline__ void operator()(const f32x4 (&acc)[2][2][4][2], const ge::Unit& u, int wr, int wc, int fr, int fq) const {
        const int slot = 4 * u.pn + wc; if (slot > 28) return;
        const bool normed = (slot < 16) || slot == 20 || slot == 21 || slot == 24 || slot == 25;
        const float* gain = (slot < 16) ? q_gain : ((slot < 22) ? k_gain + 64 : k_gain + 128);
        float gv[16];
        if (normed) {
#pragma unroll
            for (int i = 0; i < 16; ++i) gv[i] = gain[16 * fq + i]; }
#pragma unroll
        for (int ai = 0; ai < 2; ++ai)
#pragma unroll
            for (int m = 0; m < 4; ++m) { const int row = u.pm * 256 + ai * 128 + wr * 64 + m * 16 + fr; const int b = row / S, s = row % S; float v[16]; GE_VALS(v, acc, ai, m);
#pragma unroll
                for (int i = 0; i < 16; ++i) v[i] *= inscale;
                if (slot == 28) { if (fq < 3) { float* gp = gates + (size_t)row * 48 + 16 * fq;
#pragma unroll
                        for (int q4 = 0; q4 < 4; ++q4) *(float4*)(gp + 4 * q4) = make_float4(fsigmoid(v[4 * q4]), fsigmoid(v[4 * q4 + 1]), fsigmoid(v[4 * q4 + 2]), fsigmoid(v[4 * q4 + 3])); }
                    continue; }
                if (normed) { float ss = 0.f;
#pragma unroll
                    for (int i = 0; i < 16; ++i) ss += v[i] * v[i];
                    ss = sum16(ss); ss = sum32(ss); const float r = rsqrtf(ss * (1.f / 64.f) + 1e-6f);
#pragma unroll
                    for (int i = 0; i < 16; ++i) v[i] *= r * gv[i];
                    if (fq == 0) { const float sf = (float)s;
                        constexpr float IFR[8] = {0.15915494309189535f, 0.030863763158420102f, 0.00598518567638293f, 0.001160663620968869f, 0.00022507907904105153f, 4.364795481173399e-05f, 8.464330549652592e-06f, 1.6414262419538367e-06f};
#pragma unroll
                        for (int i = 0; i < 8; ++i) { const float rev = __builtin_amdgcn_fractf(sf * IFR[i]); const float cs = __builtin_amdgcn_cosf(rev), sn = __builtin_amdgcn_sinf(rev), a = v[i], bb = v[i + 8]; v[i] = a * cs - bb * sn; v[i + 8] = bb * cs + a * sn; } } }
                bf16_t* dst;
                if (slot < 16) dst = q + (size_t)row * D + slot * 64 + 16 * fq;
                else { const int kk = slot - 16, ten = kk >> 1, g = kk & 1; dst = kv + (size_t)ten * T * 128 + ((size_t)(b * 2 + g) * S + s) * 64 + 16 * fq; }
                store16_bf16(dst, v); }
    } };
struct EpiMlIn { bf16_t* proj; float inscale;
    __device__ __forceinline__ void operator()(const f32x4 (&acc)[2][2][4][2], const ge::Unit& u, int wr, int wc, int fr, int fq) const {
        const int slot = 4 * u.pn + wc; const int L0 = slot * 64 + 16 * fq;
#pragma unroll
        for (int ai = 0; ai < 2; ++ai)
#pragma unroll
            for (int m = 0; m < 4; ++m) { const int row = u.pm * 256 + ai * 128 + wr * 64 + m * 16 + fr; float v[16]; GE_VALS(v, acc, ai, m);
                { const float sc = (slot >= 8 && slot < 16) ? 0.08838834764831845f * inscale : inscale;
#pragma unroll
                    for (int i = 0; i < 16; ++i) v[i] *= sc; }
                if (slot >= 32) {
#pragma unroll
                    for (int i = 0; i < 16; ++i) v[i] = fsigmoid(v[i]) * 256.f;
                    *(uint4*)((unsigned char*)(proj + (size_t)row * 3072 + 2048) + (L0 - 2048)) = make_uint4(pk4_fp8(v[0], v[1], v[2], v[3]), pk4_fp8(v[4], v[5], v[6], v[7]), pk4_fp8(v[8], v[9], v[10], v[11]), pk4_fp8(v[12], v[13], v[14], v[15])); }
                else store16_bf16(proj + (size_t)row * 3072 + L0, v); }
    } };
struct OneUnit { int pm; __device__ bool next(int i, ge::Unit& u) const { if (i) return false; u.pm = pm; u.pn = 0; u.bt = 0; u.aux = 0; return true; } };
struct EpiCmpPart { float* part;
    __device__ __forceinline__ void operator()(const f32x4 (&acc)[2][2][4][2], const ge::Unit& u, int wr, int wc, int fr, int fq) const {
        const int L0 = (4 * u.pn + wc) * 64 + 16 * fq;
#pragma unroll
        for (int ai = 0; ai < 2; ++ai)
#pragma unroll
            for (int m = 0; m < 4; ++m) { const int row = u.pm * 256 + ai * 128 + wr * 64 + m * 16 + fr; float v[16]; GE_VALS(v, acc, ai, m); store16_bf16((bf16_t*)part + (size_t)row * 256 + L0, v); }
    } };
struct EpiCmp1 { const float* cb1; bf16_t* hid;
    __device__ __forceinline__ void operator()(const f32x4 (&acc)[2][2][4][2], const ge::Unit& u, int wr, int wc, int fr, int fq) const {
        const int L0 = (4 * u.pn + wc) * 64 + 16 * fq; float bv[16];
#pragma unroll
        for (int i = 0; i < 16; ++i) bv[i] = cb1[L0 + i];
#pragma unroll
        for (int ai = 0; ai < 2; ++ai)
#pragma unroll
            for (int m = 0; m < 4; ++m) { const int row = u.pm * 256 + ai * 128 + wr * 64 + m * 16 + fr; float v[16]; GE_VALS(v, acc, ai, m);
#pragma unroll
                for (int i = 0; i < 16; ++i) { const float x = v[i] + bv[i]; v[i] = 0.5f * x * (1.f + ftanh(0.7978845608028654f * (x + 0.044715f * x * x * x))); }
                store16_bf16(hid + (size_t)row * 256 + L0, v); }
    } };

#define PARAM_LIST(X) \
    X(const float*, x) X(const float*, c) X(const float*, ada_w) X(const float*, ada_b) X(const float*, g_mix) X(const float*, g_ffn) X(const float*, nsa_w_in) X(const float*, nsa_w_out) \
    X(const float*, q_gain) X(const float*, k_gain) X(const float*, cmp_pe) X(const float*, cmp_w1) X(const float*, cmp_b1) X(const float*, cmp_w2) X(const float*, cmp_b2) \
    X(const float*, ml_w_in) X(const float*, ml_bi) X(const float*, ml_bf) X(const float*, ml_ng) X(const float*, ml_w_out) X(const float*, router_w) X(const float*, router_b) \
    X(const float*, w_gate) X(const float*, w_up) X(const float*, w_down) \
    X(float*, out) X(unsigned*, bar) X(int*, cnt) X(float*, mod) X(float*, rope) X(float*, cb1) X(float*, tokw) X(int*, list) X(float*, li) X(float*, lf) \
    X(bf16_t*, h) X(bf16_t*, hidc) X(bf16_t*, xb13) X(bf16_t*, xb2) X(bf16_t*, wo_nsa_t) X(bf16_t*, wo_ml_t) X(bf16_t*, win_nsa_t) X(bf16_t*, win_ml_t) X(bf16_t*, w1c_t) X(bf16_t*, gu_t) X(bf16_t*, dn_t) \
    X(bf16_t*, q) X(bf16_t*, kv) X(float*, gates) X(bf16_t*, kcmp) X(bf16_t*, vcmp) X(bf16_t*, proj) X(bf16_t*, hid) X(bf16_t*, outk) X(int*, dcnt) X(int*, dlist) X(float*, cpart)
struct Params {
#define X(t, n) t n;
    PARAM_LIST(X)
#undef X
};
template <class Tp> __device__ __forceinline__ Tp* uni_ptr(Tp* v) { const unsigned long long u = (unsigned long long)v; const unsigned lo = __builtin_amdgcn_readfirstlane((unsigned)u), hi = __builtin_amdgcn_readfirstlane((unsigned)(u >> 32)); typedef Tp __attribute__((address_space(1))) * GP; return (Tp*)(GP)(((unsigned long long)hi << 32) | lo); }
#define LP(n) q.n = uni_ptr(P->n)
struct Frame { LAS unsigned char* lds; int tid, lane, wave, bid, G; };
__device__ __forceinline__ int lane_id_asm() { int l; asm volatile("v_mbcnt_lo_u32_b32 %0, -1, 0\n\tv_mbcnt_hi_u32_b32 %0, -1, %0" : "=v"(l)); return l; }
__device__ __forceinline__ Frame launder(const Frame& F) { Frame R = F; const int l = lane_id_asm(); int wv = F.wave, bd = F.bid; asm volatile("" : "+s"(wv), "+s"(bd)); R.wave = wv; R.bid = bd; R.tid = wv * 64 + l; R.lane = l; return R; }
constexpr int LDS_GEN = 143872;
constexpr int LDS_MISC = LDS_GEN;
constexpr int LDS_PARAMS = LDS_GEN + 4096;
constexpr int LDS_CONST = LDS_GEN + 6144;
constexpr int LDS_BYTES = LDS_GEN + 18432;

constexpr float F8_SA = 8.f, F8_SW = 32.f, F8_SH = 4.f, F8_SW2 = 32.f, F8_SO = 16.f;
__device__ __forceinline__ float fp8f(unsigned w, int i) { return i == 0 ? __builtin_amdgcn_cvt_f32_fp8((int)w, 0) : i == 1 ? __builtin_amdgcn_cvt_f32_fp8((int)w, 1) : i == 2 ? __builtin_amdgcn_cvt_f32_fp8((int)w, 2) : __builtin_amdgcn_cvt_f32_fp8((int)w, 3); }
template <int NB>
__device__ __forceinline__ void colgemv(const Frame& F, const LAS float* vec, LAS float* part, const float* W, int ldw, int K, int n0, const float* bias, float* out, int out_stride) {
    const int kper = K / 8, kb = F.wave * kper, c4 = F.lane & 15, kq = F.lane >> 4; float acc[NB][4];
#pragma unroll
    for (int b = 0; b < NB; ++b)
#pragma unroll
        for (int j = 0; j < 4; ++j) acc[b][j] = 0.f;
    const float* wp = W + (size_t)(kb + kq) * ldw + n0 + 4 * c4;
#pragma unroll 4
    for (int k = 0; k < kper; k += 4) { const float4 wv = *(const float4*)(wp + (size_t)k * ldw);
#pragma unroll
        for (int b = 0; b < NB; ++b) { const float x = vec[(kb + k + kq) * NB + b]; acc[b][0] += x * wv.x; acc[b][1] += x * wv.y; acc[b][2] += x * wv.z; acc[b][3] += x * wv.w; } }
#pragma unroll
    for (int b = 0; b < NB; ++b)
#pragma unroll
        for (int j = 0; j < 4; ++j) { const float t = sum32(sum16(acc[b][j])); if (kq == 0) part[(F.wave * NB + b) * 64 + 4 * c4 + j] = t; }
    __syncthreads();
    for (int idx = F.tid; idx < NB * 64; idx += NTHR) { const int b = idx >> 6, l = idx & 63; float s = bias[n0 + l];
#pragma unroll
        for (int w = 0; w < 8; ++w) s += part[(w * NB + b) * 64 + l];
        out[(size_t)b * out_stride + n0 + l] = s; }
    __syncthreads();
}
struct ColPlain { const float* W; int ncols; int pad; __device__ const float* operator()(int c) const { const int L = ge::logical_col(c); return L < ncols ? W + L : nullptr; } };
struct ColGateUp { const float* wg; const float* wu; __device__ const float* operator()(int c) const { const int e = c >> 10, cc = c & 1023; const int pn = cc >> 8, bj = (cc >> 7) & 1, wc = (cc >> 5) & 3, n = (cc >> 4) & 1, fq = (cc >> 2) & 3, j = cc & 3;
        const int hidx = 32 * (4 * pn + wc) + 8 * fq + 4 * n + j; const unsigned long long a = (unsigned long long)wg, d = (unsigned long long)wu - a;
        return (const float*)(a + (bj ? d : 0ull)) + (size_t)e * D * DE + hidx; } };
struct ColDown { const float* wd; __device__ const float* operator()(int c) const { const int e = c >> 10; return wd + (size_t)e * DE * D + ge::logical_col(c & 1023); } };
template <bool F8 = false, class ColF>
__device__ __forceinline__ void prep_weights(const Frame& F, void* Bt_, int N, int K, int ldw, const ColF cf, int start, int stride, const float wscale = 1.f) {
    bf16_t* Bt = (bf16_t*)Bt_;
    LAS float* tile = (LAS float*)(F.lds) + (F.tid >> 8) * (128 * 65);
    const int ntx = N / 64, ntiles = ntx * (K / 128), htid = F.tid & 255, half = F.tid >> 8;
    float r[32];
#define PW_LOAD(it_) do { const int tl_ = (it_) * 2 + half; if (tl_ < ntiles) { const int c0_ = (tl_ % ntx) * 64, k0_ = (tl_ / ntx) * 128; const float* p_ = cf(c0_ + (htid & 63)); \
        if (p_) { p_ += (size_t)(k0_ + (htid >> 6)) * ldw; _Pragma("unroll") for (int i_ = 0; i_ < 32; ++i_) r[i_] = p_[(size_t)(4 * i_) * ldw]; } \
        else { _Pragma("unroll") for (int i_ = 0; i_ < 32; ++i_) r[i_] = 0.f; } } } while (0)
    int it = start;
    if (it * 2 < ntiles) PW_LOAD(it);
    for (; it * 2 < ntiles; it += stride) {
        const int tl = it * 2 + half; const bool act = tl < ntiles; const int c0 = (tl % ntx) * 64, k0 = (tl / ntx) * 128;
        if (act) { const int cc = htid & 63;
#pragma unroll
            for (int i = 0; i < 32; ++i) tile[((htid >> 6) + 4 * i) * 65 + cc] = r[i]; }
        __syncthreads();
        if ((it + stride) * 2 < ntiles) PW_LOAD(it + stride);
        if (act) { const int cc = htid >> 2, ch = (htid & 3) * 32;
            if (F8) { unsigned w[8];
#pragma unroll
                for (int i = 0; i < 8; ++i) w[i] = pk4_fp8(tile[(ch + 4 * i) * 65 + cc] * wscale, tile[(ch + 4 * i + 1) * 65 + cc] * wscale, tile[(ch + 4 * i + 2) * 65 + cc] * wscale, tile[(ch + 4 * i + 3) * 65 + cc] * wscale);
                uint4* dst = (uint4*)((unsigned char*)Bt_ + (size_t)(c0 + cc) * K + k0 + ch); dst[0] = make_uint4(w[0], w[1], w[2], w[3]); dst[1] = make_uint4(w[4], w[5], w[6], w[7]); }
            else { unsigned w[16];
#pragma unroll
                for (int i = 0; i < 16; ++i) w[i] = pk2g(tile[(ch + 2 * i) * 65 + cc], tile[(ch + 2 * i + 1) * 65 + cc]);
                uint4* dst = (uint4*)(Bt + (size_t)(c0 + cc) * K + k0 + ch);
#pragma unroll
                for (int q4 = 0; q4 < 4; ++q4) dst[q4] = make_uint4(w[4 * q4], w[4 * q4 + 1], w[4 * q4 + 2], w[4 * q4 + 3]); } }
        __syncthreads();
    }
#undef PW_LOAD
}
__device__ __forceinline__ void prep_moe_weights(const Params& p, const Frame& F, int layer, int start, int stride) {
    const size_t wo = (size_t)layer * NE * D * DE;
    prep_weights<true>(F, p.gu_t, NE * 1024, D, DE, ColGateUp{p.w_gate + wo, p.w_up + wo}, start, stride, F8_SW);
    prep_weights<true>(F, p.dn_t, NE * 1024, DE, D, ColDown{p.w_down + wo}, start, stride, F8_SW2);
}

__device__ __forceinline__ void phase_prologue_a(const Params& p, const Frame& F) {
    for (int i = (F.bid - 200) * NTHR + F.tid; F.bid >= 200 && i < 2048 * 8; i += (F.G - 200) * NTHR) { const int pos = i >> 3, j = i & 7; const float inv = (float)pow(500000.0, -(double)j / 8.0); const float ang = (float)pos * inv;
        p.rope[pos * 16 + j] = (float)cos((double)ang); p.rope[pos * 16 + 8 + j] = (float)sin((double)ang); }
    if (F.bid == F.G - 1) for (int i = F.tid; i < 8 * D / 2; i += NTHR) ((unsigned*)(p.h + (size_t)T * D))[i] = 0u;
}
__device__ __forceinline__ void phase_prologue_b(const Params& p, const Frame& F) {
    LAS float* vec = (LAS float*)F.lds; LAS float* part = (LAS float*)(F.lds + 65536 + 16384);
    if (F.bid < 192) {
        for (int idx = F.tid; idx < 16 * D; idx += NTHR) { const int b = idx >> 10, k = idx & 1023; const float cv = p.c[idx]; vec[k * 16 + b] = cv / (1.f + expf(-cv)); }
        __syncthreads();
        const int i = F.bid / 96, n0 = (F.bid % 96) * 64;
        colgemv<16>(F, vec, part, p.ada_w + (size_t)i * D * 6144, 6144, D, n0, p.ada_b + i * 6144, p.mod + (size_t)i * 16 * 6144, 6144);
    } else if (F.bid < 200) {
        const int it = F.bid - 192, w = it >> 2, n0 = (it & 3) * 64;
        for (int idx = F.tid; idx < 2048; idx += NTHR) vec[idx] = p.cmp_pe[w * 2048 + idx];
        __syncthreads();
        colgemv<1>(F, vec, part, p.cmp_w1 + (size_t)w * 2048 * 256, 256, 2048, n0, p.cmp_b1 + w * 256, p.cb1 + w * 256, 0);
    }
    __syncthreads();
}

template <int MODE, bool XBF>
__device__ __forceinline__ void phase_norm(const Params& p, const Frame& F, const void* xin_, bf16_t* xout, const float* gain, const float* mod_sh, const float* mod_sc, const float* mod_gprev, int layer) {
    constexpr int rows_per_wg = T / NWG, rpw = rows_per_wg / 8;
    constexpr int TP = (MODE == 1) ? 34 : 10;
    const int row0 = F.bid * rows_per_wg;
    LAS float* rw = (LAS float*)F.lds;
    LAS int* lcnt = (LAS int*)(F.lds + LDS_MISC + 64); LAS int* gbase = lcnt + 32; LAS int* ent = gbase + 32;
    if (MODE == 1) { for (int idx = F.tid; idx < D * NE; idx += NTHR) { const int c = idx >> 5; rw[((c & 3) * 256 + (c >> 2)) * TP + (idx & 31)] = p.router_w[idx]; } if (F.tid < 32) lcnt[F.tid] = 0; }
    if (MODE == 2) { for (int idx = F.tid; idx < D * 8; idx += NTHR) { const int c = idx >> 3; rw[((c & 3) * 256 + (c >> 2)) * TP + (idx & 7)] = p.ml_w_in[(size_t)c * ML_COLS + 3072 + (idx & 7)]; } }
    const int b = row0 / S;
    LAS float* cg = (LAS float*)(F.lds + LDS_CONST); LAS float* csh = cg + D; LAS float* cgp = csh + D;
    for (int col = F.tid; col < D; col += NTHR) { cg[col] = gain[col] * (1.f + mod_sc[b * 6144 + col]); csh[col] = mod_sh[b * 6144 + col]; if (MODE == 2) cgp[col] = mod_gprev[b * 6144 + col] * (1.f / F8_SO); }
    __syncthreads();
    const int rbase = row0 + F.wave * rpw;
    float4 xn[4]; unsigned on0[4], on1[4];
#define NORM_LOAD(r_) do { if (XBF) { const bf16_t* xr_ = (const bf16_t*)xin_ + (size_t)(r_) * D + 4 * F.lane; _Pragma("unroll") for (int j_ = 0; j_ < 4; ++j_) { const uint2 t_ = *(const uint2*)(xr_ + 256 * j_); \
            xn[j_] = make_float4(__uint_as_float(t_.x << 16), __uint_as_float(t_.x & 0xFFFF0000u), __uint_as_float(t_.y << 16), __uint_as_float(t_.y & 0xFFFF0000u)); } } \
        else { const float* xr_ = (const float*)xin_ + (size_t)(r_) * D + 4 * F.lane; _Pragma("unroll") for (int j_ = 0; j_ < 4; ++j_) xn[j_] = *(const float4*)(xr_ + 256 * j_); } \
        if (MODE == 2) { const unsigned char* o0_ = (const unsigned char*)p.outk + (size_t)(r_) * D + 4 * F.lane; _Pragma("unroll") for (int j_ = 0; j_ < 4; ++j_) { on0[j_] = *(const unsigned*)(o0_ + 256 * j_); on1[j_] = *(const unsigned*)(o0_ + (size_t)T * D + 256 * j_); } } } while (0)
    NORM_LOAD(rbase);
#pragma unroll 1
    for (int ri = 0; ri < rpw; ++ri) {
        const int row = rbase + ri; float v[16];
#pragma unroll
        for (int j = 0; j < 4; ++j) { v[4 * j] = xn[j].x; v[4 * j + 1] = xn[j].y; v[4 * j + 2] = xn[j].z; v[4 * j + 3] = xn[j].w; }
        if (MODE == 2) {
#pragma unroll
            for (int j = 0; j < 4; ++j) { const f32x4 gq = *(const LAS f32x4*)(cgp + 4 * F.lane + 256 * j);
                v[4 * j] += gq[0] * (fp8f(on0[j], 0) + fp8f(on1[j], 0)); v[4 * j + 1] += gq[1] * (fp8f(on0[j], 1) + fp8f(on1[j], 1));
                v[4 * j + 2] += gq[2] * (fp8f(on0[j], 2) + fp8f(on1[j], 2)); v[4 * j + 3] += gq[3] * (fp8f(on0[j], 3) + fp8f(on1[j], 3));
                uint2 xo_; xo_.x = pk2g(v[4 * j], v[4 * j + 1]); xo_.y = pk2g(v[4 * j + 2], v[4 * j + 3]); *(uint2*)(xout + (size_t)row * D + 4 * F.lane + 256 * j) = xo_; } }
        if (ri + 1 < rpw) NORM_LOAD(row + 1);
        float ss = 0.f;
#pragma unroll
        for (int i = 0; i < 16; ++i) ss += v[i] * v[i];
        ss = wave_sum(ss); const float r = rsqrtf(ss * (1.f / D) + 1e-6f);
#pragma unroll
        for (int j = 0; j < 4; ++j) { const f32x4 g4 = *(const LAS f32x4*)(cg + 4 * F.lane + 256 * j), s4 = *(const LAS f32x4*)(csh + 4 * F.lane + 256 * j);
#pragma unroll
            for (int e = 0; e < 4; ++e) v[4 * j + e] = v[4 * j + e] * r * g4[e] + s4[e];
            if (MODE == 2 || MODE == 0) *(unsigned*)((unsigned char*)p.h + (size_t)row * D + 4 * F.lane + 256 * j) = pk4_fp8(v[4 * j] * F8_SA, v[4 * j + 1] * F8_SA, v[4 * j + 2] * F8_SA, v[4 * j + 3] * F8_SA);
            else { uint2 pk; pk.x = pk2g(v[4 * j], v[4 * j + 1]); pk.y = pk2g(v[4 * j + 2], v[4 * j + 3]); *(uint2*)(p.h + (size_t)row * D + 4 * F.lane + 256 * j) = pk; } }
        if (MODE == 2) { float a8[8];
#pragma unroll
            for (int j = 0; j < 8; ++j) a8[j] = 0.f;
#pragma unroll
            for (int j = 0; j < 4; ++j)
#pragma unroll
                for (int e = 0; e < 4; ++e) { const LAS float* wr_ = rw + (e * 256 + 64 * j + F.lane) * TP; const float hv = v[4 * j + e];
#pragma unroll
                    for (int q2 = 0; q2 < 4; ++q2) { const f32x2_t w2 = *(const LAS f32x2_t*)(wr_ + 2 * q2); a8[2 * q2] += hv * w2[0]; a8[2 * q2 + 1] += hv * w2[1]; } }
#pragma unroll
            for (int j = 0; j < 8; ++j) a8[j] = wave_sum(a8[j]);
            if (F.lane < 8) { float a = 0.f;
#pragma unroll
                for (int j = 0; j < 8; ++j) a = (F.lane == j) ? a8[j] : a;
                if (F.lane < 4) { a += p.ml_bi[F.lane]; p.li[row * 4 + F.lane] = 15.f * tanhf(a / 15.f); }
                else { a += p.ml_bf[F.lane - 4]; const float cc = 15.f * tanhf(a / 15.f); p.lf[row * 4 + F.lane - 4] = (cc >= 0.f) ? -log1pf(expf(-cc)) : (cc - log1pf(expf(cc))); } } }
        if (MODE == 1) { float acc[32];
#pragma unroll
            for (int e = 0; e < 32; ++e) acc[e] = 0.f;
#pragma unroll
            for (int j = 0; j < 4; ++j)
#pragma unroll
                for (int e = 0; e < 4; ++e) { const LAS float* wr_ = rw + (e * 256 + 64 * j + F.lane) * TP; const float hv = v[4 * j + e]; asm volatile("" ::: "memory");
#pragma unroll
                    for (int q2 = 0; q2 < 16; ++q2) { const f32x2_t w2 = *(const LAS f32x2_t*)(wr_ + 2 * q2); acc[2 * q2] += hv * w2[0]; acc[2 * q2 + 1] += hv * w2[1]; } }
            float r16[16], r8[8], r4[4], r2[2], r1;
            { const bool hi = (F.lane & 32) != 0;
#pragma unroll
              for (int i = 0; i < 16; ++i) { const float keep = hi ? acc[16 + i] : acc[i], send = hi ? acc[i] : acc[16 + i]; r16[i] = keep + other32(send, hi); } }
            { const bool hi = (F.lane & 16) != 0;
#pragma unroll
              for (int i = 0; i < 8; ++i) { const float keep = hi ? r16[8 + i] : r16[i], send = hi ? r16[i] : r16[8 + i]; r8[i] = keep + sx<16>(send); } }
            { const bool hi = (F.lane & 8) != 0;
#pragma unroll
              for (int i = 0; i < 4; ++i) { const float keep = hi ? r8[4 + i] : r8[i], send = hi ? r8[i] : r8[4 + i]; r4[i] = keep + sx<8>(send); } }
            { const bool hi = (F.lane & 4) != 0;
#pragma unroll
              for (int i = 0; i < 2; ++i) { const float keep = hi ? r4[2 + i] : r4[i], send = hi ? r4[i] : r4[2 + i]; r2[i] = keep + sx<4>(send); } }
            { const bool hi = (F.lane & 2) != 0; const float keep = hi ? r2[1] : r2[0], send = hi ? r2[0] : r2[1]; r1 = keep + sx<2>(send); }
            r1 += sx<1>(r1);
            const float aff = sigmoidf_(r1); const float ch = aff + p.router_b[F.lane >> 1];
            float bestgs = -3e38f; int be0 = 0, be1 = 0; float ba0 = 0.f, ba1 = 0.f;
#pragma unroll
            for (int g = 0; g < 4; ++g) { float v1 = -3e38f, v2 = -3e38f, a1 = 0.f, a2 = 0.f; int i1 = 0, i2 = 0;
#pragma unroll
                for (int i = 0; i < 8; ++i) { const float a = rdlane(aff, 2 * (g * 8 + i)), c_ = rdlane(ch, 2 * (g * 8 + i));
                    if (c_ > v1) { v2 = v1; a2 = a1; i2 = i1; v1 = c_; a1 = a; i1 = i; } else if (c_ > v2) { v2 = c_; a2 = a; i2 = i; } }
                const float gs = v1 + v2; if (gs > bestgs) { bestgs = gs; be0 = g * 8 + i1; be1 = g * 8 + i2; ba0 = a1; ba1 = a2; } }
            if (F.lane == 0) { const float sum = ba0 + ba1; p.tokw[row * 2] = ba0 / sum; p.tokw[row * 2 + 1] = ba1 / sum;
                const int lr = row - row0; const int r0_ = atomicAdd((int*)&lcnt[be0], 1); const int r1_ = atomicAdd((int*)&lcnt[be1], 1);
                ent[lr * 4 + 0] = be0 | (r0_ << 8); ent[lr * 4 + 1] = row * 2; ent[lr * 4 + 2] = be1 | (r1_ << 8); ent[lr * 4 + 3] = row * 2 + 1; } }
    }
#undef NORM_LOAD
    if (MODE == 1) { __syncthreads();
        if (F.tid < 32) gbase[F.tid] = atomicAdd(&p.cnt[layer * 64 + F.tid], lcnt[F.tid]);
        __syncthreads();
        for (int idx = F.tid; idx < rows_per_wg * 2; idx += NTHR) { const int er = ent[idx * 2], tk = ent[idx * 2 + 1]; const int e = er & 255, rk = er >> 8; p.list[(size_t)e * T + gbase[e] + rk] = tk; }
        __syncthreads(); }
}

__device__ __forceinline__ void phase_norm_route(const Params& p, const Frame& F, const bf16_t* xin, const float* gain, const float* mod_sh, const float* mod_sc, int layer) {
    constexpr int rows_per_wg = T / NWG;
    const int row0 = F.bid * rows_per_wg, b = row0 / S, lane = F.lane, i16 = lane & 15, g = lane >> 4;
    constexpr int RTP = 2064;
    LAS unsigned char* thi = F.lds; LAS unsigned char* tlo = F.lds + 32 * RTP;
    LAS float* cg = (LAS float*)(F.lds + LDS_CONST); LAS float* csh = cg + D; LAS float* bias = csh + D; LAS float* bpart = bias + 32;
    LAS int* lcnt = (LAS int*)(F.lds + LDS_MISC + 64); LAS int* gbase = lcnt + 32; LAS int* ent = gbase + 32;
    for (int col = F.tid; col < D; col += NTHR) { cg[col] = gain[col] * (1.f + mod_sc[b * 6144 + col]); csh[col] = mod_sh[b * 6144 + col]; }
    if (F.tid < 32) lcnt[F.tid] = 0;
    __syncthreads();
    { const int e = F.tid & 31, part = F.tid >> 5; float a = 0.f;
#pragma unroll 8
      for (int k = part * 64; k < part * 64 + 64; k += 2) { const float w0 = p.router_w[k * 32 + e], w1 = p.router_w[(k + 1) * 32 + e];
          a += csh[k] * w0 + csh[k + 1] * w1;
          const float s0 = w0 * cg[k] * 256.f, s1 = w1 * cg[k + 1] * 256.f; const _Float16 h0 = (_Float16)s0, h1 = (_Float16)s1; const _Float16 l0 = (_Float16)(s0 - (float)h0), l1 = (_Float16)(s1 - (float)h1);
          *(LAS unsigned*)(thi + e * RTP + k * 2) = (unsigned)__builtin_bit_cast(unsigned short, h0) | ((unsigned)__builtin_bit_cast(unsigned short, h1) << 16);
          *(LAS unsigned*)(tlo + e * RTP + k * 2) = (unsigned)__builtin_bit_cast(unsigned short, l0) | ((unsigned)__builtin_bit_cast(unsigned short, l1) << 16); }
      bpart[part * 32 + e] = a; }
    __syncthreads();
    if (F.tid < 32) { float a = 0.f;
#pragma unroll
        for (int q = 0; q < 16; ++q) a += bpart[q * 32 + F.tid];
        bias[F.tid] = a; }
    const int rbase = row0 + F.wave * 16;
    const bf16_t* xr = xin + (size_t)(rbase + i16) * D + 8 * g;
    typedef _Float16 f16x8 __attribute__((ext_vector_type(8))); typedef unsigned u32x4r __attribute__((ext_vector_type(4)));
    const LAS unsigned char* bh0 = thi + i16 * RTP + 16 * g; const LAS unsigned char* bh1 = bh0 + 16 * RTP; const LAS unsigned char* bl0 = tlo + i16 * RTP + 16 * g; const LAS unsigned char* bl1 = bl0 + 16 * RTP;
    f32x4 acc0 = (f32x4){0.f, 0.f, 0.f, 0.f}, acc1 = (f32x4){0.f, 0.f, 0.f, 0.f}; float ss = 0.f;
    uint4 xa[2][8];
#define RT_LOAD(s_, q_) do { _Pragma("unroll") for (int u_ = 0; u_ < 8; ++u_) xa[s_][u_] = *(const uint4*)(xr + 32 * (8 * (q_) + u_)); } while (0)
    RT_LOAD(0, 0);
#pragma unroll
    for (int qd = 0; qd < 4; ++qd) {
        if (qd + 1 < 4) RT_LOAD((qd + 1) & 1, qd + 1);
#pragma unroll
        for (int u = 0; u < 8; ++u) { const int so = (8 * qd + u) * 64;
            const uint4 xc = xa[qd & 1][u]; const unsigned xw[4] = {xc.x, xc.y, xc.z, xc.w}; u32x4r ap;
#pragma unroll
            for (int i = 0; i < 4; ++i) { const float f0 = __uint_as_float(xw[i] << 16), f1 = __uint_as_float(xw[i] & 0xFFFF0000u); ss += f0 * f0 + f1 * f1; ap[i] = __builtin_bit_cast(unsigned, __builtin_amdgcn_cvt_pkrtz(f0, f1)); }
            const f16x8 a8 = __builtin_bit_cast(f16x8, ap);
            const f16x8 b0h = *(const LAS f16x8*)(bh0 + so), b0l = *(const LAS f16x8*)(bl0 + so), b1h = *(const LAS f16x8*)(bh1 + so), b1l = *(const LAS f16x8*)(bl1 + so);
            acc0 = __builtin_amdgcn_mfma_f32_16x16x32_f16(a8, b0h, acc0, 0, 0, 0); acc1 = __builtin_amdgcn_mfma_f32_16x16x32_f16(a8, b1h, acc1, 0, 0, 0);
            acc0 = __builtin_amdgcn_mfma_f32_16x16x32_f16(a8, b0l, acc0, 0, 0, 0); acc1 = __builtin_amdgcn_mfma_f32_16x16x32_f16(a8, b1l, acc1, 0, 0, 0); }
    }
#undef RT_LOAD
    ss = sum16(ss); ss = sum32(ss); const float r = rsqrtf(ss * (1.f / D) + 1e-6f);
    float af0[4], af1[4];
#pragma unroll
    for (int rr = 0; rr < 4; ++rr) { const float rrow = __int_as_float(__builtin_amdgcn_ds_bpermute((4 * g + rr) * 4, __float_as_int(r)));
        af0[rr] = sigmoidf_(rrow * (1.f / 256.f) * acc0[rr] + bias[i16]); af1[rr] = sigmoidf_(rrow * (1.f / 256.f) * acc1[rr] + bias[16 + i16]); }
    __syncthreads();
    LAS float* affl = (LAS float*)F.lds + F.wave * 512;
#pragma unroll
    for (int rr = 0; rr < 4; ++rr) { affl[(4 * g + rr) * 32 + i16] = af0[rr]; affl[(4 * g + rr) * 32 + 16 + i16] = af1[rr]; }
    asm volatile("s_waitcnt lgkmcnt(0)" ::: "memory");
    if (lane < 16) { const int row = rbase + lane; const LAS float* ar = affl + lane * 32;
        float bestgs = -3e38f; int be0 = 0, be1 = 0; float ba0 = 0.f, ba1 = 0.f;
#pragma unroll
        for (int gg = 0; gg < 4; ++gg) { float v1 = -3e38f, v2 = -3e38f, a1 = 0.f, a2 = 0.f; int i1 = 0, i2 = 0;
#pragma unroll
            for (int i = 0; i < 8; ++i) { const float a = ar[gg * 8 + i], c_ = a + p.router_b[gg * 8 + i];
                if (c_ > v1) { v2 = v1; a2 = a1; i2 = i1; v1 = c_; a1 = a; i1 = i; } else if (c_ > v2) { v2 = c_; a2 = a; i2 = i; } }
            const float gs = v1 + v2; if (gs > bestgs) { bestgs = gs; be0 = gg * 8 + i1; be1 = gg * 8 + i2; ba0 = a1; ba1 = a2; } }
        const float sum = ba0 + ba1; p.tokw[row * 2] = ba0 / sum; p.tokw[row * 2 + 1] = ba1 / sum;
        const int lr = row - row0; const int r0_ = atomicAdd((int*)&lcnt[be0], 1); const int r1_ = atomicAdd((int*)&lcnt[be1], 1);
        ent[lr * 4 + 0] = be0 | (r0_ << 8); ent[lr * 4 + 1] = row * 2; ent[lr * 4 + 2] = be1 | (r1_ << 8); ent[lr * 4 + 3] = row * 2 + 1; }
    { uint2 xq[2][4][4];
#define NR_LOAD(s_, r_) do { _Pragma("unroll") for (int k_ = 0; k_ < 4; ++k_) { const bf16_t* xq_ = xin + (size_t)((r_) + k_) * D + 4 * lane; _Pragma("unroll") for (int j_ = 0; j_ < 4; ++j_) xq[s_][k_][j_] = *(const uint2*)(xq_ + 256 * j_); } } while (0)
      NR_LOAD(0, rbase);
#pragma unroll
      for (int g4 = 0; g4 < 4; ++g4) {
          if (g4 + 1 < 4) NR_LOAD((g4 + 1) & 1, rbase + 4 * (g4 + 1));
#pragma unroll
          for (int k = 0; k < 4; ++k) { const int row = rbase + 4 * g4 + k; const float rr_ = rdlane(r, 4 * g4 + k);
#pragma unroll
              for (int j = 0; j < 4; ++j) { const f32x4 g4v = *(const LAS f32x4*)(cg + 4 * lane + 256 * j), s4_ = *(const LAS f32x4*)(csh + 4 * lane + 256 * j); const uint2 xc = xq[g4 & 1][k][j];
                  const float x0 = __uint_as_float(xc.x << 16), x1 = __uint_as_float(xc.x & 0xFFFF0000u), x2 = __uint_as_float(xc.y << 16), x3 = __uint_as_float(xc.y & 0xFFFF0000u);
                  *(unsigned*)((unsigned char*)p.h + (size_t)row * D + 4 * lane + 256 * j) = pk4_fp8((x0 * rr_ * g4v[0] + s4_[0]) * F8_SA, (x1 * rr_ * g4v[1] + s4_[1]) * F8_SA, (x2 * rr_ * g4v[2] + s4_[2]) * F8_SA, (x3 * rr_ * g4v[3] + s4_[3]) * F8_SA); } } }
#undef NR_LOAD
    }
    __syncthreads();
    if (F.tid < 32) gbase[F.tid] = atomicAdd(&p.cnt[layer * 64 + F.tid], lcnt[F.tid]);
    __syncthreads();
    for (int idx = F.tid; idx < rows_per_wg * 2; idx += NTHR) { const int er = ent[idx * 2], tk = ent[idx * 2 + 1]; const int e = er & 255, rk = er >> 8; p.list[(size_t)e * T + gbase[e] + rk] = tk; }
    __syncthreads();
}

struct MoeOrder { const LAS int* tab;
    __device__ bool next(int i, ge::Unit& u) const { if (i >= 8) return false; const int pm = __builtin_amdgcn_readfirstlane(tab[4 * i]); if (pm < 0) return false;
        u.pm = pm; u.pn = __builtin_amdgcn_readfirstlane(tab[4 * i + 1]); u.bt = __builtin_amdgcn_readfirstlane(tab[4 * i + 2]); u.aux = __builtin_amdgcn_readfirstlane(tab[4 * i + 3]); return true; } };
__device__ __forceinline__ void moe_plan(const Frame& F, const int* cnt, const int* list, LAS int* tab, LAS int* tkt  , int npn, const float* tokw = nullptr, LAS float* tkw = nullptr  , const float wscale = 1.f) {
    LAS int* lc = tab + 32;
    __syncthreads();
    if (F.tid < 32) lc[F.tid] = cnt[F.tid];
    __syncthreads();
    if (F.tid < 8) { const int L = F.tid * F.G + F.bid, mt = L / npn, pn = L % npn; int acc = 0, e_f = -1, mi_f = 0;
#pragma unroll 1
        for (int e = 0; e < NE; ++e) { const int nte = (lc[e] + 255) >> 8; if (e_f < 0 && mt < acc + nte) { e_f = e; mi_f = mt - acc; } acc += nte; }
        tab[4 * F.tid] = e_f < 0 ? -1 : mt; tab[4 * F.tid + 1] = pn; tab[4 * F.tid + 2] = e_f * npn + pn; tab[4 * F.tid + 3] = e_f | (mi_f << 8) | (F.tid << 24); }
    __syncthreads();
#pragma unroll
    for (int q = 0; q < 4; ++q) { const int idx = F.tid + NTHR * q, i = idx >> 8, r = idx & 255; int v = -1;
        if (tab[4 * i] >= 0) { const int aux = tab[4 * i + 3], e = aux & 255, ii = ((aux >> 8) & 0xFFFF) * 256 + r; if (ii < lc[e]) v = list[(size_t)e * T + ii]; }
        tkt[idx] = v; if (tkw) tkw[idx] = v >= 0 ? tokw[v] * wscale : 0.f; }
    __syncthreads();
}
struct MoeRows { static constexpr bool dense = false; const LAS int* tkt; __device__ __forceinline__ unsigned operator()(const ge::Unit& u, int r) const { const int tk = tkt[(u.aux >> 24) * 256 + r]; return tk < 0 ? (unsigned)T * (unsigned)(D * 2) : (unsigned)(tk >> 1) * (unsigned)D; } };
struct EpiMoe1 { unsigned char* hid8; float inscale;
    __device__ __forceinline__ void operator()(const f32x4 (&acc)[2][2][4][2], const ge::Unit& u, int wr, int wc, int fr, int fq) const {
        const int h0 = (4 * u.pn + wc) * 32 + 8 * fq;
#pragma unroll
        for (int ai = 0; ai < 2; ++ai)
#pragma unroll
            for (int m = 0; m < 4; ++m) { const int row = u.pm * 256 + ai * 128 + wr * 64 + m * 16 + fr; unsigned w[2];
#pragma unroll
                for (int n = 0; n < 2; ++n) { float r4[4];
#pragma unroll
                    for (int j = 0; j < 4; ++j) { const float g = acc[ai][0][m][n][j] * inscale, uu = acc[ai][1][m][n][j] * inscale; r4[j] = g * fsigmoid(g) * uu * F8_SH; }
                    w[n] = pk4_fp8(r4[0], r4[1], r4[2], r4[3]); }
                *(uint2*)(hid8 + (size_t)row * DE + h0) = make_uint2(w[0], w[1]); }
    } };
struct EpiMoe2 { bf16_t* outk; const LAS int* tkt; const LAS float* tkw;
    __device__ __forceinline__ void operator()(const f32x4 (&acc)[2][2][4][2], const ge::Unit& u, int wr, int wc, int fr, int fq) const {
        const int L0 = (4 * u.pn + wc) * 64 + 16 * fq; const int ub = (u.aux >> 24) * 256 + wr * 64 + fr; int tk[2][4]; float wt[2][4];
#pragma unroll
        for (int ai = 0; ai < 2; ++ai)
#pragma unroll
            for (int m = 0; m < 4; ++m) { tk[ai][m] = tkt[ub + ai * 128 + m * 16]; wt[ai][m] = tkw[ub + ai * 128 + m * 16]; }
#pragma unroll
        for (int ai = 0; ai < 2; ++ai)
#pragma unroll
            for (int m = 0; m < 4; ++m) { const int t_ = tk[ai][m]; if (t_ < 0) continue; const float w = wt[ai][m]; float v[16]; GE_VALS(v, acc, ai, m);
#pragma unroll
                for (int k = 0; k < 16; ++k) v[k] *= w;
                *(uint4*)((unsigned char*)outk + (size_t)(t_ & 1) * T * D + (size_t)(t_ >> 1) * D + L0) = make_uint4(pk4_fp8(v[0], v[1], v[2], v[3]), pk4_fp8(v[4], v[5], v[6], v[7]), pk4_fp8(v[8], v[9], v[10], v[11]), pk4_fp8(v[12], v[13], v[14], v[15])); }
    } };

__device__ __forceinline__ void phase_cmp2(const Params& p, const Frame& F) {
    LAS float* w2l = (LAS float*)F.lds; const int base = F.bid * 8 + F.wave;
#pragma unroll 1
    for (int w = 0; w < 2; ++w) {
        __syncthreads();
        for (int i4 = F.tid; i4 < 256 * 64 / 4; i4 += NTHR) { const float4 t4 = *(const float4*)(p.cmp_w2 + (size_t)w * 256 * 64 + 4 * i4); *(LAS f32x4*)(w2l + 4 * i4) = (f32x4){t4.x, t4.y, t4.z, t4.w}; }
        float hv[2][4];
#pragma unroll
        for (int k = 0; k < 2; ++k) { const int row = (base + (2 * w + k) * 2048) & 4095;
#pragma unroll
            for (int i = 0; i < 4; ++i) { float x = p.cb1[w * 256 + i * 64 + F.lane];
#pragma unroll
                for (int ks = 0; ks < 8; ++ks) x += bf2f(((const bf16_t*)p.cpart)[((size_t)(w * 8 + ks) * 4096 + row) * 256 + i * 64 + F.lane]);
                hv[k][i] = 0.5f * x * (1.f + ftanh(0.7978845608028654f * (x + 0.044715f * x * x * x))); } }
        __syncthreads();
        float acc0 = p.cmp_b2[w * 64 + F.lane], acc1 = acc0;
#pragma unroll
        for (int i = 0; i < 4; ++i)
#pragma unroll 8
            for (int l = 0; l < 64; ++l) { const float wv = w2l[(i * 64 + l) * 64 + F.lane]; acc0 += rdlane(hv[0][i], l) * wv; acc1 += rdlane(hv[1][i], l) * wv; }
#pragma unroll
        for (int k = 0; k < 2; ++k) { const int row = (base + (2 * w + k) * 2048) & 4095, c = row & 127; float v = k ? acc1 : acc0;
            if (w == 0) { const float ss = wave_sum(v * v); v = v * rsqrtf(ss * (1.f / 64.f) + 1e-6f) * p.k_gain[F.lane]; int pos = c * 16 + 31; if (pos > 2047) pos = 2047;
                const float other = sx<8>(v); if (F.lane < 16) { const int j = F.lane & 7; const float cs = p.rope[pos * 16 + j], sn = p.rope[pos * 16 + 8 + j]; v = (F.lane < 8) ? (v * cs - other * sn) : (v * cs + other * sn); } }
            if (c == 127) v = 0.f;
            (w == 0 ? p.kcmp : p.vcmp)[(size_t)row * 64 + F.lane] = f2bf(v); }
    }
}

typedef float f32x16 __attribute__((ext_vector_type(16)));
typedef short s16x4 __attribute__((ext_vector_type(4)));
namespace at {
constexpr int KP = 144, VP = 192;
constexpr int KBUF = 64 * KP, VBUF = 64 * VP;
constexpr int OFF_K0 = 0, OFF_K1 = KBUF, OFF_V0 = 4 * KBUF, OFF_V1 = 4 * KBUF + VBUF, OFF_IMP = 4 * KBUF + 4 * VBUF;
constexpr int IMP_PITCH = 33, OFF_SEL = OFF_IMP + 8 * 32 * IMP_PITCH * 4;
constexpr float SC = 0.125f * 1.4426950408889634f;
constexpr float NEG = -1e30f, THR = 8.0f;
__device__ __forceinline__ unsigned pk2(float a, float b) { typedef float f2 __attribute__((ext_vector_type(2))); typedef __bf16 b2 __attribute__((ext_vector_type(2))); b2 r = __builtin_convertvector((f2){a, b}, b2); return __builtin_bit_cast(unsigned, r); }
template <int OFF> __device__ __forceinline__ s16x4 tr_read(unsigned addr) { s16x4 r; asm volatile("ds_read_b64_tr_b16 %0, %1 offset:%2" : "=&v"(r) : "v"(addr), "i"(OFF) : "memory"); return r; }
struct St { f32x16 o[2]; float m, l; };

__device__ __forceinline__ void qk_tile(const LAS unsigned char* kb, int r32, int hi, const bf16x8 (&qf)[4], f32x16& s0, f32x16& s1) {
#pragma unroll
    for (int e = 0; e < 16; ++e) { s0[e] = 0.f; s1[e] = 0.f; }
#pragma unroll
    for (int ks = 0; ks < 4; ++ks) {
        const bf16x8 a0 = *(const LAS bf16x8*)(kb + r32 * KP + (16 * ks + 8 * hi) * 2);
        const bf16x8 a1 = *(const LAS bf16x8*)(kb + (32 + r32) * KP + (16 * ks + 8 * hi) * 2);
        s0 = __builtin_amdgcn_mfma_f32_32x32x16_bf16(a0, qf[ks], s0, 0, 0, 0);
        s1 = __builtin_amdgcn_mfma_f32_32x32x16_bf16(a1, qf[ks], s1, 0, 0, 0);
    }
}
template <int MODE>
__device__ __forceinline__ bool elem_valid(int kt, int e, int hi, int qloc, int t, int key0) {
    const int kl = kt * 32 + (e & 3) + 8 * (e >> 2) + 4 * hi;
    if (MODE == 1) { const int c = key0 + kl; return (c < 127) && (16 * c + 31 <= t); }
    if (MODE == 2) return kl <= qloc;
    if (MODE == 3) return kl > qloc;
    return true;
}
template <int DT> __device__ __forceinline__ void pv_read(unsigned vb_lane, s16x4 (&va)[4][2]) {
    va[0][0] = tr_read<0 * VP + 64 * DT>(vb_lane); va[0][1] = tr_read<8 * VP + 64 * DT>(vb_lane); va[1][0] = tr_read<16 * VP + 64 * DT>(vb_lane); va[1][1] = tr_read<24 * VP + 64 * DT>(vb_lane);
    va[2][0] = tr_read<32 * VP + 64 * DT>(vb_lane); va[2][1] = tr_read<40 * VP + 64 * DT>(vb_lane); va[3][0] = tr_read<48 * VP + 64 * DT>(vb_lane); va[3][1] = tr_read<56 * VP + 64 * DT>(vb_lane);
}
__device__ __forceinline__ void pv_mma(const s16x4 (&va)[4][2], const unsigned (&pp)[16], f32x16& o) {
#pragma unroll
    for (int kk = 0; kk < 4; ++kk) {
        const bf16x8 af = (bf16x8){va[kk][0][0], va[kk][0][1], va[kk][0][2], va[kk][0][3], va[kk][1][0], va[kk][1][1], va[kk][1][2], va[kk][1][3]};
        typedef unsigned u32x4 __attribute__((ext_vector_type(4)));
        const u32x4 pw = (u32x4){pp[4 * kk], pp[4 * kk + 1], pp[4 * kk + 2], pp[4 * kk + 3]};
        o = __builtin_amdgcn_mfma_f32_32x32x16_bf16(af, __builtin_bit_cast(bf16x8, pw), o, 0, 0, 0);
    }
}
__device__ __forceinline__ void pv_tile(unsigned vb_lane, const unsigned (&pp)[16], St& st) {
    s16x4 va[4][2];
    pv_read<0>(vb_lane, va); asm volatile("s_waitcnt lgkmcnt(0)" ::: "memory"); __builtin_amdgcn_sched_barrier(0); pv_mma(va, pp, st.o[0]);
    pv_read<1>(vb_lane, va); asm volatile("s_waitcnt lgkmcnt(0)" ::: "memory"); __builtin_amdgcn_sched_barrier(0); pv_mma(va, pp, st.o[1]);
}
__device__ __forceinline__ float max3f(float a, float b, float c) { float r; asm("v_max3_f32 %0, %1, %2, %3" : "=v"(r) : "v"(a), "v"(b), "v"(c)); return r; }
template <int MODE, bool GATED, bool FIXED>
__device__ __forceinline__ void attend_tile(const LAS unsigned char* kb, unsigned vb_lane, int r32, int hi, const bf16x8 (&qf)[4], St& st, int qloc, bool en, float mfix) {
    f32x16 s0, s1; qk_tile(kb, r32, hi, qf, s0, s1);
    s16x4 va0[4][2]; pv_read<0>(vb_lane, va0);
    if (MODE != 0) {
#pragma unroll
        for (int e = 0; e < 16; ++e) { s0[e] = elem_valid<MODE>(0, e, hi, qloc, 0, 0) ? s0[e] : NEG; s1[e] = elem_valid<MODE>(1, e, hi, qloc, 0, 0) ? s1[e] : NEG; }
    }
    float mc = 0.f;
    if (FIXED) {
    } else {
        float mx = max3f(s0[0], s0[1], s1[0]);
#pragma unroll
        for (int e = 2; e < 16; e += 2) mx = max3f(mx, s0[e], s0[e + 1]);
#pragma unroll
        for (int e = 1; e < 15; e += 2) mx = max3f(mx, s1[e], s1[e + 1]);
        mx = fmaxf(mx, s1[15]);
        if (GATED) mx = en ? mx : NEG;
        mx = max32(mx);
        float mold = st.m;
        if (__any((mx - mold) * SC > THR)) {
            const float mnew = fmaxf(mold, mx); const float al = __builtin_amdgcn_exp2f((mold - mnew) * SC);
#pragma unroll
            for (int e = 0; e < 16; ++e) { st.o[0][e] *= al; st.o[1][e] *= al; }
            st.l *= al; st.m = mnew; mold = mnew;
        }
        mc = fmaxf(mold, -1e20f) * SC; if (GATED) mc = en ? mc : 3e38f;
    }
    float rs = 0.f; unsigned pp[16];
#pragma unroll
    for (int e = 0; e < 16; e += 2) {
        float a0, a1, b0, b1;
        if (FIXED) { a0 = __builtin_amdgcn_exp2f(s0[e]); a1 = __builtin_amdgcn_exp2f(s0[e + 1]); b0 = __builtin_amdgcn_exp2f(s1[e]); b1 = __builtin_amdgcn_exp2f(s1[e + 1]); }
        else { a0 = __builtin_amdgcn_exp2f(__builtin_fmaf(s0[e], SC, -mc)); a1 = __builtin_amdgcn_exp2f(__builtin_fmaf(s0[e + 1], SC, -mc)); b0 = __builtin_amdgcn_exp2f(__builtin_fmaf(s1[e], SC, -mc)); b1 = __builtin_amdgcn_exp2f(__builtin_fmaf(s1[e + 1], SC, -mc)); }
        rs += (a0 + a1) + (b0 + b1); pp[e >> 1] = pk2(a0, a1); pp[8 + (e >> 1)] = pk2(b0, b1); }
    if (FIXED && GATED) {
#pragma unroll
        for (int i = 0; i < 16; ++i) pp[i] = en ? pp[i] : 0u;
        rs = en ? rs : 0.f; }
    if (!FIXED) rs = sum32(rs);
    st.l += rs;
    asm volatile("s_waitcnt lgkmcnt(0)" ::: "memory"); __builtin_amdgcn_sched_barrier(0); pv_mma(va0, pp, st.o[0]);
    { s16x4 va1[4][2]; pv_read<1>(vb_lane, va1); asm volatile("s_waitcnt lgkmcnt(0)" ::: "memory"); __builtin_amdgcn_sched_barrier(0); pv_mma(va1, pp, st.o[1]); }
}
__device__ __forceinline__ void st_reset(St& st) {
#pragma unroll
    for (int a = 0; a < 2; ++a)
#pragma unroll
        for (int e = 0; e < 16; ++e) st.o[a][e] = 0.f;
    st.m = NEG; st.l = 0.f;
}
__device__ __forceinline__ void st_flush(const St& st, unsigned (&ofin)[2][8], float g, bool first) {
    const float f = (st.l > 0.f ? 1.f / st.l : 0.f) * g;
#pragma unroll
    for (int dt = 0; dt < 2; ++dt)
#pragma unroll
        for (int e = 0; e < 16; e += 2) { float a = st.o[dt][e] * f, b = st.o[dt][e + 1] * f;
            if (!first) { const unsigned w = ofin[dt][e >> 1]; a += __uint_as_float(w << 16); b += __uint_as_float(w & 0xFFFF0000u); }
            ofin[dt][e >> 1] = pk2(a, b); }
#pragma unroll
    for (int dt = 0; dt < 2; ++dt) asm volatile("" : "+v"(ofin[dt][0]), "+v"(ofin[dt][1]), "+v"(ofin[dt][2]), "+v"(ofin[dt][3]), "+v"(ofin[dt][4]), "+v"(ofin[dt][5]), "+v"(ofin[dt][6]), "+v"(ofin[dt][7]));
}
__device__ __forceinline__ void tile_load(const bf16_t* kbase, const bf16_t* vbase, int key0, int tid, uint4& kr, uint4& vr) {
    const size_t o = (size_t)(key0 + (tid >> 3)) * 64 + (tid & 7) * 8; kr = *(const uint4*)(kbase + o); vr = *(const uint4*)(vbase + o); }
typedef unsigned u32x4_t __attribute__((ext_vector_type(4)));
__device__ __forceinline__ void tile_store(LAS unsigned char* lds, int buf, int tid, const uint4& kr, const uint4& vr) {
    *(LAS u32x4_t*)(lds + OFF_K0 + buf * KBUF + (tid >> 3) * KP + (tid & 7) * 16) = (u32x4_t){kr.x, kr.y, kr.z, kr.w}; *(LAS u32x4_t*)(lds + OFF_V0 + buf * VBUF + (tid >> 3) * VP + (tid & 7) * 16) = (u32x4_t){vr.x, vr.y, vr.z, vr.w}; }
}

template <bool FIXED>
__device__ __forceinline__ void phase_attn_t(const Params& p, const Frame& F, const float mfix) {
    using namespace at;
    LAS unsigned char* lds = F.lds;
    const int tid = F.tid, lane = F.lane, w = F.wave, r32 = lane & 31, hi = lane >> 5;
    const unsigned vlane = (unsigned)((4 * hi + ((lane & 15) >> 2)) * VP + (16 * ((lane >> 4) & 1) + 4 * (lane & 3)) * 2);
    LAS float* impw = (LAS float*)(lds + OFF_IMP) + w * 32 * IMP_PITCH;
    LAS unsigned* selm = (LAS unsigned*)(lds + OFF_SEL);
    LAS float* invl = (LAS float*)(lds + OFF_SEL + 512);
#define AT_UNIT(ui_, qb_, bg_, qoff_) const int idx_##qb_ = ((ui_) & 1) ? ((ui_) * 256 + 255 - F.bid) : ((ui_) * 256 + F.bid); const int qb_ = 31 - (idx_##qb_ >> 6), bg_ = (idx_##qb_ >> 1) & 31, qoff_ = (idx_##qb_ & 1) * 32
    bf16x8 qf[4]; float gt[3]; uint4 kr, vr, kr1, vr1;
    { AT_UNIT(0, qb, bg, qoff);
      const bf16_t* kc = p.kcmp + (size_t)bg * 128 * 64; const bf16_t* vc = p.vcmp + (size_t)bg * 128 * 64;
      tile_load(kc, vc, 0, tid, kr, vr); if (qb >= 16) tile_load(kc, vc, 64, tid, kr1, vr1); }
#pragma unroll 1
    for (int ui = 0; ui < 8; ++ui) {
        AT_UNIT(ui, qb, bg, qoff);
        const int b = bg >> 1, g = bg & 1, head = g * 8 + w, s0 = qb * 64;
        const int qloc = qoff + r32, t = s0 + qloc;
        const bf16_t* ksel = p.kv + (size_t)2 * T * 128 + (size_t)bg * S * 64; const bf16_t* vsel = p.kv + (size_t)3 * T * 128 + (size_t)bg * S * 64;
        const bf16_t* kwin = p.kv + (size_t)4 * T * 128 + (size_t)bg * S * 64; const bf16_t* vwin = p.kv + (size_t)5 * T * 128 + (size_t)bg * S * 64;
        unsigned ofin[2][8]; St st;
        { const size_t tok = (size_t)b * S + t;
#pragma unroll
          for (int ks = 0; ks < 4; ++ks) { qf[ks] = *(const bf16x8*)(p.q + tok * D + head * 64 + 16 * ks + 8 * hi);
              if (FIXED) { typedef unsigned u32x4q __attribute__((ext_vector_type(4))); const u32x4q w4 = __builtin_bit_cast(u32x4q, qf[ks]); u32x4q r4;
#pragma unroll
                  for (int i = 0; i < 4; ++i) r4[i] = pk2(__uint_as_float(w4[i] << 16) * SC, __uint_as_float(w4[i] & 0xFFFF0000u) * SC);
                  qf[ks] = __builtin_bit_cast(bf16x8, r4); } }
#pragma unroll
          for (int br = 0; br < 3; ++br) gt[br] = p.gates[tok * 48 + br * 16 + head]; }
        const int nct = (qb >= 16) ? 2 : 1;
        __syncthreads();
        tile_store(lds, 0, tid, kr, vr); if (nct == 2) tile_store(lds, 1, tid, kr1, vr1);
        tile_load(ksel, vsel, qb * 64, tid, kr, vr);
        __syncthreads();
        float cm = NEG, cl = 0.f;
        if (!FIXED) {
#pragma unroll 1
        for (int ct = 0; ct < nct; ++ct) { const LAS unsigned char* kb = lds + (ct ? OFF_K1 : OFF_K0);
            f32x16 a0, a1; qk_tile(kb, r32, hi, qf, a0, a1); float mx = NEG;
#pragma unroll
            for (int e = 0; e < 16; ++e) { a0[e] = elem_valid<1>(0, e, hi, qloc, t, ct * 64) ? a0[e] : NEG; a1[e] = elem_valid<1>(1, e, hi, qloc, t, ct * 64) ? a1[e] : NEG; mx = fmaxf(mx, fmaxf(a0[e], a1[e])); }
            mx = max32(mx); const float mnew = fmaxf(cm, mx); float rs = 0.f;
#pragma unroll
            for (int e = 0; e < 16; ++e) { rs += (a0[e] > -1e29f ? __builtin_amdgcn_exp2f((a0[e] - mnew) * SC) : 0.f) + (a1[e] > -1e29f ? __builtin_amdgcn_exp2f((a1[e] - mnew) * SC) : 0.f); }
            rs = sum32(rs); cl = cl * __builtin_amdgcn_exp2f((cm - mnew) * SC) + rs; cm = mnew; }
        }
        st_reset(st); if (FIXED) cm = mfix / SC; else st.m = cm;
        const float icl = FIXED ? 1.f : (cl > 0.f ? 1.f / cl : 0.f);
        LAS float* irow = impw + r32 * IMP_PITCH;
        if (nct == 1) {
#pragma unroll 1
            for (int j = 16; j < 32; ++j) irow[j] = 0.f; }
#pragma unroll 1
        for (int ct = 0; ct < nct; ++ct) { const LAS unsigned char* kb = lds + (ct ? OFF_K1 : OFF_K0); const unsigned vb = (unsigned)(unsigned long)(lds + (ct ? OFF_V1 : OFF_V0)) + vlane;
            f32x16 a0, a1; qk_tile(kb, r32, hi, qf, a0, a1); const float mc = cm * SC; unsigned pp[16]; float rs = 0.f; float Ai[8], Fi[8];
            int clim = (t - 31) >> 4; clim = (clim > 126 ? 126 : clim) - 4 * hi - ct * 64;
#pragma unroll
            for (int kt = 0; kt < 2; ++kt)
#pragma unroll
                for (int gq = 0; gq < 4; ++gq) { float pv[4];
#pragma unroll
                    for (int e2 = 0; e2 < 4; ++e2) { const int e = gq * 4 + e2; const float sv = kt ? a1[e] : a0[e]; pv[e2] = (kt * 32 + (e & 3) + 8 * (e >> 2) <= clim) ? (FIXED ? __builtin_amdgcn_exp2f(sv) : __builtin_amdgcn_exp2f(sv * SC - mc)) : 0.f; }
                    pp[kt * 8 + gq * 2] = pk2(pv[0], pv[1]); pp[kt * 8 + gq * 2 + 1] = pk2(pv[2], pv[3]); rs += (pv[0] + pv[1]) + (pv[2] + pv[3]);
                    Ai[kt * 4 + gq] = (pv[0] + 2.f * (pv[1] + pv[2] + pv[3])) * icl; Fi[kt * 4 + gq] = pv[0] * icl; }
            st.l += rs;
            float Fr[8];
#pragma unroll
            for (int g8 = 0; g8 < 8; ++g8) Fr[g8] = other32(Fi[g8], hi != 0);
#pragma unroll
            for (int g8 = 0; g8 < 8; ++g8) { const float nxt = (g8 < 7) ? Fr[g8 + 1] : 0.f;
                irow[ct * 16 + 2 * g8 + hi] = Ai[g8] + (hi ? nxt : Fr[g8]); }
            if (ct == 1 && hi) irow[15] += Fr[0];
            pv_tile(vb, pp, st); }
        st.l = sum32(st.l);
        if (hi == 0) invl[w * 32 + r32] = FIXED ? (st.l > 0.f ? 1.f / st.l : 0.f) : 1.f;
        tile_store(lds, 2, tid, kr, vr);
        st_flush(st, ofin, gt[0], true);
        __syncthreads();
        if (w == 0) { unsigned mask;
            if (qb < 8) mask = (2u << qb) - 1u;
            else { mask = 1u | (1u << qb) | (1u << (qb - 1));
                const LAS float* ib = (const LAS float*)(lds + OFF_IMP) + r32 * IMP_PITCH; float iv[32];
#pragma unroll
                for (int j = 0; j < 32; ++j) { float v = 0.f;
#pragma unroll
                    for (int ww = 0; ww < 8; ++ww) v += ib[ww * 32 * IMP_PITCH + j] * invl[ww * 32 + r32];
                    iv[j] = (j >= 1 && j <= qb - 2) ? v : -3e38f; }
#pragma unroll 1
                for (int pick = 0; pick < 5; ++pick) { int best = -1; float bv = -3e38f;
#pragma unroll
                    for (int j = 1; j < 31; ++j) { const bool take = !((mask >> j) & 1u) && iv[j] > bv; bv = take ? iv[j] : bv; best = take ? j : best; }
                    if (best >= 0) mask |= 1u << best; } }
            if (hi == 0) selm[r32] = mask; unsigned um = mask;
            um |= sxu<16>(um); um |= sxu<8>(um); um |= sxu<4>(um); um |= sxu<2>(um); um |= sxu<1>(um);
            if (lane == 0) selm[32] = um; }
        __syncthreads();
        const int jlo = qb >= 8 ? qb - 8 : 0;
        { const unsigned um = selm[32]; const unsigned mq = selm[r32];
          st_reset(st);
          unsigned rem = um & ~(1u << qb);
#define SEL_POP(dst) do { if (rem) { dst = 31 - __builtin_clz(rem); rem &= ~(1u << dst); } else dst = -1; } while (0)
          int jA = qb, jB = -1, sb = 1;
          for (;;) {
              int nA, nB = -1; SEL_POP(nA); if (nA >= 0) SEL_POP(nB);
              if (nA >= 0) tile_load(ksel, vsel, nA * 64, tid, kr, vr);
              if (nB >= 0) tile_load(ksel, vsel, nB * 64, tid, kr1, vr1);
              if (nA < 0) { tile_load(kwin, vwin, qb * 64, tid, kr, vr); if (qb - 1 >= jlo) tile_load(kwin, vwin, (qb - 1) * 64, tid, kr1, vr1); }
              { const LAS unsigned char* kb = lds + OFF_K0 + (2 * sb) * KBUF; const unsigned vb = (unsigned)(unsigned long)(lds + OFF_V0 + (2 * sb) * VBUF) + vlane;
                if (jA == qb) attend_tile<2, false, FIXED>(kb, vb, r32, hi, qf, st, qloc, true, mfix);
                else attend_tile<0, true, FIXED>(kb, vb, r32, hi, qf, st, qloc, (mq >> jA) & 1u, mfix); }
              if (jB >= 0) { const LAS unsigned char* kb = lds + OFF_K0 + (2 * sb + 1) * KBUF; const unsigned vb = (unsigned)(unsigned long)(lds + OFF_V0 + (2 * sb + 1) * VBUF) + vlane;
                attend_tile<0, true, FIXED>(kb, vb, r32, hi, qf, st, qloc, (mq >> jB) & 1u, mfix); }
              if (nA < 0) break;
              tile_store(lds, 2 * (sb ^ 1), tid, kr, vr); if (nB >= 0) tile_store(lds, 2 * (sb ^ 1) + 1, tid, kr1, vr1);
              __syncthreads();
              jA = nA; jB = nB; sb ^= 1;
          }
#undef SEL_POP
          if (FIXED) st.l = sum32(st.l);
          st_flush(st, ofin, gt[1], false); }
        __syncthreads();
        { st_reset(st);
          int jA = qb, jB = (qb - 1 >= jlo) ? qb - 1 : -1, sb = 0;
          tile_store(lds, 0, tid, kr, vr); if (jB >= 0) tile_store(lds, 1, tid, kr1, vr1);
          __syncthreads();
          for (;;) {
              const int nA = (jB >= 0 && jB - 1 >= jlo) ? jB - 1 : -1, nB = (nA >= 0 && nA - 1 >= jlo) ? nA - 1 : -1;
              if (nA >= 0) tile_load(kwin, vwin, nA * 64, tid, kr, vr);
              if (nB >= 0) tile_load(kwin, vwin, nB * 64, tid, kr1, vr1);
              if (nA < 0 && ui + 1 < 8) {
                  AT_UNIT(ui + 1, qbn, bgn, qoffn);
                  const bf16_t* kcn = p.kcmp + (size_t)bgn * 128 * 64; const bf16_t* vcn = p.vcmp + (size_t)bgn * 128 * 64;
                  tile_load(kcn, vcn, 0, tid, kr, vr); if (qbn >= 16) tile_load(kcn, vcn, 64, tid, kr1, vr1); }
#define WIN_TILE(j_, bi_) do { const LAS unsigned char* kb = lds + OFF_K0 + (bi_) * KBUF; const unsigned vb = (unsigned)(unsigned long)(lds + OFF_V0 + (bi_) * VBUF) + vlane; \
                if ((j_) == qb) attend_tile<2, false, FIXED>(kb, vb, r32, hi, qf, st, qloc, true, mfix); else if ((j_) == qb - 8) attend_tile<3, false, FIXED>(kb, vb, r32, hi, qf, st, qloc, true, mfix); else attend_tile<0, false, FIXED>(kb, vb, r32, hi, qf, st, qloc, true, mfix); } while (0)
              WIN_TILE(jA, 2 * sb);
              if (jB >= 0) WIN_TILE(jB, 2 * sb + 1);
#undef WIN_TILE
              if (nA < 0) break;
              tile_store(lds, 2 * (sb ^ 1), tid, kr, vr); if (nB >= 0) tile_store(lds, 2 * (sb ^ 1) + 1, tid, kr1, vr1);
              __syncthreads();
              jA = nA; jB = nB; sb ^= 1;
          }
          if (FIXED) st.l = sum32(st.l);
          st_flush(st, ofin, gt[2], false); }
        { int l2 = lane; asm volatile("" : "+v"(l2)); unsigned char* op = (unsigned char*)p.h + ((size_t)b * S + s0 + qoff + (l2 & 31)) * D + head * 64 + 4 * (l2 >> 5);
#pragma unroll
          for (int dt = 0; dt < 2; ++dt)
#pragma unroll
            for (int gq = 0; gq < 4; ++gq) { const unsigned w0 = ofin[dt][2 * gq], w1 = ofin[dt][2 * gq + 1];
                *(unsigned*)(op + dt * 32 + 8 * gq) = pk4_fp8(__uint_as_float(w0 << 16) * F8_SA, __uint_as_float(w0 & 0xFFFF0000u) * F8_SA, __uint_as_float(w1 << 16) * F8_SA, __uint_as_float(w1 & 0xFFFF0000u) * F8_SA); } }
    }
#undef AT_UNIT
}

__device__ __forceinline__ void phase_attn(const Params& p, const Frame& F) {
    const float gq = wave_max(fabsf(p.q_gain[F.lane])); const float gk = wave_max(fmaxf(fabsf(p.k_gain[F.lane]), fmaxf(fabsf(p.k_gain[64 + F.lane]), fabsf(p.k_gain[128 + F.lane]))));
    const float mfix = 64.f * 1.02f * gq * gk * at::SC;
    if (mfix < 60.f) phase_attn_t<true>(p, F, mfix);
    else phase_attn_t<false>(p, F, 0.f);
}

namespace ml {
constexpr int QP = 272, VP = 192;
constexpr int OFF_Q = 0, OFF_K = 64 * QP, OFF_V = 2 * 64 * QP, OFF_WV = OFF_V + 64 * VP, OFF_CB = OFF_WV + 64 * VP, OFF_GA = OFF_CB + 128 * VP, OFF_GAM = OFF_GA + 8192, OFF_GB = OFF_GAM + 8192,
              OFF_MP = OFF_GB + 8192, OFF_W = OFF_MP + 256, OFF_N = OFF_W + 256, OFF_RS = OFF_N + 512, OFF_QN = OFF_RS + 256, OFF_END = OFF_QN + 256;
typedef unsigned u32x4_t __attribute__((ext_vector_type(4)));
}
__device__ __forceinline__ void phase_scan(const Params& p, const Frame& F, bf16_t* hs_base  , const int hs_stride) {
    using namespace ml; using at::tr_read; using at::pk2;
    LAS unsigned char* lds = F.lds;
    const int tid = F.tid, lane = F.lane, w = F.wave, i16 = lane & 15, g = lane >> 4, r32 = lane & 31, hi = lane >> 5;
    const int b = F.bid >> 4, h = (F.bid >> 2) & 3, vs = F.bid & 3;
    LAS float* ga = (LAS float*)(lds + OFF_GA); LAS float* gam = (LAS float*)(lds + OFF_GAM); LAS float* gb = (LAS float*)(lds + OFF_GB); LAS float* mp = (LAS float*)(lds + OFF_MP);
    LAS float* wl = (LAS float*)(lds + OFF_W); LAS float* nl = (LAS float*)(lds + OFF_N); LAS float* rsl = (LAS float*)(lds + OFF_RS); LAS float* qnl = (LAS float*)(lds + OFF_QN);
    for (int ck = w; ck < 32; ck += 8) { const int pos = ck * 64 + lane; const size_t tg = ((size_t)b * S + pos) * 4 + h; const float lfv = p.lf[tg], liv = p.li[tg];
        float bs = lfv;
#pragma unroll
        for (int o = 1; o < 64; o <<= 1) { const float x = __int_as_float(__builtin_amdgcn_ds_bpermute((lane - o) * 4, __float_as_int(bs))); if (lane >= o) bs += x; }
        const float av = liv - bs; float am = av;
#pragma unroll
        for (int o = 1; o < 64; o <<= 1) { const float x = __int_as_float(__builtin_amdgcn_ds_bpermute((lane - o) * 4, __float_as_int(am))); if (lane >= o) am = fmaxf(am, x); }
        ga[pos] = av; gam[pos] = am; gb[pos] = bs; }
    for (int idx = tid; idx < 128 * VP / 4; idx += NTHR) ((LAS unsigned*)(lds + OFF_CB))[idx] = 0u;
    if (tid < 128) nl[tid] = 0.f;
    __syncthreads();
    if (tid == 0) { float m = 0.f;
#pragma unroll 1
        for (int k = 0; k < 32; ++k) { mp[k] = m; m = gb[k * 64 + 63] + fmaxf(m, gam[k * 64 + 63]); } }
    __syncthreads();
    const bf16_t* pq = p.proj + (size_t)b * S * 3072 + h * 128; const bf16_t* pk = pq + 512; bf16_t* pv = p.proj + (size_t)b * S * 3072 + 1024 + h * 256 + vs * 64;
    uint4 rq[2], rk[2], rv;
#define ML_LOAD(ck_) do { const size_t t0_ = (size_t)(ck_) * 64; _Pragma("unroll") for (int i_ = 0; i_ < 2; ++i_) { const int idx_ = tid + 512 * i_; const size_t o_ = (t0_ + (idx_ >> 4)) * 3072 + (idx_ & 15) * 8; rq[i_] = *(const uint4*)(pq + o_); rk[i_] = *(const uint4*)(pk + o_); } \
        rv = *(const uint4*)(pv + (t0_ + (tid >> 3)) * 3072 + (tid & 7) * 8); } while (0)
#define ML_STORE(ck_) do { _Pragma("unroll") for (int i_ = 0; i_ < 2; ++i_) { const int idx_ = tid + 512 * i_; const int o_ = (idx_ >> 4) * QP + (idx_ & 15) * 16; \
            *(LAS u32x4_t*)(lds + OFF_Q + o_) = (u32x4_t){rq[i_].x, rq[i_].y, rq[i_].z, rq[i_].w}; *(LAS u32x4_t*)(lds + OFF_K + o_) = (u32x4_t){rk[i_].x, rk[i_].y, rk[i_].z, rk[i_].w}; } \
        { const int s_ = tid >> 3; const float m63_ = fmaxf(mp[ck_], gam[(ck_) * 64 + 63]); const float ws_ = __expf(ga[(ck_) * 64 + s_] - m63_); if ((tid & 7) == 0) wl[s_] = ws_; \
          const int o_ = s_ * VP + (tid & 7) * 16; *(LAS u32x4_t*)(lds + OFF_V + o_) = (u32x4_t){rv.x, rv.y, rv.z, rv.w}; const unsigned vv_[4] = {rv.x, rv.y, rv.z, rv.w}; unsigned ww_[4]; \
          _Pragma("unroll") for (int e_ = 0; e_ < 4; ++e_) ww_[e_] = pk2(__uint_as_float(vv_[e_] << 16) * ws_, __uint_as_float(vv_[e_] & 0xFFFF0000u) * ws_); \
          *(LAS u32x4_t*)(lds + OFF_WV + o_) = (u32x4_t){ww_[0], ww_[1], ww_[2], ww_[3]}; } } while (0)
    ML_LOAD(0); ML_STORE(0);
    __syncthreads();
    const int tt = w >> 1, vh = w & 1;
    const int dt = w >> 1, vt2 = w & 1;
    const unsigned trl16 = (unsigned)(((lane & 15) >> 2) * VP + (4 * (lane & 3)) * 2);
    const unsigned trl32v = (unsigned)(((lane & 15) >> 2) * VP + (16 * ((lane >> 4) & 1) + 4 * (lane & 3)) * 2);
    const unsigned trl32k = (unsigned)(((lane & 15) >> 2) * QP + (16 * ((lane >> 4) & 1) + 4 * (lane & 3)) * 2);
    f32x16 cacc;
#pragma unroll
    for (int e = 0; e < 16; ++e) cacc[e] = 0.f;
    float nreg = 0.f;
    bf16_t* const hs_out = hs_base + (size_t)b * S * hs_stride + h * 256 + vs * 64 + 32 * vh + i16;
    const size_t wo1 = (size_t)NE * D * DE; const ColGateUp cgu{p.w_gate + wo1, p.w_up + wo1}; const ColDown cdn{p.w_down + wo1};
    LAS float* ptile = (LAS float*)(lds + OFF_END) + (tid >> 8) * (64 * 65); const int htid = tid & 255, half = tid >> 8;
    float pr_[16];
#define PREP_LOAD(s_) do { const bool gu_ = (s_) < 16; const int tl_ = (((gu_ ? (s_) : (s_) - 16) * F.G + F.bid) * 2 + half); const int c0_ = (tl_ & 511) * 64, k0_ = (tl_ >> 9) * 64; \
        const float* p_ = gu_ ? cgu(c0_ + (htid & 63)) : cdn(c0_ + (htid & 63)); const int ldw_ = gu_ ? DE : D; p_ += (size_t)(k0_ + (htid >> 6)) * ldw_; \
        _Pragma("unroll") for (int i_ = 0; i_ < 16; ++i_) pr_[i_] = p_[(size_t)(4 * i_) * ldw_]; } while (0)
#define PREP_WRITE() do { _Pragma("unroll") for (int i_ = 0; i_ < 16; ++i_) ptile[((htid >> 6) + 4 * i_) * 65 + (htid & 63)] = pr_[i_]; } while (0)
#define PREP_STORE(s_) do { const bool gu_ = (s_) < 16; const int tl_ = (((gu_ ? (s_) : (s_) - 16) * F.G + F.bid) * 2 + half); const int c0_ = (tl_ & 511) * 64, k0_ = (tl_ >> 9) * 64; \
        const int cc_ = htid >> 2, ch_ = (htid & 3) * 16; \
        { const float sc_ = gu_ ? F8_SW : F8_SW2; const unsigned long long a_ = (unsigned long long)p.gu_t, d_ = (unsigned long long)p.dn_t - a_; unsigned char* base_ = (unsigned char*)(a_ + (gu_ ? 0ull : d_)); const int kp_ = gu_ ? D : DE; \
          unsigned w_[4]; _Pragma("unroll") for (int i_ = 0; i_ < 4; ++i_) w_[i_] = pk4_fp8(ptile[(ch_ + 4 * i_) * 65 + cc_] * sc_, ptile[(ch_ + 4 * i_ + 1) * 65 + cc_] * sc_, ptile[(ch_ + 4 * i_ + 2) * 65 + cc_] * sc_, ptile[(ch_ + 4 * i_ + 3) * 65 + cc_] * sc_); \
          *(uint4*)(base_ + (size_t)(c0_ + cc_) * kp_ + k0_ + ch_) = make_uint4(w_[0], w_[1], w_[2], w_[3]); } } while (0)
    PREP_LOAD(0);
#pragma unroll 1
    for (int ck = 0; ck < 32; ++ck) {
        if (ck + 1 < 32) ML_LOAD(ck + 1);
        const float mprev = mp[ck]; const int c0 = ck * 64;
        bf16x8 qf[4];
#pragma unroll
        for (int ks = 0; ks < 4; ++ks) qf[ks] = *(const LAS bf16x8*)(lds + OFF_Q + (16 * tt + i16) * QP + (32 * ks + 8 * g) * 2);
        f32x4 st[4];
#pragma unroll
        for (int jt = 0; jt < 4; ++jt) { st[jt] = (f32x4){0.f, 0.f, 0.f, 0.f};
#pragma unroll
            for (int ks = 0; ks < 4; ++ks) { const bf16x8 kf = *(const LAS bf16x8*)(lds + OFF_K + (16 * jt + i16) * QP + (32 * ks + 8 * g) * 2); st[jt] = __builtin_amdgcn_mfma_f32_16x16x32_bf16(kf, qf[ks], st[jt], 0, 0, 0); } }
        const int tl = 16 * tt + i16; const float Mt = fmaxf(mprev, gam[c0 + tl]); float rs = 0.f; unsigned ap[8];
#pragma unroll
        for (int jt = 0; jt < 4; ++jt) { float v4[4]; const f32x4 ga4 = *(const LAS f32x4*)(ga + c0 + 16 * jt + 4 * g);
#pragma unroll
            for (int r = 0; r < 4; ++r) { const int j = 16 * jt + 4 * g + r; const float e = __expf(ga4[r] - Mt) * st[jt][r]; v4[r] = (j <= tl) ? e : 0.f; rs += v4[r]; }
            ap[jt * 2] = pk2(v4[0], v4[1]); ap[jt * 2 + 1] = pk2(v4[2], v4[3]); }
        rs = sum16(rs); rs = sum32(rs);
        float qn = 0.f;
#pragma unroll
        for (int ks = 0; ks < 4; ++ks) { const f32x4 n0 = *(const LAS f32x4*)(nl + 32 * ks + 8 * g), n1 = *(const LAS f32x4*)(nl + 32 * ks + 8 * g + 4);
#pragma unroll
            for (int e = 0; e < 4; ++e) { qn += bf2f((bf16_t)qf[ks][e]) * n0[e]; qn += bf2f((bf16_t)qf[ks][4 + e]) * n1[e]; } }
        qn = sum16(qn); qn = sum32(qn);
        if (vh == 0 && g == 0) { rsl[tl] = rs; qnl[tl] = qn; }
        f32x4 av[2], qc[2];
#pragma unroll
        for (int vt = 0; vt < 2; ++vt) { av[vt] = (f32x4){0.f, 0.f, 0.f, 0.f}; qc[vt] = (f32x4){0.f, 0.f, 0.f, 0.f}; }
        {   const unsigned vb = (unsigned)(unsigned long)(lds + OFF_V) + trl16 + (unsigned)(4 * g * VP + (32 * vh) * 2);
            const unsigned cb = (unsigned)(unsigned long)(lds + OFF_CB) + trl16 + (unsigned)(8 * g * VP + (32 * vh) * 2);
            s16x4 va[2][2][2], ca[4][2][2];
#pragma unroll
            for (int vt = 0; vt < 2; ++vt) {
                if (vt == 0) { va[0][0][0] = tr_read<0 * VP>(vb); va[0][0][1] = tr_read<16 * VP>(vb); va[1][0][0] = tr_read<32 * VP>(vb); va[1][0][1] = tr_read<48 * VP>(vb);
                    ca[0][0][0] = tr_read<0 * VP>(cb); ca[0][0][1] = tr_read<4 * VP>(cb); ca[1][0][0] = tr_read<32 * VP>(cb); ca[1][0][1] = tr_read<36 * VP>(cb);
                    ca[2][0][0] = tr_read<64 * VP>(cb); ca[2][0][1] = tr_read<68 * VP>(cb); ca[3][0][0] = tr_read<96 * VP>(cb); ca[3][0][1] = tr_read<100 * VP>(cb); }
                else { va[0][1][0] = tr_read<0 * VP + 32>(vb); va[0][1][1] = tr_read<16 * VP + 32>(vb); va[1][1][0] = tr_read<32 * VP + 32>(vb); va[1][1][1] = tr_read<48 * VP + 32>(vb);
                    ca[0][1][0] = tr_read<0 * VP + 32>(cb); ca[0][1][1] = tr_read<4 * VP + 32>(cb); ca[1][1][0] = tr_read<32 * VP + 32>(cb); ca[1][1][1] = tr_read<36 * VP + 32>(cb);
                    ca[2][1][0] = tr_read<64 * VP + 32>(cb); ca[2][1][1] = tr_read<68 * VP + 32>(cb); ca[3][1][0] = tr_read<96 * VP + 32>(cb); ca[3][1][1] = tr_read<100 * VP + 32>(cb); } }
            asm volatile("s_waitcnt lgkmcnt(0)" ::: "memory"); __builtin_amdgcn_sched_barrier(0);
#pragma unroll
            for (int vt = 0; vt < 2; ++vt) {
#pragma unroll
                for (int pp = 0; pp < 2; ++pp) { const bf16x8 bfv = (bf16x8){va[pp][vt][0][0], va[pp][vt][0][1], va[pp][vt][0][2], va[pp][vt][0][3], va[pp][vt][1][0], va[pp][vt][1][1], va[pp][vt][1][2], va[pp][vt][1][3]};
                    const u32x4_t aw = (u32x4_t){ap[4 * pp], ap[4 * pp + 1], ap[4 * pp + 2], ap[4 * pp + 3]};
                    av[vt] = __builtin_amdgcn_mfma_f32_16x16x32_bf16(__builtin_bit_cast(bf16x8, aw), bfv, av[vt], 0, 0, 0); }
#pragma unroll
                for (int ks = 0; ks < 4; ++ks) { const bf16x8 bfc = (bf16x8){ca[ks][vt][0][0], ca[ks][vt][0][1], ca[ks][vt][0][2], ca[ks][vt][0][3], ca[ks][vt][1][0], ca[ks][vt][1][1], ca[ks][vt][1][2], ca[ks][vt][1][3]};
                    qc[vt] = __builtin_amdgcn_mfma_f32_16x16x32_bf16(qf[ks], bfc, qc[vt], 0, 0, 0); } }
        }
        const float M63 = fmaxf(mprev, gam[c0 + 63]); const float decay = __expf(mprev - M63);
        {   const unsigned kb = (unsigned)(unsigned long)(lds + OFF_K) + trl32k + (unsigned)(8 * hi * QP + (32 * dt) * 2);
            const unsigned wb = (unsigned)(unsigned long)(lds + OFF_WV) + trl32v + (unsigned)(8 * hi * VP + (32 * vt2) * 2);
            s16x4 ka[4][2], wa[4][2];
            ka[0][0] = tr_read<0 * QP>(kb); ka[0][1] = tr_read<4 * QP>(kb); ka[1][0] = tr_read<16 * QP>(kb); ka[1][1] = tr_read<20 * QP>(kb);
            ka[2][0] = tr_read<32 * QP>(kb); ka[2][1] = tr_read<36 * QP>(kb); ka[3][0] = tr_read<48 * QP>(kb); ka[3][1] = tr_read<52 * QP>(kb);
            wa[0][0] = tr_read<0 * VP>(wb); wa[0][1] = tr_read<4 * VP>(wb); wa[1][0] = tr_read<16 * VP>(wb); wa[1][1] = tr_read<20 * VP>(wb);
            wa[2][0] = tr_read<32 * VP>(wb); wa[2][1] = tr_read<36 * VP>(wb); wa[3][0] = tr_read<48 * VP>(wb); wa[3][1] = tr_read<52 * VP>(wb);
            asm volatile("s_waitcnt lgkmcnt(0)" ::: "memory"); __builtin_amdgcn_sched_barrier(0);
#pragma unroll
            for (int e = 0; e < 16; ++e) cacc[e] *= decay;
#pragma unroll
            for (int ks = 0; ks < 4; ++ks) { const bf16x8 fa = (bf16x8){ka[ks][0][0], ka[ks][0][1], ka[ks][0][2], ka[ks][0][3], ka[ks][1][0], ka[ks][1][1], ka[ks][1][2], ka[ks][1][3]};
                const bf16x8 fb = (bf16x8){wa[ks][0][0], wa[ks][0][1], wa[ks][0][2], wa[ks][0][3], wa[ks][1][0], wa[ks][1][1], wa[ks][1][2], wa[ks][1][3]};
                cacc = __builtin_amdgcn_mfma_f32_32x32x16_bf16(fa, fb, cacc, 0, 0, 0); } }
        { const int d_ = tid & 127, part_ = tid >> 7; float acc = 0.f;
#pragma unroll
            for (int s = 0; s < 16; ++s) acc += wl[16 * part_ + s] * bf2f(*(const LAS bf16_t*)(lds + OFF_K + (16 * part_ + s) * QP + d_ * 2));
            ((LAS float*)(lds + LDS_CONST))[part_ * 128 + d_] = acc; }
        if (ck < 24) { PREP_WRITE(); if (ck + 1 < 24) PREP_LOAD(ck + 1); }
        __syncthreads();
        if (ck < 24) PREP_STORE(ck);
        { const int tr0 = 16 * tt + 4 * g;
          const f32x4 gam4 = *(const LAS f32x4*)(gam + c0 + tr0), gb4 = *(const LAS f32x4*)(gb + c0 + tr0), rs4 = *(const LAS f32x4*)(rsl + tr0), qn4 = *(const LAS f32x4*)(qnl + tr0);
          bf16_t* hp = hs_out + (size_t)(c0 + tr0) * hs_stride;
#pragma unroll
          for (int r = 0; r < 4; ++r) { const float Mr = fmaxf(mprev, gam4[r]); const float inter = __expf(mprev - Mr), mt = gb4[r] + Mr;
            const float den = rs4[r] + inter * qn4[r]; const float dd = __builtin_amdgcn_rcpf(fmaxf(fabsf(den), __expf(-mt)));
#pragma unroll
            for (int vt = 0; vt < 2; ++vt) { const float hv = (av[vt][r] + inter * qc[vt][r]) * dd; hp[(size_t)r * hs_stride + 16 * vt] = f2bf(hv); } } }
#pragma unroll
        for (int e = 0; e < 16; ++e) { const int d = 32 * dt + (e & 3) + 8 * (e >> 2) + 4 * hi; *(LAS bf16_t*)(lds + OFF_CB + d * VP + (32 * vt2 + r32) * 2) = f2bf(cacc[e]); }
        if (tid < 128) { const LAS float* np_ = (const LAS float*)(lds + LDS_CONST); nreg = decay * nreg + ((np_[tid] + np_[128 + tid]) + (np_[256 + tid] + np_[384 + tid])); nl[tid] = nreg; }
        if (ck + 1 < 32) ML_STORE(ck + 1);
        __syncthreads();
    }
#undef ML_LOAD
#undef ML_STORE
#undef PREP_LOAD
#undef PREP_WRITE
#undef PREP_STORE
}

__device__ __forceinline__ void phase_ml_gate(const Params& p, const Frame& F, unsigned char* a8) {
    const int step = F.G * 8;
#pragma unroll 1
    for (int gw = F.bid * 8 + F.wave; gw < T * 4; gw += 4 * step) { uint2 hv2[4]; unsigned ov[4];
#pragma unroll
        for (int k = 0; k < 4; ++k) { const int g_ = gw + k * step; const bf16_t* pr = p.proj + (size_t)(g_ >> 2) * 3072 + (g_ & 3) * 256 + 4 * F.lane; hv2[k] = *(const uint2*)(pr + 1024); ov[k] = *(const unsigned*)((const unsigned char*)(p.proj + (size_t)(g_ >> 2) * 3072 + 2048) + (g_ & 3) * 256 + 4 * F.lane); }
#pragma unroll
        for (int k = 0; k < 4; ++k) { const int g_ = gw + k * step, t = g_ >> 2, h = g_ & 3; const float4 g4 = *(const float4*)(p.ml_ng + h * 256 + 4 * F.lane);
            const float h0 = __uint_as_float(hv2[k].x << 16), h1 = __uint_as_float(hv2[k].x & 0xFFFF0000u), h2 = __uint_as_float(hv2[k].y << 16), h3 = __uint_as_float(hv2[k].y & 0xFFFF0000u);
            float ss = h0 * h0 + h1 * h1 + h2 * h2 + h3 * h3; ss = wave_sum(ss); const float rs = rsqrtf(ss * (1.f / 256.f) + 1e-6f) * (F8_SA / 256.f);
            *(unsigned*)(a8 + (size_t)t * D + h * 256 + 4 * F.lane) = pk4_fp8(fp8f(ov[k], 0) * h0 * rs * g4.x, fp8f(ov[k], 1) * h1 * rs * g4.y, fp8f(ov[k], 2) * h2 * rs * g4.z, fp8f(ov[k], 3) * h3 * rs * g4.w); } }
}
__device__ __forceinline__ void phase_final(const Params& p, const Frame& F, float* dst) {
    const float* mg = p.mod + (size_t)16 * 6144 + 5 * D;
    for (size_t i4 = (size_t)F.bid * NTHR + F.tid; i4 < (size_t)T * D / 4; i4 += (size_t)F.G * NTHR) { const size_t i = i4 * 4; const int col = (int)(i % D), row = (int)(i / D), b = row / S;
        const uint2 xw = *(const uint2*)(p.xb13 + i); const float4 xv = make_float4(__uint_as_float(xw.x << 16), __uint_as_float(xw.x & 0xFFFF0000u), __uint_as_float(xw.y << 16), __uint_as_float(xw.y & 0xFFFF0000u)); float4 g = *(const float4*)(mg + b * 6144 + col); g.x *= 1.f / F8_SO; g.y *= 1.f / F8_SO; g.z *= 1.f / F8_SO; g.w *= 1.f / F8_SO; const unsigned a0 = *(const unsigned*)((const unsigned char*)p.outk + i), a1 = *(const unsigned*)((const unsigned char*)p.outk + (size_t)T * D + i);
        float4 o; o.x = xv.x + g.x * (fp8f(a0, 0) + fp8f(a1, 0)); o.y = xv.y + g.y * (fp8f(a0, 1) + fp8f(a1, 1));
        o.z = xv.z + g.z * (fp8f(a0, 2) + fp8f(a1, 2)); o.w = xv.w + g.w * (fp8f(a0, 3) + fp8f(a1, 3));
        *(float4*)(dst + i) = o; }
}

__global__ void __launch_bounds__(NTHR, 2) mega_fwd(Params p) {
    extern __shared__ __attribute__((aligned(16))) unsigned char lds_raw[];
    Frame F; F.lds = (LAS unsigned char*)lds_raw; F.tid = threadIdx.x; F.lane = F.tid & 63; F.wave = __builtin_amdgcn_readfirstlane(F.tid >> 6); F.bid = blockIdx.x; F.G = gridDim.x;
    volatile LAS unsigned* misc = (volatile LAS unsigned*)(F.lds + LDS_MISC);
    LAS Params* P = (LAS Params*)(F.lds + LDS_PARAMS);
    if (F.tid < 16) misc[F.tid] = 0u;
    if (F.tid == 64) {
#define X(t, n) P->n = p.n;
        PARAM_LIST(X)
#undef X
    }
    __syncthreads();
    { XcdBarrier b0 = xcd_barrier_post(uni_ptr(P->bar), misc); if (F.tid == 0) misc[2] = b0.x; }
    __syncthreads();
#define GRID_BAR() do { XcdBarrier bb_; bb_.bar = uni_ptr(P->bar); bb_.x = (unsigned)__builtin_amdgcn_readfirstlane((int)misc[2]); bb_.st = misc; xcd_barrier(bb_, F.wave == 0 && lane_id_asm() == 0); } while (0)
    LAS unsigned char* stage = F.lds;
#define MOD0 (q.mod)
#define MOD1 (q.mod + (size_t)16 * 6144)

    { Params q; LP(rope); LP(h); phase_prologue_a(q, launder(F)); }
    { Params q; LP(c); LP(ada_w); LP(ada_b); LP(mod); LP(cmp_pe); LP(cmp_w1); LP(cmp_b1); LP(cb1); phase_prologue_b(q, launder(F)); }
    { Params q; LP(nsa_w_in); LP(win_nsa_t); prep_weights<true>(launder(F), q.win_nsa_t, 2048, D, NSA_COLS, ColPlain{q.nsa_w_in, NSA_COLS, 0}, F.bid, F.G, F8_SW); }
    { Params q; LP(nsa_w_out); LP(wo_nsa_t); prep_weights<true>(launder(F), q.wo_nsa_t, D, D, D, ColPlain{q.nsa_w_out, D, 0}, F.bid, F.G, F8_SW); }
    { Params q; LP(ml_w_in); LP(win_ml_t); prep_weights<true>(launder(F), q.win_ml_t, 3072, D, ML_COLS, ColPlain{q.ml_w_in, 3072, 0}, F.bid, F.G, F8_SW); }
    { Params q; LP(ml_w_out); LP(wo_ml_t); prep_weights<true>(launder(F), q.wo_ml_t, D, D, D, ColPlain{q.ml_w_out, D, 0}, F.bid, F.G, F8_SW); }
    { Params q; LP(cmp_w1); LP(w1c_t); prep_weights(launder(F), q.w1c_t, 256, 2048, 256, ColPlain{q.cmp_w1, 256, 0}, F.bid, F.G);
      prep_weights(launder(F), q.w1c_t + (size_t)256 * 2048, 256, 2048, 256, ColPlain{q.cmp_w1 + (size_t)2048 * 256, 256, 0}, F.bid, F.G); }
    { Params q; LP(w_gate); LP(w_up); LP(w_down); LP(gu_t); LP(dn_t); prep_moe_weights(q, launder(F), 0, F.bid, F.G); }
    GRID_BAR();
    { Params q; LP(x); LP(g_mix); LP(mod); LP(h);
      phase_norm<0, false>(q, launder(F), q.x, nullptr, q.g_mix, MOD0 + 0 * D, MOD0 + 1 * D, nullptr, 0); }
    GRID_BAR();
    { Params q; LP(h); LP(win_nsa_t); LP(q_gain); LP(k_gain); LP(rope); LP(q); LP(kv); LP(gates);
      ge::DenseOrder So; So.init(T, 2048, F.G, F.bid);
      ge::gemm_phase<true>(stage, q.h, q.win_nsa_t, D, So, ge::DenseRows{(unsigned)D}, EpiNsaIn{q.q_gain, q.k_gain, q.rope, q.q, q.kv, q.gates, 1.f / (F8_SA * F8_SW)}, F.wave); }
    GRID_BAR();
    {
      Params q; LP(kv); LP(w1c_t); LP(cpart);
      const int w = F.bid >> 7, mt = (F.bid >> 3) & 15, ks = F.bid & 7; OneUnit So{mt};
      ge::gemm_phase(stage, q.kv + (size_t)w * T * 128 + ks * 256, q.w1c_t + (size_t)w * 256 * 2048 + ks * 256, 256, So, ge::DenseRows{2048u}, EpiCmpPart{(float*)((bf16_t*)q.cpart + (size_t)(w * 8 + ks) * 4096 * 256)}, F.wave, 2048); }
    GRID_BAR();
    { Params q; LP(cpart); LP(cb1); LP(cmp_w2); LP(cmp_b2); LP(k_gain); LP(rope); LP(kcmp); LP(vcmp);
      phase_cmp2(q, launder(F)); }
    GRID_BAR();
    { Params q; LP(q); LP(kv); LP(kcmp); LP(vcmp); LP(gates); LP(h); LP(q_gain); LP(k_gain);
      phase_attn(q, launder(F)); }
    GRID_BAR();
    { Params q; LP(h); LP(wo_nsa_t); LP(x); LP(mod); LP(xb13);
      ge::DenseOrder So; So.init(T, D, F.G, F.bid);
      ge::gemm_phase<true>(stage, q.h, q.wo_nsa_t, D, So, ge::DenseRows{(unsigned)D}, EpiResid<false>{q.x, MOD0 + 2 * D, q.xb13, 1.f / (F8_SA * F8_SW)}, F.wave); }
    GRID_BAR();
    { Params q; LP(xb13); LP(g_ffn); LP(mod); LP(h); LP(router_w); LP(router_b); LP(tokw); LP(cnt); LP(list);
      phase_norm_route(q, launder(F), q.xb13, q.g_ffn, MOD0 + 3 * D, MOD0 + 4 * D, 0); }
    GRID_BAR();
    { Params q; LP(cnt); LP(list); LP(h); LP(gu_t); LP(hid);
      LAS int* mtab = (LAS int*)(F.lds + LDS_MISC + 64); LAS int* tkt = (LAS int*)(F.lds + LDS_CONST); moe_plan(launder(F), q.cnt, q.list, mtab, tkt, 4); MoeOrder So{mtab};
      ge::gemm_phase<true>(stage, q.h, q.gu_t, D, So, MoeRows{tkt}, EpiMoe1{(unsigned char*)q.hid, 1.f / (F8_SA * F8_SW)}, F.wave); }
    GRID_BAR();
    { Params q; LP(cnt); LP(list); LP(hid); LP(dn_t); LP(outk); LP(tokw);
      LAS int* mtab = (LAS int*)(F.lds + LDS_MISC + 64); LAS int* tkt = (LAS int*)(F.lds + LDS_CONST); LAS float* tkw = (LAS float*)(F.lds + 131072); moe_plan(launder(F), q.cnt, q.list, mtab, tkt, 4, q.tokw, tkw, F8_SO / (F8_SH * F8_SW2)); MoeOrder So{mtab};
      ge::gemm_phase<true>(stage, q.hid, q.dn_t, DE, So, ge::DenseRows{(unsigned)DE}, EpiMoe2{q.outk, tkt, tkw}, F.wave); }
    GRID_BAR();
    { Params q; LP(xb13); LP(xb2); LP(g_mix); LP(mod); LP(h); LP(outk); LP(ml_w_in); LP(ml_bi); LP(ml_bf); LP(li); LP(lf);
      phase_norm<2, true>(q, launder(F), q.xb13, q.xb2, q.g_mix + D, MOD1 + 0 * D, MOD1 + 1 * D, MOD0 + 5 * D, 1); }
    GRID_BAR();
    { Params q; LP(h); LP(win_ml_t); LP(proj);
      ge::DenseOrder So; So.init(T, 3072, F.G, F.bid);
      ge::gemm_phase<true>(stage, q.h, q.win_ml_t, D, So, ge::DenseRows{(unsigned)D}, EpiMlIn{q.proj, 1.f / (F8_SA * F8_SW)}, F.wave); }
    GRID_BAR();
    { Params q; LP(proj); LP(li); LP(lf); LP(w_gate); LP(w_up); LP(w_down); LP(gu_t); LP(dn_t);
      phase_scan(q, launder(F), q.proj + 1024, 3072); }
    GRID_BAR();
    { Params q; LP(proj); LP(ml_ng); LP(h);
      phase_ml_gate(q, launder(F), (unsigned char*)q.h); }
    GRID_BAR();
    { Params q; LP(h); LP(wo_ml_t); LP(xb2); LP(mod); LP(xb13);
      ge::DenseOrder So; So.init(T, D, F.G, F.bid);
      ge::gemm_phase<true>(stage, q.h, q.wo_ml_t, D, So, ge::DenseRows{(unsigned)D}, EpiResid<true>{q.xb2, MOD1 + 2 * D, q.xb13, 1.f / (F8_SA * F8_SW)}, F.wave); }
    GRID_BAR();
    { Params q; LP(xb13); LP(g_ffn); LP(mod); LP(h); LP(router_w); LP(router_b); LP(tokw); LP(cnt); LP(list);
      phase_norm_route(q, launder(F), q.xb13, q.g_ffn + D, MOD1 + 3 * D, MOD1 + 4 * D, 1); }
    GRID_BAR();
    { Params q; LP(cnt); LP(list); LP(h); LP(gu_t); LP(hid);
      LAS int* mtab = (LAS int*)(F.lds + LDS_MISC + 64); LAS int* tkt = (LAS int*)(F.lds + LDS_CONST); moe_plan(launder(F), q.cnt + 64, q.list, mtab, tkt, 4); MoeOrder So{mtab};
      ge::gemm_phase<true>(stage, q.h, q.gu_t, D, So, MoeRows{tkt}, EpiMoe1{(unsigned char*)q.hid, 1.f / (F8_SA * F8_SW)}, F.wave); }
    GRID_BAR();
    { Params q; LP(cnt); LP(list); LP(hid); LP(dn_t); LP(outk); LP(tokw);
      LAS int* mtab = (LAS int*)(F.lds + LDS_MISC + 64); LAS int* tkt = (LAS int*)(F.lds + LDS_CONST); LAS float* tkw = (LAS float*)(F.lds + 131072); moe_plan(launder(F), q.cnt + 64, q.list, mtab, tkt, 4, q.tokw, tkw, F8_SO / (F8_SH * F8_SW2)); MoeOrder So{mtab};
      ge::gemm_phase<true>(stage, q.hid, q.dn_t, DE, So, ge::DenseRows{(unsigned)DE}, EpiMoe2{q.outk, tkt, tkw}, F.wave); }
    GRID_BAR();
    { Params q; LP(mod); LP(out); LP(outk); LP(xb13);
      phase_final(q, launder(F), q.out); }
}

static inline size_t al(size_t x) { return (x + 255) & ~(size_t)255; }
extern "C" void kernel_launch(void* const* d_in, const int* in_sizes, int n_in, void* d_out, int out_size, void* d_ws, size_t ws_size, hipStream_t stream) {
    char* ws = (char*)d_ws; size_t off = 0;
    auto take = [&](size_t bytes) { size_t o = off; off = al(off + bytes); return o; };
    Params p{};
    const float** pin = (const float**)&p;
    for (int i = 0; i < 25; ++i) pin[i] = (const float*)d_in[i];
    p.out = (float*)d_out;
    const size_t ctl_bytes = (size_t)XCD_BAR_WORDS * 4 + 1024;
    p.bar = (unsigned*)(ws + take(ctl_bytes)); p.cnt = (int*)(p.bar + XCD_BAR_WORDS); p.dcnt = p.cnt + 128;
    p.mod = (float*)(ws + take((size_t)2 * 16 * 6144 * 4)); p.rope = (float*)(ws + take(2048 * 16 * 4)); p.cb1 = (float*)(ws + take(512 * 4));
    p.tokw = (float*)(ws + take((size_t)T * 2 * 4)); p.list = (int*)(ws + take((size_t)NE * T * 4)); p.dlist = (int*)(ws + take((size_t)NE * T * 4)); p.li = (float*)(ws + take((size_t)T * 4 * 4)); p.lf = (float*)(ws + take((size_t)T * 4 * 4));
    p.h = (bf16_t*)(ws + take((size_t)(T + 8) * D * 2)); p.hidc = (bf16_t*)(ws + take((size_t)2 * 4096 * 256 * 2)); p.xb13 = (bf16_t*)(ws + take((size_t)T * D * 2)); p.xb2 = (bf16_t*)(ws + take((size_t)T * D * 2));
    p.wo_nsa_t = (bf16_t*)(ws + take((size_t)D * D * 2)); p.wo_ml_t = (bf16_t*)(ws + take((size_t)D * D * 2));
    p.win_nsa_t = (bf16_t*)(ws + take((size_t)2048 * D * 2)); p.win_ml_t = (bf16_t*)(ws + take((size_t)3072 * D * 2)); p.w1c_t = (bf16_t*)(ws + take((size_t)2 * 256 * 2048 * 2));
    p.gu_t = (bf16_t*)(ws + take((size_t)NE * 1024 * D * 2)); p.dn_t = (bf16_t*)(ws + take((size_t)NE * D * DE * 2));
    const size_t r1 = off;
    p.q = (bf16_t*)(ws + take((size_t)T * D * 2)); p.kv = (bf16_t*)(ws + take((size_t)6 * T * 128 * 2 + (1 << 20)));
    p.gates = (float*)(ws + take((size_t)T * 48 * 4)); p.kcmp = (bf16_t*)(ws + take((size_t)32 * 128 * 64 * 2)); p.vcmp = (bf16_t*)(ws + take((size_t)32 * 128 * 64 * 2));
    p.cpart = (float*)(ws + take((size_t)2 * 8 * 4096 * 256 * 4));
    const size_t end_nsa = off; off = r1;
    p.proj = (bf16_t*)(ws + take((size_t)T * 3072 * 2)); const size_t end_ml = off; off = r1;
    p.hid = (bf16_t*)(ws + take((size_t)(65536 + 8192) * DE * 2)); p.outk = (bf16_t*)(ws + take((size_t)2 * T * D * 2)); const size_t end_moe = off;
    size_t need = end_nsa > end_ml ? end_nsa : end_ml; if (end_moe > need) need = end_moe;
    if (need > ws_size || n_in != 25) return;
    static bool attr_done = false;
    if (!attr_done) { (void)hipFuncSetAttribute((const void*)mega_fwd, hipFuncAttributeMaxDynamicSharedMemorySize, LDS_BYTES); attr_done = true; }
    (void)hipMemsetAsync(p.bar, 0, ctl_bytes, stream);
    hipLaunchKernelGGL(mega_fwd, dim3(NWG), dim3(NTHR), LDS_BYTES, stream, p);
}
```

```cpp
#include <hip/hip_runtime.h>
#include <stdint.h>

typedef unsigned short bf16_t;
__device__ __forceinline__ float bf2f(bf16_t v) { return __uint_as_float(((unsigned)v) << 16); }
typedef float f32x2_t __attribute__((ext_vector_type(2)));
__device__ __forceinline__ unsigned pk2g(float a, float b) { typedef __bf16 b2 __attribute__((ext_vector_type(2))); b2 r = __builtin_convertvector((f32x2_t){a, b}, b2); return __builtin_bit_cast(unsigned, r); }
__device__ __forceinline__ bf16_t f2bf(float f) { return (bf16_t)pk2g(f, f); }
__device__ __forceinline__ unsigned pk4_fp8(float a, float b, float c, float d) { int w = 0;
    w = __builtin_amdgcn_cvt_pk_fp8_f32(__builtin_amdgcn_fmed3f(a, -448.f, 448.f), __builtin_amdgcn_fmed3f(b, -448.f, 448.f), w, false);
    w = __builtin_amdgcn_cvt_pk_fp8_f32(__builtin_amdgcn_fmed3f(c, -448.f, 448.f), __builtin_amdgcn_fmed3f(d, -448.f, 448.f), w, true); return (unsigned)w; }

constexpr int Bn = 16, S = 2048, D = 1024, T = Bn * S;
constexpr int NSA_COLS = 1840, ML_COLS = 3080;
constexpr int NE = 32, DE = 512;
constexpr int NWG = 256, NTHR = 512;

template <int M> __device__ __forceinline__ float sx(float v) { return __int_as_float(__builtin_amdgcn_ds_swizzle(__float_as_int(v), (M << 10) | 0x1F)); }
template <int M> __device__ __forceinline__ unsigned sxu(unsigned v) { return (unsigned)__builtin_amdgcn_ds_swizzle((int)v, (M << 10) | 0x1F); }
__device__ __forceinline__ float sum32(float v) { const auto r = __builtin_amdgcn_permlane32_swap(__float_as_uint(v), __float_as_uint(v), false, false); return __uint_as_float(r[0]) + __uint_as_float(r[1]); }
__device__ __forceinline__ float max32(float v) { const auto r = __builtin_amdgcn_permlane32_swap(__float_as_uint(v), __float_as_uint(v), false, false); return fmaxf(__uint_as_float(r[0]), __uint_as_float(r[1])); }
__device__ __forceinline__ float other32(float v, bool hi) { const auto r = __builtin_amdgcn_permlane32_swap(__float_as_uint(v), __float_as_uint(v), false, false); return __uint_as_float(hi ? r[0] : r[1]); }
template <int CTRL> __device__ __forceinline__ float dppf(float v) { return __int_as_float(__builtin_amdgcn_update_dpp(0, __float_as_int(v), CTRL, 0xF, 0xF, true)); }
__device__ __forceinline__ float sum16(float v) { const auto r = __builtin_amdgcn_permlane16_swap(__float_as_uint(v), __float_as_uint(v), false, false); return __uint_as_float(r[0]) + __uint_as_float(r[1]); }
__device__ __forceinline__ float max16(float v) { const auto r = __builtin_amdgcn_permlane16_swap(__float_as_uint(v), __float_as_uint(v), false, false); return fmaxf(__uint_as_float(r[0]), __uint_as_float(r[1])); }
__device__ __forceinline__ float wave_sum(float v) { v += dppf<0xB1>(v); v += dppf<0x4E>(v); v += dppf<0x141>(v); v += dppf<0x140>(v); v = sum16(v); return sum32(v); }
__device__ __forceinline__ float wave_max(float v) { v = fmaxf(v, dppf<0xB1>(v)); v = fmaxf(v, dppf<0x4E>(v)); v = fmaxf(v, dppf<0x141>(v)); v = fmaxf(v, dppf<0x140>(v)); v = max16(v); return max32(v); }
__device__ __forceinline__ float rdlane(float v, int l) { return __int_as_float(__builtin_amdgcn_readlane(__float_as_int(v), l)); }
__device__ __forceinline__ float sigmoidf_(float x) { return 1.f / (1.f + expf(-x)); }
__device__ __forceinline__ float fsigmoid(float x) { return __builtin_amdgcn_rcpf(1.f + __builtin_amdgcn_exp2f(-1.4426950408889634f * x)); }
__device__ __forceinline__ float ftanh(float x) { return 1.f - 2.f * __builtin_amdgcn_rcpf(1.f + __builtin_amdgcn_exp2f(2.8853900817779268f * x)); }

#define XB_TMO      128
#define XB_XCNT(j)  (256  + 64 * (j))
#define XB_XSUB(j)  (1280 + 64 * (j))
#define XB_XGEN(j)  (2304 + 64 * (j))
#define XB_TOP      3328
#define XB_TOPGEN   3392
#define XCD_BAR_WORDS 3456
#define XB_SPIN_CAP (1u << 18)
#define LAS __attribute__((address_space(3)))
__device__ __forceinline__ unsigned xb_ld(unsigned* p)              { return __hip_atomic_load(p, __ATOMIC_RELAXED, __HIP_MEMORY_SCOPE_AGENT); }
__device__ __forceinline__ unsigned xb_add(unsigned* p, unsigned v) { return __hip_atomic_fetch_add(p, v, __ATOMIC_RELAXED, __HIP_MEMORY_SCOPE_AGENT); }
__device__ __forceinline__ unsigned xb_xcc_id() { return (unsigned)__builtin_amdgcn_s_getreg((3 << 11) | 20) & 0xFu; }
#define XB_SPIN(cond, bar) do { unsigned _sp = 0; while (cond) { __builtin_amdgcn_s_sleep(1); \
    if ((++_sp & 255u) == 0u) { if (xb_ld(&(bar)[XB_TMO])) break; if (_sp > XB_SPIN_CAP) { atomicAdd(&(bar)[XB_TMO], 1u); break; } } } } while (0)
struct XcdBarrier { unsigned* bar; unsigned x; volatile LAS unsigned* st; };
__device__ __forceinline__ XcdBarrier xcd_barrier_post(unsigned* bar, volatile LAS unsigned* st) {
    XcdBarrier b; b.bar = bar; b.x = xb_xcc_id(); b.st = st;
    if (threadIdx.x == 0) (void)xb_add(&bar[XB_XCNT(b.x)], 1u);
    return b;
}
__device__ __forceinline__ void xcd_barrier_complete(unsigned* bar, unsigned x, unsigned& nloc, unsigned& nx) {
    const unsigned G = gridDim.x * gridDim.y * gridDim.z;
    unsigned sum, cnt, mine, sp = 0u;
    for (;;) {
        sum = 0u; cnt = 0u; mine = 0u;
#pragma unroll
        for (unsigned j = 0; j < 16; ++j) { const unsigned c = xb_ld(&bar[XB_XCNT(j)]); sum += c; cnt += (c > 0u) ? 1u : 0u; mine = (j == x) ? c : mine; }
        if (sum == G) break;
        __builtin_amdgcn_s_sleep(1);
        if ((++sp & 255u) == 0u) { if (xb_ld(&bar[XB_TMO])) break; if (sp > XB_SPIN_CAP) { atomicAdd(&bar[XB_TMO], 1u); break; } }
    }
    nloc = mine > 0u ? mine : 1u; nx = cnt > 0u ? cnt : 1u;
}
__device__ __forceinline__ void xcd_barrier(const XcdBarrier& b, const bool leader  ) {
    asm volatile("s_waitcnt vmcnt(0)" ::: "memory");
    __syncthreads();
    if (leader) {
        unsigned* bar = b.bar;
        __builtin_amdgcn_s_waitcnt(0);
        unsigned nloc = b.st[0], nx = b.st[1];
        if (nloc == 0u) { xcd_barrier_complete(bar, b.x, nloc, nx); b.st[0] = nloc; b.st[1] = nx; }
        const unsigned old = xb_add(&bar[XB_XSUB(b.x)], 1u);
        const unsigned gen = old / nloc;
        if (old + 1u == (gen + 1u) * nloc) {
            __builtin_amdgcn_fence(__ATOMIC_RELEASE, "agent");
            asm volatile("s_waitcnt vmcnt(0)" ::: "memory");
            const unsigned og = xb_add(&bar[XB_TOP], 1u);
            const unsigned tg = og / nx;
            if (og + 1u == (tg + 1u) * nx) xb_add(&bar[XB_TOPGEN], 1u);
            else XB_SPIN(xb_ld(&bar[XB_TOPGEN]) == tg, bar);
            __builtin_amdgcn_fence(__ATOMIC_ACQUIRE, "agent");
            xb_add(&bar[XB_XGEN(b.x)], 1u);
            asm volatile("s_waitcnt vmcnt(0)" ::: "memory");
        } else {
            XB_SPIN(xb_ld(&bar[XB_XGEN(b.x)]) == gen, bar);
            __builtin_amdgcn_fence(__ATOMIC_ACQUIRE, "agent");
            asm volatile("s_waitcnt vmcnt(0)" ::: "memory");
        }
    }
    __syncthreads();
}

typedef short bf16x8 __attribute__((ext_vector_type(8)));
typedef float f32x4 __attribute__((ext_vector_type(4)));
namespace ge {
constexpr int BM = 256, BK = 64, HALF = 128, HTB = HALF * BK * 2, STAGE_BYTES = 8 * HTB;
__host__ __device__ __forceinline__ int lds_byte(int r, int c) { const int st = (r >> 4) * 2 + (c >> 5), rr = r & 15, cc = c & 31, ob = rr * 64 + cc * 2; return st * 1024 + (ob ^ (((ob >> 9) & 1) << 5)); }
__host__ __device__ __forceinline__ void stage_rc(int b, int& R, int& C) { const int st = b / 1024, sb = b % 1024, swz = sb ^ (((sb >> 9) & 1) << 5); R = (st >> 1) * 16 + swz / 64; C = (st & 1) * 32 + (swz % 64) / 2; }
struct Unit { int pm, pn, bt, aux; };
__host__ __device__ __forceinline__ int logical_col(int c) { const int pn = c >> 8, bj = (c >> 7) & 1, wc = (c >> 5) & 3, n = (c >> 4) & 1, fq = (c >> 2) & 3, j = c & 3; return (4 * pn + wc) * 64 + 16 * fq + 8 * bj + 4 * n + j; }
struct DenseOrder {
    int nM, nN, nwg, G, c;
    __device__ void init(int M, int N, int G_, int c_) { nM = M / BM; nN = N / BM; nwg = nM * nN; G = G_; c = c_; }
    __device__ bool next(int i, Unit& u) const {
        const long L = (long)i * G + c; if (L >= nwg) return false;
        int wgid = (int)L; { const int q = nwg / 8, r = nwg % 8, xcd = wgid % 8, off = wgid / 8; wgid = (xcd < r ? xcd * (q + 1) : r * (q + 1) + (xcd - r) * q) + off; }
        const int nig = 8 * nN, gid = wgid / nig, fm = gid * 8, gsz = (nM - fm) < 8 ? (nM - fm) : 8;
        u.pm = fm + ((wgid % nig) % gsz); u.pn = (wgid % nig) / gsz; u.bt = u.pn; u.aux = 0; return true;
    }
};
struct DenseRows { static constexpr bool dense = true; unsigned ldab; __device__ __forceinline__ unsigned operator()(const Unit& u, int r) const { return (unsigned)(u.pm * 256 + r) * ldab; } };
template <class Tp> __device__ __forceinline__ Tp* uni(Tp* v) { const unsigned long long u = (unsigned long long)v; const unsigned lo = __builtin_amdgcn_readfirstlane((unsigned)u), hi = __builtin_amdgcn_readfirstlane((unsigned)(u >> 32)); return (Tp*)(((unsigned long long)hi << 32) | lo); }

typedef int i32x8 __attribute__((ext_vector_type(8)));
typedef int i32x4 __attribute__((ext_vector_type(4)));
template <bool F8> struct Frag;
template <> struct Frag<false> { bf16x8 v[2]; };
template <> struct Frag<true> { i32x8 v; };
template <bool F8> __device__ __forceinline__ void load_frag(Frag<F8>& f, const LAS unsigned char* p0) {
    if constexpr (F8) { const i32x4 lo = *(const LAS i32x4*)p0, hi = *(const LAS i32x4*)(p0 + 16); f.v = __builtin_shufflevector(lo, hi, 0, 1, 2, 3, 4, 5, 6, 7); }
    else { f.v[0] = *(const LAS bf16x8*)p0; f.v[1] = *(const LAS bf16x8*)(p0 + 1024); }
}
template <bool F8> __device__ __forceinline__ f32x4 mma_kt(const Frag<F8>& b, const Frag<F8>& a, f32x4 c) {
    if constexpr (F8) return __builtin_amdgcn_mfma_scale_f32_16x16x128_f8f6f4(b.v, a.v, c, 0, 0, 0, 0x7F7F7F7F, 0, 0x7F7F7F7F);
    else { c = __builtin_amdgcn_mfma_f32_16x16x32_bf16(b.v[0], a.v[0], c, 0, 0, 0); return __builtin_amdgcn_mfma_f32_16x16x32_bf16(b.v[1], a.v[1], c, 0, 0, 0); }
}
template <bool F8 = false, class Sched, class RowMap, class Epi>
__device__ __forceinline__ void gemm_phase(LAS unsigned char* lds, const void* A, const void* Bt, const int K, const Sched& S, const RowMap& RM, const Epi& E, const int wave_id, const int ldb_ = 0  ) {
    int tid_; asm volatile("v_mbcnt_lo_u32_b32 %0, -1, 0\n\tv_mbcnt_hi_u32_b32 %0, -1, %0" : "=v"(tid_)); tid_ += wave_id * 64;
    const int tid = tid_, wid = __builtin_amdgcn_readfirstlane(tid >> 6), lane = tid & 63, wr = wid >> 2, wc = wid & 3, fr = lane & 15, fq = lane >> 4;
    const int nt = K / (F8 ? 2 * BK : BK);
    constexpr bool DR = RowMap::dense;
    int sR[2], sC[2];
    const int ldb = ldb_ ? ldb_ : K;
#pragma unroll
    for (int i = 0; i < 2; ++i) stage_rc(tid * 16 + i * 8192, sR[i], sC[i]);
    const unsigned voffB = F8 ? (unsigned)(sR[0] * ldb + sC[0] * 2) : (unsigned)(sR[0] * ldb + sC[0]) * 2u;
    unsigned ldab_ = 0, voffA = 0; if constexpr (DR) { ldab_ = RM.ldab; voffA = (unsigned)sR[0] * ldab_ + (unsigned)sC[0] * 2u; }
    const size_t kstep = (size_t)(BK * 2), hstepB = (size_t)HALF * ldb * (F8 ? 1 : 2), tstepB = 2 * hstepB, qstepB = hstepB / 2;
    const unsigned ldsw = (unsigned)wid * 1024u;
    const int aoff = lds_byte(wr * 64 + fr, fq * (F8 ? 16 : 8)), boff = lds_byte(wc * 32 + fr, fq * (F8 ? 16 : 8));
    const char* Ab = (const char*)A;
#define GE_SA(b, h) (((b) * 2 + (h)) * ge::HTB)
#define GE_SB(b, h) ((4 + (b) * 2 + (h)) * ge::HTB)
#define GE_GLD(sp, vo, ldsoff) do { unsigned _v = (vo); asm volatile("" : "+v"(_v));     \
        __builtin_amdgcn_global_load_lds((const unsigned*)(uni((const char*)(sp)) + _v), (LAS unsigned*)(lds + (ldsoff)), 16, 0, 0); } while (0)
#define GE_STB(bufoff, gbase) do { _Pragma("unroll") for (int _i = 0; _i < 2; ++_i) GE_GLD((gbase) + _i * qstepB, voffB, (bufoff) + ldsw + _i * 8192); } while (0)
#define GE_STA(bufoff, sp, OFF, h) do { _Pragma("unroll") for (int _i = 0; _i < 2; ++_i) { \
        if constexpr (DR) GE_GLD((sp) + (size_t)((h) * 128 + _i * 64) * ldab_, voffA, (bufoff) + ldsw + _i * 8192); \
        else GE_GLD((sp), (OFF)[h][_i], (bufoff) + ldsw + _i * 8192); } } while (0)
#define GE_LDA(dst, b, h) do { _Pragma("unroll") for (int m = 0; m < 4; ++m) load_frag<F8>(dst[m], lds + GE_SA(b, h) + aoff + m * 2048); } while (0)
#define GE_LDB(dst, b, h) do { _Pragma("unroll") for (int n = 0; n < 2; ++n) load_frag<F8>(dst[n], lds + GE_SB(b, h) + boff + n * 2048); } while (0)
#define GE_MMA(ai, bj, At, Bt_) do { __builtin_amdgcn_s_setprio(1); _Pragma("unroll") for (int m = 0; m < 4; ++m) _Pragma("unroll") for (int n = 0; n < 2; ++n) \
        acc[ai][bj][m][n] = mma_kt<F8>(Bt_[n], At[m], acc[ai][bj][m][n]); __builtin_amdgcn_s_setprio(0); } while (0)
#define GE_WAIT_V(n) asm volatile("s_waitcnt vmcnt(" #n ")" ::: "memory")
#define GE_WAIT_L(n) asm volatile("s_waitcnt lgkmcnt(" #n ")" ::: "memory")
#define GE_BAR __builtin_amdgcn_s_barrier()
#define GE_SCHED __builtin_amdgcn_sched_barrier(0)
#define GE_OFFS(OFF, u) do { int _l; asm volatile("v_mbcnt_lo_u32_b32 %0, -1, 0\n\tv_mbcnt_hi_u32_b32 %0, -1, %0" : "=v"(_l)); int _r0, _c0; stage_rc((wave_id * 64 + _l) * 16, _r0, _c0);     \
        _Pragma("unroll") for (int _h = 0; _h < 2; ++_h) _Pragma("unroll") for (int _i = 0; _i < 2; ++_i) (OFF)[_h][_i] = RM((u), _h * 128 + _i * 64 + _r0) + (unsigned)_c0 * 2u; \
        asm volatile("" : "+v"((OFF)[0][0]), "+v"((OFF)[0][1]), "+v"((OFF)[1][0]), "+v"((OFF)[1][1])); } while (0)
    Unit cur, nxt; int ui = 0;
    if (!S.next(0, cur)) return;
    unsigned offC[2][2];
    const char* aC = Ab; const char* aN = Ab;
    if constexpr (DR) aC = Ab + (size_t)cur.pm * 256 * ldab_; else GE_OFFS(offC, cur);
    f32x4 acc[2][2][4][2];
#pragma unroll
    for (int a = 0; a < 2; ++a)
#pragma unroll
        for (int b = 0; b < 2; ++b)
#pragma unroll
            for (int m = 0; m < 4; ++m)
#pragma unroll
                for (int n = 0; n < 2; ++n) acc[a][b][m][n] = (f32x4){0.f, 0.f, 0.f, 0.f};
    Frag<F8> At[4], B0[2], B1[2];
    const char* cB = (const char*)Bt + (size_t)cur.bt * tstepB;
    GE_STB(GE_SB(0, 0), cB); GE_STA(GE_SA(0, 0), aC, offC, 0); GE_STB(GE_SB(0, 1), cB + hstepB); GE_STA(GE_SA(0, 1), aC, offC, 1);
    if (wr == 1) GE_BAR;
    GE_WAIT_V(4); GE_BAR;
    GE_STB(GE_SB(1, 0), cB + kstep); GE_STA(GE_SA(1, 0), aC + kstep, offC, 0); GE_STB(GE_SB(1, 1), cB + hstepB + kstep);
    GE_WAIT_V(6); GE_BAR;
    for (;;) {
        const bool has_next = S.next(ui + 1, nxt);
        if constexpr (DR) aN = has_next ? Ab + (size_t)nxt.pm * 256 * ldab_ : aC;
        const char* nB = has_next ? (const char*)Bt + (size_t)nxt.bt * tstepB : cB;
#pragma unroll 1
        for (int t = 0; t < nt; t += 2) {
            const bool last = (t == nt - 2);
            const size_t k1 = (size_t)(t + 1) * kstep;
            const size_t k2 = last ? 0 : (size_t)(t + 2) * kstep, k3 = k2 + kstep;
            const char* b2 = last ? nB : cB + (size_t)(t + 2) * kstep; const char* b3 = b2 + kstep;
            const char* a2 = last ? aN : aC;
            GE_LDB(B0, 0, 0); GE_SCHED; GE_LDA(At, 0, 0); GE_STA(GE_SA(1, 1), aC + k1, offC, 1);
            GE_WAIT_L(8); GE_BAR; GE_WAIT_L(0); GE_MMA(0, 0, At, B0); GE_BAR; GE_SCHED;
            GE_LDB(B1, 0, 1); GE_STB(GE_SB(0, 0), b2);
            GE_BAR; GE_WAIT_L(0); GE_MMA(0, 1, At, B1); GE_BAR;
            GE_LDA(At, 0, 1);
            if constexpr (!DR) { if (last && has_next) GE_OFFS(offC, nxt); }
            GE_STA(GE_SA(0, 0), a2 + k2, offC, 0);
            GE_BAR; GE_WAIT_L(0); GE_MMA(1, 0, At, B0); GE_BAR; GE_SCHED;
            GE_STB(GE_SB(0, 1), b2 + hstepB);
            GE_WAIT_V(6); GE_BAR; GE_MMA(1, 1, At, B1); GE_BAR;
            GE_LDB(B0, 1, 0); GE_SCHED; GE_LDA(At, 1, 0); GE_STA(GE_SA(0, 1), a2 + k2, offC, 1);
            GE_WAIT_L(8); GE_BAR; GE_WAIT_L(0); GE_MMA(0, 0, At, B0); GE_BAR; GE_SCHED;
            GE_LDB(B1, 1, 1); GE_STB(GE_SB(1, 0), b3);
            GE_BAR; GE_WAIT_L(0); GE_MMA(0, 1, At, B1); GE_BAR;
            GE_LDA(At, 1, 1); GE_STA(GE_SA(1, 0), a2 + k3, offC, 0);
            GE_BAR; GE_WAIT_L(0); GE_MMA(1, 0, At, B0); GE_BAR; GE_SCHED;
            GE_STB(GE_SB(1, 1), b3 + hstepB);
            GE_WAIT_V(6); GE_BAR; GE_MMA(1, 1, At, B1); GE_BAR;
        }
#pragma unroll
        for (int a = 0; a < 2; ++a)
#pragma unroll
            for (int b = 0; b < 2; ++b) asm volatile("" : "+v"(acc[a][b][0][0]), "+v"(acc[a][b][0][1]), "+v"(acc[a][b][1][0]), "+v"(acc[a][b][1][1]), "+v"(acc[a][b][2][0]), "+v"(acc[a][b][2][1]), "+v"(acc[a][b][3][0]), "+v"(acc[a][b][3][1]));
        { int l2; asm volatile("v_mbcnt_lo_u32_b32 %0, -1, 0\n\tv_mbcnt_hi_u32_b32 %0, -1, %0" : "=v"(l2)); E(acc, cur, wr, wc, l2 & 15, l2 >> 4); }
        if (!has_next) break;
#pragma unroll
        for (int a = 0; a < 2; ++a)
#pragma unroll
            for (int b = 0; b < 2; ++b)
#pragma unroll
                for (int m = 0; m < 4; ++m)
#pragma unroll
                    for (int n = 0; n < 2; ++n) acc[a][b][m][n] = (f32x4){0.f, 0.f, 0.f, 0.f};
        cur = nxt; cB = nB; aC = aN; ++ui;
    }
    GE_WAIT_V(0);
    if (wr == 0) GE_BAR;
    GE_BAR;
}
#define GE_VALS(v, acc, ai, m) do { _Pragma("unroll") for (int _b = 0; _b < 2; ++_b) _Pragma("unroll") for (int _n = 0; _n < 2; ++_n) _Pragma("unroll") for (int _j = 0; _j < 4; ++_j) (v)[8 * _b + 4 * _n + _j] = (acc)[ai][_b][m][_n][_j]; } while (0)
}
__device__ __forceinline__ void store16_bf16(bf16_t* dst, const float (&v)[16]) {
    unsigned w[8];
#pragma unroll
    for (int i = 0; i < 8; ++i) w[i] = pk2g(v[2 * i], v[2 * i + 1]);
    uint4* d4 = (uint4*)dst; d4[0] = make_uint4(w[0], w[1], w[2], w[3]); d4[1] = make_uint4(w[4], w[5], w[6], w[7]);
}
template <bool IN_BF16>
struct EpiResid { const void* xin; const float* mod_g; bf16_t* xout; float inscale;
    __device__ __forceinline__ void operator()(const f32x4 (&acc)[2][2][4][2], const ge::Unit& u, int wr, int wc, int fr, int fq) const {
        const int col0 = (4 * u.pn + wc) * 64 + 16 * fq; const int b = (u.pm * 256) / S;
        float4 gq[4];
#pragma unroll
        for (int q4 = 0; q4 < 4; ++q4) { gq[q4] = *(const float4*)(mod_g + b * 6144 + col0 + 4 * q4); gq[q4].x *= inscale; gq[q4].y *= inscale; gq[q4].z *= inscale; gq[q4].w *= inscale; }
        if constexpr (IN_BF16) {
            uint4 xh[2][4][2];
#pragma unroll
            for (int ai = 0; ai < 2; ++ai)
#pragma unroll
                for (int m = 0; m < 4; ++m) { const size_t o = (size_t)(u.pm * 256 + ai * 128 + wr * 64 + m * 16 + fr) * D + col0; xh[ai][m][0] = *(const uint4*)((const bf16_t*)xin + o); xh[ai][m][1] = *(const uint4*)((const bf16_t*)xin + o + 8); }
            const float g16[16] = {gq[0].x, gq[0].y, gq[0].z, gq[0].w, gq[1].x, gq[1].y, gq[1].z, gq[1].w, gq[2].x, gq[2].y, gq[2].z, gq[2].w, gq[3].x, gq[3].y, gq[3].z, gq[3].w};
#pragma unroll
            for (int ai = 0; ai < 2; ++ai)
#pragma unroll
                for (int m = 0; m < 4; ++m) { float v[16]; GE_VALS(v, acc, ai, m);
                    const unsigned w8[8] = {xh[ai][m][0].x, xh[ai][m][0].y, xh[ai][m][0].z, xh[ai][m][0].w, xh[ai][m][1].x, xh[ai][m][1].y, xh[ai][m][1].z, xh[ai][m][1].w};
#pragma unroll
                    for (int k = 0; k < 8; ++k) { v[2 * k] = __uint_as_float(w8[k] << 16) + g16[2 * k] * v[2 * k]; v[2 * k + 1] = __uint_as_float(w8[k] & 0xFFFF0000u) + g16[2 * k + 1] * v[2 * k + 1]; }
                    store16_bf16(xout + (size_t)(u.pm * 256 + ai * 128 + wr * 64 + m * 16 + fr) * D + col0, v); }
        } else {
#pragma unroll
        for (int ai = 0; ai < 2; ++ai) { float4 xv[4][4];
#pragma unroll
            for (int m = 0; m < 4; ++m) { const size_t o = (size_t)(u.pm * 256 + ai * 128 + wr * 64 + m * 16 + fr) * D + col0;
#pragma unroll
                for (int q4 = 0; q4 < 4; ++q4) xv[m][q4] = *(const float4*)((const float*)xin + o + 4 * q4); }
#pragma unroll
            for (int m = 0; m < 4; ++m) { float v[16]; GE_VALS(v, acc, ai, m); float xr[16];
#pragma unroll
                for (int q4 = 0; q4 < 4; ++q4) { xr[4 * q4] = xv[m][q4].x; xr[4 * q4 + 1] = xv[m][q4].y; xr[4 * q4 + 2] = xv[m][q4].z; xr[4 * q4 + 3] = xv[m][q4].w; }
                const float g16[16] = {gq[0].x, gq[0].y, gq[0].z, gq[0].w, gq[1].x, gq[1].y, gq[1].z, gq[1].w, gq[2].x, gq[2].y, gq[2].z, gq[2].w, gq[3].x, gq[3].y, gq[3].z, gq[3].w};
#pragma unroll
                for (int k = 0; k < 16; ++k) v[k] = xr[k] + g16[k] * v[k];
                store16_bf16(xout + (size_t)(u.pm * 256 + ai * 128 + wr * 64 + m * 16 + fr) * D + col0, v); } }
        }
    } };
struct EpiNsaIn { const float* q_gain; const float* k_gain; const float* rope; bf16_t* q; bf16_t* kv; float* gates; float inscale;
    __device__ __forceinline__ void operator()(const f32x4 (&acc)[2][2][4][2], const ge::Unit& u, int wr, int wc, int fr, int fq) const {
        const int slot = 4 * u.pn + wc; if (slot > 28) return;
        const bool normed = (slot < 16) || slot == 20 || slot == 21 || slot == 24 || slot == 25;
        const float* gain = (slot < 16) ? q_gain : ((slot < 22) ? k_gain + 64 : k_gain + 128);
        float gv[16];
        if (normed) {
#pragma unroll
            for (int i = 0; i < 16; ++i) gv[i] = gain[16 * fq + i]; }
#pragma unroll
        for (int ai = 0; ai < 2; ++ai)
#pragma unroll
            for (int m = 0; m < 4; ++m) { const int row = u.pm * 256 + ai * 128 + wr * 64 + m * 16 + fr; const int b = row / S, s = row % S; float v[16]; GE_VALS(v, acc, ai, m);
#pragma unroll
                for (int i = 0; i < 16; ++i) v[i] *= inscale;
                if (slot == 28) { if (fq < 3) { float* gp = gates + (size_t)row * 48 + 16 * fq;
#pragma unroll
                        for (int q4 = 0; q4 < 4; ++q4) *(float4*)(gp + 4 * q4) = make_float4(fsigmoid(v[4 * q4]), fsigmoid(v[4 * q4 + 1]), fsigmoid(v[4 * q4 + 2]), fsigmoid(v[4 * q4 + 3])); }
                    continue; }
                if (normed) { float ss = 0.f;
#pragma unroll
                    for (int i = 0; i < 16; ++i) ss += v[i] * v[i];
                    ss = sum16(ss); ss = sum32(ss); const float r = rsqrtf(ss * (1.f / 64.f) + 1e-6f);
#pragma unroll
                    for (int i = 0; i < 16; ++i) v[i] *= r * gv[i];
                    if (fq == 0) { const float sf = (float)s;
                        constexpr float IFR[8] = {0.15915494309189535f, 0.030863763158420102f, 0.00598518567638293f, 0.001160663620968869f, 0.00022507907904105153f, 4.364795481173399e-05f, 8.464330549652592e-06f, 1.6414262419538367e-06f};
#pragma unroll
                        for (int i = 0; i < 8; ++i) { const float rev = __builtin_amdgcn_fractf(sf * IFR[i]); const float cs = __builtin_amdgcn_cosf(rev), sn = __builtin_amdgcn_sinf(rev), a = v[i], bb = v[i + 8]; v[i] = a * cs - bb * sn; v[i + 8] = bb * cs + a * sn; } } }
                bf16_t* dst;
                if (slot < 16) dst = q + (size_t)row * D + slot * 64 + 16 * fq;
                else { const int kk = slot - 16, ten = kk >> 1, g = kk & 1; dst = kv + (size_t)ten * T * 128 + ((size_t)(b * 2 + g) * S + s) * 64 + 16 * fq; }
                store16_bf16(dst, v); }
    } };
struct EpiMlIn { bf16_t* proj; float inscale;
    __device__ __forceinline__ void operator()(const f32x4 (&acc)[2][2][4][2], const ge::Unit& u, int wr, int wc, int fr, int fq) const {
        const int slot = 4 * u.pn + wc; const int L0 = slot * 64 + 16 * fq;
#pragma unroll
        for (int ai = 0; ai < 2; ++ai)
#pragma unroll
            for (int m = 0; m < 4; ++m) { const int row = u.pm * 256 + ai * 128 + wr * 64 + m * 16 + fr; float v[16]; GE_VALS(v, acc, ai, m);
                { const float sc = (slot >= 8 && slot < 16) ? 0.08838834764831845f * inscale : inscale;
#pragma unroll
                    for (int i = 0; i < 16; ++i) v[i] *= sc; }
                if (slot >= 32) {
#pragma unroll
                    for (int i = 0; i < 16; ++i) v[i] = fsigmoid(v[i]) * 256.f;
                    *(uint4*)((unsigned char*)(proj + (size_t)row * 3072 + 2048) + (L0 - 2048)) = make_uint4(pk4_fp8(v[0], v[1], v[2], v[3]), pk4_fp8(v[4], v[5], v[6], v[7]), pk4_fp8(v[8], v[9], v[10], v[11]), pk4_fp8(v[12], v[13], v[14], v[15])); }
                else store16_bf16(proj + (size_t)row * 3072 + L0, v); }
    } };
struct OneUnit { int pm; __device__ bool next(int i, ge::Unit& u) const { if (i) return false; u.pm = pm; u.pn = 0; u.bt = 0; u.aux = 0; return true; } };
struct EpiCmpPart { float* part;
    __device__ __forceinline__ void operator()(const f32x4 (&acc)[2][2][4][2], const ge::Unit& u, int wr, int wc, int fr, int fq) const {
        const int L0 = (4 * u.pn + wc) * 64 + 16 * fq;
#pragma unroll
        for (int ai = 0; ai < 2; ++ai)
#pragma unroll
            for (int m = 0; m < 4; ++m) { const int row = u.pm * 256 + ai * 128 + wr * 64 + m * 16 + fr; float v[16]; GE_VALS(v, acc, ai, m); store16_bf16((bf16_t*)part + (size_t)row * 256 + L0, v); }
    } };
struct EpiCmp1 { const float* cb1; bf16_t* hid;
    __device__ __forceinline__ void operator()(const f32x4 (&acc)[2][2][4][2], const ge::Unit& u, int wr, int wc, int fr, int fq) const {
        const int L0 = (4 * u.pn + wc) * 64 + 16 * fq; float bv[16];
#pragma unroll
        for (int i = 0; i < 16; ++i) bv[i] = cb1[L0 + i];
#pragma unroll
        for (int ai = 0; ai < 2; ++ai)
#pragma unroll
            for (int m = 0; m < 4; ++m) { const int row = u.pm * 256 + ai * 128 + wr * 64 + m * 16 + fr; float v[16]; GE_VALS(v, acc, ai, m);
#pragma unroll
                for (int i = 0; i < 16; ++i) { const float x = v[i] + bv[i]; v[i] = 0.5f * x * (1.f + ftanh(0.7978845608028654f * (x + 0.044715f * x * x * x))); }
                store16_bf16(hid + (size_t)row * 256 + L0, v); }
    } };

#define PARAM_LIST(X) \
    X(const float*, x) X(const float*, c) X(const float*, ada_w) X(const float*, ada_b) X(const float*, g_mix) X(const float*, g_ffn) X(const float*, nsa_w_in) X(const float*, nsa_w_out) \
    X(const float*, q_gain) X(const float*, k_gain) X(const float*, cmp_pe) X(const float*, cmp_w1) X(const float*, cmp_b1) X(const float*, cmp_w2) X(const float*, cmp_b2) \
    X(const float*, ml_w_in) X(const float*, ml_bi) X(const float*, ml_bf) X(const float*, ml_ng) X(const float*, ml_w_out) X(const float*, router_w) X(const float*, router_b) \
    X(const float*, w_gate) X(const float*, w_up) X(const float*, w_down) \
    X(float*, out) X(unsigned*, bar) X(int*, cnt) X(float*, mod) X(float*, rope) X(float*, cb1) X(float*, tokw) X(int*, list) X(float*, li) X(float*, lf) \
    X(bf16_t*, h) X(bf16_t*, hidc) X(bf16_t*, xb13) X(bf16_t*, xb2) X(bf16_t*, wo_nsa_t) X(bf16_t*, wo_ml_t) X(bf16_t*, win_nsa_t) X(bf16_t*, win_ml_t) X(bf16_t*, w1c_t) X(bf16_t*, gu_t) X(bf16_t*, dn_t) \
    X(bf16_t*, q) X(bf16_t*, kv) X(float*, gates) X(bf16_t*, kcmp) X(bf16_t*, vcmp) X(bf16_t*, proj) X(bf16_t*, hid) X(bf16_t*, outk) X(int*, dcnt) X(int*, dlist) X(float*, cpart)
struct Params {
#define X(t, n) t n;
    PARAM_LIST(X)
#undef X
};
template <class Tp> __device__ __forceinline__ Tp* uni_ptr(Tp* v) { const unsigned long long u = (unsigned long long)v; const unsigned lo = __builtin_amdgcn_readfirstlane((unsigned)u), hi = __builtin_amdgcn_readfirstlane((unsigned)(u >> 32)); typedef Tp __attribute__((address_space(1))) * GP; return (Tp*)(GP)(((unsigned long long)hi << 32) | lo); }
#define LP(n) q.n = uni_ptr(P->n)
struct Frame { LAS unsigned char* lds; int tid, lane, wave, bid, G; };
__device__ __forceinline__ int lane_id_asm() { int l; asm volatile("v_mbcnt_lo_u32_b32 %0, -1, 0\n\tv_mbcnt_hi_u32_b32 %0, -1, %0" : "=v"(l)); return l; }
__device__ __forceinline__ Frame launder(const Frame& F) { Frame R = F; const int l = lane_id_asm(); int wv = F.wave, bd = F.bid; asm volatile("" : "+s"(wv), "+s"(bd)); R.wave = wv; R.bid = bd; R.tid = wv * 64 + l; R.lane = l; return R; }
constexpr int LDS_GEN = 143872;
constexpr int LDS_MISC = LDS_GEN;
constexpr int LDS_PARAMS = LDS_GEN + 4096;
constexpr int LDS_CONST = LDS_GEN + 6144;
constexpr int LDS_BYTES = LDS_GEN + 18432;

constexpr float F8_SA = 8.f, F8_SW = 32.f, F8_SH = 4.f, F8_SW2 = 32.f, F8_SO = 16.f;
__device__ __forceinline__ float fp8f(unsigned w, int i) { return i == 0 ? __builtin_amdgcn_cvt_f32_fp8((int)w, 0) : i == 1 ? __builtin_amdgcn_cvt_f32_fp8((int)w, 1) : i == 2 ? __builtin_amdgcn_cvt_f32_fp8((int)w, 2) : __builtin_amdgcn_cvt_f32_fp8((int)w, 3); }
template <int NB>
__device__ __forceinline__ void colgemv(const Frame& F, const LAS float* vec, LAS float* part, const float* W, int ldw, int K, int n0, const float* bias, float* out, int out_stride) {
    const int kper = K / 8, kb = F.wave * kper, c4 = F.lane & 15, kq = F.lane >> 4; float acc[NB][4];
#pragma unroll
    for (int b = 0; b < NB; ++b)
#pragma unroll
        for (int j = 0; j < 4; ++j) acc[b][j] = 0.f;
    const float* wp = W + (size_t)(kb + kq) * ldw + n0 + 4 * c4;
#pragma unroll 4
    for (int k = 0; k < kper; k += 4) { const float4 wv = *(const float4*)(wp + (size_t)k * ldw);
#pragma unroll
        for (int b = 0; b < NB; ++b) { const float x = vec[(kb + k + kq) * NB + b]; acc[b][0] += x * wv.x; acc[b][1] += x * wv.y; acc[b][2] += x * wv.z; acc[b][3] += x * wv.w; } }
#pragma unroll
    for (int b = 0; b < NB; ++b)
#pragma unroll
        for (int j = 0; j < 4; ++j) { const float t = sum32(sum16(acc[b][j])); if (kq == 0) part[(F.wave * NB + b) * 64 + 4 * c4 + j] = t; }
    __syncthreads();
    for (int idx = F.tid; idx < NB * 64; idx += NTHR) { const int b = idx >> 6, l = idx & 63; float s = bias[n0 + l];
#pragma unroll
        for (int w = 0; w < 8; ++w) s += part[(w * NB + b) * 64 + l];
        out[(size_t)b * out_stride + n0 + l] = s; }
    __syncthreads();
}
struct ColPlain { const float* W; int ncols; int pad; __device__ const float* operator()(int c) const { const int L = ge::logical_col(c); return L < ncols ? W + L : nullptr; } };
struct ColGateUp { const float* wg; const float* wu; __device__ const float* operator()(int c) const { const int e = c >> 10, cc = c & 1023; const int pn = cc >> 8, bj = (cc >> 7) & 1, wc = (cc >> 5) & 3, n = (cc >> 4) & 1, fq = (cc >> 2) & 3, j = cc & 3;
        const int hidx = 32 * (4 * pn + wc) + 8 * fq + 4 * n + j; const unsigned long long a = (unsigned long long)wg, d = (unsigned long long)wu - a;
        return (const float*)(a + (bj ? d : 0ull)) + (size_t)e * D * DE + hidx; } };
struct ColDown { const float* wd; __device__ const float* operator()(int c) const { const int e = c >> 10; return wd + (size_t)e * DE * D + ge::logical_col(c & 1023); } };
template <bool F8 = false, class ColF>
__device__ __forceinline__ void prep_weights(const Frame& F, void* Bt_, int N, int K, int ldw, const ColF cf, int start, int stride, const float wscale = 1.f) {
    bf16_t* Bt = (bf16_t*)Bt_;
    LAS float* tile = (LAS float*)(F.lds) + (F.tid >> 8) * (128 * 65);
    const int ntx = N / 64, ntiles = ntx * (K / 128), htid = F.tid & 255, half = F.tid >> 8;
    float r[32];
#define PW_LOAD(it_) do { const int tl_ = (it_) * 2 + half; if (tl_ < ntiles) { const int c0_ = (tl_ % ntx) * 64, k0_ = (tl_ / ntx) * 128; const float* p_ = cf(c0_ + (htid & 63)); \
        if (p_) { p_ += (size_t)(k0_ + (htid >> 6)) * ldw; _Pragma("unroll") for (int i_ = 0; i_ < 32; ++i_) r[i_] = p_[(size_t)(4 * i_) * ldw]; } \
        else { _Pragma("unroll") for (int i_ = 0; i_ < 32; ++i_) r[i_] = 0.f; } } } while (0)
    int it = start;
    if (it * 2 < ntiles) PW_LOAD(it);
    for (; it * 2 < ntiles; it += stride) {
        const int tl = it * 2 + half; const bool act = tl < ntiles; const int c0 = (tl % ntx) * 64, k0 = (tl / ntx) * 128;
        if (act) { const int cc = htid & 63;
#pragma unroll
            for (int i = 0; i < 32; ++i) tile[((htid >> 6) + 4 * i) * 65 + cc] = r[i]; }
        __syncthreads();
        if ((it + stride) * 2 < ntiles) PW_LOAD(it + stride);
        if (act) { const int cc = htid >> 2, ch = (htid & 3) * 32;
            if (F8) { unsigned w[8];
#pragma unroll
                for (int i = 0; i < 8; ++i) w[i] = pk4_fp8(tile[(ch + 4 * i) * 65 + cc] * wscale, tile[(ch + 4 * i + 1) * 65 + cc] * wscale, tile[(ch + 4 * i + 2) * 65 + cc] * wscale, tile[(ch + 4 * i + 3) * 65 + cc] * wscale);
                uint4* dst = (uint4*)((unsigned char*)Bt_ + (size_t)(c0 + cc) * K + k0 + ch); dst[0] = make_uint4(w[0], w[1], w[2], w[3]); dst[1] = make_uint4(w[4], w[5], w[6], w[7]); }
            else { unsigned w[16];
#pragma unroll
                for (int i = 0; i < 16; ++i) w[i] = pk2g(tile[(ch + 2 * i) * 65 + cc], tile[(ch + 2 * i + 1) * 65 + cc]);
                uint4* dst = (uint4*)(Bt + (size_t)(c0 + cc) * K + k0 + ch);
#pragma unroll
                for (int q4 = 0; q4 < 4; ++q4) dst[q4] = make_uint4(w[4 * q4], w[4 * q4 + 1], w[4 * q4 + 2], w[4 * q4 + 3]); } }
        __syncthreads();
    }
#undef PW_LOAD
}
__device__ __forceinline__ void prep_moe_weights(const Params& p, const Frame& F, int layer, int start, int stride) {
    const size_t wo = (size_t)layer * NE * D * DE;
    prep_weights<true>(F, p.gu_t, NE * 1024, D, DE, ColGateUp{p.w_gate + wo, p.w_up + wo}, start, stride, F8_SW);
    prep_weights<true>(F, p.dn_t, NE * 1024, DE, D, ColDown{p.w_down + wo}, start, stride, F8_SW2);
}

__device__ __forceinline__ void phase_prologue_a(const Params& p, const Frame& F) {
    for (int i = (F.bid - 200) * NTHR + F.tid; F.bid >= 200 && i < 2048 * 8; i += (F.G - 200) * NTHR) { const int pos = i >> 3, j = i & 7; const float inv = (float)pow(500000.0, -(double)j / 8.0); const float ang = (float)pos * inv;
        p.rope[pos * 16 + j] = (float)cos((double)ang); p.rope[pos * 16 + 8 + j] = (float)sin((double)ang); }
    if (F.bid == F.G - 1) for (int i = F.tid; i < 8 * D / 2; i += NTHR) ((unsigned*)(p.h + (size_t)T * D))[i] = 0u;
}
__device__ __forceinline__ void phase_prologue_b(const Params& p, const Frame& F) {
    LAS float* vec = (LAS float*)F.lds; LAS float* part = (LAS float*)(F.lds + 65536 + 16384);
    if (F.bid < 192) {
        for (int idx = F.tid; idx < 16 * D; idx += NTHR) { const int b = idx >> 10, k = idx & 1023; const float cv = p.c[idx]; vec[k * 16 + b] = cv / (1.f + expf(-cv)); }
        __syncthreads();
        const int i = F.bid / 96, n0 = (F.bid % 96) * 64;
        colgemv<16>(F, vec, part, p.ada_w + (size_t)i * D * 6144, 6144, D, n0, p.ada_b + i * 6144, p.mod + (size_t)i * 16 * 6144, 6144);
    } else if (F.bid < 200) {
        const int it = F.bid - 192, w = it >> 2, n0 = (it & 3) * 64;
        for (int idx = F.tid; idx < 2048; idx += NTHR) vec[idx] = p.cmp_pe[w * 2048 + idx];
        __syncthreads();
        colgemv<1>(F, vec, part, p.cmp_w1 + (size_t)w * 2048 * 256, 256, 2048, n0, p.cmp_b1 + w * 256, p.cb1 + w * 256, 0);
    }
    __syncthreads();
}

template <int MODE, bool XBF>
__device__ __forceinline__ void phase_norm(const Params& p, const Frame& F, const void* xin_, bf16_t* xout, const float* gain, const float* mod_sh, const float* mod_sc, const float* mod_gprev, int layer) {
    constexpr int rows_per_wg = T / NWG, rpw = rows_per_wg / 8;
    constexpr int TP = (MODE == 1) ? 34 : 10;
    const int row0 = F.bid * rows_per_wg;
    LAS float* rw = (LAS float*)F.lds;
    LAS int* lcnt = (LAS int*)(F.lds + LDS_MISC + 64); LAS int* gbase = lcnt + 32; LAS int* ent = gbase + 32;
    if (MODE == 1) { for (int idx = F.tid; idx < D * NE; idx += NTHR) { const int c = idx >> 5; rw[((c & 3) * 256 + (c >> 2)) * TP + (idx & 31)] = p.router_w[idx]; } if (F.tid < 32) lcnt[F.tid] = 0; }
    if (MODE == 2) { for (int idx = F.tid; idx < D * 8; idx += NTHR) { const int c = idx >> 3; rw[((c & 3) * 256 + (c >> 2)) * TP + (idx & 7)] = p.ml_w_in[(size_t)c * ML_COLS + 3072 + (idx & 7)]; } }
    const int b = row0 / S;
    LAS float* cg = (LAS float*)(F.lds + LDS_CONST); LAS float* csh = cg + D; LAS float* cgp = csh + D;
    for (int col = F.tid; col < D; col += NTHR) { cg[col] = gain[col] * (1.f + mod_sc[b * 6144 + col]); csh[col] = mod_sh[b * 6144 + col]; if (MODE == 2) cgp[col] = mod_gprev[b * 6144 + col] * (1.f / F8_SO); }
    __syncthreads();
    const int rbase = row0 + F.wave * rpw;
    float4 xn[4]; unsigned on0[4], on1[4];
#define NORM_LOAD(r_) do { if (XBF) { const bf16_t* xr_ = (const bf16_t*)xin_ + (size_t)(r_) * D + 4 * F.lane; _Pragma("unroll") for (int j_ = 0; j_ < 4; ++j_) { const uint2 t_ = *(const uint2*)(xr_ + 256 * j_); \
            xn[j_] = make_float4(__uint_as_float(t_.x << 16), __uint_as_float(t_.x & 0xFFFF0000u), __uint_as_float(t_.y << 16), __uint_as_float(t_.y & 0xFFFF0000u)); } } \
        else { const float* xr_ = (const float*)xin_ + (size_t)(r_) * D + 4 * F.lane; _Pragma("unroll") for (int j_ = 0; j_ < 4; ++j_) xn[j_] = *(const float4*)(xr_ + 256 * j_); } \
        if (MODE == 2) { const unsigned char* o0_ = (const unsigned char*)p.outk + (size_t)(r_) * D + 4 * F.lane; _Pragma("unroll") for (int j_ = 0; j_ < 4; ++j_) { on0[j_] = *(const unsigned*)(o0_ + 256 * j_); on1[j_] = *(const unsigned*)(o0_ + (size_t)T * D + 256 * j_); } } } while (0)
    NORM_LOAD(rbase);
#pragma unroll 1
    for (int ri = 0; ri < rpw; ++ri) {
        const int row = rbase + ri; float v[16];
#pragma unroll
        for (int j = 0; j < 4; ++j) { v[4 * j] = xn[j].x; v[4 * j + 1] = xn[j].y; v[4 * j + 2] = xn[j].z; v[4 * j + 3] = xn[j].w; }
        if (MODE == 2) {
#pragma unroll
            for (int j = 0; j < 4; ++j) { const f32x4 gq = *(const LAS f32x4*)(cgp + 4 * F.lane + 256 * j);
                v[4 * j] += gq[0] * (fp8f(on0[j], 0) + fp8f(on1[j], 0)); v[4 * j + 1] += gq[1] * (fp8f(on0[j], 1) + fp8f(on1[j], 1));
                v[4 * j + 2] += gq[2] * (fp8f(on0[j], 2) + fp8f(on1[j], 2)); v[4 * j + 3] += gq[3] * (fp8f(on0[j], 3) + fp8f(on1[j], 3));
                uint2 xo_; xo_.x = pk2g(v[4 * j], v[4 * j + 1]); xo_.y = pk2g(v[4 * j + 2], v[4 * j + 3]); *(uint2*)(xout + (size_t)row * D + 4 * F.lane + 256 * j) = xo_; } }
        if (ri + 1 < rpw) NORM_LOAD(row + 1);
        float ss = 0.f;
#pragma unroll
        for (int i = 0; i < 16; ++i) ss += v[i] * v[i];
        ss = wave_sum(ss); const float r = rsqrtf(ss * (1.f / D) + 1e-6f);
#pragma unroll
        for (int j = 0; j < 4; ++j) { const f32x4 g4 = *(const LAS f32x4*)(cg + 4 * F.lane + 256 * j), s4 = *(const LAS f32x4*)(csh + 4 * F.lane + 256 * j);
#pragma unroll
            for (int e = 0; e < 4; ++e) v[4 * j + e] = v[4 * j + e] * r * g4[e] + s4[e];
            if (MODE == 2 || MODE == 0) *(unsigned*)((unsigned char*)p.h + (size_t)row * D + 4 * F.lane + 256 * j) = pk4_fp8(v[4 * j] * F8_SA, v[4 * j + 1] * F8_SA, v[4 * j + 2] * F8_SA, v[4 * j + 3] * F8_SA);
            else { uint2 pk; pk.x = pk2g(v[4 * j], v[4 * j + 1]); pk.y = pk2g(v[4 * j + 2], v[4 * j + 3]); *(uint2*)(p.h + (size_t)row * D + 4 * F.lane + 256 * j) = pk; } }
        if (MODE == 2) { float a8[8];
#pragma unroll
            for (int j = 0; j < 8; ++j) a8[j] = 0.f;
#pragma unroll
            for (int j = 0; j < 4; ++j)
#pragma unroll
                for (int e = 0; e < 4; ++e) { const LAS float* wr_ = rw + (e * 256 + 64 * j + F.lane) * TP; const float hv = v[4 * j + e];
#pragma unroll
                    for (int q2 = 0; q2 < 4; ++q2) { const f32x2_t w2 = *(const LAS f32x2_t*)(wr_ + 2 * q2); a8[2 * q2] += hv * w2[0]; a8[2 * q2 + 1] += hv * w2[1]; } }
#pragma unroll
            for (int j = 0; j < 8; ++j) a8[j] = wave_sum(a8[j]);
            if (F.lane < 8) { float a = 0.f;
#pragma unroll
                for (int j = 0; j < 8; ++j) a = (F.lane == j) ? a8[j] : a;
                if (F.lane < 4) { a += p.ml_bi[F.lane]; p.li[row * 4 + F.lane] = 15.f * tanhf(a / 15.f); }
                else { a += p.ml_bf[F.lane - 4]; const float cc = 15.f * tanhf(a / 15.f); p.lf[row * 4 + F.lane - 4] = (cc >= 0.f) ? -log1pf(expf(-cc)) : (cc - log1pf(expf(cc))); } } }
        if (MODE == 1) { float acc[32];
#pragma unroll
            for (int e = 0; e < 32; ++e) acc[e] = 0.f;
#pragma unroll
            for (int j = 0; j < 4; ++j)
#pragma unroll
                for (int e = 0; e < 4; ++e) { const LAS float* wr_ = rw + (e * 256 + 64 * j + F.lane) * TP; const float hv = v[4 * j + e]; asm volatile("" ::: "memory");
#pragma unroll
                    for (int q2 = 0; q2 < 16; ++q2) { const f32x2_t w2 = *(const LAS f32x2_t*)(wr_ + 2 * q2); acc[2 * q2] += hv * w2[0]; acc[2 * q2 + 1] += hv * w2[1]; } }
            float r16[16], r8[8], r4[4], r2[2], r1;
            { const bool hi = (F.lane & 32) != 0;
#pragma unroll
              for (int i = 0; i < 16; ++i) { const float keep = hi ? acc[16 + i] : acc[i], send = hi ? acc[i] : acc[16 + i]; r16[i] = keep + other32(send, hi); } }
            { const bool hi = (F.lane & 16) != 0;
#pragma unroll
              for (int i = 0; i < 8; ++i) { const float keep = hi ? r16[8 + i] : r16[i], send = hi ? r16[i] : r16[8 + i]; r8[i] = keep + sx<16>(send); } }
            { const bool hi = (F.lane & 8) != 0;
#pragma unroll
              for (int i = 0; i < 4; ++i) { const float keep = hi ? r8[4 + i] : r8[i], send = hi ? r8[i] : r8[4 + i]; r4[i] = keep + sx<8>(send); } }
            { const bool hi = (F.lane & 4) != 0;
#pragma unroll
              for (int i = 0; i < 2; ++i) { const float keep = hi ? r4[2 + i] : r4[i], send = hi ? r4[i] : r4[2 + i]; r2[i] = keep + sx<4>(send); } }
            { const bool hi = (F.lane & 2) != 0; const float keep = hi ? r2[1] : r2[0], send = hi ? r2[0] : r2[1]; r1 = keep + sx<2>(send); }
            r1 += sx<1>(r1);
            const float aff = sigmoidf_(r1); const float ch = aff + p.router_b[F.lane >> 1];
            float bestgs = -3e38f; int be0 = 0, be1 = 0; float ba0 = 0.f, ba1 = 0.f;
#pragma unroll
            for (int g = 0; g < 4; ++g) { float v1 = -3e38f, v2 = -3e38f, a1 = 0.f, a2 = 0.f; int i1 = 0, i2 = 0;
#pragma unroll
                for (int i = 0; i < 8; ++i) { const float a = rdlane(aff, 2 * (g * 8 + i)), c_ = rdlane(ch, 2 * (g * 8 + i));
                    if (c_ > v1) { v2 = v1; a2 = a1; i2 = i1; v1 = c_; a1 = a; i1 = i; } else if (c_ > v2) { v2 = c_; a2 = a; i2 = i; } }
                const float gs = v1 + v2; if (gs > bestgs) { bestgs = gs; be0 = g * 8 + i1; be1 = g * 8 + i2; ba0 = a1; ba1 = a2; } }
            if (F.lane == 0) { const float sum = ba0 + ba1; p.tokw[row * 2] = ba0 / sum; p.tokw[row * 2 + 1] = ba1 / sum;
                const int lr = row - row0; const int r0_ = atomicAdd((int*)&lcnt[be0], 1); const int r1_ = atomicAdd((int*)&lcnt[be1], 1);
                ent[lr * 4 + 0] = be0 | (r0_ << 8); ent[lr * 4 + 1] = row * 2; ent[lr * 4 + 2] = be1 | (r1_ << 8); ent[lr * 4 + 3] = row * 2 + 1; } }
    }
#undef NORM_LOAD
    if (MODE == 1) { __syncthreads();
        if (F.tid < 32) gbase[F.tid] = atomicAdd(&p.cnt[layer * 64 + F.tid], lcnt[F.tid]);
        __syncthreads();
        for (int idx = F.tid; idx < rows_per_wg * 2; idx += NTHR) { const int er = ent[idx * 2], tk = ent[idx * 2 + 1]; const int e = er & 255, rk = er >> 8; p.list[(size_t)e * T + gbase[e] + rk] = tk; }
        __syncthreads(); }
}

__device__ __forceinline__ void phase_norm_route(const Params& p, const Frame& F, const bf16_t* xin, const float* gain, const float* mod_sh, const float* mod_sc, int layer) {
    constexpr int rows_per_wg = T / NWG;
    const int row0 = F.bid * rows_per_wg, b = row0 / S, lane = F.lane, i16 = lane & 15, g = lane >> 4;
    constexpr int RTP = 2064;
    LAS unsigned char* thi = F.lds; LAS unsigned char* tlo = F.lds + 32 * RTP;
    LAS float* cg = (LAS float*)(F.lds + LDS_CONST); LAS float* csh = cg + D; LAS float* bias = csh + D; LAS float* bpart = bias + 32;
    LAS int* lcnt = (LAS int*)(F.lds + LDS_MISC + 64); LAS int* gbase = lcnt + 32; LAS int* ent = gbase + 32;
    for (int col = F.tid; col < D; col += NTHR) { cg[col] = gain[col] * (1.f + mod_sc[b * 6144 + col]); csh[col] = mod_sh[b * 6144 + col]; }
    if (F.tid < 32) lcnt[F.tid] = 0;
    __syncthreads();
    { const int e = F.tid & 31, part = F.tid >> 5; float a = 0.f;
#pragma unroll 8
      for (int k = part * 64; k < part * 64 + 64; k += 2) { const float w0 = p.router_w[k * 32 + e], w1 = p.router_w[(k + 1) * 32 + e];
          a += csh[k] * w0 + csh[k + 1] * w1;
          const float s0 = w0 * cg[k] * 256.f, s1 = w1 * cg[k + 1] * 256.f; const _Float16 h0 = (_Float16)s0, h1 = (_Float16)s1; const _Float16 l0 = (_Float16)(s0 - (float)h0), l1 = (_Float16)(s1 - (float)h1);
          *(LAS unsigned*)(thi + e * RTP + k * 2) = (unsigned)__builtin_bit_cast(unsigned short, h0) | ((unsigned)__builtin_bit_cast(unsigned short, h1) << 16);
          *(LAS unsigned*)(tlo + e * RTP + k * 2) = (unsigned)__builtin_bit_cast(unsigned short, l0) | ((unsigned)__builtin_bit_cast(unsigned short, l1) << 16); }
      bpart[part * 32 + e] = a; }
    __syncthreads();
    if (F.tid < 32) { float a = 0.f;
#pragma unroll
        for (int q = 0; q < 16; ++q) a += bpart[q * 32 + F.tid];
        bias[F.tid] = a; }
    const int rbase = row0 + F.wave * 16;
    const bf16_t* xr = xin + (size_t)(rbase + i16) * D + 8 * g;
    typedef _Float16 f16x8 __attribute__((ext_vector_type(8))); typedef unsigned u32x4r __attribute__((ext_vector_type(4)));
    const LAS unsigned char* bh0 = thi + i16 * RTP + 16 * g; const LAS unsigned char* bh1 = bh0 + 16 * RTP; const LAS unsigned char* bl0 = tlo + i16 * RTP + 16 * g; const LAS unsigned char* bl1 = bl0 + 16 * RTP;
    f32x4 acc0 = (f32x4){0.f, 0.f, 0.f, 0.f}, acc1 = (f32x4){0.f, 0.f, 0.f, 0.f}; float ss = 0.f;
    uint4 xa[2][8];
#define RT_LOAD(s_, q_) do { _Pragma("unroll") for (int u_ = 0; u_ < 8; ++u_) xa[s_][u_] = *(const uint4*)(xr + 32 * (8 * (q_) + u_)); } while (0)
    RT_LOAD(0, 0);
#pragma unroll
    for (int qd = 0; qd < 4; ++qd) {
        if (qd + 1 < 4) RT_LOAD((qd + 1) & 1, qd + 1);
#pragma unroll
        for (int u = 0; u < 8; ++u) { const int so = (8 * qd + u) * 64;
            const uint4 xc = xa[qd & 1][u]; const unsigned xw[4] = {xc.x, xc.y, xc.z, xc.w}; u32x4r ap;
#pragma unroll
            for (int i = 0; i < 4; ++i) { const float f0 = __uint_as_float(xw[i] << 16), f1 = __uint_as_float(xw[i] & 0xFFFF0000u); ss += f0 * f0 + f1 * f1; ap[i] = __builtin_bit_cast(unsigned, __builtin_amdgcn_cvt_pkrtz(f0, f1)); }
            const f16x8 a8 = __builtin_bit_cast(f16x8, ap);
            const f16x8 b0h = *(const LAS f16x8*)(bh0 + so), b0l = *(const LAS f16x8*)(bl0 + so), b1h = *(const LAS f16x8*)(bh1 + so), b1l = *(const LAS f16x8*)(bl1 + so);
            acc0 = __builtin_amdgcn_mfma_f32_16x16x32_f16(a8, b0h, acc0, 0, 0, 0); acc1 = __builtin_amdgcn_mfma_f32_16x16x32_f16(a8, b1h, acc1, 0, 0, 0);
            acc0 = __builtin_amdgcn_mfma_f32_16x16x32_f16(a8, b0l, acc0, 0, 0, 0); acc1 = __builtin_amdgcn_mfma_f32_16x16x32_f16(a8, b1l, acc1, 0, 0, 0); }
    }
#undef RT_LOAD
    ss = sum16(ss); ss = sum32(ss); const float r = rsqrtf(ss * (1.f / D) + 1e-6f);
    float af0[4], af1[4];
#pragma unroll
    for (int rr = 0; rr < 4; ++rr) { const float rrow = __int_as_float(__builtin_amdgcn_ds_bpermute((4 * g + rr) * 4, __float_as_int(r)));
        af0[rr] = sigmoidf_(rrow * (1.f / 256.f) * acc0[rr] + bias[i16]); af1[rr] = sigmoidf_(rrow * (1.f / 256.f) * acc1[rr] + bias[16 + i16]); }
    __syncthreads();
    LAS float* affl = (LAS float*)F.lds + F.wave * 512;
#pragma unroll
    for (int rr = 0; rr < 4; ++rr) { affl[(4 * g + rr) * 32 + i16] = af0[rr]; affl[(4 * g + rr) * 32 + 16 + i16] = af1[rr]; }
    asm volatile("s_waitcnt lgkmcnt(0)" ::: "memory");
    if (lane < 16) { const int row = rbase + lane; const LAS float* ar = affl + lane * 32;
        float bestgs = -3e38f; int be0 = 0, be1 = 0; float ba0 = 0.f, ba1 = 0.f;
#pragma unroll
        for (int gg = 0; gg < 4; ++gg) { float v1 = -3e38f, v2 = -3e38f, a1 = 0.f, a2 = 0.f; int i1 = 0, i2 = 0;
#pragma unroll
            for (int i = 0; i < 8; ++i) { const float a = ar[gg * 8 + i], c_ = a + p.router_b[gg * 8 + i];
                if (c_ > v1) { v2 = v1; a2 = a1; i2 = i1; v1 = c_; a1 = a; i1 = i; } else if (c_ > v2) { v2 = c_; a2 = a; i2 = i; } }
            const float gs = v1 + v2; if (gs > bestgs) { bestgs = gs; be0 = gg * 8 + i1; be1 = gg * 8 + i2; ba0 = a1; ba1 = a2; } }
        const float sum = ba0 + ba1; p.tokw[row * 2] = ba0 / sum; p.tokw[row * 2 + 1] = ba1 / sum;
        const int lr = row - row0; const int r0_ = atomicAdd((int*)&lcnt[be0], 1); const int r1_ = atomicAdd((int*)&lcnt[be1], 1);
        ent[lr * 4 + 0] = be0 | (r0_ << 8); ent[lr * 4 + 1] = row * 2; ent[lr * 4 + 2] = be1 | (r1_ << 8); ent[lr * 4 + 3] = row * 2 + 1; }
    { uint2 xq[2][4][4];
#define NR_LOAD(s_, r_) do { _Pragma("unroll") for (int k_ = 0; k_ < 4; ++k_) { const bf16_t* xq_ = xin + (size_t)((r_) + k_) * D + 4 * lane; _Pragma("unroll") for (int j_ = 0; j_ < 4; ++j_) xq[s_][k_][j_] = *(const uint2*)(xq_ + 256 * j_); } } while (0)
      NR_LOAD(0, rbase);
#pragma unroll
      for (int g4 = 0; g4 < 4; ++g4) {
          if (g4 + 1 < 4) NR_LOAD((g4 + 1) & 1, rbase + 4 * (g4 + 1));
#pragma unroll
          for (int k = 0; k < 4; ++k) { const int row = rbase + 4 * g4 + k; const float rr_ = rdlane(r, 4 * g4 + k);
#pragma unroll
              for (int j = 0; j < 4; ++j) { const f32x4 g4v = *(const LAS f32x4*)(cg + 4 * lane + 256 * j), s4_ = *(const LAS f32x4*)(csh + 4 * lane + 256 * j); const uint2 xc = xq[g4 & 1][k][j];
                  const float x0 = __uint_as_float(xc.x << 16), x1 = __uint_as_float(xc.x & 0xFFFF0000u), x2 = __uint_as_float(xc.y << 16), x3 = __uint_as_float(xc.y & 0xFFFF0000u);
                  *(unsigned*)((unsigned char*)p.h + (size_t)row * D + 4 * lane + 256 * j) = pk4_fp8((x0 * rr_ * g4v[0] + s4_[0]) * F8_SA, (x1 * rr_ * g4v[1] + s4_[1]) * F8_SA, (x2 * rr_ * g4v[2] + s4_[2]) * F8_SA, (x3 * rr_ * g4v[3] + s4_[3]) * F8_SA); } } }
#undef NR_LOAD
    }
    __syncthreads();
    if (F.tid < 32) gbase[F.tid] = atomicAdd(&p.cnt[layer * 64 + F.tid], lcnt[F.tid]);
    __syncthreads();
    for (int idx = F.tid; idx < rows_per_wg * 2; idx += NTHR) { const int er = ent[idx * 2], tk = ent[idx * 2 + 1]; const int e = er & 255, rk = er >> 8; p.list[(size_t)e * T + gbase[e] + rk] = tk; }
    __syncthreads();
}

struct MoeOrder { const LAS int* tab;
    __device__ bool next(int i, ge::Unit& u) const { if (i >= 8) return false; const int pm = __builtin_amdgcn_readfirstlane(tab[4 * i]); if (pm < 0) return false;
        u.pm = pm; u.pn = __builtin_amdgcn_readfirstlane(tab[4 * i + 1]); u.bt = __builtin_amdgcn_readfirstlane(tab[4 * i + 2]); u.aux = __builtin_amdgcn_readfirstlane(tab[4 * i + 3]); return true; } };
__device__ __forceinline__ void moe_plan(const Frame& F, const int* cnt, const int* list, LAS int* tab, LAS int* tkt  , int npn, const float* tokw = nullptr, LAS float* tkw = nullptr  , const float wscale = 1.f) {
    LAS int* lc = tab + 32;
    __syncthreads();
    if (F.tid < 32) lc[F.tid] = cnt[F.tid];
    __syncthreads();
    if (F.tid < 8) { const int L = F.tid * F.G + F.bid, mt = L / npn, pn = L % npn; int acc = 0, e_f = -1, mi_f = 0;
#pragma unroll 1
        for (int e = 0; e < NE; ++e) { const int nte = (lc[e] + 255) >> 8; if (e_f < 0 && mt < acc + nte) { e_f = e; mi_f = mt - acc; } acc += nte; }
        tab[4 * F.tid] = e_f < 0 ? -1 : mt; tab[4 * F.tid + 1] = pn; tab[4 * F.tid + 2] = e_f * npn + pn; tab[4 * F.tid + 3] = e_f | (mi_f << 8) | (F.tid << 24); }
    __syncthreads();
#pragma unroll
    for (int q = 0; q < 4; ++q) { const int idx = F.tid + NTHR * q, i = idx >> 8, r = idx & 255; int v = -1;
        if (tab[4 * i] >= 0) { const int aux = tab[4 * i + 3], e = aux & 255, ii = ((aux >> 8) & 0xFFFF) * 256 + r; if (ii < lc[e]) v = list[(size_t)e * T + ii]; }
        tkt[idx] = v; if (tkw) tkw[idx] = v >= 0 ? tokw[v] * wscale : 0.f; }
    __syncthreads();
}
struct MoeRows { static constexpr bool dense = false; const LAS int* tkt; __device__ __forceinline__ unsigned operator()(const ge::Unit& u, int r) const { const int tk = tkt[(u.aux >> 24) * 256 + r]; return tk < 0 ? (unsigned)T * (unsigned)(D * 2) : (unsigned)(tk >> 1) * (unsigned)D; } };
struct EpiMoe1 { unsigned char* hid8; float inscale;
    __device__ __forceinline__ void operator()(const f32x4 (&acc)[2][2][4][2], const ge::Unit& u, int wr, int wc, int fr, int fq) const {
        const int h0 = (4 * u.pn + wc) * 32 + 8 * fq;
#pragma unroll
        for (int ai = 0; ai < 2; ++ai)
#pragma unroll
            for (int m = 0; m < 4; ++m) { const int row = u.pm * 256 + ai * 128 + wr * 64 + m * 16 + fr; unsigned w[2];
#pragma unroll
                for (int n = 0; n < 2; ++n) { float r4[4];
#pragma unroll
                    for (int j = 0; j < 4; ++j) { const float g = acc[ai][0][m][n][j] * inscale, uu = acc[ai][1][m][n][j] * inscale; r4[j] = g * fsigmoid(g) * uu * F8_SH; }
                    w[n] = pk4_fp8(r4[0], r4[1], r4[2], r4[3]); }
                *(uint2*)(hid8 + (size_t)row * DE + h0) = make_uint2(w[0], w[1]); }
    } };
struct EpiMoe2 { bf16_t* outk; const LAS int* tkt; const LAS float* tkw;
    __device__ __forceinline__ void operator()(const f32x4 (&acc)[2][2][4][2], const ge::Unit& u, int wr, int wc, int fr, int fq) const {
        const int L0 = (4 * u.pn + wc) * 64 + 16 * fq; const int ub = (u.aux >> 24) * 256 + wr * 64 + fr; int tk[2][4]; float wt[2][4];
#pragma unroll
        for (int ai = 0; ai < 2; ++ai)
#pragma unroll
            for (int m = 0; m < 4; ++m) { tk[ai][m] = tkt[ub + ai * 128 + m * 16]; wt[ai][m] = tkw[ub + ai * 128 + m * 16]; }
#pragma unroll
        for (int ai = 0; ai < 2; ++ai)
#pragma unroll
            for (int m = 0; m < 4; ++m) { const int t_ = tk[ai][m]; if (t_ < 0) continue; const float w = wt[ai][m]; float v[16]; GE_VALS(v, acc, ai, m);
#pragma unroll
                for (int k = 0; k < 16; ++k) v[k] *= w;
                *(uint4*)((unsigned char*)outk + (size_t)(t_ & 1) * T * D + (size_t)(t_ >> 1) * D + L0) = make_uint4(pk4_fp8(v[0], v[1], v[2], v[3]), pk4_fp8(v[4], v[5], v[6], v[7]), pk4_fp8(v[8], v[9], v[10], v[11]), pk4_fp8(v[12], v[13], v[14], v[15])); }
    } };

__device__ __forceinline__ void phase_cmp2(const Params& p, const Frame& F) {
    LAS float* w2l = (LAS float*)F.lds; const int base = F.bid * 8 + F.wave;
#pragma unroll 1
    for (int w = 0; w < 2; ++w) {
        __syncthreads();
        for (int i4 = F.tid; i4 < 256 * 64 / 4; i4 += NTHR) { const float4 t4 = *(const float4*)(p.cmp_w2 + (size_t)w * 256 * 64 + 4 * i4); *(LAS f32x4*)(w2l + 4 * i4) = (f32x4){t4.x, t4.y, t4.z, t4.w}; }
        float hv[2][4];
#pragma unroll
        for (int k = 0; k < 2; ++k) { const int row = (base + (2 * w + k) * 2048) & 4095;
#pragma unroll
            for (int i = 0; i < 4; ++i) { float x = p.cb1[w * 256 + i * 64 + F.lane];
#pragma unroll
                for (int ks = 0; ks < 8; ++ks) x += bf2f(((const bf16_t*)p.cpart)[((size_t)(w * 8 + ks) * 4096 + row) * 256 + i * 64 + F.lane]);
                hv[k][i] = 0.5f * x * (1.f + ftanh(0.7978845608028654f * (x + 0.044715f * x * x * x))); } }
        __syncthreads();
        float acc0 = p.cmp_b2[w * 64 + F.lane], acc1 = acc0;
#pragma unroll
        for (int i = 0; i < 4; ++i)
#pragma unroll 8
            for (int l = 0; l < 64; ++l) { const float wv = w2l[(i * 64 + l) * 64 + F.lane]; acc0 += rdlane(hv[0][i], l) * wv; acc1 += rdlane(hv[1][i], l) * wv; }
#pragma unroll
        for (int k = 0; k < 2; ++k) { const int row = (base + (2 * w + k) * 2048) & 4095, c = row & 127; float v = k ? acc1 : acc0;
            if (w == 0) { const float ss = wave_sum(v * v); v = v * rsqrtf(ss * (1.f / 64.f) + 1e-6f) * p.k_gain[F.lane]; int pos = c * 16 + 31; if (pos > 2047) pos = 2047;
                const float other = sx<8>(v); if (F.lane < 16) { const int j = F.lane & 7; const float cs = p.rope[pos * 16 + j], sn = p.rope[pos * 16 + 8 + j]; v = (F.lane < 8) ? (v * cs - other * sn) : (v * cs + other * sn); } }
            if (c == 127) v = 0.f;
            (w == 0 ? p.kcmp : p.vcmp)[(size_t)row * 64 + F.lane] = f2bf(v); }
    }
}

typedef float f32x16 __attribute__((ext_vector_type(16)));
typedef short s16x4 __attribute__((ext_vector_type(4)));
namespace at {
constexpr int KP = 144, VP = 192;
constexpr int KBUF = 64 * KP, VBUF = 64 * VP;
constexpr int OFF_K0 = 0, OFF_K1 = KBUF, OFF_V0 = 4 * KBUF, OFF_V1 = 4 * KBUF + VBUF, OFF_IMP = 4 * KBUF + 4 * VBUF;
constexpr int IMP_PITCH = 33, OFF_SEL = OFF_IMP + 8 * 32 * IMP_PITCH * 4;
constexpr float SC = 0.125f * 1.4426950408889634f;
constexpr float NEG = -1e30f, THR = 8.0f;
__device__ __forceinline__ unsigned pk2(float a, float b) { typedef float f2 __attribute__((ext_vector_type(2))); typedef __bf16 b2 __attribute__((ext_vector_type(2))); b2 r = __builtin_convertvector((f2){a, b}, b2); return __builtin_bit_cast(unsigned, r); }
template <int OFF> __device__ __forceinline__ s16x4 tr_read(unsigned addr) { s16x4 r; asm volatile("ds_read_b64_tr_b16 %0, %1 offset:%2" : "=&v"(r) : "v"(addr), "i"(OFF) : "memory"); return r; }
struct St { f32x16 o[2]; float m, l; };

__device__ __forceinline__ void qk_tile(const LAS unsigned char* kb, int r32, int hi, const bf16x8 (&qf)[4], f32x16& s0, f32x16& s1) {
#pragma unroll
    for (int e = 0; e < 16; ++e) { s0[e] = 0.f; s1[e] = 0.f; }
#pragma unroll
    for (int ks = 0; ks < 4; ++ks) {
        const bf16x8 a0 = *(const LAS bf16x8*)(kb + r32 * KP + (16 * ks + 8 * hi) * 2);
        const bf16x8 a1 = *(const LAS bf16x8*)(kb + (32 + r32) * KP + (16 * ks + 8 * hi) * 2);
        s0 = __builtin_amdgcn_mfma_f32_32x32x16_bf16(a0, qf[ks], s0, 0, 0, 0);
        s1 = __builtin_amdgcn_mfma_f32_32x32x16_bf16(a1, qf[ks], s1, 0, 0, 0);
    }
}
template <int MODE>
__device__ __forceinline__ bool elem_valid(int kt, int e, int hi, int qloc, int t, int key0) {
    const int kl = kt * 32 + (e & 3) + 8 * (e >> 2) + 4 * hi;
    if (MODE == 1) { const int c = key0 + kl; return (c < 127) && (16 * c + 31 <= t); }
    if (MODE == 2) return kl <= qloc;
    if (MODE == 3) return kl > qloc;
    return true;
}
template <int DT> __device__ __forceinline__ void pv_read(unsigned vb_lane, s16x4 (&va)[4][2]) {
    va[0][0] = tr_read<0 * VP + 64 * DT>(vb_lane); va[0][1] = tr_read<8 * VP + 64 * DT>(vb_lane); va[1][0] = tr_read<16 * VP + 64 * DT>(vb_lane); va[1][1] = tr_read<24 * VP + 64 * DT>(vb_lane);
    va[2][0] = tr_read<32 * VP + 64 * DT>(vb_lane); va[2][1] = tr_read<40 * VP + 64 * DT>(vb_lane); va[3][0] = tr_read<48 * VP + 64 * DT>(vb_lane); va[3][1] = tr_read<56 * VP + 64 * DT>(vb_lane);
}
__device__ __forceinline__ void pv_mma(const s16x4 (&va)[4][2], const unsigned (&pp)[16], f32x16& o) {
#pragma unroll
    for (int kk = 0; kk < 4; ++kk) {
        const bf16x8 af = (bf16x8){va[kk][0][0], va[kk][0][1], va[kk][0][2], va[kk][0][3], va[kk][1][0], va[kk][1][1], va[kk][1][2], va[kk][1][3]};
        typedef unsigned u32x4 __attribute__((ext_vector_type(4)));
        const u32x4 pw = (u32x4){pp[4 * kk], pp[4 * kk + 1], pp[4 * kk + 2], pp[4 * kk + 3]};
        o = __builtin_amdgcn_mfma_f32_32x32x16_bf16(af, __builtin_bit_cast(bf16x8, pw), o, 0, 0, 0);
    }
}
__device__ __forceinline__ void pv_tile(unsigned vb_lane, const unsigned (&pp)[16], St& st) {
    s16x4 va[4][2];
    pv_read<0>(vb_lane, va); asm volatile("s_waitcnt lgkmcnt(0)" ::: "memory"); __builtin_amdgcn_sched_barrier(0); pv_mma(va, pp, st.o[0]);
    pv_read<1>(vb_lane, va); asm volatile("s_waitcnt lgkmcnt(0)" ::: "memory"); __builtin_amdgcn_sched_barrier(0); pv_mma(va, pp, st.o[1]);
}
__device__ __forceinline__ float max3f(float a, float b, float c) { float r; asm("v_max3_f32 %0, %1, %2, %3" : "=v"(r) : "v"(a), "v"(b), "v"(c)); return r; }
template <int KK> __device__ __forceinline__ void pv_read_slice(unsigned vb_lane, s16x4 (&v)[2][2]) {
    v[0][0] = tr_read<(16 * KK) * VP>(vb_lane); v[0][1] = tr_read<(16 * KK + 8) * VP>(vb_lane); v[1][0] = tr_read<(16 * KK) * VP + 64>(vb_lane); v[1][1] = tr_read<(16 * KK + 8) * VP + 64>(vb_lane);
}
template <bool GATED> __device__ __forceinline__ void sm_slice(const f32x16& sc, const int e0, const s16x4 (&v)[2][2], St& st, float& rs, bool en) {
    float pe[8];
#pragma unroll
    for (int i = 0; i < 8; ++i) pe[i] = __builtin_amdgcn_exp2f(sc[e0 + i]);
    typedef unsigned u32x4 __attribute__((ext_vector_type(4))); u32x4 pw;
#pragma unroll
    for (int i = 0; i < 4; ++i) { pw[i] = pk2(pe[2 * i], pe[2 * i + 1]); if (GATED) pw[i] = en ? pw[i] : 0u; }
    float t = ((pe[0] + pe[1]) + (pe[2] + pe[3])) + ((pe[4] + pe[5]) + (pe[6] + pe[7])); if (GATED) t = en ? t : 0.f; rs += t;
    const bf16x8 pb = __builtin_bit_cast(bf16x8, pw);
    const bf16x8 a0 = (bf16x8){v[0][0][0], v[0][0][1], v[0][0][2], v[0][0][3], v[0][1][0], v[0][1][1], v[0][1][2], v[0][1][3]};
    const bf16x8 a1 = (bf16x8){v[1][0][0], v[1][0][1], v[1][0][2], v[1][0][3], v[1][1][0], v[1][1][1], v[1][1][2], v[1][1][3]};
    st.o[0] = __builtin_amdgcn_mfma_f32_32x32x16_bf16(a0, pb, st.o[0], 0, 0, 0);
    st.o[1] = __builtin_amdgcn_mfma_f32_32x32x16_bf16(a1, pb, st.o[1], 0, 0, 0);
}
template <int MODE, bool GATED, bool FIXED>
__device__ __forceinline__ void attend_tile(const LAS unsigned char* kb, unsigned vb_lane, int r32, int hi, const bf16x8 (&qf)[4], St& st, int qloc, bool en, float mfix) {
    f32x16 s0, s1; qk_tile(kb, r32, hi, qf, s0, s1);
    if constexpr (FIXED) {
        s16x4 v0[2][2], v1[2][2], v2[2][2], v3[2][2];
        pv_read_slice<0>(vb_lane, v0); pv_read_slice<1>(vb_lane, v1);
        if (MODE != 0) {
#pragma unroll
            for (int e = 0; e < 16; ++e) { s0[e] = elem_valid<MODE>(0, e, hi, qloc, 0, 0) ? s0[e] : NEG; s1[e] = elem_valid<MODE>(1, e, hi, qloc, 0, 0) ? s1[e] : NEG; }
        }
        float rs = 0.f;
        asm volatile("s_waitcnt lgkmcnt(4)" ::: "memory"); __builtin_amdgcn_sched_barrier(0); sm_slice<GATED>(s0, 0, v0, st, rs, en); __builtin_amdgcn_sched_barrier(0);
        pv_read_slice<2>(vb_lane, v2);
        asm volatile("s_waitcnt lgkmcnt(4)" ::: "memory"); __builtin_amdgcn_sched_barrier(0); sm_slice<GATED>(s0, 8, v1, st, rs, en); __builtin_amdgcn_sched_barrier(0);
        pv_read_slice<3>(vb_lane, v3);
        asm volatile("s_waitcnt lgkmcnt(4)" ::: "memory"); __builtin_amdgcn_sched_barrier(0); sm_slice<GATED>(s1, 0, v2, st, rs, en); __builtin_amdgcn_sched_barrier(0);
        asm volatile("s_waitcnt lgkmcnt(0)" ::: "memory"); __builtin_amdgcn_sched_barrier(0); sm_slice<GATED>(s1, 8, v3, st, rs, en);
        st.l += rs;
        return;
    }
    s16x4 va0[4][2]; pv_read<0>(vb_lane, va0);
    if (MODE != 0) {
#pragma unroll
        for (int e = 0; e < 16; ++e) { s0[e] = elem_valid<MODE>(0, e, hi, qloc, 0, 0) ? s0[e] : NEG; s1[e] = elem_valid<MODE>(1, e, hi, qloc, 0, 0) ? s1[e] : NEG; }
    }
    float mc = 0.f;
    if (FIXED) {
    } else {
        float mx = max3f(s0[0], s0[1], s1[0]);
#pragma unroll
        for (int e = 2; e < 16; e += 2) mx = max3f(mx, s0[e], s0[e + 1]);
#pragma unroll
        for (int e = 1; e < 15; e += 2) mx = max3f(mx, s1[e], s1[e + 1]);
        mx = fmaxf(mx, s1[15]);
        if (GATED) mx = en ? mx : NEG;
        mx = max32(mx);
        float mold = st.m;
        if (__any((mx - mold) * SC > THR)) {
            const float mnew = fmaxf(mold, mx); const float al = __builtin_amdgcn_exp2f((mold - mnew) * SC);
#pragma unroll
            for (int e = 0; e < 16; ++e) { st.o[0][e] *= al; st.o[1][e] *= al; }
            st.l *= al; st.m = mnew; mold = mnew;
        }
        mc = fmaxf(mold, -1e20f) * SC; if (GATED) mc = en ? mc : 3e38f;
    }
    float rs = 0.f; unsigned pp[16];
#pragma unroll
    for (int e = 0; e < 16; e += 2) {
        float a0, a1, b0, b1;
        if (FIXED) { a0 = __builtin_amdgcn_exp2f(s0[e]); a1 = __builtin_amdgcn_exp2f(s0[e + 1]); b0 = __builtin_amdgcn_exp2f(s1[e]); b1 = __builtin_amdgcn_exp2f(s1[e + 1]); }
        else { a0 = __builtin_amdgcn_exp2f(__builtin_fmaf(s0[e], SC, -mc)); a1 = __builtin_amdgcn_exp2f(__builtin_fmaf(s0[e + 1], SC, -mc)); b0 = __builtin_amdgcn_exp2f(__builtin_fmaf(s1[e], SC, -mc)); b1 = __builtin_amdgcn_exp2f(__builtin_fmaf(s1[e + 1], SC, -mc)); }
        rs += (a0 + a1) + (b0 + b1); pp[e >> 1] = pk2(a0, a1); pp[8 + (e >> 1)] = pk2(b0, b1); }
    if (FIXED && GATED) {
#pragma unroll
        for (int i = 0; i < 16; ++i) pp[i] = en ? pp[i] : 0u;
        rs = en ? rs : 0.f; }
    if (!FIXED) rs = sum32(rs);
    st.l += rs;
    asm volatile("s_waitcnt lgkmcnt(0)" ::: "memory"); __builtin_amdgcn_sched_barrier(0); pv_mma(va0, pp, st.o[0]);
    { s16x4 va1[4][2]; pv_read<1>(vb_lane, va1); asm volatile("s_waitcnt lgkmcnt(0)" ::: "memory"); __builtin_amdgcn_sched_barrier(0); pv_mma(va1, pp, st.o[1]); }
}
__device__ __forceinline__ void st_reset(St& st) {
#pragma unroll
    for (int a = 0; a < 2; ++a)
#pragma unroll
        for (int e = 0; e < 16; ++e) st.o[a][e] = 0.f;
    st.m = NEG; st.l = 0.f;
}
__device__ __forceinline__ void st_flush(const St& st, unsigned (&ofin)[2][8], float g, bool first) {
    const float f = (st.l > 0.f ? 1.f / st.l : 0.f) * g;
#pragma unroll
    for (int dt = 0; dt < 2; ++dt)
#pragma unroll
        for (int e = 0; e < 16; e += 2) { float a = st.o[dt][e] * f, b = st.o[dt][e + 1] * f;
            if (!first) { const unsigned w = ofin[dt][e >> 1]; a += __uint_as_float(w << 16); b += __uint_as_float(w & 0xFFFF0000u); }
            ofin[dt][e >> 1] = pk2(a, b); }
#pragma unroll
    for (int dt = 0; dt < 2; ++dt) asm volatile("" : "+v"(ofin[dt][0]), "+v"(ofin[dt][1]), "+v"(ofin[dt][2]), "+v"(ofin[dt][3]), "+v"(ofin[dt][4]), "+v"(ofin[dt][5]), "+v"(ofin[dt][6]), "+v"(ofin[dt][7]));
}
__device__ __forceinline__ void tile_load(const bf16_t* kbase, const bf16_t* vbase, int key0, int tid, uint4& kr, uint4& vr) {
    const size_t o = (size_t)(key0 + (tid >> 3)) * 64 + (tid & 7) * 8; kr = *(const uint4*)(kbase + o); vr = *(const uint4*)(vbase + o); }
typedef unsigned u32x4_t __attribute__((ext_vector_type(4)));
__device__ __forceinline__ void tile_store(LAS unsigned char* lds, int buf, int tid, const uint4& kr, const uint4& vr) {
    *(LAS u32x4_t*)(lds + OFF_K0 + buf * KBUF + (tid >> 3) * KP + (tid & 7) * 16) = (u32x4_t){kr.x, kr.y, kr.z, kr.w}; *(LAS u32x4_t*)(lds + OFF_V0 + buf * VBUF + (tid >> 3) * VP + (tid & 7) * 16) = (u32x4_t){vr.x, vr.y, vr.z, vr.w}; }
}

template <bool FIXED>
__device__ __forceinline__ void phase_attn_t(const Params& p, const Frame& F, const float mfix) {
    using namespace at;
    LAS unsigned char* lds = F.lds;
    const int tid = F.tid, lane = F.lane, w = F.wave, r32 = lane & 31, hi = lane >> 5;
    const unsigned vlane = (unsigned)((4 * hi + ((lane & 15) >> 2)) * VP + (16 * ((lane >> 4) & 1) + 4 * (lane & 3)) * 2);
    LAS float* impw = (LAS float*)(lds + OFF_IMP) + w * 32 * IMP_PITCH;
    LAS unsigned* selm = (LAS unsigned*)(lds + OFF_SEL);
    LAS float* invl = (LAS float*)(lds + OFF_SEL + 512);
#define AT_UNIT(ui_, qb_, bg_, qoff_) const int idx_##qb_ = ((ui_) & 1) ? ((ui_) * 256 + 255 - F.bid) : ((ui_) * 256 + F.bid); const int qb_ = 31 - (idx_##qb_ >> 6), bg_ = (idx_##qb_ >> 1) & 31, qoff_ = (idx_##qb_ & 1) * 32
    bf16x8 qf[4]; float gt[3]; uint4 kr, vr, kr1, vr1;
    { AT_UNIT(0, qb, bg, qoff);
      const bf16_t* kc = p.kcmp + (size_t)bg * 128 * 64; const bf16_t* vc = p.vcmp + (size_t)bg * 128 * 64;
      tile_load(kc, vc, 0, tid, kr, vr); if (qb >= 16) tile_load(kc, vc, 64, tid, kr1, vr1); }
#pragma unroll 1
    for (int ui = 0; ui < 8; ++ui) {
        AT_UNIT(ui, qb, bg, qoff);
        const int b = bg >> 1, g = bg & 1, head = g * 8 + w, s0 = qb * 64;
        const int qloc = qoff + r32, t = s0 + qloc;
        const bf16_t* ksel = p.kv + (size_t)2 * T * 128 + (size_t)bg * S * 64; const bf16_t* vsel = p.kv + (size_t)3 * T * 128 + (size_t)bg * S * 64;
        const bf16_t* kwin = p.kv + (size_t)4 * T * 128 + (size_t)bg * S * 64; const bf16_t* vwin = p.kv + (size_t)5 * T * 128 + (size_t)bg * S * 64;
        unsigned ofin[2][8]; St st;
        { const size_t tok = (size_t)b * S + t;
#pragma unroll
          for (int ks = 0; ks < 4; ++ks) { qf[ks] = *(const bf16x8*)(p.q + tok * D + head * 64 + 16 * ks + 8 * hi);
              if (FIXED) { typedef unsigned u32x4q __attribute__((ext_vector_type(4))); const u32x4q w4 = __builtin_bit_cast(u32x4q, qf[ks]); u32x4q r4;
#pragma unroll
                  for (int i = 0; i < 4; ++i) r4[i] = pk2(__uint_as_float(w4[i] << 16) * SC, __uint_as_float(w4[i] & 0xFFFF0000u) * SC);
                  qf[ks] = __builtin_bit_cast(bf16x8, r4); } }
#pragma unroll
          for (int br = 0; br < 3; ++br) gt[br] = p.gates[tok * 48 + br * 16 + head]; }
        const int nct = (qb >= 16) ? 2 : 1;
        __syncthreads();
        tile_store(lds, 0, tid, kr, vr); if (nct == 2) tile_store(lds, 1, tid, kr1, vr1);
        tile_load(ksel, vsel, qb * 64, tid, kr, vr);
        __syncthreads();
        float cm = NEG, cl = 0.f;
        if (!FIXED) {
#pragma unroll 1
        for (int ct = 0; ct < nct; ++ct) { const LAS unsigned char* kb = lds + (ct ? OFF_K1 : OFF_K0);
            f32x16 a0, a1; qk_tile(kb, r32, hi, qf, a0, a1); float mx = NEG;
#pragma unroll
            for (int e = 0; e < 16; ++e) { a0[e] = elem_valid<1>(0, e, hi, qloc, t, ct * 64) ? a0[e] : NEG; a1[e] = elem_valid<1>(1, e, hi, qloc, t, ct * 64) ? a1[e] : NEG; mx = fmaxf(mx, fmaxf(a0[e], a1[e])); }
            mx = max32(mx); const float mnew = fmaxf(cm, mx); float rs = 0.f;
#pragma unroll
            for (int e = 0; e < 16; ++e) { rs += (a0[e] > -1e29f ? __builtin_amdgcn_exp2f((a0[e] - mnew) * SC) : 0.f) + (a1[e] > -1e29f ? __builtin_amdgcn_exp2f((a1[e] - mnew) * SC) : 0.f); }
            rs = sum32(rs); cl = cl * __builtin_amdgcn_exp2f((cm - mnew) * SC) + rs; cm = mnew; }
        }
        st_reset(st); if (FIXED) cm = mfix / SC; else st.m = cm;
        const float icl = FIXED ? 1.f : (cl > 0.f ? 1.f / cl : 0.f);
        LAS float* irow = impw + r32 * IMP_PITCH;
        if (nct == 1) {
#pragma unroll 1
            for (int j = 16; j < 32; ++j) irow[j] = 0.f; }
#pragma unroll 1
        for (int ct = 0; ct < nct; ++ct) { const LAS unsigned char* kb = lds + (ct ? OFF_K1 : OFF_K0); const unsigned vb = (unsigned)(unsigned long)(lds + (ct ? OFF_V1 : OFF_V0)) + vlane;
            f32x16 a0, a1; qk_tile(kb, r32, hi, qf, a0, a1); const float mc = cm * SC; unsigned pp[16]; float rs = 0.f; float Ai[8], Fi[8];
            int clim = (t - 31) >> 4; clim = (clim > 126 ? 126 : clim) - 4 * hi - ct * 64;
#pragma unroll
            for (int kt = 0; kt < 2; ++kt)
#pragma unroll
                for (int gq = 0; gq < 4; ++gq) { float pv[4];
#pragma unroll
                    for (int e2 = 0; e2 < 4; ++e2) { const int e = gq * 4 + e2; const float sv = kt ? a1[e] : a0[e]; pv[e2] = (kt * 32 + (e & 3) + 8 * (e >> 2) <= clim) ? (FIXED ? __builtin_amdgcn_exp2f(sv) : __builtin_amdgcn_exp2f(sv * SC - mc)) : 0.f; }
                    pp[kt * 8 + gq * 2] = pk2(pv[0], pv[1]); pp[kt * 8 + gq * 2 + 1] = pk2(pv[2], pv[3]); rs += (pv[0] + pv[1]) + (pv[2] + pv[3]);
                    Ai[kt * 4 + gq] = (pv[0] + 2.f * (pv[1] + pv[2] + pv[3])) * icl; Fi[kt * 4 + gq] = pv[0] * icl; }
            st.l += rs;
            float Fr[8];
#pragma unroll
            for (int g8 = 0; g8 < 8; ++g8) Fr[g8] = other32(Fi[g8], hi != 0);
#pragma unroll
            for (int g8 = 0; g8 < 8; ++g8) { const float nxt = (g8 < 7) ? Fr[g8 + 1] : 0.f;
                irow[ct * 16 + 2 * g8 + hi] = Ai[g8] + (hi ? nxt : Fr[g8]); }
            if (ct == 1 && hi) irow[15] += Fr[0];
            pv_tile(vb, pp, st); }
        st.l = sum32(st.l);
        if (hi == 0) invl[w * 32 + r32] = FIXED ? (st.l > 0.f ? 1.f / st.l : 0.f) : 1.f;
        tile_store(lds, 2, tid, kr, vr);
        st_flush(st, ofin, gt[0], true);
        __syncthreads();
        if (w == 0) { unsigned mask;
            if (qb < 8) mask = (2u << qb) - 1u;
            else { mask = 1u | (1u << qb) | (1u << (qb - 1));
                const LAS float* ib = (const LAS float*)(lds + OFF_IMP) + r32 * IMP_PITCH; float iv[32];
#pragma unroll
                for (int j = 0; j < 32; ++j) { float v = 0.f;
#pragma unroll
                    for (int ww = 0; ww < 8; ++ww) v += ib[ww * 32 * IMP_PITCH + j] * invl[ww * 32 + r32];
                    iv[j] = (j >= 1 && j <= qb - 2) ? v : -3e38f; }
#pragma unroll 1
                for (int pick = 0; pick < 5; ++pick) { int best = -1; float bv = -3e38f;
#pragma unroll
                    for (int j = 1; j < 31; ++j) { const bool take = !((mask >> j) & 1u) && iv[j] > bv; bv = take ? iv[j] : bv; best = take ? j : best; }
                    if (best >= 0) mask |= 1u << best; } }
            if (hi == 0) selm[r32] = mask; unsigned um = mask;
            um |= sxu<16>(um); um |= sxu<8>(um); um |= sxu<4>(um); um |= sxu<2>(um); um |= sxu<1>(um);
            if (lane == 0) selm[32] = um; }
        __syncthreads();
        const int jlo = qb >= 8 ? qb - 8 : 0;
        { const unsigned um = selm[32]; const unsigned mq = selm[r32];
          st_reset(st);
          unsigned rem = um & ~(1u << qb);
#define SEL_POP(dst) do { if (rem) { dst = 31 - __builtin_clz(rem); rem &= ~(1u << dst); } else dst = -1; } while (0)
          int jA = qb, jB = -1, sb = 1;
          for (;;) {
              int nA, nB = -1; SEL_POP(nA); if (nA >= 0) SEL_POP(nB);
              if (nA >= 0) tile_load(ksel, vsel, nA * 64, tid, kr, vr);
              if (nB >= 0) tile_load(ksel, vsel, nB * 64, tid, kr1, vr1);
              if (nA < 0) { tile_load(kwin, vwin, qb * 64, tid, kr, vr); if (qb - 1 >= jlo) tile_load(kwin, vwin, (qb - 1) * 64, tid, kr1, vr1); }
              { const LAS unsigned char* kb = lds + OFF_K0 + (2 * sb) * KBUF; const unsigned vb = (unsigned)(unsigned long)(lds + OFF_V0 + (2 * sb) * VBUF) + vlane;
                if (jA == qb) attend_tile<2, false, FIXED>(kb, vb, r32, hi, qf, st, qloc, true, mfix);
                else attend_tile<0, true, FIXED>(kb, vb, r32, hi, qf, st, qloc, (mq >> jA) & 1u, mfix); }
              if (jB >= 0) { const LAS unsigned char* kb = lds + OFF_K0 + (2 * sb + 1) * KBUF; const unsigned vb = (unsigned)(unsigned long)(lds + OFF_V0 + (2 * sb + 1) * VBUF) + vlane;
                attend_tile<0, true, FIXED>(kb, vb, r32, hi, qf, st, qloc, (mq >> jB) & 1u, mfix); }
              if (nA < 0) break;
              tile_store(lds, 2 * (sb ^ 1), tid, kr, vr); if (nB >= 0) tile_store(lds, 2 * (sb ^ 1) + 1, tid, kr1, vr1);
              __syncthreads();
              jA = nA; jB = nB; sb ^= 1;
          }
#undef SEL_POP
          if (FIXED) st.l = sum32(st.l);
          st_flush(st, ofin, gt[1], false); }
        __syncthreads();
        { st_reset(st);
          int jA = qb, jB = (qb - 1 >= jlo) ? qb - 1 : -1, sb = 0;
          tile_store(lds, 0, tid, kr, vr); if (jB >= 0) tile_store(lds, 1, tid, kr1, vr1);
          __syncthreads();
          for (;;) {
              const int nA = (jB >= 0 && jB - 1 >= jlo) ? jB - 1 : -1, nB = (nA >= 0 && nA - 1 >= jlo) ? nA - 1 : -1;
              if (nA >= 0) tile_load(kwin, vwin, nA * 64, tid, kr, vr);
              if (nB >= 0) tile_load(kwin, vwin, nB * 64, tid, kr1, vr1);
              if (nA < 0 && ui + 1 < 8) {
                  AT_UNIT(ui + 1, qbn, bgn, qoffn);
                  const bf16_t* kcn = p.kcmp + (size_t)bgn * 128 * 64; const bf16_t* vcn = p.vcmp + (size_t)bgn * 128 * 64;
                  tile_load(kcn, vcn, 0, tid, kr, vr); if (qbn >= 16) tile_load(kcn, vcn, 64, tid, kr1, vr1); }
#define WIN_TILE(j_, bi_) do { const LAS unsigned char* kb = lds + OFF_K0 + (bi_) * KBUF; const unsigned vb = (unsigned)(unsigned long)(lds + OFF_V0 + (bi_) * VBUF) + vlane; \
                if ((j_) == qb) attend_tile<2, false, FIXED>(kb, vb, r32, hi, qf, st, qloc, true, mfix); else if ((j_) == qb - 8) attend_tile<3, false, FIXED>(kb, vb, r32, hi, qf, st, qloc, true, mfix); else attend_tile<0, false, FIXED>(kb, vb, r32, hi, qf, st, qloc, true, mfix); } while (0)
              WIN_TILE(jA, 2 * sb);
              if (jB >= 0) WIN_TILE(jB, 2 * sb + 1);
#undef WIN_TILE
              if (nA < 0) break;
              tile_store(lds, 2 * (sb ^ 1), tid, kr, vr); if (nB >= 0) tile_store(lds, 2 * (sb ^ 1) + 1, tid, kr1, vr1);
              __syncthreads();
              jA = nA; jB = nB; sb ^= 1;
          }
          if (FIXED) st.l = sum32(st.l);
          st_flush(st, ofin, gt[2], false); }
        { int l2 = lane; asm volatile("" : "+v"(l2)); unsigned char* op = (unsigned char*)p.h + ((size_t)b * S + s0 + qoff + (l2 & 31)) * D + head * 64 + 4 * (l2 >> 5);
#pragma unroll
          for (int dt = 0; dt < 2; ++dt)
#pragma unroll
            for (int gq = 0; gq < 4; ++gq) { const unsigned w0 = ofin[dt][2 * gq], w1 = ofin[dt][2 * gq + 1];
                *(unsigned*)(op + dt * 32 + 8 * gq) = pk4_fp8(__uint_as_float(w0 << 16) * F8_SA, __uint_as_float(w0 & 0xFFFF0000u) * F8_SA, __uint_as_float(w1 << 16) * F8_SA, __uint_as_float(w1 & 0xFFFF0000u) * F8_SA); } }
    }
#undef AT_UNIT
}

__device__ __forceinline__ void phase_attn(const Params& p, const Frame& F) {
    const float gq = wave_max(fabsf(p.q_gain[F.lane])); const float gk = wave_max(fmaxf(fabsf(p.k_gain[F.lane]), fmaxf(fabsf(p.k_gain[64 + F.lane]), fabsf(p.k_gain[128 + F.lane]))));
    const float mfix = 64.f * 1.02f * gq * gk * at::SC;
    if (mfix < 60.f) phase_attn_t<true>(p, F, mfix);
    else phase_attn_t<false>(p, F, 0.f);
}

namespace ml {
constexpr int QP = 272, VP = 192;
constexpr int OFF_Q = 0, OFF_K = 64 * QP, OFF_V = 2 * 64 * QP, OFF_WV = OFF_V + 64 * VP, OFF_CB = OFF_WV + 64 * VP, OFF_GA = OFF_CB + 128 * VP, OFF_GAM = OFF_GA + 8192, OFF_GB = OFF_GAM + 8192,
              OFF_MP = OFF_GB + 8192, OFF_W = OFF_MP + 256, OFF_N = OFF_W + 256, OFF_RS = OFF_N + 512, OFF_QN = OFF_RS + 256, OFF_END = OFF_QN + 256;
typedef unsigned u32x4_t __attribute__((ext_vector_type(4)));
}
__device__ __forceinline__ void phase_scan(const Params& p, const Frame& F, bf16_t* hs_base  , const int hs_stride) {
    using namespace ml; using at::tr_read; using at::pk2;
    LAS unsigned char* lds = F.lds;
    const int tid = F.tid, lane = F.lane, w = F.wave, i16 = lane & 15, g = lane >> 4, r32 = lane & 31, hi = lane >> 5;
    const int b = F.bid >> 4, h = (F.bid >> 2) & 3, vs = F.bid & 3;
    LAS float* ga = (LAS float*)(lds + OFF_GA); LAS float* gam = (LAS float*)(lds + OFF_GAM); LAS float* gb = (LAS float*)(lds + OFF_GB); LAS float* mp = (LAS float*)(lds + OFF_MP);
    LAS float* wl = (LAS float*)(lds + OFF_W); LAS float* nl = (LAS float*)(lds + OFF_N); LAS float* rsl = (LAS float*)(lds + OFF_RS); LAS float* qnl = (LAS float*)(lds + OFF_QN);
    for (int ck = w; ck < 32; ck += 8) { const int pos = ck * 64 + lane; const size_t tg = ((size_t)b * S + pos) * 4 + h; const float lfv = p.lf[tg], liv = p.li[tg];
        float bs = lfv;
#pragma unroll
        for (int o = 1; o < 64; o <<= 1) { const float x = __int_as_float(__builtin_amdgcn_ds_bpermute((lane - o) * 4, __float_as_int(bs))); if (lane >= o) bs += x; }
        const float av = liv - bs; float am = av;
#pragma unroll
        for (int o = 1; o < 64; o <<= 1) { const float x = __int_as_float(__builtin_amdgcn_ds_bpermute((lane - o) * 4, __float_as_int(am))); if (lane >= o) am = fmaxf(am, x); }
        ga[pos] = av; gam[pos] = am; gb[pos] = bs; }
    for (int idx = tid; idx < 128 * VP / 4; idx += NTHR) ((LAS unsigned*)(lds + OFF_CB))[idx] = 0u;
    if (tid < 128) nl[tid] = 0.f;
    __syncthreads();
    if (tid == 0) { float m = 0.f;
#pragma unroll 1
        for (int k = 0; k < 32; ++k) { mp[k] = m; m = gb[k * 64 + 63] + fmaxf(m, gam[k * 64 + 63]); } }
    __syncthreads();
    const bf16_t* pq = p.proj + (size_t)b * S * 3072 + h * 128; const bf16_t* pk = pq + 512; bf16_t* pv = p.proj + (size_t)b * S * 3072 + 1024 + h * 256 + vs * 64;
    uint4 rq[2], rk[2], rv;
#define ML_LOAD(ck_) do { const size_t t0_ = (size_t)(ck_) * 64; _Pragma("unroll") for (int i_ = 0; i_ < 2; ++i_) { const int idx_ = tid + 512 * i_; const size_t o_ = (t0_ + (idx_ >> 4)) * 3072 + (idx_ & 15) * 8; rq[i_] = *(const uint4*)(pq + o_); rk[i_] = *(const uint4*)(pk + o_); } \
        rv = *(const uint4*)(pv + (t0_ + (tid >> 3)) * 3072 + (tid & 7) * 8); } while (0)
#define ML_STORE(ck_) do { _Pragma("unroll") for (int i_ = 0; i_ < 2; ++i_) { const int idx_ = tid + 512 * i_; const int o_ = (idx_ >> 4) * QP + (idx_ & 15) * 16; \
            *(LAS u32x4_t*)(lds + OFF_Q + o_) = (u32x4_t){rq[i_].x, rq[i_].y, rq[i_].z, rq[i_].w}; *(LAS u32x4_t*)(lds + OFF_K + o_) = (u32x4_t){rk[i_].x, rk[i_].y, rk[i_].z, rk[i_].w}; } \
        { const int s_ = tid >> 3; const float m63_ = fmaxf(mp[ck_], gam[(ck_) * 64 + 63]); const float ws_ = __expf(ga[(ck_) * 64 + s_] - m63_); if ((tid & 7) == 0) wl[s_] = ws_; \
          const int o_ = s_ * VP + (tid & 7) * 16; *(LAS u32x4_t*)(lds + OFF_V + o_) = (u32x4_t){rv.x, rv.y, rv.z, rv.w}; const unsigned vv_[4] = {rv.x, rv.y, rv.z, rv.w}; unsigned ww_[4]; \
          _Pragma("unroll") for (int e_ = 0; e_ < 4; ++e_) ww_[e_] = pk2(__uint_as_float(vv_[e_] << 16) * ws_, __uint_as_float(vv_[e_] & 0xFFFF0000u) * ws_); \
          *(LAS u32x4_t*)(lds + OFF_WV + o_) = (u32x4_t){ww_[0], ww_[1], ww_[2], ww_[3]}; } } while (0)
    ML_LOAD(0); ML_STORE(0);
    __syncthreads();
    const int tt = w >> 1, vh = w & 1;
    const int dt = w >> 1, vt2 = w & 1;
    const unsigned trl16 = (unsigned)(((lane & 15) >> 2) * VP + (4 * (lane & 3)) * 2);
    const unsigned trl32v = (unsigned)(((lane & 15) >> 2) * VP + (16 * ((lane >> 4) & 1) + 4 * (lane & 3)) * 2);
    const unsigned trl32k = (unsigned)(((lane & 15) >> 2) * QP + (16 * ((lane >> 4) & 1) + 4 * (lane & 3)) * 2);
    f32x16 cacc;
#pragma unroll
    for (int e = 0; e < 16; ++e) cacc[e] = 0.f;
    float nreg = 0.f;
    bf16_t* const hs_out = hs_base + (size_t)b * S * hs_stride + h * 256 + vs * 64 + 32 * vh + i16;
    const size_t wo1 = (size_t)NE * D * DE; const ColGateUp cgu{p.w_gate + wo1, p.w_up + wo1}; const ColDown cdn{p.w_down + wo1};
    LAS float* ptile = (LAS float*)(lds + OFF_END) + (tid >> 8) * (64 * 65); const int htid = tid & 255, half = tid >> 8;
    float pr_[16];
#define PREP_LOAD(s_) do { const bool gu_ = (s_) < 16; const int tl_ = (((gu_ ? (s_) : (s_) - 16) * F.G + F.bid) * 2 + half); const int c0_ = (tl_ & 511) * 64, k0_ = (tl_ >> 9) * 64; \
        const float* p_ = gu_ ? cgu(c0_ + (htid & 63)) : cdn(c0_ + (htid & 63)); const int ldw_ = gu_ ? DE : D; p_ += (size_t)(k0_ + (htid >> 6)) * ldw_; \
        _Pragma("unroll") for (int i_ = 0; i_ < 16; ++i_) pr_[i_] = p_[(size_t)(4 * i_) * ldw_]; } while (0)
#define PREP_WRITE() do { _Pragma("unroll") for (int i_ = 0; i_ < 16; ++i_) ptile[((htid >> 6) + 4 * i_) * 65 + (htid & 63)] = pr_[i_]; } while (0)
#define PREP_STORE(s_) do { const bool gu_ = (s_) < 16; const int tl_ = (((gu_ ? (s_) : (s_) - 16) * F.G + F.bid) * 2 + half); const int c0_ = (tl_ & 511) * 64, k0_ = (tl_ >> 9) * 64; \
        const int cc_ = htid >> 2, ch_ = (htid & 3) * 16; \
        { const float sc_ = gu_ ? F8_SW : F8_SW2; const unsigned long long a_ = (unsigned long long)p.gu_t, d_ = (unsigned long long)p.dn_t - a_; unsigned char* base_ = (unsigned char*)(a_ + (gu_ ? 0ull : d_)); const int kp_ = gu_ ? D : DE; \
          unsigned w_[4]; _Pragma("unroll") for (int i_ = 0; i_ < 4; ++i_) w_[i_] = pk4_fp8(ptile[(ch_ + 4 * i_) * 65 + cc_] * sc_, ptile[(ch_ + 4 * i_ + 1) * 65 + cc_] * sc_, ptile[(ch_ + 4 * i_ + 2) * 65 + cc_] * sc_, ptile[(ch_ + 4 * i_ + 3) * 65 + cc_] * sc_); \
          *(uint4*)(base_ + (size_t)(c0_ + cc_) * kp_ + k0_ + ch_) = make_uint4(w_[0], w_[1], w_[2], w_[3]); } } while (0)
    PREP_LOAD(0);
#pragma unroll 1
    for (int ck = 0; ck < 32; ++ck) {
        if (ck + 1 < 32) ML_LOAD(ck + 1);
        const float mprev = mp[ck]; const int c0 = ck * 64;
        bf16x8 qf[4];
#pragma unroll
        for (int ks = 0; ks < 4; ++ks) qf[ks] = *(const LAS bf16x8*)(lds + OFF_Q + (16 * tt + i16) * QP + (32 * ks + 8 * g) * 2);
        f32x4 st[4];
#pragma unroll
        for (int jt = 0; jt < 4; ++jt) { st[jt] = (f32x4){0.f, 0.f, 0.f, 0.f};
#pragma unroll
            for (int ks = 0; ks < 4; ++ks) { const bf16x8 kf = *(const LAS bf16x8*)(lds + OFF_K + (16 * jt + i16) * QP + (32 * ks + 8 * g) * 2); st[jt] = __builtin_amdgcn_mfma_f32_16x16x32_bf16(kf, qf[ks], st[jt], 0, 0, 0); } }
        const int tl = 16 * tt + i16; const float Mt = fmaxf(mprev, gam[c0 + tl]); float rs = 0.f; unsigned ap[8];
#pragma unroll
        for (int jt = 0; jt < 4; ++jt) { float v4[4]; const f32x4 ga4 = *(const LAS f32x4*)(ga + c0 + 16 * jt + 4 * g);
#pragma unroll
            for (int r = 0; r < 4; ++r) { const int j = 16 * jt + 4 * g + r; const float e = __expf(ga4[r] - Mt) * st[jt][r]; v4[r] = (j <= tl) ? e : 0.f; rs += v4[r]; }
            ap[jt * 2] = pk2(v4[0], v4[1]); ap[jt * 2 + 1] = pk2(v4[2], v4[3]); }
        rs = sum16(rs); rs = sum32(rs);
        float qn = 0.f;
#pragma unroll
        for (int ks = 0; ks < 4; ++ks) { const f32x4 n0 = *(const LAS f32x4*)(nl + 32 * ks + 8 * g), n1 = *(const LAS f32x4*)(nl + 32 * ks + 8 * g + 4);
#pragma unroll
            for (int e = 0; e < 4; ++e) { qn += bf2f((bf16_t)qf[ks][e]) * n0[e]; qn += bf2f((bf16_t)qf[ks][4 + e]) * n1[e]; } }
        qn = sum16(qn); qn = sum32(qn);
        if (vh == 0 && g == 0) { rsl[tl] = rs; qnl[tl] = qn; }
        f32x4 av[2], qc[2];
#pragma unroll
        for (int vt = 0; vt < 2; ++vt) { av[vt] = (f32x4){0.f, 0.f, 0.f, 0.f}; qc[vt] = (f32x4){0.f, 0.f, 0.f, 0.f}; }
        {   const unsigned vb = (unsigned)(unsigned long)(lds + OFF_V) + trl16 + (unsigned)(4 * g * VP + (32 * vh) * 2);
            const unsigned cb = (unsigned)(unsigned long)(lds + OFF_CB) + trl16 + (unsigned)(8 * g * VP + (32 * vh) * 2);
            s16x4 va[2][2][2], ca[4][2][2];
#pragma unroll
            for (int vt = 0; vt < 2; ++vt) {
                if (vt == 0) { va[0][0][0] = tr_read<0 * VP>(vb); va[0][0][1] = tr_read<16 * VP>(vb); va[1][0][0] = tr_read<32 * VP>(vb); va[1][0][1] = tr_read<48 * VP>(vb);
                    ca[0][0][0] = tr_read<0 * VP>(cb); ca[0][0][1] = tr_read<4 * VP>(cb); ca[1][0][0] = tr_read<32 * VP>(cb); ca[1][0][1] = tr_read<36 * VP>(cb);
                    ca[2][0][0] = tr_read<64 * VP>(cb); ca[2][0][1] = tr_read<68 * VP>(cb); ca[3][0][0] = tr_read<96 * VP>(cb); ca[3][0][1] = tr_read<100 * VP>(cb); }
                else { va[0][1][0] = tr_read<0 * VP + 32>(vb); va[0][1][1] = tr_read<16 * VP + 32>(vb); va[1][1][0] = tr_read<32 * VP + 32>(vb); va[1][1][1] = tr_read<48 * VP + 32>(vb);
                    ca[0][1][0] = tr_read<0 * VP + 32>(cb); ca[0][1][1] = tr_read<4 * VP + 32>(cb); ca[1][1][0] = tr_read<32 * VP + 32>(cb); ca[1][1][1] = tr_read<36 * VP + 32>(cb);
                    ca[2][1][0] = tr_read<64 * VP + 32>(cb); ca[2][1][1] = tr_read<68 * VP + 32>(cb); ca[3][1][0] = tr_read<96 * VP + 32>(cb); ca[3][1][1] = tr_read<100 * VP + 32>(cb); } }
            asm volatile("s_waitcnt lgkmcnt(0)" ::: "memory"); __builtin_amdgcn_sched_barrier(0);
#pragma unroll
            for (int vt = 0; vt < 2; ++vt) {
#pragma unroll
                for (int pp = 0; pp < 2; ++pp) { const bf16x8 bfv = (bf16x8){va[pp][vt][0][0], va[pp][vt][0][1], va[pp][vt][0][2], va[pp][vt][0][3], va[pp][vt][1][0], va[pp][vt][1][1], va[pp][vt][1][2], va[pp][vt][1][3]};
                    const u32x4_t aw = (u32x4_t){ap[4 * pp], ap[4 * pp + 1], ap[4 * pp + 2], ap[4 * pp + 3]};
                    av[vt] = __builtin_amdgcn_mfma_f32_16x16x32_bf16(__builtin_bit_cast(bf16x8, aw), bfv, av[vt], 0, 0, 0); }
#pragma unroll
                for (int ks = 0; ks < 4; ++ks) { const bf16x8 bfc = (bf16x8){ca[ks][vt][0][0], ca[ks][vt][0][1], ca[ks][vt][0][2], ca[ks][vt][0][3], ca[ks][vt][1][0], ca[ks][vt][1][1], ca[ks][vt][1][2], ca[ks][vt][1][3]};
                    qc[vt] = __builtin_amdgcn_mfma_f32_16x16x32_bf16(qf[ks], bfc, qc[vt], 0, 0, 0); } }
        }
        const float M63 = fmaxf(mprev, gam[c0 + 63]); const float decay = __expf(mprev - M63);
        {   const unsigned kb = (unsigned)(unsigned long)(lds + OFF_K) + trl32k + (unsigned)(8 * hi * QP + (32 * dt) * 2);
            const unsigned wb = (unsigned)(unsigned long)(lds + OFF_WV) + trl32v + (unsigned)(8 * hi * VP + (32 * vt2) * 2);
            s16x4 ka[4][2], wa[4][2];
            ka[0][0] = tr_read<0 * QP>(kb); ka[0][1] = tr_read<4 * QP>(kb); ka[1][0] = tr_read<16 * QP>(kb); ka[1][1] = tr_read<20 * QP>(kb);
            ka[2][0] = tr_read<32 * QP>(kb); ka[2][1] = tr_read<36 * QP>(kb); ka[3][0] = tr_read<48 * QP>(kb); ka[3][1] = tr_read<52 * QP>(kb);
            wa[0][0] = tr_read<0 * VP>(wb); wa[0][1] = tr_read<4 * VP>(wb); wa[1][0] = tr_read<16 * VP>(wb); wa[1][1] = tr_read<20 * VP>(wb);
            wa[2][0] = tr_read<32 * VP>(wb); wa[2][1] = tr_read<36 * VP>(wb); wa[3][0] = tr_read<48 * VP>(wb); wa[3][1] = tr_read<52 * VP>(wb);
            asm volatile("s_waitcnt lgkmcnt(0)" ::: "memory"); __builtin_amdgcn_sched_barrier(0);
#pragma unroll
            for (int e = 0; e < 16; ++e) cacc[e] *= decay;
#pragma unroll
            for (int ks = 0; ks < 4; ++ks) { const bf16x8 fa = (bf16x8){ka[ks][0][0], ka[ks][0][1], ka[ks][0][2], ka[ks][0][3], ka[ks][1][0], ka[ks][1][1], ka[ks][1][2], ka[ks][1][3]};
                const bf16x8 fb = (bf16x8){wa[ks][0][0], wa[ks][0][1], wa[ks][0][2], wa[ks][0][3], wa[ks][1][0], wa[ks][1][1], wa[ks][1][2], wa[ks][1][3]};
                cacc = __builtin_amdgcn_mfma_f32_32x32x16_bf16(fa, fb, cacc, 0, 0, 0); } }
        { const int d_ = tid & 127, part_ = tid >> 7; float acc = 0.f;
#pragma unroll
            for (int s = 0; s < 16; ++s) acc += wl[16 * part_ + s] * bf2f(*(const LAS bf16_t*)(lds + OFF_K + (16 * part_ + s) * QP + d_ * 2));
            ((LAS float*)(lds + LDS_CONST))[part_ * 128 + d_] = acc; }
        if (ck < 24) { PREP_WRITE(); if (ck + 1 < 24) PREP_LOAD(ck + 1); }
        __syncthreads();
        if (ck < 24) PREP_STORE(ck);
        { const int tr0 = 16 * tt + 4 * g;
          const f32x4 gam4 = *(const LAS f32x4*)(gam + c0 + tr0), gb4 = *(const LAS f32x4*)(gb + c0 + tr0), rs4 = *(const LAS f32x4*)(rsl + tr0), qn4 = *(const LAS f32x4*)(qnl + tr0);
          bf16_t* hp = hs_out + (size_t)(c0 + tr0) * hs_stride;
#pragma unroll
          for (int r = 0; r < 4; ++r) { const float Mr = fmaxf(mprev, gam4[r]); const float inter = __expf(mprev - Mr), mt = gb4[r] + Mr;
            const float den = rs4[r] + inter * qn4[r]; const float dd = __builtin_amdgcn_rcpf(fmaxf(fabsf(den), __expf(-mt)));
#pragma unroll
            for (int vt = 0; vt < 2; ++vt) { const float hv = (av[vt][r] + inter * qc[vt][r]) * dd; hp[(size_t)r * hs_stride + 16 * vt] = f2bf(hv); } } }
#pragma unroll
        for (int e = 0; e < 16; ++e) { const int d = 32 * dt + (e & 3) + 8 * (e >> 2) + 4 * hi; *(LAS bf16_t*)(lds + OFF_CB + d * VP + (32 * vt2 + r32) * 2) = f2bf(cacc[e]); }
        if (tid < 128) { const LAS float* np_ = (const LAS float*)(lds + LDS_CONST); nreg = decay * nreg + ((np_[tid] + np_[128 + tid]) + (np_[256 + tid] + np_[384 + tid])); nl[tid] = nreg; }
        if (ck + 1 < 32) ML_STORE(ck + 1);
        __syncthreads();
    }
#undef ML_LOAD
#undef ML_STORE
#undef PREP_LOAD
#undef PREP_WRITE
#undef PREP_STORE
}

__device__ __forceinline__ void phase_ml_gate(const Params& p, const Frame& F, unsigned char* a8) {
    const int step = F.G * 8;
#pragma unroll 1
    for (int gw = F.bid * 8 + F.wave; gw < T * 4; gw += 4 * step) { uint2 hv2[4]; unsigned ov[4];
#pragma unroll
        for (int k = 0; k < 4; ++k) { const int g_ = gw + k * step; const bf16_t* pr = p.proj + (size_t)(g_ >> 2) * 3072 + (g_ & 3) * 256 + 4 * F.lane; hv2[k] = *(const uint2*)(pr + 1024); ov[k] = *(const unsigned*)((const unsigned char*)(p.proj + (size_t)(g_ >> 2) * 3072 + 2048) + (g_ & 3) * 256 + 4 * F.lane); }
#pragma unroll
        for (int k = 0; k < 4; ++k) { const int g_ = gw + k * step, t = g_ >> 2, h = g_ & 3; const float4 g4 = *(const float4*)(p.ml_ng + h * 256 + 4 * F.lane);
            const float h0 = __uint_as_float(hv2[k].x << 16), h1 = __uint_as_float(hv2[k].x & 0xFFFF0000u), h2 = __uint_as_float(hv2[k].y << 16), h3 = __uint_as_float(hv2[k].y & 0xFFFF0000u);
            float ss = h0 * h0 + h1 * h1 + h2 * h2 + h3 * h3; ss = wave_sum(ss); const float rs = rsqrtf(ss * (1.f / 256.f) + 1e-6f) * (F8_SA / 256.f);
            *(unsigned*)(a8 + (size_t)t * D + h * 256 + 4 * F.lane) = pk4_fp8(fp8f(ov[k], 0) * h0 * rs * g4.x, fp8f(ov[k], 1) * h1 * rs * g4.y, fp8f(ov[k], 2) * h2 * rs * g4.z, fp8f(ov[k], 3) * h3 * rs * g4.w); } }
}
__device__ __forceinline__ void phase_final(const Params& p, const Frame& F, float* dst) {
    const float* mg = p.mod + (size_t)16 * 6144 + 5 * D;
    for (size_t i4 = (size_t)F.bid * NTHR + F.tid; i4 < (size_t)T * D / 4; i4 += (size_t)F.G * NTHR) { const size_t i = i4 * 4; const int col = (int)(i % D), row = (int)(i / D), b = row / S;
        const uint2 xw = *(const uint2*)(p.xb13 + i); const float4 xv = make_float4(__uint_as_float(xw.x << 16), __uint_as_float(xw.x & 0xFFFF0000u), __uint_as_float(xw.y << 16), __uint_as_float(xw.y & 0xFFFF0000u)); float4 g = *(const float4*)(mg + b * 6144 + col); g.x *= 1.f / F8_SO; g.y *= 1.f / F8_SO; g.z *= 1.f / F8_SO; g.w *= 1.f / F8_SO; const unsigned a0 = *(const unsigned*)((const unsigned char*)p.outk + i), a1 = *(const unsigned*)((const unsigned char*)p.outk + (size_t)T * D + i);
        float4 o; o.x = xv.x + g.x * (fp8f(a0, 0) + fp8f(a1, 0)); o.y = xv.y + g.y * (fp8f(a0, 1) + fp8f(a1, 1));
        o.z = xv.z + g.z * (fp8f(a0, 2) + fp8f(a1, 2)); o.w = xv.w + g.w * (fp8f(a0, 3) + fp8f(a1, 3));
        *(float4*)(dst + i) = o; }
}

__global__ void __launch_bounds__(NTHR, 2) mega_fwd(Params p) {
    extern __shared__ __attribute__((aligned(16))) unsigned char lds_raw[];
    Frame F; F.lds = (LAS unsigned char*)lds_raw; F.tid = threadIdx.x; F.lane = F.tid & 63; F.wave = __builtin_amdgcn_readfirstlane(F.tid >> 6); F.bid = blockIdx.x; F.G = gridDim.x;
    volatile LAS unsigned* misc = (volatile LAS unsigned*)(F.lds + LDS_MISC);
    LAS Params* P = (LAS Params*)(F.lds + LDS_PARAMS);
    if (F.tid < 16) misc[F.tid] = 0u;
    if (F.tid == 64) {
#define X(t, n) P->n = p.n;
        PARAM_LIST(X)
#undef X
    }
    __syncthreads();
    { XcdBarrier b0 = xcd_barrier_post(uni_ptr(P->bar), misc); if (F.tid == 0) misc[2] = b0.x; }
    __syncthreads();
#define GRID_BAR() do { XcdBarrier bb_; bb_.bar = uni_ptr(P->bar); bb_.x = (unsigned)__builtin_amdgcn_readfirstlane((int)misc[2]); bb_.st = misc; xcd_barrier(bb_, F.wave == 0 && lane_id_asm() == 0); } while (0)
    LAS unsigned char* stage = F.lds;
#define MOD0 (q.mod)
#define MOD1 (q.mod + (size_t)16 * 6144)

    { Params q; LP(rope); LP(h); phase_prologue_a(q, launder(F)); }
    { Params q; LP(c); LP(ada_w); LP(ada_b); LP(mod); LP(cmp_pe); LP(cmp_w1); LP(cmp_b1); LP(cb1); phase_prologue_b(q, launder(F)); }
    { Params q; LP(nsa_w_in); LP(win_nsa_t); prep_weights<true>(launder(F), q.win_nsa_t, 2048, D, NSA_COLS, ColPlain{q.nsa_w_in, NSA_COLS, 0}, F.bid, F.G, F8_SW); }
    { Params q; LP(nsa_w_out); LP(wo_nsa_t); prep_weights<true>(launder(F), q.wo_nsa_t, D, D, D, ColPlain{q.nsa_w_out, D, 0}, F.bid, F.G, F8_SW); }
    { Params q; LP(ml_w_in); LP(win_ml_t); prep_weights<true>(launder(F), q.win_ml_t, 3072, D, ML_COLS, ColPlain{q.ml_w_in, 3072, 0}, F.bid, F.G, F8_SW); }
    { Params q; LP(ml_w_out); LP(wo_ml_t); prep_weights<true>(launder(F), q.wo_ml_t, D, D, D, ColPlain{q.ml_w_out, D, 0}, F.bid, F.G, F8_SW); }
    { Params q; LP(cmp_w1); LP(w1c_t); prep_weights(launder(F), q.w1c_t, 256, 2048, 256, ColPlain{q.cmp_w1, 256, 0}, F.bid, F.G);
      prep_weights(launder(F), q.w1c_t + (size_t)256 * 2048, 256, 2048, 256, ColPlain{q.cmp_w1 + (size_t)2048 * 256, 256, 0}, F.bid, F.G); }
    { Params q; LP(w_gate); LP(w_up); LP(w_down); LP(gu_t); LP(dn_t); prep_moe_weights(q, launder(F), 0, F.bid, F.G); }
    GRID_BAR();
    { Params q; LP(x); LP(g_mix); LP(mod); LP(h);
      phase_norm<0, false>(q, launder(F), q.x, nullptr, q.g_mix, MOD0 + 0 * D, MOD0 + 1 * D, nullptr, 0); }
    GRID_BAR();
    { Params q; LP(h); LP(win_nsa_t); LP(q_gain); LP(k_gain); LP(rope); LP(q); LP(kv); LP(gates);
      ge::DenseOrder So; So.init(T, 2048, F.G, F.bid);
      ge::gemm_phase<true>(stage, q.h, q.win_nsa_t, D, So, ge::DenseRows{(unsigned)D}, EpiNsaIn{q.q_gain, q.k_gain, q.rope, q.q, q.kv, q.gates, 1.f / (F8_SA * F8_SW)}, F.wave); }
    GRID_BAR();
    {
      Params q; LP(kv); LP(w1c_t); LP(cpart);
      const int w = F.bid >> 7, mt = (F.bid >> 3) & 15, ks = F.bid & 7; OneUnit So{mt};
      ge::gemm_phase(stage, q.kv + (size_t)w * T * 128 + ks * 256, q.w1c_t + (size_t)w * 256 * 2048 + ks * 256, 256, So, ge::DenseRows{2048u}, EpiCmpPart{(float*)((bf16_t*)q.cpart + (size_t)(w * 8 + ks) * 4096 * 256)}, F.wave, 2048); }
    GRID_BAR();
    { Params q; LP(cpart); LP(cb1); LP(cmp_w2); LP(cmp_b2); LP(k_gain); LP(rope); LP(kcmp); LP(vcmp);
      phase_cmp2(q, launder(F)); }
    GRID_BAR();
    { Params q; LP(q); LP(kv); LP(kcmp); LP(vcmp); LP(gates); LP(h); LP(q_gain); LP(k_gain);
      phase_attn(q, launder(F)); }
    GRID_BAR();
    { Params q; LP(h); LP(wo_nsa_t); LP(x); LP(mod); LP(xb13);
      ge::DenseOrder So; So.init(T, D, F.G, F.bid);
      ge::gemm_phase<true>(stage, q.h, q.wo_nsa_t, D, So, ge::DenseRows{(unsigned)D}, EpiResid<false>{q.x, MOD0 + 2 * D, q.xb13, 1.f / (F8_SA * F8_SW)}, F.wave); }
    GRID_BAR();
    { Params q; LP(xb13); LP(g_ffn); LP(mod); LP(h); LP(router_w); LP(router_b); LP(tokw); LP(cnt); LP(list);
      phase_norm_route(q, launder(F), q.xb13, q.g_ffn, MOD0 + 3 * D, MOD0 + 4 * D, 0); }
    GRID_BAR();
    { Params q; LP(cnt); LP(list); LP(h); LP(gu_t); LP(hid);
      LAS int* mtab = (LAS int*)(F.lds + LDS_MISC + 64); LAS int* tkt = (LAS int*)(F.lds + LDS_CONST); moe_plan(launder(F), q.cnt, q.list, mtab, tkt, 4); MoeOrder So{mtab};
      ge::gemm_phase<true>(stage, q.h, q.gu_t, D, So, MoeRows{tkt}, EpiMoe1{(unsigned char*)q.hid, 1.f / (F8_SA * F8_SW)}, F.wave); }
    GRID_BAR();
    { Params q; LP(cnt); LP(list); LP(hid); LP(dn_t); LP(outk); LP(tokw);
      LAS int* mtab = (LAS int*)(F.lds + LDS_MISC + 64); LAS int* tkt = (LAS int*)(F.lds + LDS_CONST); LAS float* tkw = (LAS float*)(F.lds + 131072); moe_plan(launder(F), q.cnt, q.list, mtab, tkt, 4, q.tokw, tkw, F8_SO / (F8_SH * F8_SW2)); MoeOrder So{mtab};
      ge::gemm_phase<true>(stage, q.hid, q.dn_t, DE, So, ge::DenseRows{(unsigned)DE}, EpiMoe2{q.outk, tkt, tkw}, F.wave); }
    GRID_BAR();
    { Params q; LP(xb13); LP(xb2); LP(g_mix); LP(mod); LP(h); LP(outk); LP(ml_w_in); LP(ml_bi); LP(ml_bf); LP(li); LP(lf);
      phase_norm<2, true>(q, launder(F), q.xb13, q.xb2, q.g_mix + D, MOD1 + 0 * D, MOD1 + 1 * D, MOD0 + 5 * D, 1); }
    GRID_BAR();
    { Params q; LP(h); LP(win_ml_t); LP(proj);
      ge::DenseOrder So; So.init(T, 3072, F.G, F.bid);
      ge::gemm_phase<true>(stage, q.h, q.win_ml_t, D, So, ge::DenseRows{(unsigned)D}, EpiMlIn{q.proj, 1.f / (F8_SA * F8_SW)}, F.wave); }
    GRID_BAR();
    { Params q; LP(proj); LP(li); LP(lf); LP(w_gate); LP(w_up); LP(w_down); LP(gu_t); LP(dn_t);
      phase_scan(q, launder(F), q.proj + 1024, 3072); }
    GRID_BAR();
    { Params q; LP(proj); LP(ml_ng); LP(h);
      phase_ml_gate(q, launder(F), (unsigned char*)q.h); }
    GRID_BAR();
    { Params q; LP(h); LP(wo_ml_t); LP(xb2); LP(mod); LP(xb13);
      ge::DenseOrder So; So.init(T, D, F.G, F.bid);
      ge::gemm_phase<true>(stage, q.h, q.wo_ml_t, D, So, ge::DenseRows{(unsigned)D}, EpiResid<true>{q.xb2, MOD1 + 2 * D, q.xb13, 1.f / (F8_SA * F8_SW)}, F.wave); }
    GRID_BAR();
    { Params q; LP(xb13); LP(g_ffn); LP(mod); LP(h); LP(router_w); LP(router_b); LP(tokw); LP(cnt); LP(list);
      phase_norm_route(q, launder(F), q.xb13, q.g_ffn + D, MOD1 + 3 * D, MOD1 + 4 * D, 1); }
    GRID_BAR();
    { Params q; LP(cnt); LP(list); LP(h); LP(gu_t); LP(hid);
      LAS int* mtab = (LAS int*)(F.lds + LDS_MISC + 64); LAS int* tkt = (LAS int*)(F.lds + LDS_CONST); moe_plan(launder(F), q.cnt + 64, q.list, mtab, tkt, 4); MoeOrder So{mtab};
      ge::gemm_phase<true>(stage, q.h, q.gu_t, D, So, MoeRows{tkt}, EpiMoe1{(unsigned char*)q.hid, 1.f / (F8_SA * F8_SW)}, F.wave); }
    GRID_BAR();
    { Params q; LP(cnt); LP(list); LP(hid); LP(dn_t); LP(outk); LP(tokw);
      LAS int* mtab = (LAS int*)(F.lds + LDS_MISC + 64); LAS int* tkt = (LAS int*)(F.lds + LDS_CONST); LAS float* tkw = (LAS float*)(F.lds + 131072); moe_plan(launder(F), q.cnt + 64, q.list, mtab, tkt, 4, q.tokw, tkw, F8_SO / (F8_SH * F8_SW2)); MoeOrder So{mtab};
      ge::gemm_phase<true>(stage, q.hid, q.dn_t, DE, So, ge::DenseRows{(unsigned)DE}, EpiMoe2{q.outk, tkt, tkw}, F.wave); }
    GRID_BAR();
    { Params q; LP(mod); LP(out); LP(outk); LP(xb13);
      phase_final(q, launder(F), q.out); }
}

static inline size_t al(size_t x) { return (x + 255) & ~(size_t)255; }
extern "C" void kernel_launch(void* const* d_in, const int* in_sizes, int n_in, void* d_out, int out_size, void* d_ws, size_t ws_size, hipStream_t stream) {
    char* ws = (char*)d_ws; size_t off = 0;
    auto take = [&](size_t bytes) { size_t o = off; off = al(off + bytes); return o; };
    Params p{};
    const float** pin = (const float**)&p;
    for (int i = 0; i < 25; ++i) pin[i] = (const float*)d_in[i];
    p.out = (float*)d_out;
    const size_t ctl_bytes = (size_t)XCD_BAR_WORDS * 4 + 1024;
    p.bar = (unsigned*)(ws + take(ctl_bytes)); p.cnt = (int*)(p.bar + XCD_BAR_WORDS); p.dcnt = p.cnt + 128;
    p.mod = (float*)(ws + take((size_t)2 * 16 * 6144 * 4)); p.rope = (float*)(ws + take(2048 * 16 * 4)); p.cb1 = (float*)(ws + take(512 * 4));
    p.tokw = (float*)(ws + take((size_t)T * 2 * 4)); p.list = (int*)(ws + take((size_t)NE * T * 4)); p.dlist = (int*)(ws + take((size_t)NE * T * 4)); p.li = (float*)(ws + take((size_t)T * 4 * 4)); p.lf = (float*)(ws + take((size_t)T * 4 * 4));
    p.h = (bf16_t*)(ws + take((size_t)(T + 8) * D * 2)); p.hidc = (bf16_t*)(ws + take((size_t)2 * 4096 * 256 * 2)); p.xb13 = (bf16_t*)(ws + take((size_t)T * D * 2)); p.xb2 = (bf16_t*)(ws + take((size_t)T * D * 2));
    p.wo_nsa_t = (bf16_t*)(ws + take((size_t)D * D * 2)); p.wo_ml_t = (bf16_t*)(ws + take((size_t)D * D * 2));
    p.win_nsa_t = (bf16_t*)(ws + take((size_t)2048 * D * 2)); p.win_ml_t = (bf16_t*)(ws + take((size_t)3072 * D * 2)); p.w1c_t = (bf16_t*)(ws + take((size_t)2 * 256 * 2048 * 2));
    p.gu_t = (bf16_t*)(ws + take((size_t)NE * 1024 * D * 2)); p.dn_t = (bf16_t*)(ws + take((size_t)NE * D * DE * 2));
    const size_t r1 = off;
    p.q = (bf16_t*)(ws + take((size_t)T * D * 2)); p.kv = (bf16_t*)(ws + take((size_t)6 * T * 128 * 2 + (1 << 20)));
    p.gates = (float*)(ws + take((size_t)T * 48 * 4)); p.kcmp = (bf16_t*)(ws + take((size_t)32 * 128 * 64 * 2)); p.vcmp = (bf16_t*)(ws + take((size_t)32 * 128 * 64 * 2));
    p.cpart = (float*)(ws + take((size_t)2 * 8 * 4096 * 256 * 4));
    const size_t end_nsa = off; off = r1;
    p.proj = (bf16_t*)(ws + take((size_t)T * 3072 * 2)); const size_t end_ml = off; off = r1;
    p.hid = (bf16_t*)(ws + take((size_t)(65536 + 8192) * DE * 2)); p.outk = (bf16_t*)(ws + take((size_t)2 * T * D * 2)); const size_t end_moe = off;
    size_t need = end_nsa > end_ml ? end_nsa : end_ml; if (end_moe > need) need = end_moe;
    if (need > ws_size || n_in != 25) return;
    static bool attr_done = false;
    if (!attr_done) { (void)hipFuncSetAttribute((const void*)mega_fwd, hipFuncAttributeMaxDynamicSharedMemorySize, LDS_BYTES); attr_done = true; }
    (void)hipMemsetAsync(p.bar, 0, ctl_bytes, stream);
    hipLaunchKernelGGL(mega_fwd, dim3(NWG), dim3(NTHR), LDS_BYTES, stream, p);
}
```

```cpp
#include <hip/hip_runtime.h>
#include <stdint.h>

typedef unsigned short bf16_t;
__device__ __forceinline__ float bf2f(bf16_t v) { return __uint_as_float(((unsigned)v) << 16); }
typedef float f32x2_t __attribute__((ext_vector_type(2)));
__device__ __forceinline__ unsigned pk2g(float a, float b) { typedef __bf16 b2 __attribute__((ext_vector_type(2))); b2 r = __builtin_convertvector((f32x2_t){a, b}, b2); return __builtin_bit_cast(unsigned, r); }
__device__ __forceinline__ bf16_t f2bf(float f) { return (bf16_t)pk2g(f, f); }
__device__ __forceinline__ unsigned pk4_fp8(float a, float b, float c, float d) { int w = 0;
    w = __builtin_amdgcn_cvt_pk_fp8_f32(__builtin_amdgcn_fmed3f(a, -448.f, 448.f), __builtin_amdgcn_fmed3f(b, -448.f, 448.f), w, false);
    w = __builtin_amdgcn_cvt_pk_fp8_f32(__builtin_amdgcn_fmed3f(c, -448.f, 448.f), __builtin_amdgcn_fmed3f(d, -448.f, 448.f), w, true); return (unsigned)w; }

constexpr int Bn = 16, S = 2048, D = 1024, T = Bn * S;
constexpr int NSA_COLS = 1840, ML_COLS = 3080;
constexpr int NE = 32, DE = 512;
constexpr int NWG = 256, NTHR = 512;

template <int M> __device__ __forceinline__ float sx(float v) { return __int_as_float(__builtin_amdgcn_ds_swizzle(__float_as_int(v), (M << 10) | 0x1F)); }
template <int M> __device__ __forceinline__ unsigned sxu(unsigned v) { return (unsigned)__builtin_amdgcn_ds_swizzle((int)v, (M << 10) | 0x1F); }
__device__ __forceinline__ float sum32(float v) { const auto r = __builtin_amdgcn_permlane32_swap(__float_as_uint(v), __float_as_uint(v), false, false); return __uint_as_float(r[0]) + __uint_as_float(r[1]); }
__device__ __forceinline__ float max32(float v) { const auto r = __builtin_amdgcn_permlane32_swap(__float_as_uint(v), __float_as_uint(v), false, false); return fmaxf(__uint_as_float(r[0]), __uint_as_float(r[1])); }
__device__ __forceinline__ float other32(float v, bool hi) { const auto r = __builtin_amdgcn_permlane32_swap(__float_as_uint(v), __float_as_uint(v), false, false); return __uint_as_float(hi ? r[0] : r[1]); }
template <int CTRL> __device__ __forceinline__ float dppf(float v) { return __int_as_float(__builtin_amdgcn_update_dpp(0, __float_as_int(v), CTRL, 0xF, 0xF, true)); }
__device__ __forceinline__ float sum16(float v) { const auto r = __builtin_amdgcn_permlane16_swap(__float_as_uint(v), __float_as_uint(v), false, false); return __uint_as_float(r[0]) + __uint_as_float(r[1]); }
__device__ __forceinline__ float max16(float v) { const auto r = __builtin_amdgcn_permlane16_swap(__float_as_uint(v), __float_as_uint(v), false, false); return fmaxf(__uint_as_float(r[0]), __uint_as_float(r[1])); }
__device__ __forceinline__ float wave_sum(float v) { v += dppf<0xB1>(v); v += dppf<0x4E>(v); v += dppf<0x141>(v); v += dppf<0x140>(v); v = sum16(v); return sum32(v); }
__device__ __forceinline__ float wave_max(float v) { v = fmaxf(v, dppf<0xB1>(v)); v = fmaxf(v, dppf<0x4E>(v)); v = fmaxf(v, dppf<0x141>(v)); v = fmaxf(v, dppf<0x140>(v)); v = max16(v); return max32(v); }
__device__ __forceinline__ float rdlane(float v, int l) { return __int_as_float(__builtin_amdgcn_readlane(__float_as_int(v), l)); }
__device__ __forceinline__ float sigmoidf_(float x) { return 1.f / (1.f + expf(-x)); }
__device__ __forceinline__ float fsigmoid(float x) { return __builtin_amdgcn_rcpf(1.f + __builtin_amdgcn_exp2f(-1.4426950408889634f * x)); }
__device__ __forceinline__ float ftanh(float x) { return 1.f - 2.f * __builtin_amdgcn_rcpf(1.f + __builtin_amdgcn_exp2f(2.8853900817779268f * x)); }

#define XB_TMO      128
#define XB_XCNT(j)  (256  + 64 * (j))
#define XB_XSUB(j)  (1280 + 64 * (j))
#define XB_XGEN(j)  (2304 + 64 * (j))
#define XB_TOP      3328
#define XB_TOPGEN   3392
#define XCD_BAR_WORDS 3456
#define XB_SPIN_CAP (1u << 18)
#define LAS __attribute__((address_space(3)))
__device__ __forceinline__ unsigned xb_ld(unsigned* p)              { return __hip_atomic_load(p, __ATOMIC_RELAXED, __HIP_MEMORY_SCOPE_AGENT); }
__device__ __forceinline__ unsigned xb_add(unsigned* p, unsigned v) { return __hip_atomic_fetch_add(p, v, __ATOMIC_RELAXED, __HIP_MEMORY_SCOPE_AGENT); }
__device__ __forceinline__ unsigned xb_xcc_id() { return (unsigned)__builtin_amdgcn_s_getreg((3 << 11) | 20) & 0xFu; }
#define XB_SPIN(cond, bar) do { unsigned _sp = 0; while (cond) { __builtin_amdgcn_s_sleep(1); \
    if ((++_sp & 255u) == 0u) { if (xb_ld(&(bar)[XB_TMO])) break; if (_sp > XB_SPIN_CAP) { atomicAdd(&(bar)[XB_TMO], 1u); break; } } } } while (0)
struct XcdBarrier { unsigned* bar; unsigned x; volatile LAS unsigned* st; };
__device__ __forceinline__ XcdBarrier xcd_barrier_post(unsigned* bar, volatile LAS unsigned* st) {
    XcdBarrier b; b.bar = bar; b.x = xb_xcc_id(); b.st = st;
    if (threadIdx.x == 0) (void)xb_add(&bar[XB_XCNT(b.x)], 1u);
    return b;
}
__device__ __forceinline__ void xcd_barrier_complete(unsigned* bar, unsigned x, unsigned& nloc, unsigned& nx) {
    const unsigned G = gridDim.x * gridDim.y * gridDim.z;
    unsigned sum, cnt, mine, sp = 0u;
    for (;;) {
        sum = 0u; cnt = 0u; mine = 0u;
#pragma unroll
        for (unsigned j = 0; j < 16; ++j) { const unsigned c = xb_ld(&bar[XB_XCNT(j)]); sum += c; cnt += (c > 0u) ? 1u : 0u; mine = (j == x) ? c : mine; }
        if (sum == G) break;
        __builtin_amdgcn_s_sleep(1);
        if ((++sp & 255u) == 0u) { if (xb_ld(&bar[XB_TMO])) break; if (sp > XB_SPIN_CAP) { atomicAdd(&bar[XB_TMO], 1u); break; } }
    }
    nloc = mine > 0u ? mine : 1u; nx = cnt > 0u ? cnt : 1u;
}
__device__ __forceinline__ void xcd_barrier(const XcdBarrier& b, const bool leader  ) {
    asm volatile("s_waitcnt vmcnt(0)" ::: "memory");
    __syncthreads();
    if (leader) {
        unsigned* bar = b.bar;
        __builtin_amdgcn_s_waitcnt(0);
        unsigned nloc = b.st[0], nx = b.st[1];
        if (nloc == 0u) { xcd_barrier_complete(bar, b.x, nloc, nx); b.st[0] = nloc; b.st[1] = nx; }
        const unsigned old = xb_add(&bar[XB_XSUB(b.x)], 1u);
        const unsigned gen = old / nloc;
        if (old + 1u == (gen + 1u) * nloc) {
            __builtin_amdgcn_fence(__ATOMIC_RELEASE, "agent");
            asm volatile("s_waitcnt vmcnt(0)" ::: "memory");
            const unsigned og = xb_add(&bar[XB_TOP], 1u);
            const unsigned tg = og / nx;
            if (og + 1u == (tg + 1u) * nx) xb_add(&bar[XB_TOPGEN], 1u);
            else XB_SPIN(xb_ld(&bar[XB_TOPGEN]) == tg, bar);
            __builtin_amdgcn_fence(__ATOMIC_ACQUIRE, "agent");
            xb_add(&bar[XB_XGEN(b.x)], 1u);
            asm volatile("s_waitcnt vmcnt(0)" ::: "memory");
        } else {
            XB_SPIN(xb_ld(&bar[XB_XGEN(b.x)]) == gen, bar);
            __builtin_amdgcn_fence(__ATOMIC_ACQUIRE, "agent");
            asm volatile("s_waitcnt vmcnt(0)" ::: "memory");
        }
    }
    __syncthreads();
}

typedef short bf16x8 __attribute__((ext_vector_type(8)));
typedef float f32x4 __attribute__((ext_vector_type(4)));
namespace ge {
constexpr int BM = 256, BK = 64, HALF = 128, HTB = HALF * BK * 2, STAGE_BYTES = 8 * HTB;
__host__ __device__ __forceinline__ int lds_byte(int r, int c) { const int st = (r >> 4) * 2 + (c >> 5), rr = r & 15, cc = c & 31, ob = rr * 64 + cc * 2; return st * 1024 + (ob ^ (((ob >> 9) & 1) << 5)); }
__host__ __device__ __forceinline__ void stage_rc(int b, int& R, int& C) { const int st = b / 1024, sb = b % 1024, swz = sb ^ (((sb >> 9) & 1) << 5); R = (st >> 1) * 16 + swz / 64; C = (st & 1) * 32 + (swz % 64) / 2; }
struct Unit { int pm, pn, bt, aux; };
__host__ __device__ __forceinline__ int logical_col(int c) { const int pn = c >> 8, bj = (c >> 7) & 1, wc = (c >> 5) & 3, n = (c >> 4) & 1, fq = (c >> 2) & 3, j = c & 3; return (4 * pn + wc) * 64 + 16 * fq + 8 * bj + 4 * n + j; }
struct DenseOrder {
    int nM, nN, nwg, G, c;
    __device__ void init(int M, int N, int G_, int c_) { nM = M / BM; nN = N / BM; nwg = nM * nN; G = G_; c = c_; }
    __device__ bool next(int i, Unit& u) const {
        const long L = (long)i * G + c; if (L >= nwg) return false;
        int wgid = (int)L; { const int q = nwg / 8, r = nwg % 8, xcd = wgid % 8, off = wgid / 8; wgid = (xcd < r ? xcd * (q + 1) : r * (q + 1) + (xcd - r) * q) + off; }
        const int nig = 8 * nN, gid = wgid / nig, fm = gid * 8, gsz = (nM - fm) < 8 ? (nM - fm) : 8;
        u.pm = fm + ((wgid % nig) % gsz); u.pn = (wgid % nig) / gsz; u.bt = u.pn; u.aux = 0; return true;
    }
};
struct DenseRows { static constexpr bool dense = true; unsigned ldab; __device__ __forceinline__ unsigned operator()(const Unit& u, int r) const { return (unsigned)(u.pm * 256 + r) * ldab; } };
template <class Tp> __device__ __forceinline__ Tp* uni(Tp* v) { const unsigned long long u = (unsigned long long)v; const unsigned lo = __builtin_amdgcn_readfirstlane((unsigned)u), hi = __builtin_amdgcn_readfirstlane((unsigned)(u >> 32)); return (Tp*)(((unsigned long long)hi << 32) | lo); }

typedef int i32x8 __attribute__((ext_vector_type(8)));
typedef int i32x4 __attribute__((ext_vector_type(4)));
template <bool F8> struct Frag;
template <> struct Frag<false> { bf16x8 v[2]; };
template <> struct Frag<true> { i32x8 v; };
template <bool F8> __device__ __forceinline__ void load_frag(Frag<F8>& f, const LAS unsigned char* p0, const int hx = 16) {
    if constexpr (F8) { const i32x4 lo = *(const LAS i32x4*)p0, hi = *(const LAS i32x4*)(p0 + hx); f.v = __builtin_shufflevector(lo, hi, 0, 1, 2, 3, 4, 5, 6, 7); }
    else { f.v[0] = *(const LAS bf16x8*)p0; f.v[1] = *(const LAS bf16x8*)(p0 + 1024); }
}
template <bool F8> __device__ __forceinline__ f32x4 mma_kt(const Frag<F8>& b, const Frag<F8>& a, f32x4 c) {
    if constexpr (F8) return __builtin_amdgcn_mfma_scale_f32_16x16x128_f8f6f4(b.v, a.v, c, 0, 0, 0, 0x7F7F7F7F, 0, 0x7F7F7F7F);
    else { c = __builtin_amdgcn_mfma_f32_16x16x32_bf16(b.v[0], a.v[0], c, 0, 0, 0); return __builtin_amdgcn_mfma_f32_16x16x32_bf16(b.v[1], a.v[1], c, 0, 0, 0); }
}
template <bool F8 = false, class Sched, class RowMap, class Epi>
__device__ __forceinline__ void gemm_phase(LAS unsigned char* lds, const void* A, const void* Bt, const int K, const Sched& S, const RowMap& RM, const Epi& E, const int wave_id, const int ldb_ = 0  ) {
    int tid_; asm volatile("v_mbcnt_lo_u32_b32 %0, -1, 0\n\tv_mbcnt_hi_u32_b32 %0, -1, %0" : "=v"(tid_)); tid_ += wave_id * 64;
    const int tid = tid_, wid = __builtin_amdgcn_readfirstlane(tid >> 6), lane = tid & 63, wr = wid >> 2, wc = wid & 3, fr = lane & 15, fq = lane >> 4;
    const int nt = K / (F8 ? 2 * BK : BK);
    constexpr bool DR = RowMap::dense;
    int sR[2], sC[2];
    const int ldb = ldb_ ? ldb_ : K;
#pragma unroll
    for (int i = 0; i < 2; ++i) stage_rc(tid * 16 + i * 8192, sR[i], sC[i]);
    const unsigned voffB = F8 ? (unsigned)(sR[0] * ldb + sC[0] * 2) : (unsigned)(sR[0] * ldb + sC[0]) * 2u;
    unsigned ldab_ = 0, voffA = 0; if constexpr (DR) { ldab_ = RM.ldab; voffA = (unsigned)sR[0] * ldab_ + (unsigned)sC[0] * 2u; }
    const size_t kstep = (size_t)(BK * 2), hstepB = (size_t)HALF * ldb * (F8 ? 1 : 2), tstepB = 2 * hstepB, qstepB = hstepB / 2;
    const unsigned ldsw = (unsigned)wid * 1024u;
    const int sw = (F8 && (fq & 1)) ? 16 : 0, hx = 16 - 2 * sw;
    const int aoff = lds_byte(wr * 64 + fr, fq * (F8 ? 16 : 8)) + sw, boff = lds_byte(wc * 32 + fr, fq * (F8 ? 16 : 8)) + sw;
    const char* Ab = (const char*)A;
#define GE_SA(b, h) (((b) * 2 + (h)) * ge::HTB)
#define GE_SB(b, h) ((4 + (b) * 2 + (h)) * ge::HTB)
#define GE_GLD(sp, vo, ldsoff) do { unsigned _v = (vo); asm volatile("" : "+v"(_v));     \
        __builtin_amdgcn_global_load_lds((const unsigned*)(uni((const char*)(sp)) + _v), (LAS unsigned*)(lds + (ldsoff)), 16, 0, 0); } while (0)
#define GE_STB(bufoff, gbase) do { _Pragma("unroll") for (int _i = 0; _i < 2; ++_i) GE_GLD((gbase) + _i * qstepB, voffB, (bufoff) + ldsw + _i * 8192); } while (0)
#define GE_STA(bufoff, sp, OFF, h) do { _Pragma("unroll") for (int _i = 0; _i < 2; ++_i) { \
        if constexpr (DR) GE_GLD((sp) + (size_t)((h) * 128 + _i * 64) * ldab_, voffA, (bufoff) + ldsw + _i * 8192); \
        else GE_GLD((sp), (OFF)[h][_i], (bufoff) + ldsw + _i * 8192); } } while (0)
#define GE_LDA(dst, b, h) do { _Pragma("unroll") for (int m = 0; m < 4; ++m) load_frag<F8>(dst[m], lds + GE_SA(b, h) + aoff + m * 2048, hx); } while (0)
#define GE_LDB(dst, b, h) do { _Pragma("unroll") for (int n = 0; n < 2; ++n) load_frag<F8>(dst[n], lds + GE_SB(b, h) + boff + n * 2048, hx); } while (0)
#define GE_MMA(ai, bj, At, Bt_) do { __builtin_amdgcn_s_setprio(1); _Pragma("unroll") for (int m = 0; m < 4; ++m) _Pragma("unroll") for (int n = 0; n < 2; ++n) \
        acc[ai][bj][m][n] = mma_kt<F8>(Bt_[n], At[m], acc[ai][bj][m][n]); __builtin_amdgcn_s_setprio(0); } while (0)
#define GE_WAIT_V(n) asm volatile("s_waitcnt vmcnt(" #n ")" ::: "memory")
#define GE_WAIT_L(n) asm volatile("s_waitcnt lgkmcnt(" #n ")" ::: "memory")
#define GE_BAR __builtin_amdgcn_s_barrier()
#define GE_SCHED __builtin_amdgcn_sched_barrier(0)
#define GE_OFFS(OFF, u) do { int _l; asm volatile("v_mbcnt_lo_u32_b32 %0, -1, 0\n\tv_mbcnt_hi_u32_b32 %0, -1, %0" : "=v"(_l)); int _r0, _c0; stage_rc((wave_id * 64 + _l) * 16, _r0, _c0);     \
        _Pragma("unroll") for (int _h = 0; _h < 2; ++_h) _Pragma("unroll") for (int _i = 0; _i < 2; ++_i) (OFF)[_h][_i] = RM((u), _h * 128 + _i * 64 + _r0) + (unsigned)_c0 * 2u; \
        asm volatile("" : "+v"((OFF)[0][0]), "+v"((OFF)[0][1]), "+v"((OFF)[1][0]), "+v"((OFF)[1][1])); } while (0)
    Unit cur, nxt; int ui = 0;
    if (!S.next(0, cur)) return;
    unsigned offC[2][2];
    const char* aC = Ab; const char* aN = Ab;
    if constexpr (DR) aC = Ab + (size_t)cur.pm * 256 * ldab_; else GE_OFFS(offC, cur);
    f32x4 acc[2][2][4][2];
#pragma unroll
    for (int a = 0; a < 2; ++a)
#pragma unroll
        for (int b = 0; b < 2; ++b)
#pragma unroll
            for (int m = 0; m < 4; ++m)
#pragma unroll
                for (int n = 0; n < 2; ++n) acc[a][b][m][n] = (f32x4){0.f, 0.f, 0.f, 0.f};
    Frag<F8> At[4], B0[2], B1[2];
    const char* cB = (const char*)Bt + (size_t)cur.bt * tstepB;
    GE_STB(GE_SB(0, 0), cB); GE_STA(GE_SA(0, 0), aC, offC, 0); GE_STB(GE_SB(0, 1), cB + hstepB); GE_STA(GE_SA(0, 1), aC, offC, 1);
    if (wr == 1) GE_BAR;
    GE_WAIT_V(4); GE_BAR;
    GE_STB(GE_SB(1, 0), cB + kstep); GE_STA(GE_SA(1, 0), aC + kstep, offC, 0); GE_STB(GE_SB(1, 1), cB + hstepB + kstep);
    GE_WAIT_V(6); GE_BAR;
    for (;;) {
        const bool has_next = S.next(ui + 1, nxt);
        if constexpr (DR) aN = has_next ? Ab + (size_t)nxt.pm * 256 * ldab_ : aC;
        const char* nB = has_next ? (const char*)Bt + (size_t)nxt.bt * tstepB : cB;
#pragma unroll 1
        for (int t = 0; t < nt; t += 2) {
            const bool last = (t == nt - 2);
            const size_t k1 = (size_t)(t + 1) * kstep;
            const size_t k2 = last ? 0 : (size_t)(t + 2) * kstep, k3 = k2 + kstep;
            const char* b2 = last ? nB : cB + (size_t)(t + 2) * kstep; const char* b3 = b2 + kstep;
            const char* a2 = last ? aN : aC;
            GE_LDB(B0, 0, 0); GE_SCHED; GE_LDA(At, 0, 0); GE_STA(GE_SA(1, 1), aC + k1, offC, 1);
            GE_WAIT_L(8); GE_BAR; GE_WAIT_L(0); GE_MMA(0, 0, At, B0); GE_BAR; GE_SCHED;
            GE_LDB(B1, 0, 1); GE_STB(GE_SB(0, 0), b2);
            GE_BAR; GE_WAIT_L(0); GE_MMA(0, 1, At, B1); GE_BAR;
            GE_LDA(At, 0, 1);
            if constexpr (!DR) { if (last && has_next) GE_OFFS(offC, nxt); }
            GE_STA(GE_SA(0, 0), a2 + k2, offC, 0);
            GE_BAR; GE_WAIT_L(0); GE_MMA(1, 0, At, B0); GE_BAR; GE_SCHED;
            GE_STB(GE_SB(0, 1), b2 + hstepB);
            GE_WAIT_V(6); GE_BAR; GE_MMA(1, 1, At, B1); GE_BAR;
            GE_LDB(B0, 1, 0); GE_SCHED; GE_LDA(At, 1, 0); GE_STA(GE_SA(0, 1), a2 + k2, offC, 1);
            GE_WAIT_L(8); GE_BAR; GE_WAIT_L(0); GE_MMA(0, 0, At, B0); GE_BAR; GE_SCHED;
            GE_LDB(B1, 1, 1); GE_STB(GE_SB(1, 0), b3);
            GE_BAR; GE_WAIT_L(0); GE_MMA(0, 1, At, B1); GE_BAR;
            GE_LDA(At, 1, 1); GE_STA(GE_SA(1, 0), a2 + k3, offC, 0);
            GE_BAR; GE_WAIT_L(0); GE_MMA(1, 0, At, B0); GE_BAR; GE_SCHED;
            GE_STB(GE_SB(1, 1), b3 + hstepB);
            GE_WAIT_V(6); GE_BAR; GE_MMA(1, 1, At, B1); GE_BAR;
        }
#pragma unroll
        for (int a = 0; a < 2; ++a)
#pragma unroll
            for (int b = 0; b < 2; ++b) asm volatile("" : "+v"(acc[a][b][0][0]), "+v"(acc[a][b][0][1]), "+v"(acc[a][b][1][0]), "+v"(acc[a][b][1][1]), "+v"(acc[a][b][2][0]), "+v"(acc[a][b][2][1]), "+v"(acc[a][b][3][0]), "+v"(acc[a][b][3][1]));
        { int l2; asm volatile("v_mbcnt_lo_u32_b32 %0, -1, 0\n\tv_mbcnt_hi_u32_b32 %0, -1, %0" : "=v"(l2)); E(acc, cur, wr, wc, l2 & 15, l2 >> 4); }
        if (!has_next) break;
#pragma unroll
        for (int a = 0; a < 2; ++a)
#pragma unroll
            for (int b = 0; b < 2; ++b)
#pragma unroll
                for (int m = 0; m < 4; ++m)
#pragma unroll
                    for (int n = 0; n < 2; ++n) acc[a][b][m][n] = (f32x4){0.f, 0.f, 0.f, 0.f};
        cur = nxt; cB = nB; aC = aN; ++ui;
    }
    GE_WAIT_V(0);
    if (wr == 0) GE_BAR;
    GE_BAR;
}
#define GE_VALS(v, acc, ai, m) do { _Pragma("unroll") for (int _b = 0; _b < 2; ++_b) _Pragma("unroll") for (int _n = 0; _n < 2; ++_n) _Pragma("unroll") for (int _j = 0; _j < 4; ++_j) (v)[8 * _b + 4 * _n + _j] = (acc)[ai][_b][m][_n][_j]; } while (0)
}
__device__ __forceinline__ void store16_bf16(bf16_t* dst, const float (&v)[16]) {
    unsigned w[8];
#pragma unroll
    for (int i = 0; i < 8; ++i) w[i] = pk2g(v[2 * i], v[2 * i + 1]);
    uint4* d4 = (uint4*)dst; d4[0] = make_uint4(w[0], w[1], w[2], w[3]); d4[1] = make_uint4(w[4], w[5], w[6], w[7]);
}
template <bool IN_BF16>
struct EpiResid { const void* xin; const float* mod_g; bf16_t* xout; float inscale;
    __device__ __forceinline__ void operator()(const f32x4 (&acc)[2][2][4][2], const ge::Unit& u, int wr, int wc, int fr, int fq) const {
        const int col0 = (4 * u.pn + wc) * 64 + 16 * fq; const int b = (u.pm * 256) / S;
        float4 gq[4];
#pragma unroll
        for (int q4 = 0; q4 < 4; ++q4) { gq[q4] = *(const float4*)(mod_g + b * 6144 + col0 + 4 * q4); gq[q4].x *= inscale; gq[q4].y *= inscale; gq[q4].z *= inscale; gq[q4].w *= inscale; }
        if constexpr (IN_BF16) {
            uint4 xh[2][4][2];
#pragma unroll
            for (int ai = 0; ai < 2; ++ai)
#pragma unroll
                for (int m = 0; m < 4; ++m) { const size_t o = (size_t)(u.pm * 256 + ai * 128 + wr * 64 + m * 16 + fr) * D + col0; xh[ai][m][0] = *(const uint4*)((const bf16_t*)xin + o); xh[ai][m][1] = *(const uint4*)((const bf16_t*)xin + o + 8); }
            const float g16[16] = {gq[0].x, gq[0].y, gq[0].z, gq[0].w, gq[1].x, gq[1].y, gq[1].z, gq[1].w, gq[2].x, gq[2].y, gq[2].z, gq[2].w, gq[3].x, gq[3].y, gq[3].z, gq[3].w};
#pragma unroll
            for (int ai = 0; ai < 2; ++ai)
#pragma unroll
                for (int m = 0; m < 4; ++m) { float v[16]; GE_VALS(v, acc, ai, m);
                    const unsigned w8[8] = {xh[ai][m][0].x, xh[ai][m][0].y, xh[ai][m][0].z, xh[ai][m][0].w, xh[ai][m][1].x, xh[ai][m][1].y, xh[ai][m][1].z, xh[ai][m][1].w};
#pragma unroll
                    for (int k = 0; k < 8; ++k) { v[2 * k] = __uint_as_float(w8[k] << 16) + g16[2 * k] * v[2 * k]; v[2 * k + 1] = __uint_as_float(w8[k] & 0xFFFF0000u) + g16[2 * k + 1] * v[2 * k + 1]; }
                    store16_bf16(xout + (size_t)(u.pm * 256 + ai * 128 + wr * 64 + m * 16 + fr) * D + col0, v); }
        } else {
#pragma unroll
        for (int ai = 0; ai < 2; ++ai) { float4 xv[4][4];
#pragma unroll
            for (int m = 0; m < 4; ++m) { const size_t o = (size_t)(u.pm * 256 + ai * 128 + wr * 64 + m * 16 + fr) * D + col0;
#pragma unroll
                for (int q4 = 0; q4 < 4; ++q4) xv[m][q4] = *(const float4*)((const float*)xin + o + 4 * q4); }
#pragma unroll
            for (int m = 0; m < 4; ++m) { float v[16]; GE_VALS(v, acc, ai, m); float xr[16];
#pragma unroll
                for (int q4 = 0; q4 < 4; ++q4) { xr[4 * q4] = xv[m][q4].x; xr[4 * q4 + 1] = xv[m][q4].y; xr[4 * q4 + 2] = xv[m][q4].z; xr[4 * q4 + 3] = xv[m][q4].w; }
                const float g16[16] = {gq[0].x, gq[0].y, gq[0].z, gq[0].w, gq[1].x, gq[1].y, gq[1].z, gq[1].w, gq[2].x, gq[2].y, gq[2].z, gq[2].w, gq[3].x, gq[3].y, gq[3].z, gq[3].w};
#pragma unroll
                for (int k = 0; k < 16; ++k) v[k] = xr[k] + g16[k] * v[k];
                store16_bf16(xout + (size_t)(u.pm * 256 + ai * 128 + wr * 64 + m * 16 + fr) * D + col0, v); } }
        }
    } };
struct EpiNsaIn { const float* q_gain; const float* k_gain; const float* rope; bf16_t* q; bf16_t* kv; float* gates; float inscale;
    __device__ __forceinline__ void operator()(const f32x4 (&acc)[2][2][4][2], const ge::Unit& u, int wr, int wc, int fr, int fq) const {
        const int slot = 4 * u.pn + wc; if (slot > 28) return;
        const bool normed = (slot < 16) || slot == 20 || slot == 21 || slot == 24 || slot == 25;
        const float* gain = (slot < 16) ? q_gain : ((slot < 22) ? k_gain + 64 : k_gain + 128);
        float gv[16];
        if (normed) {
#pragma unroll
            for (int i = 0; i < 16; ++i) gv[i] = gain[16 * fq + i]; }
#pragma unroll
        for (int ai = 0; ai < 2; ++ai)
#pragma unroll
            for (int m = 0; m < 4; ++m) { const int row = u.pm * 256 + ai * 128 + wr * 64 + m * 16 + fr; const int b = row / S, s = row % S; float v[16]; GE_VALS(v, acc, ai, m);
#pragma unroll
                for (int i = 0; i < 16; ++i) v[i] *= inscale;
                if (slot == 28) { if (fq < 3) { float* gp = gates + (size_t)row * 48 + 16 * fq;
#pragma unroll
                        for (int q4 = 0; q4 < 4; ++q4) *(float4*)(gp + 4 * q4) = make_float4(fsigmoid(v[4 * q4]), fsigmoid(v[4 * q4 + 1]), fsigmoid(v[4 * q4 + 2]), fsigmoid(v[4 * q4 + 3])); }
                    continue; }
                if (normed) { float ss = 0.f;
#pragma unroll
                    for (int i = 0; i < 16; ++i) ss += v[i] * v[i];
                    ss = sum16(ss); ss = sum32(ss); const float r = rsqrtf(ss * (1.f / 64.f) + 1e-6f);
#pragma unroll
                    for (int i = 0; i < 16; ++i) v[i] *= r * gv[i];
                    if (fq == 0) { const float sf = (float)s;
                        constexpr float IFR[8] = {0.15915494309189535f, 0.030863763158420102f, 0.00598518567638293f, 0.001160663620968869f, 0.00022507907904105153f, 4.364795481173399e-05f, 8.464330549652592e-06f, 1.6414262419538367e-06f};
#pragma unroll
                        for (int i = 0; i < 8; ++i) { const float rev = __builtin_amdgcn_fractf(sf * IFR[i]); const float cs = __builtin_amdgcn_cosf(rev), sn = __builtin_amdgcn_sinf(rev), a = v[i], bb = v[i + 8]; v[i] = a * cs - bb * sn; v[i + 8] = bb * cs + a * sn; } } }
                bf16_t* dst;
                if (slot < 16) dst = q + (size_t)row * D + slot * 64 + 16 * fq;
                else { const int kk = slot - 16, ten = kk >> 1, g = kk & 1; dst = kv + (size_t)ten * T * 128 + ((size_t)(b * 2 + g) * S + s) * 64 + 16 * fq; }
                store16_bf16(dst, v); }
    } };
struct EpiMlIn { bf16_t* proj; float inscale;
    __device__ __forceinline__ void operator()(const f32x4 (&acc)[2][2][4][2], const ge::Unit& u, int wr, int wc, int fr, int fq) const {
        const int slot = 4 * u.pn + wc; const int L0 = slot * 64 + 16 * fq;
#pragma unroll
        for (int ai = 0; ai < 2; ++ai)
#pragma unroll
            for (int m = 0; m < 4; ++m) { const int row = u.pm * 256 + ai * 128 + wr * 64 + m * 16 + fr; float v[16]; GE_VALS(v, acc, ai, m);
                { const float sc = (slot >= 8 && slot < 16) ? 0.08838834764831845f * inscale : inscale;
#pragma unroll
                    for (int i = 0; i < 16; ++i) v[i] *= sc; }
                if (slot >= 32) {
#pragma unroll
                    for (int i = 0; i < 16; ++i) v[i] = fsigmoid(v[i]) * 256.f;
                    *(uint4*)((unsigned char*)(proj + (size_t)row * 3072 + 2048) + (L0 - 2048)) = make_uint4(pk4_fp8(v[0], v[1], v[2], v[3]), pk4_fp8(v[4], v[5], v[6], v[7]), pk4_fp8(v[8], v[9], v[10], v[11]), pk4_fp8(v[12], v[13], v[14], v[15])); }
                else store16_bf16(proj + (size_t)row * 3072 + L0, v); }
    } };
struct OneUnit { int pm; __device__ bool next(int i, ge::Unit& u) const { if (i) return false; u.pm = pm; u.pn = 0; u.bt = 0; u.aux = 0; return true; } };
struct EpiCmpPart { float* part;
    __device__ __forceinline__ void operator()(const f32x4 (&acc)[2][2][4][2], const ge::Unit& u, int wr, int wc, int fr, int fq) const {
        const int L0 = (4 * u.pn + wc) * 64 + 16 * fq;
#pragma unroll
        for (int ai = 0; ai < 2; ++ai)
#pragma unroll
            for (int m = 0; m < 4; ++m) { const int row = u.pm * 256 + ai * 128 + wr * 64 + m * 16 + fr; float v[16]; GE_VALS(v, acc, ai, m); store16_bf16((bf16_t*)part + (size_t)row * 256 + L0, v); }
    } };
struct EpiCmp1 { const float* cb1; bf16_t* hid;
    __device__ __forceinline__ void operator()(const f32x4 (&acc)[2][2][4][2], const ge::Unit& u, int wr, int wc, int fr, int fq) const {
        const int L0 = (4 * u.pn + wc) * 64 + 16 * fq; float bv[16];
#pragma unroll
        for (int i = 0; i < 16; ++i) bv[i] = cb1[L0 + i];
#pragma unroll
        for (int ai = 0; ai < 2; ++ai)
#pragma unroll
            for (int m = 0; m < 4; ++m) { const int row = u.pm * 256 + ai * 128 + wr * 64 + m * 16 + fr; float v[16]; GE_VALS(v, acc, ai, m);
#pragma unroll
                for (int i = 0; i < 16; ++i) { const float x = v[i] + bv[i]; v[i] = 0.5f * x * (1.f + ftanh(0.7978845608028654f * (x + 0.044715f * x * x * x))); }
                store16_bf16(hid + (size_t)row * 256 + L0, v); }
    } };

#define PARAM_LIST(X) \
    X(const float*, x) X(const float*, c) X(const float*, ada_w) X(const float*, ada_b) X(const float*, g_mix) X(const float*, g_ffn) X(const float*, nsa_w_in) X(const float*, nsa_w_out) \
    X(const float*, q_gain) X(const float*, k_gain) X(const float*, cmp_pe) X(const float*, cmp_w1) X(const float*, cmp_b1) X(const float*, cmp_w2) X(const float*, cmp_b2) \
    X(const float*, ml_w_in) X(const float*, ml_bi) X(const float*, ml_bf) X(const float*, ml_ng) X(const float*, ml_w_out) X(const float*, router_w) X(const float*, router_b) \
    X(const float*, w_gate) X(const float*, w_up) X(const float*, w_down) \
    X(float*, out) X(unsigned*, bar) X(int*, cnt) X(float*, mod) X(float*, rope) X(float*, cb1) X(float*, tokw) X(int*, list) X(float*, li) X(float*, lf) \
    X(bf16_t*, h) X(bf16_t*, hidc) X(bf16_t*, xb13) X(bf16_t*, xb2) X(bf16_t*, wo_nsa_t) X(bf16_t*, wo_ml_t) X(bf16_t*, win_nsa_t) X(bf16_t*, win_ml_t) X(bf16_t*, w1c_t) X(bf16_t*, gu_t) X(bf16_t*, dn_t) \
    X(bf16_t*, q) X(bf16_t*, kv) X(float*, gates) X(bf16_t*, kcmp) X(bf16_t*, vcmp) X(bf16_t*, proj) X(bf16_t*, hid) X(bf16_t*, outk) X(int*, dcnt) X(int*, dlist) X(float*, cpart)
struct Params {
#define X(t, n) t n;
    PARAM_LIST(X)
#undef X
};
template <class Tp> __device__ __forceinline__ Tp* uni_ptr(Tp* v) { const unsigned long long u = (unsigned long long)v; const unsigned lo = __builtin_amdgcn_readfirstlane((unsigned)u), hi = __builtin_amdgcn_readfirstlane((unsigned)(u >> 32)); typedef Tp __attribute__((address_space(1))) * GP; return (Tp*)(GP)(((unsigned long long)hi << 32) | lo); }
#define LP(n) q.n = uni_ptr(P->n)
struct Frame { LAS unsigned char* lds; int tid, lane, wave, bid, G; };
__device__ __forceinline__ int lane_id_asm() { int l; asm volatile("v_mbcnt_lo_u32_b32 %0, -1, 0\n\tv_mbcnt_hi_u32_b32 %0, -1, %0" : "=v"(l)); return l; }
__device__ __forceinline__ Frame launder(const Frame& F) { Frame R = F; const int l = lane_id_asm(); int wv = F.wave, bd = F.bid; asm volatile("" : "+s"(wv), "+s"(bd)); R.wave = wv; R.bid = bd; R.tid = wv * 64 + l; R.lane = l; return R; }
constexpr int LDS_GEN = 143872;
constexpr int LDS_MISC = LDS_GEN;
constexpr int LDS_PARAMS = LDS_GEN + 4096;
constexpr int LDS_CONST = LDS_GEN + 6144;
constexpr int LDS_BYTES = LDS_GEN + 18432;

constexpr float F8_SA = 8.f, F8_SW = 32.f, F8_SH = 4.f, F8_SW2 = 32.f, F8_SO = 16.f;
__device__ __forceinline__ float fp8f(unsigned w, int i) { return i == 0 ? __builtin_amdgcn_cvt_f32_fp8((int)w, 0) : i == 1 ? __builtin_amdgcn_cvt_f32_fp8((int)w, 1) : i == 2 ? __builtin_amdgcn_cvt_f32_fp8((int)w, 2) : __builtin_amdgcn_cvt_f32_fp8((int)w, 3); }
template <int NB>
__device__ __forceinline__ void colgemv(const Frame& F, const LAS float* vec, LAS float* part, const float* W, int ldw, int K, int n0, const float* bias, float* out, int out_stride) {
    const int kper = K / 8, kb = F.wave * kper, c4 = F.lane & 15, kq = F.lane >> 4; float acc[NB][4];
#pragma unroll
    for (int b = 0; b < NB; ++b)
#pragma unroll
        for (int j = 0; j < 4; ++j) acc[b][j] = 0.f;
    const float* wp = W + (size_t)(kb + kq) * ldw + n0 + 4 * c4;
#pragma unroll 4
    for (int k = 0; k < kper; k += 4) { const float4 wv = *(const float4*)(wp + (size_t)k * ldw);
#pragma unroll
        for (int b = 0; b < NB; ++b) { const float x = vec[(kb + k + kq) * NB + b]; acc[b][0] += x * wv.x; acc[b][1] += x * wv.y; acc[b][2] += x * wv.z; acc[b][3] += x * wv.w; } }
#pragma unroll
    for (int b = 0; b < NB; ++b)
#pragma unroll
        for (int j = 0; j < 4; ++j) { const float t = sum32(sum16(acc[b][j])); if (kq == 0) part[(F.wave * NB + b) * 64 + 4 * c4 + j] = t; }
    __syncthreads();
    for (int idx = F.tid; idx < NB * 64; idx += NTHR) { const int b = idx >> 6, l = idx & 63; float s = bias[n0 + l];
#pragma unroll
        for (int w = 0; w < 8; ++w) s += part[(w * NB + b) * 64 + l];
        out[(size_t)b * out_stride + n0 + l] = s; }
    __syncthreads();
}
struct ColPlain { const float* W; int ncols; int pad; __device__ const float* operator()(int c) const { const int L = ge::logical_col(c); return L < ncols ? W + L : nullptr; } };
struct ColGateUp { const float* wg; const float* wu; __device__ const float* operator()(int c) const { const int e = c >> 10, cc = c & 1023; const int pn = cc >> 8, bj = (cc >> 7) & 1, wc = (cc >> 5) & 3, n = (cc >> 4) & 1, fq = (cc >> 2) & 3, j = cc & 3;
        const int hidx = 32 * (4 * pn + wc) + 8 * fq + 4 * n + j; const unsigned long long a = (unsigned long long)wg, d = (unsigned long long)wu - a;
        return (const float*)(a + (bj ? d : 0ull)) + (size_t)e * D * DE + hidx; } };
struct ColDown { const float* wd; __device__ const float* operator()(int c) const { const int e = c >> 10; return wd + (size_t)e * DE * D + ge::logical_col(c & 1023); } };
template <bool F8 = false, class ColF>
__device__ __forceinline__ void prep_weights(const Frame& F, void* Bt_, int N, int K, int ldw, const ColF cf, int start, int stride, const float wscale = 1.f) {
    bf16_t* Bt = (bf16_t*)Bt_;
    LAS float* tile = (LAS float*)(F.lds) + (F.tid >> 8) * (128 * 65);
    const int ntx = N / 64, ntiles = ntx * (K / 128), htid = F.tid & 255, half = F.tid >> 8;
    float r[32];
#define PW_LOAD(it_) do { const int tl_ = (it_) * 2 + half; if (tl_ < ntiles) { const int c0_ = (tl_ % ntx) * 64, k0_ = (tl_ / ntx) * 128; const float* p_ = cf(c0_ + (htid & 63)); \
        if (p_) { p_ += (size_t)(k0_ + (htid >> 6)) * ldw; _Pragma("unroll") for (int i_ = 0; i_ < 32; ++i_) r[i_] = p_[(size_t)(4 * i_) * ldw]; } \
        else { _Pragma("unroll") for (int i_ = 0; i_ < 32; ++i_) r[i_] = 0.f; } } } while (0)
    int it = start;
    if (it * 2 < ntiles) PW_LOAD(it);
    for (; it * 2 < ntiles; it += stride) {
        const int tl = it * 2 + half; const bool act = tl < ntiles; const int c0 = (tl % ntx) * 64, k0 = (tl / ntx) * 128;
        if (act) { const int cc = htid & 63;
#pragma unroll
            for (int i = 0; i < 32; ++i) tile[((htid >> 6) + 4 * i) * 65 + cc] = r[i]; }
        __syncthreads();
        if ((it + stride) * 2 < ntiles) PW_LOAD(it + stride);
        if (act) { const int cc = htid >> 2, ch = (htid & 3) * 32;
            if (F8) { unsigned w[8];
#pragma unroll
                for (int i = 0; i < 8; ++i) w[i] = pk4_fp8(tile[(ch + 4 * i) * 65 + cc] * wscale, tile[(ch + 4 * i + 1) * 65 + cc] * wscale, tile[(ch + 4 * i + 2) * 65 + cc] * wscale, tile[(ch + 4 * i + 3) * 65 + cc] * wscale);
                uint4* dst = (uint4*)((unsigned char*)Bt_ + (size_t)(c0 + cc) * K + k0 + ch); dst[0] = make_uint4(w[0], w[1], w[2], w[3]); dst[1] = make_uint4(w[4], w[5], w[6], w[7]); }
            else { unsigned w[16];
#pragma unroll
                for (int i = 0; i < 16; ++i) w[i] = pk2g(tile[(ch + 2 * i) * 65 + cc], tile[(ch + 2 * i + 1) * 65 + cc]);
                uint4* dst = (uint4*)(Bt + (size_t)(c0 + cc) * K + k0 + ch);
#pragma unroll
                for (int q4 = 0; q4 < 4; ++q4) dst[q4] = make_uint4(w[4 * q4], w[4 * q4 + 1], w[4 * q4 + 2], w[4 * q4 + 3]); } }
        __syncthreads();
    }
#undef PW_LOAD
}
__device__ __forceinline__ void prep_moe_weights(const Params& p, const Frame& F, int layer, int start, int stride) {
    const size_t wo = (size_t)layer * NE * D * DE;
    prep_weights<true>(F, p.gu_t, NE * 1024, D, DE, ColGateUp{p.w_gate + wo, p.w_up + wo}, start, stride, F8_SW);
    prep_weights<true>(F, p.dn_t, NE * 1024, DE, D, ColDown{p.w_down + wo}, start, stride, F8_SW2);
}

__device__ __forceinline__ void phase_prologue_a(const Params& p, const Frame& F) {
    for (int i = (F.bid - 200) * NTHR + F.tid; F.bid >= 200 && i < 2048 * 8; i += (F.G - 200) * NTHR) { const int pos = i >> 3, j = i & 7; const float inv = (float)pow(500000.0, -(double)j / 8.0); const float ang = (float)pos * inv;
        p.rope[pos * 16 + j] = (float)cos((double)ang); p.rope[pos * 16 + 8 + j] = (float)sin((double)ang); }
    if (F.bid == F.G - 1) for (int i = F.tid; i < 8 * D / 2; i += NTHR) ((unsigned*)(p.h + (size_t)T * D))[i] = 0u;
}
__device__ __forceinline__ void phase_prologue_b(const Params& p, const Frame& F) {
    LAS float* vec = (LAS float*)F.lds; LAS float* part = (LAS float*)(F.lds + 65536 + 16384);
    if (F.bid < 192) {
        for (int idx = F.tid; idx < 16 * D; idx += NTHR) { const int b = idx >> 10, k = idx & 1023; const float cv = p.c[idx]; vec[k * 16 + b] = cv / (1.f + expf(-cv)); }
        __syncthreads();
        const int i = F.bid / 96, n0 = (F.bid % 96) * 64;
        colgemv<16>(F, vec, part, p.ada_w + (size_t)i * D * 6144, 6144, D, n0, p.ada_b + i * 6144, p.mod + (size_t)i * 16 * 6144, 6144);
    } else if (F.bid < 200) {
        const int it = F.bid - 192, w = it >> 2, n0 = (it & 3) * 64;
        for (int idx = F.tid; idx < 2048; idx += NTHR) vec[idx] = p.cmp_pe[w * 2048 + idx];
        __syncthreads();
        colgemv<1>(F, vec, part, p.cmp_w1 + (size_t)w * 2048 * 256, 256, 2048, n0, p.cmp_b1 + w * 256, p.cb1 + w * 256, 0);
    }
    __syncthreads();
}

template <int MODE, bool XBF>
__device__ __forceinline__ void phase_norm(const Params& p, const Frame& F, const void* xin_, bf16_t* xout, const float* gain, const float* mod_sh, const float* mod_sc, const float* mod_gprev, int layer) {
    constexpr int rows_per_wg = T / NWG, rpw = rows_per_wg / 8;
    constexpr int TP = (MODE == 1) ? 34 : 10;
    const int row0 = F.bid * rows_per_wg;
    LAS float* rw = (LAS float*)F.lds;
    LAS int* lcnt = (LAS int*)(F.lds + LDS_MISC + 64); LAS int* gbase = lcnt + 32; LAS int* ent = gbase + 32;
    if (MODE == 1) { for (int idx = F.tid; idx < D * NE; idx += NTHR) { const int c = idx >> 5; rw[((c & 3) * 256 + (c >> 2)) * TP + (idx & 31)] = p.router_w[idx]; } if (F.tid < 32) lcnt[F.tid] = 0; }
    if (MODE == 2) { for (int idx = F.tid; idx < D * 8; idx += NTHR) { const int c = idx >> 3; rw[((c & 3) * 256 + (c >> 2)) * TP + (idx & 7)] = p.ml_w_in[(size_t)c * ML_COLS + 3072 + (idx & 7)]; } }
    const int b = row0 / S;
    LAS float* cg = (LAS float*)(F.lds + LDS_CONST); LAS float* csh = cg + D; LAS float* cgp = csh + D;
    for (int col = F.tid; col < D; col += NTHR) { cg[col] = gain[col] * (1.f + mod_sc[b * 6144 + col]); csh[col] = mod_sh[b * 6144 + col]; if (MODE == 2) cgp[col] = mod_gprev[b * 6144 + col] * (1.f / F8_SO); }
    __syncthreads();
    const int rbase = row0 + F.wave * rpw;
    float4 xn[4]; unsigned on0[4], on1[4];
#define NORM_LOAD(r_) do { if (XBF) { const bf16_t* xr_ = (const bf16_t*)xin_ + (size_t)(r_) * D + 4 * F.lane; _Pragma("unroll") for (int j_ = 0; j_ < 4; ++j_) { const uint2 t_ = *(const uint2*)(xr_ + 256 * j_); \
            xn[j_] = make_float4(__uint_as_float(t_.x << 16), __uint_as_float(t_.x & 0xFFFF0000u), __uint_as_float(t_.y << 16), __uint_as_float(t_.y & 0xFFFF0000u)); } } \
        else { const float* xr_ = (const float*)xin_ + (size_t)(r_) * D + 4 * F.lane; _Pragma("unroll") for (int j_ = 0; j_ < 4; ++j_) xn[j_] = *(const float4*)(xr_ + 256 * j_); } \
        if (MODE == 2) { const unsigned char* o0_ = (const unsigned char*)p.outk + (size_t)(r_) * D + 4 * F.lane; _Pragma("unroll") for (int j_ = 0; j_ < 4; ++j_) { on0[j_] = *(const unsigned*)(o0_ + 256 * j_); on1[j_] = *(const unsigned*)(o0_ + (size_t)T * D + 256 * j_); } } } while (0)
    NORM_LOAD(rbase);
#pragma unroll 1
    for (int ri = 0; ri < rpw; ++ri) {
        const int row = rbase + ri; float v[16];
#pragma unroll
        for (int j = 0; j < 4; ++j) { v[4 * j] = xn[j].x; v[4 * j + 1] = xn[j].y; v[4 * j + 2] = xn[j].z; v[4 * j + 3] = xn[j].w; }
        if (MODE == 2) {
#pragma unroll
            for (int j = 0; j < 4; ++j) { const f32x4 gq = *(const LAS f32x4*)(cgp + 4 * F.lane + 256 * j);
                v[4 * j] += gq[0] * (fp8f(on0[j], 0) + fp8f(on1[j], 0)); v[4 * j + 1] += gq[1] * (fp8f(on0[j], 1) + fp8f(on1[j], 1));
                v[4 * j + 2] += gq[2] * (fp8f(on0[j], 2) + fp8f(on1[j], 2)); v[4 * j + 3] += gq[3] * (fp8f(on0[j], 3) + fp8f(on1[j], 3));
                uint2 xo_; xo_.x = pk2g(v[4 * j], v[4 * j + 1]); xo_.y = pk2g(v[4 * j + 2], v[4 * j + 3]); *(uint2*)(xout + (size_t)row * D + 4 * F.lane + 256 * j) = xo_; } }
        if (ri + 1 < rpw) NORM_LOAD(row + 1);
        float ss = 0.f;
#pragma unroll
        for (int i = 0; i < 16; ++i) ss += v[i] * v[i];
        ss = wave_sum(ss); const float r = rsqrtf(ss * (1.f / D) + 1e-6f);
#pragma unroll
        for (int j = 0; j < 4; ++j) { const f32x4 g4 = *(const LAS f32x4*)(cg + 4 * F.lane + 256 * j), s4 = *(const LAS f32x4*)(csh + 4 * F.lane + 256 * j);
#pragma unroll
            for (int e = 0; e < 4; ++e) v[4 * j + e] = v[4 * j + e] * r * g4[e] + s4[e];
            if (MODE == 2 || MODE == 0) *(unsigned*)((unsigned char*)p.h + (size_t)row * D + 4 * F.lane + 256 * j) = pk4_fp8(v[4 * j] * F8_SA, v[4 * j + 1] * F8_SA, v[4 * j + 2] * F8_SA, v[4 * j + 3] * F8_SA);
            else { uint2 pk; pk.x = pk2g(v[4 * j], v[4 * j + 1]); pk.y = pk2g(v[4 * j + 2], v[4 * j + 3]); *(uint2*)(p.h + (size_t)row * D + 4 * F.lane + 256 * j) = pk; } }
        if (MODE == 2) { float a8[8];
#pragma unroll
            for (int j = 0; j < 8; ++j) a8[j] = 0.f;
#pragma unroll
            for (int j = 0; j < 4; ++j)
#pragma unroll
                for (int e = 0; e < 4; ++e) { const LAS float* wr_ = rw + (e * 256 + 64 * j + F.lane) * TP; const float hv = v[4 * j + e];
#pragma unroll
                    for (int q2 = 0; q2 < 4; ++q2) { const f32x2_t w2 = *(const LAS f32x2_t*)(wr_ + 2 * q2); a8[2 * q2] += hv * w2[0]; a8[2 * q2 + 1] += hv * w2[1]; } }
#pragma unroll
            for (int j = 0; j < 8; ++j) a8[j] = wave_sum(a8[j]);
            if (F.lane < 8) { float a = 0.f;
#pragma unroll
                for (int j = 0; j < 8; ++j) a = (F.lane == j) ? a8[j] : a;
                if (F.lane < 4) { a += p.ml_bi[F.lane]; p.li[row * 4 + F.lane] = 15.f * tanhf(a / 15.f); }
                else { a += p.ml_bf[F.lane - 4]; const float cc = 15.f * tanhf(a / 15.f); p.lf[row * 4 + F.lane - 4] = (cc >= 0.f) ? -log1pf(expf(-cc)) : (cc - log1pf(expf(cc))); } } }
        if (MODE == 1) { float acc[32];
#pragma unroll
            for (int e = 0; e < 32; ++e) acc[e] = 0.f;
#pragma unroll
            for (int j = 0; j < 4; ++j)
#pragma unroll
                for (int e = 0; e < 4; ++e) { const LAS float* wr_ = rw + (e * 256 + 64 * j + F.lane) * TP; const float hv = v[4 * j + e]; asm volatile("" ::: "memory");
#pragma unroll
                    for (int q2 = 0; q2 < 16; ++q2) { const f32x2_t w2 = *(const LAS f32x2_t*)(wr_ + 2 * q2); acc[2 * q2] += hv * w2[0]; acc[2 * q2 + 1] += hv * w2[1]; } }
            float r16[16], r8[8], r4[4], r2[2], r1;
            { const bool hi = (F.lane & 32) != 0;
#pragma unroll
              for (int i = 0; i < 16; ++i) { const float keep = hi ? acc[16 + i] : acc[i], send = hi ? acc[i] : acc[16 + i]; r16[i] = keep + other32(send, hi); } }
            { const bool hi = (F.lane & 16) != 0;
#pragma unroll
              for (int i = 0; i < 8; ++i) { const float keep = hi ? r16[8 + i] : r16[i], send = hi ? r16[i] : r16[8 + i]; r8[i] = keep + sx<16>(send); } }
            { const bool hi = (F.lane & 8) != 0;
#pragma unroll
              for (int i = 0; i < 4; ++i) { const float keep = hi ? r8[4 + i] : r8[i], send = hi ? r8[i] : r8[4 + i]; r4[i] = keep + sx<8>(send); } }
            { const bool hi = (F.lane & 4) != 0;
#pragma unroll
              for (int i = 0; i < 2; ++i) { const float keep = hi ? r4[2 + i] : r4[i], send = hi ? r4[i] : r4[2 + i]; r2[i] = keep + sx<4>(send); } }
            { const bool hi = (F.lane & 2) != 0; const float keep = hi ? r2[1] : r2[0], send = hi ? r2[0] : r2[1]; r1 = keep + sx<2>(send); }
            r1 += sx<1>(r1);
            const float aff = sigmoidf_(r1); const float ch = aff + p.router_b[F.lane >> 1];
            float bestgs = -3e38f; int be0 = 0, be1 = 0; float ba0 = 0.f, ba1 = 0.f;
#pragma unroll
            for (int g = 0; g < 4; ++g) { float v1 = -3e38f, v2 = -3e38f, a1 = 0.f, a2 = 0.f; int i1 = 0, i2 = 0;
#pragma unroll
                for (int i = 0; i < 8; ++i) { const float a = rdlane(aff, 2 * (g * 8 + i)), c_ = rdlane(ch, 2 * (g * 8 + i));
                    if (c_ > v1) { v2 = v1; a2 = a1; i2 = i1; v1 = c_; a1 = a; i1 = i; } else if (c_ > v2) { v2 = c_; a2 = a; i2 = i; } }
                const float gs = v1 + v2; if (gs > bestgs) { bestgs = gs; be0 = g * 8 + i1; be1 = g * 8 + i2; ba0 = a1; ba1 = a2; } }
            if (F.lane == 0) { const float sum = ba0 + ba1; p.tokw[row * 2] = ba0 / sum; p.tokw[row * 2 + 1] = ba1 / sum;
                const int lr = row - row0; const int r0_ = atomicAdd((int*)&lcnt[be0], 1); const int r1_ = atomicAdd((int*)&lcnt[be1], 1);
                ent[lr * 4 + 0] = be0 | (r0_ << 8); ent[lr * 4 + 1] = row * 2; ent[lr * 4 + 2] = be1 | (r1_ << 8); ent[lr * 4 + 3] = row * 2 + 1; } }
    }
#undef NORM_LOAD
    if (MODE == 1) { __syncthreads();
        if (F.tid < 32) gbase[F.tid] = atomicAdd(&p.cnt[layer * 64 + F.tid], lcnt[F.tid]);
        __syncthreads();
        for (int idx = F.tid; idx < rows_per_wg * 2; idx += NTHR) { const int er = ent[idx * 2], tk = ent[idx * 2 + 1]; const int e = er & 255, rk = er >> 8; p.list[(size_t)e * T + gbase[e] + rk] = tk; }
        __syncthreads(); }
}

__device__ __forceinline__ void phase_norm_route(const Params& p, const Frame& F, const bf16_t* xin, const float* gain, const float* mod_sh, const float* mod_sc, int layer) {
    constexpr int rows_per_wg = T / NWG;
    const int row0 = F.bid * rows_per_wg, b = row0 / S, lane = F.lane, i16 = lane & 15, g = lane >> 4;
    constexpr int RTP = 2064;
    LAS unsigned char* thi = F.lds; LAS unsigned char* tlo = F.lds + 32 * RTP;
    LAS float* cg = (LAS float*)(F.lds + LDS_CONST); LAS float* csh = cg + D; LAS float* bias = csh + D; LAS float* bpart = bias + 32;
    LAS int* lcnt = (LAS int*)(F.lds + LDS_MISC + 64); LAS int* gbase = lcnt + 32; LAS int* ent = gbase + 32;
    for (int col = F.tid; col < D; col += NTHR) { cg[col] = gain[col] * (1.f + mod_sc[b * 6144 + col]); csh[col] = mod_sh[b * 6144 + col]; }
    if (F.tid < 32) lcnt[F.tid] = 0;
    __syncthreads();
    { const int e = F.tid & 31, part = F.tid >> 5; float a = 0.f;
#pragma unroll 8
      for (int k = part * 64; k < part * 64 + 64; k += 2) { const float w0 = p.router_w[k * 32 + e], w1 = p.router_w[(k + 1) * 32 + e];
          a += csh[k] * w0 + csh[k + 1] * w1;
          const float s0 = w0 * cg[k] * 256.f, s1 = w1 * cg[k + 1] * 256.f; const _Float16 h0 = (_Float16)s0, h1 = (_Float16)s1; const _Float16 l0 = (_Float16)(s0 - (float)h0), l1 = (_Float16)(s1 - (float)h1);
          *(LAS unsigned*)(thi + e * RTP + k * 2) = (unsigned)__builtin_bit_cast(unsigned short, h0) | ((unsigned)__builtin_bit_cast(unsigned short, h1) << 16);
          *(LAS unsigned*)(tlo + e * RTP + k * 2) = (unsigned)__builtin_bit_cast(unsigned short, l0) | ((unsigned)__builtin_bit_cast(unsigned short, l1) << 16); }
      bpart[part * 32 + e] = a; }
    __syncthreads();
    if (F.tid < 32) { float a = 0.f;
#pragma unroll
        for (int q = 0; q < 16; ++q) a += bpart[q * 32 + F.tid];
        bias[F.tid] = a; }
    const int rbase = row0 + F.wave * 16;
    const bf16_t* xr = xin + (size_t)(rbase + i16) * D + 8 * g;
    typedef _Float16 f16x8 __attribute__((ext_vector_type(8))); typedef unsigned u32x4r __attribute__((ext_vector_type(4)));
    const LAS unsigned char* bh0 = thi + i16 * RTP + 16 * g; const LAS unsigned char* bh1 = bh0 + 16 * RTP; const LAS unsigned char* bl0 = tlo + i16 * RTP + 16 * g; const LAS unsigned char* bl1 = bl0 + 16 * RTP;
    f32x4 acc0 = (f32x4){0.f, 0.f, 0.f, 0.f}, acc1 = (f32x4){0.f, 0.f, 0.f, 0.f}; float ss = 0.f;
    uint4 xa[2][8];
#define RT_LOAD(s_, q_) do { _Pragma("unroll") for (int u_ = 0; u_ < 8; ++u_) xa[s_][u_] = *(const uint4*)(xr + 32 * (8 * (q_) + u_)); } while (0)
    RT_LOAD(0, 0);
#pragma unroll
    for (int qd = 0; qd < 4; ++qd) {
        if (qd + 1 < 4) RT_LOAD((qd + 1) & 1, qd + 1);
#pragma unroll
        for (int u = 0; u < 8; ++u) { const int so = (8 * qd + u) * 64;
            const uint4 xc = xa[qd & 1][u]; const unsigned xw[4] = {xc.x, xc.y, xc.z, xc.w}; u32x4r ap;
#pragma unroll
            for (int i = 0; i < 4; ++i) { const float f0 = __uint_as_float(xw[i] << 16), f1 = __uint_as_float(xw[i] & 0xFFFF0000u); ss += f0 * f0 + f1 * f1; ap[i] = __builtin_bit_cast(unsigned, __builtin_amdgcn_cvt_pkrtz(f0, f1)); }
            const f16x8 a8 = __builtin_bit_cast(f16x8, ap);
            const f16x8 b0h = *(const LAS f16x8*)(bh0 + so), b0l = *(const LAS f16x8*)(bl0 + so), b1h = *(const LAS f16x8*)(bh1 + so), b1l = *(const LAS f16x8*)(bl1 + so);
            acc0 = __builtin_amdgcn_mfma_f32_16x16x32_f16(a8, b0h, acc0, 0, 0, 0); acc1 = __builtin_amdgcn_mfma_f32_16x16x32_f16(a8, b1h, acc1, 0, 0, 0);
            acc0 = __builtin_amdgcn_mfma_f32_16x16x32_f16(a8, b0l, acc0, 0, 0, 0); acc1 = __builtin_amdgcn_mfma_f32_16x16x32_f16(a8, b1l, acc1, 0, 0, 0); }
    }
#undef RT_LOAD
    ss = sum16(ss); ss = sum32(ss); const float r = rsqrtf(ss * (1.f / D) + 1e-6f);
    float af0[4], af1[4];
#pragma unroll
    for (int rr = 0; rr < 4; ++rr) { const float rrow = __int_as_float(__builtin_amdgcn_ds_bpermute((4 * g + rr) * 4, __float_as_int(r)));
        af0[rr] = sigmoidf_(rrow * (1.f / 256.f) * acc0[rr] + bias[i16]); af1[rr] = sigmoidf_(rrow * (1.f / 256.f) * acc1[rr] + bias[16 + i16]); }
    __syncthreads();
    LAS float* affl = (LAS float*)F.lds + F.wave * 512;
#pragma unroll
    for (int rr = 0; rr < 4; ++rr) { affl[(4 * g + rr) * 32 + i16] = af0[rr]; affl[(4 * g + rr) * 32 + 16 + i16] = af1[rr]; }
    asm volatile("s_waitcnt lgkmcnt(0)" ::: "memory");
    if (lane < 16) { const int row = rbase + lane; const LAS float* ar = affl + lane * 32;
        float bestgs = -3e38f; int be0 = 0, be1 = 0; float ba0 = 0.f, ba1 = 0.f;
#pragma unroll
        for (int gg = 0; gg < 4; ++gg) { float v1 = -3e38f, v2 = -3e38f, a1 = 0.f, a2 = 0.f; int i1 = 0, i2 = 0;
#pragma unroll
            for (int i = 0; i < 8; ++i) { const float a = ar[gg * 8 + i], c_ = a + p.router_b[gg * 8 + i];
                if (c_ > v1) { v2 = v1; a2 = a1; i2 = i1; v1 = c_; a1 = a; i1 = i; } else if (c_ > v2) { v2 = c_; a2 = a; i2 = i; } }
            const float gs = v1 + v2; if (gs > bestgs) { bestgs = gs; be0 = gg * 8 + i1; be1 = gg * 8 + i2; ba0 = a1; ba1 = a2; } }
        const float sum = ba0 + ba1; p.tokw[row * 2] = ba0 / sum; p.tokw[row * 2 + 1] = ba1 / sum;
        const int lr = row - row0; const int r0_ = atomicAdd((int*)&lcnt[be0], 1); const int r1_ = atomicAdd((int*)&lcnt[be1], 1);
        ent[lr * 4 + 0] = be0 | (r0_ << 8); ent[lr * 4 + 1] = row * 2; ent[lr * 4 + 2] = be1 | (r1_ << 8); ent[lr * 4 + 3] = row * 2 + 1; }
    { uint2 xq[2][4][4];
#define NR_LOAD(s_, r_) do { _Pragma("unroll") for (int k_ = 0; k_ < 4; ++k_) { const bf16_t* xq_ = xin + (size_t)((r_) + k_) * D + 4 * lane; _Pragma("unroll") for (int j_ = 0; j_ < 4; ++j_) xq[s_][k_][j_] = *(const uint2*)(xq_ + 256 * j_); } } while (0)
      NR_LOAD(0, rbase);
#pragma unroll
      for (int g4 = 0; g4 < 4; ++g4) {
          if (g4 + 1 < 4) NR_LOAD((g4 + 1) & 1, rbase + 4 * (g4 + 1));
#pragma unroll
          for (int k = 0; k < 4; ++k) { const int row = rbase + 4 * g4 + k; const float rr_ = rdlane(r, 4 * g4 + k);
#pragma unroll
              for (int j = 0; j < 4; ++j) { const f32x4 g4v = *(const LAS f32x4*)(cg + 4 * lane + 256 * j), s4_ = *(const LAS f32x4*)(csh + 4 * lane + 256 * j); const uint2 xc = xq[g4 & 1][k][j];
                  const float x0 = __uint_as_float(xc.x << 16), x1 = __uint_as_float(xc.x & 0xFFFF0000u), x2 = __uint_as_float(xc.y << 16), x3 = __uint_as_float(xc.y & 0xFFFF0000u);
                  *(unsigned*)((unsigned char*)p.h + (size_t)row * D + 4 * lane + 256 * j) = pk4_fp8((x0 * rr_ * g4v[0] + s4_[0]) * F8_SA, (x1 * rr_ * g4v[1] + s4_[1]) * F8_SA, (x2 * rr_ * g4v[2] + s4_[2]) * F8_SA, (x3 * rr_ * g4v[3] + s4_[3]) * F8_SA); } } }
#undef NR_LOAD
    }
    __syncthreads();
    if (F.tid < 32) gbase[F.tid] = atomicAdd(&p.cnt[layer * 64 + F.tid], lcnt[F.tid]);
    __syncthreads();
    for (int idx = F.tid; idx < rows_per_wg * 2; idx += NTHR) { const int er = ent[idx * 2], tk = ent[idx * 2 + 1]; const int e = er & 255, rk = er >> 8; p.list[(size_t)e * T + gbase[e] + rk] = tk; }
    __syncthreads();
}

struct MoeOrder { const LAS int* tab;
    __device__ bool next(int i, ge::Unit& u) const { if (i >= 8) return false; const int pm = __builtin_amdgcn_readfirstlane(tab[4 * i]); if (pm < 0) return false;
        u.pm = pm; u.pn = __builtin_amdgcn_readfirstlane(tab[4 * i + 1]); u.bt = __builtin_amdgcn_readfirstlane(tab[4 * i + 2]); u.aux = __builtin_amdgcn_readfirstlane(tab[4 * i + 3]); return true; } };
__device__ __forceinline__ void moe_plan(const Frame& F, const int* cnt, const int* list, LAS int* tab, LAS int* tkt  , int npn, const float* tokw = nullptr, LAS float* tkw = nullptr  , const float wscale = 1.f) {
    LAS int* lc = tab + 32;
    __syncthreads();
    if (F.tid < 32) lc[F.tid] = cnt[F.tid];
    __syncthreads();
    if (F.tid < 8) { const int L = F.tid * F.G + F.bid, mt = L / npn, pn = L % npn; int acc = 0, e_f = -1, mi_f = 0;
#pragma unroll 1
        for (int e = 0; e < NE; ++e) { const int nte = (lc[e] + 255) >> 8; if (e_f < 0 && mt < acc + nte) { e_f = e; mi_f = mt - acc; } acc += nte; }
        tab[4 * F.tid] = e_f < 0 ? -1 : mt; tab[4 * F.tid + 1] = pn; tab[4 * F.tid + 2] = e_f * npn + pn; tab[4 * F.tid + 3] = e_f | (mi_f << 8) | (F.tid << 24); }
    __syncthreads();
#pragma unroll
    for (int q = 0; q < 4; ++q) { const int idx = F.tid + NTHR * q, i = idx >> 8, r = idx & 255; int v = -1;
        if (tab[4 * i] >= 0) { const int aux = tab[4 * i + 3], e = aux & 255, ii = ((aux >> 8) & 0xFFFF) * 256 + r; if (ii < lc[e]) v = list[(size_t)e * T + ii]; }
        tkt[idx] = v; if (tkw) tkw[idx] = v >= 0 ? tokw[v] * wscale : 0.f; }
    __syncthreads();
}
struct MoeRows { static constexpr bool dense = false; const LAS int* tkt; __device__ __forceinline__ unsigned operator()(const ge::Unit& u, int r) const { const int tk = tkt[(u.aux >> 24) * 256 + r]; return tk < 0 ? (unsigned)T * (unsigned)(D * 2) : (unsigned)(tk >> 1) * (unsigned)D; } };
struct EpiMoe1 { unsigned char* hid8; float inscale;
    __device__ __forceinline__ void operator()(const f32x4 (&acc)[2][2][4][2], const ge::Unit& u, int wr, int wc, int fr, int fq) const {
        const int h0 = (4 * u.pn + wc) * 32 + 8 * fq;
#pragma unroll
        for (int ai = 0; ai < 2; ++ai)
#pragma unroll
            for (int m = 0; m < 4; ++m) { const int row = u.pm * 256 + ai * 128 + wr * 64 + m * 16 + fr; unsigned w[2];
#pragma unroll
                for (int n = 0; n < 2; ++n) { float r4[4];
#pragma unroll
                    for (int j = 0; j < 4; ++j) { const float g = acc[ai][0][m][n][j] * inscale, uu = acc[ai][1][m][n][j] * inscale; r4[j] = g * fsigmoid(g) * uu * F8_SH; }
                    w[n] = pk4_fp8(r4[0], r4[1], r4[2], r4[3]); }
                *(uint2*)(hid8 + (size_t)row * DE + h0) = make_uint2(w[0], w[1]); }
    } };
struct EpiMoe2 { bf16_t* outk; const LAS int* tkt; const LAS float* tkw;
    __device__ __forceinline__ void operator()(const f32x4 (&acc)[2][2][4][2], const ge::Unit& u, int wr, int wc, int fr, int fq) const {
        const int L0 = (4 * u.pn + wc) * 64 + 16 * fq; const int ub = (u.aux >> 24) * 256 + wr * 64 + fr; int tk[2][4]; float wt[2][4];
#pragma unroll
        for (int ai = 0; ai < 2; ++ai)
#pragma unroll
            for (int m = 0; m < 4; ++m) { tk[ai][m] = tkt[ub + ai * 128 + m * 16]; wt[ai][m] = tkw[ub + ai * 128 + m * 16]; }
#pragma unroll
        for (int ai = 0; ai < 2; ++ai)
#pragma unroll
            for (int m = 0; m < 4; ++m) { const int t_ = tk[ai][m]; if (t_ < 0) continue; const float w = wt[ai][m]; float v[16]; GE_VALS(v, acc, ai, m);
#pragma unroll
                for (int k = 0; k < 16; ++k) v[k] *= w;
                *(uint4*)((unsigned char*)outk + (size_t)(t_ & 1) * T * D + (size_t)(t_ >> 1) * D + L0) = make_uint4(pk4_fp8(v[0], v[1], v[2], v[3]), pk4_fp8(v[4], v[5], v[6], v[7]), pk4_fp8(v[8], v[9], v[10], v[11]), pk4_fp8(v[12], v[13], v[14], v[15])); }
    } };

__device__ __forceinline__ void phase_cmp2(const Params& p, const Frame& F) {
    LAS float* w2l = (LAS float*)F.lds; const int base = F.bid * 8 + F.wave;
#pragma unroll 1
    for (int w = 0; w < 2; ++w) {
        __syncthreads();
        for (int i4 = F.tid; i4 < 256 * 64 / 4; i4 += NTHR) { const float4 t4 = *(const float4*)(p.cmp_w2 + (size_t)w * 256 * 64 + 4 * i4); *(LAS f32x4*)(w2l + 4 * i4) = (f32x4){t4.x, t4.y, t4.z, t4.w}; }
        float hv[2][4];
#pragma unroll
        for (int k = 0; k < 2; ++k) { const int row = (base + (2 * w + k) * 2048) & 4095;
#pragma unroll
            for (int i = 0; i < 4; ++i) { float x = p.cb1[w * 256 + i * 64 + F.lane];
#pragma unroll
                for (int ks = 0; ks < 8; ++ks) x += bf2f(((const bf16_t*)p.cpart)[((size_t)(w * 8 + ks) * 4096 + row) * 256 + i * 64 + F.lane]);
                hv[k][i] = 0.5f * x * (1.f + ftanh(0.7978845608028654f * (x + 0.044715f * x * x * x))); } }
        __syncthreads();
        float acc0 = p.cmp_b2[w * 64 + F.lane], acc1 = acc0;
#pragma unroll
        for (int i = 0; i < 4; ++i)
#pragma unroll 8
            for (int l = 0; l < 64; ++l) { const float wv = w2l[(i * 64 + l) * 64 + F.lane]; acc0 += rdlane(hv[0][i], l) * wv; acc1 += rdlane(hv[1][i], l) * wv; }
#pragma unroll
        for (int k = 0; k < 2; ++k) { const int row = (base + (2 * w + k) * 2048) & 4095, c = row & 127; float v = k ? acc1 : acc0;
            if (w == 0) { const float ss = wave_sum(v * v); v = v * rsqrtf(ss * (1.f / 64.f) + 1e-6f) * p.k_gain[F.lane]; int pos = c * 16 + 31; if (pos > 2047) pos = 2047;
                const float other = sx<8>(v); if (F.lane < 16) { const int j = F.lane & 7; const float cs = p.rope[pos * 16 + j], sn = p.rope[pos * 16 + 8 + j]; v = (F.lane < 8) ? (v * cs - other * sn) : (v * cs + other * sn); } }
            if (c == 127) v = 0.f;
            (w == 0 ? p.kcmp : p.vcmp)[(size_t)row * 64 + F.lane] = f2bf(v); }
    }
}

typedef float f32x16 __attribute__((ext_vector_type(16)));
typedef short s16x4 __attribute__((ext_vector_type(4)));
namespace at {
constexpr int KP = 144, VP = 192;
constexpr int KBUF = 64 * KP, VBUF = 64 * VP;
constexpr int OFF_K0 = 0, OFF_K1 = KBUF, OFF_V0 = 4 * KBUF, OFF_V1 = 4 * KBUF + VBUF, OFF_IMP = 4 * KBUF + 4 * VBUF;
constexpr int IMP_PITCH = 33, OFF_SEL = OFF_IMP + 8 * 32 * IMP_PITCH * 4;
constexpr float SC = 0.125f * 1.4426950408889634f;
constexpr float NEG = -1e30f, THR = 8.0f;
__device__ __forceinline__ unsigned pk2(float a, float b) { typedef float f2 __attribute__((ext_vector_type(2))); typedef __bf16 b2 __attribute__((ext_vector_type(2))); b2 r = __builtin_convertvector((f2){a, b}, b2); return __builtin_bit_cast(unsigned, r); }
template <int OFF> __device__ __forceinline__ s16x4 tr_read(unsigned addr) { s16x4 r; asm volatile("ds_read_b64_tr_b16 %0, %1 offset:%2" : "=&v"(r) : "v"(addr), "i"(OFF) : "memory"); return r; }
struct St { f32x16 o[2]; float m, l; };

__device__ __forceinline__ void qk_tile(const LAS unsigned char* kb, int r32, int hi, const bf16x8 (&qf)[4], f32x16& s0, f32x16& s1) {
#pragma unroll
    for (int e = 0; e < 16; ++e) { s0[e] = 0.f; s1[e] = 0.f; }
#pragma unroll
    for (int ks = 0; ks < 4; ++ks) {
        const bf16x8 a0 = *(const LAS bf16x8*)(kb + r32 * KP + (16 * ks + 8 * hi) * 2);
        const bf16x8 a1 = *(const LAS bf16x8*)(kb + (32 + r32) * KP + (16 * ks + 8 * hi) * 2);
        s0 = __builtin_amdgcn_mfma_f32_32x32x16_bf16(a0, qf[ks], s0, 0, 0, 0);
        s1 = __builtin_amdgcn_mfma_f32_32x32x16_bf16(a1, qf[ks], s1, 0, 0, 0);
    }
}
template <int MODE>
__device__ __forceinline__ bool elem_valid(int kt, int e, int hi, int qloc, int t, int key0) {
    const int kl = kt * 32 + (e & 3) + 8 * (e >> 2) + 4 * hi;
    if (MODE == 1) { const int c = key0 + kl; return (c < 127) && (16 * c + 31 <= t); }
    if (MODE == 2) return kl <= qloc;
    if (MODE == 3) return kl > qloc;
    return true;
}
template <int DT> __device__ __forceinline__ void pv_read(unsigned vb_lane, s16x4 (&va)[4][2]) {
    va[0][0] = tr_read<0 * VP + 64 * DT>(vb_lane); va[0][1] = tr_read<8 * VP + 64 * DT>(vb_lane); va[1][0] = tr_read<16 * VP + 64 * DT>(vb_lane); va[1][1] = tr_read<24 * VP + 64 * DT>(vb_lane);
    va[2][0] = tr_read<32 * VP + 64 * DT>(vb_lane); va[2][1] = tr_read<40 * VP + 64 * DT>(vb_lane); va[3][0] = tr_read<48 * VP + 64 * DT>(vb_lane); va[3][1] = tr_read<56 * VP + 64 * DT>(vb_lane);
}
__device__ __forceinline__ void pv_mma(const s16x4 (&va)[4][2], const unsigned (&pp)[16], f32x16& o) {
#pragma unroll
    for (int kk = 0; kk < 4; ++kk) {
        const bf16x8 af = (bf16x8){va[kk][0][0], va[kk][0][1], va[kk][0][2], va[kk][0][3], va[kk][1][0], va[kk][1][1], va[kk][1][2], va[kk][1][3]};
        typedef unsigned u32x4 __attribute__((ext_vector_type(4)));
        const u32x4 pw = (u32x4){pp[4 * kk], pp[4 * kk + 1], pp[4 * kk + 2], pp[4 * kk + 3]};
        o = __builtin_amdgcn_mfma_f32_32x32x16_bf16(af, __builtin_bit_cast(bf16x8, pw), o, 0, 0, 0);
    }
}
__device__ __forceinline__ void pv_tile(unsigned vb_lane, const unsigned (&pp)[16], St& st) {
    s16x4 va[4][2];
    pv_read<0>(vb_lane, va); asm volatile("s_waitcnt lgkmcnt(0)" ::: "memory"); __builtin_amdgcn_sched_barrier(0); pv_mma(va, pp, st.o[0]);
    pv_read<1>(vb_lane, va); asm volatile("s_waitcnt lgkmcnt(0)" ::: "memory"); __builtin_amdgcn_sched_barrier(0); pv_mma(va, pp, st.o[1]);
}
__device__ __forceinline__ float max3f(float a, float b, float c) { float r; asm("v_max3_f32 %0, %1, %2, %3" : "=v"(r) : "v"(a), "v"(b), "v"(c)); return r; }
template <int KK> __device__ __forceinline__ void pv_read_slice(unsigned vb_lane, s16x4 (&v)[2][2]) {
    v[0][0] = tr_read<(16 * KK) * VP>(vb_lane); v[0][1] = tr_read<(16 * KK + 8) * VP>(vb_lane); v[1][0] = tr_read<(16 * KK) * VP + 64>(vb_lane); v[1][1] = tr_read<(16 * KK + 8) * VP + 64>(vb_lane);
}
template <bool GATED> __device__ __forceinline__ void sm_pack_mma(const float (&pe)[8], const s16x4 (&v)[2][2], St& st, float& rs, bool en) {
    typedef unsigned u32x4 __attribute__((ext_vector_type(4))); u32x4 pw;
#pragma unroll
    for (int i = 0; i < 4; ++i) { pw[i] = pk2(pe[2 * i], pe[2 * i + 1]); if (GATED) pw[i] = en ? pw[i] : 0u; }
    float t = ((pe[0] + pe[1]) + (pe[2] + pe[3])) + ((pe[4] + pe[5]) + (pe[6] + pe[7])); if (GATED) t = en ? t : 0.f; rs += t;
    const bf16x8 pb = __builtin_bit_cast(bf16x8, pw);
    const bf16x8 a0 = (bf16x8){v[0][0][0], v[0][0][1], v[0][0][2], v[0][0][3], v[0][1][0], v[0][1][1], v[0][1][2], v[0][1][3]};
    const bf16x8 a1 = (bf16x8){v[1][0][0], v[1][0][1], v[1][0][2], v[1][0][3], v[1][1][0], v[1][1][1], v[1][1][2], v[1][1][3]};
    st.o[0] = __builtin_amdgcn_mfma_f32_32x32x16_bf16(a0, pb, st.o[0], 0, 0, 0);
    st.o[1] = __builtin_amdgcn_mfma_f32_32x32x16_bf16(a1, pb, st.o[1], 0, 0, 0);
}
template <bool GATED> __device__ __forceinline__ void sm_slice(const f32x16& sc, const int e0, const s16x4 (&v)[2][2], St& st, float& rs, bool en) {
    float pe[8];
#pragma unroll
    for (int i = 0; i < 8; ++i) pe[i] = __builtin_amdgcn_exp2f(sc[e0 + i]);
    sm_pack_mma<GATED>(pe, v, st, rs, en);
}
template <int MODE, bool GATED, bool FIXED>
__device__ __forceinline__ void attend_tile(const LAS unsigned char* kb, unsigned vb_lane, int r32, int hi, const bf16x8 (&qf)[4], St& st, int qloc, bool en, float mfix) {
    if constexpr (FIXED) {
        f32x16 s0, s1; bf16x8 ka0[4], ka1[4];
#pragma unroll
        for (int ks = 0; ks < 4; ++ks) { ka0[ks] = *(const LAS bf16x8*)(kb + r32 * KP + (16 * ks + 8 * hi) * 2); ka1[ks] = *(const LAS bf16x8*)(kb + (32 + r32) * KP + (16 * ks + 8 * hi) * 2); }
        s16x4 v0[2][2], v1[2][2], v2[2][2], v3[2][2];
        pv_read_slice<0>(vb_lane, v0); pv_read_slice<1>(vb_lane, v1);
#pragma unroll
        for (int e = 0; e < 16; ++e) { s0[e] = 0.f; s1[e] = 0.f; }
#pragma unroll
        for (int ks = 0; ks < 4; ++ks) s0 = __builtin_amdgcn_mfma_f32_32x32x16_bf16(ka0[ks], qf[ks], s0, 0, 0, 0);
        if (MODE != 0) {
#pragma unroll
            for (int e = 0; e < 16; ++e) s0[e] = elem_valid<MODE>(0, e, hi, qloc, 0, 0) ? s0[e] : NEG; }
        float rs = 0.f; float pe0[8];
#pragma unroll
        for (int ks = 0; ks < 4; ++ks) { s1 = __builtin_amdgcn_mfma_f32_32x32x16_bf16(ka1[ks], qf[ks], s1, 0, 0, 0); pe0[2 * ks] = __builtin_amdgcn_exp2f(s0[2 * ks]); pe0[2 * ks + 1] = __builtin_amdgcn_exp2f(s0[2 * ks + 1]); __builtin_amdgcn_sched_barrier(0); }
        if (MODE != 0) {
#pragma unroll
            for (int e = 0; e < 16; ++e) s1[e] = elem_valid<MODE>(1, e, hi, qloc, 0, 0) ? s1[e] : NEG; }
        asm volatile("s_waitcnt lgkmcnt(4)" ::: "memory"); __builtin_amdgcn_sched_barrier(0); sm_pack_mma<GATED>(pe0, v0, st, rs, en); __builtin_amdgcn_sched_barrier(0);
        pv_read_slice<2>(vb_lane, v2);
        asm volatile("s_waitcnt lgkmcnt(4)" ::: "memory"); __builtin_amdgcn_sched_barrier(0); sm_slice<GATED>(s0, 8, v1, st, rs, en); __builtin_amdgcn_sched_barrier(0);
        pv_read_slice<3>(vb_lane, v3);
        asm volatile("s_waitcnt lgkmcnt(4)" ::: "memory"); __builtin_amdgcn_sched_barrier(0); sm_slice<GATED>(s1, 0, v2, st, rs, en); __builtin_amdgcn_sched_barrier(0);
        asm volatile("s_waitcnt lgkmcnt(0)" ::: "memory"); __builtin_amdgcn_sched_barrier(0); sm_slice<GATED>(s1, 8, v3, st, rs, en);
        st.l += rs;
        return;
    }
    f32x16 s0, s1; qk_tile(kb, r32, hi, qf, s0, s1);
    s16x4 va0[4][2]; pv_read<0>(vb_lane, va0);
    if (MODE != 0) {
#pragma unroll
        for (int e = 0; e < 16; ++e) { s0[e] = elem_valid<MODE>(0, e, hi, qloc, 0, 0) ? s0[e] : NEG; s1[e] = elem_valid<MODE>(1, e, hi, qloc, 0, 0) ? s1[e] : NEG; }
    }
    float mc = 0.f;
    if (FIXED) {
    } else {
        float mx = max3f(s0[0], s0[1], s1[0]);
#pragma unroll
        for (int e = 2; e < 16; e += 2) mx = max3f(mx, s0[e], s0[e + 1]);
#pragma unroll
        for (int e = 1; e < 15; e += 2) mx = max3f(mx, s1[e], s1[e + 1]);
        mx = fmaxf(mx, s1[15]);
        if (GATED) mx = en ? mx : NEG;
        mx = max32(mx);
        float mold = st.m;
        if (__any((mx - mold) * SC > THR)) {
            const float mnew = fmaxf(mold, mx); const float al = __builtin_amdgcn_exp2f((mold - mnew) * SC);
#pragma unroll
            for (int e = 0; e < 16; ++e) { st.o[0][e] *= al; st.o[1][e] *= al; }
            st.l *= al; st.m = mnew; mold = mnew;
        }
        mc = fmaxf(mold, -1e20f) * SC; if (GATED) mc = en ? mc : 3e38f;
    }
    float rs = 0.f; unsigned pp[16];
#pragma unroll
    for (int e = 0; e < 16; e += 2) {
        float a0, a1, b0, b1;
        if (FIXED) { a0 = __builtin_amdgcn_exp2f(s0[e]); a1 = __builtin_amdgcn_exp2f(s0[e + 1]); b0 = __builtin_amdgcn_exp2f(s1[e]); b1 = __builtin_amdgcn_exp2f(s1[e + 1]); }
        else { a0 = __builtin_amdgcn_exp2f(__builtin_fmaf(s0[e], SC, -mc)); a1 = __builtin_amdgcn_exp2f(__builtin_fmaf(s0[e + 1], SC, -mc)); b0 = __builtin_amdgcn_exp2f(__builtin_fmaf(s1[e], SC, -mc)); b1 = __builtin_amdgcn_exp2f(__builtin_fmaf(s1[e + 1], SC, -mc)); }
        rs += (a0 + a1) + (b0 + b1); pp[e >> 1] = pk2(a0, a1); pp[8 + (e >> 1)] = pk2(b0, b1); }
    if (FIXED && GATED) {
#pragma unroll
        for (int i = 0; i < 16; ++i) pp[i] = en ? pp[i] : 0u;
        rs = en ? rs : 0.f; }
    if (!FIXED) rs = sum32(rs);
    st.l += rs;
    asm volatile("s_waitcnt lgkmcnt(0)" ::: "memory"); __builtin_amdgcn_sched_barrier(0); pv_mma(va0, pp, st.o[0]);
    { s16x4 va1[4][2]; pv_read<1>(vb_lane, va1); asm volatile("s_waitcnt lgkmcnt(0)" ::: "memory"); __builtin_amdgcn_sched_barrier(0); pv_mma(va1, pp, st.o[1]); }
}
__device__ __forceinline__ void st_reset(St& st) {
#pragma unroll
    for (int a = 0; a < 2; ++a)
#pragma unroll
        for (int e = 0; e < 16; ++e) st.o[a][e] = 0.f;
    st.m = NEG; st.l = 0.f;
}
__device__ __forceinline__ void st_flush(const St& st, unsigned (&ofin)[2][8], float g, bool first) {
    const float f = (st.l > 0.f ? 1.f / st.l : 0.f) * g;
#pragma unroll
    for (int dt = 0; dt < 2; ++dt)
#pragma unroll
        for (int e = 0; e < 16; e += 2) { float a = st.o[dt][e] * f, b = st.o[dt][e + 1] * f;
            if (!first) { const unsigned w = ofin[dt][e >> 1]; a += __uint_as_float(w << 16); b += __uint_as_float(w & 0xFFFF0000u); }
            ofin[dt][e >> 1] = pk2(a, b); }
#pragma unroll
    for (int dt = 0; dt < 2; ++dt) asm volatile("" : "+v"(ofin[dt][0]), "+v"(ofin[dt][1]), "+v"(ofin[dt][2]), "+v"(ofin[dt][3]), "+v"(ofin[dt][4]), "+v"(ofin[dt][5]), "+v"(ofin[dt][6]), "+v"(ofin[dt][7]));
}
__device__ __forceinline__ void tile_load(const bf16_t* kbase, const bf16_t* vbase, int key0, int tid, uint4& kr, uint4& vr) {
    const size_t o = (size_t)(key0 + (tid >> 3)) * 64 + (tid & 7) * 8; kr = *(const uint4*)(kbase + o); vr = *(const uint4*)(vbase + o); }
typedef unsigned u32x4_t __attribute__((ext_vector_type(4)));
__device__ __forceinline__ void tile_store(LAS unsigned char* lds, int buf, int tid, const uint4& kr, const uint4& vr) {
    *(LAS u32x4_t*)(lds + OFF_K0 + buf * KBUF + (tid >> 3) * KP + (tid & 7) * 16) = (u32x4_t){kr.x, kr.y, kr.z, kr.w}; *(LAS u32x4_t*)(lds + OFF_V0 + buf * VBUF + (tid >> 3) * VP + (tid & 7) * 16) = (u32x4_t){vr.x, vr.y, vr.z, vr.w}; }
}

template <bool FIXED>
__device__ __forceinline__ void phase_attn_t(const Params& p, const Frame& F, const float mfix) {
    using namespace at;
    LAS unsigned char* lds = F.lds;
    const int tid = F.tid, lane = F.lane, w = F.wave, r32 = lane & 31, hi = lane >> 5;
    const unsigned vlane = (unsigned)((4 * hi + ((lane & 15) >> 2)) * VP + (16 * ((lane >> 4) & 1) + 4 * (lane & 3)) * 2);
    LAS float* impw = (LAS float*)(lds + OFF_IMP) + w * 32 * IMP_PITCH;
    LAS unsigned* selm = (LAS unsigned*)(lds + OFF_SEL);
    LAS float* invl = (LAS float*)(lds + OFF_SEL + 512);
#define AT_UNIT(ui_, qb_, bg_, qoff_) const int idx_##qb_ = ((ui_) & 1) ? ((ui_) * 256 + 255 - F.bid) : ((ui_) * 256 + F.bid); const int qb_ = 31 - (idx_##qb_ >> 6), bg_ = (idx_##qb_ >> 1) & 31, qoff_ = (idx_##qb_ & 1) * 32
    bf16x8 qf[4]; float gt[3]; uint4 kr, vr, kr1, vr1;
    { AT_UNIT(0, qb, bg, qoff);
      const bf16_t* kc = p.kcmp + (size_t)bg * 128 * 64; const bf16_t* vc = p.vcmp + (size_t)bg * 128 * 64;
      tile_load(kc, vc, 0, tid, kr, vr); if (qb >= 16) tile_load(kc, vc, 64, tid, kr1, vr1); }
#pragma unroll 1
    for (int ui = 0; ui < 8; ++ui) {
        AT_UNIT(ui, qb, bg, qoff);
        const int b = bg >> 1, g = bg & 1, head = g * 8 + w, s0 = qb * 64;
        const int qloc = qoff + r32, t = s0 + qloc;
        const bf16_t* ksel = p.kv + (size_t)2 * T * 128 + (size_t)bg * S * 64; const bf16_t* vsel = p.kv + (size_t)3 * T * 128 + (size_t)bg * S * 64;
        const bf16_t* kwin = p.kv + (size_t)4 * T * 128 + (size_t)bg * S * 64; const bf16_t* vwin = p.kv + (size_t)5 * T * 128 + (size_t)bg * S * 64;
        unsigned ofin[2][8]; St st;
        { const size_t tok = (size_t)b * S + t;
#pragma unroll
          for (int ks = 0; ks < 4; ++ks) { qf[ks] = *(const bf16x8*)(p.q + tok * D + head * 64 + 16 * ks + 8 * hi);
              if (FIXED) { typedef unsigned u32x4q __attribute__((ext_vector_type(4))); const u32x4q w4 = __builtin_bit_cast(u32x4q, qf[ks]); u32x4q r4;
#pragma unroll
                  for (int i = 0; i < 4; ++i) r4[i] = pk2(__uint_as_float(w4[i] << 16) * SC, __uint_as_float(w4[i] & 0xFFFF0000u) * SC);
                  qf[ks] = __builtin_bit_cast(bf16x8, r4); } }
#pragma unroll
          for (int br = 0; br < 3; ++br) gt[br] = p.gates[tok * 48 + br * 16 + head]; }
        const int nct = (qb >= 16) ? 2 : 1;
        __syncthreads();
        tile_store(lds, 0, tid, kr, vr); if (nct == 2) tile_store(lds, 1, tid, kr1, vr1);
        tile_load(ksel, vsel, qb * 64, tid, kr, vr);
        __syncthreads();
        float cm = NEG, cl = 0.f;
        if (!FIXED) {
#pragma unroll 1
        for (int ct = 0; ct < nct; ++ct) { const LAS unsigned char* kb = lds + (ct ? OFF_K1 : OFF_K0);
            f32x16 a0, a1; qk_tile(kb, r32, hi, qf, a0, a1); float mx = NEG;
#pragma unroll
            for (int e = 0; e < 16; ++e) { a0[e] = elem_valid<1>(0, e, hi, qloc, t, ct * 64) ? a0[e] : NEG; a1[e] = elem_valid<1>(1, e, hi, qloc, t, ct * 64) ? a1[e] : NEG; mx = fmaxf(mx, fmaxf(a0[e], a1[e])); }
            mx = max32(mx); const float mnew = fmaxf(cm, mx); float rs = 0.f;
#pragma unroll
            for (int e = 0; e < 16; ++e) { rs += (a0[e] > -1e29f ? __builtin_amdgcn_exp2f((a0[e] - mnew) * SC) : 0.f) + (a1[e] > -1e29f ? __builtin_amdgcn_exp2f((a1[e] - mnew) * SC) : 0.f); }
            rs = sum32(rs); cl = cl * __builtin_amdgcn_exp2f((cm - mnew) * SC) + rs; cm = mnew; }
        }
        st_reset(st); if (FIXED) cm = mfix / SC; else st.m = cm;
        const float icl = FIXED ? 1.f : (cl > 0.f ? 1.f / cl : 0.f);
        LAS float* irow = impw + r32 * IMP_PITCH;
        if (nct == 1) {
#pragma unroll 1
            for (int j = 16; j < 32; ++j) irow[j] = 0.f; }
#pragma unroll 1
        for (int ct = 0; ct < nct; ++ct) { const LAS unsigned char* kb = lds + (ct ? OFF_K1 : OFF_K0); const unsigned vb = (unsigned)(unsigned long)(lds + (ct ? OFF_V1 : OFF_V0)) + vlane;
            f32x16 a0, a1; qk_tile(kb, r32, hi, qf, a0, a1); const float mc = cm * SC; unsigned pp[16]; float rs = 0.f; float Ai[8], Fi[8];
            int clim = (t - 31) >> 4; clim = (clim > 126 ? 126 : clim) - 4 * hi - ct * 64;
#pragma unroll
            for (int kt = 0; kt < 2; ++kt)
#pragma unroll
                for (int gq = 0; gq < 4; ++gq) { float pv[4];
#pragma unroll
                    for (int e2 = 0; e2 < 4; ++e2) { const int e = gq * 4 + e2; const float sv = kt ? a1[e] : a0[e]; pv[e2] = (kt * 32 + (e & 3) + 8 * (e >> 2) <= clim) ? (FIXED ? __builtin_amdgcn_exp2f(sv) : __builtin_amdgcn_exp2f(sv * SC - mc)) : 0.f; }
                    pp[kt * 8 + gq * 2] = pk2(pv[0], pv[1]); pp[kt * 8 + gq * 2 + 1] = pk2(pv[2], pv[3]); rs += (pv[0] + pv[1]) + (pv[2] + pv[3]);
                    Ai[kt * 4 + gq] = (pv[0] + 2.f * (pv[1] + pv[2] + pv[3])) * icl; Fi[kt * 4 + gq] = pv[0] * icl; }
            st.l += rs;
            float Fr[8];
#pragma unroll
            for (int g8 = 0; g8 < 8; ++g8) Fr[g8] = other32(Fi[g8], hi != 0);
#pragma unroll
            for (int g8 = 0; g8 < 8; ++g8) { const float nxt = (g8 < 7) ? Fr[g8 + 1] : 0.f;
                irow[ct * 16 + 2 * g8 + hi] = Ai[g8] + (hi ? nxt : Fr[g8]); }
            if (ct == 1 && hi) irow[15] += Fr[0];
            pv_tile(vb, pp, st); }
        st.l = sum32(st.l);
        if (hi == 0) invl[w * 32 + r32] = FIXED ? (st.l > 0.f ? 1.f / st.l : 0.f) : 1.f;
        tile_store(lds, 2, tid, kr, vr);
        st_flush(st, ofin, gt[0], true);
        __syncthreads();
        if (w == 0) { unsigned mask;
            if (qb < 8) mask = (2u << qb) - 1u;
            else { mask = 1u | (1u << qb) | (1u << (qb - 1));
                const LAS float* ib = (const LAS float*)(lds + OFF_IMP) + r32 * IMP_PITCH; float iv[32];
#pragma unroll
                for (int j = 0; j < 32; ++j) { float v = 0.f;
#pragma unroll
                    for (int ww = 0; ww < 8; ++ww) v += ib[ww * 32 * IMP_PITCH + j] * invl[ww * 32 + r32];
                    iv[j] = (j >= 1 && j <= qb - 2) ? v : -3e38f; }
#pragma unroll 1
                for (int pick = 0; pick < 5; ++pick) { int best = -1; float bv = -3e38f;
#pragma unroll
                    for (int j = 1; j < 31; ++j) { const bool take = !((mask >> j) & 1u) && iv[j] > bv; bv = take ? iv[j] : bv; best = take ? j : best; }
                    if (best >= 0) mask |= 1u << best; } }
            if (hi == 0) selm[r32] = mask; unsigned um = mask;
            um |= sxu<16>(um); um |= sxu<8>(um); um |= sxu<4>(um); um |= sxu<2>(um); um |= sxu<1>(um);
            if (lane == 0) selm[32] = um; }
        __syncthreads();
        const int jlo = qb >= 8 ? qb - 8 : 0;
        { const unsigned um = selm[32]; const unsigned mq = selm[r32];
          st_reset(st);
          unsigned rem = um & ~(1u << qb);
#define SEL_POP(dst) do { if (rem) { dst = 31 - __builtin_clz(rem); rem &= ~(1u << dst); } else dst = -1; } while (0)
          int jA = qb, jB = -1, sb = 1;
          for (;;) {
              int nA, nB = -1; SEL_POP(nA); if (nA >= 0) SEL_POP(nB);
              if (nA >= 0) tile_load(ksel, vsel, nA * 64, tid, kr, vr);
              if (nB >= 0) tile_load(ksel, vsel, nB * 64, tid, kr1, vr1);
              if (nA < 0) { tile_load(kwin, vwin, qb * 64, tid, kr, vr); if (qb - 1 >= jlo) tile_load(kwin, vwin, (qb - 1) * 64, tid, kr1, vr1); }
              { const LAS unsigned char* kb = lds + OFF_K0 + (2 * sb) * KBUF; const unsigned vb = (unsigned)(unsigned long)(lds + OFF_V0 + (2 * sb) * VBUF) + vlane;
                if (jA == qb) attend_tile<2, false, FIXED>(kb, vb, r32, hi, qf, st, qloc, true, mfix);
                else attend_tile<0, true, FIXED>(kb, vb, r32, hi, qf, st, qloc, (mq >> jA) & 1u, mfix); }
              if (jB >= 0) { const LAS unsigned char* kb = lds + OFF_K0 + (2 * sb + 1) * KBUF; const unsigned vb = (unsigned)(unsigned long)(lds + OFF_V0 + (2 * sb + 1) * VBUF) + vlane;
                attend_tile<0, true, FIXED>(kb, vb, r32, hi, qf, st, qloc, (mq >> jB) & 1u, mfix); }
              if (nA < 0) break;
              tile_store(lds, 2 * (sb ^ 1), tid, kr, vr); if (nB >= 0) tile_store(lds, 2 * (sb ^ 1) + 1, tid, kr1, vr1);
              __syncthreads();
              jA = nA; jB = nB; sb ^= 1;
          }
#undef SEL_POP
          if (FIXED) st.l = sum32(st.l);
          st_flush(st, ofin, gt[1], false); }
        __syncthreads();
        { st_reset(st);
          int jA = qb, jB = (qb - 1 >= jlo) ? qb - 1 : -1, sb = 0;
          tile_store(lds, 0, tid, kr, vr); if (jB >= 0) tile_store(lds, 1, tid, kr1, vr1);
          __syncthreads();
          for (;;) {
              const int nA = (jB >= 0 && jB - 1 >= jlo) ? jB - 1 : -1, nB = (nA >= 0 && nA - 1 >= jlo) ? nA - 1 : -1;
              if (nA >= 0) tile_load(kwin, vwin, nA * 64, tid, kr, vr);
              if (nB >= 0) tile_load(kwin, vwin, nB * 64, tid, kr1, vr1);
              if (nA < 0 && ui + 1 < 8) {
                  AT_UNIT(ui + 1, qbn, bgn, qoffn);
                  const bf16_t* kcn = p.kcmp + (size_t)bgn * 128 * 64; const bf16_t* vcn = p.vcmp + (size_t)bgn * 128 * 64;
                  tile_load(kcn, vcn, 0, tid, kr, vr); if (qbn >= 16) tile_load(kcn, vcn, 64, tid, kr1, vr1); }
#define WIN_TILE(j_, bi_) do { const LAS unsigned char* kb = lds + OFF_K0 + (bi_) * KBUF; const unsigned vb = (unsigned)(unsigned long)(lds + OFF_V0 + (bi_) * VBUF) + vlane; \
                if ((j_) == qb) attend_tile<2, false, FIXED>(kb, vb, r32, hi, qf, st, qloc, true, mfix); else if ((j_) == qb - 8) attend_tile<3, false, FIXED>(kb, vb, r32, hi, qf, st, qloc, true, mfix); else attend_tile<0, false, FIXED>(kb, vb, r32, hi, qf, st, qloc, true, mfix); } while (0)
              WIN_TILE(jA, 2 * sb);
              if (jB >= 0) WIN_TILE(jB, 2 * sb + 1);
#undef WIN_TILE
              if (nA < 0) break;
              tile_store(lds, 2 * (sb ^ 1), tid, kr, vr); if (nB >= 0) tile_store(lds, 2 * (sb ^ 1) + 1, tid, kr1, vr1);
              __syncthreads();
              jA = nA; jB = nB; sb ^= 1;
          }
          if (FIXED) st.l = sum32(st.l);
          st_flush(st, ofin, gt[2], false); }
        { int l2 = lane; asm volatile("" : "+v"(l2)); unsigned char* op = (unsigned char*)p.h + ((size_t)b * S + s0 + qoff + (l2 & 31)) * D + head * 64 + 4 * (l2 >> 5);
#pragma unroll
          for (int dt = 0; dt < 2; ++dt)
#pragma unroll
            for (int gq = 0; gq < 4; ++gq) { const unsigned w0 = ofin[dt][2 * gq], w1 = ofin[dt][2 * gq + 1];
                *(unsigned*)(op + dt * 32 + 8 * gq) = pk4_fp8(__uint_as_float(w0 << 16) * F8_SA, __uint_as_float(w0 & 0xFFFF0000u) * F8_SA, __uint_as_float(w1 << 16) * F8_SA, __uint_as_float(w1 & 0xFFFF0000u) * F8_SA); } }
    }
#undef AT_UNIT
}

__device__ __forceinline__ void phase_attn(const Params& p, const Frame& F) {
    const float gq = wave_max(fabsf(p.q_gain[F.lane])); const float gk = wave_max(fmaxf(fabsf(p.k_gain[F.lane]), fmaxf(fabsf(p.k_gain[64 + F.lane]), fabsf(p.k_gain[128 + F.lane]))));
    const float mfix = 64.f * 1.02f * gq * gk * at::SC;
    if (mfix < 60.f) phase_attn_t<true>(p, F, mfix);
    else phase_attn_t<false>(p, F, 0.f);
}

namespace ml {
constexpr int QP = 272, VP = 192;
constexpr int OFF_Q = 0, OFF_K = 64 * QP, OFF_V = 2 * 64 * QP, OFF_WV = OFF_V + 64 * VP, OFF_CB = OFF_WV + 64 * VP, OFF_GA = OFF_CB + 128 * VP, OFF_GAM = OFF_GA + 8192, OFF_GB = OFF_GAM + 8192,
              OFF_MP = OFF_GB + 8192, OFF_W = OFF_MP + 256, OFF_N = OFF_W + 256, OFF_RS = OFF_N + 512, OFF_QN = OFF_RS + 256, OFF_END = OFF_QN + 256;
typedef unsigned u32x4_t __attribute__((ext_vector_type(4)));
}
__device__ __forceinline__ void phase_scan(const Params& p, const Frame& F, bf16_t* hs_base  , const int hs_stride) {
    using namespace ml; using at::tr_read; using at::pk2;
    LAS unsigned char* lds = F.lds;
    const int tid = F.tid, lane = F.lane, w = F.wave, i16 = lane & 15, g = lane >> 4, r32 = lane & 31, hi = lane >> 5;
    const int b = F.bid >> 4, h = (F.bid >> 2) & 3, vs = F.bid & 3;
    LAS float* ga = (LAS float*)(lds + OFF_GA); LAS float* gam = (LAS float*)(lds + OFF_GAM); LAS float* gb = (LAS float*)(lds + OFF_GB); LAS float* mp = (LAS float*)(lds + OFF_MP);
    LAS float* wl = (LAS float*)(lds + OFF_W); LAS float* nl = (LAS float*)(lds + OFF_N); LAS float* rsl = (LAS float*)(lds + OFF_RS); LAS float* qnl = (LAS float*)(lds + OFF_QN);
    for (int ck = w; ck < 32; ck += 8) { const int pos = ck * 64 + lane; const size_t tg = ((size_t)b * S + pos) * 4 + h; const float lfv = p.lf[tg], liv = p.li[tg];
        float bs = lfv;
#pragma unroll
        for (int o = 1; o < 64; o <<= 1) { const float x = __int_as_float(__builtin_amdgcn_ds_bpermute((lane - o) * 4, __float_as_int(bs))); if (lane >= o) bs += x; }
        const float av = liv - bs; float am = av;
#pragma unroll
        for (int o = 1; o < 64; o <<= 1) { const float x = __int_as_float(__builtin_amdgcn_ds_bpermute((lane - o) * 4, __float_as_int(am))); if (lane >= o) am = fmaxf(am, x); }
        ga[pos] = av; gam[pos] = am; gb[pos] = bs; }
    for (int idx = tid; idx < 128 * VP / 4; idx += NTHR) ((LAS unsigned*)(lds + OFF_CB))[idx] = 0u;
    if (tid < 128) nl[tid] = 0.f;
    __syncthreads();
    if (tid == 0) { float m = 0.f;
#pragma unroll 1
        for (int k = 0; k < 32; ++k) { mp[k] = m; m = gb[k * 64 + 63] + fmaxf(m, gam[k * 64 + 63]); } }
    __syncthreads();
    const bf16_t* pq = p.proj + (size_t)b * S * 3072 + h * 128; const bf16_t* pk = pq + 512; bf16_t* pv = p.proj + (size_t)b * S * 3072 + 1024 + h * 256 + vs * 64;
    uint4 rq[2], rk[2], rv;
#define ML_LOAD(ck_) do { const size_t t0_ = (size_t)(ck_) * 64; _Pragma("unroll") for (int i_ = 0; i_ < 2; ++i_) { const int idx_ = tid + 512 * i_; const size_t o_ = (t0_ + (idx_ >> 4)) * 3072 + (idx_ & 15) * 8; rq[i_] = *(const uint4*)(pq + o_); rk[i_] = *(const uint4*)(pk + o_); } \
        rv = *(const uint4*)(pv + (t0_ + (tid >> 3)) * 3072 + (tid & 7) * 8); } while (0)
#define ML_STORE(ck_) do { _Pragma("unroll") for (int i_ = 0; i_ < 2; ++i_) { const int idx_ = tid + 512 * i_; const int o_ = (idx_ >> 4) * QP + (idx_ & 15) * 16; \
            *(LAS u32x4_t*)(lds + OFF_Q + o_) = (u32x4_t){rq[i_].x, rq[i_].y, rq[i_].z, rq[i_].w}; *(LAS u32x4_t*)(lds + OFF_K + o_) = (u32x4_t){rk[i_].x, rk[i_].y, rk[i_].z, rk[i_].w}; } \
        { const int s_ = tid >> 3; const float m63_ = fmaxf(mp[ck_], gam[(ck_) * 64 + 63]); const float ws_ = __expf(ga[(ck_) * 64 + s_] - m63_); if ((tid & 7) == 0) wl[s_] = ws_; \
          const int o_ = s_ * VP + (tid & 7) * 16; *(LAS u32x4_t*)(lds + OFF_V + o_) = (u32x4_t){rv.x, rv.y, rv.z, rv.w}; const unsigned vv_[4] = {rv.x, rv.y, rv.z, rv.w}; unsigned ww_[4]; \
          _Pragma("unroll") for (int e_ = 0; e_ < 4; ++e_) ww_[e_] = pk2(__uint_as_float(vv_[e_] << 16) * ws_, __uint_as_float(vv_[e_] & 0xFFFF0000u) * ws_); \
          *(LAS u32x4_t*)(lds + OFF_WV + o_) = (u32x4_t){ww_[0], ww_[1], ww_[2], ww_[3]}; } } while (0)
    ML_LOAD(0); ML_STORE(0);
    __syncthreads();
    const int tt = w >> 1, vh = w & 1;
    const int dt = w >> 1, vt2 = w & 1;
    const unsigned trl16 = (unsigned)(((lane & 15) >> 2) * VP + (4 * (lane & 3)) * 2);
    const unsigned trl32v = (unsigned)(((lane & 15) >> 2) * VP + (16 * ((lane >> 4) & 1) + 4 * (lane & 3)) * 2);
    const unsigned trl32k = (unsigned)(((lane & 15) >> 2) * QP + (16 * ((lane >> 4) & 1) + 4 * (lane & 3)) * 2);
    f32x16 cacc;
#pragma unroll
    for (int e = 0; e < 16; ++e) cacc[e] = 0.f;
    float nreg = 0.f;
    bf16_t* const hs_out = hs_base + (size_t)b * S * hs_stride + h * 256 + vs * 64 + 32 * vh + i16;
    const size_t wo1 = (size_t)NE * D * DE; const ColGateUp cgu{p.w_gate + wo1, p.w_up + wo1}; const ColDown cdn{p.w_down + wo1};
    LAS float* ptile = (LAS float*)(lds + OFF_END) + (tid >> 8) * (64 * 65); const int htid = tid & 255, half = tid >> 8;
    float pr_[16];
#define PREP_LOAD(s_) do { const bool gu_ = (s_) < 16; const int tl_ = (((gu_ ? (s_) : (s_) - 16) * F.G + F.bid) * 2 + half); const int c0_ = (tl_ & 511) * 64, k0_ = (tl_ >> 9) * 64; \
        const float* p_ = gu_ ? cgu(c0_ + (htid & 63)) : cdn(c0_ + (htid & 63)); const int ldw_ = gu_ ? DE : D; p_ += (size_t)(k0_ + (htid >> 6)) * ldw_; \
        _Pragma("unroll") for (int i_ = 0; i_ < 16; ++i_) pr_[i_] = p_[(size_t)(4 * i_) * ldw_]; } while (0)
#define PREP_WRITE() do { _Pragma("unroll") for (int i_ = 0; i_ < 16; ++i_) ptile[((htid >> 6) + 4 * i_) * 65 + (htid & 63)] = pr_[i_]; } while (0)
#define PREP_STORE(s_) do { const bool gu_ = (s_) < 16; const int tl_ = (((gu_ ? (s_) : (s_) - 16) * F.G + F.bid) * 2 + half); const int c0_ = (tl_ & 511) * 64, k0_ = (tl_ >> 9) * 64; \
        const int cc_ = htid >> 2, ch_ = (htid & 3) * 16; \
        { const float sc_ = gu_ ? F8_SW : F8_SW2; const unsigned long long a_ = (unsigned long long)p.gu_t, d_ = (unsigned long long)p.dn_t - a_; unsigned char* base_ = (unsigned char*)(a_ + (gu_ ? 0ull : d_)); const int kp_ = gu_ ? D : DE; \
          unsigned w_[4]; _Pragma("unroll") for (int i_ = 0; i_ < 4; ++i_) w_[i_] = pk4_fp8(ptile[(ch_ + 4 * i_) * 65 + cc_] * sc_, ptile[(ch_ + 4 * i_ + 1) * 65 + cc_] * sc_, ptile[(ch_ + 4 * i_ + 2) * 65 + cc_] * sc_, ptile[(ch_ + 4 * i_ + 3) * 65 + cc_] * sc_); \
          *(uint4*)(base_ + (size_t)(c0_ + cc_) * kp_ + k0_ + ch_) = make_uint4(w_[0], w_[1], w_[2], w_[3]); } } while (0)
    PREP_LOAD(0);
#pragma unroll 1
    for (int ck = 0; ck < 32; ++ck) {
        if (ck + 1 < 32) ML_LOAD(ck + 1);
        const float mprev = mp[ck]; const int c0 = ck * 64;
        bf16x8 qf[4];
#pragma unroll
        for (int ks = 0; ks < 4; ++ks) qf[ks] = *(const LAS bf16x8*)(lds + OFF_Q + (16 * tt + i16) * QP + (32 * ks + 8 * g) * 2);
        f32x4 st[4];
#pragma unroll
        for (int jt = 0; jt < 4; ++jt) { st[jt] = (f32x4){0.f, 0.f, 0.f, 0.f};
#pragma unroll
            for (int ks = 0; ks < 4; ++ks) { const bf16x8 kf = *(const LAS bf16x8*)(lds + OFF_K + (16 * jt + i16) * QP + (32 * ks + 8 * g) * 2); st[jt] = __builtin_amdgcn_mfma_f32_16x16x32_bf16(kf, qf[ks], st[jt], 0, 0, 0); } }
        const int tl = 16 * tt + i16; const float Mt = fmaxf(mprev, gam[c0 + tl]); float rs = 0.f; unsigned ap[8];
#pragma unroll
        for (int jt = 0; jt < 4; ++jt) { float v4[4]; const f32x4 ga4 = *(const LAS f32x4*)(ga + c0 + 16 * jt + 4 * g);
#pragma unroll
            for (int r = 0; r < 4; ++r) { const int j = 16 * jt + 4 * g + r; const float e = __expf(ga4[r] - Mt) * st[jt][r]; v4[r] = (j <= tl) ? e : 0.f; rs += v4[r]; }
            ap[jt * 2] = pk2(v4[0], v4[1]); ap[jt * 2 + 1] = pk2(v4[2], v4[3]); }
        rs = sum16(rs); rs = sum32(rs);
        float qn = 0.f;
#pragma unroll
        for (int ks = 0; ks < 4; ++ks) { const f32x4 n0 = *(const LAS f32x4*)(nl + 32 * ks + 8 * g), n1 = *(const LAS f32x4*)(nl + 32 * ks + 8 * g + 4);
#pragma unroll
            for (int e = 0; e < 4; ++e) { qn += bf2f((bf16_t)qf[ks][e]) * n0[e]; qn += bf2f((bf16_t)qf[ks][4 + e]) * n1[e]; } }
        qn = sum16(qn); qn = sum32(qn);
        if (vh == 0 && g == 0) { rsl[tl] = rs; qnl[tl] = qn; }
        f32x4 av[2], qc[2];
#pragma unroll
        for (int vt = 0; vt < 2; ++vt) { av[vt] = (f32x4){0.f, 0.f, 0.f, 0.f}; qc[vt] = (f32x4){0.f, 0.f, 0.f, 0.f}; }
        {   const unsigned vb = (unsigned)(unsigned long)(lds + OFF_V) + trl16 + (unsigned)(4 * g * VP + (32 * vh) * 2);
            const unsigned cb = (unsigned)(unsigned long)(lds + OFF_CB) + trl16 + (unsigned)(8 * g * VP + (32 * vh) * 2);
            s16x4 va[2][2][2], ca[4][2][2];
#pragma unroll
            for (int vt = 0; vt < 2; ++vt) {
                if (vt == 0) { va[0][0][0] = tr_read<0 * VP>(vb); va[0][0][1] = tr_read<16 * VP>(vb); va[1][0][0] = tr_read<32 * VP>(vb); va[1][0][1] = tr_read<48 * VP>(vb);
                    ca[0][0][0] = tr_read<0 * VP>(cb); ca[0][0][1] = tr_read<4 * VP>(cb); ca[1][0][0] = tr_read<32 * VP>(cb); ca[1][0][1] = tr_read<36 * VP>(cb);
                    ca[2][0][0] = tr_read<64 * VP>(cb); ca[2][0][1] = tr_read<68 * VP>(cb); ca[3][0][0] = tr_read<96 * VP>(cb); ca[3][0][1] = tr_read<100 * VP>(cb); }
                else { va[0][1][0] = tr_read<0 * VP + 32>(vb); va[0][1][1] = tr_read<16 * VP + 32>(vb); va[1][1][0] = tr_read<32 * VP + 32>(vb); va[1][1][1] = tr_read<48 * VP + 32>(vb);
                    ca[0][1][0] = tr_read<0 * VP + 32>(cb); ca[0][1][1] = tr_read<4 * VP + 32>(cb); ca[1][1][0] = tr_read<32 * VP + 32>(cb); ca[1][1][1] = tr_read<36 * VP + 32>(cb);
                    ca[2][1][0] = tr_read<64 * VP + 32>(cb); ca[2][1][1] = tr_read<68 * VP + 32>(cb); ca[3][1][0] = tr_read<96 * VP + 32>(cb); ca[3][1][1] = tr_read<100 * VP + 32>(cb); } }
            asm volatile("s_waitcnt lgkmcnt(0)" ::: "memory"); __builtin_amdgcn_sched_barrier(0);
#pragma unroll
            for (int vt = 0; vt < 2; ++vt) {
#pragma unroll
                for (int pp = 0; pp < 2; ++pp) { const bf16x8 bfv = (bf16x8){va[pp][vt][0][0], va[pp][vt][0][1], va[pp][vt][0][2], va[pp][vt][0][3], va[pp][vt][1][0], va[pp][vt][1][1], va[pp][vt][1][2], va[pp][vt][1][3]};
                    const u32x4_t aw = (u32x4_t){ap[4 * pp], ap[4 * pp + 1], ap[4 * pp + 2], ap[4 * pp + 3]};
                    av[vt] = __builtin_amdgcn_mfma_f32_16x16x32_bf16(__builtin_bit_cast(bf16x8, aw), bfv, av[vt], 0, 0, 0); }
#pragma unroll
                for (int ks = 0; ks < 4; ++ks) { const bf16x8 bfc = (bf16x8){ca[ks][vt][0][0], ca[ks][vt][0][1], ca[ks][vt][0][2], ca[ks][vt][0][3], ca[ks][vt][1][0], ca[ks][vt][1][1], ca[ks][vt][1][2], ca[ks][vt][1][3]};
                    qc[vt] = __builtin_amdgcn_mfma_f32_16x16x32_bf16(qf[ks], bfc, qc[vt], 0, 0, 0); } }
        }
        const float M63 = fmaxf(mprev, gam[c0 + 63]); const float decay = __expf(mprev - M63);
        {   const unsigned kb = (unsigned)(unsigned long)(lds + OFF_K) + trl32k + (unsigned)(8 * hi * QP + (32 * dt) * 2);
            const unsigned wb = (unsigned)(unsigned long)(lds + OFF_WV) + trl32v + (unsigned)(8 * hi * VP + (32 * vt2) * 2);
            s16x4 ka[4][2], wa[4][2];
            ka[0][0] = tr_read<0 * QP>(kb); ka[0][1] = tr_read<4 * QP>(kb); ka[1][0] = tr_read<16 * QP>(kb); ka[1][1] = tr_read<20 * QP>(kb);
            ka[2][0] = tr_read<32 * QP>(kb); ka[2][1] = tr_read<36 * QP>(kb); ka[3][0] = tr_read<48 * QP>(kb); ka[3][1] = tr_read<52 * QP>(kb);
            wa[0][0] = tr_read<0 * VP>(wb); wa[0][1] = tr_read<4 * VP>(wb); wa[1][0] = tr_read<16 * VP>(wb); wa[1][1] = tr_read<20 * VP>(wb);
            wa[2][0] = tr_read<32 * VP>(wb); wa[2][1] = tr_read<36 * VP>(wb); wa[3][0] = tr_read<48 * VP>(wb); wa[3][1] = tr_read<52 * VP>(wb);
            asm volatile("s_waitcnt lgkmcnt(0)" ::: "memory"); __builtin_amdgcn_sched_barrier(0);
#pragma unroll
            for (int e = 0; e < 16; ++e) cacc[e] *= decay;
#pragma unroll
            for (int ks = 0; ks < 4; ++ks) { const bf16x8 fa = (bf16x8){ka[ks][0][0], ka[ks][0][1], ka[ks][0][2], ka[ks][0][3], ka[ks][1][0], ka[ks][1][1], ka[ks][1][2], ka[ks][1][3]};
                const bf16x8 fb = (bf16x8){wa[ks][0][0], wa[ks][0][1], wa[ks][0][2], wa[ks][0][3], wa[ks][1][0], wa[ks][1][1], wa[ks][1][2], wa[ks][1][3]};
                cacc = __builtin_amdgcn_mfma_f32_32x32x16_bf16(fa, fb, cacc, 0, 0, 0); } }
        { const int d_ = tid & 127, part_ = tid >> 7; float acc = 0.f;
#pragma unroll
            for (int s = 0; s < 16; ++s) acc += wl[16 * part_ + s] * bf2f(*(const LAS bf16_t*)(lds + OFF_K + (16 * part_ + s) * QP + d_ * 2));
            ((LAS float*)(lds + LDS_CONST))[part_ * 128 + d_] = acc; }
        if (ck < 24) { PREP_WRITE(); if (ck + 1 < 24) PREP_LOAD(ck + 1); }
        __syncthreads();
        if (ck < 24) PREP_STORE(ck);
        { const int tr0 = 16 * tt + 4 * g;
          const f32x4 gam4 = *(const LAS f32x4*)(gam + c0 + tr0), gb4 = *(const LAS f32x4*)(gb + c0 + tr0), rs4 = *(const LAS f32x4*)(rsl + tr0), qn4 = *(const LAS f32x4*)(qnl + tr0);
          bf16_t* hp = hs_out + (size_t)(c0 + tr0) * hs_stride;
#pragma unroll
          for (int r = 0; r < 4; ++r) { const float Mr = fmaxf(mprev, gam4[r]); const float inter = __expf(mprev - Mr), mt = gb4[r] + Mr;
            const float den = rs4[r] + inter * qn4[r]; const float dd = __builtin_amdgcn_rcpf(fmaxf(fabsf(den), __expf(-mt)));
#pragma unroll
            for (int vt = 0; vt < 2; ++vt) { const float hv = (av[vt][r] + inter * qc[vt][r]) * dd; hp[(size_t)r * hs_stride + 16 * vt] = f2bf(hv); } } }
#pragma unroll
        for (int e = 0; e < 16; ++e) { const int d = 32 * dt + (e & 3) + 8 * (e >> 2) + 4 * hi; *(LAS bf16_t*)(lds + OFF_CB + d * VP + (32 * vt2 + r32) * 2) = f2bf(cacc[e]); }
        if (tid < 128) { const LAS float* np_ = (const LAS float*)(lds + LDS_CONST); nreg = decay * nreg + ((np_[tid] + np_[128 + tid]) + (np_[256 + tid] + np_[384 + tid])); nl[tid] = nreg; }
        if (ck + 1 < 32) ML_STORE(ck + 1);
        __syncthreads();
    }
#undef ML_LOAD
#undef ML_STORE
#undef PREP_LOAD
#undef PREP_WRITE
#undef PREP_STORE
}

__device__ __forceinline__ void phase_ml_gate(const Params& p, const Frame& F, unsigned char* a8) {
    const int step = F.G * 8;
#pragma unroll 1
    for (int gw = F.bid * 8 + F.wave; gw < T * 4; gw += 4 * step) { uint2 hv2[4]; unsigned ov[4];
#pragma unroll
        for (int k = 0; k < 4; ++k) { const int g_ = gw + k * step; const bf16_t* pr = p.proj + (size_t)(g_ >> 2) * 3072 + (g_ & 3) * 256 + 4 * F.lane; hv2[k] = *(const uint2*)(pr + 1024); ov[k] = *(const unsigned*)((const unsigned char*)(p.proj + (size_t)(g_ >> 2) * 3072 + 2048) + (g_ & 3) * 256 + 4 * F.lane); }
#pragma unroll
        for (int k = 0; k < 4; ++k) { const int g_ = gw + k * step, t = g_ >> 2, h = g_ & 3; const float4 g4 = *(const float4*)(p.ml_ng + h * 256 + 4 * F.lane);
            const float h0 = __uint_as_float(hv2[k].x << 16), h1 = __uint_as_float(hv2[k].x & 0xFFFF0000u), h2 = __uint_as_float(hv2[k].y << 16), h3 = __uint_as_float(hv2[k].y & 0xFFFF0000u);
            float ss = h0 * h0 + h1 * h1 + h2 * h2 + h3 * h3; ss = wave_sum(ss); const float rs = rsqrtf(ss * (1.f / 256.f) + 1e-6f) * (F8_SA / 256.f);
            *(unsigned*)(a8 + (size_t)t * D + h * 256 + 4 * F.lane) = pk4_fp8(fp8f(ov[k], 0) * h0 * rs * g4.x, fp8f(ov[k], 1) * h1 * rs * g4.y, fp8f(ov[k], 2) * h2 * rs * g4.z, fp8f(ov[k], 3) * h3 * rs * g4.w); } }
}
__device__ __forceinline__ void phase_final(const Params& p, const Frame& F, float* dst) {
    const float* mg = p.mod + (size_t)16 * 6144 + 5 * D;
    for (size_t i4 = (size_t)F.bid * NTHR + F.tid; i4 < (size_t)T * D / 4; i4 += (size_t)F.G * NTHR) { const size_t i = i4 * 4; const int col = (int)(i % D), row = (int)(i / D), b = row / S;
        const uint2 xw = *(const uint2*)(p.xb13 + i); const float4 xv = make_float4(__uint_as_float(xw.x << 16), __uint_as_float(xw.x & 0xFFFF0000u), __uint_as_float(xw.y << 16), __uint_as_float(xw.y & 0xFFFF0000u)); float4 g = *(const float4*)(mg + b * 6144 + col); g.x *= 1.f / F8_SO; g.y *= 1.f / F8_SO; g.z *= 1.f / F8_SO; g.w *= 1.f / F8_SO; const unsigned a0 = *(const unsigned*)((const unsigned char*)p.outk + i), a1 = *(const unsigned*)((const unsigned char*)p.outk + (size_t)T * D + i);
        float4 o; o.x = xv.x + g.x * (fp8f(a0, 0) + fp8f(a1, 0)); o.y = xv.y + g.y * (fp8f(a0, 1) + fp8f(a1, 1));
        o.z = xv.z + g.z * (fp8f(a0, 2) + fp8f(a1, 2)); o.w = xv.w + g.w * (fp8f(a0, 3) + fp8f(a1, 3));
        *(float4*)(dst + i) = o; }
}

__global__ void __launch_bounds__(NTHR, 2) mega_fwd(Params p) {
    extern __shared__ __attribute__((aligned(16))) unsigned char lds_raw[];
    Frame F; F.lds = (LAS unsigned char*)lds_raw; F.tid = threadIdx.x; F.lane = F.tid & 63; F.wave = __builtin_amdgcn_readfirstlane(F.tid >> 6); F.bid = blockIdx.x; F.G = gridDim.x;
    volatile LAS unsigned* misc = (volatile LAS unsigned*)(F.lds + LDS_MISC);
    LAS Params* P = (LAS Params*)(F.lds + LDS_PARAMS);
    if (F.tid < 16) misc[F.tid] = 0u;
    if (F.tid == 64) {
#define X(t, n) P->n = p.n;
        PARAM_LIST(X)
#undef X
    }
    __syncthreads();
    { XcdBarrier b0 = xcd_barrier_post(uni_ptr(P->bar), misc); if (F.tid == 0) misc[2] = b0.x; }
    __syncthreads();
#define GRID_BAR() do { XcdBarrier bb_; bb_.bar = uni_ptr(P->bar); bb_.x = (unsigned)__builtin_amdgcn_readfirstlane((int)misc[2]); bb_.st = misc; xcd_barrier(bb_, F.wave == 0 && lane_id_asm() == 0); } while (0)
    LAS unsigned char* stage = F.lds;
#define MOD0 (q.mod)
#define MOD1 (q.mod + (size_t)16 * 6144)

    { Params q; LP(rope); LP(h); phase_prologue_a(q, launder(F)); }
    { Params q; LP(c); LP(ada_w); LP(ada_b); LP(mod); LP(cmp_pe); LP(cmp_w1); LP(cmp_b1); LP(cb1); phase_prologue_b(q, launder(F)); }
    { Params q; LP(nsa_w_in); LP(win_nsa_t); prep_weights<true>(launder(F), q.win_nsa_t, 2048, D, NSA_COLS, ColPlain{q.nsa_w_in, NSA_COLS, 0}, F.bid, F.G, F8_SW); }
    { Params q; LP(nsa_w_out); LP(wo_nsa_t); prep_weights<true>(launder(F), q.wo_nsa_t, D, D, D, ColPlain{q.nsa_w_out, D, 0}, F.bid, F.G, F8_SW); }
    { Params q; LP(ml_w_in); LP(win_ml_t); prep_weights<true>(launder(F), q.win_ml_t, 3072, D, ML_COLS, ColPlain{q.ml_w_in, 3072, 0}, F.bid, F.G, F8_SW); }
    { Params q; LP(ml_w_out); LP(wo_ml_t); prep_weights<true>(launder(F), q.wo_ml_t, D, D, D, ColPlain{q.ml_w_out, D, 0}, F.bid, F.G, F8_SW); }
    { Params q; LP(cmp_w1); LP(w1c_t); prep_weights(launder(F), q.w1c_t, 256, 2048, 256, ColPlain{q.cmp_w1, 256, 0}, F.bid, F.G);
      prep_weights(launder(F), q.w1c_t + (size_t)256 * 2048, 256, 2048, 256, ColPlain{q.cmp_w1 + (size_t)2048 * 256, 256, 0}, F.bid, F.G); }
    { Params q; LP(w_gate); LP(w_up); LP(w_down); LP(gu_t); LP(dn_t); prep_moe_weights(q, launder(F), 0, F.bid, F.G); }
    GRID_BAR();
    { Params q; LP(x); LP(g_mix); LP(mod); LP(h);
      phase_norm<0, false>(q, launder(F), q.x, nullptr, q.g_mix, MOD0 + 0 * D, MOD0 + 1 * D, nullptr, 0); }
    GRID_BAR();
    { Params q; LP(h); LP(win_nsa_t); LP(q_gain); LP(k_gain); LP(rope); LP(q); LP(kv); LP(gates);
      ge::DenseOrder So; So.init(T, 2048, F.G, F.bid);
      ge::gemm_phase<true>(stage, q.h, q.win_nsa_t, D, So, ge::DenseRows{(unsigned)D}, EpiNsaIn{q.q_gain, q.k_gain, q.rope, q.q, q.kv, q.gates, 1.f / (F8_SA * F8_SW)}, F.wave); }
    GRID_BAR();
    {
      Params q; LP(kv); LP(w1c_t); LP(cpart);
      const int w = F.bid >> 7, mt = (F.bid >> 3) & 15, ks = F.bid & 7; OneUnit So{mt};
      ge::gemm_phase(stage, q.kv + (size_t)w * T * 128 + ks * 256, q.w1c_t + (size_t)w * 256 * 2048 + ks * 256, 256, So, ge::DenseRows{2048u}, EpiCmpPart{(float*)((bf16_t*)q.cpart + (size_t)(w * 8 + ks) * 4096 * 256)}, F.wave, 2048); }
    GRID_BAR();
    { Params q; LP(cpart); LP(cb1); LP(cmp_w2); LP(cmp_b2); LP(k_gain); LP(rope); LP(kcmp); LP(vcmp);
      phase_cmp2(q, launder(F)); }
    GRID_BAR();
    { Params q; LP(q); LP(kv); LP(kcmp); LP(vcmp); LP(gates); LP(h); LP(q_gain); LP(k_gain);
      phase_attn(q, launder(F)); }
    GRID_BAR();
    { Params q; LP(h); LP(wo_nsa_t); LP(x); LP(mod); LP(xb13);
      ge::DenseOrder So; So.init(T, D, F.G, F.bid);
      ge::gemm_phase<true>(stage, q.h, q.wo_nsa_t, D, So, ge::DenseRows{(unsigned)D}, EpiResid<false>{q.x, MOD0 + 2 * D, q.xb13, 1.f / (F8_SA * F8_SW)}, F.wave); }
    GRID_BAR();
    { Params q; LP(xb13); LP(g_ffn); LP(mod); LP(h); LP(router_w); LP(router_b); LP(tokw); LP(cnt); LP(list);
      phase_norm_route(q, launder(F), q.xb13, q.g_ffn, MOD0 + 3 * D, MOD0 + 4 * D, 0); }
    GRID_BAR();
    { Params q; LP(cnt); LP(list); LP(h); LP(gu_t); LP(hid);
      LAS int* mtab = (LAS int*)(F.lds + LDS_MISC + 64); LAS int* tkt = (LAS int*)(F.lds + LDS_CONST); moe_plan(launder(F), q.cnt, q.list, mtab, tkt, 4); MoeOrder So{mtab};
      ge::gemm_phase<true>(stage, q.h, q.gu_t, D, So, MoeRows{tkt}, EpiMoe1{(unsigned char*)q.hid, 1.f / (F8_SA * F8_SW)}, F.wave); }
    GRID_BAR();
    { Params q; LP(cnt); LP(list); LP(hid); LP(dn_t); LP(outk); LP(tokw);
      LAS int* mtab = (LAS int*)(F.lds + LDS_MISC + 64); LAS int* tkt = (LAS int*)(F.lds + LDS_CONST); LAS float* tkw = (LAS float*)(F.lds + 131072); moe_plan(launder(F), q.cnt, q.list, mtab, tkt, 4, q.tokw, tkw, F8_SO / (F8_SH * F8_SW2)); MoeOrder So{mtab};
      ge::gemm_phase<true>(stage, q.hid, q.dn_t, DE, So, ge::DenseRows{(unsigned)DE}, EpiMoe2{q.outk, tkt, tkw}, F.wave); }
    GRID_BAR();
    { Params q; LP(xb13); LP(xb2); LP(g_mix); LP(mod); LP(h); LP(outk); LP(ml_w_in); LP(ml_bi); LP(ml_bf); LP(li); LP(lf);
      phase_norm<2, true>(q, launder(F), q.xb13, q.xb2, q.g_mix + D, MOD1 + 0 * D, MOD1 + 1 * D, MOD0 + 5 * D, 1); }
    GRID_BAR();
    { Params q; LP(h); LP(win_ml_t); LP(proj);
      ge::DenseOrder So; So.init(T, 3072, F.G, F.bid);
      ge::gemm_phase<true>(stage, q.h, q.win_ml_t, D, So, ge::DenseRows{(unsigned)D}, EpiMlIn{q.proj, 1.f / (F8_SA * F8_SW)}, F.wave); }
    GRID_BAR();
    { Params q; LP(proj); LP(li); LP(lf); LP(w_gate); LP(w_up); LP(w_down); LP(gu_t); LP(dn_t);
      phase_scan(q, launder(F), q.proj + 1024, 3072); }
    GRID_BAR();
    { Params q; LP(proj); LP(ml_ng); LP(h);
      phase_ml_gate(q, launder(F), (unsigned char*)q.h); }
    GRID_BAR();
    { Params q; LP(h); LP(wo_ml_t); LP(xb2); LP(mod); LP(xb13);
      ge::DenseOrder So; So.init(T, D, F.G, F.bid);
      ge::gemm_phase<true>(stage, q.h, q.wo_ml_t, D, So, ge::DenseRows{(unsigned)D}, EpiResid<true>{q.xb2, MOD1 + 2 * D, q.xb13, 1.f / (F8_SA * F8_SW)}, F.wave); }
    GRID_BAR();
    { Params q; LP(xb13); LP(g_ffn); LP(mod); LP(h); LP(router_w); LP(router_b); LP(tokw); LP(cnt); LP(list);
      phase_norm_route(q, launder(F), q.xb13, q.g_ffn + D, MOD1 + 3 * D, MOD1 + 4 * D, 1); }
    GRID_BAR();
    { Params q; LP(cnt); LP(list); LP(h); LP(gu_t); LP(hid);
      LAS int* mtab = (LAS int*)(F.lds + LDS_MISC + 64); LAS int* tkt = (LAS int*)(F.lds + LDS_CONST); moe_plan(launder(F), q.cnt + 64, q.list, mtab, tkt, 4); MoeOrder So{mtab};
      ge::gemm_phase<true>(stage, q.h, q.gu_t, D, So, MoeRows{tkt}, EpiMoe1{(unsigned char*)q.hid, 1.f / (F8_SA * F8_SW)}, F.wave); }
    GRID_BAR();
    { Params q; LP(cnt); LP(list); LP(hid); LP(dn_t); LP(outk); LP(tokw);
      LAS int* mtab = (LAS int*)(F.lds + LDS_MISC + 64); LAS int* tkt = (LAS int*)(F.lds + LDS_CONST); LAS float* tkw = (LAS float*)(F.lds + 131072); moe_plan(launder(F), q.cnt + 64, q.list, mtab, tkt, 4, q.tokw, tkw, F8_SO / (F8_SH * F8_SW2)); MoeOrder So{mtab};
      ge::gemm_phase<true>(stage, q.hid, q.dn_t, DE, So, ge::DenseRows{(unsigned)DE}, EpiMoe2{q.outk, tkt, tkw}, F.wave); }
    GRID_BAR();
    { Params q; LP(mod); LP(out); LP(outk); LP(xb13);
      phase_final(q, launder(F), q.out); }
}

static inline size_t al(size_t x) { return (x + 255) & ~(size_t)255; }
extern "C" void kernel_launch(void* const* d_in, const int* in_sizes, int n_in, void* d_out, int out_size, void* d_ws, size_t ws_size, hipStream_t stream) {
    char* ws = (char*)d_ws; size_t off = 0;
    auto take = [&](size_t bytes) { size_t o = off; off = al(off + bytes); return o; };
    Params p{};
    const float** pin = (const float**)&p;
    for (int i = 0; i < 25; ++i) pin[i] = (const float*)d_in[i];
    p.out = (float*)d_out;
    const size_t ctl_bytes = (size_t)XCD_BAR_WORDS * 4 + 1024;
    p.bar = (unsigned*)(ws + take(ctl_bytes)); p.cnt = (int*)(p.bar + XCD_BAR_WORDS); p.dcnt = p.cnt + 128;
    p.mod = (float*)(ws + take((size_t)2 * 16 * 6144 * 4)); p.rope = (float*)(ws + take(2048 * 16 * 4)); p.cb1 = (float*)(ws + take(512 * 4));
    p.tokw = (float*)(ws + take((size_t)T * 2 * 4)); p.list = (int*)(ws + take((size_t)NE * T * 4)); p.dlist = (int*)(ws + take((size_t)NE * T * 4)); p.li = (float*)(ws + take((size_t)T * 4 * 4)); p.lf = (float*)(ws + take((size_t)T * 4 * 4));
    p.h = (bf16_t*)(ws + take((size_t)(T + 8) * D * 2)); p.hidc = (bf16_t*)(ws + take((size_t)2 * 4096 * 256 * 2)); p.xb13 = (bf16_t*)(ws + take((size_t)T * D * 2)); p.xb2 = (bf16_t*)(ws + take((size_t)T * D * 2));
    p.wo_nsa_t = (bf16_t*)(ws + take((size_t)D * D * 2)); p.wo_ml_t = (bf16_t*)(ws + take((size_t)D * D * 2));
    p.win_nsa_t = (bf16_t*)(ws + take((size_t)2048 * D * 2)); p.win_ml_t = (bf16_t*)(ws + take((size_t)3072 * D * 2)); p.w1c_t = (bf16_t*)(ws + take((size_t)2 * 256 * 2048 * 2));
    p.gu_t = (bf16_t*)(ws + take((size_t)NE * 1024 * D * 2)); p.dn_t = (bf16_t*)(ws + take((size_t)NE * D * DE * 2));
    const size_t r1 = off;
    p.q = (bf16_t*)(ws + take((size_t)T * D * 2)); p.kv = (bf16_t*)(ws + take((size_t)6 * T * 128 * 2 + (1 << 20)));
    p.gates = (float*)(ws + take((size_t)T * 48 * 4)); p.kcmp = (bf16_t*)(ws + take((size_t)32 * 128 * 64 * 2)); p.vcmp = (bf16_t*)(ws + take((size_t)32 * 128 * 64 * 2));
    p.cpart = (float*)(ws + take((size_t)2 * 8 * 4096 * 256 * 4));
    const size_t end_nsa = off; off = r1;
    p.proj = (bf16_t*)(ws + take((size_t)T * 3072 * 2)); const size_t end_ml = off; off = r1;
    p.hid = (bf16_t*)(ws + take((size_t)(65536 + 8192) * DE * 2)); p.outk = (bf16_t*)(ws + take((size_t)2 * T * D * 2)); const size_t end_moe = off;
    size_t need = end_nsa > end_ml ? end_nsa : end_ml; if (end_moe > need) need = end_moe;
    if (need > ws_size || n_in != 25) return;
    static bool attr_done = false;
    if (!attr_done) { (void)hipFuncSetAttribute((const void*)mega_fwd, hipFuncAttributeMaxDynamicSharedMemorySize, LDS_BYTES); attr_done = true; }
    (void)hipMemsetAsync(p.bar, 0, ctl_bytes, stream);
    hipLaunchKernelGGL(mega_fwd, dim3(NWG), dim3(NTHR), LDS_BYTES, stream, p);
}
```

```cpp
#include <hip/hip_runtime.h>
#include <stdint.h>

typedef unsigned short bf16_t;
__device__ __forceinline__ float bf2f(bf16_t v) { return __uint_as_float(((unsigned)v) << 16); }
typedef float f32x2_t __attribute__((ext_vector_type(2)));
__device__ __forceinline__ unsigned pk2g(float a, float b) { typedef __bf16 b2 __attribute__((ext_vector_type(2))); b2 r = __builtin_convertvector((f32x2_t){a, b}, b2); return __builtin_bit_cast(unsigned, r); }
__device__ __forceinline__ bf16_t f2bf(float f) { return (bf16_t)pk2g(f, f); }
__device__ __forceinline__ unsigned pk4_fp8(float a, float b, float c, float d) { int w = 0;
    w = __builtin_amdgcn_cvt_pk_fp8_f32(__builtin_amdgcn_fmed3f(a, -448.f, 448.f), __builtin_amdgcn_fmed3f(b, -448.f, 448.f), w, false);
    w = __builtin_amdgcn_cvt_pk_fp8_f32(__builtin_amdgcn_fmed3f(c, -448.f, 448.f), __builtin_amdgcn_fmed3f(d, -448.f, 448.f), w, true); return (unsigned)w; }

constexpr int Bn = 16, S = 2048, D = 1024, T = Bn * S;
constexpr int NSA_COLS = 1840, ML_COLS = 3080;
constexpr int NE = 32, DE = 512;
constexpr int NWG = 256, NTHR = 512;

template <int M> __device__ __forceinline__ float sx(float v) { return __int_as_float(__builtin_amdgcn_ds_swizzle(__float_as_int(v), (M << 10) | 0x1F)); }
template <int M> __device__ __forceinline__ unsigned sxu(unsigned v) { return (unsigned)__builtin_amdgcn_ds_swizzle((int)v, (M << 10) | 0x1F); }
__device__ __forceinline__ float sum32(float v) { const auto r = __builtin_amdgcn_permlane32_swap(__float_as_uint(v), __float_as_uint(v), false, false); return __uint_as_float(r[0]) + __uint_as_float(r[1]); }
__device__ __forceinline__ float max32(float v) { const auto r = __builtin_amdgcn_permlane32_swap(__float_as_uint(v), __float_as_uint(v), false, false); return fmaxf(__uint_as_float(r[0]), __uint_as_float(r[1])); }
__device__ __forceinline__ float other32(float v, bool hi) { const auto r = __builtin_amdgcn_permlane32_swap(__float_as_uint(v), __float_as_uint(v), false, false); return __uint_as_float(hi ? r[0] : r[1]); }
template <int CTRL> __device__ __forceinline__ float dppf(float v) { return __int_as_float(__builtin_amdgcn_update_dpp(0, __float_as_int(v), CTRL, 0xF, 0xF, true)); }
__device__ __forceinline__ float sum16(float v) { const auto r = __builtin_amdgcn_permlane16_swap(__float_as_uint(v), __float_as_uint(v), false, false); return __uint_as_float(r[0]) + __uint_as_float(r[1]); }
__device__ __forceinline__ float max16(float v) { const auto r = __builtin_amdgcn_permlane16_swap(__float_as_uint(v), __float_as_uint(v), false, false); return fmaxf(__uint_as_float(r[0]), __uint_as_float(r[1])); }
__device__ __forceinline__ float wave_sum(float v) { v += dppf<0xB1>(v); v += dppf<0x4E>(v); v += dppf<0x141>(v); v += dppf<0x140>(v); v = sum16(v); return sum32(v); }
__device__ __forceinline__ float wave_max(float v) { v = fmaxf(v, dppf<0xB1>(v)); v = fmaxf(v, dppf<0x4E>(v)); v = fmaxf(v, dppf<0x141>(v)); v = fmaxf(v, dppf<0x140>(v)); v = max16(v); return max32(v); }
__device__ __forceinline__ float rdlane(float v, int l) { return __int_as_float(__builtin_amdgcn_readlane(__float_as_int(v), l)); }
__device__ __forceinline__ float sigmoidf_(float x) { return 1.f / (1.f + expf(-x)); }
__device__ __forceinline__ float fsigmoid(float x) { return __builtin_amdgcn_rcpf(1.f + __builtin_amdgcn_exp2f(-1.4426950408889634f * x)); }
__device__ __forceinline__ float ftanh(float x) { return 1.f - 2.f * __builtin_amdgcn_rcpf(1.f + __builtin_amdgcn_exp2f(2.8853900817779268f * x)); }

#define XB_TMO      128
#define XB_XCNT(j)  (256  + 64 * (j))
#define XB_XSUB(j)  (1280 + 64 * (j))
#define XB_XGEN(j)  (2304 + 64 * (j))
#define XB_TOP      3328
#define XB_TOPGEN   3392
#define XCD_BAR_WORDS 3456
#define XB_SPIN_CAP (1u << 18)
#define LAS __attribute__((address_space(3)))
__device__ __forceinline__ unsigned xb_ld(unsigned* p)              { return __hip_atomic_load(p, __ATOMIC_RELAXED, __HIP_MEMORY_SCOPE_AGENT); }
__device__ __forceinline__ unsigned xb_add(unsigned* p, unsigned v) { return __hip_atomic_fetch_add(p, v, __ATOMIC_RELAXED, __HIP_MEMORY_SCOPE_AGENT); }
__device__ __forceinline__ unsigned xb_xcc_id() { return (unsigned)__builtin_amdgcn_s_getreg((3 << 11) | 20) & 0xFu; }
#define XB_SPIN(cond, bar) do { unsigned _sp = 0; while (cond) { __builtin_amdgcn_s_sleep(1); \
    if ((++_sp & 255u) == 0u) { if (xb_ld(&(bar)[XB_TMO])) break; if (_sp > XB_SPIN_CAP) { atomicAdd(&(bar)[XB_TMO], 1u); break; } } } } while (0)
struct XcdBarrier { unsigned* bar; unsigned x; volatile LAS unsigned* st; };
__device__ __forceinline__ XcdBarrier xcd_barrier_post(unsigned* bar, volatile LAS unsigned* st) {
    XcdBarrier b; b.bar = bar; b.x = xb_xcc_id(); b.st = st;
    if (threadIdx.x == 0) (void)xb_add(&bar[XB_XCNT(b.x)], 1u);
    return b;
}
__device__ __forceinline__ void xcd_barrier_complete(unsigned* bar, unsigned x, unsigned& nloc, unsigned& nx) {
    const unsigned G = gridDim.x * gridDim.y * gridDim.z;
    unsigned sum, cnt, mine, sp = 0u;
    for (;;) {
        sum = 0u; cnt = 0u; mine = 0u;
#pragma unroll
        for (unsigned j = 0; j < 16; ++j) { const unsigned c = xb_ld(&bar[XB_XCNT(j)]); sum += c; cnt += (c > 0u) ? 1u : 0u; mine = (j == x) ? c : mine; }
        if (sum == G) break;
        __builtin_amdgcn_s_sleep(1);
        if ((++sp & 255u) == 0u) { if (xb_ld(&bar[XB_TMO])) break; if (sp > XB_SPIN_CAP) { atomicAdd(&bar[XB_TMO], 1u); break; } }
    }
    nloc = mine > 0u ? mine : 1u; nx = cnt > 0u ? cnt : 1u;
}
__device__ __forceinline__ void xcd_barrier(const XcdBarrier& b, const bool leader  ) {
    asm volatile("s_waitcnt vmcnt(0)" ::: "memory");
    __syncthreads();
    if (leader) {
        unsigned* bar = b.bar;
        __builtin_amdgcn_s_waitcnt(0);
        unsigned nloc = b.st[0], nx = b.st[1];
        if (nloc == 0u) { xcd_barrier_complete(bar, b.x, nloc, nx); b.st[0] = nloc; b.st[1] = nx; }
        const unsigned old = xb_add(&bar[XB_XSUB(b.x)], 1u);
        const unsigned gen = old / nloc;
        if (old + 1u == (gen + 1u) * nloc) {
            __builtin_amdgcn_fence(__ATOMIC_RELEASE, "agent");
            asm volatile("s_waitcnt vmcnt(0)" ::: "memory");
            const unsigned og = xb_add(&bar[XB_TOP], 1u);
            const unsigned tg = og / nx;
            if (og + 1u == (tg + 1u) * nx) xb_add(&bar[XB_TOPGEN], 1u);
            else XB_SPIN(xb_ld(&bar[XB_TOPGEN]) == tg, bar);
            __builtin_amdgcn_fence(__ATOMIC_ACQUIRE, "agent");
            xb_add(&bar[XB_XGEN(b.x)], 1u);
            asm volatile("s_waitcnt vmcnt(0)" ::: "memory");
        } else {
            XB_SPIN(xb_ld(&bar[XB_XGEN(b.x)]) == gen, bar);
            __builtin_amdgcn_fence(__ATOMIC_ACQUIRE, "agent");
            asm volatile("s_waitcnt vmcnt(0)" ::: "memory");
        }
    }
    __syncthreads();
}

typedef short bf16x8 __attribute__((ext_vector_type(8)));
typedef float f32x4 __attribute__((ext_vector_type(4)));
namespace ge {
constexpr int BM = 256, BK = 64, HALF = 128, HTB = HALF * BK * 2, STAGE_BYTES = 8 * HTB;
__host__ __device__ __forceinline__ int lds_byte(int r, int c) { const int st = (r >> 4) * 2 + (c >> 5), rr = r & 15, cc = c & 31, ob = rr * 64 + cc * 2; return st * 1024 + (ob ^ (((ob >> 9) & 1) << 5)); }
__host__ __device__ __forceinline__ void stage_rc(int b, int& R, int& C) { const int st = b / 1024, sb = b % 1024, swz = sb ^ (((sb >> 9) & 1) << 5); R = (st >> 1) * 16 + swz / 64; C = (st & 1) * 32 + (swz % 64) / 2; }
struct Unit { int pm, pn, bt, aux; };
__host__ __device__ __forceinline__ int logical_col(int c) { const int pn = c >> 8, bj = (c >> 7) & 1, wc = (c >> 5) & 3, n = (c >> 4) & 1, fq = (c >> 2) & 3, j = c & 3; return (4 * pn + wc) * 64 + 16 * fq + 8 * bj + 4 * n + j; }
struct DenseOrder {
    int nM, nN, nwg, G, c;
    __device__ void init(int M, int N, int G_, int c_) { nM = M / BM; nN = N / BM; nwg = nM * nN; G = G_; c = c_; }
    __device__ bool next(int i, Unit& u) const {
        const long L = (long)i * G + c; if (L >= nwg) return false;
        int wgid = (int)L; { const int q = nwg / 8, r = nwg % 8, xcd = wgid % 8, off = wgid / 8; wgid = (xcd < r ? xcd * (q + 1) : r * (q + 1) + (xcd - r) * q) + off; }
        const int nig = 8 * nN, gid = wgid / nig, fm = gid * 8, gsz = (nM - fm) < 8 ? (nM - fm) : 8;
        u.pm = fm + ((wgid % nig) % gsz); u.pn = (wgid % nig) / gsz; u.bt = u.pn; u.aux = 0; return true;
    }
};
struct DenseRows { static constexpr bool dense = true; unsigned ldab; __device__ __forceinline__ unsigned operator()(const Unit& u, int r) const { return (unsigned)(u.pm * 256 + r) * ldab; } };
template <class Tp> __device__ __forceinline__ Tp* uni(Tp* v) { const unsigned long long u = (unsigned long long)v; const unsigned lo = __builtin_amdgcn_readfirstlane((unsigned)u), hi = __builtin_amdgcn_readfirstlane((unsigned)(u >> 32)); return (Tp*)(((unsigned long long)hi << 32) | lo); }

typedef int i32x8 __attribute__((ext_vector_type(8)));
typedef int i32x4 __attribute__((ext_vector_type(4)));
template <bool F8> struct Frag;
template <> struct Frag<false> { bf16x8 v[2]; };
template <> struct Frag<true> { i32x8 v; };
template <bool F8> __device__ __forceinline__ void load_frag(Frag<F8>& f, const LAS unsigned char* p0, const int hx = 16) {
    if constexpr (F8) { const i32x4 lo = *(const LAS i32x4*)p0, hi = *(const LAS i32x4*)(p0 + hx); f.v = __builtin_shufflevector(lo, hi, 0, 1, 2, 3, 4, 5, 6, 7); }
    else { f.v[0] = *(const LAS bf16x8*)p0; f.v[1] = *(const LAS bf16x8*)(p0 + 1024); }
}
template <bool F8> __device__ __forceinline__ f32x4 mma_kt(const Frag<F8>& b, const Frag<F8>& a, f32x4 c) {
    if constexpr (F8) return __builtin_amdgcn_mfma_scale_f32_16x16x128_f8f6f4(b.v, a.v, c, 0, 0, 0, 0x7F7F7F7F, 0, 0x7F7F7F7F);
    else { c = __builtin_amdgcn_mfma_f32_16x16x32_bf16(b.v[0], a.v[0], c, 0, 0, 0); return __builtin_amdgcn_mfma_f32_16x16x32_bf16(b.v[1], a.v[1], c, 0, 0, 0); }
}
template <bool F8 = false, class Sched, class RowMap, class Epi>
__device__ __forceinline__ void gemm_phase(LAS unsigned char* lds, const void* A, const void* Bt, const int K, const Sched& S, const RowMap& RM, const Epi& E, const int wave_id, const int ldb_ = 0  ) {
    int tid_; asm volatile("v_mbcnt_lo_u32_b32 %0, -1, 0\n\tv_mbcnt_hi_u32_b32 %0, -1, %0" : "=v"(tid_)); tid_ += wave_id * 64;
    const int tid = tid_, wid = __builtin_amdgcn_readfirstlane(tid >> 6), lane = tid & 63, wr = wid >> 2, wc = wid & 3, fr = lane & 15, fq = lane >> 4;
    const int nt = K / (F8 ? 2 * BK : BK);
    constexpr bool DR = RowMap::dense;
    int sR[2], sC[2];
    const int ldb = ldb_ ? ldb_ : K;
#pragma unroll
    for (int i = 0; i < 2; ++i) stage_rc(tid * 16 + i * 8192, sR[i], sC[i]);
    const unsigned voffB = F8 ? (unsigned)(sR[0] * ldb + sC[0] * 2) : (unsigned)(sR[0] * ldb + sC[0]) * 2u;
    unsigned ldab_ = 0, voffA = 0; if constexpr (DR) { ldab_ = RM.ldab; voffA = (unsigned)sR[0] * ldab_ + (unsigned)sC[0] * 2u; }
    const size_t kstep = (size_t)(BK * 2), hstepB = (size_t)HALF * ldb * (F8 ? 1 : 2), tstepB = 2 * hstepB, qstepB = hstepB / 2;
    const unsigned ldsw = (unsigned)wid * 1024u;
    const int sw = (F8 && (fq & 1)) ? 16 : 0, hx = 16 - 2 * sw;
    const int aoff = lds_byte(wr * 64 + fr, fq * (F8 ? 16 : 8)) + sw, boff = lds_byte(wc * 32 + fr, fq * (F8 ? 16 : 8)) + sw;
    const char* Ab = (const char*)A;
#define GE_SA(b, h) (((b) * 2 + (h)) * ge::HTB)
#define GE_SB(b, h) ((4 + (b) * 2 + (h)) * ge::HTB)
#define GE_GLD(sp, vo, ldsoff) do { unsigned _v = (vo); asm volatile("" : "+v"(_v));     \
        __builtin_amdgcn_global_load_lds((const unsigned*)(uni((const char*)(sp)) + _v), (LAS unsigned*)(lds + (ldsoff)), 16, 0, 0); } while (0)
#define GE_STB(bufoff, gbase) do { _Pragma("unroll") for (int _i = 0; _i < 2; ++_i) GE_GLD((gbase) + _i * qstepB, voffB, (bufoff) + ldsw + _i * 8192); } while (0)
#define GE_STA(bufoff, sp, OFF, h) do { _Pragma("unroll") for (int _i = 0; _i < 2; ++_i) { \
        if constexpr (DR) GE_GLD((sp) + (size_t)((h) * 128 + _i * 64) * ldab_, voffA, (bufoff) + ldsw + _i * 8192); \
        else GE_GLD((sp), (OFF)[h][_i], (bufoff) + ldsw + _i * 8192); } } while (0)
#define GE_LDA(dst, b, h) do { _Pragma("unroll") for (int m = 0; m < 4; ++m) load_frag<F8>(dst[m], lds + GE_SA(b, h) + aoff + m * 2048, hx); } while (0)
#define GE_LDB(dst, b, h) do { _Pragma("unroll") for (int n = 0; n < 2; ++n) load_frag<F8>(dst[n], lds + GE_SB(b, h) + boff + n * 2048, hx); } while (0)
#define GE_MMA(ai, bj, At, Bt_) do { __builtin_amdgcn_s_setprio(1); _Pragma("unroll") for (int m = 0; m < 4; ++m) _Pragma("unroll") for (int n = 0; n < 2; ++n) \
        acc[ai][bj][m][n] = mma_kt<F8>(Bt_[n], At[m], acc[ai][bj][m][n]); __builtin_amdgcn_s_setprio(0); } while (0)
#define GE_WAIT_V(n) asm volatile("s_waitcnt vmcnt(" #n ")" ::: "memory")
#define GE_WAIT_L(n) asm volatile("s_waitcnt lgkmcnt(" #n ")" ::: "memory")
#define GE_BAR __builtin_amdgcn_s_barrier()
#define GE_SCHED __builtin_amdgcn_sched_barrier(0)
#define GE_OFFS(OFF, u) do { int _l; asm volatile("v_mbcnt_lo_u32_b32 %0, -1, 0\n\tv_mbcnt_hi_u32_b32 %0, -1, %0" : "=v"(_l)); int _r0, _c0; stage_rc((wave_id * 64 + _l) * 16, _r0, _c0);     \
        _Pragma("unroll") for (int _h = 0; _h < 2; ++_h) _Pragma("unroll") for (int _i = 0; _i < 2; ++_i) (OFF)[_h][_i] = RM((u), _h * 128 + _i * 64 + _r0) + (unsigned)_c0 * 2u; \
        asm volatile("" : "+v"((OFF)[0][0]), "+v"((OFF)[0][1]), "+v"((OFF)[1][0]), "+v"((OFF)[1][1])); } while (0)
    Unit cur, nxt; int ui = 0;
    if (!S.next(0, cur)) return;
    unsigned offC[2][2];
    const char* aC = Ab; const char* aN = Ab;
    if constexpr (DR) aC = Ab + (size_t)cur.pm * 256 * ldab_; else GE_OFFS(offC, cur);
    f32x4 acc[2][2][4][2];
#pragma unroll
    for (int a = 0; a < 2; ++a)
#pragma unroll
        for (int b = 0; b < 2; ++b)
#pragma unroll
            for (int m = 0; m < 4; ++m)
#pragma unroll
                for (int n = 0; n < 2; ++n) acc[a][b][m][n] = (f32x4){0.f, 0.f, 0.f, 0.f};
    Frag<F8> At[4], B0[2], B1[2];
    const char* cB = (const char*)Bt + (size_t)cur.bt * tstepB;
    GE_STB(GE_SB(0, 0), cB); GE_STA(GE_SA(0, 0), aC, offC, 0); GE_STB(GE_SB(0, 1), cB + hstepB); GE_STA(GE_SA(0, 1), aC, offC, 1);
    if (wr == 1) GE_BAR;
    GE_WAIT_V(4); GE_BAR;
    GE_STB(GE_SB(1, 0), cB + kstep); GE_STA(GE_SA(1, 0), aC + kstep, offC, 0); GE_STB(GE_SB(1, 1), cB + hstepB + kstep);
    GE_WAIT_V(6); GE_BAR;
    for (;;) {
        const bool has_next = S.next(ui + 1, nxt);
        if constexpr (DR) aN = has_next ? Ab + (size_t)nxt.pm * 256 * ldab_ : aC;
        const char* nB = has_next ? (const char*)Bt + (size_t)nxt.bt * tstepB : cB;
#pragma unroll 1
        for (int t = 0; t < nt; t += 2) {
            const bool last = (t == nt - 2);
            const size_t k1 = (size_t)(t + 1) * kstep;
            const size_t k2 = last ? 0 : (size_t)(t + 2) * kstep, k3 = k2 + kstep;
            const char* b2 = last ? nB : cB + (size_t)(t + 2) * kstep; const char* b3 = b2 + kstep;
            const char* a2 = last ? aN : aC;
            GE_LDB(B0, 0, 0); GE_SCHED; GE_LDA(At, 0, 0); GE_STA(GE_SA(1, 1), aC + k1, offC, 1);
            GE_WAIT_L(8); GE_BAR; GE_WAIT_L(0); GE_MMA(0, 0, At, B0); GE_BAR; GE_SCHED;
            GE_LDB(B1, 0, 1); GE_STB(GE_SB(0, 0), b2);
            GE_BAR; GE_WAIT_L(0); GE_MMA(0, 1, At, B1); GE_BAR;
            GE_LDA(At, 0, 1);
            if constexpr (!DR) { if (last && has_next) GE_OFFS(offC, nxt); }
            GE_STA(GE_SA(0, 0), a2 + k2, offC, 0);
            GE_BAR; GE_WAIT_L(0); GE_MMA(1, 0, At, B0); GE_BAR; GE_SCHED;
            GE_STB(GE_SB(0, 1), b2 + hstepB);
            GE_WAIT_V(6); GE_BAR; GE_MMA(1, 1, At, B1); GE_BAR;
            GE_LDB(B0, 1, 0); GE_SCHED; GE_LDA(At, 1, 0); GE_STA(GE_SA(0, 1), a2 + k2, offC, 1);
            GE_WAIT_L(8); GE_BAR; GE_WAIT_L(0); GE_MMA(0, 0, At, B0); GE_BAR; GE_SCHED;
            GE_LDB(B1, 1, 1); GE_STB(GE_SB(1, 0), b3);
            GE_BAR; GE_WAIT_L(0); GE_MMA(0, 1, At, B1); GE_BAR;
            GE_LDA(At, 1, 1); GE_STA(GE_SA(1, 0), a2 + k3, offC, 0);
            GE_BAR; GE_WAIT_L(0); GE_MMA(1, 0, At, B0); GE_BAR; GE_SCHED;
            GE_STB(GE_SB(1, 1), b3 + hstepB);
            GE_WAIT_V(6); GE_BAR; GE_MMA(1, 1, At, B1); GE_BAR;
        }
#pragma unroll
        for (int a = 0; a < 2; ++a)
#pragma unroll
            for (int b = 0; b < 2; ++b) asm volatile("" : "+v"(acc[a][b][0][0]), "+v"(acc[a][b][0][1]), "+v"(acc[a][b][1][0]), "+v"(acc[a][b][1][1]), "+v"(acc[a][b][2][0]), "+v"(acc[a][b][2][1]), "+v"(acc[a][b][3][0]), "+v"(acc[a][b][3][1]));
        { int l2; asm volatile("v_mbcnt_lo_u32_b32 %0, -1, 0\n\tv_mbcnt_hi_u32_b32 %0, -1, %0" : "=v"(l2)); E(acc, cur, wr, wc, l2 & 15, l2 >> 4); }
        if (!has_next) break;
#pragma unroll
        for (int a = 0; a < 2; ++a)
#pragma unroll
            for (int b = 0; b < 2; ++b)
#pragma unroll
                for (int m = 0; m < 4; ++m)
#pragma unroll
                    for (int n = 0; n < 2; ++n) acc[a][b][m][n] = (f32x4){0.f, 0.f, 0.f, 0.f};
        cur = nxt; cB = nB; aC = aN; ++ui;
    }
    GE_WAIT_V(0);
    if (wr == 0) GE_BAR;
    GE_BAR;
}
#define GE_VALS(v, acc, ai, m) do { _Pragma("unroll") for (int _b = 0; _b < 2; ++_b) _Pragma("unroll") for (int _n = 0; _n < 2; ++_n) _Pragma("unroll") for (int _j = 0; _j < 4; ++_j) (v)[8 * _b + 4 * _n + _j] = (acc)[ai][_b][m][_n][_j]; } while (0)
}
__device__ __forceinline__ void store16_bf16(bf16_t* dst, const float (&v)[16]) {
    unsigned w[8];
#pragma unroll
    for (int i = 0; i < 8; ++i) w[i] = pk2g(v[2 * i], v[2 * i + 1]);
    uint4* d4 = (uint4*)dst; d4[0] = make_uint4(w[0], w[1], w[2], w[3]); d4[1] = make_uint4(w[4], w[5], w[6], w[7]);
}
template <bool IN_BF16>
struct EpiResid { const void* xin; const float* mod_g; bf16_t* xout; float inscale;
    __device__ __forceinline__ void operator()(const f32x4 (&acc)[2][2][4][2], const ge::Unit& u, int wr, int wc, int fr, int fq) const {
        const int col0 = (4 * u.pn + wc) * 64 + 16 * fq; const int b = (u.pm * 256) / S;
        float4 gq[4];
#pragma unroll
        for (int q4 = 0; q4 < 4; ++q4) { gq[q4] = *(const float4*)(mod_g + b * 6144 + col0 + 4 * q4); gq[q4].x *= inscale; gq[q4].y *= inscale; gq[q4].z *= inscale; gq[q4].w *= inscale; }
        if constexpr (IN_BF16) {
            uint4 xh[2][4][2];
#pragma unroll
            for (int ai = 0; ai < 2; ++ai)
#pragma unroll
                for (int m = 0; m < 4; ++m) { const size_t o = (size_t)(u.pm * 256 + ai * 128 + wr * 64 + m * 16 + fr) * D + col0; xh[ai][m][0] = *(const uint4*)((const bf16_t*)xin + o); xh[ai][m][1] = *(const uint4*)((const bf16_t*)xin + o + 8); }
            const float g16[16] = {gq[0].x, gq[0].y, gq[0].z, gq[0].w, gq[1].x, gq[1].y, gq[1].z, gq[1].w, gq[2].x, gq[2].y, gq[2].z, gq[2].w, gq[3].x, gq[3].y, gq[3].z, gq[3].w};
#pragma unroll
            for (int ai = 0; ai < 2; ++ai)
#pragma unroll
                for (int m = 0; m < 4; ++m) { float v[16]; GE_VALS(v, acc, ai, m);
                    const unsigned w8[8] = {xh[ai][m][0].x, xh[ai][m][0].y, xh[ai][m][0].z, xh[ai][m][0].w, xh[ai][m][1].x, xh[ai][m][1].y, xh[ai][m][1].z, xh[ai][m][1].w};
#pragma unroll
                    for (int k = 0; k < 8; ++k) { v[2 * k] = __uint_as_float(w8[k] << 16) + g16[2 * k] * v[2 * k]; v[2 * k + 1] = __uint_as_float(w8[k] & 0xFFFF0000u) + g16[2 * k + 1] * v[2 * k + 1]; }
                    store16_bf16(xout + (size_t)(u.pm * 256 + ai * 128 + wr * 64 + m * 16 + fr) * D + col0, v); }
        } else {
#pragma unroll
        for (int ai = 0; ai < 2; ++ai) { float4 xv[4][4];
#pragma unroll
            for (int m = 0; m < 4; ++m) { const size_t o = (size_t)(u.pm * 256 + ai * 128 + wr * 64 + m * 16 + fr) * D + col0;
#pragma unroll
                for (int q4 = 0; q4 < 4; ++q4) xv[m][q4] = *(const float4*)((const float*)xin + o + 4 * q4); }
#pragma unroll
            for (int m = 0; m < 4; ++m) { float v[16]; GE_VALS(v, acc, ai, m); float xr[16];
#pragma unroll
                for (int q4 = 0; q4 < 4; ++q4) { xr[4 * q4] = xv[m][q4].x; xr[4 * q4 + 1] = xv[m][q4].y; xr[4 * q4 + 2] = xv[m][q4].z; xr[4 * q4 + 3] = xv[m][q4].w; }
                const float g16[16] = {gq[0].x, gq[0].y, gq[0].z, gq[0].w, gq[1].x, gq[1].y, gq[1].z, gq[1].w, gq[2].x, gq[2].y, gq[2].z, gq[2].w, gq[3].x, gq[3].y, gq[3].z, gq[3].w};
#pragma unroll
                for (int k = 0; k < 16; ++k) v[k] = xr[k] + g16[k] * v[k];
                store16_bf16(xout + (size_t)(u.pm * 256 + ai * 128 + wr * 64 + m * 16 + fr) * D + col0, v); } }
        }
    } };
struct EpiNsaIn { const float* q_gain; const float* k_gain; const float* rope; bf16_t* q; bf16_t* kv; float* gates; float inscale;
    __device__ __forceinline__ void operator()(const f32x4 (&acc)[2][2][4][2], const ge::Unit& u, int wr, int wc, int fr, int fq) const {
        const int slot = 4 * u.pn + wc; if (slot > 28) return;
        const bool normed = (slot < 16) || slot == 20 || slot == 21 || slot == 24 || slot == 25;
        const float* gain = (slot < 16) ? q_gain : ((slot < 22) ? k_gain + 64 : k_gain + 128);
        float gv[16];
        if (normed) {
#pragma unroll
            for (int i = 0; i < 16; ++i) gv[i] = gain[16 * fq + i]; }
#pragma unroll
        for (int ai = 0; ai < 2; ++ai)
#pragma unroll
            for (int m = 0; m < 4; ++m) { const int row = u.pm * 256 + ai * 128 + wr * 64 + m * 16 + fr; const int b = row / S, s = row % S; float v[16]; GE_VALS(v, acc, ai, m);
#pragma unroll
                for (int i = 0; i < 16; ++i) v[i] *= inscale;
                if (slot == 28) { if (fq < 3) { float* gp = gates + (size_t)row * 48 + 16 * fq;
#pragma unroll
                        for (int q4 = 0; q4 < 4; ++q4) *(float4*)(gp + 4 * q4) = make_float4(fsigmoid(v[4 * q4]), fsigmoid(v[4 * q4 + 1]), fsigmoid(v[4 * q4 + 2]), fsigmoid(v[4 * q4 + 3])); }
                    continue; }
                if (normed) { float ss = 0.f;
#pragma unroll
                    for (int i = 0; i < 16; ++i) ss += v[i] * v[i];
                    ss = sum16(ss); ss = sum32(ss); const float r = rsqrtf(ss * (1.f / 64.f) + 1e-6f);
#pragma unroll
                    for (int i = 0; i < 16; ++i) v[i] *= r * gv[i];
                    if (fq == 0) { const float sf = (float)s;
                        constexpr float IFR[8] = {0.15915494309189535f, 0.030863763158420102f, 0.00598518567638293f, 0.001160663620968869f, 0.00022507907904105153f, 4.364795481173399e-05f, 8.464330549652592e-06f, 1.6414262419538367e-06f};
#pragma unroll
                        for (int i = 0; i < 8; ++i) { const float rev = __builtin_amdgcn_fractf(sf * IFR[i]); const float cs = __builtin_amdgcn_cosf(rev), sn = __builtin_amdgcn_sinf(rev), a = v[i], bb = v[i + 8]; v[i] = a * cs - bb * sn; v[i + 8] = bb * cs + a * sn; } } }
                bf16_t* dst;
                if (slot < 16) dst = q + (size_t)row * D + slot * 64 + 16 * fq;
                else { const int kk = slot - 16, ten = kk >> 1, g = kk & 1; dst = kv + (size_t)ten * T * 128 + ((size_t)(b * 2 + g) * S + s) * 64 + 16 * fq; }
                store16_bf16(dst, v); }
    } };
struct EpiMlIn { bf16_t* proj; float inscale;
    __device__ __forceinline__ void operator()(const f32x4 (&acc)[2][2][4][2], const ge::Unit& u, int wr, int wc, int fr, int fq) const {
        const int slot = 4 * u.pn + wc; const int L0 = slot * 64 + 16 * fq;
#pragma unroll
        for (int ai = 0; ai < 2; ++ai)
#pragma unroll
            for (int m = 0; m < 4; ++m) { const int row = u.pm * 256 + ai * 128 + wr * 64 + m * 16 + fr; float v[16]; GE_VALS(v, acc, ai, m);
                { const float sc = (slot >= 8 && slot < 16) ? 0.08838834764831845f * inscale : inscale;
#pragma unroll
                    for (int i = 0; i < 16; ++i) v[i] *= sc; }
                if (slot >= 32) {
#pragma unroll
                    for (int i = 0; i < 16; ++i) v[i] = fsigmoid(v[i]) * 256.f;
                    *(uint4*)((unsigned char*)(proj + (size_t)row * 3072 + 2048) + (L0 - 2048)) = make_uint4(pk4_fp8(v[0], v[1], v[2], v[3]), pk4_fp8(v[4], v[5], v[6], v[7]), pk4_fp8(v[8], v[9], v[10], v[11]), pk4_fp8(v[12], v[13], v[14], v[15])); }
                else store16_bf16(proj + (size_t)row * 3072 + L0, v); }
    } };
struct OneUnit { int pm; __device__ bool next(int i, ge::Unit& u) const { if (i) return false; u.pm = pm; u.pn = 0; u.bt = 0; u.aux = 0; return true; } };
struct EpiCmpPart { float* part;
    __device__ __forceinline__ void operator()(const f32x4 (&acc)[2][2][4][2], const ge::Unit& u, int wr, int wc, int fr, int fq) const {
        const int L0 = (4 * u.pn + wc) * 64 + 16 * fq;
#pragma unroll
        for (int ai = 0; ai < 2; ++ai)
#pragma unroll
            for (int m = 0; m < 4; ++m) { const int row = u.pm * 256 + ai * 128 + wr * 64 + m * 16 + fr; float v[16]; GE_VALS(v, acc, ai, m); store16_bf16((bf16_t*)part + (size_t)row * 256 + L0, v); }
    } };
struct EpiCmp1 { const float* cb1; bf16_t* hid;
    __device__ __forceinline__ void operator()(const f32x4 (&acc)[2][2][4][2], const ge::Unit& u, int wr, int wc, int fr, int fq) const {
        const int L0 = (4 * u.pn + wc) * 64 + 16 * fq; float bv[16];
#pragma unroll
        for (int i = 0; i < 16; ++i) bv[i] = cb1[L0 + i];
#pragma unroll
        for (int ai = 0; ai < 2; ++ai)
#pragma unroll
            for (int m = 0; m < 4; ++m) { const int row = u.pm * 256 + ai * 128 + wr * 64 + m * 16 + fr; float v[16]; GE_VALS(v, acc, ai, m);
#pragma unroll
                for (int i = 0; i < 16; ++i) { const float x = v[i] + bv[i]; v[i] = 0.5f * x * (1.f + ftanh(0.7978845608028654f * (x + 0.044715f * x * x * x))); }
                store16_bf16(hid + (size_t)row * 256 + L0, v); }
    } };

#define PARAM_LIST(X) \
    X(const float*, x) X(const float*, c) X(const float*, ada_w) X(const float*, ada_b) X(const float*, g_mix) X(const float*, g_ffn) X(const float*, nsa_w_in) X(const float*, nsa_w_out) \
    X(const float*, q_gain) X(const float*, k_gain) X(const float*, cmp_pe) X(const float*, cmp_w1) X(const float*, cmp_b1) X(const float*, cmp_w2) X(const float*, cmp_b2) \
    X(const float*, ml_w_in) X(const float*, ml_bi) X(const float*, ml_bf) X(const float*, ml_ng) X(const float*, ml_w_out) X(const float*, router_w) X(const float*, router_b) \
    X(const float*, w_gate) X(const float*, w_up) X(const float*, w_down) \
    X(float*, out) X(unsigned*, bar) X(int*, cnt) X(float*, mod) X(float*, rope) X(float*, cb1) X(float*, tokw) X(int*, list) X(float*, li) X(float*, lf) \
    X(bf16_t*, h) X(bf16_t*, hidc) X(bf16_t*, xb13) X(bf16_t*, xb2) X(bf16_t*, wo_nsa_t) X(bf16_t*, wo_ml_t) X(bf16_t*, win_nsa_t) X(bf16_t*, win_ml_t) X(bf16_t*, w1c_t) X(bf16_t*, gu_t) X(bf16_t*, dn_t) \
    X(bf16_t*, q) X(bf16_t*, kv) X(float*, gates) X(bf16_t*, kcmp) X(bf16_t*, vcmp) X(bf16_t*, proj) X(bf16_t*, hid) X(bf16_t*, outk) X(int*, dcnt) X(int*, dlist) X(float*, cpart)
struct Params {
#define X(t, n) t n;
    PARAM_LIST(X)
#undef X
};
template <class Tp> __device__ __forceinline__ Tp* uni_ptr(Tp* v) { const unsigned long long u = (unsigned long long)v; const unsigned lo = __builtin_amdgcn_readfirstlane((unsigned)u), hi = __builtin_amdgcn_readfirstlane((unsigned)(u >> 32)); typedef Tp __attribute__((address_space(1))) * GP; return (Tp*)(GP)(((unsigned long long)hi << 32) | lo); }
#define LP(n) q.n = uni_ptr(P->n)
struct Frame { LAS unsigned char* lds; int tid, lane, wave, bid, G; };
__device__ __forceinline__ int lane_id_asm() { int l; asm volatile("v_mbcnt_lo_u32_b32 %0, -1, 0\n\tv_mbcnt_hi_u32_b32 %0, -1, %0" : "=v"(l)); return l; }
__device__ __forceinline__ Frame launder(const Frame& F) { Frame R = F; const int l = lane_id_asm(); int wv = F.wave, bd = F.bid; asm volatile("" : "+s"(wv), "+s"(bd)); R.wave = wv; R.bid = bd; R.tid = wv * 64 + l; R.lane = l; return R; }
constexpr int LDS_GEN = 143872;
constexpr int LDS_MISC = LDS_GEN;
constexpr int LDS_PARAMS = LDS_GEN + 4096;
constexpr int LDS_CONST = LDS_GEN + 6144;
constexpr int LDS_BYTES = LDS_GEN + 18432;

constexpr float F8_SA = 8.f, F8_SW = 32.f, F8_SH = 4.f, F8_SW2 = 32.f, F8_SO = 16.f;
__device__ __forceinline__ float fp8f(unsigned w, int i) { return i == 0 ? __builtin_amdgcn_cvt_f32_fp8((int)w, 0) : i == 1 ? __builtin_amdgcn_cvt_f32_fp8((int)w, 1) : i == 2 ? __builtin_amdgcn_cvt_f32_fp8((int)w, 2) : __builtin_amdgcn_cvt_f32_fp8((int)w, 3); }
template <int NB>
__device__ __forceinline__ void colgemv(const Frame& F, const LAS float* vec, LAS float* part, const float* W, int ldw, int K, int n0, const float* bias, float* out, int out_stride) {
    const int kper = K / 8, kb = F.wave * kper, c4 = F.lane & 15, kq = F.lane >> 4; float acc[NB][4];
#pragma unroll
    for (int b = 0; b < NB; ++b)
#pragma unroll
        for (int j = 0; j < 4; ++j) acc[b][j] = 0.f;
    const float* wp = W + (size_t)(kb + kq) * ldw + n0 + 4 * c4;
#pragma unroll 4
    for (int k = 0; k < kper; k += 4) { const float4 wv = *(const float4*)(wp + (size_t)k * ldw);
#pragma unroll
        for (int b = 0; b < NB; ++b) { const float x = vec[(kb + k + kq) * NB + b]; acc[b][0] += x * wv.x; acc[b][1] += x * wv.y; acc[b][2] += x * wv.z; acc[b][3] += x * wv.w; } }
#pragma unroll
    for (int b = 0; b < NB; ++b)
#pragma unroll
        for (int j = 0; j < 4; ++j) { const float t = sum32(sum16(acc[b][j])); if (kq == 0) part[(F.wave * NB + b) * 64 + 4 * c4 + j] = t; }
    __syncthreads();
    for (int idx = F.tid; idx < NB * 64; idx += NTHR) { const int b = idx >> 6, l = idx & 63; float s = bias[n0 + l];
#pragma unroll
        for (int w = 0; w < 8; ++w) s += part[(w * NB + b) * 64 + l];
        out[(size_t)b * out_stride + n0 + l] = s; }
    __syncthreads();
}
struct ColPlain { const float* W; int ncols; int pad; __device__ const float* operator()(int c) const { const int L = ge::logical_col(c); return L < ncols ? W + L : nullptr; } };
struct ColGateUp { const float* wg; const float* wu; __device__ const float* operator()(int c) const { const int e = c >> 10, cc = c & 1023; const int pn = cc >> 8, bj = (cc >> 7) & 1, wc = (cc >> 5) & 3, n = (cc >> 4) & 1, fq = (cc >> 2) & 3, j = cc & 3;
        const int hidx = 32 * (4 * pn + wc) + 8 * fq + 4 * n + j; const unsigned long long a = (unsigned long long)wg, d = (unsigned long long)wu - a;
        return (const float*)(a + (bj ? d : 0ull)) + (size_t)e * D * DE + hidx; } };
struct ColDown { const float* wd; __device__ const float* operator()(int c) const { const int e = c >> 10; return wd + (size_t)e * DE * D + ge::logical_col(c & 1023); } };
template <bool F8 = false, class ColF>
__device__ __forceinline__ void prep_weights(const Frame& F, void* Bt_, int N, int K, int ldw, const ColF cf, int start, int stride, const float wscale = 1.f) {
    bf16_t* Bt = (bf16_t*)Bt_;
    LAS float* tile = (LAS float*)(F.lds) + (F.tid >> 8) * (128 * 65);
    const int ntx = N / 64, ntiles = ntx * (K / 128), htid = F.tid & 255, half = F.tid >> 8;
    float r[32];
#define PW_LOAD(it_) do { const int tl_ = (it_) * 2 + half; if (tl_ < ntiles) { const int c0_ = (tl_ % ntx) * 64, k0_ = (tl_ / ntx) * 128; const float* p_ = cf(c0_ + (htid & 63)); \
        if (p_) { p_ += (size_t)(k0_ + (htid >> 6)) * ldw; _Pragma("unroll") for (int i_ = 0; i_ < 32; ++i_) r[i_] = p_[(size_t)(4 * i_) * ldw]; } \
        else { _Pragma("unroll") for (int i_ = 0; i_ < 32; ++i_) r[i_] = 0.f; } } } while (0)
    int it = start;
    if (it * 2 < ntiles) PW_LOAD(it);
    for (; it * 2 < ntiles; it += stride) {
        const int tl = it * 2 + half; const bool act = tl < ntiles; const int c0 = (tl % ntx) * 64, k0 = (tl / ntx) * 128;
        if (act) { const int cc = htid & 63;
#pragma unroll
            for (int i = 0; i < 32; ++i) tile[((htid >> 6) + 4 * i) * 65 + cc] = r[i]; }
        __syncthreads();
        if ((it + stride) * 2 < ntiles) PW_LOAD(it + stride);
        if (act) { const int cc = htid >> 2, ch = (htid & 3) * 32;
            if (F8) { unsigned w[8];
#pragma unroll
                for (int i = 0; i < 8; ++i) w[i] = pk4_fp8(tile[(ch + 4 * i) * 65 + cc] * wscale, tile[(ch + 4 * i + 1) * 65 + cc] * wscale, tile[(ch + 4 * i + 2) * 65 + cc] * wscale, tile[(ch + 4 * i + 3) * 65 + cc] * wscale);
                uint4* dst = (uint4*)((unsigned char*)Bt_ + (size_t)(c0 + cc) * K + k0 + ch); dst[0] = make_uint4(w[0], w[1], w[2], w[3]); dst[1] = make_uint4(w[4], w[5], w[6], w[7]); }
            else { unsigned w[16];
#pragma unroll
                for (int i = 0; i < 16; ++i) w[i] = pk2g(tile[(ch + 2 * i) * 65 + cc], tile[(ch + 2 * i + 1) * 65 + cc]);
                uint4* dst = (uint4*)(Bt + (size_t)(c0 + cc) * K + k0 + ch);
#pragma unroll
                for (int q4 = 0; q4 < 4; ++q4) dst[q4] = make_uint4(w[4 * q4], w[4 * q4 + 1], w[4 * q4 + 2], w[4 * q4 + 3]); } }
        __syncthreads();
    }
#undef PW_LOAD
}
__device__ __forceinline__ void prep_moe_weights(const Params& p, const Frame& F, int layer, int start, int stride) {
    const size_t wo = (size_t)layer * NE * D * DE;
    prep_weights<true>(F, p.gu_t, NE * 1024, D, DE, ColGateUp{p.w_gate + wo, p.w_up + wo}, start, stride, F8_SW);
    prep_weights<true>(F, p.dn_t, NE * 1024, DE, D, ColDown{p.w_down + wo}, start, stride, F8_SW2);
}

__device__ __forceinline__ void phase_prologue_a(const Params& p, const Frame& F) {
    for (int i = (F.bid - 200) * NTHR + F.tid; F.bid >= 200 && i < 2048 * 8; i += (F.G - 200) * NTHR) { const int pos = i >> 3, j = i & 7; const float inv = (float)pow(500000.0, -(double)j / 8.0); const float ang = (float)pos * inv;
        p.rope[pos * 16 + j] = (float)cos((double)ang); p.rope[pos * 16 + 8 + j] = (float)sin((double)ang); }
    if (F.bid == F.G - 1) for (int i = F.tid; i < 8 * D / 2; i += NTHR) ((unsigned*)(p.h + (size_t)T * D))[i] = 0u;
}
__device__ __forceinline__ void phase_prologue_b(const Params& p, const Frame& F) {
    LAS float* vec = (LAS float*)F.lds; LAS float* part = (LAS float*)(F.lds + 65536 + 16384);
    if (F.bid < 192) {
        for (int idx = F.tid; idx < 16 * D; idx += NTHR) { const int b = idx >> 10, k = idx & 1023; const float cv = p.c[idx]; vec[k * 16 + b] = cv / (1.f + expf(-cv)); }
        __syncthreads();
        const int i = F.bid / 96, n0 = (F.bid % 96) * 64;
        colgemv<16>(F, vec, part, p.ada_w + (size_t)i * D * 6144, 6144, D, n0, p.ada_b + i * 6144, p.mod + (size_t)i * 16 * 6144, 6144);
    } else if (F.bid < 200) {
        const int it = F.bid - 192, w = it >> 2, n0 = (it & 3) * 64;
        for (int idx = F.tid; idx < 2048; idx += NTHR) vec[idx] = p.cmp_pe[w * 2048 + idx];
        __syncthreads();
        colgemv<1>(F, vec, part, p.cmp_w1 + (size_t)w * 2048 * 256, 256, 2048, n0, p.cmp_b1 + w * 256, p.cb1 + w * 256, 0);
    }
    __syncthreads();
}

template <int MODE, bool XBF>
__device__ __forceinline__ void phase_norm(const Params& p, const Frame& F, const void* xin_, bf16_t* xout, const float* gain, const float* mod_sh, const float* mod_sc, const float* mod_gprev, int layer) {
    constexpr int rows_per_wg = T / NWG, rpw = rows_per_wg / 8;
    constexpr int TP = (MODE == 1) ? 34 : 10;
    const int row0 = F.bid * rows_per_wg;
    LAS float* rw = (LAS float*)F.lds;
    LAS int* lcnt = (LAS int*)(F.lds + LDS_MISC + 64); LAS int* gbase = lcnt + 32; LAS int* ent = gbase + 32;
    if (MODE == 1) { for (int idx = F.tid; idx < D * NE; idx += NTHR) { const int c = idx >> 5; rw[((c & 3) * 256 + (c >> 2)) * TP + (idx & 31)] = p.router_w[idx]; } if (F.tid < 32) lcnt[F.tid] = 0; }
    if (MODE == 2) { for (int idx = F.tid; idx < D * 8; idx += NTHR) { const int c = idx >> 3; rw[((c & 3) * 256 + (c >> 2)) * TP + (idx & 7)] = p.ml_w_in[(size_t)c * ML_COLS + 3072 + (idx & 7)]; } }
    const int b = row0 / S;
    LAS float* cg = (LAS float*)(F.lds + LDS_CONST); LAS float* csh = cg + D; LAS float* cgp = csh + D;
    for (int col = F.tid; col < D; col += NTHR) { cg[col] = gain[col] * (1.f + mod_sc[b * 6144 + col]); csh[col] = mod_sh[b * 6144 + col]; if (MODE == 2) cgp[col] = mod_gprev[b * 6144 + col] * (1.f / F8_SO); }
    __syncthreads();
    const int rbase = row0 + F.wave * rpw;
    float4 xn[4]; unsigned on0[4], on1[4];
#define NORM_LOAD(r_) do { if (XBF) { const bf16_t* xr_ = (const bf16_t*)xin_ + (size_t)(r_) * D + 4 * F.lane; _Pragma("unroll") for (int j_ = 0; j_ < 4; ++j_) { const uint2 t_ = *(const uint2*)(xr_ + 256 * j_); \
            xn[j_] = make_float4(__uint_as_float(t_.x << 16), __uint_as_float(t_.x & 0xFFFF0000u), __uint_as_float(t_.y << 16), __uint_as_float(t_.y & 0xFFFF0000u)); } } \
        else { const float* xr_ = (const float*)xin_ + (size_t)(r_) * D + 4 * F.lane; _Pragma("unroll") for (int j_ = 0; j_ < 4; ++j_) xn[j_] = *(const float4*)(xr_ + 256 * j_); } \
        if (MODE == 2) { const unsigned char* o0_ = (const unsigned char*)p.outk + (size_t)(r_) * D + 4 * F.lane; _Pragma("unroll") for (int j_ = 0; j_ < 4; ++j_) { on0[j_] = *(const unsigned*)(o0_ + 256 * j_); on1[j_] = *(const unsigned*)(o0_ + (size_t)T * D + 256 * j_); } } } while (0)
    NORM_LOAD(rbase);
#pragma unroll 1
    for (int ri = 0; ri < rpw; ++ri) {
        const int row = rbase + ri; float v[16];
#pragma unroll
        for (int j = 0; j < 4; ++j) { v[4 * j] = xn[j].x; v[4 * j + 1] = xn[j].y; v[4 * j + 2] = xn[j].z; v[4 * j + 3] = xn[j].w; }
        if (MODE == 2) {
#pragma unroll
            for (int j = 0; j < 4; ++j) { const f32x4 gq = *(const LAS f32x4*)(cgp + 4 * F.lane + 256 * j);
                v[4 * j] += gq[0] * (fp8f(on0[j], 0) + fp8f(on1[j], 0)); v[4 * j + 1] += gq[1] * (fp8f(on0[j], 1) + fp8f(on1[j], 1));
                v[4 * j + 2] += gq[2] * (fp8f(on0[j], 2) + fp8f(on1[j], 2)); v[4 * j + 3] += gq[3] * (fp8f(on0[j], 3) + fp8f(on1[j], 3));
                uint2 xo_; xo_.x = pk2g(v[4 * j], v[4 * j + 1]); xo_.y = pk2g(v[4 * j + 2], v[4 * j + 3]); *(uint2*)(xout + (size_t)row * D + 4 * F.lane + 256 * j) = xo_; } }
        if (ri + 1 < rpw) NORM_LOAD(row + 1);
        float ss = 0.f;
#pragma unroll
        for (int i = 0; i < 16; ++i) ss += v[i] * v[i];
        ss = wave_sum(ss); const float r = rsqrtf(ss * (1.f / D) + 1e-6f);
#pragma unroll
        for (int j = 0; j < 4; ++j) { const f32x4 g4 = *(const LAS f32x4*)(cg + 4 * F.lane + 256 * j), s4 = *(const LAS f32x4*)(csh + 4 * F.lane + 256 * j);
#pragma unroll
            for (int e = 0; e < 4; ++e) v[4 * j + e] = v[4 * j + e] * r * g4[e] + s4[e];
            if (MODE == 2 || MODE == 0) *(unsigned*)((unsigned char*)p.h + (size_t)row * D + 4 * F.lane + 256 * j) = pk4_fp8(v[4 * j] * F8_SA, v[4 * j + 1] * F8_SA, v[4 * j + 2] * F8_SA, v[4 * j + 3] * F8_SA);
            else { uint2 pk; pk.x = pk2g(v[4 * j], v[4 * j + 1]); pk.y = pk2g(v[4 * j + 2], v[4 * j + 3]); *(uint2*)(p.h + (size_t)row * D + 4 * F.lane + 256 * j) = pk; } }
        if (MODE == 2) { float a8[8];
#pragma unroll
            for (int j = 0; j < 8; ++j) a8[j] = 0.f;
#pragma unroll
            for (int j = 0; j < 4; ++j)
#pragma unroll
                for (int e = 0; e < 4; ++e) { const LAS float* wr_ = rw + (e * 256 + 64 * j + F.lane) * TP; const float hv = v[4 * j + e];
#pragma unroll
                    for (int q2 = 0; q2 < 4; ++q2) { const f32x2_t w2 = *(const LAS f32x2_t*)(wr_ + 2 * q2); a8[2 * q2] += hv * w2[0]; a8[2 * q2 + 1] += hv * w2[1]; } }
#pragma unroll
            for (int j = 0; j < 8; ++j) a8[j] = wave_sum(a8[j]);
            if (F.lane < 8) { float a = 0.f;
#pragma unroll
                for (int j = 0; j < 8; ++j) a = (F.lane == j) ? a8[j] : a;
                if (F.lane < 4) { a += p.ml_bi[F.lane]; p.li[row * 4 + F.lane] = 15.f * tanhf(a / 15.f); }
                else { a += p.ml_bf[F.lane - 4]; const float cc = 15.f * tanhf(a / 15.f); p.lf[row * 4 + F.lane - 4] = (cc >= 0.f) ? -log1pf(expf(-cc)) : (cc - log1pf(expf(cc))); } } }
        if (MODE == 1) { float acc[32];
#pragma unroll
            for (int e = 0; e < 32; ++e) acc[e] = 0.f;
#pragma unroll
            for (int j = 0; j < 4; ++j)
#pragma unroll
                for (int e = 0; e < 4; ++e) { const LAS float* wr_ = rw + (e * 256 + 64 * j + F.lane) * TP; const float hv = v[4 * j + e]; asm volatile("" ::: "memory");
#pragma unroll
                    for (int q2 = 0; q2 < 16; ++q2) { const f32x2_t w2 = *(const LAS f32x2_t*)(wr_ + 2 * q2); acc[2 * q2] += hv * w2[0]; acc[2 * q2 + 1] += hv * w2[1]; } }
            float r16[16], r8[8], r4[4], r2[2], r1;
            { const bool hi = (F.lane & 32) != 0;
#pragma unroll
              for (int i = 0; i < 16; ++i) { const float keep = hi ? acc[16 + i] : acc[i], send = hi ? acc[i] : acc[16 + i]; r16[i] = keep + other32(send, hi); } }
            { const bool hi = (F.lane & 16) != 0;
#pragma unroll
              for (int i = 0; i < 8; ++i) { const float keep = hi ? r16[8 + i] : r16[i], send = hi ? r16[i] : r16[8 + i]; r8[i] = keep + sx<16>(send); } }
            { const bool hi = (F.lane & 8) != 0;
#pragma unroll
              for (int i = 0; i < 4; ++i) { const float keep = hi ? r8[4 + i] : r8[i], send = hi ? r8[i] : r8[4 + i]; r4[i] = keep + sx<8>(send); } }
            { const bool hi = (F.lane & 4) != 0;
#pragma unroll
              for (int i = 0; i < 2; ++i) { const float keep = hi ? r4[2 + i] : r4[i], send = hi ? r4[i] : r4[2 + i]; r2[i] = keep + sx<4>(send); } }
            { const bool hi = (F.lane & 2) != 0; const float keep = hi ? r2[1] : r2[0], send = hi ? r2[0] : r2[1]; r1 = keep + sx<2>(send); }
            r1 += sx<1>(r1);
            const float aff = sigmoidf_(r1); const float ch = aff + p.router_b[F.lane >> 1];
            float bestgs = -3e38f; int be0 = 0, be1 = 0; float ba0 = 0.f, ba1 = 0.f;
#pragma unroll
            for (int g = 0; g < 4; ++g) { float v1 = -3e38f, v2 = -3e38f, a1 = 0.f, a2 = 0.f; int i1 = 0, i2 = 0;
#pragma unroll
                for (int i = 0; i < 8; ++i) { const float a = rdlane(aff, 2 * (g * 8 + i)), c_ = rdlane(ch, 2 * (g * 8 + i));
                    if (c_ > v1) { v2 = v1; a2 = a1; i2 = i1; v1 = c_; a1 = a; i1 = i; } else if (c_ > v2) { v2 = c_; a2 = a; i2 = i; } }
                const float gs = v1 + v2; if (gs > bestgs) { bestgs = gs; be0 = g * 8 + i1; be1 = g * 8 + i2; ba0 = a1; ba1 = a2; } }
            if (F.lane == 0) { const float sum = ba0 + ba1; p.tokw[row * 2] = ba0 / sum; p.tokw[row * 2 + 1] = ba1 / sum;
                const int lr = row - row0; const int r0_ = atomicAdd((int*)&lcnt[be0], 1); const int r1_ = atomicAdd((int*)&lcnt[be1], 1);
                ent[lr * 4 + 0] = be0 | (r0_ << 8); ent[lr * 4 + 1] = row * 2; ent[lr * 4 + 2] = be1 | (r1_ << 8); ent[lr * 4 + 3] = row * 2 + 1; } }
    }
#undef NORM_LOAD
    if (MODE == 1) { __syncthreads();
        if (F.tid < 32) gbase[F.tid] = atomicAdd(&p.cnt[layer * 64 + F.tid], lcnt[F.tid]);
        __syncthreads();
        for (int idx = F.tid; idx < rows_per_wg * 2; idx += NTHR) { const int er = ent[idx * 2], tk = ent[idx * 2 + 1]; const int e = er & 255, rk = er >> 8; p.list[(size_t)e * T + gbase[e] + rk] = tk; }
        __syncthreads(); }
}

__device__ __forceinline__ void phase_norm_route(const Params& p, const Frame& F, const bf16_t* xin, const float* gain, const float* mod_sh, const float* mod_sc, int layer) {
    constexpr int rows_per_wg = T / NWG;
    const int row0 = F.bid * rows_per_wg, b = row0 / S, lane = F.lane, i16 = lane & 15, g = lane >> 4;
    constexpr int RTP = 2064;
    LAS unsigned char* thi = F.lds; LAS unsigned char* tlo = F.lds + 32 * RTP;
    LAS float* cg = (LAS float*)(F.lds + LDS_CONST); LAS float* csh = cg + D; LAS float* bias = csh + D; LAS float* bpart = bias + 32;
    LAS int* lcnt = (LAS int*)(F.lds + LDS_MISC + 64); LAS int* gbase = lcnt + 32; LAS int* ent = gbase + 32;
    for (int col = F.tid; col < D; col += NTHR) { cg[col] = gain[col] * (1.f + mod_sc[b * 6144 + col]); csh[col] = mod_sh[b * 6144 + col]; }
    if (F.tid < 32) lcnt[F.tid] = 0;
    __syncthreads();
    { const int e = F.tid & 31, part = F.tid >> 5; float a = 0.f;
#pragma unroll 8
      for (int k = part * 64; k < part * 64 + 64; k += 2) { const float w0 = p.router_w[k * 32 + e], w1 = p.router_w[(k + 1) * 32 + e];
          a += csh[k] * w0 + csh[k + 1] * w1;
          const float s0 = w0 * cg[k] * 256.f, s1 = w1 * cg[k + 1] * 256.f; const _Float16 h0 = (_Float16)s0, h1 = (_Float16)s1; const _Float16 l0 = (_Float16)(s0 - (float)h0), l1 = (_Float16)(s1 - (float)h1);
          *(LAS unsigned*)(thi + e * RTP + k * 2) = (unsigned)__builtin_bit_cast(unsigned short, h0) | ((unsigned)__builtin_bit_cast(unsigned short, h1) << 16);
          *(LAS unsigned*)(tlo + e * RTP + k * 2) = (unsigned)__builtin_bit_cast(unsigned short, l0) | ((unsigned)__builtin_bit_cast(unsigned short, l1) << 16); }
      bpart[part * 32 + e] = a; }
    __syncthreads();
    if (F.tid < 32) { float a = 0.f;
#pragma unroll
        for (int q = 0; q < 16; ++q) a += bpart[q * 32 + F.tid];
        bias[F.tid] = a; }
    const int rbase = row0 + F.wave * 16;
    const bf16_t* xr = xin + (size_t)(rbase + i16) * D + 8 * g;
    typedef _Float16 f16x8 __attribute__((ext_vector_type(8))); typedef unsigned u32x4r __attribute__((ext_vector_type(4)));
    const LAS unsigned char* bh0 = thi + i16 * RTP + 16 * g; const LAS unsigned char* bh1 = bh0 + 16 * RTP; const LAS unsigned char* bl0 = tlo + i16 * RTP + 16 * g; const LAS unsigned char* bl1 = bl0 + 16 * RTP;
    f32x4 acc0 = (f32x4){0.f, 0.f, 0.f, 0.f}, acc1 = (f32x4){0.f, 0.f, 0.f, 0.f}; float ss = 0.f;
    uint4 xa[2][8];
#define RT_LOAD(s_, q_) do { _Pragma("unroll") for (int u_ = 0; u_ < 8; ++u_) xa[s_][u_] = *(const uint4*)(xr + 32 * (8 * (q_) + u_)); } while (0)
    RT_LOAD(0, 0);
#pragma unroll
    for (int qd = 0; qd < 4; ++qd) {
        if (qd + 1 < 4) RT_LOAD((qd + 1) & 1, qd + 1);
#pragma unroll
        for (int u = 0; u < 8; ++u) { const int so = (8 * qd + u) * 64;
            const uint4 xc = xa[qd & 1][u]; const unsigned xw[4] = {xc.x, xc.y, xc.z, xc.w}; u32x4r ap;
#pragma unroll
            for (int i = 0; i < 4; ++i) { const float f0 = __uint_as_float(xw[i] << 16), f1 = __uint_as_float(xw[i] & 0xFFFF0000u); ss += f0 * f0 + f1 * f1; ap[i] = __builtin_bit_cast(unsigned, __builtin_amdgcn_cvt_pkrtz(f0, f1)); }
            const f16x8 a8 = __builtin_bit_cast(f16x8, ap);
            const f16x8 b0h = *(const LAS f16x8*)(bh0 + so), b0l = *(const LAS f16x8*)(bl0 + so), b1h = *(const LAS f16x8*)(bh1 + so), b1l = *(const LAS f16x8*)(bl1 + so);
            acc0 = __builtin_amdgcn_mfma_f32_16x16x32_f16(a8, b0h, acc0, 0, 0, 0); acc1 = __builtin_amdgcn_mfma_f32_16x16x32_f16(a8, b1h, acc1, 0, 0, 0);
            acc0 = __builtin_amdgcn_mfma_f32_16x16x32_f16(a8, b0l, acc0, 0, 0, 0); acc1 = __builtin_amdgcn_mfma_f32_16x16x32_f16(a8, b1l, acc1, 0, 0, 0); }
    }
#undef RT_LOAD
    ss = sum16(ss); ss = sum32(ss); const float r = rsqrtf(ss * (1.f / D) + 1e-6f);
    float af0[4], af1[4];
#pragma unroll
    for (int rr = 0; rr < 4; ++rr) { const float rrow = __int_as_float(__builtin_amdgcn_ds_bpermute((4 * g + rr) * 4, __float_as_int(r)));
        af0[rr] = sigmoidf_(rrow * (1.f / 256.f) * acc0[rr] + bias[i16]); af1[rr] = sigmoidf_(rrow * (1.f / 256.f) * acc1[rr] + bias[16 + i16]); }
    __syncthreads();
    LAS float* affl = (LAS float*)F.lds + F.wave * 512;
#pragma unroll
    for (int rr = 0; rr < 4; ++rr) { affl[(4 * g + rr) * 32 + i16] = af0[rr]; affl[(4 * g + rr) * 32 + 16 + i16] = af1[rr]; }
    asm volatile("s_waitcnt lgkmcnt(0)" ::: "memory");
    if (lane < 16) { const int row = rbase + lane; const LAS float* ar = affl + lane * 32;
        float bestgs = -3e38f; int be0 = 0, be1 = 0; float ba0 = 0.f, ba1 = 0.f;
#pragma unroll
        for (int gg = 0; gg < 4; ++gg) { float v1 = -3e38f, v2 = -3e38f, a1 = 0.f, a2 = 0.f; int i1 = 0, i2 = 0;
#pragma unroll
            for (int i = 0; i < 8; ++i) { const float a = ar[gg * 8 + i], c_ = a + p.router_b[gg * 8 + i];
                if (c_ > v1) { v2 = v1; a2 = a1; i2 = i1; v1 = c_; a1 = a; i1 = i; } else if (c_ > v2) { v2 = c_; a2 = a; i2 = i; } }
            const float gs = v1 + v2; if (gs > bestgs) { bestgs = gs; be0 = gg * 8 + i1; be1 = gg * 8 + i2; ba0 = a1; ba1 = a2; } }
        const float sum = ba0 + ba1; p.tokw[row * 2] = ba0 / sum; p.tokw[row * 2 + 1] = ba1 / sum;
        const int lr = row - row0; const int r0_ = atomicAdd((int*)&lcnt[be0], 1); const int r1_ = atomicAdd((int*)&lcnt[be1], 1);
        ent[lr * 4 + 0] = be0 | (r0_ << 8); ent[lr * 4 + 1] = row * 2; ent[lr * 4 + 2] = be1 | (r1_ << 8); ent[lr * 4 + 3] = row * 2 + 1; }
    { uint2 xq[2][4][4];
#define NR_LOAD(s_, r_) do { _Pragma("unroll") for (int k_ = 0; k_ < 4; ++k_) { const bf16_t* xq_ = xin + (size_t)((r_) + k_) * D + 4 * lane; _Pragma("unroll") for (int j_ = 0; j_ < 4; ++j_) xq[s_][k_][j_] = *(const uint2*)(xq_ + 256 * j_); } } while (0)
      NR_LOAD(0, rbase);
#pragma unroll
      for (int g4 = 0; g4 < 4; ++g4) {
          if (g4 + 1 < 4) NR_LOAD((g4 + 1) & 1, rbase + 4 * (g4 + 1));
#pragma unroll
          for (int k = 0; k < 4; ++k) { const int row = rbase + 4 * g4 + k; const float rr_ = rdlane(r, 4 * g4 + k);
#pragma unroll
              for (int j = 0; j < 4; ++j) { const f32x4 g4v = *(const LAS f32x4*)(cg + 4 * lane + 256 * j), s4_ = *(const LAS f32x4*)(csh + 4 * lane + 256 * j); const uint2 xc = xq[g4 & 1][k][j];
                  const float x0 = __uint_as_float(xc.x << 16), x1 = __uint_as_float(xc.x & 0xFFFF0000u), x2 = __uint_as_float(xc.y << 16), x3 = __uint_as_float(xc.y & 0xFFFF0000u);
                  *(unsigned*)((unsigned char*)p.h + (size_t)row * D + 4 * lane + 256 * j) = pk4_fp8((x0 * rr_ * g4v[0] + s4_[0]) * F8_SA, (x1 * rr_ * g4v[1] + s4_[1]) * F8_SA, (x2 * rr_ * g4v[2] + s4_[2]) * F8_SA, (x3 * rr_ * g4v[3] + s4_[3]) * F8_SA); } } }
#undef NR_LOAD
    }
    __syncthreads();
    if (F.tid < 32) gbase[F.tid] = atomicAdd(&p.cnt[layer * 64 + F.tid], lcnt[F.tid]);
    __syncthreads();
    for (int idx = F.tid; idx < rows_per_wg * 2; idx += NTHR) { const int er = ent[idx * 2], tk = ent[idx * 2 + 1]; const int e = er & 255, rk = er >> 8; p.list[(size_t)e * T + gbase[e] + rk] = tk; }
    __syncthreads();
}

struct MoeOrder { const LAS int* tab;
    __device__ bool next(int i, ge::Unit& u) const { if (i >= 8) return false; const int pm = __builtin_amdgcn_readfirstlane(tab[4 * i]); if (pm < 0) return false;
        u.pm = pm; u.pn = __builtin_amdgcn_readfirstlane(tab[4 * i + 1]); u.bt = __builtin_amdgcn_readfirstlane(tab[4 * i + 2]); u.aux = __builtin_amdgcn_readfirstlane(tab[4 * i + 3]); return true; } };
__device__ __forceinline__ void moe_plan(const Frame& F, const int* cnt, const int* list, LAS int* tab, LAS int* tkt  , int npn, const float* tokw = nullptr, LAS float* tkw = nullptr  , const float wscale = 1.f) {
    LAS int* lc = tab + 32;
    __syncthreads();
    if (F.tid < 32) lc[F.tid] = cnt[F.tid];
    __syncthreads();
    if (F.tid < 8) { const int L = F.tid * F.G + F.bid, mt = L / npn, pn = L % npn; int acc = 0, e_f = -1, mi_f = 0;
#pragma unroll 1
        for (int e = 0; e < NE; ++e) { const int nte = (lc[e] + 255) >> 8; if (e_f < 0 && mt < acc + nte) { e_f = e; mi_f = mt - acc; } acc += nte; }
        tab[4 * F.tid] = e_f < 0 ? -1 : mt; tab[4 * F.tid + 1] = pn; tab[4 * F.tid + 2] = e_f * npn + pn; tab[4 * F.tid + 3] = e_f | (mi_f << 8) | (F.tid << 24); }
    __syncthreads();
#pragma unroll
    for (int q = 0; q < 4; ++q) { const int idx = F.tid + NTHR * q, i = idx >> 8, r = idx & 255; int v = -1;
        if (tab[4 * i] >= 0) { const int aux = tab[4 * i + 3], e = aux & 255, ii = ((aux >> 8) & 0xFFFF) * 256 + r; if (ii < lc[e]) v = list[(size_t)e * T + ii]; }
        tkt[idx] = v; if (tkw) tkw[idx] = v >= 0 ? tokw[v] * wscale : 0.f; }
    __syncthreads();
}
struct MoeRows { static constexpr bool dense = false; const LAS int* tkt; __device__ __forceinline__ unsigned operator()(const ge::Unit& u, int r) const { const int tk = tkt[(u.aux >> 24) * 256 + r]; return tk < 0 ? (unsigned)T * (unsigned)(D * 2) : (unsigned)(tk >> 1) * (unsigned)D; } };
struct EpiMoe1 { unsigned char* hid8; float inscale;
    __device__ __forceinline__ void operator()(const f32x4 (&acc)[2][2][4][2], const ge::Unit& u, int wr, int wc, int fr, int fq) const {
        const int h0 = (4 * u.pn + wc) * 32 + 8 * fq;
#pragma unroll
        for (int ai = 0; ai < 2; ++ai)
#pragma unroll
            for (int m = 0; m < 4; ++m) { const int row = u.pm * 256 + ai * 128 + wr * 64 + m * 16 + fr; unsigned w[2];
#pragma unroll
                for (int n = 0; n < 2; ++n) { float r4[4];
#pragma unroll
                    for (int j = 0; j < 4; ++j) { const float g = acc[ai][0][m][n][j] * inscale, uu = acc[ai][1][m][n][j] * inscale; r4[j] = g * fsigmoid(g) * uu * F8_SH; }
                    w[n] = pk4_fp8(r4[0], r4[1], r4[2], r4[3]); }
                *(uint2*)(hid8 + (size_t)row * DE + h0) = make_uint2(w[0], w[1]); }
    } };
struct EpiMoe2 { bf16_t* outk; const LAS int* tkt; const LAS float* tkw;
    __device__ __forceinline__ void operator()(const f32x4 (&acc)[2][2][4][2], const ge::Unit& u, int wr, int wc, int fr, int fq) const {
        const int L0 = (4 * u.pn + wc) * 64 + 16 * fq; const int ub = (u.aux >> 24) * 256 + wr * 64 + fr; int tk[2][4]; float wt[2][4];
#pragma unroll
        for (int ai = 0; ai < 2; ++ai)
#pragma unroll
            for (int m = 0; m < 4; ++m) { tk[ai][m] = tkt[ub + ai * 128 + m * 16]; wt[ai][m] = tkw[ub + ai * 128 + m * 16]; }
#pragma unroll
        for (int ai = 0; ai < 2; ++ai)
#pragma unroll
            for (int m = 0; m < 4; ++m) { const int t_ = tk[ai][m]; if (t_ < 0) continue; const float w = wt[ai][m]; float v[16]; GE_VALS(v, acc, ai, m);
#pragma unroll
                for (int k = 0; k < 16; ++k) v[k] *= w;
                *(uint4*)((unsigned char*)outk + (size_t)(t_ & 1) * T * D + (size_t)(t_ >> 1) * D + L0) = make_uint4(pk4_fp8(v[0], v[1], v[2], v[3]), pk4_fp8(v[4], v[5], v[6], v[7]), pk4_fp8(v[8], v[9], v[10], v[11]), pk4_fp8(v[12], v[13], v[14], v[15])); }
    } };

__device__ __forceinline__ void phase_cmp2(const Params& p, const Frame& F) {
    LAS float* w2l = (LAS float*)F.lds; const int base = F.bid * 8 + F.wave;
#pragma unroll 1
    for (int w = 0; w < 2; ++w) {
        __syncthreads();
        for (int i4 = F.tid; i4 < 256 * 64 / 4; i4 += NTHR) { const float4 t4 = *(const float4*)(p.cmp_w2 + (size_t)w * 256 * 64 + 4 * i4); *(LAS f32x4*)(w2l + 4 * i4) = (f32x4){t4.x, t4.y, t4.z, t4.w}; }
        float hv[2][4];
#pragma unroll
        for (int k = 0; k < 2; ++k) { const int row = (base + (2 * w + k) * 2048) & 4095;
#pragma unroll
            for (int i = 0; i < 4; ++i) { float x = p.cb1[w * 256 + i * 64 + F.lane];
#pragma unroll
                for (int ks = 0; ks < 8; ++ks) x += bf2f(((const bf16_t*)p.cpart)[((size_t)(w * 8 + ks) * 4096 + row) * 256 + i * 64 + F.lane]);
                hv[k][i] = 0.5f * x * (1.f + ftanh(0.7978845608028654f * (x + 0.044715f * x * x * x))); } }
        __syncthreads();
        float acc0 = p.cmp_b2[w * 64 + F.lane], acc1 = acc0;
#pragma unroll
        for (int i = 0; i < 4; ++i)
#pragma unroll 8
            for (int l = 0; l < 64; ++l) { const float wv = w2l[(i * 64 + l) * 64 + F.lane]; acc0 += rdlane(hv[0][i], l) * wv; acc1 += rdlane(hv[1][i], l) * wv; }
#pragma unroll
        for (int k = 0; k < 2; ++k) { const int row = (base + (2 * w + k) * 2048) & 4095, c = row & 127; float v = k ? acc1 : acc0;
            if (w == 0) { const float ss = wave_sum(v * v); v = v * rsqrtf(ss * (1.f / 64.f) + 1e-6f) * p.k_gain[F.lane]; int pos = c * 16 + 31; if (pos > 2047) pos = 2047;
                const float other = sx<8>(v); if (F.lane < 16) { const int j = F.lane & 7; const float cs = p.rope[pos * 16 + j], sn = p.rope[pos * 16 + 8 + j]; v = (F.lane < 8) ? (v * cs - other * sn) : (v * cs + other * sn); } }
            if (c == 127) v = 0.f;
            (w == 0 ? p.kcmp : p.vcmp)[(size_t)row * 64 + F.lane] = f2bf(v); }
    }
}

typedef float f32x16 __attribute__((ext_vector_type(16)));
typedef short s16x4 __attribute__((ext_vector_type(4)));
namespace at {
constexpr int KP = 144, VP = 192;
constexpr int KBUF = 64 * KP, VBUF = 64 * VP;
constexpr int OFF_K0 = 0, OFF_K1 = KBUF, OFF_V0 = 4 * KBUF, OFF_V1 = 4 * KBUF + VBUF, OFF_IMP = 4 * KBUF + 4 * VBUF;
constexpr int IMP_PITCH = 33, OFF_SEL = OFF_IMP + 8 * 32 * IMP_PITCH * 4;
constexpr float SC = 0.125f * 1.4426950408889634f;
constexpr float NEG = -1e30f, THR = 8.0f;
__device__ __forceinline__ unsigned pk2(float a, float b) { typedef float f2 __attribute__((ext_vector_type(2))); typedef __bf16 b2 __attribute__((ext_vector_type(2))); b2 r = __builtin_convertvector((f2){a, b}, b2); return __builtin_bit_cast(unsigned, r); }
template <int OFF> __device__ __forceinline__ s16x4 tr_read(unsigned addr) { s16x4 r; asm volatile("ds_read_b64_tr_b16 %0, %1 offset:%2" : "=&v"(r) : "v"(addr), "i"(OFF) : "memory"); return r; }
struct St { f32x16 o[2]; float m, l; };

__device__ __forceinline__ void qk_tile(const LAS unsigned char* kb, int r32, int hi, const bf16x8 (&qf)[4], f32x16& s0, f32x16& s1) {
#pragma unroll
    for (int e = 0; e < 16; ++e) { s0[e] = 0.f; s1[e] = 0.f; }
#pragma unroll
    for (int ks = 0; ks < 4; ++ks) {
        const bf16x8 a0 = *(const LAS bf16x8*)(kb + r32 * KP + (16 * ks + 8 * hi) * 2);
        const bf16x8 a1 = *(const LAS bf16x8*)(kb + (32 + r32) * KP + (16 * ks + 8 * hi) * 2);
        s0 = __builtin_amdgcn_mfma_f32_32x32x16_bf16(a0, qf[ks], s0, 0, 0, 0);
        s1 = __builtin_amdgcn_mfma_f32_32x32x16_bf16(a1, qf[ks], s1, 0, 0, 0);
    }
}
template <int MODE>
__device__ __forceinline__ bool elem_valid(int kt, int e, int hi, int qloc, int t, int key0) {
    const int kl = kt * 32 + (e & 3) + 8 * (e >> 2) + 4 * hi;
    if (MODE == 1) { const int c = key0 + kl; return (c < 127) && (16 * c + 31 <= t); }
    if (MODE == 2) return kl <= qloc;
    if (MODE == 3) return kl > qloc;
    return true;
}
template <int DT> __device__ __forceinline__ void pv_read(unsigned vb_lane, s16x4 (&va)[4][2]) {
    va[0][0] = tr_read<0 * VP + 64 * DT>(vb_lane); va[0][1] = tr_read<8 * VP + 64 * DT>(vb_lane); va[1][0] = tr_read<16 * VP + 64 * DT>(vb_lane); va[1][1] = tr_read<24 * VP + 64 * DT>(vb_lane);
    va[2][0] = tr_read<32 * VP + 64 * DT>(vb_lane); va[2][1] = tr_read<40 * VP + 64 * DT>(vb_lane); va[3][0] = tr_read<48 * VP + 64 * DT>(vb_lane); va[3][1] = tr_read<56 * VP + 64 * DT>(vb_lane);
}
__device__ __forceinline__ void pv_mma(const s16x4 (&va)[4][2], const unsigned (&pp)[16], f32x16& o) {
#pragma unroll
    for (int kk = 0; kk < 4; ++kk) {
        const bf16x8 af = (bf16x8){va[kk][0][0], va[kk][0][1], va[kk][0][2], va[kk][0][3], va[kk][1][0], va[kk][1][1], va[kk][1][2], va[kk][1][3]};
        typedef unsigned u32x4 __attribute__((ext_vector_type(4)));
        const u32x4 pw = (u32x4){pp[4 * kk], pp[4 * kk + 1], pp[4 * kk + 2], pp[4 * kk + 3]};
        o = __builtin_amdgcn_mfma_f32_32x32x16_bf16(af, __builtin_bit_cast(bf16x8, pw), o, 0, 0, 0);
    }
}
__device__ __forceinline__ void pv_tile(unsigned vb_lane, const unsigned (&pp)[16], St& st) {
    s16x4 va[4][2];
    pv_read<0>(vb_lane, va); asm volatile("s_waitcnt lgkmcnt(0)" ::: "memory"); __builtin_amdgcn_sched_barrier(0); pv_mma(va, pp, st.o[0]);
    pv_read<1>(vb_lane, va); asm volatile("s_waitcnt lgkmcnt(0)" ::: "memory"); __builtin_amdgcn_sched_barrier(0); pv_mma(va, pp, st.o[1]);
}
__device__ __forceinline__ float max3f(float a, float b, float c) { float r; asm("v_max3_f32 %0, %1, %2, %3" : "=v"(r) : "v"(a), "v"(b), "v"(c)); return r; }
template <int KK> __device__ __forceinline__ void pv_read_slice(unsigned vb_lane, s16x4 (&v)[2][2]) {
    v[0][0] = tr_read<(16 * KK) * VP>(vb_lane); v[0][1] = tr_read<(16 * KK + 8) * VP>(vb_lane); v[1][0] = tr_read<(16 * KK) * VP + 64>(vb_lane); v[1][1] = tr_read<(16 * KK + 8) * VP + 64>(vb_lane);
}
template <bool GATED> __device__ __forceinline__ void sm_pack_mma(const float (&pe)[8], const s16x4 (&v)[2][2], St& st, float& rs, bool en) {
    typedef unsigned u32x4 __attribute__((ext_vector_type(4))); u32x4 pw;
#pragma unroll
    for (int i = 0; i < 4; ++i) { pw[i] = pk2(pe[2 * i], pe[2 * i + 1]); if (GATED) pw[i] = en ? pw[i] : 0u; }
    float t = ((pe[0] + pe[1]) + (pe[2] + pe[3])) + ((pe[4] + pe[5]) + (pe[6] + pe[7])); if (GATED) t = en ? t : 0.f; rs += t;
    const bf16x8 pb = __builtin_bit_cast(bf16x8, pw);
    const bf16x8 a0 = (bf16x8){v[0][0][0], v[0][0][1], v[0][0][2], v[0][0][3], v[0][1][0], v[0][1][1], v[0][1][2], v[0][1][3]};
    const bf16x8 a1 = (bf16x8){v[1][0][0], v[1][0][1], v[1][0][2], v[1][0][3], v[1][1][0], v[1][1][1], v[1][1][2], v[1][1][3]};
    st.o[0] = __builtin_amdgcn_mfma_f32_32x32x16_bf16(a0, pb, st.o[0], 0, 0, 0);
    st.o[1] = __builtin_amdgcn_mfma_f32_32x32x16_bf16(a1, pb, st.o[1], 0, 0, 0);
}
template <bool GATED> __device__ __forceinline__ void sm_slice(const f32x16& sc, const int e0, const s16x4 (&v)[2][2], St& st, float& rs, bool en) {
    float pe[8];
#pragma unroll
    for (int i = 0; i < 8; ++i) pe[i] = __builtin_amdgcn_exp2f(sc[e0 + i]);
    sm_pack_mma<GATED>(pe, v, st, rs, en);
}
template <int MODE, bool GATED, bool FIXED>
__device__ __forceinline__ void attend_tile(const LAS unsigned char* kb, unsigned vb_lane, int r32, int hi, const bf16x8 (&qf)[4], St& st, int qloc, bool en, float mfix) {
    if constexpr (FIXED) {
        f32x16 s0, s1; bf16x8 ka0[4], ka1[4];
#pragma unroll
        for (int ks = 0; ks < 4; ++ks) { ka0[ks] = *(const LAS bf16x8*)(kb + r32 * KP + (16 * ks + 8 * hi) * 2); ka1[ks] = *(const LAS bf16x8*)(kb + (32 + r32) * KP + (16 * ks + 8 * hi) * 2); }
        s16x4 v0[2][2], v1[2][2], v2[2][2], v3[2][2];
        pv_read_slice<0>(vb_lane, v0); pv_read_slice<1>(vb_lane, v1);
#pragma unroll
        for (int e = 0; e < 16; ++e) { s0[e] = 0.f; s1[e] = 0.f; }
#pragma unroll
        for (int ks = 0; ks < 4; ++ks) s0 = __builtin_amdgcn_mfma_f32_32x32x16_bf16(ka0[ks], qf[ks], s0, 0, 0, 0);
        if (MODE != 0) {
#pragma unroll
            for (int e = 0; e < 16; ++e) s0[e] = elem_valid<MODE>(0, e, hi, qloc, 0, 0) ? s0[e] : NEG; }
        float rs = 0.f; float pe0[8];
#pragma unroll
        for (int ks = 0; ks < 4; ++ks) { s1 = __builtin_amdgcn_mfma_f32_32x32x16_bf16(ka1[ks], qf[ks], s1, 0, 0, 0); pe0[2 * ks] = __builtin_amdgcn_exp2f(s0[2 * ks]); pe0[2 * ks + 1] = __builtin_amdgcn_exp2f(s0[2 * ks + 1]); __builtin_amdgcn_sched_barrier(0); }
        if (MODE != 0) {
#pragma unroll
            for (int e = 0; e < 16; ++e) s1[e] = elem_valid<MODE>(1, e, hi, qloc, 0, 0) ? s1[e] : NEG; }
        asm volatile("s_waitcnt lgkmcnt(4)" ::: "memory"); __builtin_amdgcn_sched_barrier(0); sm_pack_mma<GATED>(pe0, v0, st, rs, en); __builtin_amdgcn_sched_barrier(0);
        pv_read_slice<2>(vb_lane, v2);
        asm volatile("s_waitcnt lgkmcnt(4)" ::: "memory"); __builtin_amdgcn_sched_barrier(0); sm_slice<GATED>(s0, 8, v1, st, rs, en); __builtin_amdgcn_sched_barrier(0);
        pv_read_slice<3>(vb_lane, v3);
        asm volatile("s_waitcnt lgkmcnt(4)" ::: "memory"); __builtin_amdgcn_sched_barrier(0); sm_slice<GATED>(s1, 0, v2, st, rs, en); __builtin_amdgcn_sched_barrier(0);
        asm volatile("s_waitcnt lgkmcnt(0)" ::: "memory"); __builtin_amdgcn_sched_barrier(0); sm_slice<GATED>(s1, 8, v3, st, rs, en);
        st.l += rs;
        return;
    }
    f32x16 s0, s1; qk_tile(kb, r32, hi, qf, s0, s1);
    s16x4 va0[4][2]; pv_read<0>(vb_lane, va0);
    if (MODE != 0) {
#pragma unroll
        for (int e = 0; e < 16; ++e) { s0[e] = elem_valid<MODE>(0, e, hi, qloc, 0, 0) ? s0[e] : NEG; s1[e] = elem_valid<MODE>(1, e, hi, qloc, 0, 0) ? s1[e] : NEG; }
    }
    float mc = 0.f;
    if (FIXED) {
    } else {
        float mx = max3f(s0[0], s0[1], s1[0]);
#pragma unroll
        for (int e = 2; e < 16; e += 2) mx = max3f(mx, s0[e], s0[e + 1]);
#pragma unroll
        for (int e = 1; e < 15; e += 2) mx = max3f(mx, s1[e], s1[e + 1]);
        mx = fmaxf(mx, s1[15]);
        if (GATED) mx = en ? mx : NEG;
        mx = max32(mx);
        float mold = st.m;
        if (__any((mx - mold) * SC > THR)) {
            const float mnew = fmaxf(mold, mx); const float al = __builtin_amdgcn_exp2f((mold - mnew) * SC);
#pragma unroll
            for (int e = 0; e < 16; ++e) { st.o[0][e] *= al; st.o[1][e] *= al; }
            st.l *= al; st.m = mnew; mold = mnew;
        }
        mc = fmaxf(mold, -1e20f) * SC; if (GATED) mc = en ? mc : 3e38f;
    }
    float rs = 0.f; unsigned pp[16];
#pragma unroll
    for (int e = 0; e < 16; e += 2) {
        float a0, a1, b0, b1;
        if (FIXED) { a0 = __builtin_amdgcn_exp2f(s0[e]); a1 = __builtin_amdgcn_exp2f(s0[e + 1]); b0 = __builtin_amdgcn_exp2f(s1[e]); b1 = __builtin_amdgcn_exp2f(s1[e + 1]); }
        else { a0 = __builtin_amdgcn_exp2f(__builtin_fmaf(s0[e], SC, -mc)); a1 = __builtin_amdgcn_exp2f(__builtin_fmaf(s0[e + 1], SC, -mc)); b0 = __builtin_amdgcn_exp2f(__builtin_fmaf(s1[e], SC, -mc)); b1 = __builtin_amdgcn_exp2f(__builtin_fmaf(s1[e + 1], SC, -mc)); }
        rs += (a0 + a1) + (b0 + b1); pp[e >> 1] = pk2(a0, a1); pp[8 + (e >> 1)] = pk2(b0, b1); }
    if (FIXED && GATED) {
#pragma unroll
        for (int i = 0; i < 16; ++i) pp[i] = en ? pp[i] : 0u;
        rs = en ? rs : 0.f; }
    if (!FIXED) rs = sum32(rs);
    st.l += rs;
    asm volatile("s_waitcnt lgkmcnt(0)" ::: "memory"); __builtin_amdgcn_sched_barrier(0); pv_mma(va0, pp, st.o[0]);
    { s16x4 va1[4][2]; pv_read<1>(vb_lane, va1); asm volatile("s_waitcnt lgkmcnt(0)" ::: "memory"); __builtin_amdgcn_sched_barrier(0); pv_mma(va1, pp, st.o[1]); }
}
__device__ __forceinline__ void st_reset(St& st) {
#pragma unroll
    for (int a = 0; a < 2; ++a)
#pragma unroll
        for (int e = 0; e < 16; ++e) st.o[a][e] = 0.f;
    st.m = NEG; st.l = 0.f;
}
__device__ __forceinline__ void st_flush(const St& st, unsigned (&ofin)[2][8], float g, bool first) {
    const float f = (st.l > 0.f ? 1.f / st.l : 0.f) * g;
#pragma unroll
    for (int dt = 0; dt < 2; ++dt)
#pragma unroll
        for (int e = 0; e < 16; e += 2) { float a = st.o[dt][e] * f, b = st.o[dt][e + 1] * f;
            if (!first) { const unsigned w = ofin[dt][e >> 1]; a += __uint_as_float(w << 16); b += __uint_as_float(w & 0xFFFF0000u); }
            ofin[dt][e >> 1] = pk2(a, b); }
#pragma unroll
    for (int dt = 0; dt < 2; ++dt) asm volatile("" : "+v"(ofin[dt][0]), "+v"(ofin[dt][1]), "+v"(ofin[dt][2]), "+v"(ofin[dt][3]), "+v"(ofin[dt][4]), "+v"(ofin[dt][5]), "+v"(ofin[dt][6]), "+v"(ofin[dt][7]));
}
__device__ __forceinline__ void tile_load(const bf16_t* kbase, const bf16_t* vbase, int key0, int tid, uint4& kr, uint4& vr) {
    const size_t o = (size_t)(key0 + (tid >> 3)) * 64 + (tid & 7) * 8; kr = *(const uint4*)(kbase + o); vr = *(const uint4*)(vbase + o); }
typedef unsigned u32x4_t __attribute__((ext_vector_type(4)));
__device__ __forceinline__ void tile_store(LAS unsigned char* lds, int buf, int tid, const uint4& kr, const uint4& vr) {
    *(LAS u32x4_t*)(lds + OFF_K0 + buf * KBUF + (tid >> 3) * KP + (tid & 7) * 16) = (u32x4_t){kr.x, kr.y, kr.z, kr.w}; *(LAS u32x4_t*)(lds + OFF_V0 + buf * VBUF + (tid >> 3) * VP + (tid & 7) * 16) = (u32x4_t){vr.x, vr.y, vr.z, vr.w}; }
}

template <bool FIXED>
__device__ __forceinline__ void phase_attn_t(const Params& p, const Frame& F, const float mfix) {
    using namespace at;
    LAS unsigned char* lds = F.lds;
    const int tid = F.tid, lane = F.lane, w = F.wave, r32 = lane & 31, hi = lane >> 5;
    const unsigned vlane = (unsigned)((4 * hi + ((lane & 15) >> 2)) * VP + (16 * ((lane >> 4) & 1) + 4 * (lane & 3)) * 2);
    LAS float* impw = (LAS float*)(lds + OFF_IMP) + w * 32 * IMP_PITCH;
    LAS unsigned* selm = (LAS unsigned*)(lds + OFF_SEL);
    LAS float* invl = (LAS float*)(lds + OFF_SEL + 512);
#define AT_UNIT(ui_, qb_, bg_, qoff_) const int idx_##qb_ = ((ui_) & 1) ? ((ui_) * 256 + 255 - F.bid) : ((ui_) * 256 + F.bid); const int qb_ = 31 - (idx_##qb_ >> 6), bg_ = (idx_##qb_ >> 1) & 31, qoff_ = (idx_##qb_ & 1) * 32
    bf16x8 qf[4]; float gt[3]; uint4 kr, vr, kr1, vr1;
    { AT_UNIT(0, qb, bg, qoff);
      const bf16_t* kc = p.kcmp + (size_t)bg * 128 * 64; const bf16_t* vc = p.vcmp + (size_t)bg * 128 * 64;
      tile_load(kc, vc, 0, tid, kr, vr); if (qb >= 16) tile_load(kc, vc, 64, tid, kr1, vr1); }
#pragma unroll 1
    for (int ui = 0; ui < 8; ++ui) {
        AT_UNIT(ui, qb, bg, qoff);
        const int b = bg >> 1, g = bg & 1, head = g * 8 + w, s0 = qb * 64;
        const int qloc = qoff + r32, t = s0 + qloc;
        const bf16_t* ksel = p.kv + (size_t)2 * T * 128 + (size_t)bg * S * 64; const bf16_t* vsel = p.kv + (size_t)3 * T * 128 + (size_t)bg * S * 64;
        const bf16_t* kwin = p.kv + (size_t)4 * T * 128 + (size_t)bg * S * 64; const bf16_t* vwin = p.kv + (size_t)5 * T * 128 + (size_t)bg * S * 64;
        unsigned ofin[2][8]; St st;
        { const size_t tok = (size_t)b * S + t;
#pragma unroll
          for (int ks = 0; ks < 4; ++ks) { qf[ks] = *(const bf16x8*)(p.q + tok * D + head * 64 + 16 * ks + 8 * hi);
              if (FIXED) { typedef unsigned u32x4q __attribute__((ext_vector_type(4))); const u32x4q w4 = __builtin_bit_cast(u32x4q, qf[ks]); u32x4q r4;
#pragma unroll
                  for (int i = 0; i < 4; ++i) r4[i] = pk2(__uint_as_float(w4[i] << 16) * SC, __uint_as_float(w4[i] & 0xFFFF0000u) * SC);
                  qf[ks] = __builtin_bit_cast(bf16x8, r4); } }
#pragma unroll
          for (int br = 0; br < 3; ++br) gt[br] = p.gates[tok * 48 + br * 16 + head]; }
        const int nct = (qb >= 16) ? 2 : 1;
        __syncthreads();
        tile_store(lds, 0, tid, kr, vr); if (nct == 2) tile_store(lds, 1, tid, kr1, vr1);
        tile_load(ksel, vsel, qb * 64, tid, kr, vr);
        __syncthreads();
        float cm = NEG, cl = 0.f;
        if (!FIXED) {
#pragma unroll 1
        for (int ct = 0; ct < nct; ++ct) { const LAS unsigned char* kb = lds + (ct ? OFF_K1 : OFF_K0);
            f32x16 a0, a1; qk_tile(kb, r32, hi, qf, a0, a1); float mx = NEG;
#pragma unroll
            for (int e = 0; e < 16; ++e) { a0[e] = elem_valid<1>(0, e, hi, qloc, t, ct * 64) ? a0[e] : NEG; a1[e] = elem_valid<1>(1, e, hi, qloc, t, ct * 64) ? a1[e] : NEG; mx = fmaxf(mx, fmaxf(a0[e], a1[e])); }
            mx = max32(mx); const float mnew = fmaxf(cm, mx); float rs = 0.f;
#pragma unroll
            for (int e = 0; e < 16; ++e) { rs += (a0[e] > -1e29f ? __builtin_amdgcn_exp2f((a0[e] - mnew) * SC) : 0.f) + (a1[e] > -1e29f ? __builtin_amdgcn_exp2f((a1[e] - mnew) * SC) : 0.f); }
            rs = sum32(rs); cl = cl * __builtin_amdgcn_exp2f((cm - mnew) * SC) + rs; cm = mnew; }
        }
        st_reset(st); if (FIXED) cm = mfix / SC; else st.m = cm;
        const float icl = FIXED ? 1.f : (cl > 0.f ? 1.f / cl : 0.f);
        LAS float* irow = impw + r32 * IMP_PITCH;
        if (nct == 1) {
#pragma unroll 1
            for (int j = 16; j < 32; ++j) irow[j] = 0.f; }
#pragma unroll 1
        for (int ct = 0; ct < nct; ++ct) { const LAS unsigned char* kb = lds + (ct ? OFF_K1 : OFF_K0); const unsigned vb = (unsigned)(unsigned long)(lds + (ct ? OFF_V1 : OFF_V0)) + vlane;
            f32x16 a0, a1; qk_tile(kb, r32, hi, qf, a0, a1); const float mc = cm * SC; unsigned pp[16]; float rs = 0.f; float Ai[8], Fi[8];
            int clim = (t - 31) >> 4; clim = (clim > 126 ? 126 : clim) - 4 * hi - ct * 64;
#pragma unroll
            for (int kt = 0; kt < 2; ++kt)
#pragma unroll
                for (int gq = 0; gq < 4; ++gq) { float pv[4];
#pragma unroll
                    for (int e2 = 0; e2 < 4; ++e2) { const int e = gq * 4 + e2; const float sv = kt ? a1[e] : a0[e]; pv[e2] = (kt * 32 + (e & 3) + 8 * (e >> 2) <= clim) ? (FIXED ? __builtin_amdgcn_exp2f(sv) : __builtin_amdgcn_exp2f(sv * SC - mc)) : 0.f; }
                    pp[kt * 8 + gq * 2] = pk2(pv[0], pv[1]); pp[kt * 8 + gq * 2 + 1] = pk2(pv[2], pv[3]); rs += (pv[0] + pv[1]) + (pv[2] + pv[3]);
                    Ai[kt * 4 + gq] = (pv[0] + 2.f * (pv[1] + pv[2] + pv[3])) * icl; Fi[kt * 4 + gq] = pv[0] * icl; }
            st.l += rs;
            float Fr[8];
#pragma unroll
            for (int g8 = 0; g8 < 8; ++g8) Fr[g8] = other32(Fi[g8], hi != 0);
#pragma unroll
            for (int g8 = 0; g8 < 8; ++g8) { const float nxt = (g8 < 7) ? Fr[g8 + 1] : 0.f;
                irow[ct * 16 + 2 * g8 + hi] = Ai[g8] + (hi ? nxt : Fr[g8]); }
            if (ct == 1 && hi) irow[15] += Fr[0];
            pv_tile(vb, pp, st); }
        st.l = sum32(st.l);
        if (hi == 0) invl[w * 32 + r32] = FIXED ? (st.l > 0.f ? 1.f / st.l : 0.f) : 1.f;
        tile_store(lds, 2, tid, kr, vr);
        st_flush(st, ofin, gt[0], true);
        if (tid == 0) selm[32] = 0u;
        __syncthreads();
        { const int q_ = 4 * w + (lane >> 4), l16 = lane & 15; unsigned mask;
            if (qb < 8) mask = (2u << qb) - 1u;
            else { mask = 1u | (1u << qb) | (1u << (qb - 1));
                const LAS float* ib = (const LAS float*)(lds + OFF_IMP) + q_ * IMP_PITCH + l16; float v0 = 0.f, v1 = 0.f;
#pragma unroll
                for (int ww = 0; ww < 8; ++ww) { const float il = invl[ww * 32 + q_]; v0 += ib[ww * 32 * IMP_PITCH] * il; v1 += ib[ww * 32 * IMP_PITCH + 16] * il; }
                v0 = (l16 >= 1 && l16 <= qb - 2) ? v0 : -3e38f; v1 = (l16 + 16 <= qb - 2 && l16 + 16 <= 30) ? v1 : -3e38f;
#pragma unroll 1
                for (int pick = 0; pick < 5; ++pick) { float m = fmaxf(v0, v1);
                    m = fmaxf(m, dppf<0xB1>(m)); m = fmaxf(m, dppf<0x4E>(m)); m = fmaxf(m, dppf<0x141>(m)); m = fmaxf(m, dppf<0x140>(m));
                    int cand = (v0 == m) ? l16 : ((v1 == m) ? l16 + 16 : 99);
                    cand = min(cand, __builtin_amdgcn_update_dpp(0, cand, 0xB1, 0xF, 0xF, true)); cand = min(cand, __builtin_amdgcn_update_dpp(0, cand, 0x4E, 0xF, 0xF, true));
                    cand = min(cand, __builtin_amdgcn_update_dpp(0, cand, 0x141, 0xF, 0xF, true)); cand = min(cand, __builtin_amdgcn_update_dpp(0, cand, 0x140, 0xF, 0xF, true));
                    if (m > -3e38f) { mask |= 1u << cand; v0 = (cand == l16) ? -3e38f : v0; v1 = (cand == l16 + 16) ? -3e38f : v1; } } }
            if (l16 == 0) { selm[q_] = mask; __atomic_fetch_or(&selm[32], mask, __ATOMIC_RELAXED); } }
        __syncthreads();
        const int jlo = qb >= 8 ? qb - 8 : 0;
        { const unsigned um = selm[32]; const unsigned mq = selm[r32];
          st_reset(st);
          unsigned rem = um & ~(1u << qb);
#define SEL_POP(dst) do { if (rem) { dst = 31 - __builtin_clz(rem); rem &= ~(1u << dst); } else dst = -1; } while (0)
          int jA = qb, jB = -1, sb = 1;
          for (;;) {
              int nA, nB = -1; SEL_POP(nA); if (nA >= 0) SEL_POP(nB);
              if (nA >= 0) tile_load(ksel, vsel, nA * 64, tid, kr, vr);
              if (nB >= 0) tile_load(ksel, vsel, nB * 64, tid, kr1, vr1);
              if (nA < 0) { tile_load(kwin, vwin, qb * 64, tid, kr, vr); if (qb - 1 >= jlo) tile_load(kwin, vwin, (qb - 1) * 64, tid, kr1, vr1); }
              { const LAS unsigned char* kb = lds + OFF_K0 + (2 * sb) * KBUF; const unsigned vb = (unsigned)(unsigned long)(lds + OFF_V0 + (2 * sb) * VBUF) + vlane;
                if (jA == qb) attend_tile<2, false, FIXED>(kb, vb, r32, hi, qf, st, qloc, true, mfix);
                else attend_tile<0, true, FIXED>(kb, vb, r32, hi, qf, st, qloc, (mq >> jA) & 1u, mfix); }
              if (jB >= 0) { const LAS unsigned char* kb = lds + OFF_K0 + (2 * sb + 1) * KBUF; const unsigned vb = (unsigned)(unsigned long)(lds + OFF_V0 + (2 * sb + 1) * VBUF) + vlane;
                attend_tile<0, true, FIXED>(kb, vb, r32, hi, qf, st, qloc, (mq >> jB) & 1u, mfix); }
              if (nA < 0) break;
              tile_store(lds, 2 * (sb ^ 1), tid, kr, vr); if (nB >= 0) tile_store(lds, 2 * (sb ^ 1) + 1, tid, kr1, vr1);
              __syncthreads();
              jA = nA; jB = nB; sb ^= 1;
          }
#undef SEL_POP
          if (FIXED) st.l = sum32(st.l);
          st_flush(st, ofin, gt[1], false); }
        __syncthreads();
        { st_reset(st);
          int jA = qb, jB = (qb - 1 >= jlo) ? qb - 1 : -1, sb = 0;
          tile_store(lds, 0, tid, kr, vr); if (jB >= 0) tile_store(lds, 1, tid, kr1, vr1);
          __syncthreads();
          for (;;) {
              const int nA = (jB >= 0 && jB - 1 >= jlo) ? jB - 1 : -1, nB = (nA >= 0 && nA - 1 >= jlo) ? nA - 1 : -1;
              if (nA >= 0) tile_load(kwin, vwin, nA * 64, tid, kr, vr);
              if (nB >= 0) tile_load(kwin, vwin, nB * 64, tid, kr1, vr1);
              if (nA < 0 && ui + 1 < 8) {
                  AT_UNIT(ui + 1, qbn, bgn, qoffn);
                  const bf16_t* kcn = p.kcmp + (size_t)bgn * 128 * 64; const bf16_t* vcn = p.vcmp + (size_t)bgn * 128 * 64;
                  tile_load(kcn, vcn, 0, tid, kr, vr); if (qbn >= 16) tile_load(kcn, vcn, 64, tid, kr1, vr1); }
#define WIN_TILE(j_, bi_) do { const LAS unsigned char* kb = lds + OFF_K0 + (bi_) * KBUF; const unsigned vb = (unsigned)(unsigned long)(lds + OFF_V0 + (bi_) * VBUF) + vlane; \
                if ((j_) == qb) attend_tile<2, false, FIXED>(kb, vb, r32, hi, qf, st, qloc, true, mfix); else if ((j_) == qb - 8) attend_tile<3, false, FIXED>(kb, vb, r32, hi, qf, st, qloc, true, mfix); else attend_tile<0, false, FIXED>(kb, vb, r32, hi, qf, st, qloc, true, mfix); } while (0)
              WIN_TILE(jA, 2 * sb);
              if (jB >= 0) WIN_TILE(jB, 2 * sb + 1);
#undef WIN_TILE
              if (nA < 0) break;
              tile_store(lds, 2 * (sb ^ 1), tid, kr, vr); if (nB >= 0) tile_store(lds, 2 * (sb ^ 1) + 1, tid, kr1, vr1);
              __syncthreads();
              jA = nA; jB = nB; sb ^= 1;
          }
          if (FIXED) st.l = sum32(st.l);
          st_flush(st, ofin, gt[2], false); }
        { int l2 = lane; asm volatile("" : "+v"(l2)); unsigned char* op = (unsigned char*)p.h + ((size_t)b * S + s0 + qoff + (l2 & 31)) * D + head * 64 + 4 * (l2 >> 5);
#pragma unroll
          for (int dt = 0; dt < 2; ++dt)
#pragma unroll
            for (int gq = 0; gq < 4; ++gq) { const unsigned w0 = ofin[dt][2 * gq], w1 = ofin[dt][2 * gq + 1];
                *(unsigned*)(op + dt * 32 + 8 * gq) = pk4_fp8(__uint_as_float(w0 << 16) * F8_SA, __uint_as_float(w0 & 0xFFFF0000u) * F8_SA, __uint_as_float(w1 << 16) * F8_SA, __uint_as_float(w1 & 0xFFFF0000u) * F8_SA); } }
    }
#undef AT_UNIT
}

__device__ __forceinline__ void phase_attn(const Params& p, const Frame& F) {
    const float gq = wave_max(fabsf(p.q_gain[F.lane])); const float gk = wave_max(fmaxf(fabsf(p.k_gain[F.lane]), fmaxf(fabsf(p.k_gain[64 + F.lane]), fabsf(p.k_gain[128 + F.lane]))));
    const float mfix = 64.f * 1.02f * gq * gk * at::SC;
    if (mfix < 60.f) phase_attn_t<true>(p, F, mfix);
    else phase_attn_t<false>(p, F, 0.f);
}

namespace ml {
constexpr int QP = 272, VP = 192;
constexpr int OFF_Q = 0, OFF_K = 64 * QP, OFF_V = 2 * 64 * QP, OFF_WV = OFF_V + 64 * VP, OFF_CB = OFF_WV + 64 * VP, OFF_GA = OFF_CB + 128 * VP, OFF_GAM = OFF_GA + 8192, OFF_GB = OFF_GAM + 8192,
              OFF_MP = OFF_GB + 8192, OFF_W = OFF_MP + 256, OFF_N = OFF_W + 256, OFF_RS = OFF_N + 512, OFF_QN = OFF_RS + 256, OFF_END = OFF_QN + 256;
typedef unsigned u32x4_t __attribute__((ext_vector_type(4)));
}
__device__ __forceinline__ void phase_scan(const Params& p, const Frame& F, bf16_t* hs_base  , const int hs_stride) {
    using namespace ml; using at::tr_read; using at::pk2;
    LAS unsigned char* lds = F.lds;
    const int tid = F.tid, lane = F.lane, w = F.wave, i16 = lane & 15, g = lane >> 4, r32 = lane & 31, hi = lane >> 5;
    const int b = F.bid >> 4, h = (F.bid >> 2) & 3, vs = F.bid & 3;
    LAS float* ga = (LAS float*)(lds + OFF_GA); LAS float* gam = (LAS float*)(lds + OFF_GAM); LAS float* gb = (LAS float*)(lds + OFF_GB); LAS float* mp = (LAS float*)(lds + OFF_MP);
    LAS float* wl = (LAS float*)(lds + OFF_W); LAS float* nl = (LAS float*)(lds + OFF_N); LAS float* rsl = (LAS float*)(lds + OFF_RS); LAS float* qnl = (LAS float*)(lds + OFF_QN);
    for (int ck = w; ck < 32; ck += 8) { const int pos = ck * 64 + lane; const size_t tg = ((size_t)b * S + pos) * 4 + h; const float lfv = p.lf[tg], liv = p.li[tg];
        float bs = lfv;
#pragma unroll
        for (int o = 1; o < 64; o <<= 1) { const float x = __int_as_float(__builtin_amdgcn_ds_bpermute((lane - o) * 4, __float_as_int(bs))); if (lane >= o) bs += x; }
        const float av = liv - bs; float am = av;
#pragma unroll
        for (int o = 1; o < 64; o <<= 1) { const float x = __int_as_float(__builtin_amdgcn_ds_bpermute((lane - o) * 4, __float_as_int(am))); if (lane >= o) am = fmaxf(am, x); }
        ga[pos] = av; gam[pos] = am; gb[pos] = bs; }
    for (int idx = tid; idx < 128 * VP / 4; idx += NTHR) ((LAS unsigned*)(lds + OFF_CB))[idx] = 0u;
    if (tid < 128) nl[tid] = 0.f;
    __syncthreads();
    if (tid == 0) { float m = 0.f;
#pragma unroll 1
        for (int k = 0; k < 32; ++k) { mp[k] = m; m = gb[k * 64 + 63] + fmaxf(m, gam[k * 64 + 63]); } }
    __syncthreads();
    const bf16_t* pq = p.proj + (size_t)b * S * 3072 + h * 128; const bf16_t* pk = pq + 512; bf16_t* pv = p.proj + (size_t)b * S * 3072 + 1024 + h * 256 + vs * 64;
    uint4 rq[2], rk[2], rv;
#define ML_LOAD(ck_) do { const size_t t0_ = (size_t)(ck_) * 64; _Pragma("unroll") for (int i_ = 0; i_ < 2; ++i_) { const int idx_ = tid + 512 * i_; const size_t o_ = (t0_ + (idx_ >> 4)) * 3072 + (idx_ & 15) * 8; rq[i_] = *(const uint4*)(pq + o_); rk[i_] = *(const uint4*)(pk + o_); } \
        rv = *(const uint4*)(pv + (t0_ + (tid >> 3)) * 3072 + (tid & 7) * 8); } while (0)
#define ML_STORE(ck_) do { _Pragma("unroll") for (int i_ = 0; i_ < 2; ++i_) { const int idx_ = tid + 512 * i_; const int o_ = (idx_ >> 4) * QP + (idx_ & 15) * 16; \
            *(LAS u32x4_t*)(lds + OFF_Q + o_) = (u32x4_t){rq[i_].x, rq[i_].y, rq[i_].z, rq[i_].w}; *(LAS u32x4_t*)(lds + OFF_K + o_) = (u32x4_t){rk[i_].x, rk[i_].y, rk[i_].z, rk[i_].w}; } \
        { const int s_ = tid >> 3; const float m63_ = fmaxf(mp[ck_], gam[(ck_) * 64 + 63]); const float ws_ = __expf(ga[(ck_) * 64 + s_] - m63_); if ((tid & 7) == 0) wl[s_] = ws_; \
          const int o_ = s_ * VP + (tid & 7) * 16; *(LAS u32x4_t*)(lds + OFF_V + o_) = (u32x4_t){rv.x, rv.y, rv.z, rv.w}; const unsigned vv_[4] = {rv.x, rv.y, rv.z, rv.w}; unsigned ww_[4]; \
          _Pragma("unroll") for (int e_ = 0; e_ < 4; ++e_) ww_[e_] = pk2(__uint_as_float(vv_[e_] << 16) * ws_, __uint_as_float(vv_[e_] & 0xFFFF0000u) * ws_); \
          *(LAS u32x4_t*)(lds + OFF_WV + o_) = (u32x4_t){ww_[0], ww_[1], ww_[2], ww_[3]}; } } while (0)
    ML_LOAD(0); ML_STORE(0);
    __syncthreads();
    const int tt = w >> 1, vh = w & 1;
    const int dt = w >> 1, vt2 = w & 1;
    const unsigned trl16 = (unsigned)(((lane & 15) >> 2) * VP + (4 * (lane & 3)) * 2);
    const unsigned trl32v = (unsigned)(((lane & 15) >> 2) * VP + (16 * ((lane >> 4) & 1) + 4 * (lane & 3)) * 2);
    const unsigned trl32k = (unsigned)(((lane & 15) >> 2) * QP + (16 * ((lane >> 4) & 1) + 4 * (lane & 3)) * 2);
    f32x16 cacc;
#pragma unroll
    for (int e = 0; e < 16; ++e) cacc[e] = 0.f;
    float nreg = 0.f;
    bf16_t* const hs_out = hs_base + (size_t)b * S * hs_stride + h * 256 + vs * 64 + 32 * vh + i16;
    const size_t wo1 = (size_t)NE * D * DE; const ColGateUp cgu{p.w_gate + wo1, p.w_up + wo1}; const ColDown cdn{p.w_down + wo1};
    LAS float* ptile = (LAS float*)(lds + OFF_END) + (tid >> 8) * (64 * 65); const int htid = tid & 255, half = tid >> 8;
    float pr_[16];
#define PREP_LOAD(s_) do { const bool gu_ = (s_) < 16; const int tl_ = (((gu_ ? (s_) : (s_) - 16) * F.G + F.bid) * 2 + half); const int c0_ = (tl_ & 511) * 64, k0_ = (tl_ >> 9) * 64; \
        const float* p_ = gu_ ? cgu(c0_ + (htid & 63)) : cdn(c0_ + (htid & 63)); const int ldw_ = gu_ ? DE : D; p_ += (size_t)(k0_ + (htid >> 6)) * ldw_; \
        _Pragma("unroll") for (int i_ = 0; i_ < 16; ++i_) pr_[i_] = p_[(size_t)(4 * i_) * ldw_]; } while (0)
#define PREP_WRITE() do { _Pragma("unroll") for (int i_ = 0; i_ < 16; ++i_) ptile[((htid >> 6) + 4 * i_) * 65 + (htid & 63)] = pr_[i_]; } while (0)
#define PREP_STORE(s_) do { const bool gu_ = (s_) < 16; const int tl_ = (((gu_ ? (s_) : (s_) - 16) * F.G + F.bid) * 2 + half); const int c0_ = (tl_ & 511) * 64, k0_ = (tl_ >> 9) * 64; \
        const int cc_ = htid >> 2, ch_ = (htid & 3) * 16; \
        { const float sc_ = gu_ ? F8_SW : F8_SW2; const unsigned long long a_ = (unsigned long long)p.gu_t, d_ = (unsigned long long)p.dn_t - a_; unsigned char* base_ = (unsigned char*)(a_ + (gu_ ? 0ull : d_)); const int kp_ = gu_ ? D : DE; \
          unsigned w_[4]; _Pragma("unroll") for (int i_ = 0; i_ < 4; ++i_) w_[i_] = pk4_fp8(ptile[(ch_ + 4 * i_) * 65 + cc_] * sc_, ptile[(ch_ + 4 * i_ + 1) * 65 + cc_] * sc_, ptile[(ch_ + 4 * i_ + 2) * 65 + cc_] * sc_, ptile[(ch_ + 4 * i_ + 3) * 65 + cc_] * sc_); \
          *(uint4*)(base_ + (size_t)(c0_ + cc_) * kp_ + k0_ + ch_) = make_uint4(w_[0], w_[1], w_[2], w_[3]); } } while (0)
    PREP_LOAD(0);
#pragma unroll 1
    for (int ck = 0; ck < 32; ++ck) {
        if (ck + 1 < 32) ML_LOAD(ck + 1);
        const float mprev = mp[ck]; const int c0 = ck * 64;
        bf16x8 qf[4];
#pragma unroll
        for (int ks = 0; ks < 4; ++ks) qf[ks] = *(const LAS bf16x8*)(lds + OFF_Q + (16 * tt + i16) * QP + (32 * ks + 8 * g) * 2);
        f32x4 st[4];
#pragma unroll
        for (int jt = 0; jt < 4; ++jt) { st[jt] = (f32x4){0.f, 0.f, 0.f, 0.f};
#pragma unroll
            for (int ks = 0; ks < 4; ++ks) { const bf16x8 kf = *(const LAS bf16x8*)(lds + OFF_K + (16 * jt + i16) * QP + (32 * ks + 8 * g) * 2); st[jt] = __builtin_amdgcn_mfma_f32_16x16x32_bf16(kf, qf[ks], st[jt], 0, 0, 0); } }
        const int tl = 16 * tt + i16; const float Mt = fmaxf(mprev, gam[c0 + tl]); float rs = 0.f; unsigned ap[8];
#pragma unroll
        for (int jt = 0; jt < 4; ++jt) { float v4[4]; const f32x4 ga4 = *(const LAS f32x4*)(ga + c0 + 16 * jt + 4 * g);
#pragma unroll
            for (int r = 0; r < 4; ++r) { const int j = 16 * jt + 4 * g + r; const float e = __expf(ga4[r] - Mt) * st[jt][r]; v4[r] = (j <= tl) ? e : 0.f; rs += v4[r]; }
            ap[jt * 2] = pk2(v4[0], v4[1]); ap[jt * 2 + 1] = pk2(v4[2], v4[3]); }
        rs = sum16(rs); rs = sum32(rs);
        float qn = 0.f;
#pragma unroll
        for (int ks = 0; ks < 4; ++ks) { const f32x4 n0 = *(const LAS f32x4*)(nl + 32 * ks + 8 * g), n1 = *(const LAS f32x4*)(nl + 32 * ks + 8 * g + 4);
#pragma unroll
            for (int e = 0; e < 4; ++e) { qn += bf2f((bf16_t)qf[ks][e]) * n0[e]; qn += bf2f((bf16_t)qf[ks][4 + e]) * n1[e]; } }
        qn = sum16(qn); qn = sum32(qn);
        if (vh == 0 && g == 0) { rsl[tl] = rs; qnl[tl] = qn; }
        f32x4 av[2], qc[2];
#pragma unroll
        for (int vt = 0; vt < 2; ++vt) { av[vt] = (f32x4){0.f, 0.f, 0.f, 0.f}; qc[vt] = (f32x4){0.f, 0.f, 0.f, 0.f}; }
        {   const unsigned vb = (unsigned)(unsigned long)(lds + OFF_V) + trl16 + (unsigned)(4 * g * VP + (32 * vh) * 2);
            const unsigned cb = (unsigned)(unsigned long)(lds + OFF_CB) + trl16 + (unsigned)(8 * g * VP + (32 * vh) * 2);
            s16x4 va[2][2][2], ca[4][2][2];
#pragma unroll
            for (int vt = 0; vt < 2; ++vt) {
                if (vt == 0) { va[0][0][0] = tr_read<0 * VP>(vb); va[0][0][1] = tr_read<16 * VP>(vb); va[1][0][0] = tr_read<32 * VP>(vb); va[1][0][1] = tr_read<48 * VP>(vb);
                    ca[0][0][0] = tr_read<0 * VP>(cb); ca[0][0][1] = tr_read<4 * VP>(cb); ca[1][0][0] = tr_read<32 * VP>(cb); ca[1][0][1] = tr_read<36 * VP>(cb);
                    ca[2][0][0] = tr_read<64 * VP>(cb); ca[2][0][1] = tr_read<68 * VP>(cb); ca[3][0][0] = tr_read<96 * VP>(cb); ca[3][0][1] = tr_read<100 * VP>(cb); }
                else { va[0][1][0] = tr_read<0 * VP + 32>(vb); va[0][1][1] = tr_read<16 * VP + 32>(vb); va[1][1][0] = tr_read<32 * VP + 32>(vb); va[1][1][1] = tr_read<48 * VP + 32>(vb);
                    ca[0][1][0] = tr_read<0 * VP + 32>(cb); ca[0][1][1] = tr_read<4 * VP + 32>(cb); ca[1][1][0] = tr_read<32 * VP + 32>(cb); ca[1][1][1] = tr_read<36 * VP + 32>(cb);
                    ca[2][1][0] = tr_read<64 * VP + 32>(cb); ca[2][1][1] = tr_read<68 * VP + 32>(cb); ca[3][1][0] = tr_read<96 * VP + 32>(cb); ca[3][1][1] = tr_read<100 * VP + 32>(cb); } }
            asm volatile("s_waitcnt lgkmcnt(0)" ::: "memory"); __builtin_amdgcn_sched_barrier(0);
#pragma unroll
            for (int vt = 0; vt < 2; ++vt) {
#pragma unroll
                for (int pp = 0; pp < 2; ++pp) { const bf16x8 bfv = (bf16x8){va[pp][vt][0][0], va[pp][vt][0][1], va[pp][vt][0][2], va[pp][vt][0][3], va[pp][vt][1][0], va[pp][vt][1][1], va[pp][vt][1][2], va[pp][vt][1][3]};
                    const u32x4_t aw = (u32x4_t){ap[4 * pp], ap[4 * pp + 1], ap[4 * pp + 2], ap[4 * pp + 3]};
                    av[vt] = __builtin_amdgcn_mfma_f32_16x16x32_bf16(__builtin_bit_cast(bf16x8, aw), bfv, av[vt], 0, 0, 0); }
#pragma unroll
                for (int ks = 0; ks < 4; ++ks) { const bf16x8 bfc = (bf16x8){ca[ks][vt][0][0], ca[ks][vt][0][1], ca[ks][vt][0][2], ca[ks][vt][0][3], ca[ks][vt][1][0], ca[ks][vt][1][1], ca[ks][vt][1][2], ca[ks][vt][1][3]};
                    qc[vt] = __builtin_amdgcn_mfma_f32_16x16x32_bf16(qf[ks], bfc, qc[vt], 0, 0, 0); } }
        }
        const float M63 = fmaxf(mprev, gam[c0 + 63]); const float decay = __expf(mprev - M63);
        {   const unsigned kb = (unsigned)(unsigned long)(lds + OFF_K) + trl32k + (unsigned)(8 * hi * QP + (32 * dt) * 2);
            const unsigned wb = (unsigned)(unsigned long)(lds + OFF_WV) + trl32v + (unsigned)(8 * hi * VP + (32 * vt2) * 2);
            s16x4 ka[4][2], wa[4][2];
            ka[0][0] = tr_read<0 * QP>(kb); ka[0][1] = tr_read<4 * QP>(kb); ka[1][0] = tr_read<16 * QP>(kb); ka[1][1] = tr_read<20 * QP>(kb);
            ka[2][0] = tr_read<32 * QP>(kb); ka[2][1] = tr_read<36 * QP>(kb); ka[3][0] = tr_read<48 * QP>(kb); ka[3][1] = tr_read<52 * QP>(kb);
            wa[0][0] = tr_read<0 * VP>(wb); wa[0][1] = tr_read<4 * VP>(wb); wa[1][0] = tr_read<16 * VP>(wb); wa[1][1] = tr_read<20 * VP>(wb);
            wa[2][0] = tr_read<32 * VP>(wb); wa[2][1] = tr_read<36 * VP>(wb); wa[3][0] = tr_read<48 * VP>(wb); wa[3][1] = tr_read<52 * VP>(wb);
            asm volatile("s_waitcnt lgkmcnt(0)" ::: "memory"); __builtin_amdgcn_sched_barrier(0);
#pragma unroll
            for (int e = 0; e < 16; ++e) cacc[e] *= decay;
#pragma unroll
            for (int ks = 0; ks < 4; ++ks) { const bf16x8 fa = (bf16x8){ka[ks][0][0], ka[ks][0][1], ka[ks][0][2], ka[ks][0][3], ka[ks][1][0], ka[ks][1][1], ka[ks][1][2], ka[ks][1][3]};
                const bf16x8 fb = (bf16x8){wa[ks][0][0], wa[ks][0][1], wa[ks][0][2], wa[ks][0][3], wa[ks][1][0], wa[ks][1][1], wa[ks][1][2], wa[ks][1][3]};
                cacc = __builtin_amdgcn_mfma_f32_32x32x16_bf16(fa, fb, cacc, 0, 0, 0); } }
        { const int d_ = tid & 127, part_ = tid >> 7; float acc = 0.f;
#pragma unroll
            for (int s = 0; s < 16; ++s) acc += wl[16 * part_ + s] * bf2f(*(const LAS bf16_t*)(lds + OFF_K + (16 * part_ + s) * QP + d_ * 2));
            ((LAS float*)(lds + LDS_CONST))[part_ * 128 + d_] = acc; }
        if (ck < 24) { PREP_WRITE(); if (ck + 1 < 24) PREP_LOAD(ck + 1); }
        __syncthreads();
        if (ck < 24) PREP_STORE(ck);
        { const int tr0 = 16 * tt + 4 * g;
          const f32x4 gam4 = *(const LAS f32x4*)(gam + c0 + tr0), gb4 = *(const LAS f32x4*)(gb + c0 + tr0), rs4 = *(const LAS f32x4*)(rsl + tr0), qn4 = *(const LAS f32x4*)(qnl + tr0);
          bf16_t* hp = hs_out + (size_t)(c0 + tr0) * hs_stride;
#pragma unroll
          for (int r = 0; r < 4; ++r) { const float Mr = fmaxf(mprev, gam4[r]); const float inter = __expf(mprev - Mr), mt = gb4[r] + Mr;
            const float den = rs4[r] + inter * qn4[r]; const float dd = __builtin_amdgcn_rcpf(fmaxf(fabsf(den), __expf(-mt)));
#pragma unroll
            for (int vt = 0; vt < 2; ++vt) { const float hv = (av[vt][r] + inter * qc[vt][r]) * dd; hp[(size_t)r * hs_stride + 16 * vt] = f2bf(hv); } } }
#pragma unroll
        for (int e = 0; e < 16; ++e) { const int d = 32 * dt + (e & 3) + 8 * (e >> 2) + 4 * hi; *(LAS bf16_t*)(lds + OFF_CB + d * VP + (32 * vt2 + r32) * 2) = f2bf(cacc[e]); }
        if (tid < 128) { const LAS float* np_ = (const LAS float*)(lds + LDS_CONST); nreg = decay * nreg + ((np_[tid] + np_[128 + tid]) + (np_[256 + tid] + np_[384 + tid])); nl[tid] = nreg; }
        if (ck + 1 < 32) ML_STORE(ck + 1);
        __syncthreads();
    }
#undef ML_LOAD
#undef ML_STORE
#undef PREP_LOAD
#undef PREP_WRITE
#undef PREP_STORE
}

__device__ __forceinline__ void phase_ml_gate(const Params& p, const Frame& F, unsigned char* a8) {
    const int step = F.G * 8;
#pragma unroll 1
    for (int gw = F.bid * 8 + F.wave; gw < T * 4; gw += 4 * step) { uint2 hv2[4]; unsigned ov[4];
#pragma unroll
        for (int k = 0; k < 4; ++k) { const int g_ = gw + k * step; const bf16_t* pr = p.proj + (size_t)(g_ >> 2) * 3072 + (g_ & 3) * 256 + 4 * F.lane; hv2[k] = *(const uint2*)(pr + 1024); ov[k] = *(const unsigned*)((const unsigned char*)(p.proj + (size_t)(g_ >> 2) * 3072 + 2048) + (g_ & 3) * 256 + 4 * F.lane); }
#pragma unroll
        for (int k = 0; k < 4; ++k) { const int g_ = gw + k * step, t = g_ >> 2, h = g_ & 3; const float4 g4 = *(const float4*)(p.ml_ng + h * 256 + 4 * F.lane);
            const float h0 = __uint_as_float(hv2[k].x << 16), h1 = __uint_as_float(hv2[k].x & 0xFFFF0000u), h2 = __uint_as_float(hv2[k].y << 16), h3 = __uint_as_float(hv2[k].y & 0xFFFF0000u);
            float ss = h0 * h0 + h1 * h1 + h2 * h2 + h3 * h3; ss = wave_sum(ss); const float rs = rsqrtf(ss * (1.f / 256.f) + 1e-6f) * (F8_SA / 256.f);
            *(unsigned*)(a8 + (size_t)t * D + h * 256 + 4 * F.lane) = pk4_fp8(fp8f(ov[k], 0) * h0 * rs * g4.x, fp8f(ov[k], 1) * h1 * rs * g4.y, fp8f(ov[k], 2) * h2 * rs * g4.z, fp8f(ov[k], 3) * h3 * rs * g4.w); } }
}
__device__ __forceinline__ void phase_final(const Params& p, const Frame& F, float* dst) {
    const float* mg = p.mod + (size_t)16 * 6144 + 5 * D;
    for (size_t i4 = (size_t)F.bid * NTHR + F.tid; i4 < (size_t)T * D / 4; i4 += (size_t)F.G * NTHR) { const size_t i = i4 * 4; const int col = (int)(i % D), row = (int)(i / D), b = row / S;
        const uint2 xw = *(const uint2*)(p.xb13 + i); const float4 xv = make_float4(__uint_as_float(xw.x << 16), __uint_as_float(xw.x & 0xFFFF0000u), __uint_as_float(xw.y << 16), __uint_as_float(xw.y & 0xFFFF0000u)); float4 g = *(const float4*)(mg + b * 6144 + col); g.x *= 1.f / F8_SO; g.y *= 1.f / F8_SO; g.z *= 1.f / F8_SO; g.w *= 1.f / F8_SO; const unsigned a0 = *(const unsigned*)((const unsigned char*)p.outk + i), a1 = *(const unsigned*)((const unsigned char*)p.outk + (size_t)T * D + i);
        float4 o; o.x = xv.x + g.x * (fp8f(a0, 0) + fp8f(a1, 0)); o.y = xv.y + g.y * (fp8f(a0, 1) + fp8f(a1, 1));
        o.z = xv.z + g.z * (fp8f(a0, 2) + fp8f(a1, 2)); o.w = xv.w + g.w * (fp8f(a0, 3) + fp8f(a1, 3));
        *(float4*)(dst + i) = o; }
}

__global__ void __launch_bounds__(NTHR, 2) mega_fwd(Params p) {
    extern __shared__ __attribute__((aligned(16))) unsigned char lds_raw[];
    Frame F; F.lds = (LAS unsigned char*)lds_raw; F.tid = threadIdx.x; F.lane = F.tid & 63; F.wave = __builtin_amdgcn_readfirstlane(F.tid >> 6); F.bid = blockIdx.x; F.G = gridDim.x;
    volatile LAS unsigned* misc = (volatile LAS unsigned*)(F.lds + LDS_MISC);
    LAS Params* P = (LAS Params*)(F.lds + LDS_PARAMS);
    if (F.tid < 16) misc[F.tid] = 0u;
    if (F.tid == 64) {
#define X(t, n) P->n = p.n;
        PARAM_LIST(X)
#undef X
    }
    __syncthreads();
    { XcdBarrier b0 = xcd_barrier_post(uni_ptr(P->bar), misc); if (F.tid == 0) misc[2] = b0.x; }
    __syncthreads();
#define GRID_BAR() do { XcdBarrier bb_; bb_.bar = uni_ptr(P->bar); bb_.x = (unsigned)__builtin_amdgcn_readfirstlane((int)misc[2]); bb_.st = misc; xcd_barrier(bb_, F.wave == 0 && lane_id_asm() == 0); } while (0)
    LAS unsigned char* stage = F.lds;
#define MOD0 (q.mod)
#define MOD1 (q.mod + (size_t)16 * 6144)

    { Params q; LP(rope); LP(h); phase_prologue_a(q, launder(F)); }
    { Params q; LP(c); LP(ada_w); LP(ada_b); LP(mod); LP(cmp_pe); LP(cmp_w1); LP(cmp_b1); LP(cb1); phase_prologue_b(q, launder(F)); }
    { Params q; LP(nsa_w_in); LP(win_nsa_t); prep_weights<true>(launder(F), q.win_nsa_t, 2048, D, NSA_COLS, ColPlain{q.nsa_w_in, NSA_COLS, 0}, F.bid, F.G, F8_SW); }
    { Params q; LP(nsa_w_out); LP(wo_nsa_t); prep_weights<true>(launder(F), q.wo_nsa_t, D, D, D, ColPlain{q.nsa_w_out, D, 0}, F.bid, F.G, F8_SW); }
    { Params q; LP(ml_w_in); LP(win_ml_t); prep_weights<true>(launder(F), q.win_ml_t, 3072, D, ML_COLS, ColPlain{q.ml_w_in, 3072, 0}, F.bid, F.G, F8_SW); }
    { Params q; LP(ml_w_out); LP(wo_ml_t); prep_weights<true>(launder(F), q.wo_ml_t, D, D, D, ColPlain{q.ml_w_out, D, 0}, F.bid, F.G, F8_SW); }
    { Params q; LP(cmp_w1); LP(w1c_t); prep_weights(launder(F), q.w1c_t, 256, 2048, 256, ColPlain{q.cmp_w1, 256, 0}, F.bid, F.G);
      prep_weights(launder(F), q.w1c_t + (size_t)256 * 2048, 256, 2048, 256, ColPlain{q.cmp_w1 + (size_t)2048 * 256, 256, 0}, F.bid, F.G); }
    { Params q; LP(w_gate); LP(w_up); LP(w_down); LP(gu_t); LP(dn_t); prep_moe_weights(q, launder(F), 0, F.bid, F.G); }
    GRID_BAR();
    { Params q; LP(x); LP(g_mix); LP(mod); LP(h);
      phase_norm<0, false>(q, launder(F), q.x, nullptr, q.g_mix, MOD0 + 0 * D, MOD0 + 1 * D, nullptr, 0); }
    GRID_BAR();
    { Params q; LP(h); LP(win_nsa_t); LP(q_gain); LP(k_gain); LP(rope); LP(q); LP(kv); LP(gates);
      ge::DenseOrder So; So.init(T, 2048, F.G, F.bid);
      ge::gemm_phase<true>(stage, q.h, q.win_nsa_t, D, So, ge::DenseRows{(unsigned)D}, EpiNsaIn{q.q_gain, q.k_gain, q.rope, q.q, q.kv, q.gates, 1.f / (F8_SA * F8_SW)}, F.wave); }
    GRID_BAR();
    {
      Params q; LP(kv); LP(w1c_t); LP(cpart);
      const int w = F.bid >> 7, mt = (F.bid >> 3) & 15, ks = F.bid & 7; OneUnit So{mt};
      ge::gemm_phase(stage, q.kv + (size_t)w * T * 128 + ks * 256, q.w1c_t + (size_t)w * 256 * 2048 + ks * 256, 256, So, ge::DenseRows{2048u}, EpiCmpPart{(float*)((bf16_t*)q.cpart + (size_t)(w * 8 + ks) * 4096 * 256)}, F.wave, 2048); }
    GRID_BAR();
    { Params q; LP(cpart); LP(cb1); LP(cmp_w2); LP(cmp_b2); LP(k_gain); LP(rope); LP(kcmp); LP(vcmp);
      phase_cmp2(q, launder(F)); }
    GRID_BAR();
    { Params q; LP(q); LP(kv); LP(kcmp); LP(vcmp); LP(gates); LP(h); LP(q_gain); LP(k_gain);
      phase_attn(q, launder(F)); }
    GRID_BAR();
    { Params q; LP(h); LP(wo_nsa_t); LP(x); LP(mod); LP(xb13);
      ge::DenseOrder So; So.init(T, D, F.G, F.bid);
      ge::gemm_phase<true>(stage, q.h, q.wo_nsa_t, D, So, ge::DenseRows{(unsigned)D}, EpiResid<false>{q.x, MOD0 + 2 * D, q.xb13, 1.f / (F8_SA * F8_SW)}, F.wave); }
    GRID_BAR();
    { Params q; LP(xb13); LP(g_ffn); LP(mod); LP(h); LP(router_w); LP(router_b); LP(tokw); LP(cnt); LP(list);
      phase_norm_route(q, launder(F), q.xb13, q.g_ffn, MOD0 + 3 * D, MOD0 + 4 * D, 0); }
    GRID_BAR();
    { Params q; LP(cnt); LP(list); LP(h); LP(gu_t); LP(hid);
      LAS int* mtab = (LAS int*)(F.lds + LDS_MISC + 64); LAS int* tkt = (LAS int*)(F.lds + LDS_CONST); moe_plan(launder(F), q.cnt, q.list, mtab, tkt, 4); MoeOrder So{mtab};
      ge::gemm_phase<true>(stage, q.h, q.gu_t, D, So, MoeRows{tkt}, EpiMoe1{(unsigned char*)q.hid, 1.f / (F8_SA * F8_SW)}, F.wave); }
    GRID_BAR();
    { Params q; LP(cnt); LP(list); LP(hid); LP(dn_t); LP(outk); LP(tokw);
      LAS int* mtab = (LAS int*)(F.lds + LDS_MISC + 64); LAS int* tkt = (LAS int*)(F.lds + LDS_CONST); LAS float* tkw = (LAS float*)(F.lds + 131072); moe_plan(launder(F), q.cnt, q.list, mtab, tkt, 4, q.tokw, tkw, F8_SO / (F8_SH * F8_SW2)); MoeOrder So{mtab};
      ge::gemm_phase<true>(stage, q.hid, q.dn_t, DE, So, ge::DenseRows{(unsigned)DE}, EpiMoe2{q.outk, tkt, tkw}, F.wave); }
    GRID_BAR();
    { Params q; LP(xb13); LP(xb2); LP(g_mix); LP(mod); LP(h); LP(outk); LP(ml_w_in); LP(ml_bi); LP(ml_bf); LP(li); LP(lf);
      phase_norm<2, true>(q, launder(F), q.xb13, q.xb2, q.g_mix + D, MOD1 + 0 * D, MOD1 + 1 * D, MOD0 + 5 * D, 1); }
    GRID_BAR();
    { Params q; LP(h); LP(win_ml_t); LP(proj);
      ge::DenseOrder So; So.init(T, 3072, F.G, F.bid);
      ge::gemm_phase<true>(stage, q.h, q.win_ml_t, D, So, ge::DenseRows{(unsigned)D}, EpiMlIn{q.proj, 1.f / (F8_SA * F8_SW)}, F.wave); }
    GRID_BAR();
    { Params q; LP(proj); LP(li); LP(lf); LP(w_gate); LP(w_up); LP(w_down); LP(gu_t); LP(dn_t);
      phase_scan(q, launder(F), q.proj + 1024, 3072); }
    GRID_BAR();
    { Params q; LP(proj); LP(ml_ng); LP(h);
      phase_ml_gate(q, launder(F), (unsigned char*)q.h); }
    GRID_BAR();
    { Params q; LP(h); LP(wo_ml_t); LP(xb2); LP(mod); LP(xb13);
      ge::DenseOrder So; So.init(T, D, F.G, F.bid);
      ge::gemm_phase<true>(stage, q.h, q.wo_ml_t, D, So, ge::DenseRows{(unsigned)D}, EpiResid<true>{q.xb2, MOD1 + 2 * D, q.xb13, 1.f / (F8_SA * F8_SW)}, F.wave); }
    GRID_BAR();
    { Params q; LP(xb13); LP(g_ffn); LP(mod); LP(h); LP(router_w); LP(router_b); LP(tokw); LP(cnt); LP(list);
      phase_norm_route(q, launder(F), q.xb13, q.g_ffn + D, MOD1 + 3 * D, MOD1 + 4 * D, 1); }
    GRID_BAR();
    { Params q; LP(cnt); LP(list); LP(h); LP(gu_t); LP(hid);
      LAS int* mtab = (LAS int*)(F.lds + LDS_MISC + 64); LAS int* tkt = (LAS int*)(F.lds + LDS_CONST); moe_plan(launder(F), q.cnt + 64, q.list, mtab, tkt, 4); MoeOrder So{mtab};
      ge::gemm_phase<true>(stage, q.h, q.gu_t, D, So, MoeRows{tkt}, EpiMoe1{(unsigned char*)q.hid, 1.f / (F8_SA * F8_SW)}, F.wave); }
    GRID_BAR();
    { Params q; LP(cnt); LP(list); LP(hid); LP(dn_t); LP(outk); LP(tokw);
      LAS int* mtab = (LAS int*)(F.lds + LDS_MISC + 64); LAS int* tkt = (LAS int*)(F.lds + LDS_CONST); LAS float* tkw = (LAS float*)(F.lds + 131072); moe_plan(launder(F), q.cnt + 64, q.list, mtab, tkt, 4, q.tokw, tkw, F8_SO / (F8_SH * F8_SW2)); MoeOrder So{mtab};
      ge::gemm_phase<true>(stage, q.hid, q.dn_t, DE, So, ge::DenseRows{(unsigned)DE}, EpiMoe2{q.outk, tkt, tkw}, F.wave); }
    GRID_BAR();
    { Params q; LP(mod); LP(out); LP(outk); LP(xb13);
      phase_final(q, launder(F), q.out); }
}

static inline size_t al(size_t x) { return (x + 255) & ~(size_t)255; }
extern "C" void kernel_launch(void* const* d_in, const int* in_sizes, int n_in, void* d_out, int out_size, void* d_ws, size_t ws_size, hipStream_t stream) {
    char* ws = (char*)d_ws; size_t off = 0;
    auto take = [&](size_t bytes) { size_t o = off; off = al(off + bytes); return o; };
    Params p{};
    const float** pin = (const float**)&p;
    for (int i = 0; i < 25; ++i) pin[i] = (const float*)d_in[i];
    p.out = (float*)d_out;
    const size_t ctl_bytes = (size_t)XCD_BAR_WORDS * 4 + 1024;
    p.bar = (unsigned*)(ws + take(ctl_bytes)); p.cnt = (int*)(p.bar + XCD_BAR_WORDS); p.dcnt = p.cnt + 128;
    p.mod = (float*)(ws + take((size_t)2 * 16 * 6144 * 4)); p.rope = (float*)(ws + take(2048 * 16 * 4)); p.cb1 = (float*)(ws + take(512 * 4));
    p.tokw = (float*)(ws + take((size_t)T * 2 * 4)); p.list = (int*)(ws + take((size_t)NE * T * 4)); p.dlist = (int*)(ws + take((size_t)NE * T * 4)); p.li = (float*)(ws + take((size_t)T * 4 * 4)); p.lf = (float*)(ws + take((size_t)T * 4 * 4));
    p.h = (bf16_t*)(ws + take((size_t)(T + 8) * D * 2)); p.hidc = (bf16_t*)(ws + take((size_t)2 * 4096 * 256 * 2)); p.xb13 = (bf16_t*)(ws + take((size_t)T * D * 2)); p.xb2 = (bf16_t*)(ws + take((size_t)T * D * 2));
    p.wo_nsa_t = (bf16_t*)(ws + take((size_t)D * D * 2)); p.wo_ml_t = (bf16_t*)(ws + take((size_t)D * D * 2));
    p.win_nsa_t = (bf16_t*)(ws + take((size_t)2048 * D * 2)); p.win_ml_t = (bf16_t*)(ws + take((size_t)3072 * D * 2)); p.w1c_t = (bf16_t*)(ws + take((size_t)2 * 256 * 2048 * 2));
    p.gu_t = (bf16_t*)(ws + take((size_t)NE * 1024 * D * 2)); p.dn_t = (bf16_t*)(ws + take((size_t)NE * D * DE * 2));
    const size_t r1 = off;
    p.q = (bf16_t*)(ws + take((size_t)T * D * 2)); p.kv = (bf16_t*)(ws + take((size_t)6 * T * 128 * 2 + (1 << 20)));
    p.gates = (float*)(ws + take((size_t)T * 48 * 4)); p.kcmp = (bf16_t*)(ws + take((size_t)32 * 128 * 64 * 2)); p.vcmp = (bf16_t*)(ws + take((size_t)32 * 128 * 64 * 2));
    p.cpart = (float*)(ws + take((size_t)2 * 8 * 4096 * 256 * 4));
    const size_t end_nsa = off; off = r1;
    p.proj = (bf16_t*)(ws + take((size_t)T * 3072 * 2)); const size_t end_ml = off; off = r1;
    p.hid = (bf16_t*)(ws + take((size_t)(65536 + 8192) * DE * 2)); p.outk = (bf16_t*)(ws + take((size_t)2 * T * D * 2)); const size_t end_moe = off;
    size_t need = end_nsa > end_ml ? end_nsa : end_ml; if (end_moe > need) need = end_moe;
    if (need > ws_size || n_in != 25) return;
    static bool attr_done = false;
    if (!attr_done) { (void)hipFuncSetAttribute((const void*)mega_fwd, hipFuncAttributeMaxDynamicSharedMemorySize, LDS_BYTES); attr_done = true; }
    (void)hipMemsetAsync(p.bar, 0, ctl_bytes, stream);
    hipLaunchKernelGGL(mega_fwd, dim3(NWG), dim3(NTHR), LDS_BYTES, stream, p);
}
```
